# Optimizing an MI355X kernel written in HIP

```python
import math
import jax, jax.numpy as jnp
from jax import lax
import numpy as np

D_MODEL = 1024
BATCH = 8
SEQ = 2048
DEPTH = 4

GRID_W = 64
CTX_LEN = 256
HEAD_DIM = 64
ROPE_THETA = 10000.0
NORM_EPS = 1e-6
Q_BLOCK = 128
A_HEADS = 4
A_KV_HEADS = 2
B_HEADS = 4
B_QK_DIM = 32
B_V_DIM = 2 * B_QK_DIM
C_HEADS = 8
C_HEAD = 64
C_WIDTH = C_HEADS * C_HEAD
C_DECAY_LORA = 64
C_ICL_LORA = 64
C_GATE_LORA = 128
N_DIR = 2
C_GN_EPS = 64e-5
A_Q = A_HEADS * HEAD_DIM
A_KV = A_KV_HEADS * HEAD_DIM
B_Q = B_HEADS * 2 * B_QK_DIM
B_V = B_HEADS * B_V_DIM
C_SLICE = 3 * C_WIDTH + N_DIR * C_DECAY_LORA + N_DIR * C_ICL_LORA + C_GATE_LORA
IN_SPLITS = (A_Q, A_Q + A_KV, A_Q + 2 * A_KV, A_Q + 2 * A_KV + B_Q, A_Q + 2 * A_KV + 2 * B_Q, A_Q + 2 * A_KV + 2 * B_Q + B_V)
IN_WIDTH = A_Q + 2 * A_KV + 2 * B_Q + B_V + C_SLICE
MIX_WIDTH = A_HEADS * HEAD_DIM + B_HEADS * B_V_DIM + C_WIDTH
N_GROUPS = 4
EXPERTS_PER_GROUP = 8
N_EXPERTS = N_GROUPS * EXPERTS_PER_GROUP
TOP_K = 2
EXPERT_FF = 512
EXPERT_BLOCK = 128

kernel_name = "hymba_style_diff_rwkv7_hier_moe_dit"


def rms_norm(x, gain, eps=NORM_EPS):
    xf = x.astype(jnp.float32)
    y = xf * lax.rsqrt(jnp.mean(xf * xf, axis=-1, keepdims=True) + eps)
    return (y * gain.astype(jnp.float32)).astype(x.dtype)


def ada_norm(x, gain, shift, scale):
    return rms_norm(x, gain) * (1 + scale) + shift


def axial_rope_tables(row_idx, col_idx, dim):
    half = dim // 2
    inv = ROPE_THETA ** (-jnp.arange(0, half, 2, dtype=jnp.float32) / half)
    ar = row_idx.astype(jnp.float32)[:, None] * inv
    ac = col_idx.astype(jnp.float32)[:, None] * inv
    ang = jnp.concatenate([ar, ar, ac, ac], axis=-1)
    return jnp.cos(ang), jnp.sin(ang)


def rotate_halves(x):
    q = x.shape[-1] // 4
    x = x.reshape(x.shape[:-1] + (2, 2, q))
    x = jnp.stack([-x[..., 1, :], x[..., 0, :]], axis=-2)
    return x.reshape(x.shape[:-3] + (4 * q,))


def apply_rope(x, cos, sin):
    xf = x.astype(jnp.float32)
    return (xf * cos + rotate_halves(xf) * sin).astype(x.dtype)


def split_combined(p):
    bsz, t = p.shape[:2]
    aq, ak, av, bq, bk, bv, cp = jnp.split(p, list(IN_SPLITS), axis=-1)
    return (aq.reshape(bsz, t, A_HEADS, HEAD_DIM), ak.reshape(bsz, t, A_KV_HEADS, HEAD_DIM),
            av.reshape(bsz, t, A_KV_HEADS, HEAD_DIM), bq.reshape(bsz, t, B_HEADS, 2, B_QK_DIM),
            bk.reshape(bsz, t, B_HEADS, 2, B_QK_DIM), bv.reshape(bsz, t, B_HEADS, B_V_DIM), cp)


def sweep_query_blocks(attend, q, *args):
    b, s = q.shape[:2]
    nb = s // Q_BLOCK
    qb = jnp.moveaxis(q.reshape((b, nb, Q_BLOCK) + q.shape[2:]), 1, 0)
    out = lax.map(lambda blk: attend(blk, *args), qb)
    return jnp.moveaxis(out, 0, 1).reshape(b, s, -1)


def gqa_attend(q, k, v):
    b, t, h, d = q.shape
    kvh = k.shape[2]
    qg = q.reshape(b, t, kvh, h // kvh, d)
    s = jnp.einsum('btkgd,bskd->bkgts', qg, k, preferred_element_type=jnp.float32) * (d ** -0.5)
    p = jax.nn.softmax(s, axis=-1).astype(v.dtype)
    o = jnp.einsum('bkgts,bskd->btkgd', p, v)
    return o.reshape(b, t, h * d)


def diff_attend(q, k, v, lam):
    b, t = q.shape[:2]
    d = q.shape[-1]
    s = jnp.einsum('bthmd,bshmd->bhmts', q, k, preferred_element_type=jnp.float32) * (d ** -0.5)
    p = jax.nn.softmax(s, axis=-1)
    a = (p[:, :, 0] - lam * p[:, :, 1]).astype(v.dtype)
    o = jnp.einsum('bhts,bshe->bthe', a, v)
    return o.reshape(b, t, -1)


def diff_head_norm(o, gain, lam_init):
    b, t = o.shape[:2]
    o = rms_norm(o.reshape(b, t, B_HEADS, B_V_DIM), gain) * (1.0 - lam_init)
    return o.reshape(b, t, B_HEADS * B_V_DIM)


def rwkv_inputs(p, mu, w0, w2, a0, a2, g2, k_k, k_a):
    prev = jnp.pad(p[:, :-1], ((0, 0), (1, 0), (0, 0)))
    nxt = jnp.pad(p[:, 1:], ((0, 0), (0, 1), (0, 0)))
    pf = (p + mu * (0.5 * (prev + nxt) - p)).astype(jnp.float32)
    o1 = C_WIDTH; o2 = 2 * C_WIDTH; o3 = 3 * C_WIDTH
    o4 = o3 + N_DIR * C_DECAY_LORA; o5 = o4 + N_DIR * C_ICL_LORA
    r, k, v, wd, ad, gd = jnp.split(pf, [o1, o2, o3, o4, o5], axis=-1)
    bsz, t = p.shape[:2]
    wd = wd.reshape(bsz, t, N_DIR, C_DECAY_LORA)
    ad = ad.reshape(bsz, t, N_DIR, C_ICL_LORA)
    wlog = -jax.nn.softplus(-(w0 + jnp.einsum('btzr,zrc->btzc', jnp.tanh(wd), w2))) - 0.5
    decay = jnp.exp(-jnp.exp(wlog))
    icl = jax.nn.sigmoid(a0 + jnp.einsum('btzr,zrc->btzc', ad, a2))
    g = jax.nn.sigmoid(gd) @ g2.astype(jnp.float32)
    heads = lambda z: z.reshape(z.shape[:-1] + (C_HEADS, C_HEAD))
    kk = heads(k * k_k)
    kk = kk / jnp.maximum(jnp.sqrt(jnp.sum(kk * kk, axis=-1, keepdims=True)), 1e-12)
    k_dir = k[:, :, None] * (1 + (icl - 1) * k_a)
    return heads(r), heads(k_dir), heads(v), heads(decay), heads(icl), kk, g


def rwkv_direction(inp, z):
    r, kd, v, dec, icl, kk, g = inp
    return r, dec[:, :, z], kd[:, :, z], v, -kk, kk * icl[:, :, z]


def wkv7_scan(state0, r, w, k, v, a, b, reverse, emit):
    xs = tuple(jnp.moveaxis(t_, 1, 0) for t_ in (r, w, k, v, a, b))

    def step(S, inp):
        r_t, w_t, k_t, v_t, a_t, b_t = inp
        sa = jnp.einsum('bhvk,bhk->bhv', S, a_t)
        S = S * w_t[:, :, None, :] + sa[..., None] * b_t[:, :, None, :] + v_t[..., None] * k_t[:, :, None, :]
        y = jnp.einsum('bhvk,bhk->bhv', S, r_t) if emit else None
        return S, y

    S, ys = lax.scan(step, state0, xs, reverse=reverse)
    return S, (jnp.moveaxis(ys, 0, 1) if emit else None)


def rwkv_readout(y_dirs, inp, r_k, ln_w, ln_b):
    r, kd, v, dec, icl, kk, g = inp
    y = y_dirs[0] + y_dirs[1]
    mean = jnp.mean(y, axis=-1, keepdims=True)
    var = jnp.mean(jnp.square(y - mean), axis=-1, keepdims=True)
    y = (y - mean) * lax.rsqrt(var + C_GN_EPS) * ln_w.reshape(C_HEADS, C_HEAD) + ln_b.reshape(C_HEADS, C_HEAD)
    bonus = jnp.sum(jnp.sum(r[:, :, None] * kd * r_k, axis=-1, keepdims=True) * v[:, :, None], axis=2)
    bsz, t = y.shape[:2]
    return (y + bonus).reshape(bsz, t, C_WIDTH) * g


def routed_experts(t, experts, gates, w1, w3, w2):
    n_tok, d = t.shape
    n_assign = n_tok * TOP_K
    n_exp = w1.shape[0]
    n_blocks = (n_assign + n_exp * (EXPERT_BLOCK - 1) + EXPERT_BLOCK - 1) // EXPERT_BLOCK
    n_rows = n_blocks * EXPERT_BLOCK
    flat_e = experts.reshape(-1)
    order = jnp.argsort(flat_e)
    sorted_e = flat_e[order]
    counts = jnp.bincount(flat_e, length=n_exp)
    padded = (counts + EXPERT_BLOCK - 1) // EXPERT_BLOCK * EXPERT_BLOCK
    pad_end = jnp.cumsum(padded)
    pad_start = pad_end - padded
    raw_start = jnp.cumsum(counts) - counts
    dest = pad_start[sorted_e] + jnp.arange(n_assign, dtype=jnp.int32) - raw_start[sorted_e]
    row_tok = jnp.full((n_rows,), n_tok, jnp.int32).at[dest].set((order // TOP_K).astype(jnp.int32))
    row_gate = jnp.zeros((n_rows,), jnp.float32).at[dest].set(gates.reshape(-1)[order])
    block_exp = jnp.minimum(jnp.searchsorted(pad_end, jnp.arange(n_blocks, dtype=jnp.int32) * EXPERT_BLOCK, side='right'), n_exp - 1)
    t_pad = jnp.concatenate([t, jnp.zeros((1, d), t.dtype)], axis=0)

    def expert_block(args):
        rows, e = args
        xb = t_pad[rows]
        h = jax.nn.silu(xb @ w1[e]) * (xb @ w3[e])
        return h @ w2[e]

    y_rows = lax.map(expert_block, (row_tok.reshape(n_blocks, EXPERT_BLOCK), block_exp))
    y_rows = y_rows.reshape(n_rows, d) * row_gate[:, None].astype(t.dtype)
    out = jnp.zeros((n_tok + 1, d), t.dtype).at[row_tok].add(y_rows)
    return out[:n_tok]


def hier_moe(t, w_group, b_group, w_expert, b_expert, w1, w3, w2):
    n_tok = t.shape[0]
    tf = t.astype(jnp.float32)
    group_prob = jax.nn.softmax(tf @ w_group.astype(jnp.float32) + b_group, axis=-1)
    g_idx = jnp.argmax(group_prob, axis=-1).astype(jnp.int32)
    g_p = jnp.max(group_prob, axis=-1)
    e_logits = (tf @ w_expert.astype(jnp.float32) + b_expert).reshape(n_tok, N_GROUPS, EXPERTS_PER_GROUP)
    e_logits = jnp.take_along_axis(e_logits, g_idx[:, None, None], axis=1)[:, 0]
    top_v, top_i = lax.top_k(e_logits, TOP_K)
    gates = jax.nn.softmax(top_v, axis=-1) * g_p[:, None]
    experts = g_idx[:, None] * EXPERTS_PER_GROUP + top_i.astype(jnp.int32)
    return routed_experts(t, experts, gates, w1, w3, w2)


def setup_inputs(seed: int = 0) -> dict:
    key = jax.random.key(seed)
    ks = iter(jax.random.split(key, 40))
    f32 = jnp.float32
    nrm = lambda shape, s: jax.random.normal(next(ks), shape, f32) * s
    D = D_MODEL
    return {
        "x": nrm((BATCH, SEQ, D), 1.0),
        "c": nrm((BATCH, D), 1.0),
        "ctx": nrm((BATCH, CTX_LEN, D), 1.0),
        "c_ctx": nrm((D,), 1.0),
        "w_mod": nrm((DEPTH, D, 6 * D), 0.5 * D ** -0.5),
        "b_mod": nrm((DEPTH, 6 * D), 0.02),
        "g_mix": 1.0 + nrm((DEPTH, D), 0.05),
        "g_ffn": 1.0 + nrm((DEPTH, D), 0.05),
        "w_in": nrm((DEPTH, D, IN_WIDTH), D ** -0.5),
        "a_q_gain": 1.0 + nrm((DEPTH, HEAD_DIM), 0.05),
        "a_k_gain": 1.0 + nrm((DEPTH, HEAD_DIM), 0.05),
        "b_lq1": nrm((DEPTH, B_QK_DIM), 0.1),
        "b_lk1": nrm((DEPTH, B_QK_DIM), 0.1),
        "b_lq2": nrm((DEPTH, B_QK_DIM), 0.1),
        "b_lk2": nrm((DEPTH, B_QK_DIM), 0.1),
        "b_subln": 1.0 + nrm((DEPTH, B_V_DIM), 0.05),
        "c_mu": jax.random.uniform(next(ks), (DEPTH, C_SLICE), f32),
        "c_w0": jax.random.uniform(next(ks), (DEPTH, N_DIR, C_WIDTH), f32, -6.0, -1.0),
        "c_w2": nrm((DEPTH, N_DIR, C_DECAY_LORA, C_WIDTH), 0.1),
        "c_a0": nrm((DEPTH, N_DIR, C_WIDTH), 0.5),
        "c_a2": nrm((DEPTH, N_DIR, C_ICL_LORA, C_WIDTH), 0.1),
        "c_g2": nrm((DEPTH, C_GATE_LORA, C_WIDTH), C_GATE_LORA ** -0.5),
        "c_k_k": 0.85 + nrm((DEPTH, C_WIDTH), 0.05),
        "c_k_a": 1.0 + nrm((DEPTH, C_WIDTH), 0.05),
        "c_r_k": nrm((DEPTH, C_HEADS, C_HEAD), 0.1),
        "c_ln_w": 1.0 + nrm((DEPTH, C_WIDTH), 0.05),
        "c_ln_b": nrm((DEPTH, C_WIDTH), 0.01),
        "w_out": nrm((DEPTH, MIX_WIDTH, D), MIX_WIDTH ** -0.5),
        "r_w_group": nrm((DEPTH, D, N_GROUPS), D ** -0.5),
        "r_b_group": nrm((DEPTH, N_GROUPS), 0.01),
        "r_w_expert": nrm((DEPTH, D, N_EXPERTS), D ** -0.5),
        "r_b_expert": nrm((DEPTH, N_EXPERTS), 0.01),
        "e_w1": nrm((DEPTH, N_EXPERTS, D, EXPERT_FF), D ** -0.5),
        "e_w3": nrm((DEPTH, N_EXPERTS, D, EXPERT_FF), D ** -0.5),
        "e_w2": nrm((DEPTH, N_EXPERTS, EXPERT_FF, D), EXPERT_FF ** -0.5),
        "g_final": 1.0 + nrm((D,), 0.05),
    }


def reference(x, c, ctx, c_ctx, w_mod, b_mod, g_mix, g_ffn, w_in, a_q_gain, a_k_gain,
              b_lq1, b_lk1, b_lq2, b_lk2, b_subln, c_mu, c_w0, c_w2, c_a0, c_a2, c_g2,
              c_k_k, c_k_a, c_r_k, c_ln_w, c_ln_b, w_out, r_w_group, r_b_group,
              r_w_expert, r_b_expert, e_w1, e_w3, e_w2, g_final):
    bsz, n_lat, d = x.shape
    n_ctx = ctx.shape[1]
    ROWS = n_lat // GRID_W
    row_idx = jnp.repeat(jnp.arange(ROWS, dtype=jnp.int32), GRID_W)
    col_idx = jnp.tile(jnp.arange(GRID_W, dtype=jnp.int32), ROWS)
    cos_a, sin_a = axial_rope_tables(row_idx, col_idx, HEAD_DIM)
    cos_a, sin_a = cos_a[None, :, None, :], sin_a[None, :, None, :]
    cos_b, sin_b = axial_rope_tables(row_idx, col_idx, B_QK_DIM)
    cos_b, sin_b = cos_b[None, :, None, None, :], sin_b[None, :, None, None, :]
    act_c = jax.nn.silu(c)
    act_cc = jax.nn.silu(c_ctx)
    state0 = jnp.zeros((bsz, C_HEADS, C_HEAD, C_HEAD), jnp.float32)
    xc = ctx
    for i in range(DEPTH):
        update_ctx = i < DEPTH - 1
        mod_l = (act_c @ w_mod[i] + b_mod[i]).reshape(bsz, 6, 1, d)
        sh1, sc1, ga1, sh2, sc2, ga2 = [mod_l[:, j] for j in range(6)]
        mod_c = (act_cc @ w_mod[i] + b_mod[i]).reshape(6, d)
        csh1, csc1, cga1, csh2, csc2, cga2 = [mod_c[j] for j in range(6)]

        p_l = ada_norm(x, g_mix[i], sh1, sc1) @ w_in[i]
        p_c = ada_norm(xc, g_mix[i], csh1, csc1) @ w_in[i]
        aq_l, ak_l, av_l, bq_l, bk_l, bv_l, cp_l = split_combined(p_l)
        aq_c, ak_c, av_c, bq_c, bk_c, bv_c, cp_c = split_combined(p_c)

        aq_l = apply_rope(rms_norm(aq_l, a_q_gain[i]), cos_a, sin_a)
        ak_l = apply_rope(rms_norm(ak_l, a_k_gain[i]), cos_a, sin_a)
        ak_c = rms_norm(ak_c, a_k_gain[i])
        ak_all = jnp.concatenate([ak_c, ak_l], axis=1)
        av_all = jnp.concatenate([av_c, av_l], axis=1)
        ya_l = sweep_query_blocks(gqa_attend, aq_l, ak_all, av_all)

        lam_init = 0.8 - 0.6 * math.exp(-0.3 * i)
        lam = (jnp.exp(jnp.sum(b_lq1[i].astype(jnp.float32) * b_lk1[i].astype(jnp.float32)))
               - jnp.exp(jnp.sum(b_lq2[i].astype(jnp.float32) * b_lk2[i].astype(jnp.float32))) + lam_init)
        bq_l = apply_rope(bq_l, cos_b, sin_b)
        bk_l = apply_rope(bk_l, cos_b, sin_b)
        bk_all = jnp.concatenate([bk_c, bk_l], axis=1)
        bv_all = jnp.concatenate([bv_c, bv_l], axis=1)
        yb_l = diff_head_norm(sweep_query_blocks(diff_attend, bq_l, bk_all, bv_all, lam), b_subln[i], lam_init)

        rw = (c_mu[i], c_w0[i], c_w2[i], c_a0[i], c_a2[i], c_g2[i], c_k_k[i], c_k_a[i])
        cin_l = rwkv_inputs(cp_l, *rw)
        cin_c = rwkv_inputs(cp_c, *rw)
        yl_dirs, yc_dirs = [], []
        for z, rev in enumerate((False, True)):
            s_c, y_c = wkv7_scan(state0, *rwkv_direction(cin_c, z), reverse=rev, emit=update_ctx)
            _, y_l = wkv7_scan(s_c, *rwkv_direction(cin_l, z), reverse=rev, emit=True)
            yl_dirs.append(y_l)
            yc_dirs.append(y_c)
        yc_l = rwkv_readout(yl_dirs, cin_l, c_r_k[i], c_ln_w[i], c_ln_b[i]).astype(x.dtype)

        if update_ctx:
            ya_c = gqa_attend(rms_norm(aq_c, a_q_gain[i]), ak_c, av_c)
            yb_c = diff_head_norm(diff_attend(bq_c, bk_c, bv_c, lam), b_subln[i], lam_init)
            yc_c = rwkv_readout(yc_dirs, cin_c, c_r_k[i], c_ln_w[i], c_ln_b[i]).astype(xc.dtype)
            xc = xc + cga1 * (jnp.concatenate([ya_c, yb_c, yc_c], axis=-1) @ w_out[i])
        x = x + ga1 * (jnp.concatenate([ya_l, yb_l, yc_l], axis=-1) @ w_out[i])

        f_l = ada_norm(x, g_ffn[i], sh2, sc2).reshape(bsz * n_lat, d)
        if update_ctx:
            f_c = ada_norm(xc, g_ffn[i], csh2, csc2).reshape(bsz * n_ctx, d)
            tokens = jnp.concatenate([f_l, f_c], axis=0)
        else:
            tokens = f_l
        y = hier_moe(tokens, r_w_group[i], r_b_group[i], r_w_expert[i], r_b_expert[i], e_w1[i], e_w3[i], e_w2[i])
        x = x + ga2 * y[:bsz * n_lat].reshape(bsz, n_lat, d)
        if update_ctx:
            xc = xc + cga2 * y[bsz * n_lat:].reshape(bsz, n_ctx, d)
    return rms_norm(x, g_final)
```

```cpp
#include <hip/hip_runtime.h>
#include <stdint.h>
#include <stdio.h>

typedef unsigned short bfu;
using bf16x8 = __attribute__((ext_vector_type(8))) short;
using f32x4  = __attribute__((ext_vector_type(4))) float;

#define DM 1024
#define NB 8
#define SEQ 2048
#define CL 256
#define NKEY 2304
#define ML 16384
#define MC 2048
#define MA 18432
#define INW 3200
#define CSL 1920
#define NEXP 32
#define FF 512
#define NLAYER 4
#define LOG2E 1.4426950408889634f

#define MBy(x) ((size_t)(x) << 20)
constexpr size_t WS_CTL   = 0;
constexpr size_t WS_MOD   = 65536;
constexpr size_t WS_ROPE  = WS_MOD + (size_t)4 * 9 * 6144 * 4;
constexpr size_t WS_ECNT  = WS_ROPE + 64 * 16 * 2 * 4 + 64 * 8 * 2 * 4;
constexpr size_t WS_WRT   = WS_ECNT + 4096;
constexpr size_t WS_EIDX  = WS_WRT + (size_t)48 * 1024 * 4;
constexpr size_t WS_EGATE = WS_EIDX + (size_t)MA * 2 * 4;
constexpr size_t WS_ELIST = WS_EGATE + (size_t)MA * 2 * 4;
constexpr size_t WS_X     = MBy(8);
constexpr size_t WS_H     = WS_X + (size_t)MA * DM * 4;
constexpr size_t WS_WIN   = WS_H + (size_t)MA * DM * 2;
constexpr size_t WS_WOUT  = WS_WIN + (size_t)INW * DM * 2;
constexpr size_t WS_W1    = WS_WOUT + (size_t)DM * DM * 2;
constexpr size_t WS_W3    = WS_W1 + (size_t)NEXP * FF * DM * 2;
constexpr size_t WS_W2    = WS_W3 + (size_t)NEXP * FF * DM * 2;
constexpr size_t WS_LW2   = WS_W2 + (size_t)NEXP * FF * DM * 2;
constexpr size_t WS_LA2   = WS_LW2 + (size_t)2 * 512 * 64 * 2;
constexpr size_t WS_LG2   = WS_LA2 + (size_t)2 * 512 * 64 * 2;
constexpr size_t WS_QA    = WS_LG2 + (size_t)512 * 128 * 2;
constexpr size_t WS_KA    = WS_QA + (size_t)NB * 4 * NKEY * 64 * 2;
constexpr size_t WS_VAT   = WS_KA + (size_t)NB * 2 * NKEY * 64 * 2;
constexpr size_t WS_QB    = WS_VAT + (size_t)NB * 2 * NKEY * 64 * 2;
constexpr size_t WS_KB    = WS_QB + (size_t)NB * 4 * NKEY * 64 * 2;
constexpr size_t WS_VBT   = WS_KB + (size_t)NB * 4 * NKEY * 64 * 2;
constexpr size_t WS_CP    = WS_VBT + (size_t)NB * 4 * NKEY * 64 * 2;
constexpr size_t WS_LX    = WS_CP + (size_t)MA * CSL * 4;
constexpr size_t WS_GG    = WS_LX + (size_t)MA * 384 * 2;
constexpr size_t WS_MIX   = WS_GG + (size_t)MA * 512 * 4;
constexpr size_t HEADARR  = (size_t)NB * 8 * NKEY * 64 * 4;
constexpr size_t WS_RR    = WS_MIX + (size_t)MA * DM * 2;
constexpr size_t WS_VV    = WS_RR + HEADARR;
constexpr size_t WS_KK    = WS_VV + HEADARR;
constexpr size_t WS_YS    = WS_KK + HEADARR;
constexpr size_t WS_WW    = WS_YS + 2 * HEADARR;
constexpr size_t WS_KD    = WS_WW + 2 * HEADARR;
constexpr size_t WS_BB    = WS_KD + 2 * HEADARR;
constexpr size_t WS_END   = WS_BB + 2 * HEADARR;
constexpr size_t WS_Y01   = WS_WW;
constexpr size_t WS_HB    = WS_RR;

struct P {
    const float *x, *c, *ctx, *c_ctx, *w_mod, *b_mod, *g_mix, *g_ffn, *w_in, *a_q_gain, *a_k_gain, *b_lq1, *b_lk1, *b_lq2, *b_lk2, *b_subln,
        *c_mu, *c_w0, *c_w2, *c_a0, *c_a2, *c_g2, *c_k_k, *c_k_a, *c_r_k, *c_ln_w, *c_ln_b, *w_out, *r_w_group, *r_b_group, *r_w_expert, *r_b_expert,
        *e_w1, *e_w3, *e_w2, *g_final;
    float* out;
    char* ws;
};

__device__ __forceinline__ float bf2f(bfu b) { return __uint_as_float((unsigned)b << 16); }
__device__ __forceinline__ unsigned pack2(float a, float b) {
    typedef float f2 __attribute__((ext_vector_type(2)));
    typedef __bf16 b2 __attribute__((ext_vector_type(2)));
    f2 v = {a, b}; b2 r = __builtin_convertvector(v, b2); return __builtin_bit_cast(unsigned, r);
}
__device__ __forceinline__ bfu f2bf(float a) { return (bfu)(pack2(a, 0.f) & 0xFFFFu); }
__device__ __forceinline__ float wave_sum(float v) {
#pragma unroll
    for (int o = 32; o >= 1; o >>= 1) v += __shfl_xor(v, o);
    return v;
}
__device__ __forceinline__ float sigmoidf_(float x) { return 1.f / (1.f + __expf(-x)); }
__device__ __forceinline__ float siluf_(float x) { return x / (1.f + __expf(-x)); }
__device__ __forceinline__ void row_info(int grow, int& b, int& j, int& s) {
    if (grow < ML) { b = grow >> 11; j = 256 + (grow & 2047); s = b; }
    else { int r = grow - ML; b = r >> 8; j = r & 255; s = 8; }
}
__device__ __forceinline__ int grow_of(int b, int j) { return j < 256 ? ML + b * 256 + j : b * 2048 + (j - 256); }

#define SMEM_BYTES 69632

__device__ void phase_setup(const P& p, int bid, int nb) {
    float4* X4 = (float4*)(p.ws + WS_X);
    const float4* x4 = (const float4*)p.x; const float4* c4 = (const float4*)p.ctx;
    const size_t nl = (size_t)ML * DM / 4, nc = (size_t)MC * DM / 4;
    for (size_t i = (size_t)bid * 256 + threadIdx.x; i < nl + nc; i += (size_t)nb * 256) X4[i] = i < nl ? x4[i] : c4[i - nl];
    if (bid == 0) {
        float* TA = (float*)(p.ws + WS_ROPE); float* TB = TA + 64 * 16 * 2;
        for (int i = threadIdx.x; i < 64 * 16; i += 256) { int pos = i >> 4, f = i & 15; double inv = pow(10000.0, -(double)f / 16.0); double a = (double)pos * inv; TA[i * 2] = (float)cos(a); TA[i * 2 + 1] = (float)sin(a); }
        for (int i = threadIdx.x; i < 64 * 8; i += 256) { int pos = i >> 3, f = i & 7; double inv = pow(10000.0, -(double)f / 8.0); double a = (double)pos * inv; TB[i * 2] = (float)cos(a); TB[i * 2 + 1] = (float)sin(a); }
        int* ec = (int*)(p.ws + WS_ECNT);
        for (int i = threadIdx.x; i < 128; i += 256) ec[i] = 0;
    }
}

__device__ void phase_mod(const P& p, int bid, int nb, char* smem) {
    float* act = (float*)smem;
    float* red = act + 9 * 1024;
    for (int i = threadIdx.x; i < 9 * 1024; i += 256) { float v = i < 8 * 1024 ? p.c[i] : p.c_ctx[i - 8 * 1024]; act[i] = siluf_(v); }
    __syncthreads();
    float* mod = (float*)(p.ws + WS_MOD);
    const int nitems = 4 * 6144 / 64;
    const int cl = threadIdx.x & 63, kq = threadIdx.x >> 6;
    for (int it = bid; it < nitems; it += nb) {
        const int layer = it / 96, n = (it % 96) * 64 + cl;
        const float* w = p.w_mod + (size_t)layer * DM * 6144 + n;
        float a[9];
#pragma unroll
        for (int s = 0; s < 9; ++s) a[s] = 0.f;
        for (int k = kq * 256; k < kq * 256 + 256; ++k) {
            const float wv = w[(size_t)k * 6144];
#pragma unroll
            for (int s = 0; s < 9; ++s) a[s] += act[s * 1024 + k] * wv;
        }
#pragma unroll
        for (int s = 0; s < 9; ++s) red[(kq * 9 + s) * 64 + cl] = a[s];
        __syncthreads();
        for (int i = threadIdx.x; i < 9 * 64; i += 256) {
            const int s = i >> 6, c2 = i & 63, n2 = (it % 96) * 64 + c2;
            float v = red[(0 * 9 + s) * 64 + c2] + red[(1 * 9 + s) * 64 + c2] + red[(2 * 9 + s) * 64 + c2] + red[(3 * 9 + s) * 64 + c2];
            mod[((size_t)layer * 9 + s) * 6144 + n2] = v + p.b_mod[layer * 6144 + n2];
        }
        __syncthreads();
    }
}

__device__ __forceinline__ void conv_tile(const float* src, int K, int N, bfu* dst, int k0, int n0, float* ts) {
    const int t = threadIdx.x;
    {
        const int kk = t >> 4, n4 = (t & 15) * 4;
#pragma unroll
        for (int pz = 0; pz < 4; ++pz) {
            const float4 v = *(const float4*)(src + (size_t)(k0 + kk + 16 * pz) * N + n0 + n4);
            float* d = ts + (kk + 16 * pz) * 65 + n4; d[0] = v.x; d[1] = v.y; d[2] = v.z; d[3] = v.w;
        }
    }
    __syncthreads();
    {
        const int n = t >> 2, kc = (t & 3) * 16;
        unsigned o[8];
#pragma unroll
        for (int i = 0; i < 8; ++i) o[i] = pack2(ts[(kc + 2 * i) * 65 + n], ts[(kc + 2 * i + 1) * 65 + n]);
        uint4* d = (uint4*)(dst + (size_t)(n0 + n) * K + k0 + kc);
        d[0] = make_uint4(o[0], o[1], o[2], o[3]); d[1] = make_uint4(o[4], o[5], o[6], o[7]);
    }
    __syncthreads();
}
__device__ void phase_conv(const P& p, int layer, int bid, int nb, char* smem) {
    float* ts = (float*)smem;
    const float* srcs[8]; bfu* dsts[8]; int Ks[8], Ns[8], Bs[8];
    char* ws = p.ws;
    srcs[0] = p.w_in + (size_t)layer * DM * INW;  Ks[0] = DM; Ns[0] = INW; Bs[0] = 1;  dsts[0] = (bfu*)(ws + WS_WIN);
    srcs[1] = p.w_out + (size_t)layer * DM * DM;  Ks[1] = DM; Ns[1] = DM;  Bs[1] = 1;  dsts[1] = (bfu*)(ws + WS_WOUT);
    srcs[2] = p.e_w1 + (size_t)layer * NEXP * DM * FF; Ks[2] = DM; Ns[2] = FF; Bs[2] = NEXP; dsts[2] = (bfu*)(ws + WS_W1);
    srcs[3] = p.e_w3 + (size_t)layer * NEXP * DM * FF; Ks[3] = DM; Ns[3] = FF; Bs[3] = NEXP; dsts[3] = (bfu*)(ws + WS_W3);
    srcs[4] = p.e_w2 + (size_t)layer * NEXP * FF * DM; Ks[4] = FF; Ns[4] = DM; Bs[4] = NEXP; dsts[4] = (bfu*)(ws + WS_W2);
    srcs[5] = p.c_w2 + (size_t)layer * 2 * 64 * 512;   Ks[5] = 64; Ns[5] = 512; Bs[5] = 2;   dsts[5] = (bfu*)(ws + WS_LW2);
    srcs[6] = p.c_a2 + (size_t)layer * 2 * 64 * 512;   Ks[6] = 64; Ns[6] = 512; Bs[6] = 2;   dsts[6] = (bfu*)(ws + WS_LA2);
    srcs[7] = p.c_g2 + (size_t)layer * 128 * 512;      Ks[7] = 128; Ns[7] = 512; Bs[7] = 1;  dsts[7] = (bfu*)(ws + WS_LG2);
    int start = 0;
#pragma unroll
    for (int jb = 0; jb < 8; ++jb) {
        const int tk = Ks[jb] / 64, tn = Ns[jb] / 64, per = tk * tn, tot = per * Bs[jb];
        int first = bid - (start % nb); if (first < 0) first += nb;
        for (int it = first; it < tot; it += nb) {
            const int bt = it / per, r = it % per, kt = r / tn, nt = r % tn;
            conv_tile(srcs[jb] + (size_t)bt * Ks[jb] * Ns[jb], Ks[jb], Ns[jb], dsts[jb] + (size_t)bt * Ks[jb] * Ns[jb], kt * 64, nt * 64, ts);
        }
        start += tot;
    }
    float* wrt = (float*)(ws + WS_WRT);
    const float* wg = p.r_w_group + (size_t)layer * DM * 4; const float* we = p.r_w_expert + (size_t)layer * DM * 32;
    for (int i = bid * 256 + threadIdx.x; i < 48 * 1024; i += nb * 256) {
        const int r = i >> 10, k = i & 1023;
        wrt[i] = r < 4 ? wg[k * 4 + r] : (r < 36 ? we[k * 32 + (r - 4)] : 0.f);
    }
}

__device__ void phase_norm1(const P& p, int layer, int mode, int bid, int nb) {
    float* X = (float*)(p.ws + WS_X); bfu* H = (bfu*)(p.ws + WS_H);
    const float* Y0 = (const float*)(p.ws + WS_Y01); const float* Y1 = Y0 + (size_t)MA * DM;
    const float* mod = (const float*)(p.ws + WS_MOD);
    const int lane = threadIdx.x & 63, wv = threadIdx.x >> 6;
    const int nrows = mode ? ML : MA;
    if (bid == 0 && mode == 0 && threadIdx.x < 32) ((int*)(p.ws + WS_ECNT))[layer * 32 + threadIdx.x] = 0;
    for (int row = bid * 4 + wv; row < nrows; row += nb * 4) {
        int b, j, s; row_info(row, b, j, s);
        float4 v[4];
        float ss = 0.f;
#pragma unroll
        for (int c = 0; c < 4; ++c) {
            const int col = c * 256 + lane * 4;
            float4 xv = *(const float4*)(X + (size_t)row * DM + col);
            if (layer > 0) {
                const float4 a = *(const float4*)(Y0 + (size_t)row * DM + col), bq = *(const float4*)(Y1 + (size_t)row * DM + col);
                const float4 g = *(const float4*)(mod + ((size_t)(layer - 1) * 9 + s) * 6144 + 5 * 1024 + col);
                xv.x += g.x * (a.x + bq.x); xv.y += g.y * (a.y + bq.y); xv.z += g.z * (a.z + bq.z); xv.w += g.w * (a.w + bq.w);
                if (!mode) *(float4*)(X + (size_t)row * DM + col) = xv;
            }
            v[c] = xv; ss += xv.x * xv.x + xv.y * xv.y + xv.z * xv.z + xv.w * xv.w;
        }
        ss = wave_sum(ss);
        const float rs = rsqrtf(ss * (1.f / 1024.f) + 1e-6f);
#pragma unroll
        for (int c = 0; c < 4; ++c) {
            const int col = c * 256 + lane * 4;
            if (mode) {
                const float4 g = *(const float4*)(p.g_final + col);
                float4 o; o.x = v[c].x * rs * g.x; o.y = v[c].y * rs * g.y; o.z = v[c].z * rs * g.z; o.w = v[c].w * rs * g.w;
                *(float4*)(p.out + (size_t)row * DM + col) = o;
            } else {
                const float4 g = *(const float4*)(p.g_mix + layer * DM + col);
                const float4 sh = *(const float4*)(mod + ((size_t)layer * 9 + s) * 6144 + 0 * 1024 + col);
                const float4 sc = *(const float4*)(mod + ((size_t)layer * 9 + s) * 6144 + 1 * 1024 + col);
                const float o0 = v[c].x * rs * g.x * (1.f + sc.x) + sh.x, o1 = v[c].y * rs * g.y * (1.f + sc.y) + sh.y;
                const float o2 = v[c].z * rs * g.z * (1.f + sc.z) + sh.z, o3 = v[c].w * rs * g.w * (1.f + sc.w) + sh.w;
                *(uint2*)(H + (size_t)row * DM + col) = make_uint2(pack2(o0, o1), pack2(o2, o3));
            }
        }
    }
}

template <class FA, class FB, class FE>
__device__ __forceinline__ void gemm_tile(FA arow, FB brow, int K, FE epi, char* smem) {
    bfu* sA = (bfu*)smem; bfu* sB = sA + 2 * 4096;
    const int tid = threadIdx.x, lane = tid & 63, wid = tid >> 6, wr = wid >> 1, wc = wid & 1, fr = lane & 15, fq = lane >> 4;
    const int lr = tid >> 2, lc = tid & 3;
    const bfu* pa0 = arow(lr) + lc * 8; const bfu* pa1 = arow(lr + 64) + lc * 8;
    const bfu* pb0 = brow(lr) + lc * 8; const bfu* pb1 = brow(lr + 64) + lc * 8;
    f32x4 acc[4][4];
#pragma unroll
    for (int m = 0; m < 4; ++m)
#pragma unroll
        for (int n = 0; n < 4; ++n) acc[m][n] = (f32x4){0.f, 0.f, 0.f, 0.f};
    uint4 ra0 = *(const uint4*)pa0, ra1 = *(const uint4*)pa1, rb0 = *(const uint4*)pb0, rb1 = *(const uint4*)pb1;
    const int so = lr * 32 + lc * 8;
    __syncthreads();
    *(uint4*)(sA + so) = ra0; *(uint4*)(sA + so + 64 * 32) = ra1; *(uint4*)(sB + so) = rb0; *(uint4*)(sB + so + 64 * 32) = rb1;
    __syncthreads();
    const int nk = K >> 5;
    for (int kt = 0; kt < nk; ++kt) {
        if (kt + 1 < nk) {
            const int ko = (kt + 1) * 32;
            ra0 = *(const uint4*)(pa0 + ko); ra1 = *(const uint4*)(pa1 + ko); rb0 = *(const uint4*)(pb0 + ko); rb1 = *(const uint4*)(pb1 + ko);
        }
        const bfu* cA = sA + (kt & 1) * 4096; const bfu* cB = sB + (kt & 1) * 4096;
        bf16x8 af[4], bfr[4];
#pragma unroll
        for (int m = 0; m < 4; ++m) af[m] = *(const bf16x8*)(cA + (wr * 64 + m * 16 + fr) * 32 + fq * 8);
#pragma unroll
        for (int n = 0; n < 4; ++n) bfr[n] = *(const bf16x8*)(cB + (wc * 64 + n * 16 + fr) * 32 + fq * 8);
#pragma unroll
        for (int m = 0; m < 4; ++m)
#pragma unroll
            for (int n = 0; n < 4; ++n) acc[m][n] = __builtin_amdgcn_mfma_f32_16x16x32_bf16(af[m], bfr[n], acc[m][n], 0, 0, 0);
        if (kt + 1 < nk) {
            bfu* nA = sA + ((kt + 1) & 1) * 4096; bfu* nB = sB + ((kt + 1) & 1) * 4096;
            *(uint4*)(nA + so) = ra0; *(uint4*)(nA + so + 64 * 32) = ra1; *(uint4*)(nB + so) = rb0; *(uint4*)(nB + so + 64 * 32) = rb1;
        }
        __syncthreads();
    }
    epi(acc, wr, wc, fr, fq);
}
#define ACC_FOREACH(...)                                                                      \
    _Pragma("unroll") for (int m_ = 0; m_ < 4; ++m_) _Pragma("unroll") for (int n_ = 0; n_ < 4; ++n_) \
    _Pragma("unroll") for (int j_ = 0; j_ < 4; ++j_) {                                        \
        const int row = wr * 64 + m_ * 16 + fq * 4 + j_; const int col = wc * 64 + n_ * 16 + fr; const float val = acc[m_][n_][j_]; __VA_ARGS__ }

__device__ void phase_inproj(const P& p, int layer, int bid, int nb, char* smem) {
    const bfu* H = (const bfu*)(p.ws + WS_H); const bfu* W = (const bfu*)(p.ws + WS_WIN);
    float* Cs = (float*)smem;
    const float* TA = (const float*)(p.ws + WS_ROPE); const float* TB = TA + 64 * 16 * 2;
    const int nitems = 144 * 25;
    for (int it = bid; it < nitems; it += nb) {
        const int mt = it / 25, nt = it % 25;
        const int row0 = mt * 128, col0 = nt * 128;
        gemm_tile([&](int r) { return H + (size_t)(row0 + r) * DM; }, [&](int r) { return W + (size_t)(col0 + r) * DM; }, DM,
            [&](f32x4 (&acc)[4][4], int wr, int wc, int fr, int fq) {
                ACC_FOREACH(Cs[row * 132 + col] = val;)
            }, smem);
        __syncthreads();
        const int tid = threadIdx.x;
        int b, j0, s; row_info(row0, b, j0, s);
        const bool lat = row0 < ML;
        if (nt <= 2) {
            const int r = tid & 127, hl = tid >> 7;
            const bool isq = nt < 2;
            const float* gain = (isq ? p.a_q_gain : p.a_k_gain) + layer * 64;
            float v[64]; float ss = 0.f;
#pragma unroll
            for (int d4 = 0; d4 < 16; ++d4) { const float4 t4 = *(const float4*)(Cs + r * 132 + hl * 64 + d4 * 4); v[d4 * 4] = t4.x; v[d4 * 4 + 1] = t4.y; v[d4 * 4 + 2] = t4.z; v[d4 * 4 + 3] = t4.w; ss += t4.x * t4.x + t4.y * t4.y + t4.z * t4.z + t4.w * t4.w; }
            const float rs = rsqrtf(ss * (1.f / 64.f) + 1e-6f);
#pragma unroll
            for (int d = 0; d < 64; ++d) v[d] = v[d] * rs * gain[d];
            if (lat) {
                const int t = (j0 - 256) + r;
#pragma unroll
                for (int a = 0; a < 2; ++a) {
                    const int pos = a == 0 ? (t >> 6) : (t & 63);
#pragma unroll
                    for (int f = 0; f < 16; ++f) {
                        const float cs = TA[(pos * 16 + f) * 2], sn = TA[(pos * 16 + f) * 2 + 1];
                        const float x0 = v[a * 32 + f], x1 = v[a * 32 + 16 + f];
                        v[a * 32 + f] = x0 * cs - x1 * sn; v[a * 32 + 16 + f] = x1 * cs + x0 * sn;
                    }
                }
            }
            const float qs = isq ? 0.125f * LOG2E : 1.f;
            bfu* dst = isq ? (bfu*)(p.ws + WS_QA) + (((size_t)b * 4 + (nt * 2 + hl)) * NKEY + j0 + r) * 64
                           : (bfu*)(p.ws + WS_KA) + (((size_t)b * 2 + hl) * NKEY + j0 + r) * 64;
#pragma unroll
            for (int d8 = 0; d8 < 8; ++d8)
                ((uint4*)dst)[d8] = make_uint4(pack2(v[d8 * 8] * qs, v[d8 * 8 + 1] * qs), pack2(v[d8 * 8 + 2] * qs, v[d8 * 8 + 3] * qs),
                                               pack2(v[d8 * 8 + 4] * qs, v[d8 * 8 + 5] * qs), pack2(v[d8 * 8 + 6] * qs, v[d8 * 8 + 7] * qs));
        } else if (nt == 3 || nt == 8 || nt == 9) {
            const int c = tid & 127, half = tid >> 7, hl = c >> 6, d = c & 63;
            bfu* dst = nt == 3 ? (bfu*)(p.ws + WS_VAT) + (((size_t)b * 2 + hl) * 64 + d) * NKEY + j0 + half * 64
                               : (bfu*)(p.ws + WS_VBT) + (((size_t)b * 4 + ((nt - 8) * 2 + hl)) * 64 + d) * NKEY + j0 + half * 64;
#pragma unroll
            for (int r8 = 0; r8 < 8; ++r8) {
                const float* s0 = Cs + (half * 64 + r8 * 8) * 132 + c;
                ((uint4*)dst)[r8] = make_uint4(pack2(s0[0], s0[132]), pack2(s0[2 * 132], s0[3 * 132]), pack2(s0[4 * 132], s0[5 * 132]), pack2(s0[6 * 132], s0[7 * 132]));
            }
        } else if (nt <= 7) {
            const bool isq = nt < 6;
            const int hbase = ((nt - 4) & 1) * 2;
#pragma unroll
            for (int itq = 0; itq < 2; ++itq) {
                const int u = tid + 256 * itq, r = u & 127, hm = u >> 7;
                float v[32];
#pragma unroll
                for (int d4 = 0; d4 < 8; ++d4) { const float4 t4 = *(const float4*)(Cs + r * 132 + hm * 32 + d4 * 4); v[d4 * 4] = t4.x; v[d4 * 4 + 1] = t4.y; v[d4 * 4 + 2] = t4.z; v[d4 * 4 + 3] = t4.w; }
                if (lat) {
                    const int t = (j0 - 256) + r;
#pragma unroll
                    for (int a = 0; a < 2; ++a) {
                        const int pos = a == 0 ? (t >> 6) : (t & 63);
#pragma unroll
                        for (int f = 0; f < 8; ++f) {
                            const float cs = TB[(pos * 8 + f) * 2], sn = TB[(pos * 8 + f) * 2 + 1];
                            const float x0 = v[a * 16 + f], x1 = v[a * 16 + 8 + f];
                            v[a * 16 + f] = x0 * cs - x1 * sn; v[a * 16 + 8 + f] = x1 * cs + x0 * sn;
                        }
                    }
                }
                const float qs = isq ? 0.17677669529663687f * LOG2E : 1.f;
                const int h = hbase + (hm >> 1), mp = hm & 1;
                bfu* dst = (bfu*)(p.ws + (isq ? WS_QB : WS_KB)) + ((((size_t)b * 4 + h) * 2 + mp) * NKEY + j0 + r) * 32;
#pragma unroll
                for (int d8 = 0; d8 < 4; ++d8)
                    ((uint4*)dst)[d8] = make_uint4(pack2(v[d8 * 8] * qs, v[d8 * 8 + 1] * qs), pack2(v[d8 * 8 + 2] * qs, v[d8 * 8 + 3] * qs),
                                                   pack2(v[d8 * 8 + 4] * qs, v[d8 * 8 + 5] * qs), pack2(v[d8 * 8 + 6] * qs, v[d8 * 8 + 7] * qs));
            }
        } else {
            const int r = tid & 127, half = tid >> 7;
            float* dst = (float*)(p.ws + WS_CP) + (size_t)(row0 + r) * CSL + (nt - 10) * 128 + half * 64;
#pragma unroll
            for (int d4 = 0; d4 < 16; ++d4) ((float4*)dst)[d4] = *(const float4*)(Cs + r * 132 + half * 64 + d4 * 4);
        }
        __syncthreads();
    }
}

__device__ void phase_rwkv_prep(const P& p, int layer, int bid, int nb) {
    const float* CP = (const float*)(p.ws + WS_CP);
    float* RR = (float*)(p.ws + WS_RR); float* VV = (float*)(p.ws + WS_VV); float* KK = (float*)(p.ws + WS_KK);
    float* KR = (float*)(p.ws + WS_YS) + HEADARR / 4;
    bfu* LX = (bfu*)(p.ws + WS_LX);
    const float* mu = p.c_mu + layer * CSL; const float* k_k = p.c_k_k + layer * 512;
    const int lane = threadIdx.x & 63, wv = threadIdx.x >> 6;
    for (int row = bid * 4 + wv; row < MA; row += nb * 4) {
        int b, j, s; row_info(row, b, j, s);
        const int t = row < ML ? (row & 2047) : ((row - ML) & 255), T = row < ML ? SEQ : CL;
        const float* c0 = CP + (size_t)row * CSL;
        const bool hp = t > 0, hn = t < T - 1;
#pragma unroll 2
        for (int c = 0; c < 30; ++c) {
            const int col = c * 64 + lane;
            const float pc = c0[col];
            const float pp = hp ? c0[col - CSL] : 0.f, pn = hn ? c0[col + CSL] : 0.f;
            const float pf = pc + mu[col] * (0.5f * (pp + pn) - pc);
            if (c < 24) {
                const int h = c & 7;
                const size_t o = (((size_t)b * 8 + h) * NKEY + j) * 64 + lane;
                if (c < 8) RR[o] = pf;
                else if (c < 16) {
                    KR[o] = pf;
                    const float kv = pf * k_k[h * 64 + lane];
                    const float ss = wave_sum(kv * kv);
                    KK[o] = kv / fmaxf(sqrtf(ss), 1e-12f);
                } else VV[o] = pf;
            } else {
                float o;
                if (c < 26) o = tanhf(pf); else if (c < 28) o = pf; else o = sigmoidf_(pf);
                LX[(size_t)row * 384 + (c - 24) * 64 + lane] = f2bf(o);
            }
        }
    }
}

__device__ void phase_rwkv_lora(const P& p, int layer, int bid, int nb, char* smem) {
    const bfu* LX = (const bfu*)(p.ws + WS_LX);
    const int nitems = 144 * 4 * 5;
    for (int it = bid; it < nitems; it += nb) {
        const int job = it / (144 * 4), r2 = it % (144 * 4), mt = r2 >> 2, nt = r2 & 3;
        const int row0 = mt * 128, col0 = nt * 128;
        int b, j0, s; row_info(row0, b, j0, s);
        const int z = job & 1;
        const bfu* Bt; int K, aoff;
        if (job < 2) { Bt = (const bfu*)(p.ws + WS_LW2) + (size_t)z * 512 * 64; K = 64; aoff = z * 64; }
        else if (job < 4) { Bt = (const bfu*)(p.ws + WS_LA2) + (size_t)z * 512 * 64; K = 64; aoff = 128 + z * 64; }
        else { Bt = (const bfu*)(p.ws + WS_LG2); K = 128; aoff = 256; }
        gemm_tile([&](int r) { return LX + (size_t)(row0 + r) * 384 + aoff; }, [&](int r) { return Bt + (size_t)(col0 + r) * K; }, K,
            [&](f32x4 (&acc)[4][4], int wr, int wc, int fr, int fq) {
                if (job < 2) {
                    float* WW = (float*)(p.ws + WS_WW) + (size_t)z * (HEADARR / 4);
                    const float* w0 = p.c_w0 + ((size_t)layer * 2 + z) * 512;
                    ACC_FOREACH({
                        const int gc = col0 + col; const float xx = w0[gc] + val;
                        const float nx = -xx; const float sp = nx > 20.f ? nx : log1pf(__expf(nx));
                        const float wlog = -sp - 0.5f;
                        WW[(((size_t)b * 8 + (gc >> 6)) * NKEY + j0 + row) * 64 + (gc & 63)] = __expf(-__expf(wlog));
                    })
                } else if (job < 4) {
                    float* KD = (float*)(p.ws + WS_KD) + (size_t)z * (HEADARR / 4); float* BB = (float*)(p.ws + WS_BB) + (size_t)z * (HEADARR / 4);
                    const float* KR = (const float*)(p.ws + WS_YS) + HEADARR / 4; const float* KK = (const float*)(p.ws + WS_KK);
                    const float* a0 = p.c_a0 + ((size_t)layer * 2 + z) * 512; const float* k_a = p.c_k_a + layer * 512;
                    ACC_FOREACH({
                        const int gc = col0 + col; const float icl = sigmoidf_(a0[gc] + val);
                        const size_t o = (((size_t)b * 8 + (gc >> 6)) * NKEY + j0 + row) * 64 + (gc & 63);
                        KD[o] = KR[o] * (1.f + (icl - 1.f) * k_a[gc]); BB[o] = KK[o] * icl;
                    })
                } else {
                    float* GG = (float*)(p.ws + WS_GG);
                    ACC_FOREACH(GG[(size_t)(row0 + row) * 512 + col0 + col] = val;)
                }
            }, smem);
    }
}

__device__ void phase_scan(const P& p, int layer, int bid, int nb, char* smem) {
    float* sbuf = (float*)smem;
    const int tid = threadIdx.x, cg = tid & 7, rl = tid >> 3;
    for (int it = bid; it < 256; it += nb) {
        const int half = it & 1, z = (it >> 1) & 1, h = (it >> 2) & 7, b = it >> 5;
        const size_t hb = ((size_t)b * 8 + h) * NKEY * 64;
        const float* aW = (const float*)(p.ws + WS_WW) + (size_t)z * (HEADARR / 4) + hb;
        const float* aK = (const float*)(p.ws + WS_KD) + (size_t)z * (HEADARR / 4) + hb;
        const float* aB = (const float*)(p.ws + WS_BB) + (size_t)z * (HEADARR / 4) + hb;
        const float* aA = (const float*)(p.ws + WS_KK) + hb;
        const float* aR = (const float*)(p.ws + WS_RR) + hb;
        const float* aV = (const float*)(p.ws + WS_VV) + hb;
        float* aY = (float*)(p.ws + WS_YS) + (size_t)z * (HEADARR / 4) + hb;
        const int vrow = half * 32 + rl;
        float S[8];
#pragma unroll
        for (int i = 0; i < 8; ++i) S[i] = 0.f;
        auto chunk_j0 = [&](int c) { return z == 0 ? c * 16 : (c < 16 ? 240 - c * 16 : 2288 - (c - 16) * 16); };
        float4 pre0, pre1, pre2, pre3, pre4, pre5;
#define load_chunk(c) { const size_t jo = (size_t)chunk_j0(c) * 64 + tid * 4; pre0 = *(const float4*)(aW + jo); pre1 = *(const float4*)(aA + jo); pre2 = *(const float4*)(aB + jo); \
                        pre3 = *(const float4*)(aK + jo); pre4 = *(const float4*)(aR + jo); pre5 = *(const float4*)(aV + jo); }
#define store_chunk(buf) { float* d_ = sbuf + (((buf) * 16 + (tid >> 4)) * 6) * 64 + (tid & 15) * 4; *(float4*)(d_) = pre0; *(float4*)(d_ + 64) = pre1; *(float4*)(d_ + 128) = pre2; \
                        *(float4*)(d_ + 192) = pre3; *(float4*)(d_ + 256) = pre4; *(float4*)(d_ + 320) = pre5; }
        __syncthreads();
        load_chunk(0); store_chunk(0);
        __syncthreads();
        for (int c = 0; c < 144; ++c) {
            if (c + 1 < 144) load_chunk(c + 1);
            const int jl = chunk_j0(c);
            const float* cb = sbuf + (c & 1) * 16 * 6 * 64;
            for (int s = 0; s < 16; ++s) {
                const int st = z == 0 ? s : 15 - s;
                const float* sv = cb + st * 6 * 64;
                const float4 w0 = *(const float4*)(sv + 0 * 64 + cg * 8), w1 = *(const float4*)(sv + 0 * 64 + cg * 8 + 4);
                const float4 a0 = *(const float4*)(sv + 1 * 64 + cg * 8), a1 = *(const float4*)(sv + 1 * 64 + cg * 8 + 4);
                const float4 b0 = *(const float4*)(sv + 2 * 64 + cg * 8), b1 = *(const float4*)(sv + 2 * 64 + cg * 8 + 4);
                const float4 k0 = *(const float4*)(sv + 3 * 64 + cg * 8), k1 = *(const float4*)(sv + 3 * 64 + cg * 8 + 4);
                const float4 r0 = *(const float4*)(sv + 4 * 64 + cg * 8), r1 = *(const float4*)(sv + 4 * 64 + cg * 8 + 4);
                const float vv = sv[5 * 64 + vrow];
                const float w[8] = {w0.x, w0.y, w0.z, w0.w, w1.x, w1.y, w1.z, w1.w};
                const float a[8] = {a0.x, a0.y, a0.z, a0.w, a1.x, a1.y, a1.z, a1.w};
                const float bb[8] = {b0.x, b0.y, b0.z, b0.w, b1.x, b1.y, b1.z, b1.w};
                const float kk[8] = {k0.x, k0.y, k0.z, k0.w, k1.x, k1.y, k1.z, k1.w};
                const float rr[8] = {r0.x, r0.y, r0.z, r0.w, r1.x, r1.y, r1.z, r1.w};
                float sa = 0.f;
#pragma unroll
                for (int i = 0; i < 8; ++i) sa += S[i] * a[i];
                sa += __shfl_xor(sa, 1); sa += __shfl_xor(sa, 2); sa += __shfl_xor(sa, 4);
                sa = -sa;
                float y = 0.f;
#pragma unroll
                for (int i = 0; i < 8; ++i) { S[i] = S[i] * w[i] + sa * bb[i] + vv * kk[i]; y += S[i] * rr[i]; }
                y += __shfl_xor(y, 1); y += __shfl_xor(y, 2); y += __shfl_xor(y, 4);
                if (cg == 0) aY[(size_t)(jl + st) * 64 + vrow] = y;
            }
            if (c + 1 < 144) store_chunk((c + 1) & 1);
            __syncthreads();
        }
    }
}

__device__ void phase_readout(const P& p, int layer, int nrows, int bid, int nb) {
    const float* Y0 = (const float*)(p.ws + WS_YS); const float* Y1 = Y0 + HEADARR / 4;
    const float* RR = (const float*)(p.ws + WS_RR); const float* VV = (const float*)(p.ws + WS_VV);
    const float* KD0 = (const float*)(p.ws + WS_KD); const float* KD1 = KD0 + HEADARR / 4;
    const float* GG = (const float*)(p.ws + WS_GG);
    bfu* MIX = (bfu*)(p.ws + WS_MIX);
    const float* lnw = p.c_ln_w + layer * 512; const float* lnb = p.c_ln_b + layer * 512; const float* rk = p.c_r_k + layer * 512;
    const int lane = threadIdx.x & 63, wv = threadIdx.x >> 6;
    for (int row = bid * 4 + wv; row < nrows; row += nb * 4) {
        int b, j, s; row_info(row, b, j, s);
#pragma unroll 2
        for (int h = 0; h < 8; ++h) {
            const size_t o = (((size_t)b * 8 + h) * NKEY + j) * 64 + lane;
            const float y = Y0[o] + Y1[o];
            const float mean = wave_sum(y) * (1.f / 64.f);
            const float dv = y - mean;
            const float var = wave_sum(dv * dv) * (1.f / 64.f);
            const float yn = dv * rsqrtf(var + 64e-5f) * lnw[h * 64 + lane] + lnb[h * 64 + lane];
            const float r = RR[o], v = VV[o];
            const float rkv = rk[h * 64 + lane];
            const float bs = wave_sum(r * KD0[o] * rkv) + wave_sum(r * KD1[o] * rkv);
            const float outv = (yn + bs * v) * GG[(size_t)row * 512 + h * 64 + lane];
            MIX[(size_t)row * DM + 512 + h * 64 + lane] = f2bf(outv);
        }
    }
}

__device__ void phase_attn_naive(const P& p, int layer, bool do_ctx, int bid, int nb, char* smem) {
    float* Ks = (float*)smem;
    float* Vs = Ks + 32 * 64;
    const int tid = threadIdx.x;
    const float lam_init = 0.8f - 0.6f * expf(-0.3f * (float)layer);
    float d1 = 0.f, d2 = 0.f;
    for (int i = 0; i < 32; ++i) { d1 += p.b_lq1[layer * 32 + i] * p.b_lk1[layer * 32 + i]; d2 += p.b_lq2[layer * 32 + i] * p.b_lk2[layer * 32 + i]; }
    const float lam = expf(d1) - expf(d2) + lam_init;
    const int nitems = 2 * 8 * 4 * 9;
    bfu* MIX = (bfu*)(p.ws + WS_MIX);
    for (int it = bid; it < nitems; it += nb) {
        const int qb = it % 9, h = (it / 9) & 3, b = (it / 36) & 7, grp = it / 288;
        if (qb == 0 && !do_ctx) continue;
        const int jq = qb * 256 + tid;
        const int nkeys = qb == 0 ? 256 : NKEY;
        const int grow = grow_of(b, jq);
        if (grp == 0) {
            const bfu* Q = (const bfu*)(p.ws + WS_QA) + (((size_t)b * 4 + h) * NKEY + jq) * 64;
            const bfu* Kg = (const bfu*)(p.ws + WS_KA) + ((size_t)b * 2 + (h >> 1)) * NKEY * 64;
            const bfu* Vt = (const bfu*)(p.ws + WS_VAT) + ((size_t)b * 2 + (h >> 1)) * 64 * NKEY;
            float q[64], o[64];
#pragma unroll
            for (int d = 0; d < 64; ++d) { q[d] = bf2f(Q[d]); o[d] = 0.f; }
            float mx = -1e30f, l = 0.f;
            for (int k0 = 0; k0 < nkeys; k0 += 32) {
                __syncthreads();
                { const int kr = tid >> 3, c8 = (tid & 7) * 8; const uint4 u = *(const uint4*)(Kg + (size_t)(k0 + kr) * 64 + c8);
                  const unsigned uu[4] = {u.x, u.y, u.z, u.w};
#pragma unroll
                  for (int i = 0; i < 4; ++i) { Ks[kr * 64 + c8 + 2 * i] = __uint_as_float(uu[i] << 16); Ks[kr * 64 + c8 + 2 * i + 1] = __uint_as_float(uu[i] & 0xFFFF0000u); } }
                { const int d = tid >> 2, c8 = (tid & 3) * 8; const uint4 u = *(const uint4*)(Vt + (size_t)d * NKEY + k0 + c8);
                  const unsigned uu[4] = {u.x, u.y, u.z, u.w};
#pragma unroll
                  for (int i = 0; i < 4; ++i) { Vs[(c8 + 2 * i) * 64 + d] = __uint_as_float(uu[i] << 16); Vs[(c8 + 2 * i + 1) * 64 + d] = __uint_as_float(uu[i] & 0xFFFF0000u); } }
                __syncthreads();
                for (int kk = 0; kk < 32; ++kk) {
                    float sacc = 0.f;
#pragma unroll
                    for (int d4 = 0; d4 < 16; ++d4) { const float4 kv = *(const float4*)(Ks + kk * 64 + d4 * 4); sacc += q[d4 * 4] * kv.x + q[d4 * 4 + 1] * kv.y + q[d4 * 4 + 2] * kv.z + q[d4 * 4 + 3] * kv.w; }
                    if (sacc > mx) { const float al = exp2f(mx - sacc); l *= al;
#pragma unroll
                        for (int d = 0; d < 64; ++d) o[d] *= al;
                        mx = sacc; }
                    const float pr = exp2f(sacc - mx); l += pr;
#pragma unroll
                    for (int d4 = 0; d4 < 16; ++d4) { const float4 vv = *(const float4*)(Vs + kk * 64 + d4 * 4); o[d4 * 4] += pr * vv.x; o[d4 * 4 + 1] += pr * vv.y; o[d4 * 4 + 2] += pr * vv.z; o[d4 * 4 + 3] += pr * vv.w; }
                }
            }
            const float il = 1.f / l;
            bfu* dst = MIX + (size_t)grow * DM + h * 64;
#pragma unroll
            for (int d8 = 0; d8 < 8; ++d8)
                ((uint4*)dst)[d8] = make_uint4(pack2(o[d8 * 8] * il, o[d8 * 8 + 1] * il), pack2(o[d8 * 8 + 2] * il, o[d8 * 8 + 3] * il),
                                               pack2(o[d8 * 8 + 4] * il, o[d8 * 8 + 5] * il), pack2(o[d8 * 8 + 6] * il, o[d8 * 8 + 7] * il));
        } else {
            const bfu* Q1 = (const bfu*)(p.ws + WS_QB) + ((((size_t)b * 4 + h) * 2 + 0) * NKEY + jq) * 32;
            const bfu* Q2 = (const bfu*)(p.ws + WS_QB) + ((((size_t)b * 4 + h) * 2 + 1) * NKEY + jq) * 32;
            const bfu* K1 = (const bfu*)(p.ws + WS_KB) + (((size_t)b * 4 + h) * 2 + 0) * NKEY * 32;
            const bfu* K2 = (const bfu*)(p.ws + WS_KB) + (((size_t)b * 4 + h) * 2 + 1) * NKEY * 32;
            const bfu* Vt = (const bfu*)(p.ws + WS_VBT) + ((size_t)b * 4 + h) * 64 * NKEY;
            float q[64], o[64];
#pragma unroll
            for (int d = 0; d < 32; ++d) { q[d] = bf2f(Q1[d]); q[32 + d] = bf2f(Q2[d]); }
#pragma unroll
            for (int d = 0; d < 64; ++d) o[d] = 0.f;
            float m1 = -1e30f, l1 = 0.f, m2 = -1e30f, l2 = 0.f;
            for (int pass = 0; pass < 2; ++pass) {
                const float i1 = pass ? 1.f / l1 : 0.f, i2 = pass ? lam / l2 : 0.f;
                for (int k0 = 0; k0 < nkeys; k0 += 32) {
                    __syncthreads();
                    { const int kr = tid >> 3, mp = (tid >> 2) & 1, c8 = (tid & 3) * 8; const uint4 u = *(const uint4*)((mp ? K2 : K1) + (size_t)(k0 + kr) * 32 + c8);
                      const unsigned uu[4] = {u.x, u.y, u.z, u.w};
#pragma unroll
                      for (int i = 0; i < 4; ++i) { Ks[kr * 64 + mp * 32 + c8 + 2 * i] = __uint_as_float(uu[i] << 16); Ks[kr * 64 + mp * 32 + c8 + 2 * i + 1] = __uint_as_float(uu[i] & 0xFFFF0000u); } }
                    if (pass) { const int d = tid >> 2, c8 = (tid & 3) * 8; const uint4 u = *(const uint4*)(Vt + (size_t)d * NKEY + k0 + c8);
                      const unsigned uu[4] = {u.x, u.y, u.z, u.w};
#pragma unroll
                      for (int i = 0; i < 4; ++i) { Vs[(c8 + 2 * i) * 64 + d] = __uint_as_float(uu[i] << 16); Vs[(c8 + 2 * i + 1) * 64 + d] = __uint_as_float(uu[i] & 0xFFFF0000u); } }
                    __syncthreads();
                    for (int kk = 0; kk < 32; ++kk) {
                        float s1 = 0.f, s2 = 0.f;
#pragma unroll
                        for (int d4 = 0; d4 < 8; ++d4) { const float4 kv = *(const float4*)(Ks + kk * 64 + d4 * 4); s1 += q[d4 * 4] * kv.x + q[d4 * 4 + 1] * kv.y + q[d4 * 4 + 2] * kv.z + q[d4 * 4 + 3] * kv.w; }
#pragma unroll
                        for (int d4 = 8; d4 < 16; ++d4) { const float4 kv = *(const float4*)(Ks + kk * 64 + d4 * 4); s2 += q[d4 * 4] * kv.x + q[d4 * 4 + 1] * kv.y + q[d4 * 4 + 2] * kv.z + q[d4 * 4 + 3] * kv.w; }
                        if (!pass) {
                            if (s1 > m1) { l1 *= exp2f(m1 - s1); m1 = s1; }
                            l1 += exp2f(s1 - m1);
                            if (s2 > m2) { l2 *= exp2f(m2 - s2); m2 = s2; }
                            l2 += exp2f(s2 - m2);
                        } else {
                            const float pr = exp2f(s1 - m1) * i1 - exp2f(s2 - m2) * i2;
#pragma unroll
                            for (int d4 = 0; d4 < 16; ++d4) { const float4 vv = *(const float4*)(Vs + kk * 64 + d4 * 4); o[d4 * 4] += pr * vv.x; o[d4 * 4 + 1] += pr * vv.y; o[d4 * 4 + 2] += pr * vv.z; o[d4 * 4 + 3] += pr * vv.w; }
                        }
                    }
                }
            }
            float ss = 0.f;
#pragma unroll
            for (int d = 0; d < 64; ++d) ss += o[d] * o[d];
            const float rs = rsqrtf(ss * (1.f / 64.f) + 1e-6f) * (1.f - lam_init);
            const float* gn = p.b_subln + layer * 64;
            bfu* dst = MIX + (size_t)grow * DM + 256 + h * 64;
#pragma unroll
            for (int d8 = 0; d8 < 8; ++d8)
                ((uint4*)dst)[d8] = make_uint4(pack2(o[d8 * 8] * rs * gn[d8 * 8], o[d8 * 8 + 1] * rs * gn[d8 * 8 + 1]), pack2(o[d8 * 8 + 2] * rs * gn[d8 * 8 + 2], o[d8 * 8 + 3] * rs * gn[d8 * 8 + 3]),
                                               pack2(o[d8 * 8 + 4] * rs * gn[d8 * 8 + 4], o[d8 * 8 + 5] * rs * gn[d8 * 8 + 5]), pack2(o[d8 * 8 + 6] * rs * gn[d8 * 8 + 6], o[d8 * 8 + 7] * rs * gn[d8 * 8 + 7]));
        }
    }
}

__device__ void phase_outproj(const P& p, int layer, int nrows, int bid, int nb, char* smem) {
    const bfu* MIX = (const bfu*)(p.ws + WS_MIX); const bfu* W = (const bfu*)(p.ws + WS_WOUT);
    float* X = (float*)(p.ws + WS_X); const float* mod = (const float*)(p.ws + WS_MOD);
    const int nitems = (nrows / 128) * 8;
    for (int it = bid; it < nitems; it += nb) {
        const int mt = it >> 3, nt = it & 7, row0 = mt * 128, col0 = nt * 128;
        int b, j0, s; row_info(row0, b, j0, s);
        const float* ga = mod + ((size_t)layer * 9 + s) * 6144 + 2 * 1024;
        gemm_tile([&](int r) { return MIX + (size_t)(row0 + r) * DM; }, [&](int r) { return W + (size_t)(col0 + r) * DM; }, DM,
            [&](f32x4 (&acc)[4][4], int wr, int wc, int fr, int fq) {
                ACC_FOREACH({ float* xp = X + (size_t)(row0 + row) * DM + col0 + col; *xp += ga[col0 + col] * val; })
            }, smem);
    }
}

__device__ void phase_norm2_route(const P& p, int layer, int nrows, int bid, int nb, char* smem) {
    const float* X = (const float*)(p.ws + WS_X); bfu* H = (bfu*)(p.ws + WS_H);
    const float* mod = (const float*)(p.ws + WS_MOD); const float* WRT = (const float*)(p.ws + WS_WRT);
    int* ECNT = (int*)(p.ws + WS_ECNT) + layer * 32; int* EIDX = (int*)(p.ws + WS_EIDX); float* EGATE = (float*)(p.ws + WS_EGATE); int* ELIST = (int*)(p.ws + WS_ELIST);
    float* lg = (float*)smem;
    int* lcnt = (int*)(lg + 4 * 16 * 48);
    int* lbase = lcnt + 32;
    int* lsel = lbase + 32;
    int* lrank = lsel + 128;
    const int tid = threadIdx.x, lane = tid & 63, wv = tid >> 6, r = lane & 15, kq = lane >> 4;
    const float* gf = p.g_ffn + layer * DM;
    const float* bg = p.r_b_group + layer * 4; const float* be = p.r_b_expert + layer * 32;
    const int nitems = nrows / 64;
    for (int it = bid; it < nitems; it += nb) {
        const int row = it * 64 + wv * 16 + r;
        int b, j, s; row_info(row, b, j, s);
        const float* xr = X + (size_t)row * DM;
        const float* sh = mod + ((size_t)layer * 9 + s) * 6144 + 3 * 1024; const float* sc = sh + 1024;
        if (tid < 32) lcnt[tid] = 0;
        float ss = 0.f;
        for (int c = 0; c < 64; ++c) { const float4 v = *(const float4*)(xr + c * 16 + kq * 4); ss += v.x * v.x + v.y * v.y + v.z * v.z + v.w * v.w; }
        ss += __shfl_xor(ss, 16); ss += __shfl_xor(ss, 32);
        const float rs = rsqrtf(ss * (1.f / 1024.f) + 1e-6f);
        f32x4 acc[3];
#pragma unroll
        for (int n = 0; n < 3; ++n) acc[n] = (f32x4){0.f, 0.f, 0.f, 0.f};
        for (int c = 0; c < 64; ++c) {
            const int k = c * 16 + kq * 4;
            const float4 v = *(const float4*)(xr + k), g = *(const float4*)(gf + k), s1 = *(const float4*)(sc + k), s0 = *(const float4*)(sh + k);
            float f[4];
            f[0] = v.x * rs * g.x * (1.f + s1.x) + s0.x; f[1] = v.y * rs * g.y * (1.f + s1.y) + s0.y;
            f[2] = v.z * rs * g.z * (1.f + s1.z) + s0.z; f[3] = v.w * rs * g.w * (1.f + s1.w) + s0.w;
            *(uint2*)(H + (size_t)row * DM + k) = make_uint2(pack2(f[0], f[1]), pack2(f[2], f[3]));
#pragma unroll
            for (int n = 0; n < 3; ++n) {
                const float4 w = *(const float4*)(WRT + (size_t)(n * 16 + r) * DM + k);
                acc[n] = __builtin_amdgcn_mfma_f32_16x16x4f32(f[0], w.x, acc[n], 0, 0, 0);
                acc[n] = __builtin_amdgcn_mfma_f32_16x16x4f32(f[1], w.y, acc[n], 0, 0, 0);
                acc[n] = __builtin_amdgcn_mfma_f32_16x16x4f32(f[2], w.z, acc[n], 0, 0, 0);
                acc[n] = __builtin_amdgcn_mfma_f32_16x16x4f32(f[3], w.w, acc[n], 0, 0, 0);
            }
        }
#pragma unroll
        for (int n = 0; n < 3; ++n)
#pragma unroll
            for (int jj = 0; jj < 4; ++jj) lg[(wv * 16 + kq * 4 + jj) * 48 + n * 16 + r] = acc[n][jj];
        __syncthreads();
        if (lane < 16) {
            const float* L = lg + (wv * 16 + lane) * 48;
            const int grow = it * 64 + wv * 16 + lane;
            float gl[4]; float gm = -1e30f; int gi = 0;
#pragma unroll
            for (int g = 0; g < 4; ++g) { gl[g] = L[g] + bg[g]; if (gl[g] > gm) { gm = gl[g]; gi = g; } }
            float gs = 0.f;
#pragma unroll
            for (int g = 0; g < 4; ++g) gs += __expf(gl[g] - gm);
            const float gp = 1.f / gs;
            float v1 = -1e30f, v2 = -1e30f; int i1 = 0, i2 = 0;
            for (int e = 0; e < 8; ++e) {
                const float v = L[4 + gi * 8 + e] + be[gi * 8 + e];
                if (v > v1) { v2 = v1; i2 = i1; v1 = v; i1 = e; } else if (v > v2) { v2 = v; i2 = e; }
            }
            const float e2 = __expf(v2 - v1), den = 1.f / (1.f + e2);
            const int ex1 = gi * 8 + i1, ex2 = gi * 8 + i2;
            EIDX[grow * 2] = ex1; EIDX[grow * 2 + 1] = ex2;
            EGATE[grow * 2] = den * gp; EGATE[grow * 2 + 1] = e2 * den * gp;
            const int lr = wv * 16 + lane;
            lsel[lr * 2] = ex1; lsel[lr * 2 + 1] = ex2;
            lrank[lr * 2] = atomicAdd(&lcnt[ex1], 1); lrank[lr * 2 + 1] = atomicAdd(&lcnt[ex2], 1);
        }
        __syncthreads();
        if (tid < 32) lbase[tid] = lcnt[tid] > 0 ? atomicAdd(&ECNT[tid], lcnt[tid]) : 0;
        __syncthreads();
        if (tid < 128) { const int e = lsel[tid]; ELIST[(size_t)e * (2 * MA) + lbase[e] + lrank[tid]] = ((it * 64 + (tid >> 1)) << 1) | (tid & 1); }
        __syncthreads();
    }
}

__device__ __forceinline__ int moe_prefix(const int* ECNT, int* spre  ) {
    if (threadIdx.x == 0) { int a = 0; for (int e = 0; e < 32; ++e) { spre[e] = a; a += (ECNT[e] + 127) >> 7; } spre[32] = a; }
    __syncthreads();
    return spre[32];
}
__device__ void phase_expert1(const P& p, int layer, int bid, int nb, char* smem) {
    const bfu* H = (const bfu*)(p.ws + WS_H); const bfu* W1 = (const bfu*)(p.ws + WS_W1); const bfu* W3 = (const bfu*)(p.ws + WS_W3);
    bfu* HB = (bfu*)(p.ws + WS_HB);
    const int* ECNT = (const int*)(p.ws + WS_ECNT) + layer * 32; const int* ELIST = (const int*)(p.ws + WS_ELIST);
    int* spre = (int*)(smem + 65536);
    const int nblk = moe_prefix(ECNT, spre);
    const int nitems = nblk * 8;
    for (int it = bid; it < nitems; it += nb) {
        const int blk = it >> 3, nt = it & 7;
        int e = 0;
        while (spre[e + 1] <= blk) ++e;
        const int rb = blk - spre[e], cnt = ECNT[e];
        const int* lst = ELIST + (size_t)e * (2 * MA) + rb * 128;
        const int nvalid = min(128, cnt - rb * 128);
        const bfu* w1 = W1 + (size_t)e * FF * DM; const bfu* w3 = W3 + (size_t)e * FF * DM;
        bfu* hb = HB + (size_t)blk * 128 * FF;
        gemm_tile([&](int r) { const int tok = r < nvalid ? (lst[r] >> 1) : 0; return H + (size_t)tok * DM; },
                  [&](int r) { const int wcx = r >> 6, n4 = (r >> 4) & 3, rr = r & 15; const int hc = nt * 64 + wcx * 32 + (n4 & 1) * 16 + rr; return (n4 < 2 ? w1 : w3) + (size_t)hc * DM; }, DM,
            [&](f32x4 (&acc)[4][4], int wr, int wc, int fr, int fq) {
#pragma unroll
                for (int m = 0; m < 4; ++m)
#pragma unroll
                    for (int n = 0; n < 2; ++n)
#pragma unroll
                        for (int jj = 0; jj < 4; ++jj) {
                            const int row = wr * 64 + m * 16 + fq * 4 + jj; const int hc = nt * 64 + wc * 32 + n * 16 + fr;
                            const float a = acc[m][n][jj], g = acc[m][n + 2][jj];
                            hb[(size_t)row * FF + hc] = f2bf(siluf_(a) * g);
                        }
            }, smem);
    }
}
__device__ void phase_expert2(const P& p, int layer, int bid, int nb, char* smem) {
    const bfu* HB = (const bfu*)(p.ws + WS_HB); const bfu* W2 = (const bfu*)(p.ws + WS_W2);
    float* Y = (float*)(p.ws + WS_Y01);
    const int* ECNT = (const int*)(p.ws + WS_ECNT) + layer * 32; const int* ELIST = (const int*)(p.ws + WS_ELIST); const float* EGATE = (const float*)(p.ws + WS_EGATE);
    int* spre = (int*)(smem + 65536);
    const int nblk = moe_prefix(ECNT, spre);
    const int nitems = nblk * 8;
    for (int it = bid; it < nitems; it += nb) {
        const int blk = it >> 3, nt = it & 7;
        int e = 0;
        while (spre[e + 1] <= blk) ++e;
        const int rb = blk - spre[e], cnt = ECNT[e];
        const int* lst = ELIST + (size_t)e * (2 * MA) + rb * 128;
        const int nvalid = min(128, cnt - rb * 128);
        const bfu* w2 = W2 + (size_t)e * DM * FF;
        const bfu* hb = HB + (size_t)blk * 128 * FF;
        gemm_tile([&](int r) { return hb + (size_t)r * FF; }, [&](int r) { return w2 + (size_t)(nt * 128 + r) * FF; }, FF,
            [&](f32x4 (&acc)[4][4], int wr, int wc, int fr, int fq) {
#pragma unroll
                for (int m = 0; m < 4; ++m)
#pragma unroll
                    for (int jj = 0; jj < 4; ++jj) {
                        const int row = wr * 64 + m * 16 + fq * 4 + jj;
                        if (row < nvalid) {
                            const int ent = lst[row]; const float gt = EGATE[ent];
                            float* yp = Y + ((size_t)(ent & 1) * MA + (ent >> 1)) * DM + nt * 128 + wc * 64 + fr;
#pragma unroll
                            for (int n = 0; n < 4; ++n) yp[n * 16] = gt * acc[m][n][jj];
                        }
                    }
            }, smem);
    }
}

#define KDEF(name, call) __global__ void __launch_bounds__(256, 2) name(P p, int layer, int arg) { __shared__ __attribute__((aligned(16))) char smem[SMEM_BYTES]; call; }
KDEF(k_setup, phase_setup(p, blockIdx.x, gridDim.x))
KDEF(k_mod, phase_mod(p, blockIdx.x, gridDim.x, smem))
KDEF(k_conv, phase_conv(p, layer, blockIdx.x, gridDim.x, smem))
KDEF(k_norm1, phase_norm1(p, layer, arg, blockIdx.x, gridDim.x))
KDEF(k_inproj, phase_inproj(p, layer, blockIdx.x, gridDim.x, smem))
KDEF(k_rprep, phase_rwkv_prep(p, layer, blockIdx.x, gridDim.x))
KDEF(k_rlora, phase_rwkv_lora(p, layer, blockIdx.x, gridDim.x, smem))
KDEF(k_scan, phase_scan(p, layer, blockIdx.x, gridDim.x, smem))
KDEF(k_attn, phase_attn_naive(p, layer, arg != 0, blockIdx.x, gridDim.x, smem))
KDEF(k_readout, phase_readout(p, layer, arg, blockIdx.x, gridDim.x))
KDEF(k_outproj, phase_outproj(p, layer, arg, blockIdx.x, gridDim.x, smem))
KDEF(k_route, phase_norm2_route(p, layer, arg, blockIdx.x, gridDim.x, smem))
KDEF(k_exp1, phase_expert1(p, layer, blockIdx.x, gridDim.x, smem))
KDEF(k_exp2, phase_expert2(p, layer, blockIdx.x, gridDim.x, smem))

extern "C" void kernel_launch(void* const* d_in, const int* in_sizes, int n_in, void* d_out, int out_size, void* d_ws, size_t ws_size, hipStream_t stream) {
    if (n_in != 36 || ws_size < WS_END) { fprintf(stderr, "kernel_launch: unexpected n_in %d or ws_size %zu < %zu\n", n_in, ws_size, (size_t)WS_END); return; }
    P p{};
    const float** pp = (const float**)&p;
    for (int i = 0; i < 36; ++i) pp[i] = (const float*)d_in[i];
    p.out = (float*)d_out; p.ws = (char*)d_ws;
    const dim3 B(256); const int G = 1024;
    k_setup<<<G, B, 0, stream>>>(p, 0, 0);
    k_mod<<<384, B, 0, stream>>>(p, 0, 0);
    for (int l = 0; l < NLAYER; ++l) {
        const int nr = l < NLAYER - 1 ? MA : ML;
        k_conv<<<G, B, 0, stream>>>(p, l, 0);
        k_norm1<<<G, B, 0, stream>>>(p, l, 0);
        k_inproj<<<G, B, 0, stream>>>(p, l, 0);
        k_rprep<<<G, B, 0, stream>>>(p, l, 0);
        k_rlora<<<G, B, 0, stream>>>(p, l, 0);
        k_scan<<<256, B, 0, stream>>>(p, l, 0);
        k_attn<<<576, B, 0, stream>>>(p, l, l < NLAYER - 1 ? 1 : 0);
        k_readout<<<G, B, 0, stream>>>(p, l, nr);
        k_outproj<<<G, B, 0, stream>>>(p, l, nr);
        k_route<<<nr / 64, B, 0, stream>>>(p, l, nr);
        k_exp1<<<G, B, 0, stream>>>(p, l, 0);
        k_exp2<<<G, B, 0, stream>>>(p, l, 0);
    }
    k_norm1<<<G, B, 0, stream>>>(p, NLAYER, 1);
}
```

```cpp
#include <hip/hip_runtime.h>
#include <stdint.h>
#include <stdio.h>

typedef unsigned short bfu;
using bf16x8 = __attribute__((ext_vector_type(8))) short;
using f32x4  = __attribute__((ext_vector_type(4))) float;

#define DM 1024
#define NB 8
#define SEQ 2048
#define CL 256
#define NKEY 2304
#define ML 16384
#define MC 2048
#define MA 18432
#define INW 3200
#define CSL 1920
#define NEXP 32
#define FF 512
#define NLAYER 4
#define LOG2E 1.4426950408889634f

#define MBy(x) ((size_t)(x) << 20)
constexpr size_t WS_CTL   = 0;
constexpr size_t WS_MOD   = 65536;
constexpr size_t WS_ROPE  = WS_MOD + (size_t)4 * 9 * 6144 * 4;
constexpr size_t WS_ECNT  = WS_ROPE + 64 * 16 * 2 * 4 + 64 * 8 * 2 * 4;
constexpr size_t WS_WRT   = WS_ECNT + 4096;
constexpr size_t WS_EIDX  = WS_WRT + (size_t)48 * 1024 * 4;
constexpr size_t WS_EGATE = WS_EIDX + (size_t)MA * 2 * 4;
constexpr size_t WS_ELIST = WS_EGATE + (size_t)MA * 2 * 4;
constexpr size_t WS_X     = MBy(8);
constexpr size_t WS_H     = WS_X + (size_t)MA * DM * 4;
constexpr size_t WS_WIN   = WS_H + (size_t)MA * DM * 2;
constexpr size_t WS_WOUT  = WS_WIN + (size_t)INW * DM * 2;
constexpr size_t WS_W1    = WS_WOUT + (size_t)DM * DM * 2;
constexpr size_t WS_W3    = WS_W1 + (size_t)NEXP * FF * DM * 2;
constexpr size_t WS_W2    = WS_W3 + (size_t)NEXP * FF * DM * 2;
constexpr size_t WS_LW2   = WS_W2 + (size_t)NEXP * FF * DM * 2;
constexpr size_t WS_LA2   = WS_LW2 + (size_t)2 * 512 * 64 * 2;
constexpr size_t WS_LG2   = WS_LA2 + (size_t)2 * 512 * 64 * 2;
constexpr size_t WS_QA    = WS_LG2 + (size_t)512 * 128 * 2;
constexpr size_t WS_KA    = WS_QA + (size_t)NB * 4 * NKEY * 64 * 2;
constexpr size_t WS_VAT   = WS_KA + (size_t)NB * 2 * NKEY * 64 * 2;
constexpr size_t WS_QB    = WS_VAT + (size_t)NB * 2 * NKEY * 64 * 2;
constexpr size_t WS_KB    = WS_QB + (size_t)NB * 4 * NKEY * 64 * 2;
constexpr size_t WS_VBT   = WS_KB + (size_t)NB * 4 * NKEY * 64 * 2;
constexpr size_t WS_CP    = WS_VBT + (size_t)NB * 4 * NKEY * 64 * 2;
constexpr size_t WS_LX    = WS_CP + (size_t)MA * CSL * 4;
constexpr size_t WS_GG    = WS_LX + (size_t)MA * 384 * 2;
constexpr size_t WS_MIX   = WS_GG + (size_t)MA * 512 * 4;
constexpr size_t HEADARR  = (size_t)NB * 8 * NKEY * 64 * 4;
constexpr size_t WS_RR    = WS_MIX + (size_t)MA * DM * 2;
constexpr size_t WS_VV    = WS_RR + HEADARR;
constexpr size_t WS_KK    = WS_VV + HEADARR;
constexpr size_t WS_YS    = WS_KK + HEADARR;
constexpr size_t WS_WW    = WS_YS + 2 * HEADARR;
constexpr size_t WS_KD    = WS_WW + 2 * HEADARR;
constexpr size_t WS_BB    = WS_KD + 2 * HEADARR;
constexpr size_t WS_END   = WS_BB + 2 * HEADARR;
constexpr size_t WS_Y01   = WS_WW;
constexpr size_t WS_HB    = WS_RR;

struct P {
    const float *x, *c, *ctx, *c_ctx, *w_mod, *b_mod, *g_mix, *g_ffn, *w_in, *a_q_gain, *a_k_gain, *b_lq1, *b_lk1, *b_lq2, *b_lk2, *b_subln,
        *c_mu, *c_w0, *c_w2, *c_a0, *c_a2, *c_g2, *c_k_k, *c_k_a, *c_r_k, *c_ln_w, *c_ln_b, *w_out, *r_w_group, *r_b_group, *r_w_expert, *r_b_expert,
        *e_w1, *e_w3, *e_w2, *g_final;
    float* out;
    char* ws;
};

__device__ __forceinline__ float bf2f(bfu b) { return __uint_as_float((unsigned)b << 16); }
__device__ __forceinline__ unsigned pack2(float a, float b) {
    typedef float f2 __attribute__((ext_vector_type(2)));
    typedef __bf16 b2 __attribute__((ext_vector_type(2)));
    f2 v = {a, b}; b2 r = __builtin_convertvector(v, b2); return __builtin_bit_cast(unsigned, r);
}
__device__ __forceinline__ bfu f2bf(float a) { return (bfu)(pack2(a, 0.f) & 0xFFFFu); }
__device__ __forceinline__ float wave_sum(float v) {
#pragma unroll
    for (int o = 32; o >= 1; o >>= 1) v += __shfl_xor(v, o);
    return v;
}
__device__ __forceinline__ float sigmoidf_(float x) { return 1.f / (1.f + __expf(-x)); }
__device__ __forceinline__ float siluf_(float x) { return x / (1.f + __expf(-x)); }
__device__ __forceinline__ void row_info(int grow, int& b, int& j, int& s) {
    if (grow < ML) { b = grow >> 11; j = 256 + (grow & 2047); s = b; }
    else { int r = grow - ML; b = r >> 8; j = r & 255; s = 8; }
}
__device__ __forceinline__ int grow_of(int b, int j) { return j < 256 ? ML + b * 256 + j : b * 2048 + (j - 256); }

#define SMEM_BYTES 69632

#define PHASE_PROLOGUE int tid_ = threadIdx.x; asm volatile("" : "+v"(tid_)); char* ws_ = p.ws; asm volatile("" : "+s"(ws_));

__device__ void phase_setup(const P& p, int bid, int nb) {
    PHASE_PROLOGUE
    float4* X4 = (float4*)(ws_ + WS_X);
    const float4* x4 = (const float4*)p.x; const float4* c4 = (const float4*)p.ctx;
    const size_t nl = (size_t)ML * DM / 4, nc = (size_t)MC * DM / 4;
    for (size_t i = (size_t)bid * 256 + tid_; i < nl + nc; i += (size_t)nb * 256) X4[i] = i < nl ? x4[i] : c4[i - nl];
    if (bid == 0) {
        float* TA = (float*)(ws_ + WS_ROPE); float* TB = TA + 64 * 16 * 2;
        for (int i = tid_; i < 64 * 16; i += 256) { int pos = i >> 4, f = i & 15; double inv = pow(10000.0, -(double)f / 16.0); double a = (double)pos * inv; TA[i * 2] = (float)cos(a); TA[i * 2 + 1] = (float)sin(a); }
        for (int i = tid_; i < 64 * 8; i += 256) { int pos = i >> 3, f = i & 7; double inv = pow(10000.0, -(double)f / 8.0); double a = (double)pos * inv; TB[i * 2] = (float)cos(a); TB[i * 2 + 1] = (float)sin(a); }
        int* ec = (int*)(ws_ + WS_ECNT);
        for (int i = tid_; i < 128; i += 256) ec[i] = 0;
    }
}

__device__ void phase_mod(const P& p, int bid, int nb, char* smem) {
    PHASE_PROLOGUE
    float* act = (float*)smem;
    float* red = act + 9 * 1024;
    for (int i = tid_; i < 9 * 1024; i += 256) { float v = i < 8 * 1024 ? p.c[i] : p.c_ctx[i - 8 * 1024]; act[i] = siluf_(v); }
    __syncthreads();
    float* mod = (float*)(ws_ + WS_MOD);
    const int nitems = 4 * 6144 / 64;
    const int cl = tid_ & 63, kq = tid_ >> 6;
    for (int it = bid; it < nitems; it += nb) {
        const int layer = it / 96, n = (it % 96) * 64 + cl;
        const float* w = p.w_mod + (size_t)layer * DM * 6144 + n;
        float a[9];
#pragma unroll
        for (int s = 0; s < 9; ++s) a[s] = 0.f;
        for (int k = kq * 256; k < kq * 256 + 256; ++k) {
            const float wv = w[(size_t)k * 6144];
#pragma unroll
            for (int s = 0; s < 9; ++s) a[s] += act[s * 1024 + k] * wv;
        }
#pragma unroll
        for (int s = 0; s < 9; ++s) red[(kq * 9 + s) * 64 + cl] = a[s];
        __syncthreads();
        for (int i = tid_; i < 9 * 64; i += 256) {
            const int s = i >> 6, c2 = i & 63, n2 = (it % 96) * 64 + c2;
            float v = red[(0 * 9 + s) * 64 + c2] + red[(1 * 9 + s) * 64 + c2] + red[(2 * 9 + s) * 64 + c2] + red[(3 * 9 + s) * 64 + c2];
            mod[((size_t)layer * 9 + s) * 6144 + n2] = v + p.b_mod[layer * 6144 + n2];
        }
        __syncthreads();
    }
}

__device__ __forceinline__ void conv_tile(const float* src, int K, int N, bfu* dst, int k0, int n0, float* ts, int tid_) {
    const int t = tid_;
    {
        const int kk = t >> 4, n4 = (t & 15) * 4;
#pragma unroll
        for (int pz = 0; pz < 4; ++pz) {
            const float4 v = *(const float4*)(src + (size_t)(k0 + kk + 16 * pz) * N + n0 + n4);
            float* d = ts + (kk + 16 * pz) * 65 + n4; d[0] = v.x; d[1] = v.y; d[2] = v.z; d[3] = v.w;
        }
    }
    __syncthreads();
    {
        const int n = t >> 2, kc = (t & 3) * 16;
        unsigned o[8];
#pragma unroll
        for (int i = 0; i < 8; ++i) o[i] = pack2(ts[(kc + 2 * i) * 65 + n], ts[(kc + 2 * i + 1) * 65 + n]);
        uint4* d = (uint4*)(dst + (size_t)(n0 + n) * K + k0 + kc);
        d[0] = make_uint4(o[0], o[1], o[2], o[3]); d[1] = make_uint4(o[4], o[5], o[6], o[7]);
    }
    __syncthreads();
}
__device__ void phase_conv(const P& p, int layer, int bid, int nb, char* smem) {
    PHASE_PROLOGUE
    float* ts = (float*)smem;
    const float* srcs[8]; bfu* dsts[8]; int Ks[8], Ns[8], Bs[8];
    char* ws = ws_;
    srcs[0] = p.w_in + (size_t)layer * DM * INW;  Ks[0] = DM; Ns[0] = INW; Bs[0] = 1;  dsts[0] = (bfu*)(ws + WS_WIN);
    srcs[1] = p.w_out + (size_t)layer * DM * DM;  Ks[1] = DM; Ns[1] = DM;  Bs[1] = 1;  dsts[1] = (bfu*)(ws + WS_WOUT);
    srcs[2] = p.e_w1 + (size_t)layer * NEXP * DM * FF; Ks[2] = DM; Ns[2] = FF; Bs[2] = NEXP; dsts[2] = (bfu*)(ws + WS_W1);
    srcs[3] = p.e_w3 + (size_t)layer * NEXP * DM * FF; Ks[3] = DM; Ns[3] = FF; Bs[3] = NEXP; dsts[3] = (bfu*)(ws + WS_W3);
    srcs[4] = p.e_w2 + (size_t)layer * NEXP * FF * DM; Ks[4] = FF; Ns[4] = DM; Bs[4] = NEXP; dsts[4] = (bfu*)(ws + WS_W2);
    srcs[5] = p.c_w2 + (size_t)layer * 2 * 64 * 512;   Ks[5] = 64; Ns[5] = 512; Bs[5] = 2;   dsts[5] = (bfu*)(ws + WS_LW2);
    srcs[6] = p.c_a2 + (size_t)layer * 2 * 64 * 512;   Ks[6] = 64; Ns[6] = 512; Bs[6] = 2;   dsts[6] = (bfu*)(ws + WS_LA2);
    srcs[7] = p.c_g2 + (size_t)layer * 128 * 512;      Ks[7] = 128; Ns[7] = 512; Bs[7] = 1;  dsts[7] = (bfu*)(ws + WS_LG2);
    int start = 0;
#pragma unroll
    for (int jb = 0; jb < 8; ++jb) {
        const int tk = Ks[jb] / 64, tn = Ns[jb] / 64, per = tk * tn, tot = per * Bs[jb];
        int first = bid - (start % nb); if (first < 0) first += nb;
        for (int it = first; it < tot; it += nb) {
            const int bt = it / per, r = it % per, kt = r / tn, nt = r % tn;
            conv_tile(srcs[jb] + (size_t)bt * Ks[jb] * Ns[jb], Ks[jb], Ns[jb], dsts[jb] + (size_t)bt * Ks[jb] * Ns[jb], kt * 64, nt * 64, ts, tid_);
        }
        start += tot;
    }
    float* wrt = (float*)(ws + WS_WRT);
    const float* wg = p.r_w_group + (size_t)layer * DM * 4; const float* we = p.r_w_expert + (size_t)layer * DM * 32;
    for (int i = bid * 256 + tid_; i < 48 * 1024; i += nb * 256) {
        const int r = i >> 10, k = i & 1023;
        wrt[i] = r < 4 ? wg[k * 4 + r] : (r < 36 ? we[k * 32 + (r - 4)] : 0.f);
    }
}

__device__ void phase_norm1(const P& p, int layer, int mode, int bid, int nb) {
    PHASE_PROLOGUE
    float* X = (float*)(ws_ + WS_X); bfu* H = (bfu*)(ws_ + WS_H);
    const float* Y0 = (const float*)(ws_ + WS_Y01); const float* Y1 = Y0 + (size_t)MA * DM;
    const float* mod = (const float*)(ws_ + WS_MOD);
    const int lane = tid_ & 63, wv = tid_ >> 6;
    const int nrows = mode ? ML : MA;
    if (bid == 0 && mode == 0 && tid_ < 32) ((int*)(ws_ + WS_ECNT))[layer * 32 + tid_] = 0;
    for (int row = bid * 4 + wv; row < nrows; row += nb * 4) {
        int b, j, s; row_info(row, b, j, s);
        float4 v[4];
        float ss = 0.f;
#pragma unroll
        for (int c = 0; c < 4; ++c) {
            const int col = c * 256 + lane * 4;
            float4 xv = *(const float4*)(X + (size_t)row * DM + col);
            if (layer > 0) {
                const float4 a = *(const float4*)(Y0 + (size_t)row * DM + col), bq = *(const float4*)(Y1 + (size_t)row * DM + col);
                const float4 g = *(const float4*)(mod + ((size_t)(layer - 1) * 9 + s) * 6144 + 5 * 1024 + col);
                xv.x += g.x * (a.x + bq.x); xv.y += g.y * (a.y + bq.y); xv.z += g.z * (a.z + bq.z); xv.w += g.w * (a.w + bq.w);
                if (!mode) *(float4*)(X + (size_t)row * DM + col) = xv;
            }
            v[c] = xv; ss += xv.x * xv.x + xv.y * xv.y + xv.z * xv.z + xv.w * xv.w;
        }
        ss = wave_sum(ss);
        const float rs = rsqrtf(ss * (1.f / 1024.f) + 1e-6f);
#pragma unroll
        for (int c = 0; c < 4; ++c) {
            const int col = c * 256 + lane * 4;
            if (mode) {
                const float4 g = *(const float4*)(p.g_final + col);
                float4 o; o.x = v[c].x * rs * g.x; o.y = v[c].y * rs * g.y; o.z = v[c].z * rs * g.z; o.w = v[c].w * rs * g.w;
                *(float4*)(p.out + (size_t)row * DM + col) = o;
            } else {
                const float4 g = *(const float4*)(p.g_mix + layer * DM + col);
                const float4 sh = *(const float4*)(mod + ((size_t)layer * 9 + s) * 6144 + 0 * 1024 + col);
                const float4 sc = *(const float4*)(mod + ((size_t)layer * 9 + s) * 6144 + 1 * 1024 + col);
                const float o0 = v[c].x * rs * g.x * (1.f + sc.x) + sh.x, o1 = v[c].y * rs * g.y * (1.f + sc.y) + sh.y;
                const float o2 = v[c].z * rs * g.z * (1.f + sc.z) + sh.z, o3 = v[c].w * rs * g.w * (1.f + sc.w) + sh.w;
                *(uint2*)(H + (size_t)row * DM + col) = make_uint2(pack2(o0, o1), pack2(o2, o3));
            }
        }
    }
}

template <class FA, class FB, class FE>
__device__ __forceinline__ void gemm_tile(FA arow, FB brow, int K, FE epi, char* smem) {
    bfu* sA = (bfu*)smem; bfu* sB = sA + 2 * 4096;
    int tid = threadIdx.x; asm volatile("" : "+v"(tid));
    const int lane = tid & 63, wid = tid >> 6, wr = wid >> 1, wc = wid & 1, fr = lane & 15, fq = lane >> 4;
    const int lr = tid >> 2, lc = tid & 3;
    const bfu* pa0 = arow(lr) + lc * 8; const bfu* pa1 = arow(lr + 64) + lc * 8;
    const bfu* pb0 = brow(lr) + lc * 8; const bfu* pb1 = brow(lr + 64) + lc * 8;
    f32x4 acc[4][4];
#pragma unroll
    for (int m = 0; m < 4; ++m)
#pragma unroll
        for (int n = 0; n < 4; ++n) acc[m][n] = (f32x4){0.f, 0.f, 0.f, 0.f};
    uint4 ra0 = *(const uint4*)pa0, ra1 = *(const uint4*)pa1, rb0 = *(const uint4*)pb0, rb1 = *(const uint4*)pb1;
    const int so = lr * 32 + lc * 8;
    __syncthreads();
    *(uint4*)(sA + so) = ra0; *(uint4*)(sA + so + 64 * 32) = ra1; *(uint4*)(sB + so) = rb0; *(uint4*)(sB + so + 64 * 32) = rb1;
    __syncthreads();
    const int nk = K >> 5;
    for (int kt = 0; kt < nk; ++kt) {
        if (kt + 1 < nk) {
            const int ko = (kt + 1) * 32;
            ra0 = *(const uint4*)(pa0 + ko); ra1 = *(const uint4*)(pa1 + ko); rb0 = *(const uint4*)(pb0 + ko); rb1 = *(const uint4*)(pb1 + ko);
        }
        const bfu* cA = sA + (kt & 1) * 4096; const bfu* cB = sB + (kt & 1) * 4096;
        bf16x8 af[4], bfr[4];
#pragma unroll
        for (int m = 0; m < 4; ++m) af[m] = *(const bf16x8*)(cA + (wr * 64 + m * 16 + fr) * 32 + fq * 8);
#pragma unroll
        for (int n = 0; n < 4; ++n) bfr[n] = *(const bf16x8*)(cB + (wc * 64 + n * 16 + fr) * 32 + fq * 8);
#pragma unroll
        for (int m = 0; m < 4; ++m)
#pragma unroll
            for (int n = 0; n < 4; ++n) acc[m][n] = __builtin_amdgcn_mfma_f32_16x16x32_bf16(af[m], bfr[n], acc[m][n], 0, 0, 0);
        if (kt + 1 < nk) {
            bfu* nA = sA + ((kt + 1) & 1) * 4096; bfu* nB = sB + ((kt + 1) & 1) * 4096;
            *(uint4*)(nA + so) = ra0; *(uint4*)(nA + so + 64 * 32) = ra1; *(uint4*)(nB + so) = rb0; *(uint4*)(nB + so + 64 * 32) = rb1;
        }
        __syncthreads();
    }
    epi(acc, wr, wc, fr, fq);
}
#define ACC_FOREACH(...)                                                                      \
    _Pragma("unroll") for (int m_ = 0; m_ < 4; ++m_) _Pragma("unroll") for (int n_ = 0; n_ < 4; ++n_) \
    _Pragma("unroll") for (int j_ = 0; j_ < 4; ++j_) {                                        \
        const int row = wr * 64 + m_ * 16 + fq * 4 + j_; const int col = wc * 64 + n_ * 16 + fr; const float val = acc[m_][n_][j_]; __VA_ARGS__ }

__device__ void phase_inproj(const P& p, int layer, int bid, int nb, char* smem) {
    PHASE_PROLOGUE
    const bfu* H = (const bfu*)(ws_ + WS_H); const bfu* W = (const bfu*)(ws_ + WS_WIN);
    float* Cs = (float*)smem;
    const float* TA = (const float*)(ws_ + WS_ROPE); const float* TB = TA + 64 * 16 * 2;
    const int nitems = 144 * 25;
    for (int it = bid; it < nitems; it += nb) {
        const int mt = it / 25, nt = it % 25;
        const int row0 = mt * 128, col0 = nt * 128;
        gemm_tile([&](int r) { return H + (size_t)(row0 + r) * DM; }, [&](int r) { return W + (size_t)(col0 + r) * DM; }, DM,
            [&](f32x4 (&acc)[4][4], int wr, int wc, int fr, int fq) {
                ACC_FOREACH(Cs[row * 132 + col] = val;)
            }, smem);
        __syncthreads();
        const int tid = tid_;
        int b, j0, s; row_info(row0, b, j0, s);
        const bool lat = row0 < ML;
        if (nt <= 2) {
            const int r = tid & 127, hl = tid >> 7;
            const bool isq = nt < 2;
            const float* gain = (isq ? p.a_q_gain : p.a_k_gain) + layer * 64;
            float v[64]; float ss = 0.f;
#pragma unroll
            for (int d4 = 0; d4 < 16; ++d4) { const float4 t4 = *(const float4*)(Cs + r * 132 + hl * 64 + d4 * 4); v[d4 * 4] = t4.x; v[d4 * 4 + 1] = t4.y; v[d4 * 4 + 2] = t4.z; v[d4 * 4 + 3] = t4.w; ss += t4.x * t4.x + t4.y * t4.y + t4.z * t4.z + t4.w * t4.w; }
            const float rs = rsqrtf(ss * (1.f / 64.f) + 1e-6f);
#pragma unroll
            for (int d = 0; d < 64; ++d) v[d] = v[d] * rs * gain[d];
            if (lat) {
                const int t = (j0 - 256) + r;
#pragma unroll
                for (int a = 0; a < 2; ++a) {
                    const int pos = a == 0 ? (t >> 6) : (t & 63);
#pragma unroll
                    for (int f = 0; f < 16; ++f) {
                        const float cs = TA[(pos * 16 + f) * 2], sn = TA[(pos * 16 + f) * 2 + 1];
                        const float x0 = v[a * 32 + f], x1 = v[a * 32 + 16 + f];
                        v[a * 32 + f] = x0 * cs - x1 * sn; v[a * 32 + 16 + f] = x1 * cs + x0 * sn;
                    }
                }
            }
            const float qs = isq ? 0.125f * LOG2E : 1.f;
            bfu* dst = isq ? (bfu*)(ws_ + WS_QA) + (((size_t)b * 4 + (nt * 2 + hl)) * NKEY + j0 + r) * 64
                           : (bfu*)(ws_ + WS_KA) + (((size_t)b * 2 + hl) * NKEY + j0 + r) * 64;
#pragma unroll
            for (int d8 = 0; d8 < 8; ++d8)
                ((uint4*)dst)[d8] = make_uint4(pack2(v[d8 * 8] * qs, v[d8 * 8 + 1] * qs), pack2(v[d8 * 8 + 2] * qs, v[d8 * 8 + 3] * qs),
                                               pack2(v[d8 * 8 + 4] * qs, v[d8 * 8 + 5] * qs), pack2(v[d8 * 8 + 6] * qs, v[d8 * 8 + 7] * qs));
        } else if (nt == 3 || nt == 8 || nt == 9) {
            const int c = tid & 127, half = tid >> 7, hl = c >> 6, d = c & 63;
            bfu* dst = nt == 3 ? (bfu*)(ws_ + WS_VAT) + (((size_t)b * 2 + hl) * 64 + d) * NKEY + j0 + half * 64
                               : (bfu*)(ws_ + WS_VBT) + (((size_t)b * 4 + ((nt - 8) * 2 + hl)) * 64 + d) * NKEY + j0 + half * 64;
#pragma unroll
            for (int r8 = 0; r8 < 8; ++r8) {
                const float* s0 = Cs + (half * 64 + r8 * 8) * 132 + c;
                ((uint4*)dst)[r8] = make_uint4(pack2(s0[0], s0[132]), pack2(s0[2 * 132], s0[3 * 132]), pack2(s0[4 * 132], s0[5 * 132]), pack2(s0[6 * 132], s0[7 * 132]));
            }
        } else if (nt <= 7) {
            const bool isq = nt < 6;
            const int hbase = ((nt - 4) & 1) * 2;
#pragma unroll
            for (int itq = 0; itq < 2; ++itq) {
                const int u = tid + 256 * itq, r = u & 127, hm = u >> 7;
                float v[32];
#pragma unroll
                for (int d4 = 0; d4 < 8; ++d4) { const float4 t4 = *(const float4*)(Cs + r * 132 + hm * 32 + d4 * 4); v[d4 * 4] = t4.x; v[d4 * 4 + 1] = t4.y; v[d4 * 4 + 2] = t4.z; v[d4 * 4 + 3] = t4.w; }
                if (lat) {
                    const int t = (j0 - 256) + r;
#pragma unroll
                    for (int a = 0; a < 2; ++a) {
                        const int pos = a == 0 ? (t >> 6) : (t & 63);
#pragma unroll
                        for (int f = 0; f < 8; ++f) {
                            const float cs = TB[(pos * 8 + f) * 2], sn = TB[(pos * 8 + f) * 2 + 1];
                            const float x0 = v[a * 16 + f], x1 = v[a * 16 + 8 + f];
                            v[a * 16 + f] = x0 * cs - x1 * sn; v[a * 16 + 8 + f] = x1 * cs + x0 * sn;
                        }
                    }
                }
                const float qs = isq ? 0.17677669529663687f * LOG2E : 1.f;
                const int h = hbase + (hm >> 1), mp = hm & 1;
                bfu* dst = (bfu*)(ws_ + (isq ? WS_QB : WS_KB)) + ((((size_t)b * 4 + h) * 2 + mp) * NKEY + j0 + r) * 32;
#pragma unroll
                for (int d8 = 0; d8 < 4; ++d8)
                    ((uint4*)dst)[d8] = make_uint4(pack2(v[d8 * 8] * qs, v[d8 * 8 + 1] * qs), pack2(v[d8 * 8 + 2] * qs, v[d8 * 8 + 3] * qs),
                                                   pack2(v[d8 * 8 + 4] * qs, v[d8 * 8 + 5] * qs), pack2(v[d8 * 8 + 6] * qs, v[d8 * 8 + 7] * qs));
            }
        } else {
            const int r = tid & 127, half = tid >> 7;
            float* dst = (float*)(ws_ + WS_CP) + (size_t)(row0 + r) * CSL + (nt - 10) * 128 + half * 64;
#pragma unroll
            for (int d4 = 0; d4 < 16; ++d4) ((float4*)dst)[d4] = *(const float4*)(Cs + r * 132 + half * 64 + d4 * 4);
        }
        __syncthreads();
    }
}

__device__ void phase_rwkv_prep(const P& p, int layer, int bid, int nb) {
    PHASE_PROLOGUE
    const float* CP = (const float*)(ws_ + WS_CP);
    float* RR = (float*)(ws_ + WS_RR); float* VV = (float*)(ws_ + WS_VV); float* KK = (float*)(ws_ + WS_KK);
    float* KR = (float*)(ws_ + WS_YS) + HEADARR / 4;
    bfu* LX = (bfu*)(ws_ + WS_LX);
    const float* mu = p.c_mu + layer * CSL; const float* k_k = p.c_k_k + layer * 512;
    const int lane = tid_ & 63, wv = tid_ >> 6;
    for (int row = bid * 4 + wv; row < MA; row += nb * 4) {
        int b, j, s; row_info(row, b, j, s);
        const int t = row < ML ? (row & 2047) : ((row - ML) & 255), T = row < ML ? SEQ : CL;
        const float* c0 = CP + (size_t)row * CSL;
        const bool hp = t > 0, hn = t < T - 1;
#pragma unroll 2
        for (int c = 0; c < 30; ++c) {
            const int col = c * 64 + lane;
            const float pc = c0[col];
            const float pp = hp ? c0[col - CSL] : 0.f, pn = hn ? c0[col + CSL] : 0.f;
            const float pf = pc + mu[col] * (0.5f * (pp + pn) - pc);
            if (c < 24) {
                const int h = c & 7;
                const size_t o = (((size_t)b * 8 + h) * NKEY + j) * 64 + lane;
                if (c < 8) RR[o] = pf;
                else if (c < 16) {
                    KR[o] = pf;
                    const float kv = pf * k_k[h * 64 + lane];
                    const float ss = wave_sum(kv * kv);
                    KK[o] = kv / fmaxf(sqrtf(ss), 1e-12f);
                } else VV[o] = pf;
            } else {
                float o;
                if (c < 26) o = tanhf(pf); else if (c < 28) o = pf; else o = sigmoidf_(pf);
                LX[(size_t)row * 384 + (c - 24) * 64 + lane] = f2bf(o);
            }
        }
    }
}

__device__ void phase_rwkv_lora(const P& p, int layer, int bid, int nb, char* smem) {
    PHASE_PROLOGUE
    const bfu* LX = (const bfu*)(ws_ + WS_LX);
    const int nitems = 144 * 4 * 5;
    for (int it = bid; it < nitems; it += nb) {
        const int job = it / (144 * 4), r2 = it % (144 * 4), mt = r2 >> 2, nt = r2 & 3;
        const int row0 = mt * 128, col0 = nt * 128;
        int b, j0, s; row_info(row0, b, j0, s);
        const int z = job & 1;
        const bfu* Bt; int K, aoff;
        if (job < 2) { Bt = (const bfu*)(ws_ + WS_LW2) + (size_t)z * 512 * 64; K = 64; aoff = z * 64; }
        else if (job < 4) { Bt = (const bfu*)(ws_ + WS_LA2) + (size_t)z * 512 * 64; K = 64; aoff = 128 + z * 64; }
        else { Bt = (const bfu*)(ws_ + WS_LG2); K = 128; aoff = 256; }
        gemm_tile([&](int r) { return LX + (size_t)(row0 + r) * 384 + aoff; }, [&](int r) { return Bt + (size_t)(col0 + r) * K; }, K,
            [&](f32x4 (&acc)[4][4], int wr, int wc, int fr, int fq) {
                if (job < 2) {
                    float* WW = (float*)(ws_ + WS_WW) + (size_t)z * (HEADARR / 4);
                    const float* w0 = p.c_w0 + ((size_t)layer * 2 + z) * 512;
                    ACC_FOREACH({
                        const int gc = col0 + col; const float xx = w0[gc] + val;
                        const float nx = -xx; const float sp = nx > 20.f ? nx : log1pf(__expf(nx));
                        const float wlog = -sp - 0.5f;
                        WW[(((size_t)b * 8 + (gc >> 6)) * NKEY + j0 + row) * 64 + (gc & 63)] = __expf(-__expf(wlog));
                    })
                } else if (job < 4) {
                    float* KD = (float*)(ws_ + WS_KD) + (size_t)z * (HEADARR / 4); float* BB = (float*)(ws_ + WS_BB) + (size_t)z * (HEADARR / 4);
                    const float* KR = (const float*)(ws_ + WS_YS) + HEADARR / 4; const float* KK = (const float*)(ws_ + WS_KK);
                    const float* a0 = p.c_a0 + ((size_t)layer * 2 + z) * 512; const float* k_a = p.c_k_a + layer * 512;
                    ACC_FOREACH({
                        const int gc = col0 + col; const float icl = sigmoidf_(a0[gc] + val);
                        const size_t o = (((size_t)b * 8 + (gc >> 6)) * NKEY + j0 + row) * 64 + (gc & 63);
                        KD[o] = KR[o] * (1.f + (icl - 1.f) * k_a[gc]); BB[o] = KK[o] * icl;
                    })
                } else {
                    float* GG = (float*)(ws_ + WS_GG);
                    ACC_FOREACH(GG[(size_t)(row0 + row) * 512 + col0 + col] = val;)
                }
            }, smem);
    }
}

__device__ void phase_scan(const P& p, int layer, int bid, int nb, char* smem) {
    PHASE_PROLOGUE
    float* sbuf = (float*)smem;
    const int tid = tid_, cg = tid & 7, rl = tid >> 3;
    for (int it = bid; it < 256; it += nb) {
        const int half = it & 1, z = (it >> 1) & 1, h = (it >> 2) & 7, b = it >> 5;
        const size_t hb = ((size_t)b * 8 + h) * NKEY * 64;
        const float* aW = (const float*)(ws_ + WS_WW) + (size_t)z * (HEADARR / 4) + hb;
        const float* aK = (const float*)(ws_ + WS_KD) + (size_t)z * (HEADARR / 4) + hb;
        const float* aB = (const float*)(ws_ + WS_BB) + (size_t)z * (HEADARR / 4) + hb;
        const float* aA = (const float*)(ws_ + WS_KK) + hb;
        const float* aR = (const float*)(ws_ + WS_RR) + hb;
        const float* aV = (const float*)(ws_ + WS_VV) + hb;
        float* aY = (float*)(ws_ + WS_YS) + (size_t)z * (HEADARR / 4) + hb;
        const int vrow = half * 32 + rl;
        float S[8];
#pragma unroll
        for (int i = 0; i < 8; ++i) S[i] = 0.f;
        auto chunk_j0 = [&](int c) { return z == 0 ? c * 16 : (c < 16 ? 240 - c * 16 : 2288 - (c - 16) * 16); };
        float4 pre0, pre1, pre2, pre3, pre4, pre5;
#define load_chunk(c) { const size_t jo = (size_t)chunk_j0(c) * 64 + tid * 4; pre0 = *(const float4*)(aW + jo); pre1 = *(const float4*)(aA + jo); pre2 = *(const float4*)(aB + jo); \
                        pre3 = *(const float4*)(aK + jo); pre4 = *(const float4*)(aR + jo); pre5 = *(const float4*)(aV + jo); }
#define store_chunk(buf) { float* d_ = sbuf + (((buf) * 16 + (tid >> 4)) * 6) * 64 + (tid & 15) * 4; *(float4*)(d_) = pre0; *(float4*)(d_ + 64) = pre1; *(float4*)(d_ + 128) = pre2; \
                        *(float4*)(d_ + 192) = pre3; *(float4*)(d_ + 256) = pre4; *(float4*)(d_ + 320) = pre5; }
        __syncthreads();
        load_chunk(0); store_chunk(0);
        __syncthreads();
        for (int c = 0; c < 144; ++c) {
            if (c + 1 < 144) load_chunk(c + 1);
            const int jl = chunk_j0(c);
            const float* cb = sbuf + (c & 1) * 16 * 6 * 64;
            for (int s = 0; s < 16; ++s) {
                const int st = z == 0 ? s : 15 - s;
                const float* sv = cb + st * 6 * 64;
                const float4 w0 = *(const float4*)(sv + 0 * 64 + cg * 8), w1 = *(const float4*)(sv + 0 * 64 + cg * 8 + 4);
                const float4 a0 = *(const float4*)(sv + 1 * 64 + cg * 8), a1 = *(const float4*)(sv + 1 * 64 + cg * 8 + 4);
                const float4 b0 = *(const float4*)(sv + 2 * 64 + cg * 8), b1 = *(const float4*)(sv + 2 * 64 + cg * 8 + 4);
                const float4 k0 = *(const float4*)(sv + 3 * 64 + cg * 8), k1 = *(const float4*)(sv + 3 * 64 + cg * 8 + 4);
                const float4 r0 = *(const float4*)(sv + 4 * 64 + cg * 8), r1 = *(const float4*)(sv + 4 * 64 + cg * 8 + 4);
                const float vv = sv[5 * 64 + vrow];
                const float w[8] = {w0.x, w0.y, w0.z, w0.w, w1.x, w1.y, w1.z, w1.w};
                const float a[8] = {a0.x, a0.y, a0.z, a0.w, a1.x, a1.y, a1.z, a1.w};
                const float bb[8] = {b0.x, b0.y, b0.z, b0.w, b1.x, b1.y, b1.z, b1.w};
                const float kk[8] = {k0.x, k0.y, k0.z, k0.w, k1.x, k1.y, k1.z, k1.w};
                const float rr[8] = {r0.x, r0.y, r0.z, r0.w, r1.x, r1.y, r1.z, r1.w};
                float sa = 0.f;
#pragma unroll
                for (int i = 0; i < 8; ++i) sa += S[i] * a[i];
                sa += __shfl_xor(sa, 1); sa += __shfl_xor(sa, 2); sa += __shfl_xor(sa, 4);
                sa = -sa;
                float y = 0.f;
#pragma unroll
                for (int i = 0; i < 8; ++i) { S[i] = S[i] * w[i] + sa * bb[i] + vv * kk[i]; y += S[i] * rr[i]; }
                y += __shfl_xor(y, 1); y += __shfl_xor(y, 2); y += __shfl_xor(y, 4);
                if (cg == 0) aY[(size_t)(jl + st) * 64 + vrow] = y;
            }
            if (c + 1 < 144) store_chunk((c + 1) & 1);
            __syncthreads();
        }
    }
}

__device__ void phase_readout(const P& p, int layer, int nrows, int bid, int nb) {
    PHASE_PROLOGUE
    const float* Y0 = (const float*)(ws_ + WS_YS); const float* Y1 = Y0 + HEADARR / 4;
    const float* RR = (const float*)(ws_ + WS_RR); const float* VV = (const float*)(ws_ + WS_VV);
    const float* KD0 = (const float*)(ws_ + WS_KD); const float* KD1 = KD0 + HEADARR / 4;
    const float* GG = (const float*)(ws_ + WS_GG);
    bfu* MIX = (bfu*)(ws_ + WS_MIX);
    const float* lnw = p.c_ln_w + layer * 512; const float* lnb = p.c_ln_b + layer * 512; const float* rk = p.c_r_k + layer * 512;
    const int lane = tid_ & 63, wv = tid_ >> 6;
    for (int row = bid * 4 + wv; row < nrows; row += nb * 4) {
        int b, j, s; row_info(row, b, j, s);
#pragma unroll 2
        for (int h = 0; h < 8; ++h) {
            const size_t o = (((size_t)b * 8 + h) * NKEY + j) * 64 + lane;
            const float y = Y0[o] + Y1[o];
            const float mean = wave_sum(y) * (1.f / 64.f);
            const float dv = y - mean;
            const float var = wave_sum(dv * dv) * (1.f / 64.f);
            const float yn = dv * rsqrtf(var + 64e-5f) * lnw[h * 64 + lane] + lnb[h * 64 + lane];
            const float r = RR[o], v = VV[o];
            const float rkv = rk[h * 64 + lane];
            const float bs = wave_sum(r * KD0[o] * rkv) + wave_sum(r * KD1[o] * rkv);
            const float outv = (yn + bs * v) * GG[(size_t)row * 512 + h * 64 + lane];
            MIX[(size_t)row * DM + 512 + h * 64 + lane] = f2bf(outv);
        }
    }
}

__device__ void phase_attn_naive(const P& p, int layer, bool do_ctx, unsigned* qctr, int* s_item, char* smem) {
    PHASE_PROLOGUE
    float* Ks = (float*)smem;
    float* Vs = Ks + 32 * 64;
    const int tid = tid_;
    const float lam_init = 0.8f - 0.6f * expf(-0.3f * (float)layer);
    float d1 = 0.f, d2 = 0.f;
    for (int i = 0; i < 32; ++i) { d1 += p.b_lq1[layer * 32 + i] * p.b_lk1[layer * 32 + i]; d2 += p.b_lq2[layer * 32 + i] * p.b_lk2[layer * 32 + i]; }
    const float lam = expf(d1) - expf(d2) + lam_init;
    const int nitems = 2 * 8 * 4 * 9;
    bfu* MIX = (bfu*)(ws_ + WS_MIX);
    for (;;) {
        __syncthreads();
        if (tid == 0) *s_item = (int)atomicAdd(qctr, 1u);
        __syncthreads();
        const int it = *s_item;
        if (it >= nitems) break;
        const int qb = it % 9, h = (it / 9) & 3, b = (it / 36) & 7, grp = it / 288;
        if (qb == 0 && !do_ctx) continue;
        const int jq = qb * 256 + tid;
        const int nkeys = qb == 0 ? 256 : NKEY;
        const int grow = grow_of(b, jq);
        if (grp == 0) {
            const bfu* Q = (const bfu*)(ws_ + WS_QA) + (((size_t)b * 4 + h) * NKEY + jq) * 64;
            const bfu* Kg = (const bfu*)(ws_ + WS_KA) + ((size_t)b * 2 + (h >> 1)) * NKEY * 64;
            const bfu* Vt = (const bfu*)(ws_ + WS_VAT) + ((size_t)b * 2 + (h >> 1)) * 64 * NKEY;
            float q[64], o[64];
#pragma unroll
            for (int d = 0; d < 64; ++d) { q[d] = bf2f(Q[d]); o[d] = 0.f; }
            float mx = -1e30f, l = 0.f;
            for (int k0 = 0; k0 < nkeys; k0 += 32) {
                __syncthreads();
                { const int kr = tid >> 3, c8 = (tid & 7) * 8; const uint4 u = *(const uint4*)(Kg + (size_t)(k0 + kr) * 64 + c8);
                  const unsigned uu[4] = {u.x, u.y, u.z, u.w};
#pragma unroll
                  for (int i = 0; i < 4; ++i) { Ks[kr * 64 + c8 + 2 * i] = __uint_as_float(uu[i] << 16); Ks[kr * 64 + c8 + 2 * i + 1] = __uint_as_float(uu[i] & 0xFFFF0000u); } }
                { const int d = tid >> 2, c8 = (tid & 3) * 8; const uint4 u = *(const uint4*)(Vt + (size_t)d * NKEY + k0 + c8);
                  const unsigned uu[4] = {u.x, u.y, u.z, u.w};
#pragma unroll
                  for (int i = 0; i < 4; ++i) { Vs[(c8 + 2 * i) * 64 + d] = __uint_as_float(uu[i] << 16); Vs[(c8 + 2 * i + 1) * 64 + d] = __uint_as_float(uu[i] & 0xFFFF0000u); } }
                __syncthreads();
                for (int kk = 0; kk < 32; ++kk) {
                    float sacc = 0.f;
#pragma unroll
                    for (int d4 = 0; d4 < 16; ++d4) { const float4 kv = *(const float4*)(Ks + kk * 64 + d4 * 4); sacc += q[d4 * 4] * kv.x + q[d4 * 4 + 1] * kv.y + q[d4 * 4 + 2] * kv.z + q[d4 * 4 + 3] * kv.w; }
                    if (sacc > mx) { const float al = exp2f(mx - sacc); l *= al;
#pragma unroll
                        for (int d = 0; d < 64; ++d) o[d] *= al;
                        mx = sacc; }
                    const float pr = exp2f(sacc - mx); l += pr;
#pragma unroll
                    for (int d4 = 0; d4 < 16; ++d4) { const float4 vv = *(const float4*)(Vs + kk * 64 + d4 * 4); o[d4 * 4] += pr * vv.x; o[d4 * 4 + 1] += pr * vv.y; o[d4 * 4 + 2] += pr * vv.z; o[d4 * 4 + 3] += pr * vv.w; }
                }
            }
            const float il = 1.f / l;
            bfu* dst = MIX + (size_t)grow * DM + h * 64;
#pragma unroll
            for (int d8 = 0; d8 < 8; ++d8)
                ((uint4*)dst)[d8] = make_uint4(pack2(o[d8 * 8] * il, o[d8 * 8 + 1] * il), pack2(o[d8 * 8 + 2] * il, o[d8 * 8 + 3] * il),
                                               pack2(o[d8 * 8 + 4] * il, o[d8 * 8 + 5] * il), pack2(o[d8 * 8 + 6] * il, o[d8 * 8 + 7] * il));
        } else {
            const bfu* Q1 = (const bfu*)(ws_ + WS_QB) + ((((size_t)b * 4 + h) * 2 + 0) * NKEY + jq) * 32;
            const bfu* Q2 = (const bfu*)(ws_ + WS_QB) + ((((size_t)b * 4 + h) * 2 + 1) * NKEY + jq) * 32;
            const bfu* K1 = (const bfu*)(ws_ + WS_KB) + (((size_t)b * 4 + h) * 2 + 0) * NKEY * 32;
            const bfu* K2 = (const bfu*)(ws_ + WS_KB) + (((size_t)b * 4 + h) * 2 + 1) * NKEY * 32;
            const bfu* Vt = (const bfu*)(ws_ + WS_VBT) + ((size_t)b * 4 + h) * 64 * NKEY;
            float q[64], o[64];
#pragma unroll
            for (int d = 0; d < 32; ++d) { q[d] = bf2f(Q1[d]); q[32 + d] = bf2f(Q2[d]); }
#pragma unroll
            for (int d = 0; d < 64; ++d) o[d] = 0.f;
            float m1 = -1e30f, l1 = 0.f, m2 = -1e30f, l2 = 0.f;
            for (int pass = 0; pass < 2; ++pass) {
                const float i1 = pass ? 1.f / l1 : 0.f, i2 = pass ? lam / l2 : 0.f;
                for (int k0 = 0; k0 < nkeys; k0 += 32) {
                    __syncthreads();
                    { const int kr = tid >> 3, mp = (tid >> 2) & 1, c8 = (tid & 3) * 8; const uint4 u = *(const uint4*)((mp ? K2 : K1) + (size_t)(k0 + kr) * 32 + c8);
                      const unsigned uu[4] = {u.x, u.y, u.z, u.w};
#pragma unroll
                      for (int i = 0; i < 4; ++i) { Ks[kr * 64 + mp * 32 + c8 + 2 * i] = __uint_as_float(uu[i] << 16); Ks[kr * 64 + mp * 32 + c8 + 2 * i + 1] = __uint_as_float(uu[i] & 0xFFFF0000u); } }
                    if (pass) { const int d = tid >> 2, c8 = (tid & 3) * 8; const uint4 u = *(const uint4*)(Vt + (size_t)d * NKEY + k0 + c8);
                      const unsigned uu[4] = {u.x, u.y, u.z, u.w};
#pragma unroll
                      for (int i = 0; i < 4; ++i) { Vs[(c8 + 2 * i) * 64 + d] = __uint_as_float(uu[i] << 16); Vs[(c8 + 2 * i + 1) * 64 + d] = __uint_as_float(uu[i] & 0xFFFF0000u); } }
                    __syncthreads();
                    for (int kk = 0; kk < 32; ++kk) {
                        float s1 = 0.f, s2 = 0.f;
#pragma unroll
                        for (int d4 = 0; d4 < 8; ++d4) { const float4 kv = *(const float4*)(Ks + kk * 64 + d4 * 4); s1 += q[d4 * 4] * kv.x + q[d4 * 4 + 1] * kv.y + q[d4 * 4 + 2] * kv.z + q[d4 * 4 + 3] * kv.w; }
#pragma unroll
                        for (int d4 = 8; d4 < 16; ++d4) { const float4 kv = *(const float4*)(Ks + kk * 64 + d4 * 4); s2 += q[d4 * 4] * kv.x + q[d4 * 4 + 1] * kv.y + q[d4 * 4 + 2] * kv.z + q[d4 * 4 + 3] * kv.w; }
                        if (!pass) {
                            if (s1 > m1) { l1 *= exp2f(m1 - s1); m1 = s1; }
                            l1 += exp2f(s1 - m1);
                            if (s2 > m2) { l2 *= exp2f(m2 - s2); m2 = s2; }
                            l2 += exp2f(s2 - m2);
                        } else {
                            const float pr = exp2f(s1 - m1) * i1 - exp2f(s2 - m2) * i2;
#pragma unroll
                            for (int d4 = 0; d4 < 16; ++d4) { const float4 vv = *(const float4*)(Vs + kk * 64 + d4 * 4); o[d4 * 4] += pr * vv.x; o[d4 * 4 + 1] += pr * vv.y; o[d4 * 4 + 2] += pr * vv.z; o[d4 * 4 + 3] += pr * vv.w; }
                        }
                    }
                }
            }
            float ss = 0.f;
#pragma unroll
            for (int d = 0; d < 64; ++d) ss += o[d] * o[d];
            const float rs = rsqrtf(ss * (1.f / 64.f) + 1e-6f) * (1.f - lam_init);
            const float* gn = p.b_subln + layer * 64;
            bfu* dst = MIX + (size_t)grow * DM + 256 + h * 64;
#pragma unroll
            for (int d8 = 0; d8 < 8; ++d8)
                ((uint4*)dst)[d8] = make_uint4(pack2(o[d8 * 8] * rs * gn[d8 * 8], o[d8 * 8 + 1] * rs * gn[d8 * 8 + 1]), pack2(o[d8 * 8 + 2] * rs * gn[d8 * 8 + 2], o[d8 * 8 + 3] * rs * gn[d8 * 8 + 3]),
                                               pack2(o[d8 * 8 + 4] * rs * gn[d8 * 8 + 4], o[d8 * 8 + 5] * rs * gn[d8 * 8 + 5]), pack2(o[d8 * 8 + 6] * rs * gn[d8 * 8 + 6], o[d8 * 8 + 7] * rs * gn[d8 * 8 + 7]));
        }
    }
}

__device__ void phase_outproj(const P& p, int layer, int nrows, int bid, int nb, char* smem) {
    PHASE_PROLOGUE
    const bfu* MIX = (const bfu*)(ws_ + WS_MIX); const bfu* W = (const bfu*)(ws_ + WS_WOUT);
    float* X = (float*)(ws_ + WS_X); const float* mod = (const float*)(ws_ + WS_MOD);
    const int nitems = (nrows / 128) * 8;
    for (int it = bid; it < nitems; it += nb) {
        const int mt = it >> 3, nt = it & 7, row0 = mt * 128, col0 = nt * 128;
        int b, j0, s; row_info(row0, b, j0, s);
        const float* ga = mod + ((size_t)layer * 9 + s) * 6144 + 2 * 1024;
        gemm_tile([&](int r) { return MIX + (size_t)(row0 + r) * DM; }, [&](int r) { return W + (size_t)(col0 + r) * DM; }, DM,
            [&](f32x4 (&acc)[4][4], int wr, int wc, int fr, int fq) {
                ACC_FOREACH({ float* xp = X + (size_t)(row0 + row) * DM + col0 + col; *xp += ga[col0 + col] * val; })
            }, smem);
    }
}

__device__ void phase_norm2_route(const P& p, int layer, int nrows, int bid, int nb, char* smem) {
    PHASE_PROLOGUE
    const float* X = (const float*)(ws_ + WS_X); bfu* H = (bfu*)(ws_ + WS_H);
    const float* mod = (const float*)(ws_ + WS_MOD); const float* WRT = (const float*)(ws_ + WS_WRT);
    int* ECNT = (int*)(ws_ + WS_ECNT) + layer * 32; int* EIDX = (int*)(ws_ + WS_EIDX); float* EGATE = (float*)(ws_ + WS_EGATE); int* ELIST = (int*)(ws_ + WS_ELIST);
    float* lg = (float*)smem;
    int* lcnt = (int*)(lg + 4 * 16 * 48);
    int* lbase = lcnt + 32;
    int* lsel = lbase + 32;
    int* lrank = lsel + 128;
    const int tid = tid_, lane = tid & 63, wv = tid >> 6, r = lane & 15, kq = lane >> 4;
    const float* gf = p.g_ffn + layer * DM;
    const float* bg = p.r_b_group + layer * 4; const float* be = p.r_b_expert + layer * 32;
    const int nitems = nrows / 64;
    for (int it = bid; it < nitems; it += nb) {
        const int row = it * 64 + wv * 16 + r;
        int b, j, s; row_info(row, b, j, s);
        const float* xr = X + (size_t)row * DM;
        const float* sh = mod + ((size_t)layer * 9 + s) * 6144 + 3 * 1024; const float* sc = sh + 1024;
        if (tid < 32) lcnt[tid] = 0;
        float ss = 0.f;
        for (int c = 0; c < 64; ++c) { const float4 v = *(const float4*)(xr + c * 16 + kq * 4); ss += v.x * v.x + v.y * v.y + v.z * v.z + v.w * v.w; }
        ss += __shfl_xor(ss, 16); ss += __shfl_xor(ss, 32);
        const float rs = rsqrtf(ss * (1.f / 1024.f) + 1e-6f);
        f32x4 acc[3];
#pragma unroll
        for (int n = 0; n < 3; ++n) acc[n] = (f32x4){0.f, 0.f, 0.f, 0.f};
        for (int c = 0; c < 64; ++c) {
            const int k = c * 16 + kq * 4;
            const float4 v = *(const float4*)(xr + k), g = *(const float4*)(gf + k), s1 = *(const float4*)(sc + k), s0 = *(const float4*)(sh + k);
            float f[4];
            f[0] = v.x * rs * g.x * (1.f + s1.x) + s0.x; f[1] = v.y * rs * g.y * (1.f + s1.y) + s0.y;
            f[2] = v.z * rs * g.z * (1.f + s1.z) + s0.z; f[3] = v.w * rs * g.w * (1.f + s1.w) + s0.w;
            *(uint2*)(H + (size_t)row * DM + k) = make_uint2(pack2(f[0], f[1]), pack2(f[2], f[3]));
#pragma unroll
            for (int n = 0; n < 3; ++n) {
                const float4 w = *(const float4*)(WRT + (size_t)(n * 16 + r) * DM + k);
                acc[n] = __builtin_amdgcn_mfma_f32_16x16x4f32(f[0], w.x, acc[n], 0, 0, 0);
                acc[n] = __builtin_amdgcn_mfma_f32_16x16x4f32(f[1], w.y, acc[n], 0, 0, 0);
                acc[n] = __builtin_amdgcn_mfma_f32_16x16x4f32(f[2], w.z, acc[n], 0, 0, 0);
                acc[n] = __builtin_amdgcn_mfma_f32_16x16x4f32(f[3], w.w, acc[n], 0, 0, 0);
            }
        }
#pragma unroll
        for (int n = 0; n < 3; ++n)
#pragma unroll
            for (int jj = 0; jj < 4; ++jj) lg[(wv * 16 + kq * 4 + jj) * 48 + n * 16 + r] = acc[n][jj];
        __syncthreads();
        if (lane < 16) {
            const float* L = lg + (wv * 16 + lane) * 48;
            const int grow = it * 64 + wv * 16 + lane;
            float gl[4]; float gm = -1e30f; int gi = 0;
#pragma unroll
            for (int g = 0; g < 4; ++g) { gl[g] = L[g] + bg[g]; if (gl[g] > gm) { gm = gl[g]; gi = g; } }
            float gs = 0.f;
#pragma unroll
            for (int g = 0; g < 4; ++g) gs += __expf(gl[g] - gm);
            const float gp = 1.f / gs;
            float v1 = -1e30f, v2 = -1e30f; int i1 = 0, i2 = 0;
            for (int e = 0; e < 8; ++e) {
                const float v = L[4 + gi * 8 + e] + be[gi * 8 + e];
                if (v > v1) { v2 = v1; i2 = i1; v1 = v; i1 = e; } else if (v > v2) { v2 = v; i2 = e; }
            }
            const float e2 = __expf(v2 - v1), den = 1.f / (1.f + e2);
            const int ex1 = gi * 8 + i1, ex2 = gi * 8 + i2;
            EIDX[grow * 2] = ex1; EIDX[grow * 2 + 1] = ex2;
            EGATE[grow * 2] = den * gp; EGATE[grow * 2 + 1] = e2 * den * gp;
            const int lr = wv * 16 + lane;
            lsel[lr * 2] = ex1; lsel[lr * 2 + 1] = ex2;
            lrank[lr * 2] = atomicAdd(&lcnt[ex1], 1); lrank[lr * 2 + 1] = atomicAdd(&lcnt[ex2], 1);
        }
        __syncthreads();
        if (tid < 32) lbase[tid] = lcnt[tid] > 0 ? atomicAdd(&ECNT[tid], lcnt[tid]) : 0;
        __syncthreads();
        if (tid < 128) { const int e = lsel[tid]; ELIST[(size_t)e * (2 * MA) + lbase[e] + lrank[tid]] = ((it * 64 + (tid >> 1)) << 1) | (tid & 1); }
        __syncthreads();
    }
}

__device__ __forceinline__ int moe_prefix(const int* ECNT, int* spre  ) {
    if (threadIdx.x == 0) { int a = 0; for (int e = 0; e < 32; ++e) { spre[e] = a; a += (ECNT[e] + 127) >> 7; } spre[32] = a; }
    __syncthreads();
    return spre[32];
}
__device__ void phase_expert1(const P& p, int layer, int bid, int nb, char* smem) {
    PHASE_PROLOGUE
    const bfu* H = (const bfu*)(ws_ + WS_H); const bfu* W1 = (const bfu*)(ws_ + WS_W1); const bfu* W3 = (const bfu*)(ws_ + WS_W3);
    bfu* HB = (bfu*)(ws_ + WS_HB);
    const int* ECNT = (const int*)(ws_ + WS_ECNT) + layer * 32; const int* ELIST = (const int*)(ws_ + WS_ELIST);
    int* spre = (int*)(smem + 65536);
    const int nblk = moe_prefix(ECNT, spre);
    const int nitems = nblk * 8;
    for (int it = bid; it < nitems; it += nb) {
        const int blk = it >> 3, nt = it & 7;
        int e = 0;
        while (spre[e + 1] <= blk) ++e;
        const int rb = blk - spre[e], cnt = ECNT[e];
        const int* lst = ELIST + (size_t)e * (2 * MA) + rb * 128;
        const int nvalid = min(128, cnt - rb * 128);
        const bfu* w1 = W1 + (size_t)e * FF * DM; const bfu* w3 = W3 + (size_t)e * FF * DM;
        bfu* hb = HB + (size_t)blk * 128 * FF;
        gemm_tile([&](int r) { const int tok = r < nvalid ? (lst[r] >> 1) : 0; return H + (size_t)tok * DM; },
                  [&](int r) { const int wcx = r >> 6, n4 = (r >> 4) & 3, rr = r & 15; const int hc = nt * 64 + wcx * 32 + (n4 & 1) * 16 + rr; return (n4 < 2 ? w1 : w3) + (size_t)hc * DM; }, DM,
            [&](f32x4 (&acc)[4][4], int wr, int wc, int fr, int fq) {
#pragma unroll
                for (int m = 0; m < 4; ++m)
#pragma unroll
                    for (int n = 0; n < 2; ++n)
#pragma unroll
                        for (int jj = 0; jj < 4; ++jj) {
                            const int row = wr * 64 + m * 16 + fq * 4 + jj; const int hc = nt * 64 + wc * 32 + n * 16 + fr;
                            const float a = acc[m][n][jj], g = acc[m][n + 2][jj];
                            hb[(size_t)row * FF + hc] = f2bf(siluf_(a) * g);
                        }
            }, smem);
    }
}
__device__ void phase_expert2(const P& p, int layer, int bid, int nb, char* smem) {
    PHASE_PROLOGUE
    const bfu* HB = (const bfu*)(ws_ + WS_HB); const bfu* W2 = (const bfu*)(ws_ + WS_W2);
    float* Y = (float*)(ws_ + WS_Y01);
    const int* ECNT = (const int*)(ws_ + WS_ECNT) + layer * 32; const int* ELIST = (const int*)(ws_ + WS_ELIST); const float* EGATE = (const float*)(ws_ + WS_EGATE);
    int* spre = (int*)(smem + 65536);
    const int nblk = moe_prefix(ECNT, spre);
    const int nitems = nblk * 8;
    for (int it = bid; it < nitems; it += nb) {
        const int blk = it >> 3, nt = it & 7;
        int e = 0;
        while (spre[e + 1] <= blk) ++e;
        const int rb = blk - spre[e], cnt = ECNT[e];
        const int* lst = ELIST + (size_t)e * (2 * MA) + rb * 128;
        const int nvalid = min(128, cnt - rb * 128);
        const bfu* w2 = W2 + (size_t)e * DM * FF;
        const bfu* hb = HB + (size_t)blk * 128 * FF;
        gemm_tile([&](int r) { return hb + (size_t)r * FF; }, [&](int r) { return w2 + (size_t)(nt * 128 + r) * FF; }, FF,
            [&](f32x4 (&acc)[4][4], int wr, int wc, int fr, int fq) {
#pragma unroll
                for (int m = 0; m < 4; ++m)
#pragma unroll
                    for (int jj = 0; jj < 4; ++jj) {
                        const int row = wr * 64 + m * 16 + fq * 4 + jj;
                        if (row < nvalid) {
                            const int ent = lst[row]; const float gt = EGATE[ent];
                            float* yp = Y + ((size_t)(ent & 1) * MA + (ent >> 1)) * DM + nt * 128 + wc * 64 + fr;
#pragma unroll
                            for (int n = 0; n < 4; ++n) yp[n * 16] = gt * acc[m][n][jj];
                        }
                    }
            }, smem);
    }
}

#define XB_TMO      128
#define XB_XCNT(j)  (256  + 64 * (j))
#define XB_XSUB(j)  (1280 + 64 * (j))
#define XB_XGEN(j)  (2304 + 64 * (j))
#define XB_TOP      3328
#define XB_TOPGEN   3392
#define XCD_BAR_WORDS 3456
#define XB_SPIN_CAP (1u << 22)
#define LAS __attribute__((address_space(3)))

__device__ __forceinline__ unsigned xb_ld(unsigned* p)              { return __hip_atomic_load(p, __ATOMIC_RELAXED, __HIP_MEMORY_SCOPE_AGENT); }
__device__ __forceinline__ unsigned xb_add(unsigned* p, unsigned v) { return __hip_atomic_fetch_add(p, v, __ATOMIC_RELAXED, __HIP_MEMORY_SCOPE_AGENT); }
__device__ __forceinline__ unsigned xb_xcc_id() { return (unsigned)__builtin_amdgcn_s_getreg((3 << 11) | 20) & 0xFu; }
#define XB_SPIN(cond, bar) do { unsigned _sp = 0; while (cond) { __builtin_amdgcn_s_sleep(1); \
    if ((++_sp & 255u) == 0u) { if (xb_ld(&(bar)[XB_TMO])) break; if (_sp > XB_SPIN_CAP) { atomicAdd(&(bar)[XB_TMO], 1u); break; } } } } while (0)

struct XcdBarrier {
    unsigned* bar; unsigned x;
    volatile LAS unsigned* st;
};

__device__ __forceinline__ XcdBarrier xcd_barrier_post(unsigned* bar, volatile LAS unsigned* st) {
    XcdBarrier b; b.bar = bar; b.x = xb_xcc_id(); b.st = st;
    if (threadIdx.x == 0) (void)xb_add(&bar[XB_XCNT(b.x)], 1u);
    return b;
}
__device__ __forceinline__ void xcd_barrier_complete(unsigned* bar, unsigned x, unsigned& nloc, unsigned& nx) {
    const unsigned G = gridDim.x * gridDim.y * gridDim.z;
    unsigned sum, cnt, mine, sp = 0u;
    for (;;) {
        sum = 0u; cnt = 0u; mine = 0u;
#pragma unroll
        for (unsigned j = 0; j < 16; ++j) { const unsigned c = xb_ld(&bar[XB_XCNT(j)]); sum += c; cnt += (c > 0u) ? 1u : 0u; mine = (j == x) ? c : mine; }
        if (sum == G) break;
        __builtin_amdgcn_s_sleep(1);
        if ((++sp & 255u) == 0u) { if (xb_ld(&bar[XB_TMO])) break; if (sp > XB_SPIN_CAP) { atomicAdd(&bar[XB_TMO], 1u); break; } }
    }
    nloc = mine > 0u ? mine : 1u; nx = cnt > 0u ? cnt : 1u;
}

__device__ __forceinline__ void xcd_barrier(const XcdBarrier& b) {
    asm volatile("s_waitcnt vmcnt(0)" ::: "memory");
    __syncthreads();
    if (threadIdx.x == 0) {
        unsigned* bar = b.bar;
        __builtin_amdgcn_s_waitcnt(0);
        unsigned nloc = b.st[0], nx = b.st[1];
        if (nloc == 0u) { xcd_barrier_complete(bar, b.x, nloc, nx); b.st[0] = nloc; b.st[1] = nx; }
        const unsigned old = xb_add(&bar[XB_XSUB(b.x)], 1u);
        const unsigned gen = old / nloc;
        if (old + 1u == (gen + 1u) * nloc) {
            __builtin_amdgcn_fence(__ATOMIC_RELEASE, "agent");
            asm volatile("s_waitcnt vmcnt(0)" ::: "memory");
            const unsigned og = xb_add(&bar[XB_TOP], 1u);
            const unsigned tg = og / nx;
            if (og + 1u == (tg + 1u) * nx) xb_add(&bar[XB_TOPGEN], 1u);
            else XB_SPIN(xb_ld(&bar[XB_TOPGEN]) == tg, bar);
            __builtin_amdgcn_fence(__ATOMIC_ACQUIRE, "agent");
            xb_add(&bar[XB_XGEN(b.x)], 1u);
            asm volatile("s_waitcnt vmcnt(0)" ::: "memory");
        } else {
            XB_SPIN(xb_ld(&bar[XB_XGEN(b.x)]) == gen, bar);
            __builtin_amdgcn_fence(__ATOMIC_ACQUIRE, "agent");
            asm volatile("s_waitcnt vmcnt(0)" ::: "memory");
        }
    }
    __syncthreads();
}


#define CTL_Q(l) (4096 + 64 * (l))
__global__ void __launch_bounds__(256, 2) fwd(P p) {
    __shared__ __attribute__((aligned(16))) char smem[SMEM_BYTES];
    __shared__ uint4 xb_words;
    __shared__ int s_item;
    if (threadIdx.x == 0) xb_words = make_uint4(0u, 0u, 0u, 0u);
    __syncthreads();
    unsigned* ctl = (unsigned*)(p.ws + WS_CTL);
    XcdBarrier bar = xcd_barrier_post(ctl, (volatile LAS unsigned*)&xb_words);
    const int bid = blockIdx.x, nb = gridDim.x;
    phase_setup(p, bid, nb);
    phase_mod(p, bid, nb, smem);
    for (int l = 0; l < NLAYER; ++l) {
        const int nr = l < NLAYER - 1 ? MA : ML;
        phase_conv(p, l, bid, nb, smem);
        if (l == 0) xcd_barrier(bar);
        phase_norm1(p, l, 0, bid, nb);
        xcd_barrier(bar);
        phase_inproj(p, l, bid, nb, smem);
        xcd_barrier(bar);
        phase_rwkv_prep(p, l, bid, nb);
        xcd_barrier(bar);
        phase_rwkv_lora(p, l, bid, nb, smem);
        xcd_barrier(bar);
        if (bid < 256) phase_scan(p, l, bid, 256, smem);
        phase_attn_naive(p, l, l < NLAYER - 1, ctl + CTL_Q(l), &s_item, smem);
        xcd_barrier(bar);
        phase_readout(p, l, nr, bid, nb);
        xcd_barrier(bar);
        phase_outproj(p, l, nr, bid, nb, smem);
        xcd_barrier(bar);
        phase_norm2_route(p, l, nr, bid, nb, smem);
        xcd_barrier(bar);
        phase_expert1(p, l, bid, nb, smem);
        xcd_barrier(bar);
        phase_expert2(p, l, bid, nb, smem);
        xcd_barrier(bar);
    }
    phase_norm1(p, NLAYER, 1, bid, nb);
}

extern "C" void kernel_launch(void* const* d_in, const int* in_sizes, int n_in, void* d_out, int out_size, void* d_ws, size_t ws_size, hipStream_t stream) {
    if (n_in != 36 || ws_size < WS_END) { fprintf(stderr, "kernel_launch: unexpected n_in %d or ws_size %zu < %zu\n", n_in, ws_size, (size_t)WS_END); return; }
    static int grid = 0;
    if (!grid) {
        int dev = 0, cus = 0, per_cu = 0;
        hipGetDevice(&dev);
        hipDeviceGetAttribute(&cus, hipDeviceAttributeMultiprocessorCount, dev);
        hipOccupancyMaxActiveBlocksPerMultiprocessor(&per_cu, (const void*)fwd, 256, 0);
        if (per_cu < 1) per_cu = 1;
        grid = cus * (per_cu < 2 ? per_cu : 2);
    }
    P p{};
    const float** pp = (const float**)&p;
    for (int i = 0; i < 36; ++i) pp[i] = (const float*)d_in[i];
    p.out = (float*)d_out; p.ws = (char*)d_ws;
    hipMemsetAsync((char*)d_ws + WS_CTL, 0, 65536, stream);
    fwd<<<grid, 256, 0, stream>>>(p);
}
```

```cpp
#include <hip/hip_runtime.h>
#include <stdint.h>
#include <stdio.h>

typedef unsigned short bfu;
using bf16x8 = __attribute__((ext_vector_type(8))) short;
using f32x4  = __attribute__((ext_vector_type(4))) float;

#define DM 1024
#define NB 8
#define SEQ 2048
#define CL 256
#define NKEY 2304
#define ML 16384
#define MC 2048
#define MA 18432
#define INW 3200
#define CSL 1920
#define NEXP 32
#define FF 512
#define NLAYER 4
#define LOG2E 1.4426950408889634f

#define MBy(x) ((size_t)(x) << 20)
constexpr size_t WS_CTL   = 0;
constexpr size_t WS_MOD   = 65536;
constexpr size_t WS_ROPE  = WS_MOD + (size_t)4 * 9 * 6144 * 4;
constexpr size_t WS_ECNT  = WS_ROPE + 64 * 16 * 2 * 4 + 64 * 8 * 2 * 4;
constexpr size_t WS_WRT   = WS_ECNT + 4096;
constexpr size_t WS_EIDX  = WS_WRT + (size_t)48 * 1024 * 4;
constexpr size_t WS_EGATE = WS_EIDX + (size_t)MA * 2 * 4;
constexpr size_t WS_ELIST = WS_EGATE + (size_t)MA * 2 * 4;
constexpr size_t WS_X     = MBy(8);
constexpr size_t WS_H     = WS_X + (size_t)MA * DM * 4;
constexpr size_t WS_WIN   = WS_H + (size_t)MA * DM * 2;
constexpr size_t WS_WOUT  = WS_WIN + (size_t)INW * DM * 2;
constexpr size_t WS_W1    = WS_WOUT + (size_t)DM * DM * 2;
constexpr size_t WS_W3    = WS_W1 + (size_t)NEXP * FF * DM * 2;
constexpr size_t WS_W2    = WS_W3 + (size_t)NEXP * FF * DM * 2;
constexpr size_t WS_LW2   = WS_W2 + (size_t)NEXP * FF * DM * 2;
constexpr size_t WS_LA2   = WS_LW2 + (size_t)2 * 512 * 64 * 2;
constexpr size_t WS_LG2   = WS_LA2 + (size_t)2 * 512 * 64 * 2;
constexpr size_t WS_QA    = WS_LG2 + (size_t)512 * 128 * 2;
constexpr size_t WS_KA    = WS_QA + (size_t)NB * 4 * NKEY * 64 * 2;
constexpr size_t WS_VAT   = WS_KA + (size_t)NB * 2 * NKEY * 64 * 2;
constexpr size_t WS_QB    = WS_VAT + (size_t)NB * 2 * NKEY * 64 * 2;
constexpr size_t WS_KB    = WS_QB + (size_t)NB * 4 * NKEY * 64 * 2;
constexpr size_t WS_VBT   = WS_KB + (size_t)NB * 4 * NKEY * 64 * 2;
constexpr size_t WS_CP    = WS_VBT + (size_t)NB * 4 * NKEY * 64 * 2;
constexpr size_t WS_LX    = WS_CP + (size_t)MA * CSL * 4;
constexpr size_t WS_GG    = WS_LX + (size_t)MA * 384 * 2;
constexpr size_t WS_MIX   = WS_GG + (size_t)MA * 512 * 4;
constexpr size_t HEADARR  = (size_t)NB * 8 * NKEY * 64 * 4;
constexpr size_t WS_RR    = WS_MIX + (size_t)MA * DM * 2;
constexpr size_t WS_VV    = WS_RR + HEADARR;
constexpr size_t WS_KK    = WS_VV + HEADARR;
constexpr size_t WS_YS    = WS_KK + HEADARR;
constexpr size_t WS_WW    = WS_YS + 2 * HEADARR;
constexpr size_t WS_KD    = WS_WW + 2 * HEADARR;
constexpr size_t WS_BB    = WS_KD + 2 * HEADARR;
constexpr size_t WS_END   = WS_BB + 2 * HEADARR;
constexpr size_t WS_Y01   = WS_WW;
constexpr size_t WS_HB    = WS_RR;

struct P {
    const float *x, *c, *ctx, *c_ctx, *w_mod, *b_mod, *g_mix, *g_ffn, *w_in, *a_q_gain, *a_k_gain, *b_lq1, *b_lk1, *b_lq2, *b_lk2, *b_subln,
        *c_mu, *c_w0, *c_w2, *c_a0, *c_a2, *c_g2, *c_k_k, *c_k_a, *c_r_k, *c_ln_w, *c_ln_b, *w_out, *r_w_group, *r_b_group, *r_w_expert, *r_b_expert,
        *e_w1, *e_w3, *e_w2, *g_final;
    float* out;
    char* ws;
};

__device__ __forceinline__ float bf2f(bfu b) { return __uint_as_float((unsigned)b << 16); }
__device__ __forceinline__ unsigned pack2(float a, float b) {
    typedef float f2 __attribute__((ext_vector_type(2)));
    typedef __bf16 b2 __attribute__((ext_vector_type(2)));
    f2 v = {a, b}; b2 r = __builtin_convertvector(v, b2); return __builtin_bit_cast(unsigned, r);
}
__device__ __forceinline__ bfu f2bf(float a) { return (bfu)(pack2(a, 0.f) & 0xFFFFu); }
__device__ __forceinline__ float wave_sum(float v) {
#pragma unroll
    for (int o = 32; o >= 1; o >>= 1) v += __shfl_xor(v, o);
    return v;
}
__device__ __forceinline__ float sigmoidf_(float x) { return 1.f / (1.f + __expf(-x)); }
__device__ __forceinline__ float siluf_(float x) { return x / (1.f + __expf(-x)); }
__device__ __forceinline__ void row_info(int grow, int& b, int& j, int& s) {
    if (grow < ML) { b = grow >> 11; j = 256 + (grow & 2047); s = b; }
    else { int r = grow - ML; b = r >> 8; j = r & 255; s = 8; }
}
__device__ __forceinline__ int grow_of(int b, int j) { return j < 256 ? ML + b * 256 + j : b * 2048 + (j - 256); }

#define SMEM_BYTES 69632

#define PHASE_PROLOGUE int tid_ = threadIdx.x; asm volatile("" : "+v"(tid_)); char* ws_ = p.ws; asm volatile("" : "+s"(ws_));

__device__ void phase_setup(const P& p, int bid, int nb) {
    PHASE_PROLOGUE
    float4* X4 = (float4*)(ws_ + WS_X);
    const float4* x4 = (const float4*)p.x; const float4* c4 = (const float4*)p.ctx;
    const size_t nl = (size_t)ML * DM / 4, nc = (size_t)MC * DM / 4;
    for (size_t i = (size_t)bid * 256 + tid_; i < nl + nc; i += (size_t)nb * 256) X4[i] = i < nl ? x4[i] : c4[i - nl];
    if (bid == 0) {
        float* TA = (float*)(ws_ + WS_ROPE); float* TB = TA + 64 * 16 * 2;
        for (int i = tid_; i < 64 * 16; i += 256) { int pos = i >> 4, f = i & 15; double inv = pow(10000.0, -(double)f / 16.0); double a = (double)pos * inv; TA[i * 2] = (float)cos(a); TA[i * 2 + 1] = (float)sin(a); }
        for (int i = tid_; i < 64 * 8; i += 256) { int pos = i >> 3, f = i & 7; double inv = pow(10000.0, -(double)f / 8.0); double a = (double)pos * inv; TB[i * 2] = (float)cos(a); TB[i * 2 + 1] = (float)sin(a); }
        int* ec = (int*)(ws_ + WS_ECNT);
        for (int i = tid_; i < 128; i += 256) ec[i] = 0;
    }
}

__device__ void phase_mod(const P& p, int bid, int nb, char* smem) {
    PHASE_PROLOGUE
    float* act = (float*)smem;
    float* red = act + 9 * 1024;
    for (int i = tid_; i < 9 * 1024; i += 256) { float v = i < 8 * 1024 ? p.c[i] : p.c_ctx[i - 8 * 1024]; act[i] = siluf_(v); }
    __syncthreads();
    float* mod = (float*)(ws_ + WS_MOD);
    const int nitems = 4 * 6144 / 64;
    const int cl = tid_ & 63, kq = tid_ >> 6;
    for (int it = bid; it < nitems; it += nb) {
        const int layer = it / 96, n = (it % 96) * 64 + cl;
        const float* w = p.w_mod + (size_t)layer * DM * 6144 + n;
        float a[9];
#pragma unroll
        for (int s = 0; s < 9; ++s) a[s] = 0.f;
        for (int k = kq * 256; k < kq * 256 + 256; ++k) {
            const float wv = w[(size_t)k * 6144];
#pragma unroll
            for (int s = 0; s < 9; ++s) a[s] += act[s * 1024 + k] * wv;
        }
#pragma unroll
        for (int s = 0; s < 9; ++s) red[(kq * 9 + s) * 64 + cl] = a[s];
        __syncthreads();
        for (int i = tid_; i < 9 * 64; i += 256) {
            const int s = i >> 6, c2 = i & 63, n2 = (it % 96) * 64 + c2;
            float v = red[(0 * 9 + s) * 64 + c2] + red[(1 * 9 + s) * 64 + c2] + red[(2 * 9 + s) * 64 + c2] + red[(3 * 9 + s) * 64 + c2];
            mod[((size_t)layer * 9 + s) * 6144 + n2] = v + p.b_mod[layer * 6144 + n2];
        }
        __syncthreads();
    }
}

__device__ __forceinline__ void conv_tile(const float* src, int K, int N, bfu* dst, int k0, int n0, float* ts, int tid_) {
    const int t = tid_;
    {
        const int kk = t >> 4, n4 = (t & 15) * 4;
#pragma unroll
        for (int pz = 0; pz < 4; ++pz) {
            const float4 v = *(const float4*)(src + (size_t)(k0 + kk + 16 * pz) * N + n0 + n4);
            float* d = ts + (kk + 16 * pz) * 65 + n4; d[0] = v.x; d[1] = v.y; d[2] = v.z; d[3] = v.w;
        }
    }
    __syncthreads();
    {
        const int n = t >> 2, kc = (t & 3) * 16;
        unsigned o[8];
#pragma unroll
        for (int i = 0; i < 8; ++i) o[i] = pack2(ts[(kc + 2 * i) * 65 + n], ts[(kc + 2 * i + 1) * 65 + n]);
        uint4* d = (uint4*)(dst + (size_t)(n0 + n) * K + k0 + kc);
        d[0] = make_uint4(o[0], o[1], o[2], o[3]); d[1] = make_uint4(o[4], o[5], o[6], o[7]);
    }
    __syncthreads();
}
__device__ void phase_conv(const P& p, int layer, int bid, int nb, char* smem) {
    PHASE_PROLOGUE
    float* ts = (float*)smem;
    const float* srcs[8]; bfu* dsts[8]; int Ks[8], Ns[8], Bs[8];
    char* ws = ws_;
    srcs[0] = p.w_in + (size_t)layer * DM * INW;  Ks[0] = DM; Ns[0] = INW; Bs[0] = 1;  dsts[0] = (bfu*)(ws + WS_WIN);
    srcs[1] = p.w_out + (size_t)layer * DM * DM;  Ks[1] = DM; Ns[1] = DM;  Bs[1] = 1;  dsts[1] = (bfu*)(ws + WS_WOUT);
    srcs[2] = p.e_w1 + (size_t)layer * NEXP * DM * FF; Ks[2] = DM; Ns[2] = FF; Bs[2] = NEXP; dsts[2] = (bfu*)(ws + WS_W1);
    srcs[3] = p.e_w3 + (size_t)layer * NEXP * DM * FF; Ks[3] = DM; Ns[3] = FF; Bs[3] = NEXP; dsts[3] = (bfu*)(ws + WS_W3);
    srcs[4] = p.e_w2 + (size_t)layer * NEXP * FF * DM; Ks[4] = FF; Ns[4] = DM; Bs[4] = NEXP; dsts[4] = (bfu*)(ws + WS_W2);
    srcs[5] = p.c_w2 + (size_t)layer * 2 * 64 * 512;   Ks[5] = 64; Ns[5] = 512; Bs[5] = 2;   dsts[5] = (bfu*)(ws + WS_LW2);
    srcs[6] = p.c_a2 + (size_t)layer * 2 * 64 * 512;   Ks[6] = 64; Ns[6] = 512; Bs[6] = 2;   dsts[6] = (bfu*)(ws + WS_LA2);
    srcs[7] = p.c_g2 + (size_t)layer * 128 * 512;      Ks[7] = 128; Ns[7] = 512; Bs[7] = 1;  dsts[7] = (bfu*)(ws + WS_LG2);
    int start = 0;
#pragma unroll
    for (int jb = 0; jb < 8; ++jb) {
        const int tk = Ks[jb] / 64, tn = Ns[jb] / 64, per = tk * tn, tot = per * Bs[jb];
        int first = bid - (start % nb); if (first < 0) first += nb;
        for (int it = first; it < tot; it += nb) {
            const int bt = it / per, r = it % per, kt = r / tn, nt = r % tn;
            conv_tile(srcs[jb] + (size_t)bt * Ks[jb] * Ns[jb], Ks[jb], Ns[jb], dsts[jb] + (size_t)bt * Ks[jb] * Ns[jb], kt * 64, nt * 64, ts, tid_);
        }
        start += tot;
    }
    float* wrt = (float*)(ws + WS_WRT);
    const float* wg = p.r_w_group + (size_t)layer * DM * 4; const float* we = p.r_w_expert + (size_t)layer * DM * 32;
    for (int i = bid * 256 + tid_; i < 48 * 1024; i += nb * 256) {
        const int r = i >> 10, k = i & 1023;
        wrt[i] = r < 4 ? wg[k * 4 + r] : (r < 36 ? we[k * 32 + (r - 4)] : 0.f);
    }
}

__device__ void phase_norm1(const P& p, int layer, int mode, int bid, int nb) {
    PHASE_PROLOGUE
    float* X = (float*)(ws_ + WS_X); bfu* H = (bfu*)(ws_ + WS_H);
    const float* Y0 = (const float*)(ws_ + WS_Y01); const float* Y1 = Y0 + (size_t)MA * DM;
    const float* mod = (const float*)(ws_ + WS_MOD);
    const int lane = tid_ & 63, wv = tid_ >> 6;
    const int nrows = mode ? ML : MA;
    if (bid == 0 && mode == 0 && tid_ < 32) ((int*)(ws_ + WS_ECNT))[layer * 32 + tid_] = 0;
    for (int row = bid * 4 + wv; row < nrows; row += nb * 4) {
        int b, j, s; row_info(row, b, j, s);
        float4 v[4];
        float ss = 0.f;
#pragma unroll
        for (int c = 0; c < 4; ++c) {
            const int col = c * 256 + lane * 4;
            float4 xv = *(const float4*)(X + (size_t)row * DM + col);
            if (layer > 0) {
                const float4 a = *(const float4*)(Y0 + (size_t)row * DM + col), bq = *(const float4*)(Y1 + (size_t)row * DM + col);
                const float4 g = *(const float4*)(mod + ((size_t)(layer - 1) * 9 + s) * 6144 + 5 * 1024 + col);
                xv.x += g.x * (a.x + bq.x); xv.y += g.y * (a.y + bq.y); xv.z += g.z * (a.z + bq.z); xv.w += g.w * (a.w + bq.w);
                if (!mode) *(float4*)(X + (size_t)row * DM + col) = xv;
            }
            v[c] = xv; ss += xv.x * xv.x + xv.y * xv.y + xv.z * xv.z + xv.w * xv.w;
        }
        ss = wave_sum(ss);
        const float rs = rsqrtf(ss * (1.f / 1024.f) + 1e-6f);
#pragma unroll
        for (int c = 0; c < 4; ++c) {
            const int col = c * 256 + lane * 4;
            if (mode) {
                const float4 g = *(const float4*)(p.g_final + col);
                float4 o; o.x = v[c].x * rs * g.x; o.y = v[c].y * rs * g.y; o.z = v[c].z * rs * g.z; o.w = v[c].w * rs * g.w;
                *(float4*)(p.out + (size_t)row * DM + col) = o;
            } else {
                const float4 g = *(const float4*)(p.g_mix + layer * DM + col);
                const float4 sh = *(const float4*)(mod + ((size_t)layer * 9 + s) * 6144 + 0 * 1024 + col);
                const float4 sc = *(const float4*)(mod + ((size_t)layer * 9 + s) * 6144 + 1 * 1024 + col);
                const float o0 = v[c].x * rs * g.x * (1.f + sc.x) + sh.x, o1 = v[c].y * rs * g.y * (1.f + sc.y) + sh.y;
                const float o2 = v[c].z * rs * g.z * (1.f + sc.z) + sh.z, o3 = v[c].w * rs * g.w * (1.f + sc.w) + sh.w;
                *(uint2*)(H + (size_t)row * DM + col) = make_uint2(pack2(o0, o1), pack2(o2, o3));
            }
        }
    }
}

template <class FA, class FB, class FE>
__device__ __forceinline__ void gemm_tile(FA arow, FB brow, int K, FE epi, char* smem) {
    bfu* sA = (bfu*)smem; bfu* sB = sA + 2 * 4096;
    int tid = threadIdx.x; asm volatile("" : "+v"(tid));
    const int lane = tid & 63, wid = tid >> 6, wr = wid >> 1, wc = wid & 1, fr = lane & 15, fq = lane >> 4;
    const int lr = tid >> 2, lc = tid & 3;
    const bfu* pa0 = arow(lr) + lc * 8; const bfu* pa1 = arow(lr + 64) + lc * 8;
    const bfu* pb0 = brow(lr) + lc * 8; const bfu* pb1 = brow(lr + 64) + lc * 8;
    f32x4 acc[4][4];
#pragma unroll
    for (int m = 0; m < 4; ++m)
#pragma unroll
        for (int n = 0; n < 4; ++n) acc[m][n] = (f32x4){0.f, 0.f, 0.f, 0.f};
    uint4 ra0 = *(const uint4*)pa0, ra1 = *(const uint4*)pa1, rb0 = *(const uint4*)pb0, rb1 = *(const uint4*)pb1;
    const int so = lr * 32 + lc * 8;
    __syncthreads();
    *(uint4*)(sA + so) = ra0; *(uint4*)(sA + so + 64 * 32) = ra1; *(uint4*)(sB + so) = rb0; *(uint4*)(sB + so + 64 * 32) = rb1;
    __syncthreads();
    const int nk = K >> 5;
    for (int kt = 0; kt < nk; ++kt) {
        if (kt + 1 < nk) {
            const int ko = (kt + 1) * 32;
            ra0 = *(const uint4*)(pa0 + ko); ra1 = *(const uint4*)(pa1 + ko); rb0 = *(const uint4*)(pb0 + ko); rb1 = *(const uint4*)(pb1 + ko);
        }
        const bfu* cA = sA + (kt & 1) * 4096; const bfu* cB = sB + (kt & 1) * 4096;
        bf16x8 af[4], bfr[4];
#pragma unroll
        for (int m = 0; m < 4; ++m) af[m] = *(const bf16x8*)(cA + (wr * 64 + m * 16 + fr) * 32 + fq * 8);
#pragma unroll
        for (int n = 0; n < 4; ++n) bfr[n] = *(const bf16x8*)(cB + (wc * 64 + n * 16 + fr) * 32 + fq * 8);
#pragma unroll
        for (int m = 0; m < 4; ++m)
#pragma unroll
            for (int n = 0; n < 4; ++n) acc[m][n] = __builtin_amdgcn_mfma_f32_16x16x32_bf16(af[m], bfr[n], acc[m][n], 0, 0, 0);
        if (kt + 1 < nk) {
            bfu* nA = sA + ((kt + 1) & 1) * 4096; bfu* nB = sB + ((kt + 1) & 1) * 4096;
            *(uint4*)(nA + so) = ra0; *(uint4*)(nA + so + 64 * 32) = ra1; *(uint4*)(nB + so) = rb0; *(uint4*)(nB + so + 64 * 32) = rb1;
        }
        __syncthreads();
    }
    epi(acc, wr, wc, fr, fq);
}
#define ACC_FOREACH(...)                                                                      \
    _Pragma("unroll") for (int m_ = 0; m_ < 4; ++m_) _Pragma("unroll") for (int n_ = 0; n_ < 4; ++n_) \
    _Pragma("unroll") for (int j_ = 0; j_ < 4; ++j_) {                                        \
        const int row = wr * 64 + m_ * 16 + fq * 4 + j_; const int col = wc * 64 + n_ * 16 + fr; const float val = acc[m_][n_][j_]; __VA_ARGS__ }

__device__ void phase_inproj(const P& p, int layer, int bid, int nb, char* smem) {
    PHASE_PROLOGUE
    const bfu* H = (const bfu*)(ws_ + WS_H); const bfu* W = (const bfu*)(ws_ + WS_WIN);
    float* Cs = (float*)smem;
    const float* TA = (const float*)(ws_ + WS_ROPE); const float* TB = TA + 64 * 16 * 2;
    const int nitems = 144 * 25;
    for (int it = bid; it < nitems; it += nb) {
        const int mt = it / 25, nt = it % 25;
        const int row0 = mt * 128, col0 = nt * 128;
        gemm_tile([&](int r) { return H + (size_t)(row0 + r) * DM; }, [&](int r) { return W + (size_t)(col0 + r) * DM; }, DM,
            [&](f32x4 (&acc)[4][4], int wr, int wc, int fr, int fq) {
                ACC_FOREACH(Cs[row * 132 + col] = val;)
            }, smem);
        __syncthreads();
        const int tid = tid_;
        int b, j0, s; row_info(row0, b, j0, s);
        const bool lat = row0 < ML;
        if (nt <= 2) {
            const int r = tid & 127, hl = tid >> 7;
            const bool isq = nt < 2;
            const float* gain = (isq ? p.a_q_gain : p.a_k_gain) + layer * 64;
            float v[64]; float ss = 0.f;
#pragma unroll
            for (int d4 = 0; d4 < 16; ++d4) { const float4 t4 = *(const float4*)(Cs + r * 132 + hl * 64 + d4 * 4); v[d4 * 4] = t4.x; v[d4 * 4 + 1] = t4.y; v[d4 * 4 + 2] = t4.z; v[d4 * 4 + 3] = t4.w; ss += t4.x * t4.x + t4.y * t4.y + t4.z * t4.z + t4.w * t4.w; }
            const float rs = rsqrtf(ss * (1.f / 64.f) + 1e-6f);
#pragma unroll
            for (int d = 0; d < 64; ++d) v[d] = v[d] * rs * gain[d];
            if (lat) {
                const int t = (j0 - 256) + r;
#pragma unroll
                for (int a = 0; a < 2; ++a) {
                    const int pos = a == 0 ? (t >> 6) : (t & 63);
#pragma unroll
                    for (int f = 0; f < 16; ++f) {
                        const float cs = TA[(pos * 16 + f) * 2], sn = TA[(pos * 16 + f) * 2 + 1];
                        const float x0 = v[a * 32 + f], x1 = v[a * 32 + 16 + f];
                        v[a * 32 + f] = x0 * cs - x1 * sn; v[a * 32 + 16 + f] = x1 * cs + x0 * sn;
                    }
                }
            }
            const float qs = isq ? 0.125f * LOG2E : 1.f;
            bfu* dst = isq ? (bfu*)(ws_ + WS_QA) + (((size_t)b * 4 + (nt * 2 + hl)) * NKEY + j0 + r) * 64
                           : (bfu*)(ws_ + WS_KA) + (((size_t)b * 2 + hl) * NKEY + j0 + r) * 64;
#pragma unroll
            for (int d8 = 0; d8 < 8; ++d8)
                ((uint4*)dst)[d8] = make_uint4(pack2(v[d8 * 8] * qs, v[d8 * 8 + 1] * qs), pack2(v[d8 * 8 + 2] * qs, v[d8 * 8 + 3] * qs),
                                               pack2(v[d8 * 8 + 4] * qs, v[d8 * 8 + 5] * qs), pack2(v[d8 * 8 + 6] * qs, v[d8 * 8 + 7] * qs));
        } else if (nt == 3 || nt == 8 || nt == 9) {
            const int c = tid & 127, half = tid >> 7, hl = c >> 6, d = c & 63;
            bfu* dst = nt == 3 ? (bfu*)(ws_ + WS_VAT) + (((size_t)b * 2 + hl) * 64 + d) * NKEY + j0 + half * 64
                               : (bfu*)(ws_ + WS_VBT) + (((size_t)b * 4 + ((nt - 8) * 2 + hl)) * 64 + d) * NKEY + j0 + half * 64;
#pragma unroll
            for (int r8 = 0; r8 < 8; ++r8) {
                const float* s0 = Cs + (half * 64 + r8 * 8) * 132 + c;
                ((uint4*)dst)[r8] = make_uint4(pack2(s0[0], s0[132]), pack2(s0[2 * 132], s0[3 * 132]), pack2(s0[4 * 132], s0[5 * 132]), pack2(s0[6 * 132], s0[7 * 132]));
            }
        } else if (nt <= 7) {
            const bool isq = nt < 6;
            const int hbase = ((nt - 4) & 1) * 2;
#pragma unroll
            for (int itq = 0; itq < 2; ++itq) {
                const int u = tid + 256 * itq, r = u & 127, hm = u >> 7;
                float v[32];
#pragma unroll
                for (int d4 = 0; d4 < 8; ++d4) { const float4 t4 = *(const float4*)(Cs + r * 132 + hm * 32 + d4 * 4); v[d4 * 4] = t4.x; v[d4 * 4 + 1] = t4.y; v[d4 * 4 + 2] = t4.z; v[d4 * 4 + 3] = t4.w; }
                if (lat) {
                    const int t = (j0 - 256) + r;
#pragma unroll
                    for (int a = 0; a < 2; ++a) {
                        const int pos = a == 0 ? (t >> 6) : (t & 63);
#pragma unroll
                        for (int f = 0; f < 8; ++f) {
                            const float cs = TB[(pos * 8 + f) * 2], sn = TB[(pos * 8 + f) * 2 + 1];
                            const float x0 = v[a * 16 + f], x1 = v[a * 16 + 8 + f];
                            v[a * 16 + f] = x0 * cs - x1 * sn; v[a * 16 + 8 + f] = x1 * cs + x0 * sn;
                        }
                    }
                }
                const float qs = isq ? 0.17677669529663687f * LOG2E : 1.f;
                const int h = hbase + (hm >> 1), mp = hm & 1;
                bfu* dst = (bfu*)(ws_ + (isq ? WS_QB : WS_KB)) + (((size_t)b * 4 + h) * NKEY + j0 + r) * 64 + mp * 32;
#pragma unroll
                for (int d8 = 0; d8 < 4; ++d8)
                    ((uint4*)dst)[d8] = make_uint4(pack2(v[d8 * 8] * qs, v[d8 * 8 + 1] * qs), pack2(v[d8 * 8 + 2] * qs, v[d8 * 8 + 3] * qs),
                                                   pack2(v[d8 * 8 + 4] * qs, v[d8 * 8 + 5] * qs), pack2(v[d8 * 8 + 6] * qs, v[d8 * 8 + 7] * qs));
            }
        } else {
            const int r = tid & 127, half = tid >> 7;
            float* dst = (float*)(ws_ + WS_CP) + (size_t)(row0 + r) * CSL + (nt - 10) * 128 + half * 64;
#pragma unroll
            for (int d4 = 0; d4 < 16; ++d4) ((float4*)dst)[d4] = *(const float4*)(Cs + r * 132 + half * 64 + d4 * 4);
        }
        __syncthreads();
    }
}

__device__ void phase_rwkv_prep(const P& p, int layer, int bid, int nb) {
    PHASE_PROLOGUE
    const float* CP = (const float*)(ws_ + WS_CP);
    float* RR = (float*)(ws_ + WS_RR); float* VV = (float*)(ws_ + WS_VV); float* KK = (float*)(ws_ + WS_KK);
    float* KR = (float*)(ws_ + WS_YS) + HEADARR / 4;
    bfu* LX = (bfu*)(ws_ + WS_LX);
    const float* mu = p.c_mu + layer * CSL; const float* k_k = p.c_k_k + layer * 512;
    const int lane = tid_ & 63, wv = tid_ >> 6;
    for (int row = bid * 4 + wv; row < MA; row += nb * 4) {
        int b, j, s; row_info(row, b, j, s);
        const int t = row < ML ? (row & 2047) : ((row - ML) & 255), T = row < ML ? SEQ : CL;
        const float* c0 = CP + (size_t)row * CSL;
        const bool hp = t > 0, hn = t < T - 1;
#pragma unroll 2
        for (int c = 0; c < 30; ++c) {
            const int col = c * 64 + lane;
            const float pc = c0[col];
            const float pp = hp ? c0[col - CSL] : 0.f, pn = hn ? c0[col + CSL] : 0.f;
            const float pf = pc + mu[col] * (0.5f * (pp + pn) - pc);
            if (c < 24) {
                const int h = c & 7;
                const size_t o = (((size_t)b * 8 + h) * NKEY + j) * 64 + lane;
                if (c < 8) RR[o] = pf;
                else if (c < 16) {
                    KR[o] = pf;
                    const float kv = pf * k_k[h * 64 + lane];
                    const float ss = wave_sum(kv * kv);
                    KK[o] = kv / fmaxf(sqrtf(ss), 1e-12f);
                } else VV[o] = pf;
            } else {
                float o;
                if (c < 26) o = tanhf(pf); else if (c < 28) o = pf; else o = sigmoidf_(pf);
                LX[(size_t)row * 384 + (c - 24) * 64 + lane] = f2bf(o);
            }
        }
    }
}

__device__ void phase_rwkv_lora(const P& p, int layer, int bid, int nb, char* smem) {
    PHASE_PROLOGUE
    const bfu* LX = (const bfu*)(ws_ + WS_LX);
    const int nitems = 144 * 4 * 5;
    for (int it = bid; it < nitems; it += nb) {
        const int job = it / (144 * 4), r2 = it % (144 * 4), mt = r2 >> 2, nt = r2 & 3;
        const int row0 = mt * 128, col0 = nt * 128;
        int b, j0, s; row_info(row0, b, j0, s);
        const int z = job & 1;
        const bfu* Bt; int K, aoff;
        if (job < 2) { Bt = (const bfu*)(ws_ + WS_LW2) + (size_t)z * 512 * 64; K = 64; aoff = z * 64; }
        else if (job < 4) { Bt = (const bfu*)(ws_ + WS_LA2) + (size_t)z * 512 * 64; K = 64; aoff = 128 + z * 64; }
        else { Bt = (const bfu*)(ws_ + WS_LG2); K = 128; aoff = 256; }
        gemm_tile([&](int r) { return LX + (size_t)(row0 + r) * 384 + aoff; }, [&](int r) { return Bt + (size_t)(col0 + r) * K; }, K,
            [&](f32x4 (&acc)[4][4], int wr, int wc, int fr, int fq) {
                if (job < 2) {
                    float* WW = (float*)(ws_ + WS_WW) + (size_t)z * (HEADARR / 4);
                    const float* w0 = p.c_w0 + ((size_t)layer * 2 + z) * 512;
                    ACC_FOREACH({
                        const int gc = col0 + col; const float xx = w0[gc] + val;
                        const float nx = -xx; const float sp = nx > 20.f ? nx : log1pf(__expf(nx));
                        const float wlog = -sp - 0.5f;
                        WW[(((size_t)b * 8 + (gc >> 6)) * NKEY + j0 + row) * 64 + (gc & 63)] = __expf(-__expf(wlog));
                    })
                } else if (job < 4) {
                    float* KD = (float*)(ws_ + WS_KD) + (size_t)z * (HEADARR / 4); float* BB = (float*)(ws_ + WS_BB) + (size_t)z * (HEADARR / 4);
                    const float* KR = (const float*)(ws_ + WS_YS) + HEADARR / 4; const float* KK = (const float*)(ws_ + WS_KK);
                    const float* a0 = p.c_a0 + ((size_t)layer * 2 + z) * 512; const float* k_a = p.c_k_a + layer * 512;
                    ACC_FOREACH({
                        const int gc = col0 + col; const float icl = sigmoidf_(a0[gc] + val);
                        const size_t o = (((size_t)b * 8 + (gc >> 6)) * NKEY + j0 + row) * 64 + (gc & 63);
                        KD[o] = KR[o] * (1.f + (icl - 1.f) * k_a[gc]); BB[o] = KK[o] * icl;
                    })
                } else {
                    float* GG = (float*)(ws_ + WS_GG);
                    ACC_FOREACH(GG[(size_t)(row0 + row) * 512 + col0 + col] = val;)
                }
            }, smem);
    }
}

__device__ void phase_scan(const P& p, int layer, int bid, int nb, char* smem) {
    PHASE_PROLOGUE
    float* sbuf = (float*)smem;
    const int tid = tid_, cg = tid & 7, rl = tid >> 3;
    for (int it = bid; it < 256; it += nb) {
        const int half = it & 1, z = (it >> 1) & 1, h = (it >> 2) & 7, b = it >> 5;
        const size_t hb = ((size_t)b * 8 + h) * NKEY * 64;
        const float* aW = (const float*)(ws_ + WS_WW) + (size_t)z * (HEADARR / 4) + hb;
        const float* aK = (const float*)(ws_ + WS_KD) + (size_t)z * (HEADARR / 4) + hb;
        const float* aB = (const float*)(ws_ + WS_BB) + (size_t)z * (HEADARR / 4) + hb;
        const float* aA = (const float*)(ws_ + WS_KK) + hb;
        const float* aR = (const float*)(ws_ + WS_RR) + hb;
        const float* aV = (const float*)(ws_ + WS_VV) + hb;
        float* aY = (float*)(ws_ + WS_YS) + (size_t)z * (HEADARR / 4) + hb;
        const int vrow = half * 32 + rl;
        float S[8];
#pragma unroll
        for (int i = 0; i < 8; ++i) S[i] = 0.f;
        auto chunk_j0 = [&](int c) { return z == 0 ? c * 16 : (c < 16 ? 240 - c * 16 : 2288 - (c - 16) * 16); };
        float4 pre0, pre1, pre2, pre3, pre4, pre5;
#define load_chunk(c) { const size_t jo = (size_t)chunk_j0(c) * 64 + tid * 4; pre0 = *(const float4*)(aW + jo); pre1 = *(const float4*)(aA + jo); pre2 = *(const float4*)(aB + jo); \
                        pre3 = *(const float4*)(aK + jo); pre4 = *(const float4*)(aR + jo); pre5 = *(const float4*)(aV + jo); }
#define store_chunk(buf) { float* d_ = sbuf + (((buf) * 16 + (tid >> 4)) * 6) * 64 + (tid & 15) * 4; *(float4*)(d_) = pre0; *(float4*)(d_ + 64) = pre1; *(float4*)(d_ + 128) = pre2; \
                        *(float4*)(d_ + 192) = pre3; *(float4*)(d_ + 256) = pre4; *(float4*)(d_ + 320) = pre5; }
        __syncthreads();
        load_chunk(0); store_chunk(0);
        __syncthreads();
        for (int c = 0; c < 144; ++c) {
            if (c + 1 < 144) load_chunk(c + 1);
            const int jl = chunk_j0(c);
            const float* cb = sbuf + (c & 1) * 16 * 6 * 64;
            for (int s = 0; s < 16; ++s) {
                const int st = z == 0 ? s : 15 - s;
                const float* sv = cb + st * 6 * 64;
                const float4 w0 = *(const float4*)(sv + 0 * 64 + cg * 8), w1 = *(const float4*)(sv + 0 * 64 + cg * 8 + 4);
                const float4 a0 = *(const float4*)(sv + 1 * 64 + cg * 8), a1 = *(const float4*)(sv + 1 * 64 + cg * 8 + 4);
                const float4 b0 = *(const float4*)(sv + 2 * 64 + cg * 8), b1 = *(const float4*)(sv + 2 * 64 + cg * 8 + 4);
                const float4 k0 = *(const float4*)(sv + 3 * 64 + cg * 8), k1 = *(const float4*)(sv + 3 * 64 + cg * 8 + 4);
                const float4 r0 = *(const float4*)(sv + 4 * 64 + cg * 8), r1 = *(const float4*)(sv + 4 * 64 + cg * 8 + 4);
                const float vv = sv[5 * 64 + vrow];
                const float w[8] = {w0.x, w0.y, w0.z, w0.w, w1.x, w1.y, w1.z, w1.w};
                const float a[8] = {a0.x, a0.y, a0.z, a0.w, a1.x, a1.y, a1.z, a1.w};
                const float bb[8] = {b0.x, b0.y, b0.z, b0.w, b1.x, b1.y, b1.z, b1.w};
                const float kk[8] = {k0.x, k0.y, k0.z, k0.w, k1.x, k1.y, k1.z, k1.w};
                const float rr[8] = {r0.x, r0.y, r0.z, r0.w, r1.x, r1.y, r1.z, r1.w};
                float sa = 0.f;
#pragma unroll
                for (int i = 0; i < 8; ++i) sa += S[i] * a[i];
                sa += __shfl_xor(sa, 1); sa += __shfl_xor(sa, 2); sa += __shfl_xor(sa, 4);
                sa = -sa;
                float y = 0.f;
#pragma unroll
                for (int i = 0; i < 8; ++i) { S[i] = S[i] * w[i] + sa * bb[i] + vv * kk[i]; y += S[i] * rr[i]; }
                y += __shfl_xor(y, 1); y += __shfl_xor(y, 2); y += __shfl_xor(y, 4);
                if (cg == 0) aY[(size_t)(jl + st) * 64 + vrow] = y;
            }
            if (c + 1 < 144) store_chunk((c + 1) & 1);
            __syncthreads();
        }
    }
}

__device__ void phase_readout(const P& p, int layer, int nrows, int bid, int nb) {
    PHASE_PROLOGUE
    const float* Y0 = (const float*)(ws_ + WS_YS); const float* Y1 = Y0 + HEADARR / 4;
    const float* RR = (const float*)(ws_ + WS_RR); const float* VV = (const float*)(ws_ + WS_VV);
    const float* KD0 = (const float*)(ws_ + WS_KD); const float* KD1 = KD0 + HEADARR / 4;
    const float* GG = (const float*)(ws_ + WS_GG);
    bfu* MIX = (bfu*)(ws_ + WS_MIX);
    const float* lnw = p.c_ln_w + layer * 512; const float* lnb = p.c_ln_b + layer * 512; const float* rk = p.c_r_k + layer * 512;
    const int lane = tid_ & 63, wv = tid_ >> 6;
    for (int row = bid * 4 + wv; row < nrows; row += nb * 4) {
        int b, j, s; row_info(row, b, j, s);
#pragma unroll 2
        for (int h = 0; h < 8; ++h) {
            const size_t o = (((size_t)b * 8 + h) * NKEY + j) * 64 + lane;
            const float y = Y0[o] + Y1[o];
            const float mean = wave_sum(y) * (1.f / 64.f);
            const float dv = y - mean;
            const float var = wave_sum(dv * dv) * (1.f / 64.f);
            const float yn = dv * rsqrtf(var + 64e-5f) * lnw[h * 64 + lane] + lnb[h * 64 + lane];
            const float r = RR[o], v = VV[o];
            const float rkv = rk[h * 64 + lane];
            const float bs = wave_sum(r * KD0[o] * rkv) + wave_sum(r * KD1[o] * rkv);
            const float outv = (yn + bs * v) * GG[(size_t)row * 512 + h * 64 + lane];
            MIX[(size_t)row * DM + 512 + h * 64 + lane] = f2bf(outv);
        }
    }
}

using f32x16 = __attribute__((ext_vector_type(16))) float;
#define AT_KBYTES 8192
#define AT_VSTRIDE 136
#define AT_VBYTES (64 * AT_VSTRIDE)
template <int GRP>
__device__ __forceinline__ void attn_item(const P& p, char* ws_, int layer, int b, int h, int qb, int nkeys, float lam, float lam_init, char* smem, int tid) {
    constexpr int KS = GRP ? 2 : 4;
    const int lane = tid & 63, wv = tid >> 6, r32 = lane & 31, hh = lane >> 5;
    const int mp = GRP ? (wv >> 1) : 0, sub = GRP ? (wv & 1) : wv;
    const int jq = qb * (GRP ? 64 : 128) + sub * 32 + r32;
    const bfu* Qg = (const bfu*)(ws_ + (GRP ? WS_QB : WS_QA)) + (((size_t)b * 4 + h) * NKEY + jq) * 64 + mp * 32;
    const bfu* Kg = GRP ? (const bfu*)(ws_ + WS_KB) + ((size_t)b * 4 + h) * NKEY * 64 : (const bfu*)(ws_ + WS_KA) + ((size_t)b * 2 + (h >> 1)) * NKEY * 64;
    const bfu* Vg = GRP ? (const bfu*)(ws_ + WS_VBT) + ((size_t)b * 4 + h) * 64 * NKEY : (const bfu*)(ws_ + WS_VAT) + ((size_t)b * 2 + (h >> 1)) * 64 * NKEY;
    bf16x8 qf[KS];
#pragma unroll
    for (int ks = 0; ks < KS; ++ks) qf[ks] = *(const bf16x8*)(Qg + ks * 16 + hh * 8);
    f32x16 oacc[2];
    float mrun = -1e30f, lrun = 0.f;
#pragma unroll
    for (int db = 0; db < 2; ++db)
#pragma unroll
        for (int i = 0; i < 16; ++i) oacc[db][i] = 0.f;
    const int lk0 = tid >> 3, lc = tid & 7;
    const bfu* kp0 = Kg + (size_t)lk0 * 64 + lc * 8; const bfu* kp1 = kp0 + 32 * 64;
    const bfu* vp0 = Vg + (size_t)lk0 * NKEY + lc * 8; const bfu* vp1 = vp0 + (size_t)32 * NKEY;
    const int ks0 = lk0 * 128 + ((lc ^ ((lk0 >> 1) & 7)) * 16), ks1 = (lk0 + 32) * 128 + ((lc ^ (((lk0 + 32) >> 1) & 7)) * 16);
    const int vs0 = lk0 * AT_VSTRIDE + lc * 16, vs1 = (lk0 + 32) * AT_VSTRIDE + lc * 16;
    char* sK = smem; char* sV = smem + 2 * AT_KBYTES;
    uint4 rk0 = *(const uint4*)kp0, rk1 = *(const uint4*)kp1, rv0 = *(const uint4*)vp0, rv1 = *(const uint4*)vp1;
    __syncthreads();
    *(uint4*)(sK + ks0) = rk0; *(uint4*)(sK + ks1) = rk1;
    *(uint2*)(sV + vs0) = make_uint2(rv0.x, rv0.y); *(uint2*)(sV + vs0 + 8) = make_uint2(rv0.z, rv0.w);
    *(uint2*)(sV + vs1) = make_uint2(rv1.x, rv1.y); *(uint2*)(sV + vs1 + 8) = make_uint2(rv1.z, rv1.w);
    __syncthreads();
    const int nt = nkeys >> 6;
    for (int t = 0; t < nt; ++t) {
        if (t + 1 < nt) {
            const size_t ko = (size_t)(t + 1) * 64 * 64; const int vo = (t + 1) * 64;
            rk0 = *(const uint4*)(kp0 + ko); rk1 = *(const uint4*)(kp1 + ko); rv0 = *(const uint4*)(vp0 + vo); rv1 = *(const uint4*)(vp1 + vo);
        }
        const char* cK = sK + (t & 1) * AT_KBYTES; const char* cV = sV + (t & 1) * AT_VBYTES;
        f32x16 sacc[2];
#pragma unroll
        for (int kb = 0; kb < 2; ++kb) {
#pragma unroll
            for (int i = 0; i < 16; ++i) sacc[kb][i] = 0.f;
            const int key = kb * 32 + r32;
#pragma unroll
            for (int ks = 0; ks < KS; ++ks) {
                const int c0 = mp * 4 + ks * 2 + hh;
                const bf16x8 kf = *(const bf16x8*)(cK + key * 128 + ((c0 ^ ((key >> 1) & 7)) * 16));
                sacc[kb] = __builtin_amdgcn_mfma_f32_32x32x16_bf16(kf, qf[ks], sacc[kb], 0, 0, 0);
            }
        }
        float mx = sacc[0][0];
#pragma unroll
        for (int i = 1; i < 16; ++i) mx = fmaxf(mx, sacc[0][i]);
#pragma unroll
        for (int i = 0; i < 16; ++i) mx = fmaxf(mx, sacc[1][i]);
        mx = fmaxf(mx, __shfl_xor(mx, 32));
        const float mnew = fmaxf(mrun, mx);
        const float alpha = __builtin_amdgcn_exp2f(mrun - mnew);
        mrun = mnew;
        float ps = 0.f;
#pragma unroll
        for (int kb = 0; kb < 2; ++kb)
#pragma unroll
            for (int i = 0; i < 16; ++i) { const float pv = __builtin_amdgcn_exp2f(sacc[kb][i] - mnew); sacc[kb][i] = pv; ps += pv; }
        lrun = lrun * alpha + ps;
#pragma unroll
        for (int db = 0; db < 2; ++db)
#pragma unroll
            for (int i = 0; i < 16; ++i) oacc[db][i] *= alpha;
#pragma unroll
        for (int kb = 0; kb < 2; ++kb)
#pragma unroll
            for (int s2 = 0; s2 < 2; ++s2) {
                union { bf16x8 v; unsigned u[4]; } pf;
#pragma unroll
                for (int i = 0; i < 4; ++i) pf.u[i] = pack2(sacc[kb][8 * s2 + 2 * i], sacc[kb][8 * s2 + 2 * i + 1]);
#pragma unroll
                for (int db = 0; db < 2; ++db) {
                    const char* vr = cV + (db * 32 + r32) * AT_VSTRIDE + (kb * 32 + s2 * 16 + hh * 4) * 2;
                    union { bf16x8 v; uint2 u[2]; } vf;
                    vf.u[0] = *(const uint2*)vr; vf.u[1] = *(const uint2*)(vr + 16);
                    oacc[db] = __builtin_amdgcn_mfma_f32_32x32x16_bf16(vf.v, pf.v, oacc[db], 0, 0, 0);
                }
            }
        if (t + 1 < nt) {
            char* nK = sK + ((t + 1) & 1) * AT_KBYTES; char* nV = sV + ((t + 1) & 1) * AT_VBYTES;
            *(uint4*)(nK + ks0) = rk0; *(uint4*)(nK + ks1) = rk1;
            *(uint2*)(nV + vs0) = make_uint2(rv0.x, rv0.y); *(uint2*)(nV + vs0 + 8) = make_uint2(rv0.z, rv0.w);
            *(uint2*)(nV + vs1) = make_uint2(rv1.x, rv1.y); *(uint2*)(nV + vs1 + 8) = make_uint2(rv1.z, rv1.w);
        }
        __syncthreads();
    }
    bfu* MIX = (bfu*)(ws_ + WS_MIX);
    const int grow = grow_of(b, jq);
    const float il = 1.f / (lrun + __shfl_xor(lrun, 32));
    if (GRP == 0) {
        bfu* dst = MIX + (size_t)grow * DM + h * 64;
#pragma unroll
        for (int db = 0; db < 2; ++db)
#pragma unroll
            for (int g = 0; g < 4; ++g)
                *(uint2*)(dst + db * 32 + g * 8 + hh * 4) = make_uint2(pack2(oacc[db][4 * g] * il, oacc[db][4 * g + 1] * il), pack2(oacc[db][4 * g + 2] * il, oacc[db][4 * g + 3] * il));
    } else {
        float* xs = (float*)smem + sub * 2048;
        if (mp == 1) {
            const float sc2 = lam * il;
#pragma unroll
            for (int db = 0; db < 2; ++db)
#pragma unroll
                for (int i = 0; i < 16; ++i) xs[(db * 16 + i) * 64 + lane] = oacc[db][i] * sc2;
        }
        __syncthreads();
        if (mp == 0) {
            float ss = 0.f;
#pragma unroll
            for (int db = 0; db < 2; ++db)
#pragma unroll
                for (int i = 0; i < 16; ++i) { const float o = oacc[db][i] * il - xs[(db * 16 + i) * 64 + lane]; oacc[db][i] = o; ss += o * o; }
            ss += __shfl_xor(ss, 32);
            const float rs = rsqrtf(ss * (1.f / 64.f) + 1e-6f) * (1.f - lam_init);
            const float* gn = p.b_subln + layer * 64;
            bfu* dst = MIX + (size_t)grow * DM + 256 + h * 64;
#pragma unroll
            for (int db = 0; db < 2; ++db)
#pragma unroll
                for (int g = 0; g < 4; ++g) {
                    const int d = db * 32 + g * 8 + hh * 4;
                    *(uint2*)(dst + d) = make_uint2(pack2(oacc[db][4 * g] * rs * gn[d], oacc[db][4 * g + 1] * rs * gn[d + 1]), pack2(oacc[db][4 * g + 2] * rs * gn[d + 2], oacc[db][4 * g + 3] * rs * gn[d + 3]));
                }
        }
    }
}
__device__ void phase_attn(const P& p, int layer, bool do_ctx, unsigned* qctr, int* s_item, char* smem) {
    PHASE_PROLOGUE
    const int tid = tid_;
    const float lam_init = 0.8f - 0.6f * expf(-0.3f * (float)layer);
    float d1 = 0.f, d2 = 0.f;
    for (int i = 0; i < 32; ++i) { d1 += p.b_lq1[layer * 32 + i] * p.b_lk1[layer * 32 + i]; d2 += p.b_lq2[layer * 32 + i] * p.b_lk2[layer * 32 + i]; }
    const float lam = expf(d1) - expf(d2) + lam_init;
    const int nitems = do_ctx ? 1728 : 1536;
    for (;;) {
        __syncthreads();
        if (tid == 0) *s_item = (int)atomicAdd(qctr, 1u);
        __syncthreads();
        const int it = *s_item;
        if (it >= nitems) break;
        int grp, b, h, qb, nkeys;
        if (it < 1024) { grp = 1; qb = 4 + (it & 31); h = (it >> 5) & 3; b = it >> 7; nkeys = NKEY; }
        else if (it < 1536) { grp = 0; const int r = it - 1024; qb = 2 + (r & 15); h = (r >> 4) & 3; b = r >> 6; nkeys = NKEY; }
        else if (it < 1664) { grp = 1; const int r = it - 1536; qb = r & 3; h = (r >> 2) & 3; b = r >> 4; nkeys = 256; }
        else { grp = 0; const int r = it - 1664; qb = r & 1; h = (r >> 1) & 3; b = r >> 3; nkeys = 256; }
        if (grp) attn_item<1>(p, ws_, layer, b, h, qb, nkeys, lam, lam_init, smem, tid);
        else attn_item<0>(p, ws_, layer, b, h, qb, nkeys, lam, lam_init, smem, tid);
    }
}

__device__ void phase_outproj(const P& p, int layer, int nrows, int bid, int nb, char* smem) {
    PHASE_PROLOGUE
    const bfu* MIX = (const bfu*)(ws_ + WS_MIX); const bfu* W = (const bfu*)(ws_ + WS_WOUT);
    float* X = (float*)(ws_ + WS_X); const float* mod = (const float*)(ws_ + WS_MOD);
    const int nitems = (nrows / 128) * 8;
    for (int it = bid; it < nitems; it += nb) {
        const int mt = it >> 3, nt = it & 7, row0 = mt * 128, col0 = nt * 128;
        int b, j0, s; row_info(row0, b, j0, s);
        const float* ga = mod + ((size_t)layer * 9 + s) * 6144 + 2 * 1024;
        gemm_tile([&](int r) { return MIX + (size_t)(row0 + r) * DM; }, [&](int r) { return W + (size_t)(col0 + r) * DM; }, DM,
            [&](f32x4 (&acc)[4][4], int wr, int wc, int fr, int fq) {
                ACC_FOREACH({ float* xp = X + (size_t)(row0 + row) * DM + col0 + col; *xp += ga[col0 + col] * val; })
            }, smem);
    }
}

__device__ void phase_norm2_route(const P& p, int layer, int nrows, int bid, int nb, char* smem) {
    PHASE_PROLOGUE
    const float* X = (const float*)(ws_ + WS_X); bfu* H = (bfu*)(ws_ + WS_H);
    const float* mod = (const float*)(ws_ + WS_MOD); const float* WRT = (const float*)(ws_ + WS_WRT);
    int* ECNT = (int*)(ws_ + WS_ECNT) + layer * 32; int* EIDX = (int*)(ws_ + WS_EIDX); float* EGATE = (float*)(ws_ + WS_EGATE); int* ELIST = (int*)(ws_ + WS_ELIST);
    float* lg = (float*)smem;
    int* lcnt = (int*)(lg + 4 * 16 * 48);
    int* lbase = lcnt + 32;
    int* lsel = lbase + 32;
    int* lrank = lsel + 128;
    const int tid = tid_, lane = tid & 63, wv = tid >> 6, r = lane & 15, kq = lane >> 4;
    const float* gf = p.g_ffn + layer * DM;
    const float* bg = p.r_b_group + layer * 4; const float* be = p.r_b_expert + layer * 32;
    const int nitems = nrows / 64;
    for (int it = bid; it < nitems; it += nb) {
        const int row = it * 64 + wv * 16 + r;
        int b, j, s; row_info(row, b, j, s);
        const float* xr = X + (size_t)row * DM;
        const float* sh = mod + ((size_t)layer * 9 + s) * 6144 + 3 * 1024; const float* sc = sh + 1024;
        if (tid < 32) lcnt[tid] = 0;
        float ss = 0.f;
        for (int c = 0; c < 64; ++c) { const float4 v = *(const float4*)(xr + c * 16 + kq * 4); ss += v.x * v.x + v.y * v.y + v.z * v.z + v.w * v.w; }
        ss += __shfl_xor(ss, 16); ss += __shfl_xor(ss, 32);
        const float rs = rsqrtf(ss * (1.f / 1024.f) + 1e-6f);
        f32x4 acc[3];
#pragma unroll
        for (int n = 0; n < 3; ++n) acc[n] = (f32x4){0.f, 0.f, 0.f, 0.f};
        for (int c = 0; c < 64; ++c) {
            const int k = c * 16 + kq * 4;
            const float4 v = *(const float4*)(xr + k), g = *(const float4*)(gf + k), s1 = *(const float4*)(sc + k), s0 = *(const float4*)(sh + k);
            float f[4];
            f[0] = v.x * rs * g.x * (1.f + s1.x) + s0.x; f[1] = v.y * rs * g.y * (1.f + s1.y) + s0.y;
            f[2] = v.z * rs * g.z * (1.f + s1.z) + s0.z; f[3] = v.w * rs * g.w * (1.f + s1.w) + s0.w;
            *(uint2*)(H + (size_t)row * DM + k) = make_uint2(pack2(f[0], f[1]), pack2(f[2], f[3]));
#pragma unroll
            for (int n = 0; n < 3; ++n) {
                const float4 w = *(const float4*)(WRT + (size_t)(n * 16 + r) * DM + k);
                acc[n] = __builtin_amdgcn_mfma_f32_16x16x4f32(f[0], w.x, acc[n], 0, 0, 0);
                acc[n] = __builtin_amdgcn_mfma_f32_16x16x4f32(f[1], w.y, acc[n], 0, 0, 0);
                acc[n] = __builtin_amdgcn_mfma_f32_16x16x4f32(f[2], w.z, acc[n], 0, 0, 0);
                acc[n] = __builtin_amdgcn_mfma_f32_16x16x4f32(f[3], w.w, acc[n], 0, 0, 0);
            }
        }
#pragma unroll
        for (int n = 0; n < 3; ++n)
#pragma unroll
            for (int jj = 0; jj < 4; ++jj) lg[(wv * 16 + kq * 4 + jj) * 48 + n * 16 + r] = acc[n][jj];
        __syncthreads();
        if (lane < 16) {
            const float* L = lg + (wv * 16 + lane) * 48;
            const int grow = it * 64 + wv * 16 + lane;
            float gl[4]; float gm = -1e30f; int gi = 0;
#pragma unroll
            for (int g = 0; g < 4; ++g) { gl[g] = L[g] + bg[g]; if (gl[g] > gm) { gm = gl[g]; gi = g; } }
            float gs = 0.f;
#pragma unroll
            for (int g = 0; g < 4; ++g) gs += __expf(gl[g] - gm);
            const float gp = 1.f / gs;
            float v1 = -1e30f, v2 = -1e30f; int i1 = 0, i2 = 0;
            for (int e = 0; e < 8; ++e) {
                const float v = L[4 + gi * 8 + e] + be[gi * 8 + e];
                if (v > v1) { v2 = v1; i2 = i1; v1 = v; i1 = e; } else if (v > v2) { v2 = v; i2 = e; }
            }
            const float e2 = __expf(v2 - v1), den = 1.f / (1.f + e2);
            const int ex1 = gi * 8 + i1, ex2 = gi * 8 + i2;
            EIDX[grow * 2] = ex1; EIDX[grow * 2 + 1] = ex2;
            EGATE[grow * 2] = den * gp; EGATE[grow * 2 + 1] = e2 * den * gp;
            const int lr = wv * 16 + lane;
            lsel[lr * 2] = ex1; lsel[lr * 2 + 1] = ex2;
            lrank[lr * 2] = atomicAdd(&lcnt[ex1], 1); lrank[lr * 2 + 1] = atomicAdd(&lcnt[ex2], 1);
        }
        __syncthreads();
        if (tid < 32) lbase[tid] = lcnt[tid] > 0 ? atomicAdd(&ECNT[tid], lcnt[tid]) : 0;
        __syncthreads();
        if (tid < 128) { const int e = lsel[tid]; ELIST[(size_t)e * (2 * MA) + lbase[e] + lrank[tid]] = ((it * 64 + (tid >> 1)) << 1) | (tid & 1); }
        __syncthreads();
    }
}

__device__ __forceinline__ int moe_prefix(const int* ECNT, int* spre  ) {
    if (threadIdx.x == 0) { int a = 0; for (int e = 0; e < 32; ++e) { spre[e] = a; a += (ECNT[e] + 127) >> 7; } spre[32] = a; }
    __syncthreads();
    return spre[32];
}
__device__ void phase_expert1(const P& p, int layer, int bid, int nb, char* smem) {
    PHASE_PROLOGUE
    const bfu* H = (const bfu*)(ws_ + WS_H); const bfu* W1 = (const bfu*)(ws_ + WS_W1); const bfu* W3 = (const bfu*)(ws_ + WS_W3);
    bfu* HB = (bfu*)(ws_ + WS_HB);
    const int* ECNT = (const int*)(ws_ + WS_ECNT) + layer * 32; const int* ELIST = (const int*)(ws_ + WS_ELIST);
    int* spre = (int*)(smem + 65536);
    const int nblk = moe_prefix(ECNT, spre);
    const int nitems = nblk * 8;
    for (int it = bid; it < nitems; it += nb) {
        const int blk = it >> 3, nt = it & 7;
        int e = 0;
        while (spre[e + 1] <= blk) ++e;
        const int rb = blk - spre[e], cnt = ECNT[e];
        const int* lst = ELIST + (size_t)e * (2 * MA) + rb * 128;
        const int nvalid = min(128, cnt - rb * 128);
        const bfu* w1 = W1 + (size_t)e * FF * DM; const bfu* w3 = W3 + (size_t)e * FF * DM;
        bfu* hb = HB + (size_t)blk * 128 * FF;
        gemm_tile([&](int r) { const int tok = r < nvalid ? (lst[r] >> 1) : 0; return H + (size_t)tok * DM; },
                  [&](int r) { const int wcx = r >> 6, n4 = (r >> 4) & 3, rr = r & 15; const int hc = nt * 64 + wcx * 32 + (n4 & 1) * 16 + rr; return (n4 < 2 ? w1 : w3) + (size_t)hc * DM; }, DM,
            [&](f32x4 (&acc)[4][4], int wr, int wc, int fr, int fq) {
#pragma unroll
                for (int m = 0; m < 4; ++m)
#pragma unroll
                    for (int n = 0; n < 2; ++n)
#pragma unroll
                        for (int jj = 0; jj < 4; ++jj) {
                            const int row = wr * 64 + m * 16 + fq * 4 + jj; const int hc = nt * 64 + wc * 32 + n * 16 + fr;
                            const float a = acc[m][n][jj], g = acc[m][n + 2][jj];
                            hb[(size_t)row * FF + hc] = f2bf(siluf_(a) * g);
                        }
            }, smem);
    }
}
__device__ void phase_expert2(const P& p, int layer, int bid, int nb, char* smem) {
    PHASE_PROLOGUE
    const bfu* HB = (const bfu*)(ws_ + WS_HB); const bfu* W2 = (const bfu*)(ws_ + WS_W2);
    float* Y = (float*)(ws_ + WS_Y01);
    const int* ECNT = (const int*)(ws_ + WS_ECNT) + layer * 32; const int* ELIST = (const int*)(ws_ + WS_ELIST); const float* EGATE = (const float*)(ws_ + WS_EGATE);
    int* spre = (int*)(smem + 65536);
    const int nblk = moe_prefix(ECNT, spre);
    const int nitems = nblk * 8;
    for (int it = bid; it < nitems; it += nb) {
        const int blk = it >> 3, nt = it & 7;
        int e = 0;
        while (spre[e + 1] <= blk) ++e;
        const int rb = blk - spre[e], cnt = ECNT[e];
        const int* lst = ELIST + (size_t)e * (2 * MA) + rb * 128;
        const int nvalid = min(128, cnt - rb * 128);
        const bfu* w2 = W2 + (size_t)e * DM * FF;
        const bfu* hb = HB + (size_t)blk * 128 * FF;
        gemm_tile([&](int r) { return hb + (size_t)r * FF; }, [&](int r) { return w2 + (size_t)(nt * 128 + r) * FF; }, FF,
            [&](f32x4 (&acc)[4][4], int wr, int wc, int fr, int fq) {
#pragma unroll
                for (int m = 0; m < 4; ++m)
#pragma unroll
                    for (int jj = 0; jj < 4; ++jj) {
                        const int row = wr * 64 + m * 16 + fq * 4 + jj;
                        if (row < nvalid) {
                            const int ent = lst[row]; const float gt = EGATE[ent];
                            float* yp = Y + ((size_t)(ent & 1) * MA + (ent >> 1)) * DM + nt * 128 + wc * 64 + fr;
#pragma unroll
                            for (int n = 0; n < 4; ++n) yp[n * 16] = gt * acc[m][n][jj];
                        }
                    }
            }, smem);
    }
}

#define XB_TMO      128
#define XB_XCNT(j)  (256  + 64 * (j))
#define XB_XSUB(j)  (1280 + 64 * (j))
#define XB_XGEN(j)  (2304 + 64 * (j))
#define XB_TOP      3328
#define XB_TOPGEN   3392
#define XCD_BAR_WORDS 3456
#define XB_SPIN_CAP (1u << 22)
#define LAS __attribute__((address_space(3)))

__device__ __forceinline__ unsigned xb_ld(unsigned* p)              { return __hip_atomic_load(p, __ATOMIC_RELAXED, __HIP_MEMORY_SCOPE_AGENT); }
__device__ __forceinline__ unsigned xb_add(unsigned* p, unsigned v) { return __hip_atomic_fetch_add(p, v, __ATOMIC_RELAXED, __HIP_MEMORY_SCOPE_AGENT); }
__device__ __forceinline__ unsigned xb_xcc_id() { return (unsigned)__builtin_amdgcn_s_getreg((3 << 11) | 20) & 0xFu; }
#define XB_SPIN(cond, bar) do { unsigned _sp = 0; while (cond) { __builtin_amdgcn_s_sleep(1); \
    if ((++_sp & 255u) == 0u) { if (xb_ld(&(bar)[XB_TMO])) break; if (_sp > XB_SPIN_CAP) { atomicAdd(&(bar)[XB_TMO], 1u); break; } } } } while (0)

struct XcdBarrier {
    unsigned* bar; unsigned x;
    volatile LAS unsigned* st;
};

__device__ __forceinline__ XcdBarrier xcd_barrier_post(unsigned* bar, volatile LAS unsigned* st) {
    XcdBarrier b; b.bar = bar; b.x = xb_xcc_id(); b.st = st;
    if (threadIdx.x == 0) (void)xb_add(&bar[XB_XCNT(b.x)], 1u);
    return b;
}
__device__ __forceinline__ void xcd_barrier_complete(unsigned* bar, unsigned x, unsigned& nloc, unsigned& nx) {
    const unsigned G = gridDim.x * gridDim.y * gridDim.z;
    unsigned sum, cnt, mine, sp = 0u;
    for (;;) {
        sum = 0u; cnt = 0u; mine = 0u;
#pragma unroll
        for (unsigned j = 0; j < 16; ++j) { const unsigned c = xb_ld(&bar[XB_XCNT(j)]); sum += c; cnt += (c > 0u) ? 1u : 0u; mine = (j == x) ? c : mine; }
        if (sum == G) break;
        __builtin_amdgcn_s_sleep(1);
        if ((++sp & 255u) == 0u) { if (xb_ld(&bar[XB_TMO])) break; if (sp > XB_SPIN_CAP) { atomicAdd(&bar[XB_TMO], 1u); break; } }
    }
    nloc = mine > 0u ? mine : 1u; nx = cnt > 0u ? cnt : 1u;
}

__device__ __forceinline__ void xcd_barrier(const XcdBarrier& b) {
    asm volatile("s_waitcnt vmcnt(0)" ::: "memory");
    __syncthreads();
    if (threadIdx.x == 0) {
        unsigned* bar = b.bar;
        __builtin_amdgcn_s_waitcnt(0);
        unsigned nloc = b.st[0], nx = b.st[1];
        if (nloc == 0u) { xcd_barrier_complete(bar, b.x, nloc, nx); b.st[0] = nloc; b.st[1] = nx; }
        const unsigned old = xb_add(&bar[XB_XSUB(b.x)], 1u);
        const unsigned gen = old / nloc;
        if (old + 1u == (gen + 1u) * nloc) {
            __builtin_amdgcn_fence(__ATOMIC_RELEASE, "agent");
            asm volatile("s_waitcnt vmcnt(0)" ::: "memory");
            const unsigned og = xb_add(&bar[XB_TOP], 1u);
            const unsigned tg = og / nx;
            if (og + 1u == (tg + 1u) * nx) xb_add(&bar[XB_TOPGEN], 1u);
            else XB_SPIN(xb_ld(&bar[XB_TOPGEN]) == tg, bar);
            __builtin_amdgcn_fence(__ATOMIC_ACQUIRE, "agent");
            xb_add(&bar[XB_XGEN(b.x)], 1u);
            asm volatile("s_waitcnt vmcnt(0)" ::: "memory");
        } else {
            XB_SPIN(xb_ld(&bar[XB_XGEN(b.x)]) == gen, bar);
            __builtin_amdgcn_fence(__ATOMIC_ACQUIRE, "agent");
            asm volatile("s_waitcnt vmcnt(0)" ::: "memory");
        }
    }
    __syncthreads();
}


#define CTL_Q(l) (4096 + 64 * (l))
__global__ void __launch_bounds__(256, 2) fwd(P p) {
    __shared__ __attribute__((aligned(16))) char smem[SMEM_BYTES];
    __shared__ uint4 xb_words;
    __shared__ int s_item;
    if (threadIdx.x == 0) xb_words = make_uint4(0u, 0u, 0u, 0u);
    __syncthreads();
    unsigned* ctl = (unsigned*)(p.ws + WS_CTL);
    XcdBarrier bar = xcd_barrier_post(ctl, (volatile LAS unsigned*)&xb_words);
    const int bid = blockIdx.x, nb = gridDim.x;
    phase_setup(p, bid, nb);
    phase_mod(p, bid, nb, smem);
    for (int l = 0; l < NLAYER; ++l) {
        const int nr = l < NLAYER - 1 ? MA : ML;
        phase_conv(p, l, bid, nb, smem);
        if (l == 0) xcd_barrier(bar);
        phase_norm1(p, l, 0, bid, nb);
        xcd_barrier(bar);
        phase_inproj(p, l, bid, nb, smem);
        xcd_barrier(bar);
        phase_rwkv_prep(p, l, bid, nb);
        xcd_barrier(bar);
        phase_rwkv_lora(p, l, bid, nb, smem);
        xcd_barrier(bar);
        if (bid < 256) phase_scan(p, l, bid, 256, smem);
        phase_attn(p, l, l < NLAYER - 1, ctl + CTL_Q(l), &s_item, smem);
        xcd_barrier(bar);
        phase_readout(p, l, nr, bid, nb);
        xcd_barrier(bar);
        phase_outproj(p, l, nr, bid, nb, smem);
        xcd_barrier(bar);
        phase_norm2_route(p, l, nr, bid, nb, smem);
        xcd_barrier(bar);
        phase_expert1(p, l, bid, nb, smem);
        xcd_barrier(bar);
        phase_expert2(p, l, bid, nb, smem);
        xcd_barrier(bar);
    }
    phase_norm1(p, NLAYER, 1, bid, nb);
}

extern "C" void kernel_launch(void* const* d_in, const int* in_sizes, int n_in, void* d_out, int out_size, void* d_ws, size_t ws_size, hipStream_t stream) {
    if (n_in != 36 || ws_size < WS_END) { fprintf(stderr, "kernel_launch: unexpected n_in %d or ws_size %zu < %zu\n", n_in, ws_size, (size_t)WS_END); return; }
    static int grid = 0;
    if (!grid) {
        int dev = 0, cus = 0, per_cu = 0;
        hipGetDevice(&dev);
        hipDeviceGetAttribute(&cus, hipDeviceAttributeMultiprocessorCount, dev);
        hipOccupancyMaxActiveBlocksPerMultiprocessor(&per_cu, (const void*)fwd, 256, 0);
        if (per_cu < 1) per_cu = 1;
        grid = cus * (per_cu < 2 ? per_cu : 2);
    }
    P p{};
    const float** pp = (const float**)&p;
    for (int i = 0; i < 36; ++i) pp[i] = (const float*)d_in[i];
    p.out = (float*)d_out; p.ws = (char*)d_ws;
    hipMemsetAsync((char*)d_ws + WS_CTL, 0, 65536, stream);
    fwd<<<grid, 256, 0, stream>>>(p);
}
```

```cpp
#include <hip/hip_runtime.h>
#include <stdint.h>
#include <stdio.h>

typedef unsigned short bfu;
using bf16x8 = __attribute__((ext_vector_type(8))) short;
using f32x4  = __attribute__((ext_vector_type(4))) float;

#define DM 1024
#define NB 8
#define SEQ 2048
#define CL 256
#define NKEY 2304
#define ML 16384
#define MC 2048
#define MA 18432
#define INW 3200
#define CSL 1920
#define NEXP 32
#define FF 512
#define NLAYER 4
#define LOG2E 1.4426950408889634f

#define MBy(x) ((size_t)(x) << 20)
constexpr size_t WS_CTL   = 0;
constexpr size_t WS_MOD   = 65536;
constexpr size_t WS_ROPE  = WS_MOD + (size_t)4 * 9 * 6144 * 4;
constexpr size_t WS_ECNT  = WS_ROPE + 64 * 16 * 2 * 4 + 64 * 8 * 2 * 4;
constexpr size_t WS_WRT   = WS_ECNT + 4096;
constexpr size_t WS_EIDX  = WS_WRT + (size_t)48 * 1024 * 4;
constexpr size_t WS_EGATE = WS_EIDX + (size_t)MA * 2 * 4;
constexpr size_t WS_ELIST = WS_EGATE + (size_t)MA * 2 * 4;
constexpr size_t WS_X     = MBy(8);
constexpr size_t WS_H     = WS_X + (size_t)MA * DM * 4;
constexpr size_t WS_WIN   = WS_H + (size_t)MA * DM * 2;
constexpr size_t WS_WOUT  = WS_WIN + (size_t)INW * DM * 2;
constexpr size_t WS_W1    = WS_WOUT + (size_t)DM * DM * 2;
constexpr size_t WS_W3    = WS_W1 + (size_t)NEXP * FF * DM * 2;
constexpr size_t WS_W2    = WS_W3 + (size_t)NEXP * FF * DM * 2;
constexpr size_t WS_LW2   = WS_W2 + (size_t)NEXP * FF * DM * 2;
constexpr size_t WS_LA2   = WS_LW2 + (size_t)2 * 512 * 64 * 2;
constexpr size_t WS_LG2   = WS_LA2 + (size_t)2 * 512 * 64 * 2;
constexpr size_t WS_QA    = WS_LG2 + (size_t)512 * 128 * 2;
constexpr size_t WS_KA    = WS_QA + (size_t)NB * 4 * NKEY * 64 * 2;
constexpr size_t WS_VAT   = WS_KA + (size_t)NB * 2 * NKEY * 64 * 2;
constexpr size_t WS_QB    = WS_VAT + (size_t)NB * 2 * NKEY * 64 * 2;
constexpr size_t WS_KB    = WS_QB + (size_t)NB * 4 * NKEY * 64 * 2;
constexpr size_t WS_VBT   = WS_KB + (size_t)NB * 4 * NKEY * 64 * 2;
constexpr size_t WS_CP    = WS_VBT + (size_t)NB * 4 * NKEY * 64 * 2;
constexpr size_t WS_GG    = WS_CP + (size_t)MA * CSL * 4;
constexpr size_t WS_MIX   = WS_GG + (size_t)MA * 512 * 4;
constexpr size_t HEADARR  = (size_t)NB * 8 * NKEY * 64 * 4;
#define OPS_REC 13568
constexpr size_t OPS_DIR  = (size_t)64 * 144 * OPS_REC;
constexpr size_t WS_OPS   = WS_MIX + (size_t)MA * DM * 2;
constexpr size_t WS_YS    = WS_OPS + 2 * OPS_DIR;
constexpr size_t WS_VB    = WS_YS + 2 * HEADARR;
constexpr size_t WS_BETA  = WS_VB + (size_t)MA * 512 * 2;
constexpr size_t WS_LXG   = WS_BETA + (size_t)2 * MA * 8 * 4;
constexpr size_t WS_END   = WS_LXG + (size_t)MA * 128 * 2;
constexpr size_t WS_Y01   = WS_OPS;
constexpr size_t WS_HB    = WS_OPS + (size_t)2 * MA * DM * 4;
static_assert((size_t)2 * MA * DM * 4 + (size_t)(2 * MA + 32 * 128) * 512 * 2 <= 2 * OPS_DIR, "MoE buffers must fit in OPS");

struct P {
    const float *x, *c, *ctx, *c_ctx, *w_mod, *b_mod, *g_mix, *g_ffn, *w_in, *a_q_gain, *a_k_gain, *b_lq1, *b_lk1, *b_lq2, *b_lk2, *b_subln,
        *c_mu, *c_w0, *c_w2, *c_a0, *c_a2, *c_g2, *c_k_k, *c_k_a, *c_r_k, *c_ln_w, *c_ln_b, *w_out, *r_w_group, *r_b_group, *r_w_expert, *r_b_expert,
        *e_w1, *e_w3, *e_w2, *g_final;
    float* out;
    char* ws;
};

__device__ __forceinline__ float bf2f(bfu b) { return __uint_as_float((unsigned)b << 16); }
__device__ __forceinline__ unsigned pack2(float a, float b) {
    typedef float f2 __attribute__((ext_vector_type(2)));
    typedef __bf16 b2 __attribute__((ext_vector_type(2)));
    f2 v = {a, b}; b2 r = __builtin_convertvector(v, b2); return __builtin_bit_cast(unsigned, r);
}
__device__ __forceinline__ bfu f2bf(float a) { return (bfu)(pack2(a, 0.f) & 0xFFFFu); }
__device__ __forceinline__ float wave_sum(float v) {
#pragma unroll
    for (int o = 32; o >= 1; o >>= 1) v += __shfl_xor(v, o);
    return v;
}
template <int CTRL> __device__ __forceinline__ float dppf(float v) { return __int_as_float(__builtin_amdgcn_update_dpp(0, __float_as_int(v), CTRL, 0xF, 0xF, true)); }
__device__ __forceinline__ float sum8(float v) { v += dppf<0xB1>(v); v += dppf<0x4E>(v); v += dppf<0x141>(v); return v; }
__device__ __forceinline__ float sigmoidf_(float x) { return 1.f / (1.f + __expf(-x)); }
__device__ __forceinline__ float siluf_(float x) { return x / (1.f + __expf(-x)); }
__device__ __forceinline__ void row_info(int grow, int& b, int& j, int& s) {
    if (grow < ML) { b = grow >> 11; j = 256 + (grow & 2047); s = b; }
    else { int r = grow - ML; b = r >> 8; j = r & 255; s = 8; }
}
__device__ __forceinline__ int grow_of(int b, int j) { return j < 256 ? ML + b * 256 + j : b * 2048 + (j - 256); }

#define SMEM_BYTES 69632

#define PHASE_PROLOGUE int tid_ = threadIdx.x; asm volatile("" : "+v"(tid_)); int z_ = 0; asm volatile("" : "+v"(z_)); char* ws_ = p.ws + __builtin_amdgcn_readfirstlane(z_);

__device__ void phase_setup(const P& p, int bid, int nb) {
    PHASE_PROLOGUE
    float4* X4 = (float4*)(ws_ + WS_X);
    const float4* x4 = (const float4*)p.x; const float4* c4 = (const float4*)p.ctx;
    const size_t nl = (size_t)ML * DM / 4, nc = (size_t)MC * DM / 4;
    for (size_t i = (size_t)bid * 256 + tid_; i < nl + nc; i += (size_t)nb * 256) X4[i] = i < nl ? x4[i] : c4[i - nl];
    if (bid == 0) {
        float* TA = (float*)(ws_ + WS_ROPE); float* TB = TA + 64 * 16 * 2;
        for (int i = tid_; i < 64 * 16; i += 256) { int pos = i >> 4, f = i & 15; double inv = pow(10000.0, -(double)f / 16.0); double a = (double)pos * inv; TA[i * 2] = (float)cos(a); TA[i * 2 + 1] = (float)sin(a); }
        for (int i = tid_; i < 64 * 8; i += 256) { int pos = i >> 3, f = i & 7; double inv = pow(10000.0, -(double)f / 8.0); double a = (double)pos * inv; TB[i * 2] = (float)cos(a); TB[i * 2 + 1] = (float)sin(a); }
        int* ec = (int*)(ws_ + WS_ECNT);
        for (int i = tid_; i < 128; i += 256) ec[i] = 0;
    }
}

__device__ void phase_mod(const P& p, int bid, int nb, char* smem) {
    PHASE_PROLOGUE
    float* act = (float*)smem;
    float* red = act + 9 * 1024;
    for (int i = tid_; i < 9 * 1024; i += 256) { float v = i < 8 * 1024 ? p.c[i] : p.c_ctx[i - 8 * 1024]; act[i] = siluf_(v); }
    __syncthreads();
    float* mod = (float*)(ws_ + WS_MOD);
    const int nitems = 4 * 6144 / 64;
    const int cl = tid_ & 63, kq = tid_ >> 6;
    for (int it = bid; it < nitems; it += nb) {
        const int layer = it / 96, n = (it % 96) * 64 + cl;
        const float* w = p.w_mod + (size_t)layer * DM * 6144 + n;
        float a[9];
#pragma unroll
        for (int s = 0; s < 9; ++s) a[s] = 0.f;
        for (int k = kq * 256; k < kq * 256 + 256; ++k) {
            const float wv = w[(size_t)k * 6144];
#pragma unroll
            for (int s = 0; s < 9; ++s) a[s] += act[s * 1024 + k] * wv;
        }
#pragma unroll
        for (int s = 0; s < 9; ++s) red[(kq * 9 + s) * 64 + cl] = a[s];
        __syncthreads();
        for (int i = tid_; i < 9 * 64; i += 256) {
            const int s = i >> 6, c2 = i & 63, n2 = (it % 96) * 64 + c2;
            float v = red[(0 * 9 + s) * 64 + c2] + red[(1 * 9 + s) * 64 + c2] + red[(2 * 9 + s) * 64 + c2] + red[(3 * 9 + s) * 64 + c2];
            mod[((size_t)layer * 9 + s) * 6144 + n2] = v + p.b_mod[layer * 6144 + n2];
        }
        __syncthreads();
    }
}

__device__ __forceinline__ void conv_tile(const float* src, int K, int N, bfu* dst, int k0, int n0, float* ts, int tid_) {
    const int t = tid_;
    {
        const int kk = t >> 4, n4 = (t & 15) * 4;
#pragma unroll
        for (int pz = 0; pz < 4; ++pz) {
            const float4 v = *(const float4*)(src + (size_t)(k0 + kk + 16 * pz) * N + n0 + n4);
            float* d = ts + (kk + 16 * pz) * 65 + n4; d[0] = v.x; d[1] = v.y; d[2] = v.z; d[3] = v.w;
        }
    }
    __syncthreads();
    {
        const int n = t >> 2, kc = (t & 3) * 16;
        unsigned o[8];
#pragma unroll
        for (int i = 0; i < 8; ++i) o[i] = pack2(ts[(kc + 2 * i) * 65 + n], ts[(kc + 2 * i + 1) * 65 + n]);
        uint4* d = (uint4*)(dst + (size_t)(n0 + n) * K + k0 + kc);
        d[0] = make_uint4(o[0], o[1], o[2], o[3]); d[1] = make_uint4(o[4], o[5], o[6], o[7]);
    }
    __syncthreads();
}
__device__ void phase_conv(const P& p, int layer, int bid, int nb, char* smem) {
    PHASE_PROLOGUE
    float* ts = (float*)smem;
    const float* srcs[8]; bfu* dsts[8]; int Ks[8], Ns[8], Bs[8];
    char* ws = ws_;
    srcs[0] = p.w_in + (size_t)layer * DM * INW;  Ks[0] = DM; Ns[0] = INW; Bs[0] = 1;  dsts[0] = (bfu*)(ws + WS_WIN);
    srcs[1] = p.w_out + (size_t)layer * DM * DM;  Ks[1] = DM; Ns[1] = DM;  Bs[1] = 1;  dsts[1] = (bfu*)(ws + WS_WOUT);
    srcs[2] = p.e_w1 + (size_t)layer * NEXP * DM * FF; Ks[2] = DM; Ns[2] = FF; Bs[2] = NEXP; dsts[2] = (bfu*)(ws + WS_W1);
    srcs[3] = p.e_w3 + (size_t)layer * NEXP * DM * FF; Ks[3] = DM; Ns[3] = FF; Bs[3] = NEXP; dsts[3] = (bfu*)(ws + WS_W3);
    srcs[4] = p.e_w2 + (size_t)layer * NEXP * FF * DM; Ks[4] = FF; Ns[4] = DM; Bs[4] = NEXP; dsts[4] = (bfu*)(ws + WS_W2);
    srcs[5] = p.c_w2 + (size_t)layer * 2 * 64 * 512;   Ks[5] = 64; Ns[5] = 512; Bs[5] = 2;   dsts[5] = (bfu*)(ws + WS_LW2);
    srcs[6] = p.c_a2 + (size_t)layer * 2 * 64 * 512;   Ks[6] = 64; Ns[6] = 512; Bs[6] = 2;   dsts[6] = (bfu*)(ws + WS_LA2);
    srcs[7] = p.c_g2 + (size_t)layer * 128 * 512;      Ks[7] = 128; Ns[7] = 512; Bs[7] = 1;  dsts[7] = (bfu*)(ws + WS_LG2);
    int start = 0;
#pragma unroll
    for (int jb = 0; jb < 8; ++jb) {
        const int tk = Ks[jb] / 64, tn = Ns[jb] / 64, per = tk * tn, tot = per * Bs[jb];
        int first = bid - (start % nb); if (first < 0) first += nb;
        for (int it = first; it < tot; it += nb) {
            const int bt = it / per, r = it % per, kt = r / tn, nt = r % tn;
            conv_tile(srcs[jb] + (size_t)bt * Ks[jb] * Ns[jb], Ks[jb], Ns[jb], dsts[jb] + (size_t)bt * Ks[jb] * Ns[jb], kt * 64, nt * 64, ts, tid_);
        }
        start += tot;
    }
    float* wrt = (float*)(ws + WS_WRT);
    const float* wg = p.r_w_group + (size_t)layer * DM * 4; const float* we = p.r_w_expert + (size_t)layer * DM * 32;
    for (int i = bid * 256 + tid_; i < 48 * 1024; i += nb * 256) {
        const int r = i >> 10, k = i & 1023;
        wrt[i] = r < 4 ? wg[k * 4 + r] : (r < 36 ? we[k * 32 + (r - 4)] : 0.f);
    }
}

__device__ void phase_norm1(const P& p, int layer, int mode, int bid, int nb) {
    PHASE_PROLOGUE
    float* X = (float*)(ws_ + WS_X); bfu* H = (bfu*)(ws_ + WS_H);
    const float* Y0 = (const float*)(ws_ + WS_Y01); const float* Y1 = Y0 + (size_t)MA * DM;
    const float* mod = (const float*)(ws_ + WS_MOD);
    const int lane = tid_ & 63, wv = tid_ >> 6;
    const int nrows = mode ? ML : MA;
    if (bid == 0 && mode == 0 && tid_ < 32) ((int*)(ws_ + WS_ECNT))[layer * 32 + tid_] = 0;
    for (int row = bid * 4 + wv; row < nrows; row += nb * 4) {
        int b, j, s; row_info(row, b, j, s);
        float4 v[4];
        float ss = 0.f;
#pragma unroll
        for (int c = 0; c < 4; ++c) {
            const int col = c * 256 + lane * 4;
            float4 xv = *(const float4*)(X + (size_t)row * DM + col);
            if (layer > 0) {
                const float4 a = *(const float4*)(Y0 + (size_t)row * DM + col), bq = *(const float4*)(Y1 + (size_t)row * DM + col);
                const float4 g = *(const float4*)(mod + ((size_t)(layer - 1) * 9 + s) * 6144 + 5 * 1024 + col);
                xv.x += g.x * (a.x + bq.x); xv.y += g.y * (a.y + bq.y); xv.z += g.z * (a.z + bq.z); xv.w += g.w * (a.w + bq.w);
                if (!mode) *(float4*)(X + (size_t)row * DM + col) = xv;
            }
            v[c] = xv; ss += xv.x * xv.x + xv.y * xv.y + xv.z * xv.z + xv.w * xv.w;
        }
        ss = wave_sum(ss);
        const float rs = rsqrtf(ss * (1.f / 1024.f) + 1e-6f);
#pragma unroll
        for (int c = 0; c < 4; ++c) {
            const int col = c * 256 + lane * 4;
            if (mode) {
                const float4 g = *(const float4*)(p.g_final + col);
                float4 o; o.x = v[c].x * rs * g.x; o.y = v[c].y * rs * g.y; o.z = v[c].z * rs * g.z; o.w = v[c].w * rs * g.w;
                *(float4*)(p.out + (size_t)row * DM + col) = o;
            } else {
                const float4 g = *(const float4*)(p.g_mix + layer * DM + col);
                const float4 sh = *(const float4*)(mod + ((size_t)layer * 9 + s) * 6144 + 0 * 1024 + col);
                const float4 sc = *(const float4*)(mod + ((size_t)layer * 9 + s) * 6144 + 1 * 1024 + col);
                const float o0 = v[c].x * rs * g.x * (1.f + sc.x) + sh.x, o1 = v[c].y * rs * g.y * (1.f + sc.y) + sh.y;
                const float o2 = v[c].z * rs * g.z * (1.f + sc.z) + sh.z, o3 = v[c].w * rs * g.w * (1.f + sc.w) + sh.w;
                *(uint2*)(H + (size_t)row * DM + col) = make_uint2(pack2(o0, o1), pack2(o2, o3));
            }
        }
    }
}

#define GLDS(gp, lp) __builtin_amdgcn_global_load_lds((const unsigned*)(gp), (__attribute__((address_space(3))) unsigned*)(lp), 16, 0, 0)
template <class FA, class FB, class FE>
__device__ __forceinline__ void gemm_tile(FA arow, FB brow, int K, FE epi, char* smem) {
    int tid = threadIdx.x; asm volatile("" : "+v"(tid));
    const int lane = tid & 63, wid = tid >> 6, wr = wid >> 1, wc = wid & 1, fr = lane & 15, fq = lane >> 4;
    const int lrow = tid >> 3, lch = ((tid & 7) ^ ((tid >> 4) & 7)) * 8;
    const bfu* ga0 = arow(lrow) + lch; const bfu* ga1 = arow(lrow + 32) + lch; const bfu* ga2 = arow(lrow + 64) + lch; const bfu* ga3 = arow(lrow + 96) + lch;
    const bfu* gb0 = brow(lrow) + lch; const bfu* gb1 = brow(lrow + 32) + lch; const bfu* gb2 = brow(lrow + 64) + lch; const bfu* gb3 = brow(lrow + 96) + lch;
    f32x4 acc[4][4];
#pragma unroll
    for (int m = 0; m < 4; ++m)
#pragma unroll
        for (int n = 0; n < 4; ++n) acc[m][n] = (f32x4){0.f, 0.f, 0.f, 0.f};
    char* lds0 = smem + tid * 16;
#define GEMM_ISSUE(kt_) { char* d_ = lds0 + ((kt_) & 1) * 32768; const int ko_ = (kt_) * 64; \
        GLDS(ga0 + ko_, d_); GLDS(ga1 + ko_, d_ + 4096); GLDS(ga2 + ko_, d_ + 8192); GLDS(ga3 + ko_, d_ + 12288); \
        GLDS(gb0 + ko_, d_ + 16384); GLDS(gb1 + ko_, d_ + 20480); GLDS(gb2 + ko_, d_ + 24576); GLDS(gb3 + ko_, d_ + 28672); }
    __syncthreads();
    GEMM_ISSUE(0)
    const int nk = K >> 6;
    const int swA = ((wr * 64 + fr) >> 1) & 7, swB = ((wc * 64 + fr) >> 1) & 7;
    const int offA = (wr * 64 + fr) * 128, offB = 16384 + (wc * 64 + fr) * 128;
    for (int kt = 0; kt < nk; ++kt) {
        asm volatile("s_waitcnt vmcnt(0)" ::: "memory");
        __syncthreads();
        if (kt + 1 < nk) GEMM_ISSUE(kt + 1)
        const char* st = smem + (kt & 1) * 32768;
#pragma unroll
        for (int kk = 0; kk < 2; ++kk) {
            bf16x8 af[4], bfr[4];
#pragma unroll
            for (int m = 0; m < 4; ++m) af[m] = *(const bf16x8*)(st + offA + m * 2048 + (((kk * 4 + fq) ^ swA) * 16));
#pragma unroll
            for (int n = 0; n < 4; ++n) bfr[n] = *(const bf16x8*)(st + offB + n * 2048 + (((kk * 4 + fq) ^ swB) * 16));
#pragma unroll
            for (int m = 0; m < 4; ++m)
#pragma unroll
                for (int n = 0; n < 4; ++n) acc[m][n] = __builtin_amdgcn_mfma_f32_16x16x32_bf16(af[m], bfr[n], acc[m][n], 0, 0, 0);
        }
    }
    __syncthreads();
    epi(acc, wr, wc, fr, fq);
}
#define ACC_FOREACH(...)                                                                      \
    _Pragma("unroll") for (int m_ = 0; m_ < 4; ++m_) _Pragma("unroll") for (int n_ = 0; n_ < 4; ++n_) \
    _Pragma("unroll") for (int j_ = 0; j_ < 4; ++j_) {                                        \
        const int row = wr * 64 + m_ * 16 + fq * 4 + j_; const int col = wc * 64 + n_ * 16 + fr; const float val = acc[m_][n_][j_]; __VA_ARGS__ }

__device__ void phase_inproj(const P& p, int layer, int bid, int nb, char* smem) {
    PHASE_PROLOGUE
    const bfu* H = (const bfu*)(ws_ + WS_H); const bfu* W = (const bfu*)(ws_ + WS_WIN);
    float* Cs = (float*)smem;
    const float* TA = (const float*)(ws_ + WS_ROPE); const float* TB = TA + 64 * 16 * 2;
    const int nitems = 144 * 25;
    for (int it = bid; it < nitems; it += nb) {
        const int mt = it / 25, nt = it % 25;
        const int row0 = mt * 128, col0 = nt * 128;
        gemm_tile([&](int r) { return H + (size_t)(row0 + r) * DM; }, [&](int r) { return W + (size_t)(col0 + r) * DM; }, DM,
            [&](f32x4 (&acc)[4][4], int wr, int wc, int fr, int fq) {
                ACC_FOREACH(Cs[row * 132 + col] = val;)
            }, smem);
        __syncthreads();
        const int tid = tid_;
        int b, j0, s; row_info(row0, b, j0, s);
        const bool lat = row0 < ML;
        if (nt <= 2) {
            const int r = tid & 127, hl = tid >> 7;
            const bool isq = nt < 2;
            const float* gain = (isq ? p.a_q_gain : p.a_k_gain) + layer * 64;
            float v[64]; float ss = 0.f;
#pragma unroll
            for (int d4 = 0; d4 < 16; ++d4) { const float4 t4 = *(const float4*)(Cs + r * 132 + hl * 64 + d4 * 4); v[d4 * 4] = t4.x; v[d4 * 4 + 1] = t4.y; v[d4 * 4 + 2] = t4.z; v[d4 * 4 + 3] = t4.w; ss += t4.x * t4.x + t4.y * t4.y + t4.z * t4.z + t4.w * t4.w; }
            const float rs = rsqrtf(ss * (1.f / 64.f) + 1e-6f);
#pragma unroll
            for (int d = 0; d < 64; ++d) v[d] = v[d] * rs * gain[d];
            if (lat) {
                const int t = (j0 - 256) + r;
#pragma unroll
                for (int a = 0; a < 2; ++a) {
                    const int pos = a == 0 ? (t >> 6) : (t & 63);
#pragma unroll
                    for (int f = 0; f < 16; ++f) {
                        const float cs = TA[(pos * 16 + f) * 2], sn = TA[(pos * 16 + f) * 2 + 1];
                        const float x0 = v[a * 32 + f], x1 = v[a * 32 + 16 + f];
                        v[a * 32 + f] = x0 * cs - x1 * sn; v[a * 32 + 16 + f] = x1 * cs + x0 * sn;
                    }
                }
            }
            const float qs = isq ? 0.125f * LOG2E : 1.f;
            bfu* dst = isq ? (bfu*)(ws_ + WS_QA) + (((size_t)b * 4 + (nt * 2 + hl)) * NKEY + j0 + r) * 64
                           : (bfu*)(ws_ + WS_KA) + (((size_t)b * 2 + hl) * NKEY + j0 + r) * 64;
#pragma unroll
            for (int d8 = 0; d8 < 8; ++d8)
                ((uint4*)dst)[d8] = make_uint4(pack2(v[d8 * 8] * qs, v[d8 * 8 + 1] * qs), pack2(v[d8 * 8 + 2] * qs, v[d8 * 8 + 3] * qs),
                                               pack2(v[d8 * 8 + 4] * qs, v[d8 * 8 + 5] * qs), pack2(v[d8 * 8 + 6] * qs, v[d8 * 8 + 7] * qs));
        } else if (nt == 3 || nt == 8 || nt == 9) {
            const int c = tid & 127, half = tid >> 7, hl = c >> 6, d = c & 63;
            bfu* dst = nt == 3 ? (bfu*)(ws_ + WS_VAT) + (((size_t)b * 2 + hl) * 64 + d) * NKEY + j0 + half * 64
                               : (bfu*)(ws_ + WS_VBT) + (((size_t)b * 4 + ((nt - 8) * 2 + hl)) * 64 + d) * NKEY + j0 + half * 64;
#pragma unroll
            for (int r8 = 0; r8 < 8; ++r8) {
                const float* s0 = Cs + (half * 64 + r8 * 8) * 132 + c;
                ((uint4*)dst)[r8] = make_uint4(pack2(s0[0], s0[132]), pack2(s0[2 * 132], s0[3 * 132]), pack2(s0[4 * 132], s0[5 * 132]), pack2(s0[6 * 132], s0[7 * 132]));
            }
        } else if (nt <= 7) {
            const bool isq = nt < 6;
            const int hbase = ((nt - 4) & 1) * 2;
#pragma unroll
            for (int itq = 0; itq < 2; ++itq) {
                const int u = tid + 256 * itq, r = u & 127, hm = u >> 7;
                float v[32];
#pragma unroll
                for (int d4 = 0; d4 < 8; ++d4) { const float4 t4 = *(const float4*)(Cs + r * 132 + hm * 32 + d4 * 4); v[d4 * 4] = t4.x; v[d4 * 4 + 1] = t4.y; v[d4 * 4 + 2] = t4.z; v[d4 * 4 + 3] = t4.w; }
                if (lat) {
                    const int t = (j0 - 256) + r;
#pragma unroll
                    for (int a = 0; a < 2; ++a) {
                        const int pos = a == 0 ? (t >> 6) : (t & 63);
#pragma unroll
                        for (int f = 0; f < 8; ++f) {
                            const float cs = TB[(pos * 8 + f) * 2], sn = TB[(pos * 8 + f) * 2 + 1];
                            const float x0 = v[a * 16 + f], x1 = v[a * 16 + 8 + f];
                            v[a * 16 + f] = x0 * cs - x1 * sn; v[a * 16 + 8 + f] = x1 * cs + x0 * sn;
                        }
                    }
                }
                const float qs = isq ? 0.17677669529663687f * LOG2E : 1.f;
                const int h = hbase + (hm >> 1), mp = hm & 1;
                bfu* dst = (bfu*)(ws_ + (isq ? WS_QB : WS_KB)) + (((size_t)b * 4 + h) * NKEY + j0 + r) * 64 + mp * 32;
#pragma unroll
                for (int d8 = 0; d8 < 4; ++d8)
                    ((uint4*)dst)[d8] = make_uint4(pack2(v[d8 * 8] * qs, v[d8 * 8 + 1] * qs), pack2(v[d8 * 8 + 2] * qs, v[d8 * 8 + 3] * qs),
                                                   pack2(v[d8 * 8 + 4] * qs, v[d8 * 8 + 5] * qs), pack2(v[d8 * 8 + 6] * qs, v[d8 * 8 + 7] * qs));
            }
        } else {
            const int r = tid & 127, half = tid >> 7;
            float* dst = (float*)(ws_ + WS_CP) + (size_t)(row0 + r) * CSL + (nt - 10) * 128 + half * 64;
#pragma unroll
            for (int d4 = 0; d4 < 16; ++d4) ((float4*)dst)[d4] = *(const float4*)(Cs + r * 132 + half * 64 + d4 * 4);
        }
        __syncthreads();
    }
}

__device__ void phase_gate(const P& p, int layer, int bid, int nb, char* smem) {
    PHASE_PROLOGUE
    const bfu* LXG = (const bfu*)(ws_ + WS_LXG); const bfu* Bt = (const bfu*)(ws_ + WS_LG2);
    float* GG = (float*)(ws_ + WS_GG);
    const int nitems = 144 * 4;
    for (int it = bid; it < nitems; it += nb) {
        const int mt = it >> 2, nt = it & 3, row0 = mt * 128, col0 = nt * 128;
        gemm_tile([&](int r) { return LXG + (size_t)(row0 + r) * 128; }, [&](int r) { return Bt + (size_t)(col0 + r) * 128; }, 128,
            [&](f32x4 (&acc)[4][4], int wr, int wc, int fr, int fq) {
                ACC_FOREACH(GG[(size_t)(row0 + row) * 512 + col0 + col] = val;)
            }, smem);
    }
}

#define OPS_AT 0
#define OPS_RT 2048
#define OPS_MAK 4096
#define OPS_T 5120
#define OPS_MRBK 6144
#define OPS_BK 7168
#define OPS_VF 11264
#define OPS_WC 13312
__device__ __forceinline__ char* ops_rec(char* ws_, int z, int seq, int c) { return ws_ + WS_OPS + ((size_t)(z * 64 + seq) * 144 + c) * OPS_REC; }
__device__ __forceinline__ float rdlane(float v, int l) { return __int_as_float(__builtin_amdgcn_readlane(__float_as_int(v), l)); }

__device__ __forceinline__ void chunk_tail(const float (&lw)[16], const float (&kk)[16], const float (&rr)[16], const float (&bb)[16], const float (&kd)[16], const float (&vv)[16],
                                           char* Lw, char* rec, int lane) {
    const int cl = lane & 15, g = lane >> 4;
    float Bt[16], Kt[16];
    float cum = 0.f, ep = 1.f;
#pragma unroll
    for (int t = 0; t < 16; ++t) {
        cum += lw[t];
        const float e = __expf(cum), ei = __expf(-cum);
        *(bfu*)(Lw + 0 + t * 128 + lane * 2) = f2bf(-kk[t] * ep);
        *(bfu*)(Lw + 2048 + t * 128 + lane * 2) = f2bf(rr[t] * e);
        Bt[t] = bb[t] * ei; Kt[t] = kd[t] * ei;
        *(bfu*)(Lw + 4096 + t * 128 + lane * 2) = f2bf(Bt[t]);
        *(bfu*)(Lw + 6144 + t * 128 + lane * 2) = f2bf(Kt[t]);
        ep = e;
    }
    const float eC = ep;
#pragma unroll
    for (int q = 0; q < 4; ++q) {
        *(uint4*)(rec + OPS_BK + ((lane >> 4) * 64 + cl + 16 * q) * 16) =
            make_uint4(pack2(Bt[4 * q] * eC, Bt[4 * q + 1] * eC), pack2(Bt[4 * q + 2] * eC, Bt[4 * q + 3] * eC), pack2(Kt[4 * q] * eC, Kt[4 * q + 1] * eC), pack2(Kt[4 * q + 2] * eC, Kt[4 * q + 3] * eC));
        *(uint2*)(rec + OPS_VF + ((lane >> 4) * 64 + cl + 16 * q) * 8) = make_uint2(pack2(vv[4 * q], vv[4 * q + 1]), pack2(vv[4 * q + 2], vv[4 * q + 3]));
    }
    *(float*)(rec + OPS_WC + lane * 4) = eC;
    f32x4 Mab = {0.f, 0.f, 0.f, 0.f}, Mak = Mab, Mrb = Mab, Mrk = Mab;
#pragma unroll
    for (int ks = 0; ks < 2; ++ks) {
        const int fo = cl * 128 + ks * 64 + g * 16;
        const bf16x8 aA = *(const bf16x8*)(Lw + 0 + fo), aR = *(const bf16x8*)(Lw + 2048 + fo), bB = *(const bf16x8*)(Lw + 4096 + fo), bK = *(const bf16x8*)(Lw + 6144 + fo);
        Mab = __builtin_amdgcn_mfma_f32_16x16x32_bf16(aA, bB, Mab, 0, 0, 0);
        Mak = __builtin_amdgcn_mfma_f32_16x16x32_bf16(aA, bK, Mak, 0, 0, 0);
        Mrb = __builtin_amdgcn_mfma_f32_16x16x32_bf16(aR, bB, Mrb, 0, 0, 0);
        Mrk = __builtin_amdgcn_mfma_f32_16x16x32_bf16(aR, bK, Mrk, 0, 0, 0);
    }
#pragma unroll
    for (int q = 0; q < 4; ++q) *(uint4*)(rec + OPS_AT + (lane + 64 * q) * 16) = *(const uint4*)(Lw + (lane + 64 * q) * 16);
#pragma unroll
    for (int q = 0; q < 4; ++q) {
        const int tau = 4 * g + q;
        if (!(cl < tau)) { Mab[q] = 0.f; Mak[q] = 0.f; }
        if (!(cl <= tau)) { Mrb[q] = 0.f; Mrk[q] = 0.f; }
    }
    float Tc[16];
#pragma unroll
    for (int t = 0; t < 16; ++t) {
        float acc = (t == cl) ? 1.f : 0.f;
#pragma unroll
        for (int j = 0; j < t; ++j) acc += rdlane(Mab[t & 3], j + 16 * (t >> 2)) * Tc[j];
        Tc[t] = acc;
    }
#pragma unroll
    for (int q = 0; q < 4; ++q) {
        const int tau = 4 * g + q;
        *(bfu*)(Lw + 8192 + tau * 32 + cl * 2) = f2bf(Mak[q]);
        *(bfu*)(Lw + 9216 + tau * 32 + cl * 2) = f2bf(Mrb[q]);
        *(bfu*)(Lw + 9728 + tau * 32 + cl * 2) = f2bf(Mrk[q]);
    }
    if (g == 0) {
#pragma unroll
        for (int t = 0; t < 16; ++t) *(bfu*)(Lw + 8704 + t * 32 + cl * 2) = f2bf(Tc[t]);
    }
    const uint2 fmak = *(const uint2*)(Lw + 8192 + cl * 32 + g * 8), ft = *(const uint2*)(Lw + 8704 + cl * 32 + g * 8);
    const uint2 fmrb = *(const uint2*)(Lw + 9216 + cl * 32 + g * 8), fmrk = *(const uint2*)(Lw + 9728 + cl * 32 + g * 8);
    *(uint4*)(rec + OPS_MAK + lane * 16) = make_uint4(fmak.x, fmak.y, 0u, 0u);
    *(uint4*)(rec + OPS_T + lane * 16) = make_uint4(ft.x, ft.y, 0u, 0u);
    *(uint4*)(rec + OPS_MRBK + lane * 16) = make_uint4(fmrb.x, fmrb.y, fmrk.x, fmrk.y);
}

__device__ __forceinline__ float sum64(float v) { v = sum8(v); v += dppf<0x140>(v); return (rdlane(v, 0) + rdlane(v, 16)) + (rdlane(v, 32) + rdlane(v, 48)); }
__device__ void phase_rk(const P& p, int layer, int bid, int nb, char* smem) {
    PHASE_PROLOGUE
    const int lane = tid_ & 63, wv = tid_ >> 6, cl = lane & 15, g = lane >> 4;
    char* Lw = smem + wv * 16384;
    const float* CP = (const float*)(ws_ + WS_CP);
    const float* mu = p.c_mu + layer * CSL;
    for (int it = bid * 4 + wv; it < 2 * 64 * 144; it += nb * 4) {
        const int c = it % 144, seq = (it / 144) & 63, z = it / (144 * 64), b = seq >> 3, h = seq & 7;
        const int grow0 = c < 16 ? ML + b * 256 + 16 * c : b * 2048 + 16 * (c - 16);
        const bool sstart = (c == 0 || c == 16), send = (c == 15 || c == 143);
        auto shifted = [&](int col, float (&out)[16]) {
            float P_[18];
#pragma unroll
            for (int q = 0; q < 18; ++q) {
                const int tau = q - 1, nat = z ? 15 - tau : tau;
                const bool ok = (nat >= 0 || !sstart) && (nat <= 15 || !send);
                P_[q] = ok ? CP[(size_t)(grow0 + nat) * CSL + col] : 0.f;
            }
            const float m = mu[col];
#pragma unroll
            for (int t = 0; t < 16; ++t) out[t] = P_[t + 1] + m * (0.5f * (P_[t] + P_[t + 2]) - P_[t + 1]);
        };
        float tmp[16], rr[16], kr[16], vv[16];
        shifted(1536 + z * 64 + lane, tmp);
#pragma unroll
        for (int t = 0; t < 16; ++t) *(bfu*)(Lw + 10240 + t * 128 + lane * 2) = f2bf(tanhf(tmp[t]));
        shifted(1664 + z * 64 + lane, tmp);
#pragma unroll
        for (int t = 0; t < 16; ++t) *(bfu*)(Lw + 12288 + t * 128 + lane * 2) = f2bf(tmp[t]);
        if (z == 0 && lane < 16) {
            shifted(1792 + h * 16 + lane, tmp);
            bfu* LXG = (bfu*)(ws_ + WS_LXG);
#pragma unroll
            for (int t = 0; t < 16; ++t) LXG[(size_t)(grow0 + t) * 128 + h * 16 + lane] = f2bf(sigmoidf_(tmp[t]));
        }
        shifted(h * 64 + lane, rr);
        shifted(512 + h * 64 + lane, kr);
        shifted(1024 + h * 64 + lane, vv);
        const bfu* W2 = (const bfu*)(ws_ + WS_LW2) + ((size_t)z * 512 + h * 64) * 64;
        const bfu* A2 = (const bfu*)(ws_ + WS_LA2) + ((size_t)z * 512 + h * 64) * 64;
        float prew[16], prea[16];
#pragma unroll
        for (int which = 0; which < 2; ++which) {
            const bfu* Wm = which ? A2 : W2; const char* Xs = Lw + (which ? 12288 : 10240);
            f32x4 ac[4];
#pragma unroll
            for (int n = 0; n < 4; ++n) ac[n] = (f32x4){0.f, 0.f, 0.f, 0.f};
#pragma unroll
            for (int ks = 0; ks < 2; ++ks) {
                const bf16x8 af = *(const bf16x8*)(Xs + cl * 128 + ks * 64 + g * 16);
#pragma unroll
                for (int n = 0; n < 4; ++n) {
                    const bf16x8 bf = *(const bf16x8*)(Wm + (size_t)(16 * n + cl) * 64 + ks * 32 + g * 8);
                    ac[n] = __builtin_amdgcn_mfma_f32_16x16x32_bf16(af, bf, ac[n], 0, 0, 0);
                }
            }
#pragma unroll
            for (int n = 0; n < 4; ++n)
#pragma unroll
                for (int q = 0; q < 4; ++q) *(float*)(Lw + (4 * g + q) * 256 + (16 * n + cl) * 4) = ac[n][q];
#pragma unroll
            for (int t = 0; t < 16; ++t) { const float x = *(const float*)(Lw + t * 256 + lane * 4); if (which) prea[t] = x; else prew[t] = x; }
        }
        const int ch = h * 64 + lane;
        const float w0v = p.c_w0[((size_t)layer * 2 + z) * 512 + ch], a0v = p.c_a0[((size_t)layer * 2 + z) * 512 + ch];
        const float kkv = p.c_k_k[layer * 512 + ch], kav = p.c_k_a[layer * 512 + ch], rkv = p.c_r_k[layer * 512 + ch];
        float lw[16], kk[16], bb[16];
        float* BETA = (float*)(ws_ + WS_BETA) + (size_t)z * MA * 8;
#pragma unroll
        for (int t = 0; t < 16; ++t) {
            const float nx = -(w0v + prew[t]);
            const float sp = nx > 20.f ? nx : log1pf(__expf(nx));
            lw[t] = -__expf(-sp - 0.5f);
            const float icl = sigmoidf_(a0v + prea[t]);
            const float kv = kr[t] * kkv;
            const float ss = sum64(kv * kv);
            kk[t] = kv / fmaxf(sqrtf(ss), 1e-12f);
            kr[t] = kr[t] * (1.f + (icl - 1.f) * kav);
            bb[t] = kk[t] * icl;
            const float bs = sum64(rr[t] * kr[t] * rkv);
            const int nat = z ? 15 - t : t;
            if (lane == 0) BETA[(size_t)(grow0 + nat) * 8 + h] = bs;
        }
        if (z == 0) {
            bfu* VB = (bfu*)(ws_ + WS_VB);
#pragma unroll
            for (int t = 0; t < 16; ++t) VB[(size_t)(grow0 + t) * 512 + ch] = f2bf(vv[t]);
        }
        chunk_tail(lw, kk, rr, bb, kr, vv, Lw, ops_rec(ws_, z, seq, c), lane);
    }
}

struct R4Ops { uint2 at[2][2], rt[2][2]; uint4 mak, tt, mrbk, bk[4]; uint2 vf; float4 wc[4]; };
__device__ __forceinline__ void r4_load(R4Ops& o, const char* rec, int lane, int vt) {
    const int cl = lane & 15, g = lane >> 4;
#pragma unroll
    for (int ks = 0; ks < 2; ++ks) {
        o.at[ks][0] = *(const uint2*)(rec + OPS_AT + cl * 128 + (32 * ks + 4 * g) * 2); o.at[ks][1] = *(const uint2*)(rec + OPS_AT + cl * 128 + (32 * ks + 16 + 4 * g) * 2);
        o.rt[ks][0] = *(const uint2*)(rec + OPS_RT + cl * 128 + (32 * ks + 4 * g) * 2); o.rt[ks][1] = *(const uint2*)(rec + OPS_RT + cl * 128 + (32 * ks + 16 + 4 * g) * 2);
    }
    o.mak = *(const uint4*)(rec + OPS_MAK + lane * 16); o.tt = *(const uint4*)(rec + OPS_T + lane * 16); o.mrbk = *(const uint4*)(rec + OPS_MRBK + lane * 16);
#pragma unroll
    for (int kt = 0; kt < 4; ++kt) { o.bk[kt] = *(const uint4*)(rec + OPS_BK + (kt * 64 + lane) * 16); o.wc[kt] = *(const float4*)(rec + OPS_WC + (16 * kt + 4 * g) * 4); }
    o.vf = *(const uint2*)(rec + OPS_VF + (vt * 64 + lane) * 8);
}
__device__ __forceinline__ bf16x8 mk8(unsigned a, unsigned b, unsigned c, unsigned d) { union { bf16x8 v; unsigned u[4]; } x; x.u[0] = a; x.u[1] = b; x.u[2] = c; x.u[3] = d; return x.v; }
__device__ void phase_r4(const P& p, int layer, int bid, int nb, char* smem) {
    PHASE_PROLOGUE
    const int lane = tid_ & 63, vt = tid_ >> 6, cl = lane & 15, g = lane >> 4;
    for (int it = bid; it < 128; it += nb) {
        const int z = it >> 6, seq = it & 63;
        float* Y = (float*)(ws_ + WS_YS) + (size_t)z * (HEADARR / 4) + (size_t)seq * NKEY * 64;
        f32x4 acc[4];
#pragma unroll
        for (int kt = 0; kt < 4; ++kt) acc[kt] = (f32x4){0.f, 0.f, 0.f, 0.f};
        R4Ops cur, nxt;
        auto chunk_of = [&](int ci) { return z ? (ci < 16 ? 15 - ci : 143 - (ci - 16)) : ci; };
        r4_load(cur, ops_rec(ws_, z, seq, chunk_of(0)), lane, vt);
        for (int ci = 0; ci < 144; ++ci) {
            const int c = chunk_of(ci);
            if (ci + 1 < 144) r4_load(nxt, ops_rec(ws_, z, seq, chunk_of(ci + 1)), lane, vt);
            const f32x4 zero4 = {0.f, 0.f, 0.f, 0.f};
            bf16x8 sb[2];
#pragma unroll
            for (int ks = 0; ks < 2; ++ks)
                sb[ks] = mk8(pack2(acc[2 * ks][0], acc[2 * ks][1]), pack2(acc[2 * ks][2], acc[2 * ks][3]), pack2(acc[2 * ks + 1][0], acc[2 * ks + 1][1]), pack2(acc[2 * ks + 1][2], acc[2 * ks + 1][3]));
            f32x4 Z = __builtin_amdgcn_mfma_f32_16x16x32_bf16(mk8(cur.at[0][0].x, cur.at[0][0].y, cur.at[0][1].x, cur.at[0][1].y), sb[0], zero4, 0, 0, 0);
            Z = __builtin_amdgcn_mfma_f32_16x16x32_bf16(mk8(cur.at[1][0].x, cur.at[1][0].y, cur.at[1][1].x, cur.at[1][1].y), sb[1], Z, 0, 0, 0);
            Z = __builtin_amdgcn_mfma_f32_16x16x32_bf16(mk8(cur.mak.x, cur.mak.y, cur.mak.z, cur.mak.w), mk8(cur.vf.x, cur.vf.y, 0u, 0u), Z, 0, 0, 0);
            f32x4 Yv = __builtin_amdgcn_mfma_f32_16x16x32_bf16(mk8(cur.rt[0][0].x, cur.rt[0][0].y, cur.rt[0][1].x, cur.rt[0][1].y), sb[0], zero4, 0, 0, 0);
            Yv = __builtin_amdgcn_mfma_f32_16x16x32_bf16(mk8(cur.rt[1][0].x, cur.rt[1][0].y, cur.rt[1][1].x, cur.rt[1][1].y), sb[1], Yv, 0, 0, 0);
            const f32x4 U = __builtin_amdgcn_mfma_f32_16x16x32_bf16(mk8(cur.tt.x, cur.tt.y, cur.tt.z, cur.tt.w), mk8(pack2(Z[0], Z[1]), pack2(Z[2], Z[3]), 0u, 0u), zero4, 0, 0, 0);
            const bf16x8 ub = mk8(pack2(U[0], U[1]), pack2(U[2], U[3]), cur.vf.x, cur.vf.y);
            Yv = __builtin_amdgcn_mfma_f32_16x16x32_bf16(mk8(cur.mrbk.x, cur.mrbk.y, cur.mrbk.z, cur.mrbk.w), ub, Yv, 0, 0, 0);
#pragma unroll
            for (int kt = 0; kt < 4; ++kt) {
                f32x4 a = acc[kt];
                a[0] *= cur.wc[kt].x; a[1] *= cur.wc[kt].y; a[2] *= cur.wc[kt].z; a[3] *= cur.wc[kt].w;
                acc[kt] = __builtin_amdgcn_mfma_f32_16x16x32_bf16(mk8(cur.bk[kt].x, cur.bk[kt].y, cur.bk[kt].z, cur.bk[kt].w), ub, a, 0, 0, 0);
            }
#pragma unroll
            for (int q = 0; q < 4; ++q) {
                const int tau = 4 * g + q, t = z ? 15 - tau : tau;
                Y[(size_t)(16 * c + t) * 64 + vt * 16 + cl] = Yv[q];
            }
            cur = nxt;
        }
    }
}

__device__ void phase_readout(const P& p, int layer, int nrows, int bid, int nb) {
    PHASE_PROLOGUE
    const float* Y0 = (const float*)(ws_ + WS_YS); const float* Y1 = Y0 + HEADARR / 4;
    const bfu* VB = (const bfu*)(ws_ + WS_VB); const float* B0 = (const float*)(ws_ + WS_BETA); const float* B1 = B0 + (size_t)MA * 8;
    const float* GG = (const float*)(ws_ + WS_GG);
    bfu* MIX = (bfu*)(ws_ + WS_MIX);
    const float* lnw = p.c_ln_w + layer * 512; const float* lnb = p.c_ln_b + layer * 512;
    const int lane = tid_ & 63, wv = tid_ >> 6;
    for (int row = bid * 4 + wv; row < nrows; row += nb * 4) {
        int b, j, s; row_info(row, b, j, s);
#pragma unroll
        for (int h = 0; h < 8; ++h) {
            const size_t o = (((size_t)b * 8 + h) * NKEY + j) * 64 + lane;
            const float y = Y0[o] + Y1[o];
            const float mean = sum64(y) * (1.f / 64.f);
            const float dv = y - mean;
            const float var = sum64(dv * dv) * (1.f / 64.f);
            const float yn = dv * rsqrtf(var + 64e-5f) * lnw[h * 64 + lane] + lnb[h * 64 + lane];
            const float bs = B0[(size_t)row * 8 + h] + B1[(size_t)row * 8 + h];
            const float outv = (yn + bs * bf2f(VB[(size_t)row * 512 + h * 64 + lane])) * GG[(size_t)row * 512 + h * 64 + lane];
            MIX[(size_t)row * DM + 512 + h * 64 + lane] = f2bf(outv);
        }
    }
}

using f32x16 = __attribute__((ext_vector_type(16))) float;
#define AT_KBYTES 8192
#define AT_VSTRIDE 136
#define AT_VBYTES (64 * AT_VSTRIDE)
template <int GRP>
__device__ __forceinline__ void attn_item(const P& p, char* ws_, int layer, int b, int h, int qb, int nkeys, float lam, float lam_init, char* smem, int tid) {
    constexpr int KS = GRP ? 2 : 4;
    const int lane = tid & 63, wv = tid >> 6, r32 = lane & 31, hh = lane >> 5;
    const int mp = GRP ? (wv >> 1) : 0, sub = GRP ? (wv & 1) : wv;
    const int jq = qb * (GRP ? 64 : 128) + sub * 32 + r32;
    const bfu* Qg = (const bfu*)(ws_ + (GRP ? WS_QB : WS_QA)) + (((size_t)b * 4 + h) * NKEY + jq) * 64 + mp * 32;
    const bfu* Kg = GRP ? (const bfu*)(ws_ + WS_KB) + ((size_t)b * 4 + h) * NKEY * 64 : (const bfu*)(ws_ + WS_KA) + ((size_t)b * 2 + (h >> 1)) * NKEY * 64;
    const bfu* Vg = GRP ? (const bfu*)(ws_ + WS_VBT) + ((size_t)b * 4 + h) * 64 * NKEY : (const bfu*)(ws_ + WS_VAT) + ((size_t)b * 2 + (h >> 1)) * 64 * NKEY;
    bf16x8 qf[KS];
#pragma unroll
    for (int ks = 0; ks < KS; ++ks) qf[ks] = *(const bf16x8*)(Qg + ks * 16 + hh * 8);
    f32x16 oacc[2];
    float mrun = -1e30f, lrun = 0.f;
#pragma unroll
    for (int db = 0; db < 2; ++db)
#pragma unroll
        for (int i = 0; i < 16; ++i) oacc[db][i] = 0.f;
    const int lk0 = tid >> 3, lc = tid & 7;
    const bfu* kp0 = Kg + (size_t)lk0 * 64 + lc * 8; const bfu* kp1 = kp0 + 32 * 64;
    const bfu* vp0 = Vg + (size_t)lk0 * NKEY + lc * 8; const bfu* vp1 = vp0 + (size_t)32 * NKEY;
    const int ks0 = lk0 * 128 + ((lc ^ ((lk0 >> 1) & 7)) * 16), ks1 = (lk0 + 32) * 128 + ((lc ^ (((lk0 + 32) >> 1) & 7)) * 16);
    const int vs0 = lk0 * AT_VSTRIDE + lc * 16, vs1 = (lk0 + 32) * AT_VSTRIDE + lc * 16;
    char* sK = smem; char* sV = smem + 2 * AT_KBYTES;
    uint4 rk0 = *(const uint4*)kp0, rk1 = *(const uint4*)kp1, rv0 = *(const uint4*)vp0, rv1 = *(const uint4*)vp1;
    __syncthreads();
    *(uint4*)(sK + ks0) = rk0; *(uint4*)(sK + ks1) = rk1;
    *(uint2*)(sV + vs0) = make_uint2(rv0.x, rv0.y); *(uint2*)(sV + vs0 + 8) = make_uint2(rv0.z, rv0.w);
    *(uint2*)(sV + vs1) = make_uint2(rv1.x, rv1.y); *(uint2*)(sV + vs1 + 8) = make_uint2(rv1.z, rv1.w);
    __syncthreads();
    const int nt = nkeys >> 6;
    for (int t = 0; t < nt; ++t) {
        if (t + 1 < nt) {
            const size_t ko = (size_t)(t + 1) * 64 * 64; const int vo = (t + 1) * 64;
            rk0 = *(const uint4*)(kp0 + ko); rk1 = *(const uint4*)(kp1 + ko); rv0 = *(const uint4*)(vp0 + vo); rv1 = *(const uint4*)(vp1 + vo);
        }
        const char* cK = sK + (t & 1) * AT_KBYTES; const char* cV = sV + (t & 1) * AT_VBYTES;
        f32x16 sacc[2];
#pragma unroll
        for (int kb = 0; kb < 2; ++kb) {
#pragma unroll
            for (int i = 0; i < 16; ++i) sacc[kb][i] = 0.f;
            const int key = kb * 32 + r32;
#pragma unroll
            for (int ks = 0; ks < KS; ++ks) {
                const int c0 = mp * 4 + ks * 2 + hh;
                const bf16x8 kf = *(const bf16x8*)(cK + key * 128 + ((c0 ^ ((key >> 1) & 7)) * 16));
                sacc[kb] = __builtin_amdgcn_mfma_f32_32x32x16_bf16(kf, qf[ks], sacc[kb], 0, 0, 0);
            }
        }
        float mx = sacc[0][0];
#pragma unroll
        for (int i = 1; i < 16; ++i) mx = fmaxf(mx, sacc[0][i]);
#pragma unroll
        for (int i = 0; i < 16; ++i) mx = fmaxf(mx, sacc[1][i]);
        mx = fmaxf(mx, __shfl_xor(mx, 32));
        const float mnew = fmaxf(mrun, mx);
        const float alpha = __builtin_amdgcn_exp2f(mrun - mnew);
        mrun = mnew;
        float ps = 0.f;
#pragma unroll
        for (int kb = 0; kb < 2; ++kb)
#pragma unroll
            for (int i = 0; i < 16; ++i) { const float pv = __builtin_amdgcn_exp2f(sacc[kb][i] - mnew); sacc[kb][i] = pv; ps += pv; }
        lrun = lrun * alpha + ps;
#pragma unroll
        for (int db = 0; db < 2; ++db)
#pragma unroll
            for (int i = 0; i < 16; ++i) oacc[db][i] *= alpha;
#pragma unroll
        for (int kb = 0; kb < 2; ++kb)
#pragma unroll
            for (int s2 = 0; s2 < 2; ++s2) {
                union { bf16x8 v; unsigned u[4]; } pf;
#pragma unroll
                for (int i = 0; i < 4; ++i) pf.u[i] = pack2(sacc[kb][8 * s2 + 2 * i], sacc[kb][8 * s2 + 2 * i + 1]);
#pragma unroll
                for (int db = 0; db < 2; ++db) {
                    const char* vr = cV + (db * 32 + r32) * AT_VSTRIDE + (kb * 32 + s2 * 16 + hh * 4) * 2;
                    union { bf16x8 v; uint2 u[2]; } vf;
                    vf.u[0] = *(const uint2*)vr; vf.u[1] = *(const uint2*)(vr + 16);
                    oacc[db] = __builtin_amdgcn_mfma_f32_32x32x16_bf16(vf.v, pf.v, oacc[db], 0, 0, 0);
                }
            }
        if (t + 1 < nt) {
            char* nK = sK + ((t + 1) & 1) * AT_KBYTES; char* nV = sV + ((t + 1) & 1) * AT_VBYTES;
            *(uint4*)(nK + ks0) = rk0; *(uint4*)(nK + ks1) = rk1;
            *(uint2*)(nV + vs0) = make_uint2(rv0.x, rv0.y); *(uint2*)(nV + vs0 + 8) = make_uint2(rv0.z, rv0.w);
            *(uint2*)(nV + vs1) = make_uint2(rv1.x, rv1.y); *(uint2*)(nV + vs1 + 8) = make_uint2(rv1.z, rv1.w);
        }
        __syncthreads();
    }
    bfu* MIX = (bfu*)(ws_ + WS_MIX);
    const int grow = grow_of(b, jq);
    const float il = 1.f / (lrun + __shfl_xor(lrun, 32));
    if (GRP == 0) {
        bfu* dst = MIX + (size_t)grow * DM + h * 64;
#pragma unroll
        for (int db = 0; db < 2; ++db)
#pragma unroll
            for (int g = 0; g < 4; ++g)
                *(uint2*)(dst + db * 32 + g * 8 + hh * 4) = make_uint2(pack2(oacc[db][4 * g] * il, oacc[db][4 * g + 1] * il), pack2(oacc[db][4 * g + 2] * il, oacc[db][4 * g + 3] * il));
    } else {
        float* xs = (float*)smem + sub * 2048;
        if (mp == 1) {
            const float sc2 = lam * il;
#pragma unroll
            for (int db = 0; db < 2; ++db)
#pragma unroll
                for (int i = 0; i < 16; ++i) xs[(db * 16 + i) * 64 + lane] = oacc[db][i] * sc2;
        }
        __syncthreads();
        if (mp == 0) {
            float ss = 0.f;
#pragma unroll
            for (int db = 0; db < 2; ++db)
#pragma unroll
                for (int i = 0; i < 16; ++i) { const float o = oacc[db][i] * il - xs[(db * 16 + i) * 64 + lane]; oacc[db][i] = o; ss += o * o; }
            ss += __shfl_xor(ss, 32);
            const float rs = rsqrtf(ss * (1.f / 64.f) + 1e-6f) * (1.f - lam_init);
            const float* gn = p.b_subln + layer * 64;
            bfu* dst = MIX + (size_t)grow * DM + 256 + h * 64;
#pragma unroll
            for (int db = 0; db < 2; ++db)
#pragma unroll
                for (int g = 0; g < 4; ++g) {
                    const int d = db * 32 + g * 8 + hh * 4;
                    *(uint2*)(dst + d) = make_uint2(pack2(oacc[db][4 * g] * rs * gn[d], oacc[db][4 * g + 1] * rs * gn[d + 1]), pack2(oacc[db][4 * g + 2] * rs * gn[d + 2], oacc[db][4 * g + 3] * rs * gn[d + 3]));
                }
        }
    }
}
__device__ void phase_attn(const P& p, int layer, bool do_ctx, unsigned* qctr, int* s_item, char* smem) {
    PHASE_PROLOGUE
    const int tid = tid_;
    const float lam_init = 0.8f - 0.6f * expf(-0.3f * (float)layer);
    float d1 = 0.f, d2 = 0.f;
    for (int i = 0; i < 32; ++i) { d1 += p.b_lq1[layer * 32 + i] * p.b_lk1[layer * 32 + i]; d2 += p.b_lq2[layer * 32 + i] * p.b_lk2[layer * 32 + i]; }
    const float lam = expf(d1) - expf(d2) + lam_init;
    const int nitems = do_ctx ? 1728 : 1536;
    for (;;) {
        __syncthreads();
        if (tid == 0) *s_item = (int)atomicAdd(qctr, 1u);
        __syncthreads();
        const int it = *s_item;
        if (it >= nitems) break;
        int grp, b, h, qb, nkeys;
        if (it < 1024) { grp = 1; qb = 4 + (it & 31); h = (it >> 5) & 3; b = it >> 7; nkeys = NKEY; }
        else if (it < 1536) { grp = 0; const int r = it - 1024; qb = 2 + (r & 15); h = (r >> 4) & 3; b = r >> 6; nkeys = NKEY; }
        else if (it < 1664) { grp = 1; const int r = it - 1536; qb = r & 3; h = (r >> 2) & 3; b = r >> 4; nkeys = 256; }
        else { grp = 0; const int r = it - 1664; qb = r & 1; h = (r >> 1) & 3; b = r >> 3; nkeys = 256; }
        if (grp) attn_item<1>(p, ws_, layer, b, h, qb, nkeys, lam, lam_init, smem, tid);
        else attn_item<0>(p, ws_, layer, b, h, qb, nkeys, lam, lam_init, smem, tid);
    }
}

__device__ void phase_outproj(const P& p, int layer, int nrows, int bid, int nb, char* smem) {
    PHASE_PROLOGUE
    const bfu* MIX = (const bfu*)(ws_ + WS_MIX); const bfu* W = (const bfu*)(ws_ + WS_WOUT);
    float* X = (float*)(ws_ + WS_X); const float* mod = (const float*)(ws_ + WS_MOD);
    const int nitems = (nrows / 128) * 8;
    for (int it = bid; it < nitems; it += nb) {
        const int mt = it >> 3, nt = it & 7, row0 = mt * 128, col0 = nt * 128;
        int b, j0, s; row_info(row0, b, j0, s);
        const float* ga = mod + ((size_t)layer * 9 + s) * 6144 + 2 * 1024;
        gemm_tile([&](int r) { return MIX + (size_t)(row0 + r) * DM; }, [&](int r) { return W + (size_t)(col0 + r) * DM; }, DM,
            [&](f32x4 (&acc)[4][4], int wr, int wc, int fr, int fq) {
                ACC_FOREACH({ float* xp = X + (size_t)(row0 + row) * DM + col0 + col; *xp += ga[col0 + col] * val; })
            }, smem);
    }
}

__device__ void phase_norm2_route(const P& p, int layer, int nrows, int bid, int nb, char* smem) {
    PHASE_PROLOGUE
    const float* X = (const float*)(ws_ + WS_X); bfu* H = (bfu*)(ws_ + WS_H);
    const float* mod = (const float*)(ws_ + WS_MOD); const float* WRT = (const float*)(ws_ + WS_WRT);
    int* ECNT = (int*)(ws_ + WS_ECNT) + layer * 32; int* EIDX = (int*)(ws_ + WS_EIDX); float* EGATE = (float*)(ws_ + WS_EGATE); int* ELIST = (int*)(ws_ + WS_ELIST);
    float* lg = (float*)smem;
    int* lcnt = (int*)(lg + 4 * 16 * 48);
    int* lbase = lcnt + 32;
    int* lsel = lbase + 32;
    int* lrank = lsel + 128;
    const int tid = tid_, lane = tid & 63, wv = tid >> 6, r = lane & 15, kq = lane >> 4;
    const float* gf = p.g_ffn + layer * DM;
    const float* bg = p.r_b_group + layer * 4; const float* be = p.r_b_expert + layer * 32;
    const int nitems = nrows / 64;
    for (int it = bid; it < nitems; it += nb) {
        const int row = it * 64 + wv * 16 + r;
        int b, j, s; row_info(row, b, j, s);
        const float* xr = X + (size_t)row * DM;
        const float* sh = mod + ((size_t)layer * 9 + s) * 6144 + 3 * 1024; const float* sc = sh + 1024;
        if (tid < 32) lcnt[tid] = 0;
        float ss = 0.f;
        for (int c = 0; c < 64; ++c) { const float4 v = *(const float4*)(xr + c * 16 + kq * 4); ss += v.x * v.x + v.y * v.y + v.z * v.z + v.w * v.w; }
        ss += __shfl_xor(ss, 16); ss += __shfl_xor(ss, 32);
        const float rs = rsqrtf(ss * (1.f / 1024.f) + 1e-6f);
        f32x4 acc[3];
#pragma unroll
        for (int n = 0; n < 3; ++n) acc[n] = (f32x4){0.f, 0.f, 0.f, 0.f};
        for (int c = 0; c < 64; ++c) {
            const int k = c * 16 + kq * 4;
            const float4 v = *(const float4*)(xr + k), g = *(const float4*)(gf + k), s1 = *(const float4*)(sc + k), s0 = *(const float4*)(sh + k);
            float f[4];
            f[0] = v.x * rs * g.x * (1.f + s1.x) + s0.x; f[1] = v.y * rs * g.y * (1.f + s1.y) + s0.y;
            f[2] = v.z * rs * g.z * (1.f + s1.z) + s0.z; f[3] = v.w * rs * g.w * (1.f + s1.w) + s0.w;
            *(uint2*)(H + (size_t)row * DM + k) = make_uint2(pack2(f[0], f[1]), pack2(f[2], f[3]));
#pragma unroll
            for (int n = 0; n < 3; ++n) {
                const float4 w = *(const float4*)(WRT + (size_t)(n * 16 + r) * DM + k);
                acc[n] = __builtin_amdgcn_mfma_f32_16x16x4f32(f[0], w.x, acc[n], 0, 0, 0);
                acc[n] = __builtin_amdgcn_mfma_f32_16x16x4f32(f[1], w.y, acc[n], 0, 0, 0);
                acc[n] = __builtin_amdgcn_mfma_f32_16x16x4f32(f[2], w.z, acc[n], 0, 0, 0);
                acc[n] = __builtin_amdgcn_mfma_f32_16x16x4f32(f[3], w.w, acc[n], 0, 0, 0);
            }
        }
#pragma unroll
        for (int n = 0; n < 3; ++n)
#pragma unroll
            for (int jj = 0; jj < 4; ++jj) lg[(wv * 16 + kq * 4 + jj) * 48 + n * 16 + r] = acc[n][jj];
        __syncthreads();
        if (lane < 16) {
            const float* L = lg + (wv * 16 + lane) * 48;
            const int grow = it * 64 + wv * 16 + lane;
            float gl[4]; float gm = -1e30f; int gi = 0;
#pragma unroll
            for (int g = 0; g < 4; ++g) { gl[g] = L[g] + bg[g]; if (gl[g] > gm) { gm = gl[g]; gi = g; } }
            float gs = 0.f;
#pragma unroll
            for (int g = 0; g < 4; ++g) gs += __expf(gl[g] - gm);
            const float gp = 1.f / gs;
            float v1 = -1e30f, v2 = -1e30f; int i1 = 0, i2 = 0;
            for (int e = 0; e < 8; ++e) {
                const float v = L[4 + gi * 8 + e] + be[gi * 8 + e];
                if (v > v1) { v2 = v1; i2 = i1; v1 = v; i1 = e; } else if (v > v2) { v2 = v; i2 = e; }
            }
            const float e2 = __expf(v2 - v1), den = 1.f / (1.f + e2);
            const int ex1 = gi * 8 + i1, ex2 = gi * 8 + i2;
            EIDX[grow * 2] = ex1; EIDX[grow * 2 + 1] = ex2;
            EGATE[grow * 2] = den * gp; EGATE[grow * 2 + 1] = e2 * den * gp;
            const int lr = wv * 16 + lane;
            lsel[lr * 2] = ex1; lsel[lr * 2 + 1] = ex2;
            lrank[lr * 2] = atomicAdd(&lcnt[ex1], 1); lrank[lr * 2 + 1] = atomicAdd(&lcnt[ex2], 1);
        }
        __syncthreads();
        if (tid < 32) lbase[tid] = lcnt[tid] > 0 ? atomicAdd(&ECNT[tid], lcnt[tid]) : 0;
        __syncthreads();
        if (tid < 128) { const int e = lsel[tid]; ELIST[(size_t)e * (2 * MA) + lbase[e] + lrank[tid]] = ((it * 64 + (tid >> 1)) << 1) | (tid & 1); }
        __syncthreads();
    }
}

__device__ __forceinline__ int moe_prefix(const int* ECNT, int* spre  ) {
    if (threadIdx.x == 0) { int a = 0; for (int e = 0; e < 32; ++e) { spre[e] = a; a += (ECNT[e] + 127) >> 7; } spre[32] = a; }
    __syncthreads();
    return spre[32];
}
__device__ void phase_expert1(const P& p, int layer, int bid, int nb, char* smem) {
    PHASE_PROLOGUE
    const bfu* H = (const bfu*)(ws_ + WS_H); const bfu* W1 = (const bfu*)(ws_ + WS_W1); const bfu* W3 = (const bfu*)(ws_ + WS_W3);
    bfu* HB = (bfu*)(ws_ + WS_HB);
    const int* ECNT = (const int*)(ws_ + WS_ECNT) + layer * 32; const int* ELIST = (const int*)(ws_ + WS_ELIST);
    int* spre = (int*)(smem + 65536);
    const int nblk = moe_prefix(ECNT, spre);
    const int nitems = nblk * 8;
    for (int it = bid; it < nitems; it += nb) {
        const int blk = it >> 3, nt = it & 7;
        int e = 0;
        while (spre[e + 1] <= blk) ++e;
        const int rb = blk - spre[e], cnt = ECNT[e];
        const int* lst = ELIST + (size_t)e * (2 * MA) + rb * 128;
        const int nvalid = min(128, cnt - rb * 128);
        const bfu* w1 = W1 + (size_t)e * FF * DM; const bfu* w3 = W3 + (size_t)e * FF * DM;
        bfu* hb = HB + (size_t)blk * 128 * FF;
        gemm_tile([&](int r) { const int tok = r < nvalid ? (lst[r] >> 1) : 0; return H + (size_t)tok * DM; },
                  [&](int r) { const int wcx = r >> 6, n4 = (r >> 4) & 3, rr = r & 15; const int hc = nt * 64 + wcx * 32 + (n4 & 1) * 16 + rr; return (n4 < 2 ? w1 : w3) + (size_t)hc * DM; }, DM,
            [&](f32x4 (&acc)[4][4], int wr, int wc, int fr, int fq) {
#pragma unroll
                for (int m = 0; m < 4; ++m)
#pragma unroll
                    for (int n = 0; n < 2; ++n)
#pragma unroll
                        for (int jj = 0; jj < 4; ++jj) {
                            const int row = wr * 64 + m * 16 + fq * 4 + jj; const int hc = nt * 64 + wc * 32 + n * 16 + fr;
                            const float a = acc[m][n][jj], g = acc[m][n + 2][jj];
                            hb[(size_t)row * FF + hc] = f2bf(siluf_(a) * g);
                        }
            }, smem);
    }
}
__device__ void phase_expert2(const P& p, int layer, int bid, int nb, char* smem) {
    PHASE_PROLOGUE
    const bfu* HB = (const bfu*)(ws_ + WS_HB); const bfu* W2 = (const bfu*)(ws_ + WS_W2);
    float* Y = (float*)(ws_ + WS_Y01);
    const int* ECNT = (const int*)(ws_ + WS_ECNT) + layer * 32; const int* ELIST = (const int*)(ws_ + WS_ELIST); const float* EGATE = (const float*)(ws_ + WS_EGATE);
    int* spre = (int*)(smem + 65536);
    const int nblk = moe_prefix(ECNT, spre);
    const int nitems = nblk * 8;
    for (int it = bid; it < nitems; it += nb) {
        const int blk = it >> 3, nt = it & 7;
        int e = 0;
        while (spre[e + 1] <= blk) ++e;
        const int rb = blk - spre[e], cnt = ECNT[e];
        const int* lst = ELIST + (size_t)e * (2 * MA) + rb * 128;
        const int nvalid = min(128, cnt - rb * 128);
        const bfu* w2 = W2 + (size_t)e * DM * FF;
        const bfu* hb = HB + (size_t)blk * 128 * FF;
        gemm_tile([&](int r) { return hb + (size_t)r * FF; }, [&](int r) { return w2 + (size_t)(nt * 128 + r) * FF; }, FF,
            [&](f32x4 (&acc)[4][4], int wr, int wc, int fr, int fq) {
#pragma unroll
                for (int m = 0; m < 4; ++m)
#pragma unroll
                    for (int jj = 0; jj < 4; ++jj) {
                        const int row = wr * 64 + m * 16 + fq * 4 + jj;
                        if (row < nvalid) {
                            const int ent = lst[row]; const float gt = EGATE[ent];
                            float* yp = Y + ((size_t)(ent & 1) * MA + (ent >> 1)) * DM + nt * 128 + wc * 64 + fr;
#pragma unroll
                            for (int n = 0; n < 4; ++n) yp[n * 16] = gt * acc[m][n][jj];
                        }
                    }
            }, smem);
    }
}

#define XB_TMO      128
#define XB_XCNT(j)  (256  + 64 * (j))
#define XB_XSUB(j)  (1280 + 64 * (j))
#define XB_XGEN(j)  (2304 + 64 * (j))
#define XB_TOP      3328
#define XB_TOPGEN   3392
#define XCD_BAR_WORDS 3456
#define XB_SPIN_CAP (1u << 22)
#define LAS __attribute__((address_space(3)))

__device__ __forceinline__ unsigned xb_ld(unsigned* p)              { return __hip_atomic_load(p, __ATOMIC_RELAXED, __HIP_MEMORY_SCOPE_AGENT); }
__device__ __forceinline__ unsigned xb_add(unsigned* p, unsigned v) { return __hip_atomic_fetch_add(p, v, __ATOMIC_RELAXED, __HIP_MEMORY_SCOPE_AGENT); }
__device__ __forceinline__ unsigned xb_xcc_id() { return (unsigned)__builtin_amdgcn_s_getreg((3 << 11) | 20) & 0xFu; }
#define XB_SPIN(cond, bar) do { unsigned _sp = 0; while (cond) { __builtin_amdgcn_s_sleep(1); \
    if ((++_sp & 255u) == 0u) { if (xb_ld(&(bar)[XB_TMO])) break; if (_sp > XB_SPIN_CAP) { atomicAdd(&(bar)[XB_TMO], 1u); break; } } } } while (0)

struct XcdBarrier {
    unsigned* bar; unsigned x;
    volatile LAS unsigned* st;
};

__device__ __forceinline__ XcdBarrier xcd_barrier_post(unsigned* bar, volatile LAS unsigned* st) {
    XcdBarrier b; b.bar = bar; b.x = xb_xcc_id(); b.st = st;
    if (threadIdx.x == 0) (void)xb_add(&bar[XB_XCNT(b.x)], 1u);
    return b;
}
__device__ __forceinline__ void xcd_barrier_complete(unsigned* bar, unsigned x, unsigned& nloc, unsigned& nx) {
    const unsigned G = gridDim.x * gridDim.y * gridDim.z;
    unsigned sum, cnt, mine, sp = 0u;
    for (;;) {
        sum = 0u; cnt = 0u; mine = 0u;
#pragma unroll
        for (unsigned j = 0; j < 16; ++j) { const unsigned c = xb_ld(&bar[XB_XCNT(j)]); sum += c; cnt += (c > 0u) ? 1u : 0u; mine = (j == x) ? c : mine; }
        if (sum == G) break;
        __builtin_amdgcn_s_sleep(1);
        if ((++sp & 255u) == 0u) { if (xb_ld(&bar[XB_TMO])) break; if (sp > XB_SPIN_CAP) { atomicAdd(&bar[XB_TMO], 1u); break; } }
    }
    nloc = mine > 0u ? mine : 1u; nx = cnt > 0u ? cnt : 1u;
}

__device__ __forceinline__ void xcd_barrier(const XcdBarrier& b) {
    asm volatile("s_waitcnt vmcnt(0)" ::: "memory");
    __syncthreads();
    if (threadIdx.x == 0) {
        unsigned* bar = b.bar;
        __builtin_amdgcn_s_waitcnt(0);
        unsigned nloc = b.st[0], nx = b.st[1];
        if (nloc == 0u) { xcd_barrier_complete(bar, b.x, nloc, nx); b.st[0] = nloc; b.st[1] = nx; }
        const unsigned old = xb_add(&bar[XB_XSUB(b.x)], 1u);
        const unsigned gen = old / nloc;
        if (old + 1u == (gen + 1u) * nloc) {
            __builtin_amdgcn_fence(__ATOMIC_RELEASE, "agent");
            asm volatile("s_waitcnt vmcnt(0)" ::: "memory");
            const unsigned og = xb_add(&bar[XB_TOP], 1u);
            const unsigned tg = og / nx;
            if (og + 1u == (tg + 1u) * nx) xb_add(&bar[XB_TOPGEN], 1u);
            else XB_SPIN(xb_ld(&bar[XB_TOPGEN]) == tg, bar);
            __builtin_amdgcn_fence(__ATOMIC_ACQUIRE, "agent");
            xb_add(&bar[XB_XGEN(b.x)], 1u);
            asm volatile("s_waitcnt vmcnt(0)" ::: "memory");
        } else {
            XB_SPIN(xb_ld(&bar[XB_XGEN(b.x)]) == gen, bar);
            __builtin_amdgcn_fence(__ATOMIC_ACQUIRE, "agent");
            asm volatile("s_waitcnt vmcnt(0)" ::: "memory");
        }
    }
    __syncthreads();
}


#define REP_CONV 1
#define REP_INPROJ 1
#define REP_RK 1
#define REP_SCANATT 1
#define REP_READOUT 1
#define REP_EXP1 1
#define REP_EXP2 1
#define REPEAT(N) _Pragma("nounroll") for (int rep_ = 0; rep_ < (N); ++rep_)
#define CTL_Q(l) (4096 + 64 * (l))
__global__ void __launch_bounds__(256, 2) fwd(P p) {
    __shared__ __attribute__((aligned(16))) char smem[SMEM_BYTES];
    __shared__ uint4 xb_words;
    __shared__ int s_item;
    if (threadIdx.x == 0) xb_words = make_uint4(0u, 0u, 0u, 0u);
    __syncthreads();
    unsigned* ctl = (unsigned*)(p.ws + WS_CTL);
    XcdBarrier bar = xcd_barrier_post(ctl, (volatile LAS unsigned*)&xb_words);
    const int bid = blockIdx.x, nb = gridDim.x;
    phase_setup(p, bid, nb);
    phase_mod(p, bid, nb, smem);
    for (int l = 0; l < NLAYER; ++l) {
        const int nr = l < NLAYER - 1 ? MA : ML;
        REPEAT(REP_CONV) phase_conv(p, l, bid, nb, smem);
        if (l == 0) xcd_barrier(bar);
        phase_norm1(p, l, 0, bid, nb);
        xcd_barrier(bar);
        REPEAT(REP_INPROJ) { phase_inproj(p, l, bid, nb, smem); xcd_barrier(bar); }
        REPEAT(REP_RK) { phase_rk(p, l, bid, nb, smem); xcd_barrier(bar); }
        REPEAT(REP_SCANATT) {
            if (bid < 128) phase_r4(p, l, bid, 128, smem);
            else phase_gate(p, l, bid - 128, nb - 128, smem);
            phase_attn(p, l, l < NLAYER - 1, ctl + CTL_Q(l) + 16 * rep_, &s_item, smem);
            xcd_barrier(bar);
        }
        REPEAT(REP_READOUT) { phase_readout(p, l, nr, bid, nb); xcd_barrier(bar); }
        phase_outproj(p, l, nr, bid, nb, smem);
        xcd_barrier(bar);
        phase_norm2_route(p, l, nr, bid, nb, smem);
        xcd_barrier(bar);
        REPEAT(REP_EXP1) { phase_expert1(p, l, bid, nb, smem); xcd_barrier(bar); }
        REPEAT(REP_EXP2) { phase_expert2(p, l, bid, nb, smem); xcd_barrier(bar); }
    }
    phase_norm1(p, NLAYER, 1, bid, nb);
}

extern "C" void kernel_launch(void* const* d_in, const int* in_sizes, int n_in, void* d_out, int out_size, void* d_ws, size_t ws_size, hipStream_t stream) {
    if (n_in != 36 || ws_size < WS_END) { fprintf(stderr, "kernel_launch: unexpected n_in %d or ws_size %zu < %zu\n", n_in, ws_size, (size_t)WS_END); return; }
    static int grid = 0;
    if (!grid) {
        int dev = 0, cus = 0, per_cu = 0;
        hipGetDevice(&dev);
        hipDeviceGetAttribute(&cus, hipDeviceAttributeMultiprocessorCount, dev);
        hipOccupancyMaxActiveBlocksPerMultiprocessor(&per_cu, (const void*)fwd, 256, 0);
        if (per_cu < 1) per_cu = 1;
        grid = cus * (per_cu < 2 ? per_cu : 2);
    }
    P p{};
    const float** pp = (const float**)&p;
    for (int i = 0; i < 36; ++i) pp[i] = (const float*)d_in[i];
    p.out = (float*)d_out; p.ws = (char*)d_ws;
    hipMemsetAsync((char*)d_ws + WS_CTL, 0, 65536, stream);
    fwd<<<grid, 256, 0, stream>>>(p);
}
```

```cpp
#include <hip/hip_runtime.h>
#include <stdint.h>
#include <stdio.h>

typedef unsigned short bfu;
using bf16x8 = __attribute__((ext_vector_type(8))) short;
using f32x4  = __attribute__((ext_vector_type(4))) float;

#define DM 1024
#define NB 8
#define SEQ 2048
#define CL 256
#define NKEY 2304
#define ML 16384
#define MC 2048
#define MA 18432
#define INW 3200
#define CSL 1920
#define NEXP 32
#define FF 512
#define NLAYER 4
#define LOG2E 1.4426950408889634f

#define MBy(x) ((size_t)(x) << 20)
constexpr size_t WS_CTL   = 0;
constexpr size_t WS_MOD   = 65536;
constexpr size_t WS_ROPE  = WS_MOD + (size_t)4 * 9 * 6144 * 4;
constexpr size_t WS_ECNT  = WS_ROPE + 64 * 16 * 2 * 4 + 64 * 8 * 2 * 4;
constexpr size_t WS_WRT   = WS_ECNT + 4096;
constexpr size_t WS_EIDX  = WS_WRT + (size_t)48 * 1024 * 4;
constexpr size_t WS_EGATE = WS_EIDX + (size_t)MA * 2 * 4;
constexpr size_t WS_ELIST = WS_EGATE + (size_t)MA * 2 * 4;
constexpr size_t WS_X     = MBy(8);
constexpr size_t WS_H     = WS_X + (size_t)MA * DM * 4;
constexpr size_t WS_WIN   = WS_H + (size_t)MA * DM * 2;
constexpr size_t WS_WOUT  = WS_WIN + (size_t)INW * DM * 2;
constexpr size_t WS_W1    = WS_WOUT + (size_t)DM * DM * 2;
constexpr size_t WS_W3    = WS_W1 + (size_t)NEXP * FF * DM * 2;
constexpr size_t WS_W2    = WS_W3 + (size_t)NEXP * FF * DM * 2;
constexpr size_t WS_LW2   = WS_W2 + (size_t)NEXP * FF * DM * 2;
constexpr size_t WS_LA2   = WS_LW2 + (size_t)2 * 512 * 64 * 2;
constexpr size_t WS_LG2   = WS_LA2 + (size_t)2 * 512 * 64 * 2;
constexpr size_t WS_QA    = WS_LG2 + (size_t)512 * 128 * 2;
constexpr size_t WS_KA    = WS_QA + (size_t)NB * 4 * NKEY * 64 * 2;
constexpr size_t WS_VAT   = WS_KA + (size_t)NB * 2 * NKEY * 64 * 2;
constexpr size_t WS_QB    = WS_VAT + (size_t)NB * 2 * NKEY * 64 * 2;
constexpr size_t WS_KB    = WS_QB + (size_t)NB * 4 * NKEY * 64 * 2;
constexpr size_t WS_VBT   = WS_KB + (size_t)NB * 4 * NKEY * 64 * 2;
constexpr size_t WS_CP    = WS_VBT + (size_t)NB * 4 * NKEY * 64 * 2;
constexpr size_t WS_GG    = WS_CP + (size_t)MA * CSL * 4;
constexpr size_t WS_MIX   = WS_GG + (size_t)MA * 512 * 4;
constexpr size_t HEADARR  = (size_t)NB * 8 * NKEY * 64 * 4;
#define OPS_REC 13568
constexpr size_t OPS_DIR  = (size_t)64 * 144 * OPS_REC;
constexpr size_t WS_OPS   = WS_MIX + (size_t)MA * DM * 2;
constexpr size_t WS_YS    = WS_OPS + 2 * OPS_DIR;
constexpr size_t WS_VB    = WS_YS + 2 * HEADARR;
constexpr size_t WS_BETA  = WS_VB + (size_t)MA * 512 * 2;
constexpr size_t WS_LXG   = WS_BETA + (size_t)2 * MA * 8 * 4;
constexpr size_t WS_END   = WS_LXG + (size_t)MA * 128 * 2;
constexpr size_t WS_Y01   = WS_OPS;
constexpr size_t WS_HB    = WS_OPS + (size_t)2 * MA * DM * 4;
static_assert((size_t)2 * MA * DM * 4 + (size_t)(2 * MA + 32 * 128) * 512 * 2 <= 2 * OPS_DIR, "MoE buffers must fit in OPS");

struct P {
    const float *x, *c, *ctx, *c_ctx, *w_mod, *b_mod, *g_mix, *g_ffn, *w_in, *a_q_gain, *a_k_gain, *b_lq1, *b_lk1, *b_lq2, *b_lk2, *b_subln,
        *c_mu, *c_w0, *c_w2, *c_a0, *c_a2, *c_g2, *c_k_k, *c_k_a, *c_r_k, *c_ln_w, *c_ln_b, *w_out, *r_w_group, *r_b_group, *r_w_expert, *r_b_expert,
        *e_w1, *e_w3, *e_w2, *g_final;
    float* out;
    char* ws;
};

__device__ __forceinline__ float bf2f(bfu b) { return __uint_as_float((unsigned)b << 16); }
__device__ __forceinline__ unsigned pack2(float a, float b) {
    typedef float f2 __attribute__((ext_vector_type(2)));
    typedef __bf16 b2 __attribute__((ext_vector_type(2)));
    f2 v = {a, b}; b2 r = __builtin_convertvector(v, b2); return __builtin_bit_cast(unsigned, r);
}
__device__ __forceinline__ bfu f2bf(float a) { return (bfu)(pack2(a, 0.f) & 0xFFFFu); }
__device__ __forceinline__ float wave_sum(float v) {
#pragma unroll
    for (int o = 32; o >= 1; o >>= 1) v += __shfl_xor(v, o);
    return v;
}
template <int CTRL> __device__ __forceinline__ float dppf(float v) { return __int_as_float(__builtin_amdgcn_update_dpp(0, __float_as_int(v), CTRL, 0xF, 0xF, true)); }
__device__ __forceinline__ float sum8(float v) { v += dppf<0xB1>(v); v += dppf<0x4E>(v); v += dppf<0x141>(v); return v; }
__device__ __forceinline__ float sigmoidf_(float x) { return 1.f / (1.f + __expf(-x)); }
__device__ __forceinline__ float siluf_(float x) { return x / (1.f + __expf(-x)); }
__device__ __forceinline__ void row_info(int grow, int& b, int& j, int& s) {
    if (grow < ML) { b = grow >> 11; j = 256 + (grow & 2047); s = b; }
    else { int r = grow - ML; b = r >> 8; j = r & 255; s = 8; }
}
__device__ __forceinline__ int grow_of(int b, int j) { return j < 256 ? ML + b * 256 + j : b * 2048 + (j - 256); }

#define SMEM_BYTES 69632

#define PHASE_PROLOGUE int tid_ = threadIdx.x; asm volatile("" : "+v"(tid_)); int z_ = 0; asm volatile("" : "+v"(z_)); char* ws_ = p.ws + __builtin_amdgcn_readfirstlane(z_);

__device__ void phase_setup(const P& p, int bid, int nb) {
    PHASE_PROLOGUE
    float4* X4 = (float4*)(ws_ + WS_X);
    const float4* x4 = (const float4*)p.x; const float4* c4 = (const float4*)p.ctx;
    const size_t nl = (size_t)ML * DM / 4, nc = (size_t)MC * DM / 4;
    for (size_t i = (size_t)bid * 256 + tid_; i < nl + nc; i += (size_t)nb * 256) X4[i] = i < nl ? x4[i] : c4[i - nl];
    if (bid == 0) {
        float* TA = (float*)(ws_ + WS_ROPE); float* TB = TA + 64 * 16 * 2;
        for (int i = tid_; i < 64 * 16; i += 256) { int pos = i >> 4, f = i & 15; double inv = pow(10000.0, -(double)f / 16.0); double a = (double)pos * inv; TA[i * 2] = (float)cos(a); TA[i * 2 + 1] = (float)sin(a); }
        for (int i = tid_; i < 64 * 8; i += 256) { int pos = i >> 3, f = i & 7; double inv = pow(10000.0, -(double)f / 8.0); double a = (double)pos * inv; TB[i * 2] = (float)cos(a); TB[i * 2 + 1] = (float)sin(a); }
        int* ec = (int*)(ws_ + WS_ECNT);
        for (int i = tid_; i < 128; i += 256) ec[i] = 0;
    }
}

__device__ void phase_mod(const P& p, int bid, int nb, char* smem) {
    PHASE_PROLOGUE
    float* act = (float*)smem;
    float* red = act + 9 * 1024;
    for (int i = tid_; i < 9 * 1024; i += 256) { float v = i < 8 * 1024 ? p.c[i] : p.c_ctx[i - 8 * 1024]; act[i] = siluf_(v); }
    __syncthreads();
    float* mod = (float*)(ws_ + WS_MOD);
    const int nitems = 4 * 6144 / 64;
    const int cl = tid_ & 63, kq = tid_ >> 6;
    for (int it = bid; it < nitems; it += nb) {
        const int layer = it / 96, n = (it % 96) * 64 + cl;
        const float* w = p.w_mod + (size_t)layer * DM * 6144 + n;
        float a[9];
#pragma unroll
        for (int s = 0; s < 9; ++s) a[s] = 0.f;
        for (int k = kq * 256; k < kq * 256 + 256; ++k) {
            const float wv = w[(size_t)k * 6144];
#pragma unroll
            for (int s = 0; s < 9; ++s) a[s] += act[s * 1024 + k] * wv;
        }
#pragma unroll
        for (int s = 0; s < 9; ++s) red[(kq * 9 + s) * 64 + cl] = a[s];
        __syncthreads();
        for (int i = tid_; i < 9 * 64; i += 256) {
            const int s = i >> 6, c2 = i & 63, n2 = (it % 96) * 64 + c2;
            float v = red[(0 * 9 + s) * 64 + c2] + red[(1 * 9 + s) * 64 + c2] + red[(2 * 9 + s) * 64 + c2] + red[(3 * 9 + s) * 64 + c2];
            mod[((size_t)layer * 9 + s) * 6144 + n2] = v + p.b_mod[layer * 6144 + n2];
        }
        __syncthreads();
    }
}

__device__ __forceinline__ void conv_tile(const float* src, int K, int N, bfu* dst, int k0, int n0, float* ts, int tid_) {
    const int t = tid_;
    {
        const int kk = t >> 4, n4 = (t & 15) * 4;
#pragma unroll
        for (int pz = 0; pz < 4; ++pz) {
            const float4 v = *(const float4*)(src + (size_t)(k0 + kk + 16 * pz) * N + n0 + n4);
            float* d = ts + (kk + 16 * pz) * 65 + n4; d[0] = v.x; d[1] = v.y; d[2] = v.z; d[3] = v.w;
        }
    }
    __syncthreads();
    {
        const int n = t >> 2, kc = (t & 3) * 16;
        unsigned o[8];
#pragma unroll
        for (int i = 0; i < 8; ++i) o[i] = pack2(ts[(kc + 2 * i) * 65 + n], ts[(kc + 2 * i + 1) * 65 + n]);
        uint4* d = (uint4*)(dst + (size_t)(n0 + n) * K + k0 + kc);
        d[0] = make_uint4(o[0], o[1], o[2], o[3]); d[1] = make_uint4(o[4], o[5], o[6], o[7]);
    }
    __syncthreads();
}
__device__ void phase_conv(const P& p, int layer, int bid, int nb, char* smem) {
    PHASE_PROLOGUE
    float* ts = (float*)smem;
    const float* srcs[8]; bfu* dsts[8]; int Ks[8], Ns[8], Bs[8];
    char* ws = ws_;
    srcs[0] = p.w_in + (size_t)layer * DM * INW;  Ks[0] = DM; Ns[0] = INW; Bs[0] = 1;  dsts[0] = (bfu*)(ws + WS_WIN);
    srcs[1] = p.w_out + (size_t)layer * DM * DM;  Ks[1] = DM; Ns[1] = DM;  Bs[1] = 1;  dsts[1] = (bfu*)(ws + WS_WOUT);
    srcs[2] = p.e_w1 + (size_t)layer * NEXP * DM * FF; Ks[2] = DM; Ns[2] = FF; Bs[2] = NEXP; dsts[2] = (bfu*)(ws + WS_W1);
    srcs[3] = p.e_w3 + (size_t)layer * NEXP * DM * FF; Ks[3] = DM; Ns[3] = FF; Bs[3] = NEXP; dsts[3] = (bfu*)(ws + WS_W3);
    srcs[4] = p.e_w2 + (size_t)layer * NEXP * FF * DM; Ks[4] = FF; Ns[4] = DM; Bs[4] = NEXP; dsts[4] = (bfu*)(ws + WS_W2);
    srcs[5] = p.c_w2 + (size_t)layer * 2 * 64 * 512;   Ks[5] = 64; Ns[5] = 512; Bs[5] = 2;   dsts[5] = (bfu*)(ws + WS_LW2);
    srcs[6] = p.c_a2 + (size_t)layer * 2 * 64 * 512;   Ks[6] = 64; Ns[6] = 512; Bs[6] = 2;   dsts[6] = (bfu*)(ws + WS_LA2);
    srcs[7] = p.c_g2 + (size_t)layer * 128 * 512;      Ks[7] = 128; Ns[7] = 512; Bs[7] = 1;  dsts[7] = (bfu*)(ws + WS_LG2);
    int start = 0;
#pragma unroll
    for (int jb = 0; jb < 8; ++jb) {
        if (jb >= 2 && jb <= 4) continue;
        const int tk = Ks[jb] / 64, tn = Ns[jb] / 64, per = tk * tn, tot = per * Bs[jb];
        int first = bid - (start % nb); if (first < 0) first += nb;
        for (int it = first; it < tot; it += nb) {
            const int bt = it / per, r = it % per, kt = r / tn, nt = r % tn;
            conv_tile(srcs[jb] + (size_t)bt * Ks[jb] * Ns[jb], Ks[jb], Ns[jb], dsts[jb] + (size_t)bt * Ks[jb] * Ns[jb], kt * 64, nt * 64, ts, tid_);
        }
        start += tot;
    }
    float* wrt = (float*)(ws + WS_WRT);
    const float* wg = p.r_w_group + (size_t)layer * DM * 4; const float* we = p.r_w_expert + (size_t)layer * DM * 32;
    for (int i = bid * 256 + tid_; i < 48 * 1024; i += nb * 256) {
        const int r = i >> 10, k = i & 1023;
        wrt[i] = r < 4 ? wg[k * 4 + r] : (r < 36 ? we[k * 32 + (r - 4)] : 0.f);
    }
}

__device__ void phase_conv_big(const P& p, int layer, unsigned* qctr, int* s_item, char* smem) {
    PHASE_PROLOGUE
    float* ts = (float*)smem;
    for (;;) {
        __syncthreads();
        if (tid_ == 0) *s_item = (int)atomicAdd(qctr, 1u);
        __syncthreads();
        const int gidx = *s_item;
        if (gidx >= 1536) break;
#pragma unroll 1
        for (int q = 0; q < 8; ++q) {
            const int it = gidx * 8 + q, jb = it >> 12, r = it & 4095, bt = r >> 7, r2 = r & 127;
            const float* src; bfu* dst; int K, N;
            if (jb == 0) { src = p.e_w1 + (size_t)layer * NEXP * DM * FF; dst = (bfu*)(ws_ + WS_W1); K = DM; N = FF; }
            else if (jb == 1) { src = p.e_w3 + (size_t)layer * NEXP * DM * FF; dst = (bfu*)(ws_ + WS_W3); K = DM; N = FF; }
            else { src = p.e_w2 + (size_t)layer * NEXP * FF * DM; dst = (bfu*)(ws_ + WS_W2); K = FF; N = DM; }
            const int tn = N >> 6, kt = r2 / tn, nt = r2 % tn;
            conv_tile(src + (size_t)bt * K * N, K, N, dst + (size_t)bt * K * N, kt * 64, nt * 64, ts, tid_);
        }
    }
}

__device__ void phase_norm1(const P& p, int layer, int mode, int bid, int nb) {
    PHASE_PROLOGUE
    float* X = (float*)(ws_ + WS_X); bfu* H = (bfu*)(ws_ + WS_H);
    const float* Y0 = (const float*)(ws_ + WS_Y01); const float* Y1 = Y0 + (size_t)MA * DM;
    const float* mod = (const float*)(ws_ + WS_MOD);
    const int lane = tid_ & 63, wv = tid_ >> 6;
    const int nrows = mode ? ML : MA;
    if (bid == 0 && mode == 0 && tid_ < 32) ((int*)(ws_ + WS_ECNT))[layer * 32 + tid_] = 0;
    for (int row = bid * 4 + wv; row < nrows; row += nb * 4) {
        int b, j, s; row_info(row, b, j, s);
        float4 v[4];
        float ss = 0.f;
#pragma unroll
        for (int c = 0; c < 4; ++c) {
            const int col = c * 256 + lane * 4;
            float4 xv = *(const float4*)(X + (size_t)row * DM + col);
            if (layer > 0) {
                const float4 a = *(const float4*)(Y0 + (size_t)row * DM + col), bq = *(const float4*)(Y1 + (size_t)row * DM + col);
                const float4 g = *(const float4*)(mod + ((size_t)(layer - 1) * 9 + s) * 6144 + 5 * 1024 + col);
                xv.x += g.x * (a.x + bq.x); xv.y += g.y * (a.y + bq.y); xv.z += g.z * (a.z + bq.z); xv.w += g.w * (a.w + bq.w);
                if (!mode) *(float4*)(X + (size_t)row * DM + col) = xv;
            }
            v[c] = xv; ss += xv.x * xv.x + xv.y * xv.y + xv.z * xv.z + xv.w * xv.w;
        }
        ss = wave_sum(ss);
        const float rs = rsqrtf(ss * (1.f / 1024.f) + 1e-6f);
#pragma unroll
        for (int c = 0; c < 4; ++c) {
            const int col = c * 256 + lane * 4;
            if (mode) {
                const float4 g = *(const float4*)(p.g_final + col);
                float4 o; o.x = v[c].x * rs * g.x; o.y = v[c].y * rs * g.y; o.z = v[c].z * rs * g.z; o.w = v[c].w * rs * g.w;
                *(float4*)(p.out + (size_t)row * DM + col) = o;
            } else {
                const float4 g = *(const float4*)(p.g_mix + layer * DM + col);
                const float4 sh = *(const float4*)(mod + ((size_t)layer * 9 + s) * 6144 + 0 * 1024 + col);
                const float4 sc = *(const float4*)(mod + ((size_t)layer * 9 + s) * 6144 + 1 * 1024 + col);
                const float o0 = v[c].x * rs * g.x * (1.f + sc.x) + sh.x, o1 = v[c].y * rs * g.y * (1.f + sc.y) + sh.y;
                const float o2 = v[c].z * rs * g.z * (1.f + sc.z) + sh.z, o3 = v[c].w * rs * g.w * (1.f + sc.w) + sh.w;
                *(uint2*)(H + (size_t)row * DM + col) = make_uint2(pack2(o0, o1), pack2(o2, o3));
            }
        }
    }
}

#define GLDS(gp, lp) __builtin_amdgcn_global_load_lds((const unsigned*)(gp), (__attribute__((address_space(3))) unsigned*)(lp), 16, 0, 0)
template <class FA, class FB, class FE>
__device__ __forceinline__ void gemm_tile(FA arow, FB brow, int K, FE epi, char* smem) {
    int tid = threadIdx.x; asm volatile("" : "+v"(tid));
    const int lane = tid & 63, wid = tid >> 6, wr = wid >> 1, wc = wid & 1, fr = lane & 15, fq = lane >> 4;
    const int lrow = tid >> 3, lch = ((tid & 7) ^ ((tid >> 4) & 7)) * 8;
    const bfu* ga0 = arow(lrow) + lch; const bfu* ga1 = arow(lrow + 32) + lch; const bfu* ga2 = arow(lrow + 64) + lch; const bfu* ga3 = arow(lrow + 96) + lch;
    const bfu* gb0 = brow(lrow) + lch; const bfu* gb1 = brow(lrow + 32) + lch; const bfu* gb2 = brow(lrow + 64) + lch; const bfu* gb3 = brow(lrow + 96) + lch;
    f32x4 acc[4][4];
#pragma unroll
    for (int m = 0; m < 4; ++m)
#pragma unroll
        for (int n = 0; n < 4; ++n) acc[m][n] = (f32x4){0.f, 0.f, 0.f, 0.f};
    char* lds0 = smem + tid * 16;
#define GEMM_ISSUE(kt_) { char* d_ = lds0 + ((kt_) & 1) * 32768; const int ko_ = (kt_) * 64; \
        GLDS(ga0 + ko_, d_); GLDS(ga1 + ko_, d_ + 4096); GLDS(ga2 + ko_, d_ + 8192); GLDS(ga3 + ko_, d_ + 12288); \
        GLDS(gb0 + ko_, d_ + 16384); GLDS(gb1 + ko_, d_ + 20480); GLDS(gb2 + ko_, d_ + 24576); GLDS(gb3 + ko_, d_ + 28672); }
    __syncthreads();
    GEMM_ISSUE(0)
    const int nk = K >> 6;
    const int swA = ((wr * 64 + fr) >> 1) & 7, swB = ((wc * 64 + fr) >> 1) & 7;
    const int offA = (wr * 64 + fr) * 128, offB = 16384 + (wc * 64 + fr) * 128;
    for (int kt = 0; kt < nk; ++kt) {
        asm volatile("s_waitcnt vmcnt(0)" ::: "memory");
        __syncthreads();
        if (kt + 1 < nk) GEMM_ISSUE(kt + 1)
        const char* st = smem + (kt & 1) * 32768;
#pragma unroll
        for (int kk = 0; kk < 2; ++kk) {
            bf16x8 af[4], bfr[4];
#pragma unroll
            for (int m = 0; m < 4; ++m) af[m] = *(const bf16x8*)(st + offA + m * 2048 + (((kk * 4 + fq) ^ swA) * 16));
#pragma unroll
            for (int n = 0; n < 4; ++n) bfr[n] = *(const bf16x8*)(st + offB + n * 2048 + (((kk * 4 + fq) ^ swB) * 16));
#pragma unroll
            for (int m = 0; m < 4; ++m)
#pragma unroll
                for (int n = 0; n < 4; ++n) acc[m][n] = __builtin_amdgcn_mfma_f32_16x16x32_bf16(af[m], bfr[n], acc[m][n], 0, 0, 0);
        }
    }
    __syncthreads();
    epi(acc, wr, wc, fr, fq);
}
#define ACC_FOREACH(...)                                                                      \
    _Pragma("unroll") for (int m_ = 0; m_ < 4; ++m_) _Pragma("unroll") for (int n_ = 0; n_ < 4; ++n_) \
    _Pragma("unroll") for (int j_ = 0; j_ < 4; ++j_) {                                        \
        const int row = wr * 64 + m_ * 16 + fq * 4 + j_; const int col = wc * 64 + n_ * 16 + fr; const float val = acc[m_][n_][j_]; __VA_ARGS__ }

__device__ void phase_inproj(const P& p, int layer, int bid, int nb, char* smem) {
    PHASE_PROLOGUE
    const bfu* H = (const bfu*)(ws_ + WS_H); const bfu* W = (const bfu*)(ws_ + WS_WIN);
    float* Cs = (float*)smem;
    const float* TA = (const float*)(ws_ + WS_ROPE); const float* TB = TA + 64 * 16 * 2;
    const int nitems = 144 * 25;
    for (int it = bid; it < nitems; it += nb) {
        const int mt = it / 25, nt = it % 25;
        const int row0 = mt * 128, col0 = nt * 128;
        gemm_tile([&](int r) { return H + (size_t)(row0 + r) * DM; }, [&](int r) { return W + (size_t)(col0 + r) * DM; }, DM,
            [&](f32x4 (&acc)[4][4], int wr, int wc, int fr, int fq) {
                ACC_FOREACH(Cs[row * 132 + col] = val;)
            }, smem);
        __syncthreads();
        const int tid = tid_;
        int b, j0, s; row_info(row0, b, j0, s);
        const bool lat = row0 < ML;
        if (nt <= 2) {
            const int r = tid & 127, hl = tid >> 7;
            const bool isq = nt < 2;
            const float* gain = (isq ? p.a_q_gain : p.a_k_gain) + layer * 64;
            float v[64]; float ss = 0.f;
#pragma unroll
            for (int d4 = 0; d4 < 16; ++d4) { const float4 t4 = *(const float4*)(Cs + r * 132 + hl * 64 + d4 * 4); v[d4 * 4] = t4.x; v[d4 * 4 + 1] = t4.y; v[d4 * 4 + 2] = t4.z; v[d4 * 4 + 3] = t4.w; ss += t4.x * t4.x + t4.y * t4.y + t4.z * t4.z + t4.w * t4.w; }
            const float rs = rsqrtf(ss * (1.f / 64.f) + 1e-6f);
#pragma unroll
            for (int d = 0; d < 64; ++d) v[d] = v[d] * rs * gain[d];
            if (lat) {
                const int t = (j0 - 256) + r;
#pragma unroll
                for (int a = 0; a < 2; ++a) {
                    const int pos = a == 0 ? (t >> 6) : (t & 63);
#pragma unroll
                    for (int f = 0; f < 16; ++f) {
                        const float cs = TA[(pos * 16 + f) * 2], sn = TA[(pos * 16 + f) * 2 + 1];
                        const float x0 = v[a * 32 + f], x1 = v[a * 32 + 16 + f];
                        v[a * 32 + f] = x0 * cs - x1 * sn; v[a * 32 + 16 + f] = x1 * cs + x0 * sn;
                    }
                }
            }
            const float qs = isq ? 0.125f * LOG2E : 1.f;
            bfu* dst = isq ? (bfu*)(ws_ + WS_QA) + (((size_t)b * 4 + (nt * 2 + hl)) * NKEY + j0 + r) * 64
                           : (bfu*)(ws_ + WS_KA) + (((size_t)b * 2 + hl) * NKEY + j0 + r) * 64;
#pragma unroll
            for (int d8 = 0; d8 < 8; ++d8)
                ((uint4*)dst)[d8] = make_uint4(pack2(v[d8 * 8] * qs, v[d8 * 8 + 1] * qs), pack2(v[d8 * 8 + 2] * qs, v[d8 * 8 + 3] * qs),
                                               pack2(v[d8 * 8 + 4] * qs, v[d8 * 8 + 5] * qs), pack2(v[d8 * 8 + 6] * qs, v[d8 * 8 + 7] * qs));
        } else if (nt == 3 || nt == 8 || nt == 9) {
            const int c = tid & 127, half = tid >> 7, hl = c >> 6, d = c & 63;
            bfu* dst = nt == 3 ? (bfu*)(ws_ + WS_VAT) + (((size_t)b * 2 + hl) * 64 + d) * NKEY + j0 + half * 64
                               : (bfu*)(ws_ + WS_VBT) + (((size_t)b * 4 + ((nt - 8) * 2 + hl)) * 64 + d) * NKEY + j0 + half * 64;
#pragma unroll
            for (int r8 = 0; r8 < 8; ++r8) {
                const float* s0 = Cs + (half * 64 + r8 * 8) * 132 + c;
                ((uint4*)dst)[r8] = make_uint4(pack2(s0[0], s0[132]), pack2(s0[2 * 132], s0[3 * 132]), pack2(s0[4 * 132], s0[5 * 132]), pack2(s0[6 * 132], s0[7 * 132]));
            }
        } else if (nt <= 7) {
            const bool isq = nt < 6;
            const int hbase = ((nt - 4) & 1) * 2;
#pragma unroll
            for (int itq = 0; itq < 2; ++itq) {
                const int u = tid + 256 * itq, r = u & 127, hm = u >> 7;
                float v[32];
#pragma unroll
                for (int d4 = 0; d4 < 8; ++d4) { const float4 t4 = *(const float4*)(Cs + r * 132 + hm * 32 + d4 * 4); v[d4 * 4] = t4.x; v[d4 * 4 + 1] = t4.y; v[d4 * 4 + 2] = t4.z; v[d4 * 4 + 3] = t4.w; }
                if (lat) {
                    const int t = (j0 - 256) + r;
#pragma unroll
                    for (int a = 0; a < 2; ++a) {
                        const int pos = a == 0 ? (t >> 6) : (t & 63);
#pragma unroll
                        for (int f = 0; f < 8; ++f) {
                            const float cs = TB[(pos * 8 + f) * 2], sn = TB[(pos * 8 + f) * 2 + 1];
                            const float x0 = v[a * 16 + f], x1 = v[a * 16 + 8 + f];
                            v[a * 16 + f] = x0 * cs - x1 * sn; v[a * 16 + 8 + f] = x1 * cs + x0 * sn;
                        }
                    }
                }
                const float qs = isq ? 0.17677669529663687f * LOG2E : 1.f;
                const int h = hbase + (hm >> 1), mp = hm & 1;
                bfu* dst = (bfu*)(ws_ + (isq ? WS_QB : WS_KB)) + (((size_t)b * 4 + h) * NKEY + j0 + r) * 64 + mp * 32;
#pragma unroll
                for (int d8 = 0; d8 < 4; ++d8)
                    ((uint4*)dst)[d8] = make_uint4(pack2(v[d8 * 8] * qs, v[d8 * 8 + 1] * qs), pack2(v[d8 * 8 + 2] * qs, v[d8 * 8 + 3] * qs),
                                                   pack2(v[d8 * 8 + 4] * qs, v[d8 * 8 + 5] * qs), pack2(v[d8 * 8 + 6] * qs, v[d8 * 8 + 7] * qs));
            }
        } else {
            const int r = tid & 127, half = tid >> 7;
            float* dst = (float*)(ws_ + WS_CP) + (size_t)(row0 + r) * CSL + (nt - 10) * 128 + half * 64;
#pragma unroll
            for (int d4 = 0; d4 < 16; ++d4) ((float4*)dst)[d4] = *(const float4*)(Cs + r * 132 + half * 64 + d4 * 4);
        }
        __syncthreads();
    }
}

__device__ void phase_gate(const P& p, int layer, int bid, int nb, char* smem) {
    PHASE_PROLOGUE
    const bfu* LXG = (const bfu*)(ws_ + WS_LXG); const bfu* Bt = (const bfu*)(ws_ + WS_LG2);
    float* GG = (float*)(ws_ + WS_GG);
    const int nitems = 144 * 4;
    for (int it = bid; it < nitems; it += nb) {
        const int mt = it >> 2, nt = it & 3, row0 = mt * 128, col0 = nt * 128;
        gemm_tile([&](int r) { return LXG + (size_t)(row0 + r) * 128; }, [&](int r) { return Bt + (size_t)(col0 + r) * 128; }, 128,
            [&](f32x4 (&acc)[4][4], int wr, int wc, int fr, int fq) {
                ACC_FOREACH(GG[(size_t)(row0 + row) * 512 + col0 + col] = val;)
            }, smem);
    }
}

#define OPS_AT 0
#define OPS_RT 2048
#define OPS_MAK 4096
#define OPS_T 5120
#define OPS_MRBK 6144
#define OPS_BK 7168
#define OPS_VF 11264
#define OPS_WC 13312
__device__ __forceinline__ char* ops_rec(char* ws_, int z, int seq, int c) { return ws_ + WS_OPS + ((size_t)(z * 64 + seq) * 144 + c) * OPS_REC; }
__device__ __forceinline__ float rdlane(float v, int l) { return __int_as_float(__builtin_amdgcn_readlane(__float_as_int(v), l)); }

__device__ __forceinline__ void chunk_tail(const float (&lw)[16], const float (&kk)[16], const float (&rr)[16], const float (&bb)[16], const float (&kd)[16], const float (&vv)[16],
                                           char* Lw, char* rec, int lane) {
    const int cl = lane & 15, g = lane >> 4;
    float Bt[16], Kt[16];
    float cum = 0.f, ep = 1.f;
#pragma unroll
    for (int t = 0; t < 16; ++t) {
        cum += lw[t];
        const float e = __expf(cum), ei = __expf(-cum);
        *(bfu*)(Lw + 0 + t * 128 + lane * 2) = f2bf(-kk[t] * ep);
        *(bfu*)(Lw + 2048 + t * 128 + lane * 2) = f2bf(rr[t] * e);
        Bt[t] = bb[t] * ei; Kt[t] = kd[t] * ei;
        *(bfu*)(Lw + 4096 + t * 128 + lane * 2) = f2bf(Bt[t]);
        *(bfu*)(Lw + 6144 + t * 128 + lane * 2) = f2bf(Kt[t]);
        ep = e;
    }
    const float eC = ep;
#pragma unroll
    for (int q = 0; q < 4; ++q) {
        *(uint4*)(rec + OPS_BK + ((lane >> 4) * 64 + cl + 16 * q) * 16) =
            make_uint4(pack2(Bt[4 * q] * eC, Bt[4 * q + 1] * eC), pack2(Bt[4 * q + 2] * eC, Bt[4 * q + 3] * eC), pack2(Kt[4 * q] * eC, Kt[4 * q + 1] * eC), pack2(Kt[4 * q + 2] * eC, Kt[4 * q + 3] * eC));
        *(uint2*)(rec + OPS_VF + ((lane >> 4) * 64 + cl + 16 * q) * 8) = make_uint2(pack2(vv[4 * q], vv[4 * q + 1]), pack2(vv[4 * q + 2], vv[4 * q + 3]));
    }
    *(float*)(rec + OPS_WC + lane * 4) = eC;
    f32x4 Mab = {0.f, 0.f, 0.f, 0.f}, Mak = Mab, Mrb = Mab, Mrk = Mab;
#pragma unroll
    for (int ks = 0; ks < 2; ++ks) {
        const int fo = cl * 128 + ks * 64 + g * 16;
        const bf16x8 aA = *(const bf16x8*)(Lw + 0 + fo), aR = *(const bf16x8*)(Lw + 2048 + fo), bB = *(const bf16x8*)(Lw + 4096 + fo), bK = *(const bf16x8*)(Lw + 6144 + fo);
        Mab = __builtin_amdgcn_mfma_f32_16x16x32_bf16(aA, bB, Mab, 0, 0, 0);
        Mak = __builtin_amdgcn_mfma_f32_16x16x32_bf16(aA, bK, Mak, 0, 0, 0);
        Mrb = __builtin_amdgcn_mfma_f32_16x16x32_bf16(aR, bB, Mrb, 0, 0, 0);
        Mrk = __builtin_amdgcn_mfma_f32_16x16x32_bf16(aR, bK, Mrk, 0, 0, 0);
    }
#pragma unroll
    for (int q = 0; q < 4; ++q) *(uint4*)(rec + OPS_AT + (lane + 64 * q) * 16) = *(const uint4*)(Lw + (lane + 64 * q) * 16);
#pragma unroll
    for (int q = 0; q < 4; ++q) {
        const int tau = 4 * g + q;
        if (!(cl < tau)) { Mab[q] = 0.f; Mak[q] = 0.f; }
        if (!(cl <= tau)) { Mrb[q] = 0.f; Mrk[q] = 0.f; }
    }
    float Tc[16];
#pragma unroll
    for (int t = 0; t < 16; ++t) {
        float acc = (t == cl) ? 1.f : 0.f;
#pragma unroll
        for (int j = 0; j < t; ++j) acc += rdlane(Mab[t & 3], j + 16 * (t >> 2)) * Tc[j];
        Tc[t] = acc;
    }
#pragma unroll
    for (int q = 0; q < 4; ++q) {
        const int tau = 4 * g + q;
        *(bfu*)(Lw + 8192 + tau * 32 + cl * 2) = f2bf(Mak[q]);
        *(bfu*)(Lw + 9216 + tau * 32 + cl * 2) = f2bf(Mrb[q]);
        *(bfu*)(Lw + 9728 + tau * 32 + cl * 2) = f2bf(Mrk[q]);
    }
    if (g == 0) {
#pragma unroll
        for (int t = 0; t < 16; ++t) *(bfu*)(Lw + 8704 + t * 32 + cl * 2) = f2bf(Tc[t]);
    }
    const uint2 fmak = *(const uint2*)(Lw + 8192 + cl * 32 + g * 8), ft = *(const uint2*)(Lw + 8704 + cl * 32 + g * 8);
    const uint2 fmrb = *(const uint2*)(Lw + 9216 + cl * 32 + g * 8), fmrk = *(const uint2*)(Lw + 9728 + cl * 32 + g * 8);
    *(uint4*)(rec + OPS_MAK + lane * 16) = make_uint4(fmak.x, fmak.y, 0u, 0u);
    *(uint4*)(rec + OPS_T + lane * 16) = make_uint4(ft.x, ft.y, 0u, 0u);
    *(uint4*)(rec + OPS_MRBK + lane * 16) = make_uint4(fmrb.x, fmrb.y, fmrk.x, fmrk.y);
}

__device__ __forceinline__ float sum64(float v) { v = sum8(v); v += dppf<0x140>(v); return (rdlane(v, 0) + rdlane(v, 16)) + (rdlane(v, 32) + rdlane(v, 48)); }
__device__ void phase_rk(const P& p, int layer, int bid, int nb, char* smem) {
    PHASE_PROLOGUE
    const int lane = tid_ & 63, wv = tid_ >> 6, cl = lane & 15, g = lane >> 4;
    char* Lw = smem + wv * 16384;
    const float* CP = (const float*)(ws_ + WS_CP);
    const float* mu = p.c_mu + layer * CSL;
    for (int it = bid * 4 + wv; it < 2 * 64 * 144; it += nb * 4) {
        const int c = it % 144, seq = (it / 144) & 63, z = it / (144 * 64), b = seq >> 3, h = seq & 7;
        const int grow0 = c < 16 ? ML + b * 256 + 16 * c : b * 2048 + 16 * (c - 16);
        const bool sstart = (c == 0 || c == 16), send = (c == 15 || c == 143);
        auto shifted = [&](int col, float (&out)[16]) {
            float P_[18];
#pragma unroll
            for (int q = 0; q < 18; ++q) {
                const int tau = q - 1, nat = z ? 15 - tau : tau;
                const bool ok = (nat >= 0 || !sstart) && (nat <= 15 || !send);
                P_[q] = ok ? CP[(size_t)(grow0 + nat) * CSL + col] : 0.f;
            }
            const float m = mu[col];
#pragma unroll
            for (int t = 0; t < 16; ++t) out[t] = P_[t + 1] + m * (0.5f * (P_[t] + P_[t + 2]) - P_[t + 1]);
        };
        float tmp[16], rr[16], kr[16], vv[16];
        shifted(1536 + z * 64 + lane, tmp);
#pragma unroll
        for (int t = 0; t < 16; ++t) *(bfu*)(Lw + 10240 + t * 128 + lane * 2) = f2bf(1.f - 2.f / (1.f + __expf(2.f * tmp[t])));
        shifted(1664 + z * 64 + lane, tmp);
#pragma unroll
        for (int t = 0; t < 16; ++t) *(bfu*)(Lw + 12288 + t * 128 + lane * 2) = f2bf(tmp[t]);
        if (z == 0 && lane < 16) {
            shifted(1792 + h * 16 + lane, tmp);
            bfu* LXG = (bfu*)(ws_ + WS_LXG);
#pragma unroll
            for (int t = 0; t < 16; ++t) LXG[(size_t)(grow0 + t) * 128 + h * 16 + lane] = f2bf(sigmoidf_(tmp[t]));
        }
        shifted(h * 64 + lane, rr);
        shifted(512 + h * 64 + lane, kr);
        shifted(1024 + h * 64 + lane, vv);
        const bfu* W2 = (const bfu*)(ws_ + WS_LW2) + ((size_t)z * 512 + h * 64) * 64;
        const bfu* A2 = (const bfu*)(ws_ + WS_LA2) + ((size_t)z * 512 + h * 64) * 64;
        float prew[16], prea[16];
#pragma unroll
        for (int which = 0; which < 2; ++which) {
            const bfu* Wm = which ? A2 : W2; const char* Xs = Lw + (which ? 12288 : 10240);
            f32x4 ac[4];
#pragma unroll
            for (int n = 0; n < 4; ++n) ac[n] = (f32x4){0.f, 0.f, 0.f, 0.f};
#pragma unroll
            for (int ks = 0; ks < 2; ++ks) {
                const bf16x8 af = *(const bf16x8*)(Xs + cl * 128 + ks * 64 + g * 16);
#pragma unroll
                for (int n = 0; n < 4; ++n) {
                    const bf16x8 bf = *(const bf16x8*)(Wm + (size_t)(16 * n + cl) * 64 + ks * 32 + g * 8);
                    ac[n] = __builtin_amdgcn_mfma_f32_16x16x32_bf16(af, bf, ac[n], 0, 0, 0);
                }
            }
#pragma unroll
            for (int n = 0; n < 4; ++n)
#pragma unroll
                for (int q = 0; q < 4; ++q) *(float*)(Lw + (4 * g + q) * 256 + (16 * n + cl) * 4) = ac[n][q];
#pragma unroll
            for (int t = 0; t < 16; ++t) { const float x = *(const float*)(Lw + t * 256 + lane * 4); if (which) prea[t] = x; else prew[t] = x; }
        }
        const int ch = h * 64 + lane;
        const float w0v = p.c_w0[((size_t)layer * 2 + z) * 512 + ch], a0v = p.c_a0[((size_t)layer * 2 + z) * 512 + ch];
        const float kkv = p.c_k_k[layer * 512 + ch], kav = p.c_k_a[layer * 512 + ch], rkv = p.c_r_k[layer * 512 + ch];
        float lw[16], kk[16], bb[16];
        float* BETA = (float*)(ws_ + WS_BETA) + (size_t)z * MA * 8;
#pragma unroll
        for (int t = 0; t < 16; ++t) {
            const float nx = -(w0v + prew[t]);
            const float sp = nx > 20.f ? nx : __logf(1.f + __expf(nx));
            lw[t] = -__expf(-sp - 0.5f);
            const float icl = sigmoidf_(a0v + prea[t]);
            const float kv = kr[t] * kkv;
            const float ss = sum64(kv * kv);
            kk[t] = kv * rsqrtf(fmaxf(ss, 1e-24f));
            kr[t] = kr[t] * (1.f + (icl - 1.f) * kav);
            bb[t] = kk[t] * icl;
            const float bs = sum64(rr[t] * kr[t] * rkv);
            const int nat = z ? 15 - t : t;
            if (lane == 0) BETA[(size_t)(grow0 + nat) * 8 + h] = bs;
        }
        if (z == 0) {
            bfu* VB = (bfu*)(ws_ + WS_VB);
#pragma unroll
            for (int t = 0; t < 16; ++t) VB[(size_t)(grow0 + t) * 512 + ch] = f2bf(vv[t]);
        }
        chunk_tail(lw, kk, rr, bb, kr, vv, Lw, ops_rec(ws_, z, seq, c), lane);
    }
}

struct R4Ops { uint2 at[2][2], rt[2][2]; uint4 mak, tt, mrbk, bk[4]; uint2 vf; float4 wc[4]; };
__device__ __forceinline__ void r4_load(R4Ops& o, const char* rec, int lane, int vt) {
    const int cl = lane & 15, g = lane >> 4;
#pragma unroll
    for (int ks = 0; ks < 2; ++ks) {
        o.at[ks][0] = *(const uint2*)(rec + OPS_AT + cl * 128 + (32 * ks + 4 * g) * 2); o.at[ks][1] = *(const uint2*)(rec + OPS_AT + cl * 128 + (32 * ks + 16 + 4 * g) * 2);
        o.rt[ks][0] = *(const uint2*)(rec + OPS_RT + cl * 128 + (32 * ks + 4 * g) * 2); o.rt[ks][1] = *(const uint2*)(rec + OPS_RT + cl * 128 + (32 * ks + 16 + 4 * g) * 2);
    }
    o.mak = *(const uint4*)(rec + OPS_MAK + lane * 16); o.tt = *(const uint4*)(rec + OPS_T + lane * 16); o.mrbk = *(const uint4*)(rec + OPS_MRBK + lane * 16);
#pragma unroll
    for (int kt = 0; kt < 4; ++kt) { o.bk[kt] = *(const uint4*)(rec + OPS_BK + (kt * 64 + lane) * 16); o.wc[kt] = *(const float4*)(rec + OPS_WC + (16 * kt + 4 * g) * 4); }
    o.vf = *(const uint2*)(rec + OPS_VF + (vt * 64 + lane) * 8);
}
__device__ __forceinline__ bf16x8 mk8(unsigned a, unsigned b, unsigned c, unsigned d) { union { bf16x8 v; unsigned u[4]; } x; x.u[0] = a; x.u[1] = b; x.u[2] = c; x.u[3] = d; return x.v; }
__device__ void phase_r4(const P& p, int layer, int bid, int nb, char* smem) {
    PHASE_PROLOGUE
    const int lane = tid_ & 63, vt = tid_ >> 6, cl = lane & 15, g = lane >> 4;
    for (int it = bid; it < 128; it += nb) {
        const int z = it >> 6, seq = it & 63;
        float* Y = (float*)(ws_ + WS_YS) + (size_t)z * (HEADARR / 4) + (size_t)seq * NKEY * 64;
        f32x4 acc[4];
#pragma unroll
        for (int kt = 0; kt < 4; ++kt) acc[kt] = (f32x4){0.f, 0.f, 0.f, 0.f};
        R4Ops cur, nxt;
        auto chunk_of = [&](int ci) { return z ? (ci < 16 ? 15 - ci : 143 - (ci - 16)) : ci; };
        r4_load(cur, ops_rec(ws_, z, seq, chunk_of(0)), lane, vt);
        for (int ci = 0; ci < 144; ++ci) {
            const int c = chunk_of(ci);
            if (ci + 1 < 144) r4_load(nxt, ops_rec(ws_, z, seq, chunk_of(ci + 1)), lane, vt);
            const f32x4 zero4 = {0.f, 0.f, 0.f, 0.f};
            bf16x8 sb[2];
#pragma unroll
            for (int ks = 0; ks < 2; ++ks)
                sb[ks] = mk8(pack2(acc[2 * ks][0], acc[2 * ks][1]), pack2(acc[2 * ks][2], acc[2 * ks][3]), pack2(acc[2 * ks + 1][0], acc[2 * ks + 1][1]), pack2(acc[2 * ks + 1][2], acc[2 * ks + 1][3]));
            f32x4 Z = __builtin_amdgcn_mfma_f32_16x16x32_bf16(mk8(cur.at[0][0].x, cur.at[0][0].y, cur.at[0][1].x, cur.at[0][1].y), sb[0], zero4, 0, 0, 0);
            Z = __builtin_amdgcn_mfma_f32_16x16x32_bf16(mk8(cur.at[1][0].x, cur.at[1][0].y, cur.at[1][1].x, cur.at[1][1].y), sb[1], Z, 0, 0, 0);
            Z = __builtin_amdgcn_mfma_f32_16x16x32_bf16(mk8(cur.mak.x, cur.mak.y, cur.mak.z, cur.mak.w), mk8(cur.vf.x, cur.vf.y, 0u, 0u), Z, 0, 0, 0);
            f32x4 Yv = __builtin_amdgcn_mfma_f32_16x16x32_bf16(mk8(cur.rt[0][0].x, cur.rt[0][0].y, cur.rt[0][1].x, cur.rt[0][1].y), sb[0], zero4, 0, 0, 0);
            Yv = __builtin_amdgcn_mfma_f32_16x16x32_bf16(mk8(cur.rt[1][0].x, cur.rt[1][0].y, cur.rt[1][1].x, cur.rt[1][1].y), sb[1], Yv, 0, 0, 0);
            const f32x4 U = __builtin_amdgcn_mfma_f32_16x16x32_bf16(mk8(cur.tt.x, cur.tt.y, cur.tt.z, cur.tt.w), mk8(pack2(Z[0], Z[1]), pack2(Z[2], Z[3]), 0u, 0u), zero4, 0, 0, 0);
            const bf16x8 ub = mk8(pack2(U[0], U[1]), pack2(U[2], U[3]), cur.vf.x, cur.vf.y);
            Yv = __builtin_amdgcn_mfma_f32_16x16x32_bf16(mk8(cur.mrbk.x, cur.mrbk.y, cur.mrbk.z, cur.mrbk.w), ub, Yv, 0, 0, 0);
#pragma unroll
            for (int kt = 0; kt < 4; ++kt) {
                f32x4 a = acc[kt];
                a[0] *= cur.wc[kt].x; a[1] *= cur.wc[kt].y; a[2] *= cur.wc[kt].z; a[3] *= cur.wc[kt].w;
                acc[kt] = __builtin_amdgcn_mfma_f32_16x16x32_bf16(mk8(cur.bk[kt].x, cur.bk[kt].y, cur.bk[kt].z, cur.bk[kt].w), ub, a, 0, 0, 0);
            }
#pragma unroll
            for (int q = 0; q < 4; ++q) {
                const int tau = 4 * g + q, t = z ? 15 - tau : tau;
                Y[(size_t)(16 * c + t) * 64 + vt * 16 + cl] = Yv[q];
            }
            cur = nxt;
        }
    }
}

__device__ void phase_readout(const P& p, int layer, int nrows, int bid, int nb) {
    PHASE_PROLOGUE
    const float* Y0 = (const float*)(ws_ + WS_YS); const float* Y1 = Y0 + HEADARR / 4;
    const bfu* VB = (const bfu*)(ws_ + WS_VB); const float* B0 = (const float*)(ws_ + WS_BETA); const float* B1 = B0 + (size_t)MA * 8;
    const float* GG = (const float*)(ws_ + WS_GG);
    bfu* MIX = (bfu*)(ws_ + WS_MIX);
    const float* lnw = p.c_ln_w + layer * 512; const float* lnb = p.c_ln_b + layer * 512;
    const int lane = tid_ & 63, wv = tid_ >> 6;
    for (int row = bid * 4 + wv; row < nrows; row += nb * 4) {
        int b, j, s; row_info(row, b, j, s);
#pragma unroll
        for (int h = 0; h < 8; ++h) {
            const size_t o = (((size_t)b * 8 + h) * NKEY + j) * 64 + lane;
            const float y = Y0[o] + Y1[o];
            const float mean = sum64(y) * (1.f / 64.f);
            const float dv = y - mean;
            const float var = sum64(dv * dv) * (1.f / 64.f);
            const float yn = dv * rsqrtf(var + 64e-5f) * lnw[h * 64 + lane] + lnb[h * 64 + lane];
            const float bs = B0[(size_t)row * 8 + h] + B1[(size_t)row * 8 + h];
            const float outv = (yn + bs * bf2f(VB[(size_t)row * 512 + h * 64 + lane])) * GG[(size_t)row * 512 + h * 64 + lane];
            MIX[(size_t)row * DM + 512 + h * 64 + lane] = f2bf(outv);
        }
    }
}

using f32x16 = __attribute__((ext_vector_type(16))) float;
#define AT_KBYTES 8192
#define AT_VSTRIDE 136
#define AT_VBYTES (64 * AT_VSTRIDE)
template <int GRP>
__device__ __forceinline__ void attn_item(const P& p, char* ws_, int layer, int b, int h, int qb, int nkeys, float lam, float lam_init, char* smem, int tid) {
    constexpr int KS = GRP ? 2 : 4;
    const int lane = tid & 63, wv = tid >> 6, r32 = lane & 31, hh = lane >> 5;
    const int mp = GRP ? (wv >> 1) : 0, sub = GRP ? (wv & 1) : wv;
    const int jq = qb * (GRP ? 64 : 128) + sub * 32 + r32;
    const bfu* Qg = (const bfu*)(ws_ + (GRP ? WS_QB : WS_QA)) + (((size_t)b * 4 + h) * NKEY + jq) * 64 + mp * 32;
    const bfu* Kg = GRP ? (const bfu*)(ws_ + WS_KB) + ((size_t)b * 4 + h) * NKEY * 64 : (const bfu*)(ws_ + WS_KA) + ((size_t)b * 2 + (h >> 1)) * NKEY * 64;
    const bfu* Vg = GRP ? (const bfu*)(ws_ + WS_VBT) + ((size_t)b * 4 + h) * 64 * NKEY : (const bfu*)(ws_ + WS_VAT) + ((size_t)b * 2 + (h >> 1)) * 64 * NKEY;
    bf16x8 qf[KS];
#pragma unroll
    for (int ks = 0; ks < KS; ++ks) qf[ks] = *(const bf16x8*)(Qg + ks * 16 + hh * 8);
    f32x16 oacc[2];
    float lrun = 0.f;
#pragma unroll
    for (int db = 0; db < 2; ++db)
#pragma unroll
        for (int i = 0; i < 16; ++i) oacc[db][i] = 0.f;
    const int lrow = tid >> 3, lch = ((tid & 7) ^ ((tid >> 4) & 7)) * 8;
    const bfu* kp0 = Kg + (size_t)lrow * 64 + lch; const bfu* kp1 = kp0 + 32 * 64;
    const bfu* vp0 = Vg + (size_t)lrow * NKEY + lch; const bfu* vp1 = vp0 + (size_t)32 * NKEY;
    char* ldst = smem + tid * 16;
#define AT_ISSUE(t_) { char* d_ = ldst + ((t_) & 1) * 16384; const size_t ko_ = (size_t)(t_) * 64 * 64; const int vo_ = (t_) * 64; \
        GLDS(kp0 + ko_, d_); GLDS(kp1 + ko_, d_ + 4096); GLDS(vp0 + vo_, d_ + 8192); GLDS(vp1 + vo_, d_ + 12288); }
    __syncthreads();
    AT_ISSUE(0)
    const int nt = nkeys >> 6;
    float mref = 0.f;
    const int swv = (r32 >> 1) & 7;
    for (int t = 0; t < nt; ++t) {
        asm volatile("s_waitcnt vmcnt(0)" ::: "memory");
        __syncthreads();
        if (t + 1 < nt) AT_ISSUE(t + 1)
        const char* cK = smem + (t & 1) * 16384; const char* cV = cK + 8192;
        f32x16 sacc[2];
        const float ninit = -mref;
#pragma unroll
        for (int kb = 0; kb < 2; ++kb) {
#pragma unroll
            for (int i = 0; i < 16; ++i) sacc[kb][i] = ninit;
            const int key = kb * 32 + r32;
#pragma unroll
            for (int ks = 0; ks < KS; ++ks) {
                const int c0 = mp * 4 + ks * 2 + hh;
                const bf16x8 kf = *(const bf16x8*)(cK + key * 128 + ((c0 ^ ((key >> 1) & 7)) * 16));
                sacc[kb] = __builtin_amdgcn_mfma_f32_32x32x16_bf16(kf, qf[ks], sacc[kb], 0, 0, 0);
            }
        }
        float mx = sacc[0][0];
#pragma unroll
        for (int i = 1; i < 16; ++i) mx = fmaxf(mx, sacc[0][i]);
#pragma unroll
        for (int i = 0; i < 16; ++i) mx = fmaxf(mx, sacc[1][i]);
        mx = fmaxf(mx, __shfl_xor(mx, 32));
        const bool need = (t == 0) || (mx > 8.f);
        if (__any(need)) {
            const float delta = need ? mx : 0.f;
            const float alpha = __builtin_amdgcn_exp2f(-delta);
            mref += delta; lrun *= alpha;
#pragma unroll
            for (int db = 0; db < 2; ++db)
#pragma unroll
                for (int i = 0; i < 16; ++i) oacc[db][i] *= alpha;
#pragma unroll
            for (int kb = 0; kb < 2; ++kb)
#pragma unroll
                for (int i = 0; i < 16; ++i) sacc[kb][i] -= delta;
        }
        float ps = 0.f;
#pragma unroll
        for (int kb = 0; kb < 2; ++kb)
#pragma unroll
            for (int i = 0; i < 16; ++i) { const float pv = __builtin_amdgcn_exp2f(sacc[kb][i]); sacc[kb][i] = pv; ps += pv; }
        lrun += ps;
#pragma unroll
        for (int kb = 0; kb < 2; ++kb)
#pragma unroll
            for (int s2 = 0; s2 < 2; ++s2) {
                union { bf16x8 v; unsigned u[4]; } pf;
#pragma unroll
                for (int i = 0; i < 4; ++i) pf.u[i] = pack2(sacc[kb][8 * s2 + 2 * i], sacc[kb][8 * s2 + 2 * i + 1]);
#pragma unroll
                for (int db = 0; db < 2; ++db) {
                    const char* vr = cV + (db * 32 + r32) * 128 + hh * 8;
                    union { bf16x8 v; uint2 u[2]; } vf;
                    vf.u[0] = *(const uint2*)(vr + (((kb * 4 + s2 * 2) ^ swv) * 16)); vf.u[1] = *(const uint2*)(vr + (((kb * 4 + s2 * 2 + 1) ^ swv) * 16));
                    oacc[db] = __builtin_amdgcn_mfma_f32_32x32x16_bf16(vf.v, pf.v, oacc[db], 0, 0, 0);
                }
            }
    }
    __syncthreads();
    bfu* MIX = (bfu*)(ws_ + WS_MIX);
    const int grow = grow_of(b, jq);
    const float il = 1.f / (lrun + __shfl_xor(lrun, 32));
    if (GRP == 0) {
        bfu* dst = MIX + (size_t)grow * DM + h * 64;
#pragma unroll
        for (int db = 0; db < 2; ++db)
#pragma unroll
            for (int g = 0; g < 4; ++g)
                *(uint2*)(dst + db * 32 + g * 8 + hh * 4) = make_uint2(pack2(oacc[db][4 * g] * il, oacc[db][4 * g + 1] * il), pack2(oacc[db][4 * g + 2] * il, oacc[db][4 * g + 3] * il));
    } else {
        float* xs = (float*)smem + sub * 2048;
        if (mp == 1) {
            const float sc2 = lam * il;
#pragma unroll
            for (int db = 0; db < 2; ++db)
#pragma unroll
                for (int i = 0; i < 16; ++i) xs[(db * 16 + i) * 64 + lane] = oacc[db][i] * sc2;
        }
        __syncthreads();
        if (mp == 0) {
            float ss = 0.f;
#pragma unroll
            for (int db = 0; db < 2; ++db)
#pragma unroll
                for (int i = 0; i < 16; ++i) { const float o = oacc[db][i] * il - xs[(db * 16 + i) * 64 + lane]; oacc[db][i] = o; ss += o * o; }
            ss += __shfl_xor(ss, 32);
            const float rs = rsqrtf(ss * (1.f / 64.f) + 1e-6f) * (1.f - lam_init);
            const float* gn = p.b_subln + layer * 64;
            bfu* dst = MIX + (size_t)grow * DM + 256 + h * 64;
#pragma unroll
            for (int db = 0; db < 2; ++db)
#pragma unroll
                for (int g = 0; g < 4; ++g) {
                    const int d = db * 32 + g * 8 + hh * 4;
                    *(uint2*)(dst + d) = make_uint2(pack2(oacc[db][4 * g] * rs * gn[d], oacc[db][4 * g + 1] * rs * gn[d + 1]), pack2(oacc[db][4 * g + 2] * rs * gn[d + 2], oacc[db][4 * g + 3] * rs * gn[d + 3]));
                }
        }
    }
}
__device__ void phase_attn(const P& p, int layer, bool do_ctx, unsigned* qctr, int* s_item, char* smem) {
    PHASE_PROLOGUE
    const int tid = tid_;
    const float lam_init = 0.8f - 0.6f * expf(-0.3f * (float)layer);
    float d1 = 0.f, d2 = 0.f;
    for (int i = 0; i < 32; ++i) { d1 += p.b_lq1[layer * 32 + i] * p.b_lk1[layer * 32 + i]; d2 += p.b_lq2[layer * 32 + i] * p.b_lk2[layer * 32 + i]; }
    const float lam = expf(d1) - expf(d2) + lam_init;
    const int nitems = do_ctx ? 1728 : 1536;
    for (;;) {
        __syncthreads();
        if (tid == 0) *s_item = (int)atomicAdd(qctr, 1u);
        __syncthreads();
        const int it = *s_item;
        if (it >= nitems) break;
        int grp, b, h, qb, nkeys;
        if (it < 1024) { grp = 1; qb = 4 + (it & 31); h = (it >> 5) & 3; b = it >> 7; nkeys = NKEY; }
        else if (it < 1536) { grp = 0; const int r = it - 1024; qb = 2 + (r & 15); h = (r >> 4) & 3; b = r >> 6; nkeys = NKEY; }
        else if (it < 1664) { grp = 1; const int r = it - 1536; qb = r & 3; h = (r >> 2) & 3; b = r >> 4; nkeys = 256; }
        else { grp = 0; const int r = it - 1664; qb = r & 1; h = (r >> 1) & 3; b = r >> 3; nkeys = 256; }
        if (grp) attn_item<1>(p, ws_, layer, b, h, qb, nkeys, lam, lam_init, smem, tid);
        else attn_item<0>(p, ws_, layer, b, h, qb, nkeys, lam, lam_init, smem, tid);
    }
}

__device__ void phase_outproj(const P& p, int layer, int nrows, int bid, int nb, char* smem) {
    PHASE_PROLOGUE
    const bfu* MIX = (const bfu*)(ws_ + WS_MIX); const bfu* W = (const bfu*)(ws_ + WS_WOUT);
    float* X = (float*)(ws_ + WS_X); const float* mod = (const float*)(ws_ + WS_MOD);
    const int nitems = (nrows / 128) * 8;
    for (int it = bid; it < nitems; it += nb) {
        const int mt = it >> 3, nt = it & 7, row0 = mt * 128, col0 = nt * 128;
        int b, j0, s; row_info(row0, b, j0, s);
        const float* ga = mod + ((size_t)layer * 9 + s) * 6144 + 2 * 1024;
        gemm_tile([&](int r) { return MIX + (size_t)(row0 + r) * DM; }, [&](int r) { return W + (size_t)(col0 + r) * DM; }, DM,
            [&](f32x4 (&acc)[4][4], int wr, int wc, int fr, int fq) {
                ACC_FOREACH({ float* xp = X + (size_t)(row0 + row) * DM + col0 + col; *xp += ga[col0 + col] * val; })
            }, smem);
    }
}

__device__ void phase_norm2_route(const P& p, int layer, int nrows, int bid, int nb, char* smem) {
    PHASE_PROLOGUE
    const float* X = (const float*)(ws_ + WS_X); bfu* H = (bfu*)(ws_ + WS_H);
    const float* mod = (const float*)(ws_ + WS_MOD); const float* WRT = (const float*)(ws_ + WS_WRT);
    int* ECNT = (int*)(ws_ + WS_ECNT) + layer * 32; int* EIDX = (int*)(ws_ + WS_EIDX); float* EGATE = (float*)(ws_ + WS_EGATE); int* ELIST = (int*)(ws_ + WS_ELIST);
    float* lg = (float*)smem;
    int* lcnt = (int*)(lg + 4 * 16 * 48);
    int* lbase = lcnt + 32;
    int* lsel = lbase + 32;
    int* lrank = lsel + 128;
    const int tid = tid_, lane = tid & 63, wv = tid >> 6, r = lane & 15, kq = lane >> 4;
    const float* gf = p.g_ffn + layer * DM;
    const float* bg = p.r_b_group + layer * 4; const float* be = p.r_b_expert + layer * 32;
    const int nitems = nrows / 64;
    for (int it = bid; it < nitems; it += nb) {
        const int row = it * 64 + wv * 16 + r;
        int b, j, s; row_info(row, b, j, s);
        const float* xr = X + (size_t)row * DM;
        const float* sh = mod + ((size_t)layer * 9 + s) * 6144 + 3 * 1024; const float* sc = sh + 1024;
        if (tid < 32) lcnt[tid] = 0;
        float ss = 0.f;
        for (int c = 0; c < 64; ++c) { const float4 v = *(const float4*)(xr + c * 16 + kq * 4); ss += v.x * v.x + v.y * v.y + v.z * v.z + v.w * v.w; }
        ss += __shfl_xor(ss, 16); ss += __shfl_xor(ss, 32);
        const float rs = rsqrtf(ss * (1.f / 1024.f) + 1e-6f);
        f32x4 acc[3];
#pragma unroll
        for (int n = 0; n < 3; ++n) acc[n] = (f32x4){0.f, 0.f, 0.f, 0.f};
        for (int c = 0; c < 64; ++c) {
            const int k = c * 16 + kq * 4;
            const float4 v = *(const float4*)(xr + k), g = *(const float4*)(gf + k), s1 = *(const float4*)(sc + k), s0 = *(const float4*)(sh + k);
            float f[4];
            f[0] = v.x * rs * g.x * (1.f + s1.x) + s0.x; f[1] = v.y * rs * g.y * (1.f + s1.y) + s0.y;
            f[2] = v.z * rs * g.z * (1.f + s1.z) + s0.z; f[3] = v.w * rs * g.w * (1.f + s1.w) + s0.w;
            *(uint2*)(H + (size_t)row * DM + k) = make_uint2(pack2(f[0], f[1]), pack2(f[2], f[3]));
#pragma unroll
            for (int n = 0; n < 3; ++n) {
                const float4 w = *(const float4*)(WRT + (size_t)(n * 16 + r) * DM + k);
                acc[n] = __builtin_amdgcn_mfma_f32_16x16x4f32(f[0], w.x, acc[n], 0, 0, 0);
                acc[n] = __builtin_amdgcn_mfma_f32_16x16x4f32(f[1], w.y, acc[n], 0, 0, 0);
                acc[n] = __builtin_amdgcn_mfma_f32_16x16x4f32(f[2], w.z, acc[n], 0, 0, 0);
                acc[n] = __builtin_amdgcn_mfma_f32_16x16x4f32(f[3], w.w, acc[n], 0, 0, 0);
            }
        }
#pragma unroll
        for (int n = 0; n < 3; ++n)
#pragma unroll
            for (int jj = 0; jj < 4; ++jj) lg[(wv * 16 + kq * 4 + jj) * 48 + n * 16 + r] = acc[n][jj];
        __syncthreads();
        if (lane < 16) {
            const float* L = lg + (wv * 16 + lane) * 48;
            const int grow = it * 64 + wv * 16 + lane;
            float gl[4]; float gm = -1e30f; int gi = 0;
#pragma unroll
            for (int g = 0; g < 4; ++g) { gl[g] = L[g] + bg[g]; if (gl[g] > gm) { gm = gl[g]; gi = g; } }
            float gs = 0.f;
#pragma unroll
            for (int g = 0; g < 4; ++g) gs += __expf(gl[g] - gm);
            const float gp = 1.f / gs;
            float v1 = -1e30f, v2 = -1e30f; int i1 = 0, i2 = 0;
            for (int e = 0; e < 8; ++e) {
                const float v = L[4 + gi * 8 + e] + be[gi * 8 + e];
                if (v > v1) { v2 = v1; i2 = i1; v1 = v; i1 = e; } else if (v > v2) { v2 = v; i2 = e; }
            }
            const float e2 = __expf(v2 - v1), den = 1.f / (1.f + e2);
            const int ex1 = gi * 8 + i1, ex2 = gi * 8 + i2;
            EIDX[grow * 2] = ex1; EIDX[grow * 2 + 1] = ex2;
            EGATE[grow * 2] = den * gp; EGATE[grow * 2 + 1] = e2 * den * gp;
            const int lr = wv * 16 + lane;
            lsel[lr * 2] = ex1; lsel[lr * 2 + 1] = ex2;
            lrank[lr * 2] = atomicAdd(&lcnt[ex1], 1); lrank[lr * 2 + 1] = atomicAdd(&lcnt[ex2], 1);
        }
        __syncthreads();
        if (tid < 32) lbase[tid] = lcnt[tid] > 0 ? atomicAdd(&ECNT[tid], lcnt[tid]) : 0;
        __syncthreads();
        if (tid < 128) { const int e = lsel[tid]; ELIST[(size_t)e * (2 * MA) + lbase[e] + lrank[tid]] = ((it * 64 + (tid >> 1)) << 1) | (tid & 1); }
        __syncthreads();
    }
}

__device__ __forceinline__ int moe_prefix(const int* ECNT, int* spre  ) {
    if (threadIdx.x == 0) { int a = 0; for (int e = 0; e < 32; ++e) { spre[e] = a; a += (ECNT[e] + 127) >> 7; } spre[32] = a; }
    __syncthreads();
    return spre[32];
}
__device__ void phase_expert1(const P& p, int layer, int bid, int nb, char* smem) {
    PHASE_PROLOGUE
    const bfu* H = (const bfu*)(ws_ + WS_H); const bfu* W1 = (const bfu*)(ws_ + WS_W1); const bfu* W3 = (const bfu*)(ws_ + WS_W3);
    bfu* HB = (bfu*)(ws_ + WS_HB);
    const int* ECNT = (const int*)(ws_ + WS_ECNT) + layer * 32; const int* ELIST = (const int*)(ws_ + WS_ELIST);
    int* spre = (int*)(smem + 65536);
    const int nblk = moe_prefix(ECNT, spre);
    const int nitems = nblk * 8;
    for (int it = bid; it < nitems; it += nb) {
        const int blk = it >> 3, nt = it & 7;
        int e = 0;
        while (spre[e + 1] <= blk) ++e;
        const int rb = blk - spre[e], cnt = ECNT[e];
        const int* lst = ELIST + (size_t)e * (2 * MA) + rb * 128;
        const int nvalid = min(128, cnt - rb * 128);
        const bfu* w1 = W1 + (size_t)e * FF * DM; const bfu* w3 = W3 + (size_t)e * FF * DM;
        bfu* hb = HB + (size_t)blk * 128 * FF;
        gemm_tile([&](int r) { const int tok = r < nvalid ? (lst[r] >> 1) : 0; return H + (size_t)tok * DM; },
                  [&](int r) { const int wcx = r >> 6, n4 = (r >> 4) & 3, rr = r & 15; const int hc = nt * 64 + wcx * 32 + (n4 & 1) * 16 + rr; return (n4 < 2 ? w1 : w3) + (size_t)hc * DM; }, DM,
            [&](f32x4 (&acc)[4][4], int wr, int wc, int fr, int fq) {
#pragma unroll
                for (int m = 0; m < 4; ++m)
#pragma unroll
                    for (int n = 0; n < 2; ++n)
#pragma unroll
                        for (int jj = 0; jj < 4; ++jj) {
                            const int row = wr * 64 + m * 16 + fq * 4 + jj; const int hc = nt * 64 + wc * 32 + n * 16 + fr;
                            const float a = acc[m][n][jj], g = acc[m][n + 2][jj];
                            hb[(size_t)row * FF + hc] = f2bf(siluf_(a) * g);
                        }
            }, smem);
    }
}
__device__ void phase_expert2(const P& p, int layer, int bid, int nb, char* smem) {
    PHASE_PROLOGUE
    const bfu* HB = (const bfu*)(ws_ + WS_HB); const bfu* W2 = (const bfu*)(ws_ + WS_W2);
    float* Y = (float*)(ws_ + WS_Y01);
    const int* ECNT = (const int*)(ws_ + WS_ECNT) + layer * 32; const int* ELIST = (const int*)(ws_ + WS_ELIST); const float* EGATE = (const float*)(ws_ + WS_EGATE);
    int* spre = (int*)(smem + 65536);
    const int nblk = moe_prefix(ECNT, spre);
    const int nitems = nblk * 8;
    for (int it = bid; it < nitems; it += nb) {
        const int blk = it >> 3, nt = it & 7;
        int e = 0;
        while (spre[e + 1] <= blk) ++e;
        const int rb = blk - spre[e], cnt = ECNT[e];
        const int* lst = ELIST + (size_t)e * (2 * MA) + rb * 128;
        const int nvalid = min(128, cnt - rb * 128);
        const bfu* w2 = W2 + (size_t)e * DM * FF;
        const bfu* hb = HB + (size_t)blk * 128 * FF;
        gemm_tile([&](int r) { return hb + (size_t)r * FF; }, [&](int r) { return w2 + (size_t)(nt * 128 + r) * FF; }, FF,
            [&](f32x4 (&acc)[4][4], int wr, int wc, int fr, int fq) {
#pragma unroll
                for (int m = 0; m < 4; ++m)
#pragma unroll
                    for (int jj = 0; jj < 4; ++jj) {
                        const int row = wr * 64 + m * 16 + fq * 4 + jj;
                        if (row < nvalid) {
                            const int ent = lst[row]; const float gt = EGATE[ent];
                            float* yp = Y + ((size_t)(ent & 1) * MA + (ent >> 1)) * DM + nt * 128 + wc * 64 + fr;
#pragma unroll
                            for (int n = 0; n < 4; ++n) yp[n * 16] = gt * acc[m][n][jj];
                        }
                    }
            }, smem);
    }
}

#define XB_TMO      128
#define XB_XCNT(j)  (256  + 64 * (j))
#define XB_XSUB(j)  (1280 + 64 * (j))
#define XB_XGEN(j)  (2304 + 64 * (j))
#define XB_TOP      3328
#define XB_TOPGEN   3392
#define XCD_BAR_WORDS 3456
#define XB_SPIN_CAP (1u << 22)
#define LAS __attribute__((address_space(3)))

__device__ __forceinline__ unsigned xb_ld(unsigned* p)              { return __hip_atomic_load(p, __ATOMIC_RELAXED, __HIP_MEMORY_SCOPE_AGENT); }
__device__ __forceinline__ unsigned xb_add(unsigned* p, unsigned v) { return __hip_atomic_fetch_add(p, v, __ATOMIC_RELAXED, __HIP_MEMORY_SCOPE_AGENT); }
__device__ __forceinline__ unsigned xb_xcc_id() { return (unsigned)__builtin_amdgcn_s_getreg((3 << 11) | 20) & 0xFu; }
#define XB_SPIN(cond, bar) do { unsigned _sp = 0; while (cond) { __builtin_amdgcn_s_sleep(1); \
    if ((++_sp & 255u) == 0u) { if (xb_ld(&(bar)[XB_TMO])) break; if (_sp > XB_SPIN_CAP) { atomicAdd(&(bar)[XB_TMO], 1u); break; } } } } while (0)

struct XcdBarrier {
    unsigned* bar; unsigned x;
    volatile LAS unsigned* st;
};

__device__ __forceinline__ XcdBarrier xcd_barrier_post(unsigned* bar, volatile LAS unsigned* st) {
    XcdBarrier b; b.bar = bar; b.x = xb_xcc_id(); b.st = st;
    if (threadIdx.x == 0) (void)xb_add(&bar[XB_XCNT(b.x)], 1u);
    return b;
}
__device__ __forceinline__ void xcd_barrier_complete(unsigned* bar, unsigned x, unsigned& nloc, unsigned& nx) {
    const unsigned G = gridDim.x * gridDim.y * gridDim.z;
    unsigned sum, cnt, mine, sp = 0u;
    for (;;) {
        sum = 0u; cnt = 0u; mine = 0u;
#pragma unroll
        for (unsigned j = 0; j < 16; ++j) { const unsigned c = xb_ld(&bar[XB_XCNT(j)]); sum += c; cnt += (c > 0u) ? 1u : 0u; mine = (j == x) ? c : mine; }
        if (sum == G) break;
        __builtin_amdgcn_s_sleep(1);
        if ((++sp & 255u) == 0u) { if (xb_ld(&bar[XB_TMO])) break; if (sp > XB_SPIN_CAP) { atomicAdd(&bar[XB_TMO], 1u); break; } }
    }
    nloc = mine > 0u ? mine : 1u; nx = cnt > 0u ? cnt : 1u;
}

__device__ __forceinline__ void xcd_barrier(const XcdBarrier& b) {
    asm volatile("s_waitcnt vmcnt(0)" ::: "memory");
    __syncthreads();
    if (threadIdx.x == 0) {
        unsigned* bar = b.bar;
        __builtin_amdgcn_s_waitcnt(0);
        unsigned nloc = b.st[0], nx = b.st[1];
        if (nloc == 0u) { xcd_barrier_complete(bar, b.x, nloc, nx); b.st[0] = nloc; b.st[1] = nx; }
        const unsigned old = xb_add(&bar[XB_XSUB(b.x)], 1u);
        const unsigned gen = old / nloc;
        if (old + 1u == (gen + 1u) * nloc) {
            __builtin_amdgcn_fence(__ATOMIC_RELEASE, "agent");
            asm volatile("s_waitcnt vmcnt(0)" ::: "memory");
            const unsigned og = xb_add(&bar[XB_TOP], 1u);
            const unsigned tg = og / nx;
            if (og + 1u == (tg + 1u) * nx) xb_add(&bar[XB_TOPGEN], 1u);
            else XB_SPIN(xb_ld(&bar[XB_TOPGEN]) == tg, bar);
            __builtin_amdgcn_fence(__ATOMIC_ACQUIRE, "agent");
            xb_add(&bar[XB_XGEN(b.x)], 1u);
            asm volatile("s_waitcnt vmcnt(0)" ::: "memory");
        } else {
            XB_SPIN(xb_ld(&bar[XB_XGEN(b.x)]) == gen, bar);
            __builtin_amdgcn_fence(__ATOMIC_ACQUIRE, "agent");
            asm volatile("s_waitcnt vmcnt(0)" ::: "memory");
        }
    }
    __syncthreads();
}


#define REP_CONV 1
#define REP_INPROJ 1
#define REP_RK 1
#define REP_SCANATT 1
#define REP_R4 1
#define REP_ATT 1
#define REP_READOUT 1
#define REP_EXP1 1
#define REP_EXP2 1
#define REPEAT(N) _Pragma("nounroll") for (int rep_ = 0; rep_ < (N); ++rep_)
#define REPEAT2(N) _Pragma("nounroll") for (int rep2_ = 0; rep2_ < (N); ++rep2_)
#define CTL_Q(l) (4096 + 64 * (l))
__global__ void __launch_bounds__(256, 2) fwd(P p) {
    __shared__ __attribute__((aligned(16))) char smem[SMEM_BYTES];
    __shared__ uint4 xb_words;
    __shared__ int s_item;
    if (threadIdx.x == 0) xb_words = make_uint4(0u, 0u, 0u, 0u);
    __syncthreads();
    unsigned* ctl = (unsigned*)(p.ws + WS_CTL);
    XcdBarrier bar = xcd_barrier_post(ctl, (volatile LAS unsigned*)&xb_words);
    const int bid = blockIdx.x, nb = gridDim.x;
    phase_setup(p, bid, nb);
    phase_mod(p, bid, nb, smem);
    for (int l = 0; l < NLAYER; ++l) {
        const int nr = l < NLAYER - 1 ? MA : ML;
        REPEAT(REP_CONV) phase_conv(p, l, bid, nb, smem);
        if (l == 0) xcd_barrier(bar);
        phase_norm1(p, l, 0, bid, nb);
        xcd_barrier(bar);
        REPEAT(REP_INPROJ) { phase_inproj(p, l, bid, nb, smem); phase_conv_big(p, l, ctl + CTL_Q(l) + 8 + rep_, &s_item, smem); xcd_barrier(bar); }
        REPEAT(REP_RK) { phase_rk(p, l, bid, nb, smem); xcd_barrier(bar); }
        REPEAT(REP_SCANATT) {
            if (bid < 128) { REPEAT(REP_R4) phase_r4(p, l, bid, 128, smem); }
            else phase_gate(p, l, bid - 128, nb - 128, smem);
            REPEAT2(REP_ATT) phase_attn(p, l, l < NLAYER - 1, ctl + CTL_Q(l) + 16 * rep_ + 32 * rep2_, &s_item, smem);
            xcd_barrier(bar);
        }
        REPEAT(REP_READOUT) { phase_readout(p, l, nr, bid, nb); xcd_barrier(bar); }
        phase_outproj(p, l, nr, bid, nb, smem);
        xcd_barrier(bar);
        phase_norm2_route(p, l, nr, bid, nb, smem);
        xcd_barrier(bar);
        REPEAT(REP_EXP1) { phase_expert1(p, l, bid, nb, smem); xcd_barrier(bar); }
        REPEAT(REP_EXP2) { phase_expert2(p, l, bid, nb, smem); xcd_barrier(bar); }
    }
    phase_norm1(p, NLAYER, 1, bid, nb);
}

extern "C" void kernel_launch(void* const* d_in, const int* in_sizes, int n_in, void* d_out, int out_size, void* d_ws, size_t ws_size, hipStream_t stream) {
    if (n_in != 36 || ws_size < WS_END) { fprintf(stderr, "kernel_launch: unexpected n_in %d or ws_size %zu < %zu\n", n_in, ws_size, (size_t)WS_END); return; }
    static int grid = 0;
    if (!grid) {
        int dev = 0, cus = 0, per_cu = 0;
        hipGetDevice(&dev);
        hipDeviceGetAttribute(&cus, hipDeviceAttributeMultiprocessorCount, dev);
        hipOccupancyMaxActiveBlocksPerMultiprocessor(&per_cu, (const void*)fwd, 256, 0);
        if (per_cu < 1) per_cu = 1;
        grid = cus * (per_cu < 2 ? per_cu : 2);
    }
    P p{};
    const float** pp = (const float**)&p;
    for (int i = 0; i < 36; ++i) pp[i] = (const float*)d_in[i];
    p.out = (float*)d_out; p.ws = (char*)d_ws;
    hipMemsetAsync((char*)d_ws + WS_CTL, 0, 65536, stream);
    fwd<<<grid, 256, 0, stream>>>(p);
}
```

```cpp
#include <hip/hip_runtime.h>
#include <stdint.h>
#include <stdio.h>

typedef unsigned short bfu;
using bf16x8 = __attribute__((ext_vector_type(8))) short;
using f32x4  = __attribute__((ext_vector_type(4))) float;

#define DM 1024
#define NB 8
#define SEQ 2048
#define CL 256
#define NKEY 2304
#define ML 16384
#define MC 2048
#define MA 18432
#define INW 3200
#define CSL 1920
#define NEXP 32
#define FF 512
#define NLAYER 4
#define LOG2E 1.4426950408889634f

#define MBy(x) ((size_t)(x) << 20)
constexpr size_t WS_CTL   = 0;
constexpr size_t WS_MOD   = 65536;
constexpr size_t WS_ROPE  = WS_MOD + (size_t)4 * 9 * 6144 * 4;
constexpr size_t WS_ECNT  = WS_ROPE + 64 * 16 * 2 * 4 + 64 * 8 * 2 * 4;
constexpr size_t WS_WRT   = WS_ECNT + 4096;
constexpr size_t WS_EIDX  = WS_WRT + (size_t)48 * 1024 * 4;
constexpr size_t WS_EGATE = WS_EIDX + (size_t)MA * 2 * 4;
constexpr size_t WS_ELIST = WS_EGATE + (size_t)MA * 2 * 4;
constexpr size_t WS_X     = MBy(8);
constexpr size_t WS_H     = WS_X + (size_t)MA * DM * 4;
constexpr size_t WS_WIN   = WS_H + (size_t)MA * DM * 2;
constexpr size_t WS_WOUT  = WS_WIN + (size_t)INW * DM * 2;
constexpr size_t WS_W1    = WS_WOUT + (size_t)DM * DM * 2;
constexpr size_t WS_W3    = WS_W1 + (size_t)NEXP * FF * DM * 2;
constexpr size_t WS_W2    = WS_W3 + (size_t)NEXP * FF * DM * 2;
constexpr size_t WS_LW2   = WS_W2 + (size_t)NEXP * FF * DM * 2;
constexpr size_t WS_LA2   = WS_LW2 + (size_t)2 * 512 * 64 * 2;
constexpr size_t WS_LG2   = WS_LA2 + (size_t)2 * 512 * 64 * 2;
constexpr size_t WS_QA    = WS_LG2 + (size_t)512 * 128 * 2;
constexpr size_t WS_KA    = WS_QA + (size_t)NB * 4 * NKEY * 64 * 2;
constexpr size_t WS_VAT   = WS_KA + (size_t)NB * 2 * NKEY * 64 * 2;
constexpr size_t WS_QB    = WS_VAT + (size_t)NB * 2 * NKEY * 64 * 2;
constexpr size_t WS_KB    = WS_QB + (size_t)NB * 4 * NKEY * 64 * 2;
constexpr size_t WS_VBT   = WS_KB + (size_t)NB * 4 * NKEY * 64 * 2;
constexpr size_t WS_CP    = WS_VBT + (size_t)NB * 4 * NKEY * 64 * 2;
constexpr size_t WS_GG    = WS_CP + (size_t)MA * CSL * 4;
constexpr size_t WS_MIX   = WS_GG + (size_t)MA * 512 * 4;
constexpr size_t HEADARR  = (size_t)NB * 8 * NKEY * 64 * 4;
#define OPS_REC 13568
constexpr size_t OPS_DIR  = (size_t)64 * 144 * OPS_REC;
constexpr size_t WS_OPS   = WS_MIX + (size_t)MA * DM * 2;
constexpr size_t WS_YS    = WS_OPS + 2 * OPS_DIR;
constexpr size_t WS_VB    = WS_YS + 2 * HEADARR;
constexpr size_t WS_BETA  = WS_VB + (size_t)MA * 512 * 2;
constexpr size_t WS_LXG   = WS_BETA + (size_t)2 * MA * 8 * 4;
constexpr size_t WS_END   = WS_LXG + (size_t)MA * 128 * 2;
constexpr size_t WS_Y01   = WS_OPS;
constexpr size_t WS_HB    = WS_OPS + (size_t)2 * MA * DM * 4;
static_assert((size_t)2 * MA * DM * 4 + (size_t)(2 * MA + 32 * 128) * 512 * 2 <= 2 * OPS_DIR, "MoE buffers must fit in OPS");

struct P {
    const float *x, *c, *ctx, *c_ctx, *w_mod, *b_mod, *g_mix, *g_ffn, *w_in, *a_q_gain, *a_k_gain, *b_lq1, *b_lk1, *b_lq2, *b_lk2, *b_subln,
        *c_mu, *c_w0, *c_w2, *c_a0, *c_a2, *c_g2, *c_k_k, *c_k_a, *c_r_k, *c_ln_w, *c_ln_b, *w_out, *r_w_group, *r_b_group, *r_w_expert, *r_b_expert,
        *e_w1, *e_w3, *e_w2, *g_final;
    float* out;
    char* ws;
};

__device__ __forceinline__ float bf2f(bfu b) { return __uint_as_float((unsigned)b << 16); }
__device__ __forceinline__ unsigned pack2(float a, float b) {
    typedef float f2 __attribute__((ext_vector_type(2)));
    typedef __bf16 b2 __attribute__((ext_vector_type(2)));
    f2 v = {a, b}; b2 r = __builtin_convertvector(v, b2); return __builtin_bit_cast(unsigned, r);
}
__device__ __forceinline__ bfu f2bf(float a) { return (bfu)(pack2(a, 0.f) & 0xFFFFu); }
__device__ __forceinline__ float wave_sum(float v) {
#pragma unroll
    for (int o = 32; o >= 1; o >>= 1) v += __shfl_xor(v, o);
    return v;
}
template <int CTRL> __device__ __forceinline__ float dppf(float v) { return __int_as_float(__builtin_amdgcn_update_dpp(0, __float_as_int(v), CTRL, 0xF, 0xF, true)); }
__device__ __forceinline__ float sum8(float v) { v += dppf<0xB1>(v); v += dppf<0x4E>(v); v += dppf<0x141>(v); return v; }
__device__ __forceinline__ float sigmoidf_(float x) { return 1.f / (1.f + __expf(-x)); }
__device__ __forceinline__ float siluf_(float x) { return x / (1.f + __expf(-x)); }
__device__ __forceinline__ void row_info(int grow, int& b, int& j, int& s) {
    if (grow < ML) { b = grow >> 11; j = 256 + (grow & 2047); s = b; }
    else { int r = grow - ML; b = r >> 8; j = r & 255; s = 8; }
}
__device__ __forceinline__ int grow_of(int b, int j) { return j < 256 ? ML + b * 256 + j : b * 2048 + (j - 256); }

#define SMEM_BYTES 69632

#define PHASE_PROLOGUE int tid_ = threadIdx.x; asm volatile("" : "+v"(tid_)); int z_ = 0; asm volatile("" : "+v"(z_)); char* ws_ = p.ws + __builtin_amdgcn_readfirstlane(z_);

__device__ void phase_setup(const P& p, int bid, int nb) {
    PHASE_PROLOGUE
    float4* X4 = (float4*)(ws_ + WS_X);
    const float4* x4 = (const float4*)p.x; const float4* c4 = (const float4*)p.ctx;
    const size_t nl = (size_t)ML * DM / 4, nc = (size_t)MC * DM / 4;
    for (size_t i = (size_t)bid * 256 + tid_; i < nl + nc; i += (size_t)nb * 256) X4[i] = i < nl ? x4[i] : c4[i - nl];
    if (bid == 0) {
        float* TA = (float*)(ws_ + WS_ROPE); float* TB = TA + 64 * 16 * 2;
        for (int i = tid_; i < 64 * 16; i += 256) { int pos = i >> 4, f = i & 15; double inv = pow(10000.0, -(double)f / 16.0); double a = (double)pos * inv; TA[i * 2] = (float)cos(a); TA[i * 2 + 1] = (float)sin(a); }
        for (int i = tid_; i < 64 * 8; i += 256) { int pos = i >> 3, f = i & 7; double inv = pow(10000.0, -(double)f / 8.0); double a = (double)pos * inv; TB[i * 2] = (float)cos(a); TB[i * 2 + 1] = (float)sin(a); }
        int* ec = (int*)(ws_ + WS_ECNT);
        for (int i = tid_; i < 128; i += 256) ec[i] = 0;
    }
}

__device__ void phase_mod(const P& p, int bid, int nb, char* smem) {
    PHASE_PROLOGUE
    float* act = (float*)smem;
    float* red = act + 9 * 1024;
    for (int i = tid_; i < 9 * 1024; i += 256) { float v = i < 8 * 1024 ? p.c[i] : p.c_ctx[i - 8 * 1024]; act[i] = siluf_(v); }
    __syncthreads();
    float* mod = (float*)(ws_ + WS_MOD);
    const int nitems = 4 * 6144 / 64;
    const int ct = tid_ & 15, kg = tid_ >> 4, wv = tid_ >> 6;
    for (int it = bid; it < nitems; it += nb) {
        const int layer = it / 96, n0 = (it % 96) * 64;
        const float* w = p.w_mod + (size_t)layer * DM * 6144 + (size_t)(kg * 64) * 6144 + n0 + ct * 4;
        float a[9][4];
#pragma unroll
        for (int s = 0; s < 9; ++s) { a[s][0] = 0.f; a[s][1] = 0.f; a[s][2] = 0.f; a[s][3] = 0.f; }
#pragma unroll 1
        for (int k0 = 0; k0 < 64; k0 += 16) {
            float4 wq[16];
#pragma unroll
            for (int j = 0; j < 16; ++j) wq[j] = *(const float4*)(w + (size_t)(k0 + j) * 6144);
#pragma unroll
            for (int j4 = 0; j4 < 4; ++j4)
#pragma unroll
                for (int s = 0; s < 9; ++s) {
                    const float4 av = *(const float4*)(act + s * 1024 + kg * 64 + k0 + j4 * 4);
                    const float avv[4] = {av.x, av.y, av.z, av.w};
#pragma unroll
                    for (int e = 0; e < 4; ++e) { const float4 q = wq[j4 * 4 + e]; a[s][0] += avv[e] * q.x; a[s][1] += avv[e] * q.y; a[s][2] += avv[e] * q.z; a[s][3] += avv[e] * q.w; }
                }
        }
#pragma unroll
        for (int s = 0; s < 9; ++s)
#pragma unroll
            for (int c = 0; c < 4; ++c) { float v = a[s][c]; v += __shfl_xor(v, 16); v += __shfl_xor(v, 32); a[s][c] = v; }
        if ((tid_ & 63) < 16) {
#pragma unroll
            for (int s = 0; s < 9; ++s) *(float4*)(red + (wv * 9 + s) * 64 + ct * 4) = make_float4(a[s][0], a[s][1], a[s][2], a[s][3]);
        }
        __syncthreads();
        for (int i = tid_; i < 9 * 64; i += 256) {
            const int s = i >> 6, c2 = i & 63, n2 = n0 + c2;
            float v = red[(0 * 9 + s) * 64 + c2] + red[(1 * 9 + s) * 64 + c2] + red[(2 * 9 + s) * 64 + c2] + red[(3 * 9 + s) * 64 + c2];
            mod[((size_t)layer * 9 + s) * 6144 + n2] = v + p.b_mod[layer * 6144 + n2];
        }
        __syncthreads();
    }
}

__device__ __forceinline__ void conv_tile(const float* src, int K, int N, bfu* dst, int k0, int n0, float* ts, int tid_) {
    const int t = tid_;
    {
        const int kk = t >> 4, n4 = (t & 15) * 4;
#pragma unroll
        for (int pz = 0; pz < 4; ++pz) {
            const float4 v = *(const float4*)(src + (size_t)(k0 + kk + 16 * pz) * N + n0 + n4);
            float* d = ts + (kk + 16 * pz) * 65 + n4; d[0] = v.x; d[1] = v.y; d[2] = v.z; d[3] = v.w;
        }
    }
    __syncthreads();
    {
        const int n = t >> 2, kc = (t & 3) * 16;
        unsigned o[8];
#pragma unroll
        for (int i = 0; i < 8; ++i) o[i] = pack2(ts[(kc + 2 * i) * 65 + n], ts[(kc + 2 * i + 1) * 65 + n]);
        uint4* d = (uint4*)(dst + (size_t)(n0 + n) * K + k0 + kc);
        d[0] = make_uint4(o[0], o[1], o[2], o[3]); d[1] = make_uint4(o[4], o[5], o[6], o[7]);
    }
    __syncthreads();
}
__device__ void phase_conv(const P& p, int layer, int bid, int nb, char* smem) {
    PHASE_PROLOGUE
    float* ts = (float*)smem;
    const float* srcs[8]; bfu* dsts[8]; int Ks[8], Ns[8], Bs[8];
    char* ws = ws_;
    srcs[0] = p.w_in + (size_t)layer * DM * INW;  Ks[0] = DM; Ns[0] = INW; Bs[0] = 1;  dsts[0] = (bfu*)(ws + WS_WIN);
    srcs[1] = p.w_out + (size_t)layer * DM * DM;  Ks[1] = DM; Ns[1] = DM;  Bs[1] = 1;  dsts[1] = (bfu*)(ws + WS_WOUT);
    srcs[2] = p.e_w1 + (size_t)layer * NEXP * DM * FF; Ks[2] = DM; Ns[2] = FF; Bs[2] = NEXP; dsts[2] = (bfu*)(ws + WS_W1);
    srcs[3] = p.e_w3 + (size_t)layer * NEXP * DM * FF; Ks[3] = DM; Ns[3] = FF; Bs[3] = NEXP; dsts[3] = (bfu*)(ws + WS_W3);
    srcs[4] = p.e_w2 + (size_t)layer * NEXP * FF * DM; Ks[4] = FF; Ns[4] = DM; Bs[4] = NEXP; dsts[4] = (bfu*)(ws + WS_W2);
    srcs[5] = p.c_w2 + (size_t)layer * 2 * 64 * 512;   Ks[5] = 64; Ns[5] = 512; Bs[5] = 2;   dsts[5] = (bfu*)(ws + WS_LW2);
    srcs[6] = p.c_a2 + (size_t)layer * 2 * 64 * 512;   Ks[6] = 64; Ns[6] = 512; Bs[6] = 2;   dsts[6] = (bfu*)(ws + WS_LA2);
    srcs[7] = p.c_g2 + (size_t)layer * 128 * 512;      Ks[7] = 128; Ns[7] = 512; Bs[7] = 1;  dsts[7] = (bfu*)(ws + WS_LG2);
    int start = 0;
#pragma unroll
    for (int jb = 0; jb < 8; ++jb) {
        if (jb >= 2 && jb <= 4) continue;
        const int tk = Ks[jb] / 64, tn = Ns[jb] / 64, per = tk * tn, tot = per * Bs[jb];
        int first = bid - (start % nb); if (first < 0) first += nb;
        for (int it = first; it < tot; it += nb) {
            const int bt = it / per, r = it % per, kt = r / tn, nt = r % tn;
            conv_tile(srcs[jb] + (size_t)bt * Ks[jb] * Ns[jb], Ks[jb], Ns[jb], dsts[jb] + (size_t)bt * Ks[jb] * Ns[jb], kt * 64, nt * 64, ts, tid_);
        }
        start += tot;
    }
    float* wrt = (float*)(ws + WS_WRT);
    const float* wg = p.r_w_group + (size_t)layer * DM * 4; const float* we = p.r_w_expert + (size_t)layer * DM * 32;
    for (int i = bid * 256 + tid_; i < 48 * 1024; i += nb * 256) {
        const int r = i >> 10, k = i & 1023;
        wrt[i] = r < 4 ? wg[k * 4 + r] : (r < 36 ? we[k * 32 + (r - 4)] : 0.f);
    }
}

__device__ __forceinline__ bool conv_big_step(const P& p, char* ws_, int layer, unsigned* qctr, int* s_item, char* smem, int tid_) {
    float* ts = (float*)smem;
    __syncthreads();
    if (tid_ == 0) *s_item = (int)atomicAdd(qctr, 1u);
    __syncthreads();
    const int gidx = *s_item;
    if (gidx >= 1536) return false;
#pragma unroll 1
    for (int q0 = 0; q0 < 8; q0 += 4) {
        const float* sp[4]; bfu* dp[4]; int Ks[4];
        float4 v[4][4];
        const int kk = tid_ >> 4, n4 = (tid_ & 15) * 4;
#pragma unroll
        for (int q = 0; q < 4; ++q) {
            const int it = gidx * 8 + q0 + q, jb = it >> 12, r = it & 4095, bt = r >> 7, r2 = r & 127;
            const float* src; bfu* dst; int K, N;
            if (jb == 0) { src = p.e_w1 + (size_t)layer * NEXP * DM * FF; dst = (bfu*)(ws_ + WS_W1); K = DM; N = FF; }
            else if (jb == 1) { src = p.e_w3 + (size_t)layer * NEXP * DM * FF; dst = (bfu*)(ws_ + WS_W3); K = DM; N = FF; }
            else { src = p.e_w2 + (size_t)layer * NEXP * FF * DM; dst = (bfu*)(ws_ + WS_W2); K = FF; N = DM; }
            const int tn = N >> 6, kt = r2 / tn, nt = r2 % tn;
            const float* s0 = src + (size_t)bt * K * N + (size_t)(kt * 64 + kk) * N + nt * 64 + n4;
#pragma unroll
            for (int pz = 0; pz < 4; ++pz) v[q][pz] = *(const float4*)(s0 + (size_t)(16 * pz) * N);
            Ks[q] = K;
            dp[q] = dst + (size_t)bt * K * N + (size_t)(nt * 64 + (tid_ >> 2)) * K + kt * 64 + (tid_ & 3) * 16;
        }
#pragma unroll
        for (int q = 0; q < 4; ++q)
#pragma unroll
            for (int pz = 0; pz < 4; ++pz) { float* d = ts + q * 4160 + (kk + 16 * pz) * 65 + n4; d[0] = v[q][pz].x; d[1] = v[q][pz].y; d[2] = v[q][pz].z; d[3] = v[q][pz].w; }
        __syncthreads();
        {
            const int n = tid_ >> 2, kc = (tid_ & 3) * 16;
#pragma unroll
            for (int q = 0; q < 4; ++q) {
                unsigned o[8];
#pragma unroll
                for (int i = 0; i < 8; ++i) o[i] = pack2(ts[q * 4160 + (kc + 2 * i) * 65 + n], ts[q * 4160 + (kc + 2 * i + 1) * 65 + n]);
                uint4* d = (uint4*)dp[q];
                d[0] = make_uint4(o[0], o[1], o[2], o[3]); d[1] = make_uint4(o[4], o[5], o[6], o[7]);
            }
        }
        __syncthreads();
    }
    return true;
}

__device__ void phase_norm1(const P& p, int layer, int mode, int bid, int nb) {
    PHASE_PROLOGUE
    float* X = (float*)(ws_ + WS_X); bfu* H = (bfu*)(ws_ + WS_H);
    const float* Y0 = (const float*)(ws_ + WS_Y01); const float* Y1 = Y0 + (size_t)MA * DM;
    const float* mod = (const float*)(ws_ + WS_MOD);
    const int lane = tid_ & 63, wv = tid_ >> 6;
    const int nrows = mode ? ML : MA;
    if (bid == 0 && mode == 0 && tid_ < 32) ((int*)(ws_ + WS_ECNT))[layer * 32 + tid_] = 0;
    for (int row = bid * 4 + wv; row < nrows; row += nb * 4) {
        int b, j, s; row_info(row, b, j, s);
        float4 v[4];
        float ss = 0.f;
#pragma unroll
        for (int c = 0; c < 4; ++c) {
            const int col = c * 256 + lane * 4;
            float4 xv = *(const float4*)(X + (size_t)row * DM + col);
            if (layer > 0) {
                const float4 a = *(const float4*)(Y0 + (size_t)row * DM + col), bq = *(const float4*)(Y1 + (size_t)row * DM + col);
                const float4 g = *(const float4*)(mod + ((size_t)(layer - 1) * 9 + s) * 6144 + 5 * 1024 + col);
                xv.x += g.x * (a.x + bq.x); xv.y += g.y * (a.y + bq.y); xv.z += g.z * (a.z + bq.z); xv.w += g.w * (a.w + bq.w);
                if (!mode) *(float4*)(X + (size_t)row * DM + col) = xv;
            }
            v[c] = xv; ss += xv.x * xv.x + xv.y * xv.y + xv.z * xv.z + xv.w * xv.w;
        }
        ss = wave_sum(ss);
        const float rs = rsqrtf(ss * (1.f / 1024.f) + 1e-6f);
#pragma unroll
        for (int c = 0; c < 4; ++c) {
            const int col = c * 256 + lane * 4;
            if (mode) {
                const float4 g = *(const float4*)(p.g_final + col);
                float4 o; o.x = v[c].x * rs * g.x; o.y = v[c].y * rs * g.y; o.z = v[c].z * rs * g.z; o.w = v[c].w * rs * g.w;
                *(float4*)(p.out + (size_t)row * DM + col) = o;
            } else {
                const float4 g = *(const float4*)(p.g_mix + layer * DM + col);
                const float4 sh = *(const float4*)(mod + ((size_t)layer * 9 + s) * 6144 + 0 * 1024 + col);
                const float4 sc = *(const float4*)(mod + ((size_t)layer * 9 + s) * 6144 + 1 * 1024 + col);
                const float o0 = v[c].x * rs * g.x * (1.f + sc.x) + sh.x, o1 = v[c].y * rs * g.y * (1.f + sc.y) + sh.y;
                const float o2 = v[c].z * rs * g.z * (1.f + sc.z) + sh.z, o3 = v[c].w * rs * g.w * (1.f + sc.w) + sh.w;
                *(uint2*)(H + (size_t)row * DM + col) = make_uint2(pack2(o0, o1), pack2(o2, o3));
            }
        }
    }
}

#define GLDS(gp, lp) __builtin_amdgcn_global_load_lds((const unsigned*)(gp), (__attribute__((address_space(3))) unsigned*)(lp), 16, 0, 0)
__device__ __forceinline__ int swzG(int x) { return (0x78 >> (2 * x)) & 3; }
template <class FA, class FB, class FE>
__device__ __forceinline__ void gemm_tile(FA arow, FB brow, int K, FE epi, char* smem) {
    int tid = threadIdx.x; asm volatile("" : "+v"(tid));
    const int lane = tid & 63, wid = tid >> 6, wr = wid >> 1, wc = wid & 1, fr = lane & 15, fq = lane >> 4;
    const int lrow = tid >> 2, lch = ((tid & 3) ^ swzG((tid >> 4) & 3)) * 8;
    const bfu* ga0 = arow(lrow) + lch; const bfu* ga1 = arow(lrow + 64) + lch;
    const bfu* gb0 = brow(lrow) + lch; const bfu* gb1 = brow(lrow + 64) + lch;
    f32x4 acc[4][4];
#pragma unroll
    for (int m = 0; m < 4; ++m)
#pragma unroll
        for (int n = 0; n < 4; ++n) acc[m][n] = (f32x4){0.f, 0.f, 0.f, 0.f};
    char* lds0 = smem + tid * 16;
#define GEMM_ISSUE(kt_) { char* d_ = lds0 + ((kt_) & 3) * 16384; const int ko_ = (kt_) * 32; \
        GLDS(ga0 + ko_, d_); GLDS(ga1 + ko_, d_ + 4096); GLDS(gb0 + ko_, d_ + 8192); GLDS(gb1 + ko_, d_ + 12288); }
    const int nk = K >> 5;
    __syncthreads();
    GEMM_ISSUE(0)
    if (nk > 1) GEMM_ISSUE(1)
    if (nk > 2) GEMM_ISSUE(2)
    const int offA = (wr * 64 + fr) * 64 + ((fq ^ swzG((fr >> 2) & 3)) * 16), offB = 8192 + (wc * 64 + fr) * 64 + ((fq ^ swzG((fr >> 2) & 3)) * 16);
    for (int kt = 0; kt < nk; ++kt) {
        if (kt + 2 < nk) asm volatile("s_waitcnt vmcnt(8)" ::: "memory");
        else if (kt + 1 < nk) asm volatile("s_waitcnt vmcnt(4)" ::: "memory");
        else asm volatile("s_waitcnt vmcnt(0)" ::: "memory");
        __builtin_amdgcn_s_barrier();
        if (kt + 3 < nk) GEMM_ISSUE(kt + 3)
        const char* st = smem + (kt & 3) * 16384;
        bf16x8 af[4], bfr[4];
#pragma unroll
        for (int m = 0; m < 4; ++m) af[m] = *(const bf16x8*)(st + offA + m * 1024);
#pragma unroll
        for (int n = 0; n < 4; ++n) bfr[n] = *(const bf16x8*)(st + offB + n * 1024);
        __builtin_amdgcn_s_setprio(1);
#pragma unroll
        for (int m = 0; m < 4; ++m)
#pragma unroll
            for (int n = 0; n < 4; ++n) acc[m][n] = __builtin_amdgcn_mfma_f32_16x16x32_bf16(af[m], bfr[n], acc[m][n], 0, 0, 0);
        __builtin_amdgcn_s_setprio(0);
    }
    __syncthreads();
    epi(acc, wr, wc, fr, fq);
}
#define ACC_FOREACH(...)                                                                      \
    _Pragma("unroll") for (int m_ = 0; m_ < 4; ++m_) _Pragma("unroll") for (int n_ = 0; n_ < 4; ++n_) \
    _Pragma("unroll") for (int j_ = 0; j_ < 4; ++j_) {                                        \
        const int row = wr * 64 + m_ * 16 + fq * 4 + j_; const int col = wc * 64 + n_ * 16 + fr; const float val = acc[m_][n_][j_]; __VA_ARGS__ }

__device__ void phase_inproj(const P& p, int layer, int bid, int nb, char* smem) {
    PHASE_PROLOGUE
    const bfu* H = (const bfu*)(ws_ + WS_H); const bfu* W = (const bfu*)(ws_ + WS_WIN);
    float* Cs = (float*)smem;
    const float* TA = (const float*)(ws_ + WS_ROPE); const float* TB = TA + 64 * 16 * 2;
    const int nitems = 144 * 25;
    for (int it = bid; it < nitems; it += nb) {
        const int mt = (it / 200) * 8 + (it / 5) % 8, nt = ((it / 40) % 5) * 5 + it % 5;
        const int row0 = mt * 128, col0 = nt * 128;
        gemm_tile([&](int r) { return H + (size_t)(row0 + r) * DM; }, [&](int r) { return W + (size_t)(col0 + r) * DM; }, DM,
            [&](f32x4 (&acc)[4][4], int wr, int wc, int fr, int fq) {
                ACC_FOREACH(Cs[row * 132 + col] = val;)
            }, smem);
        __syncthreads();
        const int tid = tid_;
        int b, j0, s; row_info(row0, b, j0, s);
        const bool lat = row0 < ML;
        if (nt <= 2) {
            const int r = tid & 127, hl = tid >> 7;
            const bool isq = nt < 2;
            const float* gain = (isq ? p.a_q_gain : p.a_k_gain) + layer * 64;
            float v[64]; float ss = 0.f;
#pragma unroll
            for (int d4 = 0; d4 < 16; ++d4) { const float4 t4 = *(const float4*)(Cs + r * 132 + hl * 64 + d4 * 4); v[d4 * 4] = t4.x; v[d4 * 4 + 1] = t4.y; v[d4 * 4 + 2] = t4.z; v[d4 * 4 + 3] = t4.w; ss += t4.x * t4.x + t4.y * t4.y + t4.z * t4.z + t4.w * t4.w; }
            const float rs = rsqrtf(ss * (1.f / 64.f) + 1e-6f);
#pragma unroll
            for (int d = 0; d < 64; ++d) v[d] = v[d] * rs * gain[d];
            if (lat) {
                const int t = (j0 - 256) + r;
#pragma unroll
                for (int a = 0; a < 2; ++a) {
                    const int pos = a == 0 ? (t >> 6) : (t & 63);
#pragma unroll
                    for (int f = 0; f < 16; ++f) {
                        const float cs = TA[(pos * 16 + f) * 2], sn = TA[(pos * 16 + f) * 2 + 1];
                        const float x0 = v[a * 32 + f], x1 = v[a * 32 + 16 + f];
                        v[a * 32 + f] = x0 * cs - x1 * sn; v[a * 32 + 16 + f] = x1 * cs + x0 * sn;
                    }
                }
            }
            const float qs = isq ? 0.125f * LOG2E : 1.f;
            bfu* dst = isq ? (bfu*)(ws_ + WS_QA) + (((size_t)b * 4 + (nt * 2 + hl)) * NKEY + j0 + r) * 64
                           : (bfu*)(ws_ + WS_KA) + (((size_t)b * 2 + hl) * NKEY + j0 + r) * 64;
#pragma unroll
            for (int d8 = 0; d8 < 8; ++d8)
                ((uint4*)dst)[d8] = make_uint4(pack2(v[d8 * 8] * qs, v[d8 * 8 + 1] * qs), pack2(v[d8 * 8 + 2] * qs, v[d8 * 8 + 3] * qs),
                                               pack2(v[d8 * 8 + 4] * qs, v[d8 * 8 + 5] * qs), pack2(v[d8 * 8 + 6] * qs, v[d8 * 8 + 7] * qs));
        } else if (nt == 3 || nt == 8 || nt == 9) {
            const int c = tid & 127, half = tid >> 7, hl = c >> 6, d = c & 63;
            bfu* dst = nt == 3 ? (bfu*)(ws_ + WS_VAT) + (((size_t)b * 2 + hl) * 64 + d) * NKEY + j0 + half * 64
                               : (bfu*)(ws_ + WS_VBT) + (((size_t)b * 4 + ((nt - 8) * 2 + hl)) * 64 + d) * NKEY + j0 + half * 64;
#pragma unroll
            for (int r8 = 0; r8 < 8; ++r8) {
                const float* s0 = Cs + (half * 64 + r8 * 8) * 132 + c;
                ((uint4*)dst)[r8] = make_uint4(pack2(s0[0], s0[132]), pack2(s0[2 * 132], s0[3 * 132]), pack2(s0[4 * 132], s0[5 * 132]), pack2(s0[6 * 132], s0[7 * 132]));
            }
        } else if (nt <= 7) {
            const bool isq = nt < 6;
            const int hbase = ((nt - 4) & 1) * 2;
#pragma unroll
            for (int itq = 0; itq < 2; ++itq) {
                const int u = tid + 256 * itq, r = u & 127, hm = u >> 7;
                float v[32];
#pragma unroll
                for (int d4 = 0; d4 < 8; ++d4) { const float4 t4 = *(const float4*)(Cs + r * 132 + hm * 32 + d4 * 4); v[d4 * 4] = t4.x; v[d4 * 4 + 1] = t4.y; v[d4 * 4 + 2] = t4.z; v[d4 * 4 + 3] = t4.w; }
                if (lat) {
                    const int t = (j0 - 256) + r;
#pragma unroll
                    for (int a = 0; a < 2; ++a) {
                        const int pos = a == 0 ? (t >> 6) : (t & 63);
#pragma unroll
                        for (int f = 0; f < 8; ++f) {
                            const float cs = TB[(pos * 8 + f) * 2], sn = TB[(pos * 8 + f) * 2 + 1];
                            const float x0 = v[a * 16 + f], x1 = v[a * 16 + 8 + f];
                            v[a * 16 + f] = x0 * cs - x1 * sn; v[a * 16 + 8 + f] = x1 * cs + x0 * sn;
                        }
                    }
                }
                const float qs = isq ? 0.17677669529663687f * LOG2E : 1.f;
                const int h = hbase + (hm >> 1), mp = hm & 1;
                bfu* dst = (bfu*)(ws_ + (isq ? WS_QB : WS_KB)) + (((size_t)b * 4 + h) * NKEY + j0 + r) * 64 + mp * 32;
#pragma unroll
                for (int d8 = 0; d8 < 4; ++d8)
                    ((uint4*)dst)[d8] = make_uint4(pack2(v[d8 * 8] * qs, v[d8 * 8 + 1] * qs), pack2(v[d8 * 8 + 2] * qs, v[d8 * 8 + 3] * qs),
                                                   pack2(v[d8 * 8 + 4] * qs, v[d8 * 8 + 5] * qs), pack2(v[d8 * 8 + 6] * qs, v[d8 * 8 + 7] * qs));
            }
        } else {
            const int r = tid & 127, half = tid >> 7;
            float* dst = (float*)(ws_ + WS_CP) + (size_t)(row0 + r) * CSL + (nt - 10) * 128 + half * 64;
#pragma unroll
            for (int d4 = 0; d4 < 16; ++d4) ((float4*)dst)[d4] = *(const float4*)(Cs + r * 132 + half * 64 + d4 * 4);
        }
        __syncthreads();
    }
}

__device__ void phase_gate(const P& p, int layer, int bid, int nb, char* smem) {
    PHASE_PROLOGUE
    const bfu* LXG = (const bfu*)(ws_ + WS_LXG); const bfu* Bt = (const bfu*)(ws_ + WS_LG2);
    float* GG = (float*)(ws_ + WS_GG);
    const int nitems = 144 * 4;
    for (int it = bid; it < nitems; it += nb) {
        const int mt = it >> 2, nt = it & 3, row0 = mt * 128, col0 = nt * 128;
        gemm_tile([&](int r) { return LXG + (size_t)(row0 + r) * 128; }, [&](int r) { return Bt + (size_t)(col0 + r) * 128; }, 128,
            [&](f32x4 (&acc)[4][4], int wr, int wc, int fr, int fq) {
                ACC_FOREACH(GG[(size_t)(row0 + row) * 512 + col0 + col] = val;)
            }, smem);
    }
}

#define OPS_AT 0
#define OPS_RT 2048
#define OPS_MAK 4096
#define OPS_T 5120
#define OPS_MRBK 6144
#define OPS_BK 7168
#define OPS_VF 11264
#define OPS_WC 13312
__device__ __forceinline__ char* ops_rec(char* ws_, int z, int seq, int c) { return ws_ + WS_OPS + ((size_t)(z * 64 + seq) * 144 + c) * OPS_REC; }
__device__ __forceinline__ float rdlane(float v, int l) { return __int_as_float(__builtin_amdgcn_readlane(__float_as_int(v), l)); }

__device__ __forceinline__ void chunk_tail(const float (&lw)[16], const float (&kk)[16], const float (&rr)[16], const float (&bb)[16], const float (&kd)[16], const float (&vv)[16],
                                           char* Lw, char* rec, int lane) {
    const int cl = lane & 15, g = lane >> 4;
    float Bt[16], Kt[16];
    float cum = 0.f, ep = 1.f;
#pragma unroll
    for (int t = 0; t < 16; ++t) {
        cum += lw[t];
        const float e = __expf(cum), ei = __expf(-cum);
        *(bfu*)(Lw + 0 + t * 128 + lane * 2) = f2bf(-kk[t] * ep);
        *(bfu*)(Lw + 2048 + t * 128 + lane * 2) = f2bf(rr[t] * e);
        Bt[t] = bb[t] * ei; Kt[t] = kd[t] * ei;
        *(bfu*)(Lw + 4096 + t * 128 + lane * 2) = f2bf(Bt[t]);
        *(bfu*)(Lw + 6144 + t * 128 + lane * 2) = f2bf(Kt[t]);
        ep = e;
    }
    const float eC = ep;
#pragma unroll
    for (int q = 0; q < 4; ++q) {
        *(uint4*)(rec + OPS_BK + ((lane >> 4) * 64 + cl + 16 * q) * 16) =
            make_uint4(pack2(Bt[4 * q] * eC, Bt[4 * q + 1] * eC), pack2(Bt[4 * q + 2] * eC, Bt[4 * q + 3] * eC), pack2(Kt[4 * q] * eC, Kt[4 * q + 1] * eC), pack2(Kt[4 * q + 2] * eC, Kt[4 * q + 3] * eC));
        *(uint2*)(rec + OPS_VF + ((lane >> 4) * 64 + cl + 16 * q) * 8) = make_uint2(pack2(vv[4 * q], vv[4 * q + 1]), pack2(vv[4 * q + 2], vv[4 * q + 3]));
    }
    *(float*)(rec + OPS_WC + lane * 4) = eC;
    f32x4 Mab = {0.f, 0.f, 0.f, 0.f}, Mak = Mab, Mrb = Mab, Mrk = Mab;
#pragma unroll
    for (int ks = 0; ks < 2; ++ks) {
        const int fo = cl * 128 + ks * 64 + g * 16;
        const bf16x8 aA = *(const bf16x8*)(Lw + 0 + fo), aR = *(const bf16x8*)(Lw + 2048 + fo), bB = *(const bf16x8*)(Lw + 4096 + fo), bK = *(const bf16x8*)(Lw + 6144 + fo);
        Mab = __builtin_amdgcn_mfma_f32_16x16x32_bf16(aA, bB, Mab, 0, 0, 0);
        Mak = __builtin_amdgcn_mfma_f32_16x16x32_bf16(aA, bK, Mak, 0, 0, 0);
        Mrb = __builtin_amdgcn_mfma_f32_16x16x32_bf16(aR, bB, Mrb, 0, 0, 0);
        Mrk = __builtin_amdgcn_mfma_f32_16x16x32_bf16(aR, bK, Mrk, 0, 0, 0);
    }
#pragma unroll
    for (int ks = 0; ks < 2; ++ks) {
        const uint2 a0 = *(const uint2*)(Lw + 0 + cl * 128 + (32 * ks + 4 * g) * 2), a1 = *(const uint2*)(Lw + 0 + cl * 128 + (32 * ks + 16 + 4 * g) * 2);
        const uint2 r0 = *(const uint2*)(Lw + 2048 + cl * 128 + (32 * ks + 4 * g) * 2), r1 = *(const uint2*)(Lw + 2048 + cl * 128 + (32 * ks + 16 + 4 * g) * 2);
        *(uint4*)(rec + OPS_AT + (ks * 64 + lane) * 16) = make_uint4(a0.x, a0.y, a1.x, a1.y);
        *(uint4*)(rec + OPS_RT + (ks * 64 + lane) * 16) = make_uint4(r0.x, r0.y, r1.x, r1.y);
    }
#pragma unroll
    for (int q = 0; q < 4; ++q) {
        const int tau = 4 * g + q;
        if (!(cl < tau)) { Mab[q] = 0.f; Mak[q] = 0.f; }
        if (!(cl <= tau)) { Mrb[q] = 0.f; Mrk[q] = 0.f; }
    }
    float Tc[16];
#pragma unroll
    for (int t = 0; t < 16; ++t) {
        float acc = (t == cl) ? 1.f : 0.f;
#pragma unroll
        for (int j = 0; j < t; ++j) acc += rdlane(Mab[t & 3], j + 16 * (t >> 2)) * Tc[j];
        Tc[t] = acc;
    }
#pragma unroll
    for (int q = 0; q < 4; ++q) {
        const int tau = 4 * g + q;
        *(bfu*)(Lw + 8192 + tau * 32 + cl * 2) = f2bf(Mak[q]);
        *(bfu*)(Lw + 9216 + tau * 32 + cl * 2) = f2bf(Mrb[q]);
        *(bfu*)(Lw + 9728 + tau * 32 + cl * 2) = f2bf(Mrk[q]);
    }
    if (g == 0) {
#pragma unroll
        for (int t = 0; t < 16; ++t) *(bfu*)(Lw + 8704 + t * 32 + cl * 2) = f2bf(Tc[t]);
    }
    const uint2 fmak = *(const uint2*)(Lw + 8192 + cl * 32 + g * 8), ft = *(const uint2*)(Lw + 8704 + cl * 32 + g * 8);
    const uint2 fmrb = *(const uint2*)(Lw + 9216 + cl * 32 + g * 8), fmrk = *(const uint2*)(Lw + 9728 + cl * 32 + g * 8);
    *(uint4*)(rec + OPS_MAK + lane * 16) = make_uint4(fmak.x, fmak.y, 0u, 0u);
    *(uint4*)(rec + OPS_T + lane * 16) = make_uint4(ft.x, ft.y, 0u, 0u);
    *(uint4*)(rec + OPS_MRBK + lane * 16) = make_uint4(fmrb.x, fmrb.y, fmrk.x, fmrk.y);
}

__device__ __forceinline__ float sum64(float v) { v = sum8(v); v += dppf<0x140>(v); return (rdlane(v, 0) + rdlane(v, 16)) + (rdlane(v, 32) + rdlane(v, 48)); }
__device__ void phase_rk(const P& p, int layer, int bid, int nb, char* smem) {
    PHASE_PROLOGUE
    const int lane = tid_ & 63, wv = tid_ >> 6, cl = lane & 15, g = lane >> 4;
    char* Lw = smem + wv * 16384;
    const float* CP = (const float*)(ws_ + WS_CP);
    const float* mu = p.c_mu + layer * CSL;
    for (int it = bid * 4 + wv; it < 2 * 64 * 144; it += nb * 4) {
        const int c = it % 144, seq = (it / 144) & 63, z = it / (144 * 64), b = seq >> 3, h = seq & 7;
        const int grow0 = c < 16 ? ML + b * 256 + 16 * c : b * 2048 + 16 * (c - 16);
        const bool sstart = (c == 0 || c == 16), send = (c == 15 || c == 143);
        auto shifted = [&](int col, float (&out)[16]) {
            float P_[18];
#pragma unroll
            for (int q = 0; q < 18; ++q) {
                const int tau = q - 1, nat = z ? 15 - tau : tau;
                const bool ok = (nat >= 0 || !sstart) && (nat <= 15 || !send);
                P_[q] = ok ? CP[(size_t)(grow0 + nat) * CSL + col] : 0.f;
            }
            const float m = mu[col];
#pragma unroll
            for (int t = 0; t < 16; ++t) out[t] = P_[t + 1] + m * (0.5f * (P_[t] + P_[t + 2]) - P_[t + 1]);
        };
        float tmp[16], rr[16], kr[16], vv[16];
        shifted(1536 + z * 64 + lane, tmp);
#pragma unroll
        for (int t = 0; t < 16; ++t) *(bfu*)(Lw + 10240 + t * 128 + lane * 2) = f2bf(1.f - 2.f / (1.f + __expf(2.f * tmp[t])));
        shifted(1664 + z * 64 + lane, tmp);
#pragma unroll
        for (int t = 0; t < 16; ++t) *(bfu*)(Lw + 12288 + t * 128 + lane * 2) = f2bf(tmp[t]);
        if (z == 0 && lane < 16) {
            shifted(1792 + h * 16 + lane, tmp);
            bfu* LXG = (bfu*)(ws_ + WS_LXG);
#pragma unroll
            for (int t = 0; t < 16; ++t) LXG[(size_t)(grow0 + t) * 128 + h * 16 + lane] = f2bf(sigmoidf_(tmp[t]));
        }
        shifted(h * 64 + lane, rr);
        shifted(512 + h * 64 + lane, kr);
        shifted(1024 + h * 64 + lane, vv);
        const bfu* W2 = (const bfu*)(ws_ + WS_LW2) + ((size_t)z * 512 + h * 64) * 64;
        const bfu* A2 = (const bfu*)(ws_ + WS_LA2) + ((size_t)z * 512 + h * 64) * 64;
        float prew[16], prea[16];
#pragma unroll
        for (int which = 0; which < 2; ++which) {
            const bfu* Wm = which ? A2 : W2; const char* Xs = Lw + (which ? 12288 : 10240);
            f32x4 ac[4];
#pragma unroll
            for (int n = 0; n < 4; ++n) ac[n] = (f32x4){0.f, 0.f, 0.f, 0.f};
#pragma unroll
            for (int ks = 0; ks < 2; ++ks) {
                const bf16x8 af = *(const bf16x8*)(Xs + cl * 128 + ks * 64 + g * 16);
#pragma unroll
                for (int n = 0; n < 4; ++n) {
                    const bf16x8 bf = *(const bf16x8*)(Wm + (size_t)(16 * n + cl) * 64 + ks * 32 + g * 8);
                    ac[n] = __builtin_amdgcn_mfma_f32_16x16x32_bf16(af, bf, ac[n], 0, 0, 0);
                }
            }
#pragma unroll
            for (int n = 0; n < 4; ++n)
#pragma unroll
                for (int q = 0; q < 4; ++q) *(float*)(Lw + (4 * g + q) * 256 + (16 * n + cl) * 4) = ac[n][q];
#pragma unroll
            for (int t = 0; t < 16; ++t) { const float x = *(const float*)(Lw + t * 256 + lane * 4); if (which) prea[t] = x; else prew[t] = x; }
        }
        const int ch = h * 64 + lane;
        const float w0v = p.c_w0[((size_t)layer * 2 + z) * 512 + ch], a0v = p.c_a0[((size_t)layer * 2 + z) * 512 + ch];
        const float kkv = p.c_k_k[layer * 512 + ch], kav = p.c_k_a[layer * 512 + ch], rkv = p.c_r_k[layer * 512 + ch];
        float lw[16], kk[16], bb[16];
        float* BETA = (float*)(ws_ + WS_BETA) + (size_t)z * MA * 8;
#pragma unroll
        for (int t = 0; t < 16; ++t) {
            const float nx = -(w0v + prew[t]);
            const float sp = nx > 20.f ? nx : __logf(1.f + __expf(nx));
            lw[t] = -__expf(-sp - 0.5f);
            const float icl = sigmoidf_(a0v + prea[t]);
            const float kv = kr[t] * kkv;
            const float ss = sum64(kv * kv);
            kk[t] = kv * rsqrtf(fmaxf(ss, 1e-24f));
            kr[t] = kr[t] * (1.f + (icl - 1.f) * kav);
            bb[t] = kk[t] * icl;
            const float bs = sum64(rr[t] * kr[t] * rkv);
            const int nat = z ? 15 - t : t;
            if (lane == 0) BETA[(size_t)(grow0 + nat) * 8 + h] = bs;
        }
        if (z == 0) {
            bfu* VB = (bfu*)(ws_ + WS_VB);
#pragma unroll
            for (int t = 0; t < 16; ++t) VB[(size_t)(grow0 + t) * 512 + ch] = f2bf(vv[t]);
        }
        chunk_tail(lw, kk, rr, bb, kr, vv, Lw, ops_rec(ws_, z, seq, c), lane);
    }
}

__device__ __forceinline__ bf16x8 mk8(unsigned a, unsigned b, unsigned c, unsigned d) { union { bf16x8 v; unsigned u[4]; } x; x.u[0] = a; x.u[1] = b; x.u[2] = c; x.u[3] = d; return x.v; }
__device__ __forceinline__ bf16x8 ld8(const char* p) { return *(const bf16x8*)p; }
__device__ __forceinline__ void glds16_asm(const void* gsrc, unsigned lds_dst) {
    unsigned keep;
    asm volatile("s_mov_b32 %0, m0\n\ts_mov_b32 m0, %2\n\ts_nop 0\n\tglobal_load_lds_dwordx4 %1, off\n\ts_mov_b32 m0, %0" : "=&s"(keep) : "v"(gsrc), "s"(lds_dst) : "memory");
}
__device__ void phase_r4(const P& p, int layer, int bid, int nb, char* smem) {
    PHASE_PROLOGUE
    const int lane = tid_ & 63, vt = tid_ >> 6, cl = lane & 15, g = lane >> 4;
    for (int it = bid; it < 128; it += nb) {
        const int z = it >> 6, seq = it & 63;
        float* Y = (float*)(ws_ + WS_YS) + (size_t)z * (HEADARR / 4) + (size_t)seq * NKEY * 64;
        const char* recs = ws_ + WS_OPS + (size_t)(z * 64 + seq) * 144 * OPS_REC;
        f32x4 acc[4];
#pragma unroll
        for (int kt = 0; kt < 4; ++kt) acc[kt] = (f32x4){0.f, 0.f, 0.f, 0.f};
        const unsigned lbase = __builtin_amdgcn_readfirstlane((unsigned)(uintptr_t)(__attribute__((address_space(3))) char*)smem + vt * 1024);
#define R4_ISSUE(ci_) { const int c_ = z ? ((ci_) < 16 ? 15 - (ci_) : 143 - ((ci_) - 16)) : (ci_); const char* g_ = recs + (size_t)c_ * OPS_REC + tid_ * 16; const unsigned d_ = lbase + ((ci_) & 3) * OPS_REC; \
            glds16_asm(g_, d_); glds16_asm(g_ + 4096, d_ + 4096); glds16_asm(g_ + 8192, d_ + 8192); if (tid_ < 80) glds16_asm(g_ + 12288, d_ + 12288); }
        __syncthreads();
        R4_ISSUE(0) R4_ISSUE(1) R4_ISSUE(2)
        for (int ci = 0; ci < 144; ++ci) {
            const int c = z ? (ci < 16 ? 15 - ci : 143 - (ci - 16)) : ci;
            if (ci >= 3 && ci <= 141) { if (vt < 2) asm volatile("s_waitcnt vmcnt(20)" ::: "memory"); else asm volatile("s_waitcnt vmcnt(18)" ::: "memory"); }
            else asm volatile("s_waitcnt vmcnt(0)" ::: "memory");
            __builtin_amdgcn_s_barrier();
            if (ci + 3 < 144) R4_ISSUE(ci + 3)
            const char* rec = smem + (ci & 3) * OPS_REC;
            const f32x4 zero4 = {0.f, 0.f, 0.f, 0.f};
            bf16x8 sb[2];
#pragma unroll
            for (int ks = 0; ks < 2; ++ks)
                sb[ks] = mk8(pack2(acc[2 * ks][0], acc[2 * ks][1]), pack2(acc[2 * ks][2], acc[2 * ks][3]), pack2(acc[2 * ks + 1][0], acc[2 * ks + 1][1]), pack2(acc[2 * ks + 1][2], acc[2 * ks + 1][3]));
            const uint2 vf = *(const uint2*)(rec + OPS_VF + (vt * 64 + lane) * 8);
            f32x4 Z = __builtin_amdgcn_mfma_f32_16x16x32_bf16(ld8(rec + OPS_AT + lane * 16), sb[0], zero4, 0, 0, 0);
            Z = __builtin_amdgcn_mfma_f32_16x16x32_bf16(ld8(rec + OPS_AT + (64 + lane) * 16), sb[1], Z, 0, 0, 0);
            Z = __builtin_amdgcn_mfma_f32_16x16x32_bf16(ld8(rec + OPS_MAK + lane * 16), mk8(vf.x, vf.y, 0u, 0u), Z, 0, 0, 0);
            f32x4 Yv = __builtin_amdgcn_mfma_f32_16x16x32_bf16(ld8(rec + OPS_RT + lane * 16), sb[0], zero4, 0, 0, 0);
            Yv = __builtin_amdgcn_mfma_f32_16x16x32_bf16(ld8(rec + OPS_RT + (64 + lane) * 16), sb[1], Yv, 0, 0, 0);
            const f32x4 U = __builtin_amdgcn_mfma_f32_16x16x32_bf16(ld8(rec + OPS_T + lane * 16), mk8(pack2(Z[0], Z[1]), pack2(Z[2], Z[3]), 0u, 0u), zero4, 0, 0, 0);
            const bf16x8 ub = mk8(pack2(U[0], U[1]), pack2(U[2], U[3]), vf.x, vf.y);
            Yv = __builtin_amdgcn_mfma_f32_16x16x32_bf16(ld8(rec + OPS_MRBK + lane * 16), ub, Yv, 0, 0, 0);
#pragma unroll
            for (int kt = 0; kt < 4; ++kt) {
                const float4 wc = *(const float4*)(rec + OPS_WC + (16 * kt + 4 * g) * 4);
                f32x4 a = acc[kt];
                a[0] *= wc.x; a[1] *= wc.y; a[2] *= wc.z; a[3] *= wc.w;
                acc[kt] = __builtin_amdgcn_mfma_f32_16x16x32_bf16(ld8(rec + OPS_BK + (kt * 64 + lane) * 16), ub, a, 0, 0, 0);
            }
#pragma unroll
            for (int q = 0; q < 4; ++q) {
                const int tau = 4 * g + q, t = z ? 15 - tau : tau;
                Y[(size_t)(16 * c + t) * 64 + vt * 16 + cl] = Yv[q];
            }
        }
    }
}

__device__ void phase_readout(const P& p, int layer, int nrows, int bid, int nb) {
    PHASE_PROLOGUE
    const float* Y0 = (const float*)(ws_ + WS_YS); const float* Y1 = Y0 + HEADARR / 4;
    const bfu* VB = (const bfu*)(ws_ + WS_VB); const float* B0 = (const float*)(ws_ + WS_BETA); const float* B1 = B0 + (size_t)MA * 8;
    const float* GG = (const float*)(ws_ + WS_GG);
    bfu* MIX = (bfu*)(ws_ + WS_MIX);
    const float* lnw = p.c_ln_w + layer * 512; const float* lnb = p.c_ln_b + layer * 512;
    const int lane = tid_ & 63, wv = tid_ >> 6;
    for (int row = bid * 4 + wv; row < nrows; row += nb * 4) {
        int b, j, s; row_info(row, b, j, s);
#pragma unroll
        for (int h = 0; h < 8; ++h) {
            const size_t o = (((size_t)b * 8 + h) * NKEY + j) * 64 + lane;
            const float y = Y0[o] + Y1[o];
            const float mean = sum64(y) * (1.f / 64.f);
            const float dv = y - mean;
            const float var = sum64(dv * dv) * (1.f / 64.f);
            const float yn = dv * rsqrtf(var + 64e-5f) * lnw[h * 64 + lane] + lnb[h * 64 + lane];
            const float bs = B0[(size_t)row * 8 + h] + B1[(size_t)row * 8 + h];
            const float outv = (yn + bs * bf2f(VB[(size_t)row * 512 + h * 64 + lane])) * GG[(size_t)row * 512 + h * 64 + lane];
            MIX[(size_t)row * DM + 512 + h * 64 + lane] = f2bf(outv);
        }
    }
}

using f32x16 = __attribute__((ext_vector_type(16))) float;
#define AT_KBYTES 8192
#define AT_VSTRIDE 136
#define AT_VBYTES (64 * AT_VSTRIDE)
template <int GRP>
__device__ __forceinline__ void attn_item(const P& p, char* ws_, int layer, int b, int h, int qb, int nkeys, float lam, float lam_init, char* smem, int tid) {
    constexpr int KS = GRP ? 2 : 4;
    const int lane = tid & 63, wv = tid >> 6, r32 = lane & 31, hh = lane >> 5;
    const int mp = GRP ? (wv >> 1) : 0, sub = GRP ? (wv & 1) : wv;
    const int jq = qb * (GRP ? 64 : 128) + sub * 32 + r32;
    const bfu* Qg = (const bfu*)(ws_ + (GRP ? WS_QB : WS_QA)) + (((size_t)b * 4 + h) * NKEY + jq) * 64 + mp * 32;
    const bfu* Kg = GRP ? (const bfu*)(ws_ + WS_KB) + ((size_t)b * 4 + h) * NKEY * 64 : (const bfu*)(ws_ + WS_KA) + ((size_t)b * 2 + (h >> 1)) * NKEY * 64;
    const bfu* Vg = GRP ? (const bfu*)(ws_ + WS_VBT) + ((size_t)b * 4 + h) * 64 * NKEY : (const bfu*)(ws_ + WS_VAT) + ((size_t)b * 2 + (h >> 1)) * 64 * NKEY;
    bf16x8 qf[KS];
#pragma unroll
    for (int ks = 0; ks < KS; ++ks) qf[ks] = *(const bf16x8*)(Qg + ks * 16 + hh * 8);
    f32x16 oacc[2];
    float lrun = 0.f;
#pragma unroll
    for (int db = 0; db < 2; ++db)
#pragma unroll
        for (int i = 0; i < 16; ++i) oacc[db][i] = 0.f;
    const int lrow = tid >> 3, lch = ((tid & 7) ^ ((tid >> 4) & 7)) * 8;
    const bfu* kp0 = Kg + (size_t)lrow * 64 + lch; const bfu* kp1 = kp0 + 32 * 64;
    const bfu* vp0 = Vg + (size_t)lrow * NKEY + lch; const bfu* vp1 = vp0 + (size_t)32 * NKEY;
    char* ldst = smem + tid * 16;
#define AT_ISSUE(t_) { char* d_ = ldst + ((t_) & 1) * 16384; const size_t ko_ = (size_t)(t_) * 64 * 64; const int vo_ = (t_) * 64; \
        GLDS(kp0 + ko_, d_); GLDS(kp1 + ko_, d_ + 4096); GLDS(vp0 + vo_, d_ + 8192); GLDS(vp1 + vo_, d_ + 12288); }
    __syncthreads();
    AT_ISSUE(0)
    const int nt = nkeys >> 6;
    float mref = 0.f;
    const int swv = (r32 >> 1) & 7;
    for (int t = 0; t < nt; ++t) {
        asm volatile("s_waitcnt vmcnt(0)" ::: "memory");
        __syncthreads();
        if (t + 1 < nt) AT_ISSUE(t + 1)
        const char* cK = smem + (t & 1) * 16384; const char* cV = cK + 8192;
        f32x16 sacc[2];
        const float ninit = -mref;
#pragma unroll
        for (int kb = 0; kb < 2; ++kb) {
#pragma unroll
            for (int i = 0; i < 16; ++i) sacc[kb][i] = ninit;
            const int key = kb * 32 + r32;
#pragma unroll
            for (int ks = 0; ks < KS; ++ks) {
                const int c0 = mp * 4 + ks * 2 + hh;
                const bf16x8 kf = *(const bf16x8*)(cK + key * 128 + ((c0 ^ ((key >> 1) & 7)) * 16));
                sacc[kb] = __builtin_amdgcn_mfma_f32_32x32x16_bf16(kf, qf[ks], sacc[kb], 0, 0, 0);
            }
        }
        float mx = sacc[0][0];
#pragma unroll
        for (int i = 1; i < 16; ++i) mx = fmaxf(mx, sacc[0][i]);
#pragma unroll
        for (int i = 0; i < 16; ++i) mx = fmaxf(mx, sacc[1][i]);
        mx = fmaxf(mx, __shfl_xor(mx, 32));
        const bool need = (t == 0) || (mx > 8.f);
        if (__any(need)) {
            const float delta = need ? mx : 0.f;
            const float alpha = __builtin_amdgcn_exp2f(-delta);
            mref += delta; lrun *= alpha;
#pragma unroll
            for (int db = 0; db < 2; ++db)
#pragma unroll
                for (int i = 0; i < 16; ++i) oacc[db][i] *= alpha;
#pragma unroll
            for (int kb = 0; kb < 2; ++kb)
#pragma unroll
                for (int i = 0; i < 16; ++i) sacc[kb][i] -= delta;
        }
        float ps = 0.f;
#pragma unroll
        for (int kb = 0; kb < 2; ++kb)
#pragma unroll
            for (int i = 0; i < 16; ++i) { const float pv = __builtin_amdgcn_exp2f(sacc[kb][i]); sacc[kb][i] = pv; ps += pv; }
        lrun += ps;
#pragma unroll
        for (int kb = 0; kb < 2; ++kb)
#pragma unroll
            for (int s2 = 0; s2 < 2; ++s2) {
                union { bf16x8 v; unsigned u[4]; } pf;
#pragma unroll
                for (int i = 0; i < 4; ++i) pf.u[i] = pack2(sacc[kb][8 * s2 + 2 * i], sacc[kb][8 * s2 + 2 * i + 1]);
#pragma unroll
                for (int db = 0; db < 2; ++db) {
                    const char* vr = cV + (db * 32 + r32) * 128 + hh * 8;
                    union { bf16x8 v; uint2 u[2]; } vf;
                    vf.u[0] = *(const uint2*)(vr + (((kb * 4 + s2 * 2) ^ swv) * 16)); vf.u[1] = *(const uint2*)(vr + (((kb * 4 + s2 * 2 + 1) ^ swv) * 16));
                    oacc[db] = __builtin_amdgcn_mfma_f32_32x32x16_bf16(vf.v, pf.v, oacc[db], 0, 0, 0);
                }
            }
    }
    __syncthreads();
    bfu* MIX = (bfu*)(ws_ + WS_MIX);
    const int grow = grow_of(b, jq);
    const float il = 1.f / (lrun + __shfl_xor(lrun, 32));
    if (GRP == 0) {
        bfu* dst = MIX + (size_t)grow * DM + h * 64;
#pragma unroll
        for (int db = 0; db < 2; ++db)
#pragma unroll
            for (int g = 0; g < 4; ++g)
                *(uint2*)(dst + db * 32 + g * 8 + hh * 4) = make_uint2(pack2(oacc[db][4 * g] * il, oacc[db][4 * g + 1] * il), pack2(oacc[db][4 * g + 2] * il, oacc[db][4 * g + 3] * il));
    } else {
        float* xs = (float*)smem + sub * 2048;
        if (mp == 1) {
            const float sc2 = lam * il;
#pragma unroll
            for (int db = 0; db < 2; ++db)
#pragma unroll
                for (int i = 0; i < 16; ++i) xs[(db * 16 + i) * 64 + lane] = oacc[db][i] * sc2;
        }
        __syncthreads();
        if (mp == 0) {
            float ss = 0.f;
#pragma unroll
            for (int db = 0; db < 2; ++db)
#pragma unroll
                for (int i = 0; i < 16; ++i) { const float o = oacc[db][i] * il - xs[(db * 16 + i) * 64 + lane]; oacc[db][i] = o; ss += o * o; }
            ss += __shfl_xor(ss, 32);
            const float rs = rsqrtf(ss * (1.f / 64.f) + 1e-6f) * (1.f - lam_init);
            const float* gn = p.b_subln + layer * 64;
            bfu* dst = MIX + (size_t)grow * DM + 256 + h * 64;
#pragma unroll
            for (int db = 0; db < 2; ++db)
#pragma unroll
                for (int g = 0; g < 4; ++g) {
                    const int d = db * 32 + g * 8 + hh * 4;
                    *(uint2*)(dst + d) = make_uint2(pack2(oacc[db][4 * g] * rs * gn[d], oacc[db][4 * g + 1] * rs * gn[d + 1]), pack2(oacc[db][4 * g + 2] * rs * gn[d + 2], oacc[db][4 * g + 3] * rs * gn[d + 3]));
                }
        }
    }
}
__device__ void phase_attn(const P& p, int layer, bool do_ctx, unsigned* qctr, unsigned* cctr, int* s_item, char* smem) {
    PHASE_PROLOGUE
    const int tid = tid_;
    const float lam_init = 0.8f - 0.6f * expf(-0.3f * (float)layer);
    float d1 = 0.f, d2 = 0.f;
    for (int i = 0; i < 32; ++i) { d1 += p.b_lq1[layer * 32 + i] * p.b_lk1[layer * 32 + i]; d2 += p.b_lq2[layer * 32 + i] * p.b_lk2[layer * 32 + i]; }
    const float lam = expf(d1) - expf(d2) + lam_init;
    const int nitems = do_ctx ? 1728 : 1536;
    bool conv_left = cctr != nullptr;
    for (;;) {
        __syncthreads();
        if (tid == 0) *s_item = (int)atomicAdd(qctr, 1u);
        __syncthreads();
        const int it = *s_item;
        if (it >= nitems) break;
        int grp, b, h, qb, nkeys;
        if (it < 1024) { grp = 1; qb = 4 + (it & 31); h = (it >> 5) & 3; b = it >> 7; nkeys = NKEY; }
        else if (it < 1536) { grp = 0; const int r = it - 1024; qb = 2 + (r & 15); h = (r >> 4) & 3; b = r >> 6; nkeys = NKEY; }
        else if (it < 1664) { grp = 1; const int r = it - 1536; qb = r & 3; h = (r >> 2) & 3; b = r >> 4; nkeys = 256; }
        else { grp = 0; const int r = it - 1664; qb = r & 1; h = (r >> 1) & 3; b = r >> 3; nkeys = 256; }
        if (grp) attn_item<1>(p, ws_, layer, b, h, qb, nkeys, lam, lam_init, smem, tid);
        else attn_item<0>(p, ws_, layer, b, h, qb, nkeys, lam, lam_init, smem, tid);
        if (conv_left) conv_left = conv_big_step(p, ws_, layer, cctr, s_item, smem, tid);
    }
    while (conv_left) conv_left = conv_big_step(p, ws_, layer, cctr, s_item, smem, tid);
}

__device__ void phase_outproj(const P& p, int layer, int nrows, int bid, int nb, char* smem) {
    PHASE_PROLOGUE
    const bfu* MIX = (const bfu*)(ws_ + WS_MIX); const bfu* W = (const bfu*)(ws_ + WS_WOUT);
    float* X = (float*)(ws_ + WS_X); const float* mod = (const float*)(ws_ + WS_MOD);
    const int nitems = (nrows / 128) * 8;
    for (int it = bid; it < nitems; it += nb) {
        const int mt = it >> 3, nt = it & 7, row0 = mt * 128, col0 = nt * 128;
        int b, j0, s; row_info(row0, b, j0, s);
        const float* ga = mod + ((size_t)layer * 9 + s) * 6144 + 2 * 1024;
        gemm_tile([&](int r) { return MIX + (size_t)(row0 + r) * DM; }, [&](int r) { return W + (size_t)(col0 + r) * DM; }, DM,
            [&](f32x4 (&acc)[4][4], int wr, int wc, int fr, int fq) {
                ACC_FOREACH({ float* xp = X + (size_t)(row0 + row) * DM + col0 + col; *xp += ga[col0 + col] * val; })
            }, smem);
    }
}

__device__ void phase_norm2_route(const P& p, int layer, int nrows, int bid, int nb, char* smem) {
    PHASE_PROLOGUE
    const float* X = (const float*)(ws_ + WS_X); bfu* H = (bfu*)(ws_ + WS_H);
    const float* mod = (const float*)(ws_ + WS_MOD); const float* WRT = (const float*)(ws_ + WS_WRT);
    int* ECNT = (int*)(ws_ + WS_ECNT) + layer * 32; int* EIDX = (int*)(ws_ + WS_EIDX); float* EGATE = (float*)(ws_ + WS_EGATE); int* ELIST = (int*)(ws_ + WS_ELIST);
    float* lg = (float*)smem;
    int* lcnt = (int*)(lg + 4 * 16 * 48);
    int* lbase = lcnt + 32;
    int* lsel = lbase + 32;
    int* lrank = lsel + 128;
    const int tid = tid_, lane = tid & 63, wv = tid >> 6, r = lane & 15, kq = lane >> 4;
    const float* gf = p.g_ffn + layer * DM;
    const float* bg = p.r_b_group + layer * 4; const float* be = p.r_b_expert + layer * 32;
    const int nitems = nrows / 64;
    for (int it = bid; it < nitems; it += nb) {
        const int row = it * 64 + wv * 16 + r;
        int b, j, s; row_info(row, b, j, s);
        const float* xr = X + (size_t)row * DM;
        const float* sh = mod + ((size_t)layer * 9 + s) * 6144 + 3 * 1024; const float* sc = sh + 1024;
        if (tid < 32) lcnt[tid] = 0;
        float ss = 0.f;
        for (int c = 0; c < 64; ++c) { const float4 v = *(const float4*)(xr + c * 16 + kq * 4); ss += v.x * v.x + v.y * v.y + v.z * v.z + v.w * v.w; }
        ss += __shfl_xor(ss, 16); ss += __shfl_xor(ss, 32);
        const float rs = rsqrtf(ss * (1.f / 1024.f) + 1e-6f);
        f32x4 acc[3];
#pragma unroll
        for (int n = 0; n < 3; ++n) acc[n] = (f32x4){0.f, 0.f, 0.f, 0.f};
        for (int c = 0; c < 64; ++c) {
            const int k = c * 16 + kq * 4;
            const float4 v = *(const float4*)(xr + k), g = *(const float4*)(gf + k), s1 = *(const float4*)(sc + k), s0 = *(const float4*)(sh + k);
            float f[4];
            f[0] = v.x * rs * g.x * (1.f + s1.x) + s0.x; f[1] = v.y * rs * g.y * (1.f + s1.y) + s0.y;
            f[2] = v.z * rs * g.z * (1.f + s1.z) + s0.z; f[3] = v.w * rs * g.w * (1.f + s1.w) + s0.w;
            *(uint2*)(H + (size_t)row * DM + k) = make_uint2(pack2(f[0], f[1]), pack2(f[2], f[3]));
#pragma unroll
            for (int n = 0; n < 3; ++n) {
                const float4 w = *(const float4*)(WRT + (size_t)(n * 16 + r) * DM + k);
                acc[n] = __builtin_amdgcn_mfma_f32_16x16x4f32(f[0], w.x, acc[n], 0, 0, 0);
                acc[n] = __builtin_amdgcn_mfma_f32_16x16x4f32(f[1], w.y, acc[n], 0, 0, 0);
                acc[n] = __builtin_amdgcn_mfma_f32_16x16x4f32(f[2], w.z, acc[n], 0, 0, 0);
                acc[n] = __builtin_amdgcn_mfma_f32_16x16x4f32(f[3], w.w, acc[n], 0, 0, 0);
            }
        }
#pragma unroll
        for (int n = 0; n < 3; ++n)
#pragma unroll
            for (int jj = 0; jj < 4; ++jj) lg[(wv * 16 + kq * 4 + jj) * 48 + n * 16 + r] = acc[n][jj];
        __syncthreads();
        if (lane < 16) {
            const float* L = lg + (wv * 16 + lane) * 48;
            const int grow = it * 64 + wv * 16 + lane;
            float gl[4]; float gm = -1e30f; int gi = 0;
#pragma unroll
            for (int g = 0; g < 4; ++g) { gl[g] = L[g] + bg[g]; if (gl[g] > gm) { gm = gl[g]; gi = g; } }
            float gs = 0.f;
#pragma unroll
            for (int g = 0; g < 4; ++g) gs += __expf(gl[g] - gm);
            const float gp = 1.f / gs;
            float v1 = -1e30f, v2 = -1e30f; int i1 = 0, i2 = 0;
            for (int e = 0; e < 8; ++e) {
                const float v = L[4 + gi * 8 + e] + be[gi * 8 + e];
                if (v > v1) { v2 = v1; i2 = i1; v1 = v; i1 = e; } else if (v > v2) { v2 = v; i2 = e; }
            }
            const float e2 = __expf(v2 - v1), den = 1.f / (1.f + e2);
            const int ex1 = gi * 8 + i1, ex2 = gi * 8 + i2;
            EIDX[grow * 2] = ex1; EIDX[grow * 2 + 1] = ex2;
            EGATE[grow * 2] = den * gp; EGATE[grow * 2 + 1] = e2 * den * gp;
            const int lr = wv * 16 + lane;
            lsel[lr * 2] = ex1; lsel[lr * 2 + 1] = ex2;
            lrank[lr * 2] = atomicAdd(&lcnt[ex1], 1); lrank[lr * 2 + 1] = atomicAdd(&lcnt[ex2], 1);
        }
        __syncthreads();
        if (tid < 32) lbase[tid] = lcnt[tid] > 0 ? atomicAdd(&ECNT[tid], lcnt[tid]) : 0;
        __syncthreads();
        if (tid < 128) { const int e = lsel[tid]; ELIST[(size_t)e * (2 * MA) + lbase[e] + lrank[tid]] = ((it * 64 + (tid >> 1)) << 1) | (tid & 1); }
        __syncthreads();
    }
}

__device__ __forceinline__ int moe_prefix(const int* ECNT, int* spre  ) {
    if (threadIdx.x == 0) { int a = 0; for (int e = 0; e < 32; ++e) { spre[e] = a; a += (ECNT[e] + 127) >> 7; } spre[32] = a; }
    __syncthreads();
    return spre[32];
}
__device__ void phase_expert1(const P& p, int layer, int bid, int nb, char* smem) {
    PHASE_PROLOGUE
    const bfu* H = (const bfu*)(ws_ + WS_H); const bfu* W1 = (const bfu*)(ws_ + WS_W1); const bfu* W3 = (const bfu*)(ws_ + WS_W3);
    bfu* HB = (bfu*)(ws_ + WS_HB);
    const int* ECNT = (const int*)(ws_ + WS_ECNT) + layer * 32; const int* ELIST = (const int*)(ws_ + WS_ELIST);
    int* spre = (int*)(smem + 65536);
    const int nblk = moe_prefix(ECNT, spre);
    const int nitems = nblk * 8;
    for (int it = bid; it < nitems; it += nb) {
        const int blk = it >> 3, nt = it & 7;
        int e = 0;
        while (spre[e + 1] <= blk) ++e;
        const int rb = blk - spre[e], cnt = ECNT[e];
        const int* lst = ELIST + (size_t)e * (2 * MA) + rb * 128;
        const int nvalid = min(128, cnt - rb * 128);
        const bfu* w1 = W1 + (size_t)e * FF * DM; const bfu* w3 = W3 + (size_t)e * FF * DM;
        bfu* hb = HB + (size_t)blk * 128 * FF;
        gemm_tile([&](int r) { const int tok = r < nvalid ? (lst[r] >> 1) : 0; return H + (size_t)tok * DM; },
                  [&](int r) { const int wcx = r >> 6, n4 = (r >> 4) & 3, rr = r & 15; const int hc = nt * 64 + wcx * 32 + (n4 & 1) * 16 + rr; return (n4 < 2 ? w1 : w3) + (size_t)hc * DM; }, DM,
            [&](f32x4 (&acc)[4][4], int wr, int wc, int fr, int fq) {
#pragma unroll
                for (int m = 0; m < 4; ++m)
#pragma unroll
                    for (int n = 0; n < 2; ++n)
#pragma unroll
                        for (int jj = 0; jj < 4; ++jj) {
                            const int row = wr * 64 + m * 16 + fq * 4 + jj; const int hc = nt * 64 + wc * 32 + n * 16 + fr;
                            const float a = acc[m][n][jj], g = acc[m][n + 2][jj];
                            hb[(size_t)row * FF + hc] = f2bf(siluf_(a) * g);
                        }
            }, smem);
    }
}
__device__ void phase_expert2(const P& p, int layer, int bid, int nb, char* smem) {
    PHASE_PROLOGUE
    const bfu* HB = (const bfu*)(ws_ + WS_HB); const bfu* W2 = (const bfu*)(ws_ + WS_W2);
    float* Y = (float*)(ws_ + WS_Y01);
    const int* ECNT = (const int*)(ws_ + WS_ECNT) + layer * 32; const int* ELIST = (const int*)(ws_ + WS_ELIST); const float* EGATE = (const float*)(ws_ + WS_EGATE);
    int* spre = (int*)(smem + 65536);
    const int nblk = moe_prefix(ECNT, spre);
    const int nitems = nblk * 8;
    for (int it = bid; it < nitems; it += nb) {
        const int blk = it >> 3, nt = it & 7;
        int e = 0;
        while (spre[e + 1] <= blk) ++e;
        const int rb = blk - spre[e], cnt = ECNT[e];
        const int* lst = ELIST + (size_t)e * (2 * MA) + rb * 128;
        const int nvalid = min(128, cnt - rb * 128);
        const bfu* w2 = W2 + (size_t)e * DM * FF;
        const bfu* hb = HB + (size_t)blk * 128 * FF;
        gemm_tile([&](int r) { return hb + (size_t)r * FF; }, [&](int r) { return w2 + (size_t)(nt * 128 + r) * FF; }, FF,
            [&](f32x4 (&acc)[4][4], int wr, int wc, int fr, int fq) {
#pragma unroll
                for (int m = 0; m < 4; ++m)
#pragma unroll
                    for (int jj = 0; jj < 4; ++jj) {
                        const int row = wr * 64 + m * 16 + fq * 4 + jj;
                        if (row < nvalid) {
                            const int ent = lst[row]; const float gt = EGATE[ent];
                            float* yp = Y + ((size_t)(ent & 1) * MA + (ent >> 1)) * DM + nt * 128 + wc * 64 + fr;
#pragma unroll
                            for (int n = 0; n < 4; ++n) yp[n * 16] = gt * acc[m][n][jj];
                        }
                    }
            }, smem);
    }
}

#define XB_TMO      128
#define XB_XCNT(j)  (256  + 64 * (j))
#define XB_XSUB(j)  (1280 + 64 * (j))
#define XB_XGEN(j)  (2304 + 64 * (j))
#define XB_TOP      3328
#define XB_TOPGEN   3392
#define XCD_BAR_WORDS 3456
#define XB_SPIN_CAP (1u << 22)
#define LAS __attribute__((address_space(3)))

__device__ __forceinline__ unsigned xb_ld(unsigned* p)              { return __hip_atomic_load(p, __ATOMIC_RELAXED, __HIP_MEMORY_SCOPE_AGENT); }
__device__ __forceinline__ unsigned xb_add(unsigned* p, unsigned v) { return __hip_atomic_fetch_add(p, v, __ATOMIC_RELAXED, __HIP_MEMORY_SCOPE_AGENT); }
__device__ __forceinline__ unsigned xb_xcc_id() { return (unsigned)__builtin_amdgcn_s_getreg((3 << 11) | 20) & 0xFu; }
#define XB_SPIN(cond, bar) do { unsigned _sp = 0; while (cond) { __builtin_amdgcn_s_sleep(1); \
    if ((++_sp & 255u) == 0u) { if (xb_ld(&(bar)[XB_TMO])) break; if (_sp > XB_SPIN_CAP) { atomicAdd(&(bar)[XB_TMO], 1u); break; } } } } while (0)

struct XcdBarrier {
    unsigned* bar; unsigned x;
    volatile LAS unsigned* st;
};

__device__ __forceinline__ XcdBarrier xcd_barrier_post(unsigned* bar, volatile LAS unsigned* st) {
    XcdBarrier b; b.bar = bar; b.x = xb_xcc_id(); b.st = st;
    if (threadIdx.x == 0) (void)xb_add(&bar[XB_XCNT(b.x)], 1u);
    return b;
}
__device__ __forceinline__ void xcd_barrier_complete(unsigned* bar, unsigned x, unsigned& nloc, unsigned& nx) {
    const unsigned G = gridDim.x * gridDim.y * gridDim.z;
    unsigned sum, cnt, mine, sp = 0u;
    for (;;) {
        sum = 0u; cnt = 0u; mine = 0u;
#pragma unroll
        for (unsigned j = 0; j < 16; ++j) { const unsigned c = xb_ld(&bar[XB_XCNT(j)]); sum += c; cnt += (c > 0u) ? 1u : 0u; mine = (j == x) ? c : mine; }
        if (sum == G) break;
        __builtin_amdgcn_s_sleep(1);
        if ((++sp & 255u) == 0u) { if (xb_ld(&bar[XB_TMO])) break; if (sp > XB_SPIN_CAP) { atomicAdd(&bar[XB_TMO], 1u); break; } }
    }
    nloc = mine > 0u ? mine : 1u; nx = cnt > 0u ? cnt : 1u;
}

__device__ __forceinline__ void xcd_barrier(const XcdBarrier& b) {
    asm volatile("s_waitcnt vmcnt(0)" ::: "memory");
    __syncthreads();
    if (threadIdx.x == 0) {
        unsigned* bar = b.bar;
        __builtin_amdgcn_s_waitcnt(0);
        unsigned nloc = b.st[0], nx = b.st[1];
        if (nloc == 0u) { xcd_barrier_complete(bar, b.x, nloc, nx); b.st[0] = nloc; b.st[1] = nx; }
        const unsigned old = xb_add(&bar[XB_XSUB(b.x)], 1u);
        const unsigned gen = old / nloc;
        if (old + 1u == (gen + 1u) * nloc) {
            __builtin_amdgcn_fence(__ATOMIC_RELEASE, "agent");
            asm volatile("s_waitcnt vmcnt(0)" ::: "memory");
            const unsigned og = xb_add(&bar[XB_TOP], 1u);
            const unsigned tg = og / nx;
            if (og + 1u == (tg + 1u) * nx) xb_add(&bar[XB_TOPGEN], 1u);
            else XB_SPIN(xb_ld(&bar[XB_TOPGEN]) == tg, bar);
            __builtin_amdgcn_fence(__ATOMIC_ACQUIRE, "agent");
            xb_add(&bar[XB_XGEN(b.x)], 1u);
            asm volatile("s_waitcnt vmcnt(0)" ::: "memory");
        } else {
            XB_SPIN(xb_ld(&bar[XB_XGEN(b.x)]) == gen, bar);
            __builtin_amdgcn_fence(__ATOMIC_ACQUIRE, "agent");
            asm volatile("s_waitcnt vmcnt(0)" ::: "memory");
        }
    }
    __syncthreads();
}


#define REP_MOD 1
#define REP_CONV 1
#define REP_INPROJ 1
#define REP_RK 1
#define REP_SCANATT 1
#define REP_R4 1
#define REP_ATT 1
#define REP_READOUT 1
#define REP_EXP1 1
#define REP_EXP2 1
#define REPEAT(N) _Pragma("nounroll") for (int rep_ = 0; rep_ < (N); ++rep_)
#define REPEAT2(N) _Pragma("nounroll") for (int rep2_ = 0; rep2_ < (N); ++rep2_)
#define CTL_Q(l) (4096 + 64 * (l))
#define CTL_XR 5120
__global__ void __launch_bounds__(256, 2) fwd(P p) {
    __shared__ __attribute__((aligned(16))) char smem[SMEM_BYTES + 32];
    uint4& xb_words = *(uint4*)(smem + SMEM_BYTES);
    int& s_item = *(int*)(smem + SMEM_BYTES + 16);
    if (threadIdx.x == 0) xb_words = make_uint4(0u, 0u, 0u, 0u);
    __syncthreads();
    unsigned* ctl = (unsigned*)(p.ws + WS_CTL);
    XcdBarrier bar = xcd_barrier_post(ctl, (volatile LAS unsigned*)&xb_words);
    const int bid = blockIdx.x, nb = gridDim.x;
    int& s_vb = *(int*)(smem + SMEM_BYTES + 20);
    const unsigned my_xcc = xb_xcc_id();
    if (threadIdx.x == 0) s_vb = (int)atomicAdd(&ctl[CTL_XR + 16 * my_xcc], 1u);
    int vb = bid;
    phase_setup(p, bid, nb);
    REPEAT(REP_MOD) phase_mod(p, bid, nb, smem);
    for (int l = 0; l < NLAYER; ++l) {
        const int nr = l < NLAYER - 1 ? MA : ML;
        REPEAT(REP_CONV) phase_conv(p, l, bid, nb, smem);
        if (l == 0) {
            xcd_barrier(bar);
            if (threadIdx.x == 0) { int pre = 0; for (unsigned x = 0; x < my_xcc; ++x) pre += (int)xb_ld(&ctl[CTL_XR + 16 * x]); s_vb += pre; }
            __syncthreads();
            vb = s_vb;
        }
        phase_norm1(p, l, 0, bid, nb);
        xcd_barrier(bar);
        REPEAT(REP_INPROJ) { phase_inproj(p, l, vb, nb, smem); xcd_barrier(bar); }
        REPEAT(REP_RK) { phase_rk(p, l, bid, nb, smem); xcd_barrier(bar); }
        REPEAT(REP_SCANATT) {
            if (bid < 128) { REPEAT(REP_R4) phase_r4(p, l, bid, 128, smem); }
            else phase_gate(p, l, bid - 128, nb - 128, smem);
            REPEAT2(REP_ATT) phase_attn(p, l, l < NLAYER - 1, ctl + CTL_Q(l) + 16 * rep_ + 32 * rep2_, ctl + CTL_Q(l) + 8 + 16 * rep_ + 32 * rep2_, &s_item, smem);
            xcd_barrier(bar);
        }
        REPEAT(REP_READOUT) { phase_readout(p, l, nr, bid, nb); xcd_barrier(bar); }
        phase_outproj(p, l, nr, vb, nb, smem);
        xcd_barrier(bar);
        phase_norm2_route(p, l, nr, bid, nb, smem);
        xcd_barrier(bar);
        REPEAT(REP_EXP1) { phase_expert1(p, l, vb, nb, smem); xcd_barrier(bar); }
        REPEAT(REP_EXP2) { phase_expert2(p, l, vb, nb, smem); xcd_barrier(bar); }
    }
    phase_norm1(p, NLAYER, 1, bid, nb);
}

extern "C" void kernel_launch(void* const* d_in, const int* in_sizes, int n_in, void* d_out, int out_size, void* d_ws, size_t ws_size, hipStream_t stream) {
    if (n_in != 36 || ws_size < WS_END) { fprintf(stderr, "kernel_launch: unexpected n_in %d or ws_size %zu < %zu\n", n_in, ws_size, (size_t)WS_END); return; }
    static int grid = 0;
    if (!grid) {
        int dev = 0, cus = 0, per_cu = 0;
        hipGetDevice(&dev);
        hipDeviceGetAttribute(&cus, hipDeviceAttributeMultiprocessorCount, dev);
        hipOccupancyMaxActiveBlocksPerMultiprocessor(&per_cu, (const void*)fwd, 256, 0);
        if (per_cu < 1) per_cu = 1;
        grid = cus * (per_cu < 2 ? per_cu : 2);
    }
    P p{};
    const float** pp = (const float**)&p;
    for (int i = 0; i < 36; ++i) pp[i] = (const float*)d_in[i];
    p.out = (float*)d_out; p.ws = (char*)d_ws;
    hipMemsetAsync((char*)d_ws + WS_CTL, 0, 65536, stream);
    fwd<<<grid, 256, 0, stream>>>(p);
}
```

```cpp
#include <hip/hip_runtime.h>
#include <stdint.h>
#include <stdio.h>

typedef unsigned short bfu;
using bf16x8 = __attribute__((ext_vector_type(8))) short;
using f32x4  = __attribute__((ext_vector_type(4))) float;

#define DM 1024
#define NB 8
#define SEQ 2048
#define CL 256
#define NKEY 2304
#define ML 16384
#define MC 2048
#define MA 18432
#define INW 3200
#define CSL 1920
#define NEXP 32
#define FF 512
#define NLAYER 4
#define LOG2E 1.4426950408889634f

#define MBy(x) ((size_t)(x) << 20)
constexpr size_t WS_CTL   = 0;
constexpr size_t WS_MOD   = 65536;
constexpr size_t WS_ROPE  = WS_MOD + (size_t)4 * 9 * 6144 * 4;
constexpr size_t WS_ECNT  = WS_ROPE + 64 * 16 * 2 * 4 + 64 * 8 * 2 * 4;
constexpr size_t WS_WRT   = WS_ECNT + 4096;
constexpr size_t WS_EIDX  = WS_WRT + (size_t)48 * 1024 * 4;
constexpr size_t WS_EGATE = WS_EIDX + (size_t)MA * 2 * 4;
constexpr size_t WS_ELIST = WS_EGATE + (size_t)MA * 2 * 4;
constexpr size_t WS_X     = MBy(8);
constexpr size_t WS_H     = WS_X + (size_t)MA * DM * 4;
constexpr size_t WS_WIN   = WS_H + (size_t)MA * DM * 2;
constexpr size_t WS_WOUT  = WS_WIN + (size_t)INW * DM * 2;
constexpr size_t WS_W1    = WS_WOUT + (size_t)DM * DM * 2;
constexpr size_t WS_W3    = WS_W1 + (size_t)NEXP * FF * DM * 2;
constexpr size_t WS_W2    = WS_W3 + (size_t)NEXP * FF * DM * 2;
constexpr size_t WS_LW2   = WS_W2 + (size_t)NEXP * FF * DM * 2;
constexpr size_t WS_LA2   = WS_LW2 + (size_t)2 * 512 * 64 * 2;
constexpr size_t WS_LG2   = WS_LA2 + (size_t)2 * 512 * 64 * 2;
constexpr size_t WS_QA    = WS_LG2 + (size_t)512 * 128 * 2;
constexpr size_t WS_KA    = WS_QA + (size_t)NB * 4 * NKEY * 64 * 2;
constexpr size_t WS_VAT   = WS_KA + (size_t)NB * 2 * NKEY * 64 * 2;
constexpr size_t WS_QB    = WS_VAT + (size_t)NB * 2 * NKEY * 64 * 2;
constexpr size_t WS_KB    = WS_QB + (size_t)NB * 4 * NKEY * 64 * 2;
constexpr size_t WS_VBT   = WS_KB + (size_t)NB * 4 * NKEY * 64 * 2;
constexpr size_t WS_CP    = WS_VBT + (size_t)NB * 4 * NKEY * 64 * 2;
constexpr size_t WS_GG    = WS_CP + (size_t)MA * CSL * 4;
constexpr size_t WS_MIX   = WS_GG + (size_t)MA * 512 * 4;
constexpr size_t HEADARR  = (size_t)NB * 8 * NKEY * 64 * 4;
#define OPS_REC 13568
constexpr size_t OPS_DIR  = (size_t)64 * 144 * OPS_REC;
constexpr size_t WS_OPS   = WS_MIX + (size_t)MA * DM * 2;
constexpr size_t WS_YS    = WS_OPS + 2 * OPS_DIR;
constexpr size_t WS_VB    = WS_YS + 2 * HEADARR;
constexpr size_t WS_BETA  = WS_VB + (size_t)MA * 512 * 2;
constexpr size_t WS_LXG   = WS_BETA + (size_t)2 * MA * 8 * 4;
constexpr size_t WS_SCR   = WS_LXG + (size_t)MA * 128 * 2;
constexpr size_t WS_END   = WS_SCR + (size_t)256 * 2 * 128 * 132 * 4;
constexpr size_t WS_Y01   = WS_OPS;
constexpr size_t WS_HB    = WS_OPS + (size_t)2 * MA * DM * 4;
static_assert((size_t)2 * MA * DM * 4 + (size_t)(2 * MA + 32 * 256) * 512 * 2 <= 2 * OPS_DIR, "MoE buffers must fit in OPS");

struct P {
    const float *x, *c, *ctx, *c_ctx, *w_mod, *b_mod, *g_mix, *g_ffn, *w_in, *a_q_gain, *a_k_gain, *b_lq1, *b_lk1, *b_lq2, *b_lk2, *b_subln,
        *c_mu, *c_w0, *c_w2, *c_a0, *c_a2, *c_g2, *c_k_k, *c_k_a, *c_r_k, *c_ln_w, *c_ln_b, *w_out, *r_w_group, *r_b_group, *r_w_expert, *r_b_expert,
        *e_w1, *e_w3, *e_w2, *g_final;
    float* out;
    char* ws;
};

typedef const __attribute__((address_space(4))) P& KP;
#define KPARG (*({ const __attribute__((address_space(4))) P* k_ = (const __attribute__((address_space(4))) P*)__builtin_amdgcn_kernarg_segment_ptr(); asm volatile("" : "+s"(k_)); k_; }))

__device__ __forceinline__ float bf2f(bfu b) { return __uint_as_float((unsigned)b << 16); }
__device__ __forceinline__ unsigned pack2(float a, float b) {
    typedef float f2 __attribute__((ext_vector_type(2)));
    typedef __bf16 b2 __attribute__((ext_vector_type(2)));
    f2 v = {a, b}; b2 r = __builtin_convertvector(v, b2); return __builtin_bit_cast(unsigned, r);
}
__device__ __forceinline__ bfu f2bf(float a) { return (bfu)(pack2(a, 0.f) & 0xFFFFu); }
__device__ __forceinline__ int lane_id_() { int l; asm volatile("v_mbcnt_lo_u32_b32 %0, -1, 0\n\tv_mbcnt_hi_u32_b32 %0, -1, %0" : "=v"(l)); return l; }
__device__ __forceinline__ float shfl_xor_(float v, int o) { return __int_as_float(__builtin_amdgcn_ds_bpermute((lane_id_() ^ o) << 2, __float_as_int(v))); }
__device__ __forceinline__ float wave_sum(float v) {
#pragma unroll
    for (int o = 32; o >= 1; o >>= 1) v += shfl_xor_(v, o);
    return v;
}
template <int CTRL> __device__ __forceinline__ float dppf(float v) { return __int_as_float(__builtin_amdgcn_update_dpp(0, __float_as_int(v), CTRL, 0xF, 0xF, true)); }
__device__ __forceinline__ float sum8(float v) { v += dppf<0xB1>(v); v += dppf<0x4E>(v); v += dppf<0x141>(v); return v; }
__device__ __forceinline__ float sigmoidf_(float x) { return 1.f / (1.f + __expf(-x)); }
__device__ __forceinline__ float siluf_(float x) { return x / (1.f + __expf(-x)); }
__device__ __forceinline__ void row_info(int grow, int& b, int& j, int& s) {
    if (grow < ML) { b = grow >> 11; j = 256 + (grow & 2047); s = b; }
    else { int r = grow - ML; b = r >> 8; j = r & 255; s = 8; }
}
__device__ __forceinline__ int grow_of(int b, int j) { return j < 256 ? ML + b * 256 + j : b * 2048 + (j - 256); }

#define SMEM_BYTES 69632

#define TID512 ((wsid_ << 6) | lane_id_())
#define PHASE_PROLOGUE int tid_ = ((wsid_ & 3) << 6) | lane_id_(); asm volatile("" : "+v"(tid_)); const int hb_ = wsid_ >> 2; (void)hb_; \
    int z_ = 0; asm volatile("" : "+v"(z_)); char* ws_ = p.ws + __builtin_amdgcn_readfirstlane(z_);

__device__ void phase_setup(KP p, int wsid_, int bid, int nb) {
    PHASE_PROLOGUE
    float4* X4 = (float4*)(ws_ + WS_X);
    const float4* x4 = (const float4*)p.x; const float4* c4 = (const float4*)p.ctx;
    const size_t nl = (size_t)ML * DM / 4, nc = (size_t)MC * DM / 4;
    for (size_t i = (size_t)bid * 256 + tid_; i < nl + nc; i += (size_t)nb * 256) X4[i] = i < nl ? x4[i] : c4[i - nl];
    if (bid == 0) {
        float* TA = (float*)(ws_ + WS_ROPE); float* TB = TA + 64 * 16 * 2;
        for (int i = tid_; i < 64 * 16; i += 256) { int pos = i >> 4, f = i & 15; double inv = pow(10000.0, -(double)f / 16.0); double a = (double)pos * inv; TA[i * 2] = (float)cos(a); TA[i * 2 + 1] = (float)sin(a); }
        for (int i = tid_; i < 64 * 8; i += 256) { int pos = i >> 3, f = i & 7; double inv = pow(10000.0, -(double)f / 8.0); double a = (double)pos * inv; TB[i * 2] = (float)cos(a); TB[i * 2 + 1] = (float)sin(a); }
        int* ec = (int*)(ws_ + WS_ECNT);
        for (int i = tid_; i < 128; i += 256) ec[i] = 0;
    }
}

__device__ void phase_mod(KP p, int wsid_, int bid, int nb, char* smem) {
    PHASE_PROLOGUE
    float* act = (float*)smem;
    float* red = act + 9 * 1024;
    for (int i = tid_; i < 9 * 1024; i += 256) { float v = i < 8 * 1024 ? p.c[i] : p.c_ctx[i - 8 * 1024]; act[i] = siluf_(v); }
    __syncthreads();
    float* mod = (float*)(ws_ + WS_MOD);
    const int nitems = 4 * 6144 / 64;
    const int ct = tid_ & 15, kg = tid_ >> 4, wv = tid_ >> 6;
    for (int it = bid; it < nitems; it += nb) {
        const int layer = it / 96, n0 = (it % 96) * 64;
        const float* w = p.w_mod + (size_t)layer * DM * 6144 + (size_t)(kg * 64) * 6144 + n0 + ct * 4;
        float a[9][4];
#pragma unroll
        for (int s = 0; s < 9; ++s) { a[s][0] = 0.f; a[s][1] = 0.f; a[s][2] = 0.f; a[s][3] = 0.f; }
#pragma unroll 1
        for (int k0 = 0; k0 < 64; k0 += 16) {
            float4 wq[16];
#pragma unroll
            for (int j = 0; j < 16; ++j) wq[j] = *(const float4*)(w + (size_t)(k0 + j) * 6144);
#pragma unroll
            for (int j4 = 0; j4 < 4; ++j4)
#pragma unroll
                for (int s = 0; s < 9; ++s) {
                    const float4 av = *(const float4*)(act + s * 1024 + kg * 64 + k0 + j4 * 4);
                    const float avv[4] = {av.x, av.y, av.z, av.w};
#pragma unroll
                    for (int e = 0; e < 4; ++e) { const float4 q = wq[j4 * 4 + e]; a[s][0] += avv[e] * q.x; a[s][1] += avv[e] * q.y; a[s][2] += avv[e] * q.z; a[s][3] += avv[e] * q.w; }
                }
        }
#pragma unroll
        for (int s = 0; s < 9; ++s)
#pragma unroll
            for (int c = 0; c < 4; ++c) { float v = a[s][c]; v += shfl_xor_(v, 16); v += shfl_xor_(v, 32); a[s][c] = v; }
        if ((tid_ & 63) < 16) {
#pragma unroll
            for (int s = 0; s < 9; ++s) *(float4*)(red + (wv * 9 + s) * 64 + ct * 4) = make_float4(a[s][0], a[s][1], a[s][2], a[s][3]);
        }
        __syncthreads();
        for (int i = tid_; i < 9 * 64; i += 256) {
            const int s = i >> 6, c2 = i & 63, n2 = n0 + c2;
            float v = red[(0 * 9 + s) * 64 + c2] + red[(1 * 9 + s) * 64 + c2] + red[(2 * 9 + s) * 64 + c2] + red[(3 * 9 + s) * 64 + c2];
            mod[((size_t)layer * 9 + s) * 6144 + n2] = v + p.b_mod[layer * 6144 + n2];
        }
        __syncthreads();
    }
}

__device__ __forceinline__ void conv_tile(const float* src, int K, int N, bfu* dst, int k0, int n0, float* ts, int tid_) {
    const int t = tid_;
    {
        const int kk = t >> 4, n4 = (t & 15) * 4;
#pragma unroll
        for (int pz = 0; pz < 4; ++pz) {
            const float4 v = *(const float4*)(src + (size_t)(k0 + kk + 16 * pz) * N + n0 + n4);
            float* d = ts + (kk + 16 * pz) * 65 + n4; d[0] = v.x; d[1] = v.y; d[2] = v.z; d[3] = v.w;
        }
    }
    __syncthreads();
    {
        const int n = t >> 2, kc = (t & 3) * 16;
        unsigned o[8];
#pragma unroll
        for (int i = 0; i < 8; ++i) o[i] = pack2(ts[(kc + 2 * i) * 65 + n], ts[(kc + 2 * i + 1) * 65 + n]);
        uint4* d = (uint4*)(dst + (size_t)(n0 + n) * K + k0 + kc);
        d[0] = make_uint4(o[0], o[1], o[2], o[3]); d[1] = make_uint4(o[4], o[5], o[6], o[7]);
    }
    __syncthreads();
}
__device__ void phase_conv(KP p, int wsid_, int layer, int bid, int nb, char* smem) {
    PHASE_PROLOGUE
    float* ts = (float*)smem;
    const float* srcs[8]; bfu* dsts[8]; int Ks[8], Ns[8], Bs[8];
    char* ws = ws_;
    srcs[0] = p.w_in + (size_t)layer * DM * INW;  Ks[0] = DM; Ns[0] = INW; Bs[0] = 1;  dsts[0] = (bfu*)(ws + WS_WIN);
    srcs[1] = p.w_out + (size_t)layer * DM * DM;  Ks[1] = DM; Ns[1] = DM;  Bs[1] = 1;  dsts[1] = (bfu*)(ws + WS_WOUT);
    srcs[2] = p.e_w1 + (size_t)layer * NEXP * DM * FF; Ks[2] = DM; Ns[2] = FF; Bs[2] = NEXP; dsts[2] = (bfu*)(ws + WS_W1);
    srcs[3] = p.e_w3 + (size_t)layer * NEXP * DM * FF; Ks[3] = DM; Ns[3] = FF; Bs[3] = NEXP; dsts[3] = (bfu*)(ws + WS_W3);
    srcs[4] = p.e_w2 + (size_t)layer * NEXP * FF * DM; Ks[4] = FF; Ns[4] = DM; Bs[4] = NEXP; dsts[4] = (bfu*)(ws + WS_W2);
    srcs[5] = p.c_w2 + (size_t)layer * 2 * 64 * 512;   Ks[5] = 64; Ns[5] = 512; Bs[5] = 2;   dsts[5] = (bfu*)(ws + WS_LW2);
    srcs[6] = p.c_a2 + (size_t)layer * 2 * 64 * 512;   Ks[6] = 64; Ns[6] = 512; Bs[6] = 2;   dsts[6] = (bfu*)(ws + WS_LA2);
    srcs[7] = p.c_g2 + (size_t)layer * 128 * 512;      Ks[7] = 128; Ns[7] = 512; Bs[7] = 1;  dsts[7] = (bfu*)(ws + WS_LG2);
    for (int it = bid; it < 1104; it += nb) {
        int jb, r;
        if (it < 800) { jb = 0; r = it; } else if (it < 1056) { jb = 1; r = it - 800; } else if (it < 1072) { jb = 5; r = it - 1056; } else if (it < 1088) { jb = 6; r = it - 1072; } else { jb = 7; r = it - 1088; }
        const float* src; bfu* dst; int K, N;
        if (jb == 0) { src = srcs[0]; dst = dsts[0]; K = DM; N = INW; } else if (jb == 1) { src = srcs[1]; dst = dsts[1]; K = DM; N = DM; }
        else if (jb == 5) { src = srcs[5]; dst = dsts[5]; K = 64; N = 512; } else if (jb == 6) { src = srcs[6]; dst = dsts[6]; K = 64; N = 512; } else { src = srcs[7]; dst = dsts[7]; K = 128; N = 512; }
        const int tk = K / 64, tn = N / 64, per = tk * tn, bt = r / per, r2 = r % per, kt = r2 / tn, nt = r2 % tn;
        conv_tile(src + (size_t)bt * K * N, K, N, dst + (size_t)bt * K * N, kt * 64, nt * 64, ts, tid_);
    }
    float* wrt = (float*)(ws + WS_WRT);
    const float* wg = p.r_w_group + (size_t)layer * DM * 4; const float* we = p.r_w_expert + (size_t)layer * DM * 32;
    for (int i = bid * 256 + tid_; i < 48 * 1024; i += nb * 256) {
        const int r = i >> 10, k = i & 1023;
        wrt[i] = r < 4 ? wg[k * 4 + r] : (r < 36 ? we[k * 32 + (r - 4)] : 0.f);
    }
}

__device__ __forceinline__ bool conv_big_step(KP p, int wsid_, char* ws_, int layer, unsigned* qctr, int* s_item, char* smem, int tid_, int hb_) {
    float* ts = (float*)smem;
    __syncthreads();
    if (TID512 == 0) *s_item = (int)atomicAdd(qctr, 1u);
    __syncthreads();
    const int gidx = __builtin_amdgcn_readfirstlane(*s_item);
    if (gidx >= 1536) return false;
    { const int q0 = hb_ * 4;
        const float* sp[4]; bfu* dp[4]; int Ks[4];
        float4 v[4][4];
        const int kk = tid_ >> 4, n4 = (tid_ & 15) * 4;
#pragma unroll
        for (int q = 0; q < 4; ++q) {
            const int it = gidx * 8 + q0 + q, jb = it >> 12, r = it & 4095, bt = r >> 7, r2 = r & 127;
            const float* src; bfu* dst; int K, N;
            if (jb == 0) { src = p.e_w1 + (size_t)layer * NEXP * DM * FF; dst = (bfu*)(ws_ + WS_W1); K = DM; N = FF; }
            else if (jb == 1) { src = p.e_w3 + (size_t)layer * NEXP * DM * FF; dst = (bfu*)(ws_ + WS_W3); K = DM; N = FF; }
            else { src = p.e_w2 + (size_t)layer * NEXP * FF * DM; dst = (bfu*)(ws_ + WS_W2); K = FF; N = DM; }
            const int tn = N >> 6, kt = r2 / tn, nt = r2 % tn;
            const float* s0 = src + (size_t)bt * K * N + (size_t)(kt * 64 + kk) * N + nt * 64 + n4;
#pragma unroll
            for (int pz = 0; pz < 4; ++pz) v[q][pz] = *(const float4*)(s0 + (size_t)(16 * pz) * N);
            Ks[q] = K;
            dp[q] = dst + (size_t)bt * K * N + (size_t)(nt * 64 + (tid_ >> 2)) * K + kt * 64 + (tid_ & 3) * 16;
        }
#pragma unroll
        for (int q = 0; q < 4; ++q)
#pragma unroll
            for (int pz = 0; pz < 4; ++pz) { float* d = ts + q * 4160 + (kk + 16 * pz) * 65 + n4; d[0] = v[q][pz].x; d[1] = v[q][pz].y; d[2] = v[q][pz].z; d[3] = v[q][pz].w; }
        __syncthreads();
        {
            const int n = tid_ >> 2, kc = (tid_ & 3) * 16;
#pragma unroll
            for (int q = 0; q < 4; ++q) {
                unsigned o[8];
#pragma unroll
                for (int i = 0; i < 8; ++i) o[i] = pack2(ts[q * 4160 + (kc + 2 * i) * 65 + n], ts[q * 4160 + (kc + 2 * i + 1) * 65 + n]);
                uint4* d = (uint4*)dp[q];
                d[0] = make_uint4(o[0], o[1], o[2], o[3]); d[1] = make_uint4(o[4], o[5], o[6], o[7]);
            }
        }
        __syncthreads();
    }
    return true;
}

__device__ void phase_norm1(KP p, int wsid_, int layer, int mode, int bid, int nb) {
    PHASE_PROLOGUE
    float* X = (float*)(ws_ + WS_X); bfu* H = (bfu*)(ws_ + WS_H);
    const float* Y0 = (const float*)(ws_ + WS_Y01); const float* Y1 = Y0 + (size_t)MA * DM;
    const float* mod = (const float*)(ws_ + WS_MOD);
    const int lane = tid_ & 63, wv = tid_ >> 6;
    const int nrows = mode ? ML : MA;
    if (bid == 0 && mode == 0 && tid_ < 32) ((int*)(ws_ + WS_ECNT))[layer * 32 + tid_] = 0;
    for (int row = bid * 4 + wv; row < nrows; row += nb * 4) {
        int b, j, s; row_info(row, b, j, s);
        float4 v[4];
        float ss = 0.f;
#pragma unroll
        for (int c = 0; c < 4; ++c) {
            const int col = c * 256 + lane * 4;
            float4 xv = *(const float4*)(X + (size_t)row * DM + col);
            if (layer > 0) {
                const float4 a = *(const float4*)(Y0 + (size_t)row * DM + col), bq = *(const float4*)(Y1 + (size_t)row * DM + col);
                const float4 g = *(const float4*)(mod + ((size_t)(layer - 1) * 9 + s) * 6144 + 5 * 1024 + col);
                xv.x += g.x * (a.x + bq.x); xv.y += g.y * (a.y + bq.y); xv.z += g.z * (a.z + bq.z); xv.w += g.w * (a.w + bq.w);
                if (!mode) *(float4*)(X + (size_t)row * DM + col) = xv;
            }
            v[c] = xv; ss += xv.x * xv.x + xv.y * xv.y + xv.z * xv.z + xv.w * xv.w;
        }
        ss = wave_sum(ss);
        const float rs = rsqrtf(ss * (1.f / 1024.f) + 1e-6f);
#pragma unroll
        for (int c = 0; c < 4; ++c) {
            const int col = c * 256 + lane * 4;
            if (mode) {
                const float4 g = *(const float4*)(p.g_final + col);
                float4 o; o.x = v[c].x * rs * g.x; o.y = v[c].y * rs * g.y; o.z = v[c].z * rs * g.z; o.w = v[c].w * rs * g.w;
                *(float4*)(p.out + (size_t)row * DM + col) = o;
            } else {
                const float4 g = *(const float4*)(p.g_mix + layer * DM + col);
                const float4 sh = *(const float4*)(mod + ((size_t)layer * 9 + s) * 6144 + 0 * 1024 + col);
                const float4 sc = *(const float4*)(mod + ((size_t)layer * 9 + s) * 6144 + 1 * 1024 + col);
                const float o0 = v[c].x * rs * g.x * (1.f + sc.x) + sh.x, o1 = v[c].y * rs * g.y * (1.f + sc.y) + sh.y;
                const float o2 = v[c].z * rs * g.z * (1.f + sc.z) + sh.z, o3 = v[c].w * rs * g.w * (1.f + sc.w) + sh.w;
                *(uint2*)(H + (size_t)row * DM + col) = make_uint2(pack2(o0, o1), pack2(o2, o3));
            }
        }
    }
}

#define GLDS(gp, lp) __builtin_amdgcn_global_load_lds((const unsigned*)(gp), (__attribute__((address_space(3))) unsigned*)(lp), 16, 0, 0)
__device__ __forceinline__ int swzG(int x) { return (0x78 >> (2 * x)) & 3; }
template <class FA, class FB, class FE>
__device__ __forceinline__ void gemm_tile(FA arow, FB brow, int K, FE epi, char* smem, int wsid_) {
    int tid = TID512 & 255; asm volatile("" : "+v"(tid));
    const int lane = tid & 63, wid = tid >> 6, wr = wid >> 1, wc = wid & 1, fr = lane & 15, fq = lane >> 4;
    const int lrow = tid >> 2, lch = ((tid & 3) ^ swzG((tid >> 4) & 3)) * 8;
    const bfu* ga0 = arow(lrow) + lch; const bfu* ga1 = arow(lrow + 64) + lch;
    const bfu* gb0 = brow(lrow) + lch; const bfu* gb1 = brow(lrow + 64) + lch;
    f32x4 acc[4][4];
#pragma unroll
    for (int m = 0; m < 4; ++m)
#pragma unroll
        for (int n = 0; n < 4; ++n) acc[m][n] = (f32x4){0.f, 0.f, 0.f, 0.f};
    char* lds0 = smem + tid * 16;
#define GEMM_ISSUE(kt_) { char* d_ = lds0 + ((kt_) & 3) * 16384; const int ko_ = (kt_) * 32; \
        GLDS(ga0 + ko_, d_); GLDS(ga1 + ko_, d_ + 4096); GLDS(gb0 + ko_, d_ + 8192); GLDS(gb1 + ko_, d_ + 12288); }
    const int nk = K >> 5;
    __syncthreads();
    GEMM_ISSUE(0)
    if (nk > 1) GEMM_ISSUE(1)
    if (nk > 2) GEMM_ISSUE(2)
    const int offA = (wr * 64 + fr) * 64 + ((fq ^ swzG((fr >> 2) & 3)) * 16), offB = 8192 + (wc * 64 + fr) * 64 + ((fq ^ swzG((fr >> 2) & 3)) * 16);
    for (int kt = 0; kt < nk; ++kt) {
        if (kt + 2 < nk) asm volatile("s_waitcnt vmcnt(8)" ::: "memory");
        else if (kt + 1 < nk) asm volatile("s_waitcnt vmcnt(4)" ::: "memory");
        else asm volatile("s_waitcnt vmcnt(0)" ::: "memory");
        __builtin_amdgcn_s_barrier();
        if (kt + 3 < nk) GEMM_ISSUE(kt + 3)
        const char* st = smem + (kt & 3) * 16384;
        bf16x8 af[4], bfr[4];
#pragma unroll
        for (int m = 0; m < 4; ++m) af[m] = *(const bf16x8*)(st + offA + m * 1024);
#pragma unroll
        for (int n = 0; n < 4; ++n) bfr[n] = *(const bf16x8*)(st + offB + n * 1024);
        __builtin_amdgcn_s_setprio(1);
#pragma unroll
        for (int m = 0; m < 4; ++m)
#pragma unroll
            for (int n = 0; n < 4; ++n) acc[m][n] = __builtin_amdgcn_mfma_f32_16x16x32_bf16(af[m], bfr[n], acc[m][n], 0, 0, 0);
        __builtin_amdgcn_s_setprio(0);
    }
    __syncthreads();
    epi(acc, wr, wc, fr, fq);
}
#define ACC_FOREACH(...)                                                                      \
    _Pragma("unroll") for (int m_ = 0; m_ < 4; ++m_) _Pragma("unroll") for (int n_ = 0; n_ < 4; ++n_) \
    _Pragma("unroll") for (int j_ = 0; j_ < 4; ++j_) {                                        \
        const int row = wr * 64 + m_ * 16 + fq * 4 + j_; const int col = wc * 64 + n_ * 16 + fr; const float val = acc[m_][n_][j_]; __VA_ARGS__ }

__device__ __forceinline__ int lds_byte256(int r, int c) { const int st = (r >> 4) * 2 + (c >> 5), rr = r & 15, cc = c & 31, ob = rr * 64 + cc * 2; return st * 1024 + (ob ^ (((ob >> 9) & 1) << 5)); }
__device__ __forceinline__ void stage_rc256(int b, int& R, int& C) { const int st = b / 1024, sb = b % 1024, swz = sb ^ (((sb >> 9) & 1) << 5); R = (st >> 1) * 16 + swz / 64; C = (st & 1) * 32 + (swz % 64) / 2; }
#define G2_HT 8192
template <int lda, int ldb, int K, class FR, class FE>
__device__ __forceinline__ void gemm256(const bfu* Abase, FR arow, const bfu* B0, const bfu* B1, FE epi, char* shmc, int wsid_) {
    bfu* shm = (bfu*)shmc;
#define G2_SA(b, h) (shm + ((b) * 2 + (h)) * G2_HT)
#define G2_SB(b, h) (shm + (4 + (b) * 2 + (h)) * G2_HT)
    int tx = TID512; asm volatile("" : "+v"(tx));
    int sR, sC; stage_rc256(tx * 16, sR, sC);
    const int ra00 = arow(sR), ra01 = arow(sR + 64), ra10 = arow(128 + sR), ra11 = arow(128 + sR + 64);
#define G2_STAGE_A(P, h, kt) { int r0_ = (h) ? ra10 : ra00, r1_ = (h) ? ra11 : ra01; asm volatile("" : "+v"(r0_), "+v"(r1_)); const size_t ko_ = (size_t)(kt) * 64 + sC; \
        GLDS(Abase + (size_t)r0_ * lda + ko_, (char*)(P) + tx * 16); GLDS(Abase + (size_t)r1_ * lda + ko_, (char*)(P) + tx * 16 + 8192); }
#define G2_STAGE_B(P, h, kt) { int o_ = sR * ldb + sC; asm volatile("" : "+v"(o_)); const bfu* b_ = ((h) ? B1 : B0) + (size_t)(kt) * 64 + o_; GLDS(b_, (char*)(P) + tx * 16); GLDS(b_ + 64 * ldb, (char*)(P) + tx * 16 + 8192); }
    int wid = tx >> 6, lane = tx & 63, wr = wid >> 2, wc = wid & 3, fr = lane & 15, fq = lane >> 4;
#define G2_LDA(dst, b, h) _Pragma("unroll") for (int m = 0; m < 4; ++m) _Pragma("unroll") for (int k = 0; k < 2; ++k) \
        dst[m][k] = *(const bf16x8*)((const char*)G2_SA(b, h) + lds_byte256(wr * 64 + m * 16 + fr, k * 32 + fq * 8))
#define G2_LDB(dst, b, h) _Pragma("unroll") for (int n = 0; n < 2; ++n) _Pragma("unroll") for (int k = 0; k < 2; ++k) \
        dst[n][k] = *(const bf16x8*)((const char*)G2_SB(b, h) + lds_byte256(wc * 32 + n * 16 + fr, k * 32 + fq * 8))
#define G2_MMA(ai, bj, At_, Bt_) { __builtin_amdgcn_s_setprio(1); \
        _Pragma("unroll") for (int m = 0; m < 4; ++m) _Pragma("unroll") for (int n = 0; n < 2; ++n) _Pragma("unroll") for (int k = 0; k < 2; ++k) \
            acc[ai][bj][m][n] = __builtin_amdgcn_mfma_f32_16x16x32_bf16(At_[m][k], Bt_[n][k], acc[ai][bj][m][n], 0, 0, 0); \
        __builtin_amdgcn_s_setprio(0); }
#define G2_WV(n) asm volatile("s_waitcnt vmcnt(" #n ")" ::: "memory")
#define G2_WL(n) asm volatile("s_waitcnt lgkmcnt(" #n ")" ::: "memory")
#define G2_BAR __builtin_amdgcn_s_barrier()
#define G2_SCHED __builtin_amdgcn_sched_barrier(0)
    f32x4 acc[2][2][4][2];
#pragma unroll
    for (int a = 0; a < 2; ++a)
#pragma unroll
        for (int b = 0; b < 2; ++b)
#pragma unroll
            for (int m = 0; m < 4; ++m)
#pragma unroll
                for (int n = 0; n < 2; ++n) acc[a][b][m][n] = (f32x4){0.f, 0.f, 0.f, 0.f};
    bf16x8 At[4][2], Bx0[2][2], Bx1[2][2];
    constexpr int nt = K >> 6;
    __syncthreads();
    G2_STAGE_B(G2_SB(0, 0), 0, 0); G2_STAGE_A(G2_SA(0, 0), 0, 0); G2_STAGE_B(G2_SB(0, 1), 1, 0); G2_STAGE_A(G2_SA(0, 1), 1, 0);
    if (wr == 1) G2_BAR;
    G2_WV(4); G2_BAR;
    G2_STAGE_B(G2_SB(1, 0), 0, 1); G2_STAGE_A(G2_SA(1, 0), 0, 1); G2_STAGE_B(G2_SB(1, 1), 1, 1);
    G2_WV(6); G2_BAR;
    for (int t = 0; t < nt - 2; t += 2) {
        G2_LDB(Bx0, 0, 0); G2_SCHED; G2_LDA(At, 0, 0); G2_STAGE_A(G2_SA(1, 1), 1, t + 1);
        G2_WL(8); G2_BAR; G2_WL(0); G2_MMA(0, 0, At, Bx0); G2_BAR; G2_SCHED;
        G2_LDB(Bx1, 0, 1); G2_STAGE_B(G2_SB(0, 0), 0, t + 2);
        G2_BAR; G2_WL(0); G2_MMA(0, 1, At, Bx1); G2_BAR;
        G2_LDA(At, 0, 1); G2_STAGE_A(G2_SA(0, 0), 0, t + 2);
        G2_BAR; G2_WL(0); G2_MMA(1, 0, At, Bx0); G2_BAR; G2_SCHED;
        G2_STAGE_B(G2_SB(0, 1), 1, t + 2);
        G2_WV(6); G2_BAR; G2_MMA(1, 1, At, Bx1); G2_BAR;
        G2_LDB(Bx0, 1, 0); G2_SCHED; G2_LDA(At, 1, 0); G2_STAGE_A(G2_SA(0, 1), 1, t + 2);
        G2_WL(8); G2_BAR; G2_WL(0); G2_MMA(0, 0, At, Bx0); G2_BAR; G2_SCHED;
        G2_LDB(Bx1, 1, 1); G2_STAGE_B(G2_SB(1, 0), 0, t + 3);
        G2_BAR; G2_WL(0); G2_MMA(0, 1, At, Bx1); G2_BAR;
        G2_LDA(At, 1, 1); G2_STAGE_A(G2_SA(1, 0), 0, t + 3);
        G2_BAR; G2_WL(0); G2_MMA(1, 0, At, Bx0); G2_BAR; G2_SCHED;
        G2_STAGE_B(G2_SB(1, 1), 1, t + 3);
        G2_WV(6); G2_BAR; G2_MMA(1, 1, At, Bx1); G2_BAR;
    }
    tx = TID512; asm volatile("" : "+v"(tx)); stage_rc256(tx * 16, sR, sC); wid = tx >> 6; lane = tx & 63; wr = wid >> 2; wc = wid & 3; fr = lane & 15; fq = lane >> 4;
    { G2_LDB(Bx0, 0, 0); G2_WV(0); G2_LDA(At, 0, 0); G2_STAGE_A(G2_SA(1, 1), 1, nt - 1);
      G2_BAR; G2_WL(0); G2_MMA(0, 0, At, Bx0); G2_BAR;
      G2_LDB(Bx1, 0, 1); G2_BAR; G2_WL(0); G2_MMA(0, 1, At, Bx1); G2_BAR;
      G2_LDA(At, 0, 1); G2_WV(4); G2_BAR; G2_WL(0); G2_MMA(1, 0, At, Bx0); G2_MMA(1, 1, At, Bx1); G2_BAR; }
    { G2_LDB(Bx0, 1, 0); G2_LDA(At, 1, 0); G2_WV(2); G2_BAR; G2_WL(0); G2_MMA(0, 0, At, Bx0); G2_BAR;
      G2_LDB(Bx1, 1, 1); G2_WV(0); G2_BAR; G2_WL(0); G2_MMA(0, 1, At, Bx1); G2_BAR;
      G2_LDA(At, 1, 1); G2_BAR; G2_WL(0); G2_MMA(1, 0, At, Bx0); G2_MMA(1, 1, At, Bx1); G2_BAR; }
    if (wr == 0) G2_BAR;
    __syncthreads();
    epi(acc, wr, wc, fr, fq);
}

__device__ __forceinline__ void inproj_post(KP p, int wsid_, char* ws_, int layer, int row0, int nt, const float* Cs, int tid_) {
    const float* TA = (const float*)(ws_ + WS_ROPE); const float* TB = TA + 64 * 16 * 2;
    const int tid = tid_;
    int b, j0, s; row_info(row0, b, j0, s);
    const bool lat = row0 < ML;
    if (nt <= 2) {
        const int r = tid & 127, hl = tid >> 7;
        const bool isq = nt < 2;
        const float* gain = (isq ? p.a_q_gain : p.a_k_gain) + layer * 64;
        float ss = 0.f;
#pragma unroll
        for (int d4 = 0; d4 < 16; ++d4) { const float4 t4 = *(const float4*)(Cs + r * 132 + hl * 64 + d4 * 4); ss += t4.x * t4.x + t4.y * t4.y + t4.z * t4.z + t4.w * t4.w; }
        const float rs = rsqrtf(ss * (1.f / 64.f) + 1e-6f);
        const float qs = isq ? 0.125f * LOG2E : 1.f;
        bfu* dst = isq ? (bfu*)(ws_ + WS_QA) + (((size_t)b * 4 + (nt * 2 + hl)) * NKEY + j0 + r) * 64
                       : (bfu*)(ws_ + WS_KA) + (((size_t)b * 2 + hl) * NKEY + j0 + r) * 64;
        const int t = (j0 - 256) + r;
#pragma unroll 1
        for (int a = 0; a < 2; ++a) {
            float v[32];
#pragma unroll
            for (int d4 = 0; d4 < 8; ++d4) {
                const float4 t4 = *(const float4*)(Cs + r * 132 + hl * 64 + a * 32 + d4 * 4); const float4 g4 = *(const float4*)(gain + a * 32 + d4 * 4);
                v[d4 * 4] = t4.x * rs * g4.x; v[d4 * 4 + 1] = t4.y * rs * g4.y; v[d4 * 4 + 2] = t4.z * rs * g4.z; v[d4 * 4 + 3] = t4.w * rs * g4.w;
            }
            if (lat) {
                const int pos = a == 0 ? (t >> 6) : (t & 63);
#pragma unroll
                for (int f = 0; f < 16; ++f) {
                    const float cs = TA[(pos * 16 + f) * 2], sn = TA[(pos * 16 + f) * 2 + 1];
                    const float x0 = v[f], x1 = v[16 + f];
                    v[f] = x0 * cs - x1 * sn; v[16 + f] = x1 * cs + x0 * sn;
                }
            }
#pragma unroll
            for (int d8 = 0; d8 < 4; ++d8)
                ((uint4*)dst)[a * 4 + d8] = make_uint4(pack2(v[d8 * 8] * qs, v[d8 * 8 + 1] * qs), pack2(v[d8 * 8 + 2] * qs, v[d8 * 8 + 3] * qs),
                                                       pack2(v[d8 * 8 + 4] * qs, v[d8 * 8 + 5] * qs), pack2(v[d8 * 8 + 6] * qs, v[d8 * 8 + 7] * qs));
        }
    } else if (nt == 3 || nt == 8 || nt == 9) {
        const int c = tid & 127, half = tid >> 7, hl = c >> 6, d = c & 63;
        bfu* dst = nt == 3 ? (bfu*)(ws_ + WS_VAT) + (((size_t)b * 2 + hl) * 64 + d) * NKEY + j0 + half * 64
                           : (bfu*)(ws_ + WS_VBT) + (((size_t)b * 4 + ((nt - 8) * 2 + hl)) * 64 + d) * NKEY + j0 + half * 64;
#pragma unroll
        for (int r8 = 0; r8 < 8; ++r8) {
            const float* s0 = Cs + (half * 64 + r8 * 8) * 132 + c;
            ((uint4*)dst)[r8] = make_uint4(pack2(s0[0], s0[132]), pack2(s0[2 * 132], s0[3 * 132]), pack2(s0[4 * 132], s0[5 * 132]), pack2(s0[6 * 132], s0[7 * 132]));
        }
    } else if (nt <= 7) {
        const bool isq = nt < 6;
        const int hbase = ((nt - 4) & 1) * 2;
#pragma unroll
        for (int itq = 0; itq < 2; ++itq) {
            const int u = tid + 256 * itq, r = u & 127, hm = u >> 7;
            float v[32];
#pragma unroll
            for (int d4 = 0; d4 < 8; ++d4) { const float4 t4 = *(const float4*)(Cs + r * 132 + hm * 32 + d4 * 4); v[d4 * 4] = t4.x; v[d4 * 4 + 1] = t4.y; v[d4 * 4 + 2] = t4.z; v[d4 * 4 + 3] = t4.w; }
            if (lat) {
                const int t = (j0 - 256) + r;
#pragma unroll
                for (int a = 0; a < 2; ++a) {
                    const int pos = a == 0 ? (t >> 6) : (t & 63);
#pragma unroll
                    for (int f = 0; f < 8; ++f) {
                        const float cs = TB[(pos * 8 + f) * 2], sn = TB[(pos * 8 + f) * 2 + 1];
                        const float x0 = v[a * 16 + f], x1 = v[a * 16 + 8 + f];
                        v[a * 16 + f] = x0 * cs - x1 * sn; v[a * 16 + 8 + f] = x1 * cs + x0 * sn;
                    }
                }
            }
            const float qs = isq ? 0.17677669529663687f * LOG2E : 1.f;
            const int h = hbase + (hm >> 1), mp = hm & 1;
            bfu* dst = (bfu*)(ws_ + (isq ? WS_QB : WS_KB)) + (((size_t)b * 4 + h) * NKEY + j0 + r) * 64 + mp * 32;
#pragma unroll
            for (int d8 = 0; d8 < 4; ++d8)
                ((uint4*)dst)[d8] = make_uint4(pack2(v[d8 * 8] * qs, v[d8 * 8 + 1] * qs), pack2(v[d8 * 8 + 2] * qs, v[d8 * 8 + 3] * qs),
                                               pack2(v[d8 * 8 + 4] * qs, v[d8 * 8 + 5] * qs), pack2(v[d8 * 8 + 6] * qs, v[d8 * 8 + 7] * qs));
        }
    } else {
        const int r = tid & 127, half = tid >> 7;
        float* dst = (float*)(ws_ + WS_CP) + (size_t)(row0 + r) * CSL + (nt - 10) * 128 + half * 64;
#pragma unroll
        for (int d4 = 0; d4 < 16; ++d4) ((float4*)dst)[d4] = *(const float4*)(Cs + r * 132 + half * 64 + d4 * 4);
    }
}

__device__ void phase_inproj256(KP p, int wsid_, int layer, int vblk, int nblk, char* smem_all) {
    PHASE_PROLOGUE
    const bfu* H = (const bfu*)(ws_ + WS_H); const bfu* W = (const bfu*)(ws_ + WS_WIN);
    for (int it = vblk; it < 72 * 13; it += nblk) {
        const int mt = (it / 104) * 8 + (it & 7), nt2 = (it >> 3) % 13;
        const int row0 = mt * 256, col0 = nt2 * 256;
        const bfu* B0 = W + (size_t)col0 * DM; const bfu* B1 = (nt2 == 12) ? B0 : B0 + (size_t)128 * DM;
        gemm256<DM, DM, DM>(H, [&](int r) { return row0 + r; }, B0, B1,
            [&](f32x4 (&acc)[2][2][4][2], int wr, int wc, int fr, int fq) {
                if (nt2 >= 5) {
                    const __amdgpu_buffer_rsrc_t rs = __builtin_amdgcn_make_buffer_rsrc((void*)(ws_ + WS_CP), 0, (int)((size_t)MA * CSL * 4), 0x00020000);
                    const int voff = (((wr * 64 + fq * 4) * CSL) + wc * 32 + fr) * 4;
#pragma unroll
                    for (int bj = 0; bj < 2; ++bj) {
                        const int cb = col0 + bj * 128 - 1280;
                        if (cb < CSL) {
#pragma unroll
                            for (int ai = 0; ai < 2; ++ai)
#pragma unroll
                                for (int m = 0; m < 4; ++m)
#pragma unroll
                                    for (int n = 0; n < 2; ++n)
#pragma unroll
                                        for (int j = 0; j < 4; ++j)
                                            __builtin_amdgcn_raw_buffer_store_b32(__float_as_uint(acc[ai][bj][m][n][j]), rs, voff, ((row0 + ai * 128 + m * 16 + j) * CSL + cb + n * 16) * 4, 0);
                        }
                    }
                } else {
                    float* SC = (float*)(ws_ + WS_SCR) + (size_t)blockIdx.x * (2 * 128 * 132);
                    const __amdgpu_buffer_rsrc_t rs = __builtin_amdgcn_make_buffer_rsrc((void*)SC, 0, 2 * 128 * 132 * 4, 0x00020000);
                    const int o0 = (wr * 64 + fq * 4) * 132 + wc * 32 + fr;
#pragma unroll
                    for (int bj = 0; bj < 2; ++bj) {
                        float* Cq = (float*)(smem_all + bj * SMEM_BYTES) + o0;
#pragma unroll
                        for (int m = 0; m < 4; ++m)
#pragma unroll
                            for (int n = 0; n < 2; ++n)
#pragma unroll
                                for (int j = 0; j < 4; ++j) {
                                    Cq[(m * 16 + j) * 132 + n * 16] = acc[0][bj][m][n][j];
                                    __builtin_amdgcn_raw_buffer_store_b32(__float_as_uint(acc[1][bj][m][n][j]), rs, o0 * 4, (bj * 128 * 132 + (m * 16 + j) * 132 + n * 16) * 4, 0);
                                }
                    }
                    __syncthreads();
                    int t2 = TID512 & 255; asm volatile("" : "+v"(t2));
                    float* Ch = (float*)(smem_all + hb_ * SMEM_BYTES);
                    inproj_post(p, wsid_, ws_, layer, row0, nt2 * 2 + hb_, Ch, t2);
                    __syncthreads();
                    { const float4* g4 = (const float4*)(SC + hb_ * (128 * 132)); float4* c4 = (float4*)Ch;
                      for (int i = t2; i < 128 * 132 / 4; i += 256) c4[i] = g4[i]; }
                    __syncthreads();
                    inproj_post(p, wsid_, ws_, layer, row0 + 128, nt2 * 2 + hb_, Ch, t2);
                    __syncthreads();
                }
            }, smem_all, wsid_);
    }
}

__device__ void phase_inproj(KP p, int wsid_, int layer, int bid, int nb, char* smem) {
    PHASE_PROLOGUE
    const bfu* H = (const bfu*)(ws_ + WS_H); const bfu* W = (const bfu*)(ws_ + WS_WIN);
    float* Cs = (float*)smem;
    const int nitems = 144 * 25;
    for (int it = bid; it < nitems; it += nb) {
        const int mt = (it / 200) * 8 + (it / 5) % 8, nt = ((it / 40) % 5) * 5 + it % 5;
        const int row0 = mt * 128, col0 = nt * 128;
        gemm_tile([&](int r) { return H + (size_t)(row0 + r) * DM; }, [&](int r) { return W + (size_t)(col0 + r) * DM; }, DM,
            [&](f32x4 (&acc)[4][4], int wr, int wc, int fr, int fq) {
                ACC_FOREACH(Cs[row * 132 + col] = val;)
            }, smem, wsid_);
        __syncthreads();
        inproj_post(p, wsid_, ws_, layer, row0, nt, Cs, tid_);
        __syncthreads();
    }
}

__device__ void phase_gate(KP p, int wsid_, int layer, int bid, int nb, char* smem) {
    PHASE_PROLOGUE
    const bfu* LXG = (const bfu*)(ws_ + WS_LXG); const bfu* Bt = (const bfu*)(ws_ + WS_LG2);
    float* GG = (float*)(ws_ + WS_GG);
    const int nitems = 144 * 4;
    for (int it = bid; it < nitems; it += nb) {
        const int mt = it >> 2, nt = it & 3, row0 = mt * 128, col0 = nt * 128;
        gemm_tile([&](int r) { return LXG + (size_t)(row0 + r) * 128; }, [&](int r) { return Bt + (size_t)(col0 + r) * 128; }, 128,
            [&](f32x4 (&acc)[4][4], int wr, int wc, int fr, int fq) {
                ACC_FOREACH(GG[(size_t)(row0 + row) * 512 + col0 + col] = val;)
            }, smem, wsid_);
    }
}

#define OPS_AT 0
#define OPS_RT 2048
#define OPS_MAK 4096
#define OPS_T 5120
#define OPS_MRBK 6144
#define OPS_BK 7168
#define OPS_VF 11264
#define OPS_WC 13312
__device__ __forceinline__ char* ops_rec(char* ws_, int z, int seq, int c) { return ws_ + WS_OPS + ((size_t)(z * 64 + seq) * 144 + c) * OPS_REC; }
__device__ __forceinline__ float rdlane(float v, int l) { return __int_as_float(__builtin_amdgcn_readlane(__float_as_int(v), l)); }

__device__ __forceinline__ void chunk_tail(const float (&lw)[16], const float (&kk)[16], const float (&rr)[16], const float (&bb)[16], const float (&kd)[16], const float (&vv)[16],
                                           char* Lw, char* rec, int lane) {
    const int cl = lane & 15, g = lane >> 4;
    float Bt[16], Kt[16];
    float cum = 0.f, ep = 1.f;
#pragma unroll
    for (int t = 0; t < 16; ++t) {
        cum += lw[t];
        const float e = __expf(cum), ei = __expf(-cum);
        *(bfu*)(Lw + 0 + t * 128 + lane * 2) = f2bf(-kk[t] * ep);
        *(bfu*)(Lw + 2048 + t * 128 + lane * 2) = f2bf(rr[t] * e);
        Bt[t] = bb[t] * ei; Kt[t] = kd[t] * ei;
        *(bfu*)(Lw + 4096 + t * 128 + lane * 2) = f2bf(Bt[t]);
        *(bfu*)(Lw + 6144 + t * 128 + lane * 2) = f2bf(Kt[t]);
        ep = e;
    }
    const float eC = ep;
#pragma unroll
    for (int q = 0; q < 4; ++q) {
        *(uint4*)(rec + OPS_BK + ((lane >> 4) * 64 + cl + 16 * q) * 16) =
            make_uint4(pack2(Bt[4 * q] * eC, Bt[4 * q + 1] * eC), pack2(Bt[4 * q + 2] * eC, Bt[4 * q + 3] * eC), pack2(Kt[4 * q] * eC, Kt[4 * q + 1] * eC), pack2(Kt[4 * q + 2] * eC, Kt[4 * q + 3] * eC));
        *(uint2*)(rec + OPS_VF + ((lane >> 4) * 64 + cl + 16 * q) * 8) = make_uint2(pack2(vv[4 * q], vv[4 * q + 1]), pack2(vv[4 * q + 2], vv[4 * q + 3]));
    }
    *(float*)(rec + OPS_WC + lane * 4) = eC;
    f32x4 Mab = {0.f, 0.f, 0.f, 0.f}, Mak = Mab, Mrb = Mab, Mrk = Mab;
#pragma unroll
    for (int ks = 0; ks < 2; ++ks) {
        const int fo = cl * 128 + ks * 64 + g * 16;
        const bf16x8 aA = *(const bf16x8*)(Lw + 0 + fo), aR = *(const bf16x8*)(Lw + 2048 + fo), bB = *(const bf16x8*)(Lw + 4096 + fo), bK = *(const bf16x8*)(Lw + 6144 + fo);
        Mab = __builtin_amdgcn_mfma_f32_16x16x32_bf16(aA, bB, Mab, 0, 0, 0);
        Mak = __builtin_amdgcn_mfma_f32_16x16x32_bf16(aA, bK, Mak, 0, 0, 0);
        Mrb = __builtin_amdgcn_mfma_f32_16x16x32_bf16(aR, bB, Mrb, 0, 0, 0);
        Mrk = __builtin_amdgcn_mfma_f32_16x16x32_bf16(aR, bK, Mrk, 0, 0, 0);
    }
#pragma unroll
    for (int ks = 0; ks < 2; ++ks) {
        const uint2 a0 = *(const uint2*)(Lw + 0 + cl * 128 + (32 * ks + 4 * g) * 2), a1 = *(const uint2*)(Lw + 0 + cl * 128 + (32 * ks + 16 + 4 * g) * 2);
        const uint2 r0 = *(const uint2*)(Lw + 2048 + cl * 128 + (32 * ks + 4 * g) * 2), r1 = *(const uint2*)(Lw + 2048 + cl * 128 + (32 * ks + 16 + 4 * g) * 2);
        *(uint4*)(rec + OPS_AT + (ks * 64 + lane) * 16) = make_uint4(a0.x, a0.y, a1.x, a1.y);
        *(uint4*)(rec + OPS_RT + (ks * 64 + lane) * 16) = make_uint4(r0.x, r0.y, r1.x, r1.y);
    }
#pragma unroll
    for (int q = 0; q < 4; ++q) {
        const int tau = 4 * g + q;
        if (!(cl < tau)) { Mab[q] = 0.f; Mak[q] = 0.f; }
        if (!(cl <= tau)) { Mrb[q] = 0.f; Mrk[q] = 0.f; }
    }
    float Tc[16];
#pragma unroll
    for (int t = 0; t < 16; ++t) {
        float acc = (t == cl) ? 1.f : 0.f;
#pragma unroll
        for (int j = 0; j < t; ++j) acc += rdlane(Mab[t & 3], j + 16 * (t >> 2)) * Tc[j];
        Tc[t] = acc;
    }
#pragma unroll
    for (int q = 0; q < 4; ++q) {
        const int tau = 4 * g + q;
        *(bfu*)(Lw + 8192 + tau * 32 + cl * 2) = f2bf(Mak[q]);
        *(bfu*)(Lw + 9216 + tau * 32 + cl * 2) = f2bf(Mrb[q]);
        *(bfu*)(Lw + 9728 + tau * 32 + cl * 2) = f2bf(Mrk[q]);
    }
    if (g == 0) {
#pragma unroll
        for (int t = 0; t < 16; ++t) *(bfu*)(Lw + 8704 + t * 32 + cl * 2) = f2bf(Tc[t]);
    }
    const uint2 fmak = *(const uint2*)(Lw + 8192 + cl * 32 + g * 8), ft = *(const uint2*)(Lw + 8704 + cl * 32 + g * 8);
    const uint2 fmrb = *(const uint2*)(Lw + 9216 + cl * 32 + g * 8), fmrk = *(const uint2*)(Lw + 9728 + cl * 32 + g * 8);
    *(uint4*)(rec + OPS_MAK + lane * 16) = make_uint4(fmak.x, fmak.y, 0u, 0u);
    *(uint4*)(rec + OPS_T + lane * 16) = make_uint4(ft.x, ft.y, 0u, 0u);
    *(uint4*)(rec + OPS_MRBK + lane * 16) = make_uint4(fmrb.x, fmrb.y, fmrk.x, fmrk.y);
}

__device__ __forceinline__ float sum64(float v) { v = sum8(v); v += dppf<0x140>(v); return (rdlane(v, 0) + rdlane(v, 16)) + (rdlane(v, 32) + rdlane(v, 48)); }
__device__ void phase_rk(KP p, int wsid_, int layer, int bid, int nb, char* smem) {
    PHASE_PROLOGUE
    const int lane = tid_ & 63, wv = tid_ >> 6, cl = lane & 15, g = lane >> 4;
    char* Lw = smem + wv * 16384;
    const float* CP = (const float*)(ws_ + WS_CP);
    const float* mu = p.c_mu + layer * CSL;
    for (int it = bid * 4 + wv; it < 2 * 64 * 144; it += nb * 4) {
        const int c = it % 144, seq = (it / 144) & 63, z = it / (144 * 64), b = seq >> 3, h = seq & 7;
        const int grow0 = c < 16 ? ML + b * 256 + 16 * c : b * 2048 + 16 * (c - 16);
        const bool sstart = (c == 0 || c == 16), send = (c == 15 || c == 143);
        auto ldgrp = [&](int col, float (&P_)[18]) {
#pragma unroll
            for (int q = 0; q < 18; ++q) {
                const int tau = q - 1, nat = z ? 15 - tau : tau;
                const bool ok = (nat >= 0 || !sstart) && (nat <= 15 || !send);
                P_[q] = ok ? CP[(size_t)(grow0 + nat) * CSL + col] : 0.f;
            }
        };
        auto shiftg = [&](int col, const float (&P_)[18], float (&out)[16]) {
            const float m = mu[col];
#pragma unroll
            for (int t = 0; t < 16; ++t) out[t] = P_[t + 1] + m * (0.5f * (P_[t] + P_[t + 2]) - P_[t + 1]);
        };
        float Pw[18], Pa[18], Pr[18], Pk[18], Pv[18];
        ldgrp(1536 + z * 64 + lane, Pw); ldgrp(1664 + z * 64 + lane, Pa); ldgrp(h * 64 + lane, Pr); ldgrp(512 + h * 64 + lane, Pk); ldgrp(1024 + h * 64 + lane, Pv);
        float tmp[16], rr[16], kr[16], vv[16];
        shiftg(1536 + z * 64 + lane, Pw, tmp);
#pragma unroll
        for (int t = 0; t < 16; ++t) *(bfu*)(Lw + 10240 + t * 128 + lane * 2) = f2bf(1.f - 2.f / (1.f + __expf(2.f * tmp[t])));
        shiftg(1664 + z * 64 + lane, Pa, tmp);
#pragma unroll
        for (int t = 0; t < 16; ++t) *(bfu*)(Lw + 12288 + t * 128 + lane * 2) = f2bf(tmp[t]);
        if (z == 0 && lane < 16) {
            float Pg[18]; ldgrp(1792 + h * 16 + lane, Pg); shiftg(1792 + h * 16 + lane, Pg, tmp);
            bfu* LXG = (bfu*)(ws_ + WS_LXG);
#pragma unroll
            for (int t = 0; t < 16; ++t) LXG[(size_t)(grow0 + t) * 128 + h * 16 + lane] = f2bf(sigmoidf_(tmp[t]));
        }
        shiftg(h * 64 + lane, Pr, rr);
        shiftg(512 + h * 64 + lane, Pk, kr);
        shiftg(1024 + h * 64 + lane, Pv, vv);
        const bfu* W2 = (const bfu*)(ws_ + WS_LW2) + ((size_t)z * 512 + h * 64) * 64;
        const bfu* A2 = (const bfu*)(ws_ + WS_LA2) + ((size_t)z * 512 + h * 64) * 64;
        float prew[16], prea[16];
#pragma unroll
        for (int which = 0; which < 2; ++which) {
            const bfu* Wm = which ? A2 : W2; const char* Xs = Lw + (which ? 12288 : 10240);
            f32x4 ac[4];
#pragma unroll
            for (int n = 0; n < 4; ++n) ac[n] = (f32x4){0.f, 0.f, 0.f, 0.f};
#pragma unroll
            for (int ks = 0; ks < 2; ++ks) {
                const bf16x8 af = *(const bf16x8*)(Xs + cl * 128 + ks * 64 + g * 16);
#pragma unroll
                for (int n = 0; n < 4; ++n) {
                    const bf16x8 bf = *(const bf16x8*)(Wm + (size_t)(16 * n + cl) * 64 + ks * 32 + g * 8);
                    ac[n] = __builtin_amdgcn_mfma_f32_16x16x32_bf16(af, bf, ac[n], 0, 0, 0);
                }
            }
#pragma unroll
            for (int n = 0; n < 4; ++n)
#pragma unroll
                for (int q = 0; q < 4; ++q) *(float*)(Lw + (4 * g + q) * 256 + (16 * n + cl) * 4) = ac[n][q];
#pragma unroll
            for (int t = 0; t < 16; ++t) { const float x = *(const float*)(Lw + t * 256 + lane * 4); if (which) prea[t] = x; else prew[t] = x; }
        }
        const int ch = h * 64 + lane;
        const float w0v = p.c_w0[((size_t)layer * 2 + z) * 512 + ch], a0v = p.c_a0[((size_t)layer * 2 + z) * 512 + ch];
        const float kkv = p.c_k_k[layer * 512 + ch], kav = p.c_k_a[layer * 512 + ch], rkv = p.c_r_k[layer * 512 + ch];
        float lw[16], kk[16], bb[16];
        float* BETA = (float*)(ws_ + WS_BETA) + (size_t)z * MA * 8;
#pragma unroll
        for (int t = 0; t < 16; ++t) {
            const float nx = -(w0v + prew[t]);
            const float sp = nx > 20.f ? nx : __logf(1.f + __expf(nx));
            lw[t] = -__expf(-sp - 0.5f);
            const float icl = sigmoidf_(a0v + prea[t]);
            const float kv = kr[t] * kkv;
            const float ss = sum64(kv * kv);
            kk[t] = kv * rsqrtf(fmaxf(ss, 1e-24f));
            kr[t] = kr[t] * (1.f + (icl - 1.f) * kav);
            bb[t] = kk[t] * icl;
            const float bs = sum64(rr[t] * kr[t] * rkv);
            const int nat = z ? 15 - t : t;
            if (lane == 0) BETA[(size_t)(grow0 + nat) * 8 + h] = bs;
        }
        if (z == 0) {
            bfu* VB = (bfu*)(ws_ + WS_VB);
#pragma unroll
            for (int t = 0; t < 16; ++t) VB[(size_t)(grow0 + t) * 512 + ch] = f2bf(vv[t]);
        }
        chunk_tail(lw, kk, rr, bb, kr, vv, Lw, ops_rec(ws_, z, seq, c), lane);
    }
}

__device__ __forceinline__ bf16x8 mk8(unsigned a, unsigned b, unsigned c, unsigned d) { union { bf16x8 v; unsigned u[4]; } x; x.u[0] = a; x.u[1] = b; x.u[2] = c; x.u[3] = d; return x.v; }
__device__ __forceinline__ bf16x8 ld8(const char* p) { return *(const bf16x8*)p; }
__device__ __forceinline__ void glds16_asm(const void* gsrc, unsigned lds_dst) {
    unsigned keep;
    asm volatile("s_mov_b32 %0, m0\n\ts_mov_b32 m0, %2\n\ts_nop 0\n\tglobal_load_lds_dwordx4 %1, off\n\ts_mov_b32 m0, %0" : "=&s"(keep) : "v"(gsrc), "s"(lds_dst) : "memory");
}
__device__ void phase_r4(KP p, int wsid_, int layer, int bid, int nb, char* smem) {
    PHASE_PROLOGUE
    const int lane = tid_ & 63, vt = tid_ >> 6, cl = lane & 15, g = lane >> 4;
    for (int it = bid; it < 128; it += nb) {
        const int z = it >> 6, seq = it & 63;
        float* Y = (float*)(ws_ + WS_YS) + (size_t)z * (HEADARR / 4) + (size_t)seq * NKEY * 64;
        const char* recs = ws_ + WS_OPS + (size_t)(z * 64 + seq) * 144 * OPS_REC;
        f32x4 acc[4];
#pragma unroll
        for (int kt = 0; kt < 4; ++kt) acc[kt] = (f32x4){0.f, 0.f, 0.f, 0.f};
        const unsigned lbase = __builtin_amdgcn_readfirstlane((unsigned)(uintptr_t)(__attribute__((address_space(3))) char*)smem + vt * 1024);
#define R4_ISSUE(ci_) { const int c_ = z ? ((ci_) < 16 ? 15 - (ci_) : 143 - ((ci_) - 16)) : (ci_); const char* g_ = recs + (size_t)c_ * OPS_REC + tid_ * 16; const unsigned d_ = lbase + ((ci_) & 3) * OPS_REC; \
            glds16_asm(g_, d_); glds16_asm(g_ + 4096, d_ + 4096); glds16_asm(g_ + 8192, d_ + 8192); if (tid_ < 80) glds16_asm(g_ + 12288, d_ + 12288); }
        __syncthreads();
        R4_ISSUE(0) R4_ISSUE(1) R4_ISSUE(2)
        for (int ci = 0; ci < 144; ++ci) {
            const int c = z ? (ci < 16 ? 15 - ci : 143 - (ci - 16)) : ci;
            if (ci >= 3 && ci <= 141) { if (vt < 2) asm volatile("s_waitcnt vmcnt(20)" ::: "memory"); else asm volatile("s_waitcnt vmcnt(18)" ::: "memory"); }
            else asm volatile("s_waitcnt vmcnt(0)" ::: "memory");
            __builtin_amdgcn_s_barrier();
            if (ci + 3 < 144) R4_ISSUE(ci + 3)
            const char* rec = smem + (ci & 3) * OPS_REC;
            const f32x4 zero4 = {0.f, 0.f, 0.f, 0.f};
            bf16x8 sb[2];
#pragma unroll
            for (int ks = 0; ks < 2; ++ks)
                sb[ks] = mk8(pack2(acc[2 * ks][0], acc[2 * ks][1]), pack2(acc[2 * ks][2], acc[2 * ks][3]), pack2(acc[2 * ks + 1][0], acc[2 * ks + 1][1]), pack2(acc[2 * ks + 1][2], acc[2 * ks + 1][3]));
            const uint2 vf = *(const uint2*)(rec + OPS_VF + (vt * 64 + lane) * 8);
            f32x4 Z = __builtin_amdgcn_mfma_f32_16x16x32_bf16(ld8(rec + OPS_AT + lane * 16), sb[0], zero4, 0, 0, 0);
            Z = __builtin_amdgcn_mfma_f32_16x16x32_bf16(ld8(rec + OPS_AT + (64 + lane) * 16), sb[1], Z, 0, 0, 0);
            Z = __builtin_amdgcn_mfma_f32_16x16x32_bf16(ld8(rec + OPS_MAK + lane * 16), mk8(vf.x, vf.y, 0u, 0u), Z, 0, 0, 0);
            f32x4 Yv = __builtin_amdgcn_mfma_f32_16x16x32_bf16(ld8(rec + OPS_RT + lane * 16), sb[0], zero4, 0, 0, 0);
            Yv = __builtin_amdgcn_mfma_f32_16x16x32_bf16(ld8(rec + OPS_RT + (64 + lane) * 16), sb[1], Yv, 0, 0, 0);
            const f32x4 U = __builtin_amdgcn_mfma_f32_16x16x32_bf16(ld8(rec + OPS_T + lane * 16), mk8(pack2(Z[0], Z[1]), pack2(Z[2], Z[3]), 0u, 0u), zero4, 0, 0, 0);
            const bf16x8 ub = mk8(pack2(U[0], U[1]), pack2(U[2], U[3]), vf.x, vf.y);
            Yv = __builtin_amdgcn_mfma_f32_16x16x32_bf16(ld8(rec + OPS_MRBK + lane * 16), ub, Yv, 0, 0, 0);
#pragma unroll
            for (int kt = 0; kt < 4; ++kt) {
                const float4 wc = *(const float4*)(rec + OPS_WC + (16 * kt + 4 * g) * 4);
                f32x4 a = acc[kt];
                a[0] *= wc.x; a[1] *= wc.y; a[2] *= wc.z; a[3] *= wc.w;
                acc[kt] = __builtin_amdgcn_mfma_f32_16x16x32_bf16(ld8(rec + OPS_BK + (kt * 64 + lane) * 16), ub, a, 0, 0, 0);
            }
#pragma unroll
            for (int q = 0; q < 4; ++q) {
                const int tau = 4 * g + q, t = z ? 15 - tau : tau;
                Y[(size_t)(16 * c + t) * 64 + vt * 16 + cl] = Yv[q];
            }
        }
    }
}

__device__ void phase_readout(KP p, int wsid_, int layer, int nrows, int bid, int nb) {
    PHASE_PROLOGUE
    const float* Y0 = (const float*)(ws_ + WS_YS); const float* Y1 = Y0 + HEADARR / 4;
    const bfu* VB = (const bfu*)(ws_ + WS_VB); const float* B0 = (const float*)(ws_ + WS_BETA); const float* B1 = B0 + (size_t)MA * 8;
    const float* GG = (const float*)(ws_ + WS_GG);
    bfu* MIX = (bfu*)(ws_ + WS_MIX);
    const float* lnw = p.c_ln_w + layer * 512; const float* lnb = p.c_ln_b + layer * 512;
    const int lane = tid_ & 63, wv = tid_ >> 6;
    for (int row = bid * 4 + wv; row < nrows; row += nb * 4) {
        int b, j, s; row_info(row, b, j, s);
#pragma unroll
        for (int h = 0; h < 8; ++h) {
            const size_t o = (((size_t)b * 8 + h) * NKEY + j) * 64 + lane;
            const float y = Y0[o] + Y1[o];
            const float mean = sum64(y) * (1.f / 64.f);
            const float dv = y - mean;
            const float var = sum64(dv * dv) * (1.f / 64.f);
            const float yn = dv * rsqrtf(var + 64e-5f) * lnw[h * 64 + lane] + lnb[h * 64 + lane];
            const float bs = B0[(size_t)row * 8 + h] + B1[(size_t)row * 8 + h];
            const float outv = (yn + bs * bf2f(VB[(size_t)row * 512 + h * 64 + lane])) * GG[(size_t)row * 512 + h * 64 + lane];
            MIX[(size_t)row * DM + 512 + h * 64 + lane] = f2bf(outv);
        }
    }
}

using f32x16 = __attribute__((ext_vector_type(16))) float;
#define AT_KBYTES 8192
#define AT_VSTRIDE 136
#define AT_VBYTES (64 * AT_VSTRIDE)
template <int GRP>
__device__ __forceinline__ void attn_item(KP p, int wsid_, char* ws_, int layer, int b, int h, int qb, int nkeys, float lam, float lam_init, char* smem, int tid) {
    constexpr int KS = GRP ? 2 : 4;
    const int lane = tid & 63, wv = tid >> 6, r32 = lane & 31, hh = lane >> 5;
    const int mp = GRP ? (wv >> 1) : 0, sub = GRP ? (wv & 1) : wv;
    const int jq = qb * (GRP ? 64 : 128) + sub * 32 + r32;
    const bfu* Qg = (const bfu*)(ws_ + (GRP ? WS_QB : WS_QA)) + (((size_t)b * 4 + h) * NKEY + jq) * 64 + mp * 32;
    const bfu* Kg = GRP ? (const bfu*)(ws_ + WS_KB) + ((size_t)b * 4 + h) * NKEY * 64 : (const bfu*)(ws_ + WS_KA) + ((size_t)b * 2 + (h >> 1)) * NKEY * 64;
    const bfu* Vg = GRP ? (const bfu*)(ws_ + WS_VBT) + ((size_t)b * 4 + h) * 64 * NKEY : (const bfu*)(ws_ + WS_VAT) + ((size_t)b * 2 + (h >> 1)) * 64 * NKEY;
    bf16x8 qf[KS];
#pragma unroll
    for (int ks = 0; ks < KS; ++ks) qf[ks] = *(const bf16x8*)(Qg + ks * 16 + hh * 8);
    f32x16 oacc[2];
    float lrun = 0.f;
#pragma unroll
    for (int db = 0; db < 2; ++db)
#pragma unroll
        for (int i = 0; i < 16; ++i) oacc[db][i] = 0.f;
    const int lrow = tid >> 3, lch = ((tid & 7) ^ ((tid >> 4) & 7)) * 8;
    const bfu* kp0 = Kg + (size_t)lrow * 64 + lch; const bfu* kp1 = kp0 + 32 * 64;
    const bfu* vp0 = Vg + (size_t)lrow * NKEY + lch; const bfu* vp1 = vp0 + (size_t)32 * NKEY;
    char* ldst = smem + tid * 16;
#define AT_ISSUE(t_) { char* d_ = ldst + ((t_) & 1) * 16384; const size_t ko_ = (size_t)(t_) * 64 * 64; const int vo_ = (t_) * 64; \
        GLDS(kp0 + ko_, d_); GLDS(kp1 + ko_, d_ + 4096); GLDS(vp0 + vo_, d_ + 8192); GLDS(vp1 + vo_, d_ + 12288); }
    __syncthreads();
    AT_ISSUE(0)
    const int nt = nkeys >> 6;
    float mref = 0.f;
    const int swv = (r32 >> 1) & 7;
    for (int t = 0; t < nt; ++t) {
        asm volatile("s_waitcnt vmcnt(0)" ::: "memory");
        __syncthreads();
        if (t + 1 < nt) AT_ISSUE(t + 1)
        const char* cK = smem + (t & 1) * 16384; const char* cV = cK + 8192;
        f32x16 sacc[2];
        const float ninit = -mref;
#pragma unroll
        for (int kb = 0; kb < 2; ++kb) {
#pragma unroll
            for (int i = 0; i < 16; ++i) sacc[kb][i] = ninit;
            const int key = kb * 32 + r32;
#pragma unroll
            for (int ks = 0; ks < KS; ++ks) {
                const int c0 = mp * 4 + ks * 2 + hh;
                const bf16x8 kf = *(const bf16x8*)(cK + key * 128 + ((c0 ^ ((key >> 1) & 7)) * 16));
                sacc[kb] = __builtin_amdgcn_mfma_f32_32x32x16_bf16(kf, qf[ks], sacc[kb], 0, 0, 0);
            }
        }
        float mx = sacc[0][0];
#pragma unroll
        for (int i = 1; i < 16; ++i) mx = fmaxf(mx, sacc[0][i]);
#pragma unroll
        for (int i = 0; i < 16; ++i) mx = fmaxf(mx, sacc[1][i]);
        mx = fmaxf(mx, shfl_xor_(mx, 32));
        const bool need = (t == 0) || (mx > 8.f);
        if (__any(need)) {
            const float delta = need ? mx : 0.f;
            const float alpha = __builtin_amdgcn_exp2f(-delta);
            mref += delta; lrun *= alpha;
#pragma unroll
            for (int db = 0; db < 2; ++db)
#pragma unroll
                for (int i = 0; i < 16; ++i) oacc[db][i] *= alpha;
#pragma unroll
            for (int kb = 0; kb < 2; ++kb)
#pragma unroll
                for (int i = 0; i < 16; ++i) sacc[kb][i] -= delta;
        }
        float ps = 0.f;
#pragma unroll
        for (int kb = 0; kb < 2; ++kb)
#pragma unroll
            for (int i = 0; i < 16; ++i) { const float pv = __builtin_amdgcn_exp2f(sacc[kb][i]); sacc[kb][i] = pv; ps += pv; }
        lrun += ps;
#pragma unroll
        for (int kb = 0; kb < 2; ++kb)
#pragma unroll
            for (int s2 = 0; s2 < 2; ++s2) {
                union { bf16x8 v; unsigned u[4]; } pf;
#pragma unroll
                for (int i = 0; i < 4; ++i) pf.u[i] = pack2(sacc[kb][8 * s2 + 2 * i], sacc[kb][8 * s2 + 2 * i + 1]);
#pragma unroll
                for (int db = 0; db < 2; ++db) {
                    const char* vr = cV + (db * 32 + r32) * 128 + hh * 8;
                    union { bf16x8 v; uint2 u[2]; } vf;
                    vf.u[0] = *(const uint2*)(vr + (((kb * 4 + s2 * 2) ^ swv) * 16)); vf.u[1] = *(const uint2*)(vr + (((kb * 4 + s2 * 2 + 1) ^ swv) * 16));
                    oacc[db] = __builtin_amdgcn_mfma_f32_32x32x16_bf16(vf.v, pf.v, oacc[db], 0, 0, 0);
                }
            }
    }
    __syncthreads();
    bfu* MIX = (bfu*)(ws_ + WS_MIX);
    const int grow = grow_of(b, jq);
    const float il = 1.f / (lrun + shfl_xor_(lrun, 32));
    if (GRP == 0) {
        bfu* dst = MIX + (size_t)grow * DM + h * 64;
#pragma unroll
        for (int db = 0; db < 2; ++db)
#pragma unroll
            for (int g = 0; g < 4; ++g)
                *(uint2*)(dst + db * 32 + g * 8 + hh * 4) = make_uint2(pack2(oacc[db][4 * g] * il, oacc[db][4 * g + 1] * il), pack2(oacc[db][4 * g + 2] * il, oacc[db][4 * g + 3] * il));
    } else {
        float* xs = (float*)smem + sub * 2048;
        if (mp == 1) {
            const float sc2 = lam * il;
#pragma unroll
            for (int db = 0; db < 2; ++db)
#pragma unroll
                for (int i = 0; i < 16; ++i) xs[(db * 16 + i) * 64 + lane] = oacc[db][i] * sc2;
        }
        __syncthreads();
        if (mp == 0) {
            float ss = 0.f;
#pragma unroll
            for (int db = 0; db < 2; ++db)
#pragma unroll
                for (int i = 0; i < 16; ++i) { const float o = oacc[db][i] * il - xs[(db * 16 + i) * 64 + lane]; oacc[db][i] = o; ss += o * o; }
            ss += shfl_xor_(ss, 32);
            const float rs = rsqrtf(ss * (1.f / 64.f) + 1e-6f) * (1.f - lam_init);
            const float* gn = p.b_subln + layer * 64;
            bfu* dst = MIX + (size_t)grow * DM + 256 + h * 64;
#pragma unroll
            for (int db = 0; db < 2; ++db)
#pragma unroll
                for (int g = 0; g < 4; ++g) {
                    const int d = db * 32 + g * 8 + hh * 4;
                    *(uint2*)(dst + d) = make_uint2(pack2(oacc[db][4 * g] * rs * gn[d], oacc[db][4 * g + 1] * rs * gn[d + 1]), pack2(oacc[db][4 * g + 2] * rs * gn[d + 2], oacc[db][4 * g + 3] * rs * gn[d + 3]));
                }
        }
    }
}
__device__ void phase_attn(KP p, int wsid_, int layer, bool do_ctx, unsigned* qctr, unsigned* cctr, int* s_item, char* smem) {
    PHASE_PROLOGUE
    const int tid = tid_;
    const float lam_init = 0.8f - 0.6f * expf(-0.3f * (float)layer);
    float d1 = 0.f, d2 = 0.f;
    for (int i = 0; i < 32; ++i) { d1 += p.b_lq1[layer * 32 + i] * p.b_lk1[layer * 32 + i]; d2 += p.b_lq2[layer * 32 + i] * p.b_lk2[layer * 32 + i]; }
    const float lam = expf(d1) - expf(d2) + lam_init;
    const int nitems = do_ctx ? 1728 : 1536;
    bool conv_left = cctr != nullptr;
    for (;;) {
        __syncthreads();
        if (TID512 == 0) *s_item = (int)atomicAdd(qctr, 1u);
        __syncthreads();
        const int pair_ = __builtin_amdgcn_readfirstlane(*s_item);
        if (2 * pair_ >= nitems) break;
        const int it = 2 * pair_ + hb_;
        int grp, b, h, qb, nkeys;
        if (it < 1024) { grp = 1; qb = 4 + (it & 31); h = (it >> 5) & 3; b = it >> 7; nkeys = NKEY; }
        else if (it < 1536) { grp = 0; const int r = it - 1024; qb = 2 + (r & 15); h = (r >> 4) & 3; b = r >> 6; nkeys = NKEY; }
        else if (it < 1664) { grp = 1; const int r = it - 1536; qb = r & 3; h = (r >> 2) & 3; b = r >> 4; nkeys = 256; }
        else { grp = 0; const int r = it - 1664; qb = r & 1; h = (r >> 1) & 3; b = r >> 3; nkeys = 256; }
        if (grp) attn_item<1>(p, wsid_, ws_, layer, b, h, qb, nkeys, lam, lam_init, smem, tid);
        else attn_item<0>(p, wsid_, ws_, layer, b, h, qb, nkeys, lam, lam_init, smem, tid);
        if (conv_left) conv_left = conv_big_step(p, wsid_, ws_, layer, cctr, s_item, smem, tid, hb_);
    }
    while (conv_left) conv_left = conv_big_step(p, wsid_, ws_, layer, cctr, s_item, smem, tid, hb_);
}

__device__ void phase_outproj(KP p, int wsid_, int layer, int nrows, int bid, int nb, char* smem) {
    PHASE_PROLOGUE
    const bfu* MIX = (const bfu*)(ws_ + WS_MIX); const bfu* W = (const bfu*)(ws_ + WS_WOUT);
    float* X = (float*)(ws_ + WS_X); const float* mod = (const float*)(ws_ + WS_MOD);
    const int nitems = (nrows / 128) * 8;
    for (int it = bid; it < nitems; it += nb) {
        const int mt = it >> 3, nt = it & 7, row0 = mt * 128, col0 = nt * 128;
        int b, j0, s; row_info(row0, b, j0, s);
        const float* ga = mod + ((size_t)layer * 9 + s) * 6144 + 2 * 1024;
        gemm_tile([&](int r) { return MIX + (size_t)(row0 + r) * DM; }, [&](int r) { return W + (size_t)(col0 + r) * DM; }, DM,
            [&](f32x4 (&acc)[4][4], int wr, int wc, int fr, int fq) {
                ACC_FOREACH({ float* xp = X + (size_t)(row0 + row) * DM + col0 + col; *xp += ga[col0 + col] * val; })
            }, smem, wsid_);
    }
}

__device__ void phase_norm2_route(KP p, int wsid_, int layer, int nrows, int bid, int nb, char* smem) {
    PHASE_PROLOGUE
    const float* X = (const float*)(ws_ + WS_X); bfu* H = (bfu*)(ws_ + WS_H);
    const float* mod = (const float*)(ws_ + WS_MOD); const float* WRT = (const float*)(ws_ + WS_WRT);
    int* ECNT = (int*)(ws_ + WS_ECNT) + layer * 32; int* EIDX = (int*)(ws_ + WS_EIDX); float* EGATE = (float*)(ws_ + WS_EGATE); int* ELIST = (int*)(ws_ + WS_ELIST);
    float* lg = (float*)smem;
    int* lcnt = (int*)(lg + 4 * 16 * 48);
    int* lbase = lcnt + 32;
    int* lsel = lbase + 32;
    int* lrank = lsel + 128;
    const int tid = tid_, lane = tid & 63, wv = tid >> 6, r = lane & 15, kq = lane >> 4;
    const float* gf = p.g_ffn + layer * DM;
    const float* bg = p.r_b_group + layer * 4; const float* be = p.r_b_expert + layer * 32;
    const int nitems = nrows / 64;
    for (int it = bid; it < nitems; it += nb) {
        const int row = it * 64 + wv * 16 + r;
        int b, j, s; row_info(row, b, j, s);
        const float* xr = X + (size_t)row * DM;
        const float* sh = mod + ((size_t)layer * 9 + s) * 6144 + 3 * 1024; const float* sc = sh + 1024;
        if (tid < 32) lcnt[tid] = 0;
        float ss = 0.f;
        for (int c = 0; c < 64; ++c) { const float4 v = *(const float4*)(xr + c * 16 + kq * 4); ss += v.x * v.x + v.y * v.y + v.z * v.z + v.w * v.w; }
        ss += shfl_xor_(ss, 16); ss += shfl_xor_(ss, 32);
        const float rs = rsqrtf(ss * (1.f / 1024.f) + 1e-6f);
        f32x4 acc[3];
#pragma unroll
        for (int n = 0; n < 3; ++n) acc[n] = (f32x4){0.f, 0.f, 0.f, 0.f};
        for (int c = 0; c < 64; ++c) {
            const int k = c * 16 + kq * 4;
            const float4 v = *(const float4*)(xr + k), g = *(const float4*)(gf + k), s1 = *(const float4*)(sc + k), s0 = *(const float4*)(sh + k);
            float f[4];
            f[0] = v.x * rs * g.x * (1.f + s1.x) + s0.x; f[1] = v.y * rs * g.y * (1.f + s1.y) + s0.y;
            f[2] = v.z * rs * g.z * (1.f + s1.z) + s0.z; f[3] = v.w * rs * g.w * (1.f + s1.w) + s0.w;
            *(uint2*)(H + (size_t)row * DM + k) = make_uint2(pack2(f[0], f[1]), pack2(f[2], f[3]));
#pragma unroll
            for (int n = 0; n < 3; ++n) {
                const float4 w = *(const float4*)(WRT + (size_t)(n * 16 + r) * DM + k);
                acc[n] = __builtin_amdgcn_mfma_f32_16x16x4f32(f[0], w.x, acc[n], 0, 0, 0);
                acc[n] = __builtin_amdgcn_mfma_f32_16x16x4f32(f[1], w.y, acc[n], 0, 0, 0);
                acc[n] = __builtin_amdgcn_mfma_f32_16x16x4f32(f[2], w.z, acc[n], 0, 0, 0);
                acc[n] = __builtin_amdgcn_mfma_f32_16x16x4f32(f[3], w.w, acc[n], 0, 0, 0);
            }
        }
#pragma unroll
        for (int n = 0; n < 3; ++n)
#pragma unroll
            for (int jj = 0; jj < 4; ++jj) lg[(wv * 16 + kq * 4 + jj) * 48 + n * 16 + r] = acc[n][jj];
        __syncthreads();
        if (lane < 16) {
            const float* L = lg + (wv * 16 + lane) * 48;
            const int grow = it * 64 + wv * 16 + lane;
            float gl[4]; float gm = -1e30f; int gi = 0;
#pragma unroll
            for (int g = 0; g < 4; ++g) { gl[g] = L[g] + bg[g]; if (gl[g] > gm) { gm = gl[g]; gi = g; } }
            float gs = 0.f;
#pragma unroll
            for (int g = 0; g < 4; ++g) gs += __expf(gl[g] - gm);
            const float gp = 1.f / gs;
            float v1 = -1e30f, v2 = -1e30f; int i1 = 0, i2 = 0;
            for (int e = 0; e < 8; ++e) {
                const float v = L[4 + gi * 8 + e] + be[gi * 8 + e];
                if (v > v1) { v2 = v1; i2 = i1; v1 = v; i1 = e; } else if (v > v2) { v2 = v; i2 = e; }
            }
            const float e2 = __expf(v2 - v1), den = 1.f / (1.f + e2);
            const int ex1 = gi * 8 + i1, ex2 = gi * 8 + i2;
            EIDX[grow * 2] = ex1; EIDX[grow * 2 + 1] = ex2;
            EGATE[grow * 2] = den * gp; EGATE[grow * 2 + 1] = e2 * den * gp;
            const int lr = wv * 16 + lane;
            lsel[lr * 2] = ex1; lsel[lr * 2 + 1] = ex2;
            lrank[lr * 2] = atomicAdd(&lcnt[ex1], 1); lrank[lr * 2 + 1] = atomicAdd(&lcnt[ex2], 1);
        }
        __syncthreads();
        if (tid < 32) lbase[tid] = lcnt[tid] > 0 ? atomicAdd(&ECNT[tid], lcnt[tid]) : 0;
        __syncthreads();
        if (tid < 128) { const int e = lsel[tid]; ELIST[(size_t)e * (2 * MA) + lbase[e] + lrank[tid]] = ((it * 64 + (tid >> 1)) << 1) | (tid & 1); }
        __syncthreads();
    }
}

__device__ __forceinline__ int moe_prefix256(const int* ECNT, int* spre  , int wsid_) {
    if (TID512 == 0) { int a = 0; for (int e = 0; e < 32; ++e) { spre[e] = a; a += (ECNT[e] + 255) >> 8; } spre[32] = a; }
    __syncthreads();
    return spre[32];
}
__device__ void phase_outproj256(KP p, int wsid_, int layer, int nrows, int vblk, int nblk, char* smem_all) {
    PHASE_PROLOGUE
    const bfu* MIX = (const bfu*)(ws_ + WS_MIX); const bfu* W = (const bfu*)(ws_ + WS_WOUT);
    const float* mod = (const float*)(ws_ + WS_MOD);
    const int nitems = (nrows >> 8) * 4;
    for (int it = vblk; it < nitems; it += nblk) {
        const int mt = it >> 2, nt = it & 3, row0 = mt * 256, col0 = nt * 256;
        int b, j0, sm; row_info(row0, b, j0, sm);
        const float* ga = mod + ((size_t)layer * 9 + sm) * 6144 + 2 * 1024 + col0;
        const bfu* B0 = W + (size_t)col0 * DM;
        gemm256<DM, DM, DM>(MIX, [&](int r) { return row0 + r; }, B0, B0 + (size_t)128 * DM,
            [&](f32x4 (&acc)[2][2][4][2], int wr, int wc, int fr, int fq) {
                const __amdgpu_buffer_rsrc_t rs = __builtin_amdgcn_make_buffer_rsrc((void*)(ws_ + WS_X), 0, (int)((size_t)MA * DM * 4), 0x00020000);
                const int voff = ((wr * 64 + fq * 4) * DM + wc * 32 + fr) * 4;
#pragma unroll
                for (int bj = 0; bj < 2; ++bj)
#pragma unroll
                    for (int n = 0; n < 2; ++n) {
                        const float g = ga[bj * 128 + wc * 32 + n * 16 + fr];
#pragma unroll
                        for (int ai = 0; ai < 2; ++ai)
#pragma unroll
                            for (int m = 0; m < 4; ++m)
#pragma unroll
                                for (int j = 0; j < 4; ++j) {
                                    const int so = ((row0 + ai * 128 + m * 16 + j) * DM + col0 + bj * 128 + n * 16) * 4;
                                    const float xo = __uint_as_float(__builtin_amdgcn_raw_buffer_load_b32(rs, voff, so, 0));
                                    __builtin_amdgcn_raw_buffer_store_b32(__float_as_uint(xo + g * acc[ai][bj][m][n][j]), rs, voff, so, 0);
                                }
                    }
            }, smem_all, wsid_);
    }
}
__device__ void phase_expert1_256(KP p, int wsid_, int layer, int vblk, int nblk, char* smem_all) {
    PHASE_PROLOGUE
    const bfu* H = (const bfu*)(ws_ + WS_H); const bfu* W1 = (const bfu*)(ws_ + WS_W1); const bfu* W3 = (const bfu*)(ws_ + WS_W3);
    const int* ECNT = (const int*)(ws_ + WS_ECNT) + layer * 32; const int* ELIST = (const int*)(ws_ + WS_ELIST);
    int* spre = (int*)(smem_all + 135168);
    const int nb256 = __builtin_amdgcn_readfirstlane(moe_prefix256(ECNT, spre, wsid_));
    const int nitems = nb256 * 4;
    for (int it = vblk; it < nitems; it += nblk) {
        const int blk = it >> 2, nt = it & 3;
        int e = 0;
        while (__builtin_amdgcn_readfirstlane(spre[e + 1]) <= blk) ++e;
        const int rb = blk - __builtin_amdgcn_readfirstlane(spre[e]), cnt = __builtin_amdgcn_readfirstlane(ECNT[e]);
        const int* lst = ELIST + (size_t)e * (2 * MA) + rb * 256;
        const int nvalid = min(256, cnt - rb * 256);
        const bfu* w1 = W1 + ((size_t)e * FF + nt * 128) * DM; const bfu* w3 = W3 + ((size_t)e * FF + nt * 128) * DM;
        gemm256<DM, DM, DM>(H, [&](int r) { return r < nvalid ? (lst[r] >> 1) : 0; }, w1, w3,
            [&](f32x4 (&acc)[2][2][4][2], int wr, int wc, int fr, int fq) {
                const __amdgpu_buffer_rsrc_t rs = __builtin_amdgcn_make_buffer_rsrc((void*)(ws_ + WS_HB), 0, (int)((size_t)(2 * MA + 32 * 256) * FF * 2), 0x00020000);
                const int voff = ((wr * 64 + fq * 4) * FF + wc * 32 + fr) * 2;
#pragma unroll
                for (int ai = 0; ai < 2; ++ai)
#pragma unroll
                    for (int m = 0; m < 4; ++m)
#pragma unroll
                        for (int n = 0; n < 2; ++n)
#pragma unroll
                            for (int j = 0; j < 4; ++j) {
                                const float a = acc[ai][0][m][n][j], g = acc[ai][1][m][n][j];
                                __builtin_amdgcn_raw_buffer_store_b16(f2bf(siluf_(a) * g), rs, voff, ((blk * 256 + ai * 128 + m * 16 + j) * FF + nt * 128 + n * 16) * 2, 0);
                            }
            }, smem_all, wsid_);
    }
}
__device__ void phase_expert2_256(KP p, int wsid_, int layer, int vblk, int nblk, char* smem_all) {
    PHASE_PROLOGUE
    const bfu* HB = (const bfu*)(ws_ + WS_HB); const bfu* W2 = (const bfu*)(ws_ + WS_W2);
    const int* ECNT = (const int*)(ws_ + WS_ECNT) + layer * 32; const int* ELIST = (const int*)(ws_ + WS_ELIST); const float* EGATE = (const float*)(ws_ + WS_EGATE);
    int* spre = (int*)(smem_all + 135168);
    const int nb256 = __builtin_amdgcn_readfirstlane(moe_prefix256(ECNT, spre, wsid_));
    const int nitems = nb256 * 4;
    for (int it = vblk; it < nitems; it += nblk) {
        const int blk = it >> 2, nt = it & 3;
        int e = 0;
        while (__builtin_amdgcn_readfirstlane(spre[e + 1]) <= blk) ++e;
        const int rb = blk - __builtin_amdgcn_readfirstlane(spre[e]), cnt = __builtin_amdgcn_readfirstlane(ECNT[e]);
        const int* lst = ELIST + (size_t)e * (2 * MA) + rb * 256;
        const int nvalid = min(256, cnt - rb * 256);
        const bfu* w2 = W2 + ((size_t)e * DM + nt * 256) * FF;
        gemm256<FF, FF, FF>(HB, [&](int r) { return blk * 256 + r; }, w2, w2 + (size_t)128 * FF,
            [&](f32x4 (&acc)[2][2][4][2], int wr, int wc, int fr, int fq) {
                int* sOff = (int*)smem_all; float* sGt = (float*)(smem_all + 1024);
                { const int r = TID512;
                  if (r < 256) {
                      const bool ok = r < nvalid; const int ent = ok ? lst[r] : 0;
                      sOff[r] = ok ? ((ent & 1) * MA + (ent >> 1)) * DM * 4 : -1; sGt[r] = EGATE[ent];
                  } }
                __syncthreads();
                const __amdgpu_buffer_rsrc_t rs = __builtin_amdgcn_make_buffer_rsrc((void*)(ws_ + WS_Y01), 0, (int)((size_t)2 * MA * DM * 4), 0x00020000);
                const int cofs = (nt * 256 + wc * 32 + fr) * 4;
#pragma unroll
                for (int ai = 0; ai < 2; ++ai)
#pragma unroll
                    for (int m = 0; m < 4; ++m) {
                        const int4 o4 = *(const int4*)(sOff + ai * 128 + wr * 64 + m * 16 + fq * 4); const float4 g4 = *(const float4*)(sGt + ai * 128 + wr * 64 + m * 16 + fq * 4);
                        const int oo[4] = {o4.x, o4.y, o4.z, o4.w}; const float gg[4] = {g4.x, g4.y, g4.z, g4.w};
#pragma unroll
                        for (int j = 0; j < 4; ++j) {
                            if (oo[j] >= 0) {
#pragma unroll
                                for (int bj = 0; bj < 2; ++bj)
#pragma unroll
                                    for (int n = 0; n < 2; ++n)
                                        __builtin_amdgcn_raw_buffer_store_b32(__float_as_uint(gg[j] * acc[ai][bj][m][n][j]), rs, oo[j] + cofs, (bj * 128 + n * 16) * 4, 0);
                            }
                        }
                    }
            }, smem_all, wsid_);
    }
}

__device__ __forceinline__ int moe_prefix(const int* ECNT, int* spre  , int wsid_) {
    if ((TID512 & 255) == 0) { int a = 0; for (int e = 0; e < 32; ++e) { spre[e] = a; a += (ECNT[e] + 127) >> 7; } spre[32] = a; }
    __syncthreads();
    return spre[32];
}
__device__ void phase_expert1(KP p, int wsid_, int layer, int bid, int nb, char* smem) {
    PHASE_PROLOGUE
    const bfu* H = (const bfu*)(ws_ + WS_H); const bfu* W1 = (const bfu*)(ws_ + WS_W1); const bfu* W3 = (const bfu*)(ws_ + WS_W3);
    bfu* HB = (bfu*)(ws_ + WS_HB);
    const int* ECNT = (const int*)(ws_ + WS_ECNT) + layer * 32; const int* ELIST = (const int*)(ws_ + WS_ELIST);
    int* spre = (int*)(smem + 65536);
    const int nblk = moe_prefix(ECNT, spre, wsid_);
    const int nitems = nblk * 8;
    for (int it = bid; it < nitems; it += nb) {
        const int blk = it >> 3, nt = it & 7;
        int e = 0;
        while (spre[e + 1] <= blk) ++e;
        const int rb = blk - spre[e], cnt = ECNT[e];
        const int* lst = ELIST + (size_t)e * (2 * MA) + rb * 128;
        const int nvalid = min(128, cnt - rb * 128);
        const bfu* w1 = W1 + (size_t)e * FF * DM; const bfu* w3 = W3 + (size_t)e * FF * DM;
        bfu* hb = HB + (size_t)blk * 128 * FF;
        gemm_tile([&](int r) { const int tok = r < nvalid ? (lst[r] >> 1) : 0; return H + (size_t)tok * DM; },
                  [&](int r) { const int wcx = r >> 6, n4 = (r >> 4) & 3, rr = r & 15; const int hc = nt * 64 + wcx * 32 + (n4 & 1) * 16 + rr; return (n4 < 2 ? w1 : w3) + (size_t)hc * DM; }, DM,
            [&](f32x4 (&acc)[4][4], int wr, int wc, int fr, int fq) {
#pragma unroll
                for (int m = 0; m < 4; ++m)
#pragma unroll
                    for (int n = 0; n < 2; ++n)
#pragma unroll
                        for (int jj = 0; jj < 4; ++jj) {
                            const int row = wr * 64 + m * 16 + fq * 4 + jj; const int hc = nt * 64 + wc * 32 + n * 16 + fr;
                            const float a = acc[m][n][jj], g = acc[m][n + 2][jj];
                            hb[(size_t)row * FF + hc] = f2bf(siluf_(a) * g);
                        }
            }, smem, wsid_);
    }
}
__device__ void phase_expert2(KP p, int wsid_, int layer, int bid, int nb, char* smem) {
    PHASE_PROLOGUE
    const bfu* HB = (const bfu*)(ws_ + WS_HB); const bfu* W2 = (const bfu*)(ws_ + WS_W2);
    float* Y = (float*)(ws_ + WS_Y01);
    const int* ECNT = (const int*)(ws_ + WS_ECNT) + layer * 32; const int* ELIST = (const int*)(ws_ + WS_ELIST); const float* EGATE = (const float*)(ws_ + WS_EGATE);
    int* spre = (int*)(smem + 65536);
    const int nblk = moe_prefix(ECNT, spre, wsid_);
    const int nitems = nblk * 8;
    for (int it = bid; it < nitems; it += nb) {
        const int blk = it >> 3, nt = it & 7;
        int e = 0;
        while (spre[e + 1] <= blk) ++e;
        const int rb = blk - spre[e], cnt = ECNT[e];
        const int* lst = ELIST + (size_t)e * (2 * MA) + rb * 128;
        const int nvalid = min(128, cnt - rb * 128);
        const bfu* w2 = W2 + (size_t)e * DM * FF;
        const bfu* hb = HB + (size_t)blk * 128 * FF;
        gemm_tile([&](int r) { return hb + (size_t)r * FF; }, [&](int r) { return w2 + (size_t)(nt * 128 + r) * FF; }, FF,
            [&](f32x4 (&acc)[4][4], int wr, int wc, int fr, int fq) {
#pragma unroll
                for (int m = 0; m < 4; ++m)
#pragma unroll
                    for (int jj = 0; jj < 4; ++jj) {
                        const int row = wr * 64 + m * 16 + fq * 4 + jj;
                        if (row < nvalid) {
                            const int ent = lst[row]; const float gt = EGATE[ent];
                            float* yp = Y + ((size_t)(ent & 1) * MA + (ent >> 1)) * DM + nt * 128 + wc * 64 + fr;
#pragma unroll
                            for (int n = 0; n < 4; ++n) yp[n * 16] = gt * acc[m][n][jj];
                        }
                    }
            }, smem, wsid_);
    }
}

#define XB_TMO      128
#define XB_XCNT(j)  (256  + 64 * (j))
#define XB_XSUB(j)  (1280 + 64 * (j))
#define XB_XGEN(j)  (2304 + 64 * (j))
#define XB_TOP      3328
#define XB_TOPGEN   3392
#define XCD_BAR_WORDS 3456
#define XB_SPIN_CAP (1u << 22)
#define LAS __attribute__((address_space(3)))

__device__ __forceinline__ unsigned xb_ld(unsigned* p)              { return __hip_atomic_load(p, __ATOMIC_RELAXED, __HIP_MEMORY_SCOPE_AGENT); }
__device__ __forceinline__ unsigned xb_add(unsigned* p, unsigned v) { return __hip_atomic_fetch_add(p, v, __ATOMIC_RELAXED, __HIP_MEMORY_SCOPE_AGENT); }
__device__ __forceinline__ unsigned xb_xcc_id() { return (unsigned)__builtin_amdgcn_s_getreg((3 << 11) | 20) & 0xFu; }
#define XB_SPIN(cond, bar) do { unsigned _sp = 0; while (cond) { __builtin_amdgcn_s_sleep(1); \
    if ((++_sp & 255u) == 0u) { if (xb_ld(&(bar)[XB_TMO])) break; if (_sp > XB_SPIN_CAP) { atomicAdd(&(bar)[XB_TMO], 1u); break; } } } } while (0)

struct XcdBarrier {
    unsigned* bar; unsigned x;
    volatile LAS unsigned* st;
};

__device__ __forceinline__ XcdBarrier xcd_barrier_post(unsigned* bar, volatile LAS unsigned* st, int wsid_) {
    XcdBarrier b; b.bar = bar; b.x = xb_xcc_id(); b.st = st;
    if (TID512 == 0) (void)xb_add(&bar[XB_XCNT(b.x)], 1u);
    return b;
}
__device__ __forceinline__ void xcd_barrier_complete(unsigned* bar, unsigned x, unsigned& nloc, unsigned& nx) {
    const unsigned G = gridDim.x * gridDim.y * gridDim.z;
    unsigned sum, cnt, mine, sp = 0u;
    for (;;) {
        sum = 0u; cnt = 0u; mine = 0u;
#pragma unroll
        for (unsigned j = 0; j < 16; ++j) { const unsigned c = xb_ld(&bar[XB_XCNT(j)]); sum += c; cnt += (c > 0u) ? 1u : 0u; mine = (j == x) ? c : mine; }
        if (sum == G) break;
        __builtin_amdgcn_s_sleep(1);
        if ((++sp & 255u) == 0u) { if (xb_ld(&bar[XB_TMO])) break; if (sp > XB_SPIN_CAP) { atomicAdd(&bar[XB_TMO], 1u); break; } }
    }
    nloc = mine > 0u ? mine : 1u; nx = cnt > 0u ? cnt : 1u;
}

__device__ __forceinline__ void xcd_barrier_(const XcdBarrier& b, int wsid_) {
    asm volatile("s_waitcnt vmcnt(0)" ::: "memory");
    __syncthreads();
    if (TID512 == 0) {
        unsigned* bar = b.bar;
        __builtin_amdgcn_s_waitcnt(0);
        unsigned nloc = b.st[0], nx = b.st[1];
        if (nloc == 0u) { xcd_barrier_complete(bar, b.x, nloc, nx); b.st[0] = nloc; b.st[1] = nx; }
        const unsigned old = xb_add(&bar[XB_XSUB(b.x)], 1u);
        const unsigned gen = old / nloc;
        if (old + 1u == (gen + 1u) * nloc) {
            __builtin_amdgcn_fence(__ATOMIC_RELEASE, "agent");
            asm volatile("s_waitcnt vmcnt(0)" ::: "memory");
            const unsigned og = xb_add(&bar[XB_TOP], 1u);
            const unsigned tg = og / nx;
            if (og + 1u == (tg + 1u) * nx) xb_add(&bar[XB_TOPGEN], 1u);
            else XB_SPIN(xb_ld(&bar[XB_TOPGEN]) == tg, bar);
            __builtin_amdgcn_fence(__ATOMIC_ACQUIRE, "agent");
            xb_add(&bar[XB_XGEN(b.x)], 1u);
            asm volatile("s_waitcnt vmcnt(0)" ::: "memory");
        } else {
            XB_SPIN(xb_ld(&bar[XB_XGEN(b.x)]) == gen, bar);
            __builtin_amdgcn_fence(__ATOMIC_ACQUIRE, "agent");
            asm volatile("s_waitcnt vmcnt(0)" ::: "memory");
        }
    }
    __syncthreads();
}


#define REP_MOD 1
#define REP_CONV 1
#define REP_INPROJ 1
#define REP_RK 1
#define REP_SCANATT 1
#define REP_R4 1
#define REP_ATT 1
#define REP_READOUT 1
#define REP_EXP1 1
#define REP_EXP2 1
#define REPEAT(N) _Pragma("nounroll") for (int rep_ = 0; rep_ < (N); ++rep_)
#define REPEAT2(N) _Pragma("nounroll") for (int rep2_ = 0; rep2_ < (N); ++rep2_)
#define CTL_Q(l) (4096 + 64 * (l))
#define CTL_XR 5120
__global__ void __launch_bounds__(512, 2) fwd(P p) {
    __shared__ __attribute__((aligned(16))) char smem_all[2 * SMEM_BYTES + 64];
    const int wsid_ = __builtin_amdgcn_readfirstlane((int)(threadIdx.x >> 6));
    const int hb = wsid_ >> 2;
    char* smem = smem_all + hb * SMEM_BYTES;
    uint4& xb_words = *(uint4*)(smem_all + 2 * SMEM_BYTES);
    int& s_item = *(int*)(smem_all + 2 * SMEM_BYTES + 16);
    int& s_vb = *(int*)(smem_all + 2 * SMEM_BYTES + 20);
    if (TID512 == 0) xb_words = make_uint4(0u, 0u, 0u, 0u);
    __syncthreads();
    unsigned* ctl = (unsigned*)(KPARG.ws + WS_CTL);
    XcdBarrier bar = xcd_barrier_post(ctl, (volatile LAS unsigned*)&xb_words, wsid_);
#define xcd_barrier(b_) xcd_barrier_(b_, wsid_)
    const int bid = blockIdx.x * 2 + hb, nb = gridDim.x * 2;
    const unsigned my_xcc = xb_xcc_id();
    if (TID512 == 0) s_vb = (int)atomicAdd(&ctl[CTL_XR + 16 * my_xcc], 1u);
    int vb = bid;
    phase_setup(KPARG, wsid_, bid, nb);
    REPEAT(REP_MOD) phase_mod(KPARG, wsid_, bid, nb, smem);
    for (int l = 0; l < NLAYER; ++l) {
        const int nr = l < NLAYER - 1 ? MA : ML;
        REPEAT(REP_CONV) phase_conv(KPARG, wsid_, l, bid, nb, smem);
        if (l == 0) {
            xcd_barrier(bar);
            if (TID512 == 0) { int pre = 0; for (unsigned x = 0; x < my_xcc; ++x) pre += (int)xb_ld(&ctl[CTL_XR + 16 * x]); s_vb += pre; }
            __syncthreads();
            vb = __builtin_amdgcn_readfirstlane(s_vb) * 2 + hb;
        }
        phase_norm1(KPARG, wsid_, l, 0, bid, nb);
        xcd_barrier(bar);
        REPEAT(REP_INPROJ) { phase_inproj256(KPARG, wsid_, l, vb >> 1, nb >> 1, smem_all); xcd_barrier(bar); }
        REPEAT(REP_RK) { phase_rk(KPARG, wsid_, l, bid, nb, smem); xcd_barrier(bar); }
        REPEAT(REP_SCANATT) {
            if (bid < 128) { REPEAT(REP_R4) phase_r4(KPARG, wsid_, l, bid, 128, smem); }
            else phase_gate(KPARG, wsid_, l, bid - 128, nb - 128, smem);
            REPEAT2(REP_ATT) phase_attn(KPARG, wsid_, l, l < NLAYER - 1, ctl + CTL_Q(l) + 16 * rep_ + 32 * rep2_, ctl + CTL_Q(l) + 8 + 16 * rep_ + 32 * rep2_, &s_item, smem);
            xcd_barrier(bar);
        }
        REPEAT(REP_READOUT) { phase_readout(KPARG, wsid_, l, nr, bid, nb); xcd_barrier(bar); }
        phase_outproj256(KPARG, wsid_, l, nr, vb >> 1, nb >> 1, smem_all);
        xcd_barrier(bar);
        phase_norm2_route(KPARG, wsid_, l, nr, bid, nb, smem);
        xcd_barrier(bar);
        REPEAT(REP_EXP1) { phase_expert1_256(KPARG, wsid_, l, vb >> 1, nb >> 1, smem_all); xcd_barrier(bar); }
        REPEAT(REP_EXP2) { phase_expert2_256(KPARG, wsid_, l, vb >> 1, nb >> 1, smem_all); xcd_barrier(bar); }
    }
    phase_norm1(KPARG, wsid_, NLAYER, 1, bid, nb);
}

extern "C" void kernel_launch(void* const* d_in, const int* in_sizes, int n_in, void* d_out, int out_size, void* d_ws, size_t ws_size, hipStream_t stream) {
    if (n_in != 36 || ws_size < WS_END) { fprintf(stderr, "kernel_launch: unexpected n_in %d or ws_size %zu < %zu\n", n_in, ws_size, (size_t)WS_END); return; }
    static int grid = 0;
    if (!grid) {
        int dev = 0, cus = 0, per_cu = 0;
        hipGetDevice(&dev);
        hipDeviceGetAttribute(&cus, hipDeviceAttributeMultiprocessorCount, dev);
        hipOccupancyMaxActiveBlocksPerMultiprocessor(&per_cu, (const void*)fwd, 512, 0);
        if (per_cu < 1) per_cu = 1;
        grid = cus;
    }
    P p{};
    const float** pp = (const float**)&p;
    for (int i = 0; i < 36; ++i) pp[i] = (const float*)d_in[i];
    p.out = (float*)d_out; p.ws = (char*)d_ws;
    hipMemsetAsync((char*)d_ws + WS_CTL, 0, 65536, stream);
    fwd<<<grid, 512, 0, stream>>>(p);
}
```

```cpp
#include <hip/hip_runtime.h>
#include <stdint.h>
#include <stdio.h>

typedef unsigned short bfu;
using bf16x8 = __attribute__((ext_vector_type(8))) short;
using f32x4  = __attribute__((ext_vector_type(4))) float;

#define DM 1024
#define NB 8
#define SEQ 2048
#define CL 256
#define NKEY 2304
#define ML 16384
#define MC 2048
#define MA 18432
#define INW 3200
#define CSL 1920
#define NEXP 32
#define FF 512
#define NLAYER 4
#define LOG2E 1.4426950408889634f

#define MBy(x) ((size_t)(x) << 20)
constexpr size_t WS_CTL   = 0;
constexpr size_t WS_MOD   = 65536;
constexpr size_t WS_ROPE  = WS_MOD + (size_t)4 * 9 * 6144 * 4;
constexpr size_t WS_ECNT  = WS_ROPE + 64 * 16 * 2 * 4 + 64 * 8 * 2 * 4;
constexpr size_t WS_WRT   = WS_ECNT + 4096;
constexpr size_t WS_WRTH  = WS_WRT + (size_t)48 * 1024 * 4;
constexpr size_t WS_WRTL  = WS_WRTH + (size_t)48 * 1024 * 2;
constexpr size_t WS_EIDX  = WS_WRTL + (size_t)48 * 1024 * 2;
constexpr size_t WS_EGATE = WS_EIDX + (size_t)MA * 2 * 4;
constexpr size_t WS_ELIST = WS_EGATE + (size_t)MA * 2 * 4;
constexpr size_t WS_X     = MBy(8);
constexpr size_t WS_H     = WS_X + (size_t)MA * DM * 4;
constexpr size_t WS_WIN   = WS_H + (size_t)MA * DM * 2;
constexpr size_t WS_WOUT  = WS_WIN + (size_t)INW * DM * 2;
constexpr size_t WS_W1    = WS_WOUT + (size_t)DM * DM * 2;
constexpr size_t WS_W3    = WS_W1 + (size_t)NEXP * FF * DM * 2;
constexpr size_t WS_W2    = WS_W3 + (size_t)NEXP * FF * DM * 2;
constexpr size_t WS_LW2   = WS_W2 + (size_t)NEXP * FF * DM * 2;
constexpr size_t WS_LA2   = WS_LW2 + (size_t)2 * 512 * 64 * 2;
constexpr size_t WS_LG2   = WS_LA2 + (size_t)2 * 512 * 64 * 2;
constexpr size_t WS_QA    = WS_LG2 + (size_t)512 * 128 * 2;
constexpr size_t WS_KA    = WS_QA + (size_t)NB * 4 * NKEY * 64 * 2;
constexpr size_t WS_VAT   = WS_KA + (size_t)NB * 2 * NKEY * 64 * 2;
constexpr size_t WS_QB    = WS_VAT + (size_t)NB * 2 * NKEY * 64 * 2;
constexpr size_t WS_KB    = WS_QB + (size_t)NB * 4 * NKEY * 64 * 2;
constexpr size_t WS_VBT   = WS_KB + (size_t)NB * 4 * NKEY * 64 * 2;
constexpr size_t WS_CP    = WS_VBT + (size_t)NB * 4 * NKEY * 64 * 2;
constexpr size_t WS_GG    = WS_CP + (size_t)MA * CSL * 4;
constexpr size_t WS_MIX   = WS_GG + (size_t)MA * 512 * 4;
constexpr size_t HEADARR  = (size_t)NB * 8 * NKEY * 64 * 4;
#define OPS_REC 13568
constexpr size_t OPS_DIR  = (size_t)64 * 144 * OPS_REC;
constexpr size_t WS_OPS   = WS_MIX + (size_t)MA * DM * 2;
constexpr size_t WS_YS    = WS_OPS + 2 * OPS_DIR;
constexpr size_t WS_VB    = WS_YS + 2 * HEADARR;
constexpr size_t WS_BETA  = WS_VB + (size_t)MA * 512 * 2;
constexpr size_t WS_LXG   = WS_BETA + (size_t)2 * MA * 8 * 4;
constexpr size_t WS_SCR   = WS_LXG + (size_t)MA * 128 * 2;
constexpr size_t WS_END   = WS_SCR + (size_t)256 * 2 * 128 * 132 * 4;
constexpr size_t WS_Y01   = WS_OPS;
constexpr size_t WS_HB    = WS_OPS + (size_t)2 * MA * DM * 4;
static_assert((size_t)2 * MA * DM * 4 + (size_t)(2 * MA + 32 * 256) * 512 * 2 <= 2 * OPS_DIR, "MoE buffers must fit in OPS");

struct P {
    const float *x, *c, *ctx, *c_ctx, *w_mod, *b_mod, *g_mix, *g_ffn, *w_in, *a_q_gain, *a_k_gain, *b_lq1, *b_lk1, *b_lq2, *b_lk2, *b_subln,
        *c_mu, *c_w0, *c_w2, *c_a0, *c_a2, *c_g2, *c_k_k, *c_k_a, *c_r_k, *c_ln_w, *c_ln_b, *w_out, *r_w_group, *r_b_group, *r_w_expert, *r_b_expert,
        *e_w1, *e_w3, *e_w2, *g_final;
    float* out;
    char* ws;
};

typedef const __attribute__((address_space(4))) P& KP;
#define KPARG (*({ const __attribute__((address_space(4))) P* k_ = (const __attribute__((address_space(4))) P*)__builtin_amdgcn_kernarg_segment_ptr(); asm volatile("" : "+s"(k_)); k_; }))

__device__ __forceinline__ float bf2f(bfu b) { return __uint_as_float((unsigned)b << 16); }
__device__ __forceinline__ unsigned pack2(float a, float b) {
    typedef float f2 __attribute__((ext_vector_type(2)));
    typedef __bf16 b2 __attribute__((ext_vector_type(2)));
    f2 v = {a, b}; b2 r = __builtin_convertvector(v, b2); return __builtin_bit_cast(unsigned, r);
}
__device__ __forceinline__ bfu f2bf(float a) { return (bfu)(pack2(a, 0.f) & 0xFFFFu); }
__device__ __forceinline__ int lane_id_() { int l; asm volatile("v_mbcnt_lo_u32_b32 %0, -1, 0\n\tv_mbcnt_hi_u32_b32 %0, -1, %0" : "=v"(l)); return l; }
__device__ __forceinline__ float shfl_xor_(float v, int o) { return __int_as_float(__builtin_amdgcn_ds_bpermute((lane_id_() ^ o) << 2, __float_as_int(v))); }
template <int CTRL> __device__ __forceinline__ float dppf(float v) { return __int_as_float(__builtin_amdgcn_update_dpp(0, __float_as_int(v), CTRL, 0xF, 0xF, true)); }
__device__ __forceinline__ float sum8(float v) { v += dppf<0xB1>(v); v += dppf<0x4E>(v); v += dppf<0x141>(v); return v; }
__device__ __forceinline__ float xor16_sum(float v) { const auto r = __builtin_amdgcn_permlane16_swap(__float_as_uint(v), __float_as_uint(v), false, false); return __uint_as_float(r[0]) + __uint_as_float(r[1]); }
__device__ __forceinline__ float xor32_sum(float v) { const auto r = __builtin_amdgcn_permlane32_swap(__float_as_uint(v), __float_as_uint(v), false, false); return __uint_as_float(r[0]) + __uint_as_float(r[1]); }
__device__ __forceinline__ float xor32_max(float v) { const auto r = __builtin_amdgcn_permlane32_swap(__float_as_uint(v), __float_as_uint(v), false, false); return fmaxf(__uint_as_float(r[0]), __uint_as_float(r[1])); }
__device__ __forceinline__ float sum64(float v) { v = sum8(v); v += dppf<0x140>(v); v = xor16_sum(v); return xor32_sum(v); }
__device__ __forceinline__ float sigmoidf_(float x) { return __builtin_amdgcn_rcpf(1.f + __expf(-x)); }
__device__ __forceinline__ float siluf_(float x) { return x * __builtin_amdgcn_rcpf(1.f + __expf(-x)); }
__device__ __forceinline__ void row_info(int grow, int& b, int& j, int& s) {
    if (grow < ML) { b = grow >> 11; j = 256 + (grow & 2047); s = b; }
    else { int r = grow - ML; b = r >> 8; j = r & 255; s = 8; }
}
__device__ __forceinline__ int grow_of(int b, int j) { return j < 256 ? ML + b * 256 + j : b * 2048 + (j - 256); }

#define SMEM_BYTES 69632

#define TID512 ((wsid_ << 6) | lane_id_())
#define PHASE_PROLOGUE int tid_ = ((wsid_ & 3) << 6) | lane_id_(); asm volatile("" : "+v"(tid_)); const int hb_ = wsid_ >> 2; (void)hb_; \
    int z_ = 0; asm volatile("" : "+v"(z_)); char* ws_ = p.ws + __builtin_amdgcn_readfirstlane(z_);

__device__ void phase_setup(KP p, int wsid_, int bid, int nb) {
    PHASE_PROLOGUE
    float4* X4 = (float4*)(ws_ + WS_X);
    const float4* x4 = (const float4*)p.x; const float4* c4 = (const float4*)p.ctx;
    const size_t nl = (size_t)ML * DM / 4, nc = (size_t)MC * DM / 4;
    for (size_t i = (size_t)bid * 256 + tid_; i < nl + nc; i += (size_t)nb * 256) X4[i] = i < nl ? x4[i] : c4[i - nl];
    if (bid == 0) {
        float* TA = (float*)(ws_ + WS_ROPE); float* TB = TA + 64 * 16 * 2;
        for (int i = tid_; i < 64 * 16; i += 256) { int pos = i >> 4, f = i & 15; double inv = pow(10000.0, -(double)f / 16.0); double a = (double)pos * inv; TA[i * 2] = (float)cos(a); TA[i * 2 + 1] = (float)sin(a); }
        for (int i = tid_; i < 64 * 8; i += 256) { int pos = i >> 3, f = i & 7; double inv = pow(10000.0, -(double)f / 8.0); double a = (double)pos * inv; TB[i * 2] = (float)cos(a); TB[i * 2 + 1] = (float)sin(a); }
        int* ec = (int*)(ws_ + WS_ECNT);
        for (int i = tid_; i < 128; i += 256) ec[i] = 0;
    }
}

__device__ void phase_mod(KP p, int wsid_, int bid, int nb, char* smem) {
    PHASE_PROLOGUE
    float* act = (float*)smem;
    float* red = act + 9 * 1024;
    for (int i = tid_; i < 9 * 1024; i += 256) { float v = i < 8 * 1024 ? p.c[i] : p.c_ctx[i - 8 * 1024]; act[i] = siluf_(v); }
    __syncthreads();
    float* mod = (float*)(ws_ + WS_MOD);
    const int nitems = 4 * 6144 / 64;
    const int ct = tid_ & 15, kg = tid_ >> 4, wv = tid_ >> 6;
    for (int it = bid; it < nitems; it += nb) {
        const int layer = it / 96, n0 = (it % 96) * 64;
        const float* w = p.w_mod + (size_t)layer * DM * 6144 + (size_t)(kg * 64) * 6144 + n0 + ct * 4;
        float a[9][4];
#pragma unroll
        for (int s = 0; s < 9; ++s) { a[s][0] = 0.f; a[s][1] = 0.f; a[s][2] = 0.f; a[s][3] = 0.f; }
#pragma unroll 1
        for (int k0 = 0; k0 < 64; k0 += 16) {
            float4 wq[16];
#pragma unroll
            for (int j = 0; j < 16; ++j) wq[j] = *(const float4*)(w + (size_t)(k0 + j) * 6144);
#pragma unroll
            for (int j4 = 0; j4 < 4; ++j4)
#pragma unroll
                for (int s = 0; s < 9; ++s) {
                    const float4 av = *(const float4*)(act + s * 1024 + kg * 64 + k0 + j4 * 4);
                    const float avv[4] = {av.x, av.y, av.z, av.w};
#pragma unroll
                    for (int e = 0; e < 4; ++e) { const float4 q = wq[j4 * 4 + e]; a[s][0] += avv[e] * q.x; a[s][1] += avv[e] * q.y; a[s][2] += avv[e] * q.z; a[s][3] += avv[e] * q.w; }
                }
        }
#pragma unroll
        for (int s = 0; s < 9; ++s)
#pragma unroll
            for (int c = 0; c < 4; ++c) { a[s][c] = xor32_sum(xor16_sum(a[s][c])); }
        if ((tid_ & 63) < 16) {
#pragma unroll
            for (int s = 0; s < 9; ++s) *(float4*)(red + (wv * 9 + s) * 64 + ct * 4) = make_float4(a[s][0], a[s][1], a[s][2], a[s][3]);
        }
        __syncthreads();
        for (int i = tid_; i < 9 * 64; i += 256) {
            const int s = i >> 6, c2 = i & 63, n2 = n0 + c2;
            float v = red[(0 * 9 + s) * 64 + c2] + red[(1 * 9 + s) * 64 + c2] + red[(2 * 9 + s) * 64 + c2] + red[(3 * 9 + s) * 64 + c2];
            mod[((size_t)layer * 9 + s) * 6144 + n2] = v + p.b_mod[layer * 6144 + n2];
        }
        __syncthreads();
    }
}

__device__ __forceinline__ void conv_tile(const float* src, int K, int N, bfu* dst, int k0, int n0, float* ts, int tid_) {
    const int t = tid_;
    {
        const int kk = t >> 4, n4 = (t & 15) * 4;
#pragma unroll
        for (int pz = 0; pz < 4; ++pz) {
            const float4 v = *(const float4*)(src + (size_t)(k0 + kk + 16 * pz) * N + n0 + n4);
            float* d = ts + (kk + 16 * pz) * 65 + n4; d[0] = v.x; d[1] = v.y; d[2] = v.z; d[3] = v.w;
        }
    }
    __syncthreads();
    {
        const int n = t >> 2, kc = (t & 3) * 16;
        unsigned o[8];
#pragma unroll
        for (int i = 0; i < 8; ++i) o[i] = pack2(ts[(kc + 2 * i) * 65 + n], ts[(kc + 2 * i + 1) * 65 + n]);
        uint4* d = (uint4*)(dst + (size_t)(n0 + n) * K + k0 + kc);
        d[0] = make_uint4(o[0], o[1], o[2], o[3]); d[1] = make_uint4(o[4], o[5], o[6], o[7]);
    }
    __syncthreads();
}
__device__ void phase_conv(KP p, int wsid_, int layer, int bid, int nb, char* smem) {
    PHASE_PROLOGUE
    float* ts = (float*)smem;
    const float* srcs[8]; bfu* dsts[8]; int Ks[8], Ns[8], Bs[8];
    char* ws = ws_;
    srcs[0] = p.w_in + (size_t)layer * DM * INW;  Ks[0] = DM; Ns[0] = INW; Bs[0] = 1;  dsts[0] = (bfu*)(ws + WS_WIN);
    srcs[1] = p.w_out + (size_t)layer * DM * DM;  Ks[1] = DM; Ns[1] = DM;  Bs[1] = 1;  dsts[1] = (bfu*)(ws + WS_WOUT);
    srcs[2] = p.e_w1 + (size_t)layer * NEXP * DM * FF; Ks[2] = DM; Ns[2] = FF; Bs[2] = NEXP; dsts[2] = (bfu*)(ws + WS_W1);
    srcs[3] = p.e_w3 + (size_t)layer * NEXP * DM * FF; Ks[3] = DM; Ns[3] = FF; Bs[3] = NEXP; dsts[3] = (bfu*)(ws + WS_W3);
    srcs[4] = p.e_w2 + (size_t)layer * NEXP * FF * DM; Ks[4] = FF; Ns[4] = DM; Bs[4] = NEXP; dsts[4] = (bfu*)(ws + WS_W2);
    srcs[5] = p.c_w2 + (size_t)layer * 2 * 64 * 512;   Ks[5] = 64; Ns[5] = 512; Bs[5] = 2;   dsts[5] = (bfu*)(ws + WS_LW2);
    srcs[6] = p.c_a2 + (size_t)layer * 2 * 64 * 512;   Ks[6] = 64; Ns[6] = 512; Bs[6] = 2;   dsts[6] = (bfu*)(ws + WS_LA2);
    srcs[7] = p.c_g2 + (size_t)layer * 128 * 512;      Ks[7] = 128; Ns[7] = 512; Bs[7] = 1;  dsts[7] = (bfu*)(ws + WS_LG2);
    for (int it = bid; it < 1104; it += nb) {
        int jb, r;
        if (it < 800) { jb = 0; r = it; } else if (it < 1056) { jb = 1; r = it - 800; } else if (it < 1072) { jb = 5; r = it - 1056; } else if (it < 1088) { jb = 6; r = it - 1072; } else { jb = 7; r = it - 1088; }
        const float* src; bfu* dst; int K, N;
        if (jb == 0) { src = srcs[0]; dst = dsts[0]; K = DM; N = INW; } else if (jb == 1) { src = srcs[1]; dst = dsts[1]; K = DM; N = DM; }
        else if (jb == 5) { src = srcs[5]; dst = dsts[5]; K = 64; N = 512; } else if (jb == 6) { src = srcs[6]; dst = dsts[6]; K = 64; N = 512; } else { src = srcs[7]; dst = dsts[7]; K = 128; N = 512; }
        const int tk = K / 64, tn = N / 64, per = tk * tn, bt = r / per, r2 = r % per, kt = r2 / tn, nt = r2 % tn;
        conv_tile(src + (size_t)bt * K * N, K, N, dst + (size_t)bt * K * N, kt * 64, nt * 64, ts, tid_);
    }
    float* wrt = (float*)(ws + WS_WRT);
    const float* wg = p.r_w_group + (size_t)layer * DM * 4; const float* we = p.r_w_expert + (size_t)layer * DM * 32;
    for (int i = bid * 256 + tid_; i < 48 * 1024; i += nb * 256) {
        const int r = i >> 10, k = i & 1023;
        const float wv_ = r < 4 ? wg[k * 4 + r] : (r < 36 ? we[k * 32 + (r - 4)] : 0.f);
        wrt[i] = wv_;
        const bfu hi_ = f2bf(wv_);
        ((bfu*)(ws + WS_WRTH))[i] = hi_; ((bfu*)(ws + WS_WRTL))[i] = f2bf(wv_ - bf2f(hi_));
    }
}

__device__ __forceinline__ bool conv_big_step(KP p, int wsid_, char* ws_, int layer, unsigned* qctr, int* s_item, char* smem, int tid_, int hb_) {
    float* ts = (float*)smem;
    __syncthreads();
    if (TID512 == 0) *s_item = (int)atomicAdd(qctr, 1u);
    __syncthreads();
    const int gidx = __builtin_amdgcn_readfirstlane(*s_item);
    if (gidx >= 1536) return false;
    { const int q0 = hb_ * 4;
        const float* sp[4]; bfu* dp[4]; int Ks[4];
        float4 v[4][4];
        const int kk = tid_ >> 4, n4 = (tid_ & 15) * 4;
#pragma unroll
        for (int q = 0; q < 4; ++q) {
            const int it = gidx * 8 + q0 + q, jb = it >> 12, r = it & 4095, bt = r >> 7, r2 = r & 127;
            const float* src; bfu* dst; int K, N;
            if (jb == 0) { src = p.e_w1 + (size_t)layer * NEXP * DM * FF; dst = (bfu*)(ws_ + WS_W1); K = DM; N = FF; }
            else if (jb == 1) { src = p.e_w3 + (size_t)layer * NEXP * DM * FF; dst = (bfu*)(ws_ + WS_W3); K = DM; N = FF; }
            else { src = p.e_w2 + (size_t)layer * NEXP * FF * DM; dst = (bfu*)(ws_ + WS_W2); K = FF; N = DM; }
            const int tn = N >> 6, kt = r2 / tn, nt = r2 % tn;
            const float* s0 = src + (size_t)bt * K * N + (size_t)(kt * 64 + kk) * N + nt * 64 + n4;
#pragma unroll
            for (int pz = 0; pz < 4; ++pz) v[q][pz] = *(const float4*)(s0 + (size_t)(16 * pz) * N);
            Ks[q] = K;
            dp[q] = dst + (size_t)bt * K * N + (size_t)(nt * 64 + (tid_ >> 2)) * K + kt * 64 + (tid_ & 3) * 16;
        }
#pragma unroll
        for (int q = 0; q < 4; ++q)
#pragma unroll
            for (int pz = 0; pz < 4; ++pz) { float* d = ts + q * 4160 + (kk + 16 * pz) * 65 + n4; d[0] = v[q][pz].x; d[1] = v[q][pz].y; d[2] = v[q][pz].z; d[3] = v[q][pz].w; }
        __syncthreads();
        {
            const int n = tid_ >> 2, kc = (tid_ & 3) * 16;
#pragma unroll
            for (int q = 0; q < 4; ++q) {
                unsigned o[8];
#pragma unroll
                for (int i = 0; i < 8; ++i) o[i] = pack2(ts[q * 4160 + (kc + 2 * i) * 65 + n], ts[q * 4160 + (kc + 2 * i + 1) * 65 + n]);
                uint4* d = (uint4*)dp[q];
                d[0] = make_uint4(o[0], o[1], o[2], o[3]); d[1] = make_uint4(o[4], o[5], o[6], o[7]);
            }
        }
        __syncthreads();
    }
    return true;
}

__device__ void phase_norm1(KP p, int wsid_, int layer, int mode, int bid, int nb, bool combine = true) {
    PHASE_PROLOGUE
    float* X = (float*)(ws_ + WS_X); bfu* H = (bfu*)(ws_ + WS_H);
    const float* Y0 = (const float*)(ws_ + WS_Y01); const float* Y1 = Y0 + (size_t)MA * DM;
    const float* mod = (const float*)(ws_ + WS_MOD);
    const int lane = tid_ & 63, wv = tid_ >> 6;
    const int nrows = mode ? ML : MA;
    if (bid == 0 && mode == 0 && tid_ < 32) ((int*)(ws_ + WS_ECNT))[layer * 32 + tid_] = 0;
    for (int row = bid * 4 + wv; row < nrows; row += nb * 4) {
        int b, j, s; row_info(row, b, j, s);
        float4 v[4];
        float ss = 0.f;
#pragma unroll
        for (int c = 0; c < 4; ++c) {
            const int col = c * 256 + lane * 4;
            float4 xv = *(const float4*)(X + (size_t)row * DM + col);
            if (layer > 0 && combine) {
                const float4 a = *(const float4*)(Y0 + (size_t)row * DM + col), bq = *(const float4*)(Y1 + (size_t)row * DM + col);
                const float4 g = *(const float4*)(mod + ((size_t)(layer - 1) * 9 + s) * 6144 + 5 * 1024 + col);
                xv.x += g.x * (a.x + bq.x); xv.y += g.y * (a.y + bq.y); xv.z += g.z * (a.z + bq.z); xv.w += g.w * (a.w + bq.w);
                if (!mode) *(float4*)(X + (size_t)row * DM + col) = xv;
            }
            v[c] = xv; ss += xv.x * xv.x + xv.y * xv.y + xv.z * xv.z + xv.w * xv.w;
        }
        ss = sum64(ss);
        const float rs = rsqrtf(ss * (1.f / 1024.f) + 1e-6f);
#pragma unroll
        for (int c = 0; c < 4; ++c) {
            const int col = c * 256 + lane * 4;
            if (mode) {
                const float4 g = *(const float4*)(p.g_final + col);
                float4 o; o.x = v[c].x * rs * g.x; o.y = v[c].y * rs * g.y; o.z = v[c].z * rs * g.z; o.w = v[c].w * rs * g.w;
                *(float4*)(p.out + (size_t)row * DM + col) = o;
            } else {
                const float4 g = *(const float4*)(p.g_mix + layer * DM + col);
                const float4 sh = *(const float4*)(mod + ((size_t)layer * 9 + s) * 6144 + 0 * 1024 + col);
                const float4 sc = *(const float4*)(mod + ((size_t)layer * 9 + s) * 6144 + 1 * 1024 + col);
                const float o0 = v[c].x * rs * g.x * (1.f + sc.x) + sh.x, o1 = v[c].y * rs * g.y * (1.f + sc.y) + sh.y;
                const float o2 = v[c].z * rs * g.z * (1.f + sc.z) + sh.z, o3 = v[c].w * rs * g.w * (1.f + sc.w) + sh.w;
                *(uint2*)(H + (size_t)row * DM + col) = make_uint2(pack2(o0, o1), pack2(o2, o3));
            }
        }
    }
}

#define GLDS(gp, lp) __builtin_amdgcn_global_load_lds((const unsigned*)(gp), (__attribute__((address_space(3))) unsigned*)(lp), 16, 0, 0)
__device__ __forceinline__ int swzG(int x) { return (0x78 >> (2 * x)) & 3; }
template <class FA, class FB, class FE>
__device__ __forceinline__ void gemm_tile(FA arow, FB brow, int K, FE epi, char* smem, int wsid_) {
    int tid = TID512 & 255; asm volatile("" : "+v"(tid));
    const int lane = tid & 63, wid = tid >> 6, wr = wid >> 1, wc = wid & 1, fr = lane & 15, fq = lane >> 4;
    const int lrow = tid >> 2, lch = ((tid & 3) ^ swzG((tid >> 4) & 3)) * 8;
    const bfu* ga0 = arow(lrow) + lch; const bfu* ga1 = arow(lrow + 64) + lch;
    const bfu* gb0 = brow(lrow) + lch; const bfu* gb1 = brow(lrow + 64) + lch;
    f32x4 acc[4][4];
#pragma unroll
    for (int m = 0; m < 4; ++m)
#pragma unroll
        for (int n = 0; n < 4; ++n) acc[m][n] = (f32x4){0.f, 0.f, 0.f, 0.f};
    char* lds0 = smem + tid * 16;
#define GEMM_ISSUE(kt_) { char* d_ = lds0 + ((kt_) & 3) * 16384; const int ko_ = (kt_) * 32; \
        GLDS(ga0 + ko_, d_); GLDS(ga1 + ko_, d_ + 4096); GLDS(gb0 + ko_, d_ + 8192); GLDS(gb1 + ko_, d_ + 12288); }
    const int nk = K >> 5;
    __syncthreads();
    GEMM_ISSUE(0)
    if (nk > 1) GEMM_ISSUE(1)
    if (nk > 2) GEMM_ISSUE(2)
    const int offA = (wr * 64 + fr) * 64 + ((fq ^ swzG((fr >> 2) & 3)) * 16), offB = 8192 + (wc * 64 + fr) * 64 + ((fq ^ swzG((fr >> 2) & 3)) * 16);
    for (int kt = 0; kt < nk; ++kt) {
        if (kt + 2 < nk) asm volatile("s_waitcnt vmcnt(8)" ::: "memory");
        else if (kt + 1 < nk) asm volatile("s_waitcnt vmcnt(4)" ::: "memory");
        else asm volatile("s_waitcnt vmcnt(0)" ::: "memory");
        __builtin_amdgcn_s_barrier();
        if (kt + 3 < nk) GEMM_ISSUE(kt + 3)
        const char* st = smem + (kt & 3) * 16384;
        bf16x8 af[4], bfr[4];
#pragma unroll
        for (int m = 0; m < 4; ++m) af[m] = *(const bf16x8*)(st + offA + m * 1024);
#pragma unroll
        for (int n = 0; n < 4; ++n) bfr[n] = *(const bf16x8*)(st + offB + n * 1024);
        __builtin_amdgcn_s_setprio(1);
#pragma unroll
        for (int m = 0; m < 4; ++m)
#pragma unroll
            for (int n = 0; n < 4; ++n) acc[m][n] = __builtin_amdgcn_mfma_f32_16x16x32_bf16(af[m], bfr[n], acc[m][n], 0, 0, 0);
        __builtin_amdgcn_s_setprio(0);
    }
    __syncthreads();
    epi(acc, wr, wc, fr, fq);
}
#define ACC_FOREACH(...)                                                                      \
    _Pragma("unroll") for (int m_ = 0; m_ < 4; ++m_) _Pragma("unroll") for (int n_ = 0; n_ < 4; ++n_) \
    _Pragma("unroll") for (int j_ = 0; j_ < 4; ++j_) {                                        \
        const int row = wr * 64 + m_ * 16 + fq * 4 + j_; const int col = wc * 64 + n_ * 16 + fr; const float val = acc[m_][n_][j_]; __VA_ARGS__ }

__device__ __forceinline__ int lds_byte256(int r, int c) { const int st = (r >> 4) * 2 + (c >> 5), rr = r & 15, cc = c & 31, ob = rr * 64 + cc * 2; return st * 1024 + (ob ^ (((ob >> 9) & 1) << 5)); }
__device__ __forceinline__ void stage_rc256(int b, int& R, int& C) { const int st = b / 1024, sb = b % 1024, swz = sb ^ (((sb >> 9) & 1) << 5); R = (st >> 1) * 16 + swz / 64; C = (st & 1) * 32 + (swz % 64) / 2; }
#define G2_HT 8192
template <int lda, int ldb, int K, class FR, class FE>
__device__ __forceinline__ void gemm256(const bfu* Abase, FR arow, const bfu* B0, const bfu* B1, FE epi, char* shmc, int wsid_) {
    bfu* shm = (bfu*)shmc;
#define G2_SA(b, h) (shm + ((b) * 2 + (h)) * G2_HT)
#define G2_SB(b, h) (shm + (4 + (b) * 2 + (h)) * G2_HT)
    int tx = TID512; asm volatile("" : "+v"(tx));
    int sR, sC; stage_rc256(tx * 16, sR, sC);
    const int ra00 = arow(sR), ra01 = arow(sR + 64), ra10 = arow(128 + sR), ra11 = arow(128 + sR + 64);
#define G2_STAGE_A(P, h, kt) { int r0_ = (h) ? ra10 : ra00, r1_ = (h) ? ra11 : ra01; asm volatile("" : "+v"(r0_), "+v"(r1_)); const size_t ko_ = (size_t)(kt) * 64 + sC; \
        GLDS(Abase + (size_t)r0_ * lda + ko_, (char*)(P) + tx * 16); GLDS(Abase + (size_t)r1_ * lda + ko_, (char*)(P) + tx * 16 + 8192); }
#define G2_STAGE_B(P, h, kt) { int o_ = sR * ldb + sC; asm volatile("" : "+v"(o_)); const bfu* b_ = ((h) ? B1 : B0) + (size_t)(kt) * 64 + o_; GLDS(b_, (char*)(P) + tx * 16); GLDS(b_ + 64 * ldb, (char*)(P) + tx * 16 + 8192); }
    int wid = tx >> 6, lane = tx & 63, wr = wid >> 2, wc = wid & 3, fr = lane & 15, fq = lane >> 4;
#define G2_LDA(dst, b, h) _Pragma("unroll") for (int m = 0; m < 4; ++m) _Pragma("unroll") for (int k = 0; k < 2; ++k) \
        dst[m][k] = *(const bf16x8*)((const char*)G2_SA(b, h) + lds_byte256(wr * 64 + m * 16 + fr, k * 32 + fq * 8))
#define G2_LDB(dst, b, h) _Pragma("unroll") for (int n = 0; n < 2; ++n) _Pragma("unroll") for (int k = 0; k < 2; ++k) \
        dst[n][k] = *(const bf16x8*)((const char*)G2_SB(b, h) + lds_byte256(wc * 32 + n * 16 + fr, k * 32 + fq * 8))
#define G2_MMA(ai, bj, At_, Bt_) { __builtin_amdgcn_s_setprio(1); \
        _Pragma("unroll") for (int m = 0; m < 4; ++m) _Pragma("unroll") for (int n = 0; n < 2; ++n) _Pragma("unroll") for (int k = 0; k < 2; ++k) \
            acc[ai][bj][m][n] = __builtin_amdgcn_mfma_f32_16x16x32_bf16(At_[m][k], Bt_[n][k], acc[ai][bj][m][n], 0, 0, 0); \
        __builtin_amdgcn_s_setprio(0); }
#define G2_WV(n) asm volatile("s_waitcnt vmcnt(" #n ")" ::: "memory")
#define G2_WL(n) asm volatile("s_waitcnt lgkmcnt(" #n ")" ::: "memory")
#define G2_BAR __builtin_amdgcn_s_barrier()
#define G2_SCHED __builtin_amdgcn_sched_barrier(0)
    f32x4 acc[2][2][4][2];
#pragma unroll
    for (int a = 0; a < 2; ++a)
#pragma unroll
        for (int b = 0; b < 2; ++b)
#pragma unroll
            for (int m = 0; m < 4; ++m)
#pragma unroll
                for (int n = 0; n < 2; ++n) acc[a][b][m][n] = (f32x4){0.f, 0.f, 0.f, 0.f};
    bf16x8 At[4][2], Bx0[2][2], Bx1[2][2];
    constexpr int nt = K >> 6;
    __syncthreads();
    G2_STAGE_B(G2_SB(0, 0), 0, 0); G2_STAGE_A(G2_SA(0, 0), 0, 0); G2_STAGE_B(G2_SB(0, 1), 1, 0); G2_STAGE_A(G2_SA(0, 1), 1, 0);
    if (wr == 1) G2_BAR;
    G2_WV(4); G2_BAR;
    G2_STAGE_B(G2_SB(1, 0), 0, 1); G2_STAGE_A(G2_SA(1, 0), 0, 1); G2_STAGE_B(G2_SB(1, 1), 1, 1);
    G2_WV(6); G2_BAR;
    for (int t = 0; t < nt - 2; t += 2) {
        G2_LDB(Bx0, 0, 0); G2_SCHED; G2_LDA(At, 0, 0); G2_STAGE_A(G2_SA(1, 1), 1, t + 1);
        G2_WL(8); G2_BAR; G2_WL(0); G2_MMA(0, 0, At, Bx0); G2_BAR; G2_SCHED;
        G2_LDB(Bx1, 0, 1); G2_STAGE_B(G2_SB(0, 0), 0, t + 2);
        G2_BAR; G2_WL(0); G2_MMA(0, 1, At, Bx1); G2_BAR;
        G2_LDA(At, 0, 1); G2_STAGE_A(G2_SA(0, 0), 0, t + 2);
        G2_BAR; G2_WL(0); G2_MMA(1, 0, At, Bx0); G2_BAR; G2_SCHED;
        G2_STAGE_B(G2_SB(0, 1), 1, t + 2);
        G2_WV(6); G2_BAR; G2_MMA(1, 1, At, Bx1); G2_BAR;
        G2_LDB(Bx0, 1, 0); G2_SCHED; G2_LDA(At, 1, 0); G2_STAGE_A(G2_SA(0, 1), 1, t + 2);
        G2_WL(8); G2_BAR; G2_WL(0); G2_MMA(0, 0, At, Bx0); G2_BAR; G2_SCHED;
        G2_LDB(Bx1, 1, 1); G2_STAGE_B(G2_SB(1, 0), 0, t + 3);
        G2_BAR; G2_WL(0); G2_MMA(0, 1, At, Bx1); G2_BAR;
        G2_LDA(At, 1, 1); G2_STAGE_A(G2_SA(1, 0), 0, t + 3);
        G2_BAR; G2_WL(0); G2_MMA(1, 0, At, Bx0); G2_BAR; G2_SCHED;
        G2_STAGE_B(G2_SB(1, 1), 1, t + 3);
        G2_WV(6); G2_BAR; G2_MMA(1, 1, At, Bx1); G2_BAR;
    }
    tx = TID512; asm volatile("" : "+v"(tx)); stage_rc256(tx * 16, sR, sC); wid = tx >> 6; lane = tx & 63; wr = wid >> 2; wc = wid & 3; fr = lane & 15; fq = lane >> 4;
    { G2_LDB(Bx0, 0, 0); G2_WV(0); G2_LDA(At, 0, 0); G2_STAGE_A(G2_SA(1, 1), 1, nt - 1);
      G2_BAR; G2_WL(0); G2_MMA(0, 0, At, Bx0); G2_BAR;
      G2_LDB(Bx1, 0, 1); G2_BAR; G2_WL(0); G2_MMA(0, 1, At, Bx1); G2_BAR;
      G2_LDA(At, 0, 1); G2_WV(4); G2_BAR; G2_WL(0); G2_MMA(1, 0, At, Bx0); G2_MMA(1, 1, At, Bx1); G2_BAR; }
    { G2_LDB(Bx0, 1, 0); G2_LDA(At, 1, 0); G2_WV(2); G2_BAR; G2_WL(0); G2_MMA(0, 0, At, Bx0); G2_BAR;
      G2_LDB(Bx1, 1, 1); G2_WV(0); G2_BAR; G2_WL(0); G2_MMA(0, 1, At, Bx1); G2_BAR;
      G2_LDA(At, 1, 1); G2_BAR; G2_WL(0); G2_MMA(1, 0, At, Bx0); G2_MMA(1, 1, At, Bx1); G2_BAR; }
    if (wr == 0) G2_BAR;
    __syncthreads();
    epi(acc, wr, wc, fr, fq);
}

__device__ __forceinline__ void inproj_post(KP p, int wsid_, char* ws_, int layer, int row0, int nt, const float* Cs, int tid_) {
    const float* TA = (const float*)(ws_ + WS_ROPE); const float* TB = TA + 64 * 16 * 2;
    const int tid = tid_;
    int b, j0, s; row_info(row0, b, j0, s);
    const bool lat = row0 < ML;
    if (nt <= 2) {
        const int r = tid & 127, hl = tid >> 7;
        const bool isq = nt < 2;
        const float* gain = (isq ? p.a_q_gain : p.a_k_gain) + layer * 64;
        float ss = 0.f;
#pragma unroll
        for (int d4 = 0; d4 < 16; ++d4) { const float4 t4 = *(const float4*)(Cs + r * 132 + hl * 64 + d4 * 4); ss += t4.x * t4.x + t4.y * t4.y + t4.z * t4.z + t4.w * t4.w; }
        const float rs = rsqrtf(ss * (1.f / 64.f) + 1e-6f);
        const float qs = isq ? 0.125f * LOG2E : 1.f;
        bfu* dst = isq ? (bfu*)(ws_ + WS_QA) + (((size_t)b * 4 + (nt * 2 + hl)) * NKEY + j0 + r) * 64
                       : (bfu*)(ws_ + WS_KA) + (((size_t)b * 2 + hl) * NKEY + j0 + r) * 64;
        const int t = (j0 - 256) + r;
#pragma unroll 1
        for (int a = 0; a < 2; ++a) {
            float v[32];
#pragma unroll
            for (int d4 = 0; d4 < 8; ++d4) {
                const float4 t4 = *(const float4*)(Cs + r * 132 + hl * 64 + a * 32 + d4 * 4); const float4 g4 = *(const float4*)(gain + a * 32 + d4 * 4);
                v[d4 * 4] = t4.x * rs * g4.x; v[d4 * 4 + 1] = t4.y * rs * g4.y; v[d4 * 4 + 2] = t4.z * rs * g4.z; v[d4 * 4 + 3] = t4.w * rs * g4.w;
            }
            if (lat) {
                const int pos = a == 0 ? (t >> 6) : (t & 63);
#pragma unroll
                for (int f = 0; f < 16; ++f) {
                    const float cs = TA[(pos * 16 + f) * 2], sn = TA[(pos * 16 + f) * 2 + 1];
                    const float x0 = v[f], x1 = v[16 + f];
                    v[f] = x0 * cs - x1 * sn; v[16 + f] = x1 * cs + x0 * sn;
                }
            }
#pragma unroll
            for (int d8 = 0; d8 < 4; ++d8)
                ((uint4*)dst)[a * 4 + d8] = make_uint4(pack2(v[d8 * 8] * qs, v[d8 * 8 + 1] * qs), pack2(v[d8 * 8 + 2] * qs, v[d8 * 8 + 3] * qs),
                                                       pack2(v[d8 * 8 + 4] * qs, v[d8 * 8 + 5] * qs), pack2(v[d8 * 8 + 6] * qs, v[d8 * 8 + 7] * qs));
        }
    } else if (nt == 3 || nt == 8 || nt == 9) {
        const int c = tid & 127, half = tid >> 7, hl = c >> 6, d = c & 63;
        bfu* dst = nt == 3 ? (bfu*)(ws_ + WS_VAT) + (((size_t)b * 2 + hl) * 64 + d) * NKEY + j0 + half * 64
                           : (bfu*)(ws_ + WS_VBT) + (((size_t)b * 4 + ((nt - 8) * 2 + hl)) * 64 + d) * NKEY + j0 + half * 64;
#pragma unroll
        for (int r8 = 0; r8 < 8; ++r8) {
            const float* s0 = Cs + (half * 64 + r8 * 8) * 132 + c;
            ((uint4*)dst)[r8] = make_uint4(pack2(s0[0], s0[132]), pack2(s0[2 * 132], s0[3 * 132]), pack2(s0[4 * 132], s0[5 * 132]), pack2(s0[6 * 132], s0[7 * 132]));
        }
    } else if (nt <= 7) {
        const bool isq = nt < 6;
        const int hbase = ((nt - 4) & 1) * 2;
#pragma unroll
        for (int itq = 0; itq < 2; ++itq) {
            const int u = tid + 256 * itq, r = u & 127, hm = u >> 7;
            float v[32];
#pragma unroll
            for (int d4 = 0; d4 < 8; ++d4) { const float4 t4 = *(const float4*)(Cs + r * 132 + hm * 32 + d4 * 4); v[d4 * 4] = t4.x; v[d4 * 4 + 1] = t4.y; v[d4 * 4 + 2] = t4.z; v[d4 * 4 + 3] = t4.w; }
            if (lat) {
                const int t = (j0 - 256) + r;
#pragma unroll
                for (int a = 0; a < 2; ++a) {
                    const int pos = a == 0 ? (t >> 6) : (t & 63);
#pragma unroll
                    for (int f = 0; f < 8; ++f) {
                        const float cs = TB[(pos * 8 + f) * 2], sn = TB[(pos * 8 + f) * 2 + 1];
                        const float x0 = v[a * 16 + f], x1 = v[a * 16 + 8 + f];
                        v[a * 16 + f] = x0 * cs - x1 * sn; v[a * 16 + 8 + f] = x1 * cs + x0 * sn;
                    }
                }
            }
            const float qs = isq ? 0.17677669529663687f * LOG2E : 1.f;
            const int h = hbase + (hm >> 1), mp = hm & 1;
            bfu* dst = (bfu*)(ws_ + (isq ? WS_QB : WS_KB)) + (((size_t)b * 4 + h) * NKEY + j0 + r) * 64 + mp * 32;
#pragma unroll
            for (int d8 = 0; d8 < 4; ++d8)
                ((uint4*)dst)[d8] = make_uint4(pack2(v[d8 * 8] * qs, v[d8 * 8 + 1] * qs), pack2(v[d8 * 8 + 2] * qs, v[d8 * 8 + 3] * qs),
                                               pack2(v[d8 * 8 + 4] * qs, v[d8 * 8 + 5] * qs), pack2(v[d8 * 8 + 6] * qs, v[d8 * 8 + 7] * qs));
        }
    } else {
        const int r = tid & 127, half = tid >> 7;
        float* dst = (float*)(ws_ + WS_CP) + (size_t)(row0 + r) * CSL + (nt - 10) * 128 + half * 64;
#pragma unroll
        for (int d4 = 0; d4 < 16; ++d4) ((float4*)dst)[d4] = *(const float4*)(Cs + r * 132 + half * 64 + d4 * 4);
    }
}

__device__ void phase_inproj256(KP p, int wsid_, int layer, int vblk, int nblk, char* smem_all) {
    PHASE_PROLOGUE
    const bfu* H = (const bfu*)(ws_ + WS_H); const bfu* W = (const bfu*)(ws_ + WS_WIN);
    for (int it = vblk; it < 72 * 13; it += nblk) {
        const int mt = (it / 104) * 8 + (it & 7), nt2 = (it >> 3) % 13;
        const int row0 = mt * 256, col0 = nt2 * 256;
        const bfu* B0 = W + (size_t)col0 * DM; const bfu* B1 = (nt2 == 12) ? B0 : B0 + (size_t)128 * DM;
        gemm256<DM, DM, DM>(H, [&](int r) { return row0 + r; }, B0, B1,
            [&](f32x4 (&acc)[2][2][4][2], int wr, int wc, int fr, int fq) {
                if (nt2 >= 5) {
                    const __amdgpu_buffer_rsrc_t rs = __builtin_amdgcn_make_buffer_rsrc((void*)(ws_ + WS_CP), 0, (int)((size_t)MA * CSL * 4), 0x00020000);
                    const int voff = (((wr * 64 + fq * 4) * CSL) + wc * 32 + fr) * 4;
#pragma unroll
                    for (int bj = 0; bj < 2; ++bj) {
                        const int cb = col0 + bj * 128 - 1280;
                        if (cb < CSL) {
#pragma unroll
                            for (int ai = 0; ai < 2; ++ai)
#pragma unroll
                                for (int m = 0; m < 4; ++m)
#pragma unroll
                                    for (int n = 0; n < 2; ++n)
#pragma unroll
                                        for (int j = 0; j < 4; ++j)
                                            __builtin_amdgcn_raw_buffer_store_b32(__float_as_uint(acc[ai][bj][m][n][j]), rs, voff, ((row0 + ai * 128 + m * 16 + j) * CSL + cb + n * 16) * 4, 0);
                        }
                    }
                } else {
                    float* SC = (float*)(ws_ + WS_SCR) + (size_t)blockIdx.x * (2 * 128 * 132);
                    const __amdgpu_buffer_rsrc_t rs = __builtin_amdgcn_make_buffer_rsrc((void*)SC, 0, 2 * 128 * 132 * 4, 0x00020000);
                    const int o0 = (wr * 64 + fq * 4) * 132 + wc * 32 + fr;
#pragma unroll
                    for (int bj = 0; bj < 2; ++bj) {
                        float* Cq = (float*)(smem_all + bj * SMEM_BYTES) + o0;
#pragma unroll
                        for (int m = 0; m < 4; ++m)
#pragma unroll
                            for (int n = 0; n < 2; ++n)
#pragma unroll
                                for (int j = 0; j < 4; ++j) {
                                    Cq[(m * 16 + j) * 132 + n * 16] = acc[0][bj][m][n][j];
                                    __builtin_amdgcn_raw_buffer_store_b32(__float_as_uint(acc[1][bj][m][n][j]), rs, o0 * 4, (bj * 128 * 132 + (m * 16 + j) * 132 + n * 16) * 4, 0);
                                }
                    }
                    __syncthreads();
                    int t2 = TID512 & 255; asm volatile("" : "+v"(t2));
                    float* Ch = (float*)(smem_all + hb_ * SMEM_BYTES);
                    inproj_post(p, wsid_, ws_, layer, row0, nt2 * 2 + hb_, Ch, t2);
                    __syncthreads();
                    { const float4* g4 = (const float4*)(SC + hb_ * (128 * 132)); float4* c4 = (float4*)Ch;
                      for (int i = t2; i < 128 * 132 / 4; i += 256) c4[i] = g4[i]; }
                    __syncthreads();
                    inproj_post(p, wsid_, ws_, layer, row0 + 128, nt2 * 2 + hb_, Ch, t2);
                    __syncthreads();
                }
            }, smem_all, wsid_);
    }
}

__device__ void phase_inproj(KP p, int wsid_, int layer, int bid, int nb, char* smem) {
    PHASE_PROLOGUE
    const bfu* H = (const bfu*)(ws_ + WS_H); const bfu* W = (const bfu*)(ws_ + WS_WIN);
    float* Cs = (float*)smem;
    const int nitems = 144 * 25;
    for (int it = bid; it < nitems; it += nb) {
        const int mt = (it / 200) * 8 + (it / 5) % 8, nt = ((it / 40) % 5) * 5 + it % 5;
        const int row0 = mt * 128, col0 = nt * 128;
        gemm_tile([&](int r) { return H + (size_t)(row0 + r) * DM; }, [&](int r) { return W + (size_t)(col0 + r) * DM; }, DM,
            [&](f32x4 (&acc)[4][4], int wr, int wc, int fr, int fq) {
                ACC_FOREACH(Cs[row * 132 + col] = val;)
            }, smem, wsid_);
        __syncthreads();
        inproj_post(p, wsid_, ws_, layer, row0, nt, Cs, tid_);
        __syncthreads();
    }
}

__device__ void phase_gate(KP p, int wsid_, int layer, int bid, int nb, char* smem) {
    PHASE_PROLOGUE
    const bfu* LXG = (const bfu*)(ws_ + WS_LXG); const bfu* Bt = (const bfu*)(ws_ + WS_LG2);
    float* GG = (float*)(ws_ + WS_GG);
    const int nitems = 144 * 4;
    for (int it = bid; it < nitems; it += nb) {
        const int mt = it >> 2, nt = it & 3, row0 = mt * 128, col0 = nt * 128;
        gemm_tile([&](int r) { return LXG + (size_t)(row0 + r) * 128; }, [&](int r) { return Bt + (size_t)(col0 + r) * 128; }, 128,
            [&](f32x4 (&acc)[4][4], int wr, int wc, int fr, int fq) {
                ACC_FOREACH(GG[(size_t)(row0 + row) * 512 + col0 + col] = val;)
            }, smem, wsid_);
    }
}

#define OPS_AT 0
#define OPS_RT 2048
#define OPS_MAK 4096
#define OPS_T 5120
#define OPS_MRBK 6144
#define OPS_BK 7168
#define OPS_VF 11264
#define OPS_WC 13312
__device__ __forceinline__ char* ops_rec(char* ws_, int z, int seq, int c) { return ws_ + WS_OPS + ((size_t)(z * 64 + seq) * 144 + c) * OPS_REC; }
__device__ __forceinline__ float rdlane(float v, int l) { return __int_as_float(__builtin_amdgcn_readlane(__float_as_int(v), l)); }

__device__ __forceinline__ void chunk_tail(const float (&lw)[16], const float (&kk)[16], const float (&rr)[16], const float (&bb)[16], const float (&kd)[16], const float (&vv)[16],
                                           char* Lw, char* rec, int lane) {
    const int cl = lane & 15, g = lane >> 4;
    float Bt[16], Kt[16];
    float cum = 0.f, ep = 1.f;
#pragma unroll
    for (int t = 0; t < 16; ++t) {
        cum += lw[t];
        const float e = __expf(cum), ei = __expf(-cum);
        *(bfu*)(Lw + 0 + t * 128 + lane * 2) = f2bf(-kk[t] * ep);
        *(bfu*)(Lw + 2048 + t * 128 + lane * 2) = f2bf(rr[t] * e);
        Bt[t] = bb[t] * ei; Kt[t] = kd[t] * ei;
        *(bfu*)(Lw + 4096 + t * 128 + lane * 2) = f2bf(Bt[t]);
        *(bfu*)(Lw + 6144 + t * 128 + lane * 2) = f2bf(Kt[t]);
        ep = e;
    }
    const float eC = ep;
#pragma unroll
    for (int q = 0; q < 4; ++q) {
        *(uint4*)(rec + OPS_BK + ((lane >> 4) * 64 + cl + 16 * q) * 16) =
            make_uint4(pack2(Bt[4 * q] * eC, Bt[4 * q + 1] * eC), pack2(Bt[4 * q + 2] * eC, Bt[4 * q + 3] * eC), pack2(Kt[4 * q] * eC, Kt[4 * q + 1] * eC), pack2(Kt[4 * q + 2] * eC, Kt[4 * q + 3] * eC));
        *(uint2*)(rec + OPS_VF + ((lane >> 4) * 64 + cl + 16 * q) * 8) = make_uint2(pack2(vv[4 * q], vv[4 * q + 1]), pack2(vv[4 * q + 2], vv[4 * q + 3]));
    }
    *(float*)(rec + OPS_WC + lane * 4) = eC;
    f32x4 Mab = {0.f, 0.f, 0.f, 0.f}, Mak = Mab, Mrb = Mab, Mrk = Mab;
#pragma unroll
    for (int ks = 0; ks < 2; ++ks) {
        const int fo = cl * 128 + ks * 64 + g * 16;
        const bf16x8 aA = *(const bf16x8*)(Lw + 0 + fo), aR = *(const bf16x8*)(Lw + 2048 + fo), bB = *(const bf16x8*)(Lw + 4096 + fo), bK = *(const bf16x8*)(Lw + 6144 + fo);
        Mab = __builtin_amdgcn_mfma_f32_16x16x32_bf16(aA, bB, Mab, 0, 0, 0);
        Mak = __builtin_amdgcn_mfma_f32_16x16x32_bf16(aA, bK, Mak, 0, 0, 0);
        Mrb = __builtin_amdgcn_mfma_f32_16x16x32_bf16(aR, bB, Mrb, 0, 0, 0);
        Mrk = __builtin_amdgcn_mfma_f32_16x16x32_bf16(aR, bK, Mrk, 0, 0, 0);
    }
#pragma unroll
    for (int ks = 0; ks < 2; ++ks) {
        const uint2 a0 = *(const uint2*)(Lw + 0 + cl * 128 + (32 * ks + 4 * g) * 2), a1 = *(const uint2*)(Lw + 0 + cl * 128 + (32 * ks + 16 + 4 * g) * 2);
        const uint2 r0 = *(const uint2*)(Lw + 2048 + cl * 128 + (32 * ks + 4 * g) * 2), r1 = *(const uint2*)(Lw + 2048 + cl * 128 + (32 * ks + 16 + 4 * g) * 2);
        *(uint4*)(rec + OPS_AT + (ks * 64 + lane) * 16) = make_uint4(a0.x, a0.y, a1.x, a1.y);
        *(uint4*)(rec + OPS_RT + (ks * 64 + lane) * 16) = make_uint4(r0.x, r0.y, r1.x, r1.y);
    }
#pragma unroll
    for (int q = 0; q < 4; ++q) {
        const int tau = 4 * g + q;
        if (!(cl < tau)) { Mab[q] = 0.f; Mak[q] = 0.f; }
        if (!(cl <= tau)) { Mrb[q] = 0.f; Mrk[q] = 0.f; }
    }
#pragma unroll
    for (int q = 0; q < 4; ++q) *(float*)(Lw + 10240 + (4 * g + q) * 64 + cl * 4) = Mab[q];
    float Tc[16];
#pragma unroll
    for (int t = 0; t < 16; ++t) {
        float acc = (t == cl) ? 1.f : 0.f;
#pragma unroll
        for (int j4 = 0; j4 < (t + 3) / 4; ++j4) {
            const float4 mr = *(const float4*)(Lw + 10240 + t * 64 + j4 * 16);
            const float mm[4] = {mr.x, mr.y, mr.z, mr.w};
#pragma unroll
            for (int e = 0; e < 4; ++e) if (j4 * 4 + e < t) acc += mm[e] * Tc[j4 * 4 + e];
        }
        Tc[t] = acc;
    }
#pragma unroll
    for (int q = 0; q < 4; ++q) {
        const int tau = 4 * g + q;
        *(bfu*)(Lw + 8192 + tau * 32 + cl * 2) = f2bf(Mak[q]);
        *(bfu*)(Lw + 9216 + tau * 32 + cl * 2) = f2bf(Mrb[q]);
        *(bfu*)(Lw + 9728 + tau * 32 + cl * 2) = f2bf(Mrk[q]);
    }
    if (g == 0) {
#pragma unroll
        for (int t = 0; t < 16; ++t) *(bfu*)(Lw + 8704 + t * 32 + cl * 2) = f2bf(Tc[t]);
    }
    const uint2 fmak = *(const uint2*)(Lw + 8192 + cl * 32 + g * 8), ft = *(const uint2*)(Lw + 8704 + cl * 32 + g * 8);
    const uint2 fmrb = *(const uint2*)(Lw + 9216 + cl * 32 + g * 8), fmrk = *(const uint2*)(Lw + 9728 + cl * 32 + g * 8);
    *(uint4*)(rec + OPS_MAK + lane * 16) = make_uint4(fmak.x, fmak.y, 0u, 0u);
    *(uint4*)(rec + OPS_T + lane * 16) = make_uint4(ft.x, ft.y, 0u, 0u);
    *(uint4*)(rec + OPS_MRBK + lane * 16) = make_uint4(fmrb.x, fmrb.y, fmrk.x, fmrk.y);
}

__device__ void phase_rk(KP p, int wsid_, int layer, int bid, int nb, char* smem) {
    PHASE_PROLOGUE
    const int lane = tid_ & 63, wv = tid_ >> 6, cl = lane & 15, g = lane >> 4;
    char* Lw = smem + wv * 16384;
    const float* CP = (const float*)(ws_ + WS_CP);
    const float* mu = p.c_mu + layer * CSL;
    for (int it = bid * 4 + wv; it < 2 * 64 * 144; it += nb * 4) {
        const int c = it % 144, seq = (it / 144) & 63, z = it / (144 * 64), b = seq >> 3, h = seq & 7;
        const int grow0 = c < 16 ? ML + b * 256 + 16 * c : b * 2048 + 16 * (c - 16);
        const bool sstart = (c == 0 || c == 16), send = (c == 15 || c == 143);
        auto ldgrp = [&](int col, float (&P_)[18]) {
#pragma unroll
            for (int q = 0; q < 18; ++q) {
                const int tau = q - 1, nat = z ? 15 - tau : tau;
                const bool ok = (nat >= 0 || !sstart) && (nat <= 15 || !send);
                P_[q] = ok ? CP[(size_t)(grow0 + nat) * CSL + col] : 0.f;
            }
        };
        auto shiftg = [&](int col, const float (&P_)[18], float (&out)[16]) {
            const float m = mu[col];
#pragma unroll
            for (int t = 0; t < 16; ++t) out[t] = P_[t + 1] + m * (0.5f * (P_[t] + P_[t + 2]) - P_[t + 1]);
        };
        float Pw[18], Pa[18], Pr[18], Pk[18], Pv[18];
        ldgrp(1536 + z * 64 + lane, Pw); ldgrp(1664 + z * 64 + lane, Pa); ldgrp(h * 64 + lane, Pr); ldgrp(512 + h * 64 + lane, Pk); ldgrp(1024 + h * 64 + lane, Pv);
        float tmp[16], rr[16], kr[16], vv[16];
        shiftg(1536 + z * 64 + lane, Pw, tmp);
#pragma unroll
        for (int t = 0; t < 16; ++t) *(bfu*)(Lw + 10240 + t * 128 + lane * 2) = f2bf(1.f - 2.f * __builtin_amdgcn_rcpf(1.f + __expf(2.f * tmp[t])));
        shiftg(1664 + z * 64 + lane, Pa, tmp);
#pragma unroll
        for (int t = 0; t < 16; ++t) *(bfu*)(Lw + 12288 + t * 128 + lane * 2) = f2bf(tmp[t]);
        if (z == 0 && lane < 16) {
            float Pg[18]; ldgrp(1792 + h * 16 + lane, Pg); shiftg(1792 + h * 16 + lane, Pg, tmp);
            bfu* LXG = (bfu*)(ws_ + WS_LXG);
#pragma unroll
            for (int t = 0; t < 16; ++t) LXG[(size_t)(grow0 + t) * 128 + h * 16 + lane] = f2bf(sigmoidf_(tmp[t]));
        }
        shiftg(h * 64 + lane, Pr, rr);
        shiftg(512 + h * 64 + lane, Pk, kr);
        shiftg(1024 + h * 64 + lane, Pv, vv);
        const bfu* W2 = (const bfu*)(ws_ + WS_LW2) + ((size_t)z * 512 + h * 64) * 64;
        const bfu* A2 = (const bfu*)(ws_ + WS_LA2) + ((size_t)z * 512 + h * 64) * 64;
        float prew[16], prea[16];
#pragma unroll
        for (int which = 0; which < 2; ++which) {
            const bfu* Wm = which ? A2 : W2; const char* Xs = Lw + (which ? 12288 : 10240);
            f32x4 ac[4];
#pragma unroll
            for (int n = 0; n < 4; ++n) ac[n] = (f32x4){0.f, 0.f, 0.f, 0.f};
#pragma unroll
            for (int ks = 0; ks < 2; ++ks) {
                const bf16x8 af = *(const bf16x8*)(Xs + cl * 128 + ks * 64 + g * 16);
#pragma unroll
                for (int n = 0; n < 4; ++n) {
                    const bf16x8 bf = *(const bf16x8*)(Wm + (size_t)(16 * n + cl) * 64 + ks * 32 + g * 8);
                    ac[n] = __builtin_amdgcn_mfma_f32_16x16x32_bf16(af, bf, ac[n], 0, 0, 0);
                }
            }
#pragma unroll
            for (int n = 0; n < 4; ++n)
#pragma unroll
                for (int q = 0; q < 4; ++q) *(float*)(Lw + (4 * g + q) * 256 + (16 * n + cl) * 4) = ac[n][q];
#pragma unroll
            for (int t = 0; t < 16; ++t) { const float x = *(const float*)(Lw + t * 256 + lane * 4); if (which) prea[t] = x; else prew[t] = x; }
        }
        const int ch = h * 64 + lane;
        const float w0v = p.c_w0[((size_t)layer * 2 + z) * 512 + ch], a0v = p.c_a0[((size_t)layer * 2 + z) * 512 + ch];
        const float kkv = p.c_k_k[layer * 512 + ch], kav = p.c_k_a[layer * 512 + ch], rkv = p.c_r_k[layer * 512 + ch];
        float lw[16], kk[16], bb[16];
        float* BETA = (float*)(ws_ + WS_BETA) + (size_t)z * MA * 8;
#pragma unroll
        for (int t = 0; t < 16; ++t) {
            const float nx = -(w0v + prew[t]);
            const float sp = nx > 20.f ? nx : __logf(1.f + __expf(nx));
            lw[t] = -__expf(-sp - 0.5f);
            const float icl = sigmoidf_(a0v + prea[t]);
            const float kv = kr[t] * kkv;
            const float ss = sum64(kv * kv);
            kk[t] = kv * rsqrtf(fmaxf(ss, 1e-24f));
            kr[t] = kr[t] * (1.f + (icl - 1.f) * kav);
            bb[t] = kk[t] * icl;
            const float bs = sum64(rr[t] * kr[t] * rkv);
            const int nat = z ? 15 - t : t;
            if (lane == 0) BETA[(size_t)(grow0 + nat) * 8 + h] = bs;
        }
        if (z == 0) {
            bfu* VB = (bfu*)(ws_ + WS_VB);
#pragma unroll
            for (int t = 0; t < 16; ++t) VB[(size_t)(grow0 + t) * 512 + ch] = f2bf(vv[t]);
        }
        chunk_tail(lw, kk, rr, bb, kr, vv, Lw, ops_rec(ws_, z, seq, c), lane);
    }
}

__device__ __forceinline__ bf16x8 mk8(unsigned a, unsigned b, unsigned c, unsigned d) { union { bf16x8 v; unsigned u[4]; } x; x.u[0] = a; x.u[1] = b; x.u[2] = c; x.u[3] = d; return x.v; }
__device__ __forceinline__ bf16x8 ld8(const char* p) { return *(const bf16x8*)p; }
__device__ __forceinline__ void glds16_asm(const void* gsrc, unsigned lds_dst) {
    unsigned keep;
    asm volatile("s_mov_b32 %0, m0\n\ts_mov_b32 m0, %2\n\ts_nop 0\n\tglobal_load_lds_dwordx4 %1, off\n\ts_mov_b32 m0, %0" : "=&s"(keep) : "v"(gsrc), "s"(lds_dst) : "memory");
}
__device__ void phase_r4(KP p, int wsid_, int layer, int bid, int nb, char* smem) {
    PHASE_PROLOGUE
    const int lane = tid_ & 63, vt = tid_ >> 6, cl = lane & 15, g = lane >> 4;
    for (int it = bid; it < 128; it += nb) {
        const int z = it >> 6, seq = it & 63;
        float* Y = (float*)(ws_ + WS_YS) + (size_t)z * (HEADARR / 4) + (size_t)seq * NKEY * 64;
        const char* recs = ws_ + WS_OPS + (size_t)(z * 64 + seq) * 144 * OPS_REC;
        f32x4 acc[4];
#pragma unroll
        for (int kt = 0; kt < 4; ++kt) acc[kt] = (f32x4){0.f, 0.f, 0.f, 0.f};
        const unsigned lbase = __builtin_amdgcn_readfirstlane((unsigned)(uintptr_t)(__attribute__((address_space(3))) char*)smem + vt * 1024);
#define R4_ISSUE(ci_) { const int c_ = z ? ((ci_) < 16 ? 15 - (ci_) : 143 - ((ci_) - 16)) : (ci_); const char* g_ = recs + (size_t)c_ * OPS_REC + tid_ * 16; const unsigned d_ = lbase + ((ci_) & 3) * OPS_REC; \
            glds16_asm(g_, d_); glds16_asm(g_ + 4096, d_ + 4096); glds16_asm(g_ + 8192, d_ + 8192); if (tid_ < 80) glds16_asm(g_ + 12288, d_ + 12288); }
        __syncthreads();
        R4_ISSUE(0) R4_ISSUE(1) R4_ISSUE(2)
        for (int ci = 0; ci < 144; ++ci) {
            const int c = z ? (ci < 16 ? 15 - ci : 143 - (ci - 16)) : ci;
            if (ci >= 3 && ci <= 141) { if (vt < 2) asm volatile("s_waitcnt vmcnt(20)" ::: "memory"); else asm volatile("s_waitcnt vmcnt(18)" ::: "memory"); }
            else asm volatile("s_waitcnt vmcnt(0)" ::: "memory");
            __builtin_amdgcn_s_barrier();
            if (ci + 3 < 144) R4_ISSUE(ci + 3)
            const char* rec = smem + (ci & 3) * OPS_REC;
            const f32x4 zero4 = {0.f, 0.f, 0.f, 0.f};
            bf16x8 sb[2];
#pragma unroll
            for (int ks = 0; ks < 2; ++ks)
                sb[ks] = mk8(pack2(acc[2 * ks][0], acc[2 * ks][1]), pack2(acc[2 * ks][2], acc[2 * ks][3]), pack2(acc[2 * ks + 1][0], acc[2 * ks + 1][1]), pack2(acc[2 * ks + 1][2], acc[2 * ks + 1][3]));
            const uint2 vf = *(const uint2*)(rec + OPS_VF + (vt * 64 + lane) * 8);
            f32x4 Z = __builtin_amdgcn_mfma_f32_16x16x32_bf16(ld8(rec + OPS_AT + lane * 16), sb[0], zero4, 0, 0, 0);
            Z = __builtin_amdgcn_mfma_f32_16x16x32_bf16(ld8(rec + OPS_AT + (64 + lane) * 16), sb[1], Z, 0, 0, 0);
            Z = __builtin_amdgcn_mfma_f32_16x16x32_bf16(ld8(rec + OPS_MAK + lane * 16), mk8(vf.x, vf.y, 0u, 0u), Z, 0, 0, 0);
            f32x4 Yv = __builtin_amdgcn_mfma_f32_16x16x32_bf16(ld8(rec + OPS_RT + lane * 16), sb[0], zero4, 0, 0, 0);
            Yv = __builtin_amdgcn_mfma_f32_16x16x32_bf16(ld8(rec + OPS_RT + (64 + lane) * 16), sb[1], Yv, 0, 0, 0);
            const f32x4 U = __builtin_amdgcn_mfma_f32_16x16x32_bf16(ld8(rec + OPS_T + lane * 16), mk8(pack2(Z[0], Z[1]), pack2(Z[2], Z[3]), 0u, 0u), zero4, 0, 0, 0);
            const bf16x8 ub = mk8(pack2(U[0], U[1]), pack2(U[2], U[3]), vf.x, vf.y);
            Yv = __builtin_amdgcn_mfma_f32_16x16x32_bf16(ld8(rec + OPS_MRBK + lane * 16), ub, Yv, 0, 0, 0);
#pragma unroll
            for (int kt = 0; kt < 4; ++kt) {
                const float4 wc = *(const float4*)(rec + OPS_WC + (16 * kt + 4 * g) * 4);
                f32x4 a = acc[kt];
                a[0] *= wc.x; a[1] *= wc.y; a[2] *= wc.z; a[3] *= wc.w;
                acc[kt] = __builtin_amdgcn_mfma_f32_16x16x32_bf16(ld8(rec + OPS_BK + (kt * 64 + lane) * 16), ub, a, 0, 0, 0);
            }
#pragma unroll
            for (int q = 0; q < 4; ++q) {
                const int tau = 4 * g + q, t = z ? 15 - tau : tau;
                Y[(size_t)(16 * c + t) * 64 + vt * 16 + cl] = Yv[q];
            }
        }
    }
}

__device__ void phase_readout(KP p, int wsid_, int layer, int nrows, int bid, int nb) {
    PHASE_PROLOGUE
    const float* Y0 = (const float*)(ws_ + WS_YS); const float* Y1 = Y0 + HEADARR / 4;
    const bfu* VB = (const bfu*)(ws_ + WS_VB); const float* B0 = (const float*)(ws_ + WS_BETA); const float* B1 = B0 + (size_t)MA * 8;
    const float* GG = (const float*)(ws_ + WS_GG);
    bfu* MIX = (bfu*)(ws_ + WS_MIX);
    const float* lnw = p.c_ln_w + layer * 512; const float* lnb = p.c_ln_b + layer * 512;
    const int lane = tid_ & 63, wv = tid_ >> 6;
    for (int row = bid * 4 + wv; row < nrows; row += nb * 4) {
        int b, j, s; row_info(row, b, j, s);
#pragma unroll
        for (int h = 0; h < 8; ++h) {
            const size_t o = (((size_t)b * 8 + h) * NKEY + j) * 64 + lane;
            const float y = Y0[o] + Y1[o];
            const float mean = sum64(y) * (1.f / 64.f);
            const float dv = y - mean;
            const float var = sum64(dv * dv) * (1.f / 64.f);
            const float yn = dv * rsqrtf(var + 64e-5f) * lnw[h * 64 + lane] + lnb[h * 64 + lane];
            const float bs = B0[(size_t)row * 8 + h] + B1[(size_t)row * 8 + h];
            const float outv = (yn + bs * bf2f(VB[(size_t)row * 512 + h * 64 + lane])) * GG[(size_t)row * 512 + h * 64 + lane];
            MIX[(size_t)row * DM + 512 + h * 64 + lane] = f2bf(outv);
        }
    }
}

using f32x16 = __attribute__((ext_vector_type(16))) float;
#define AT_KBYTES 8192
#define AT_VSTRIDE 136
#define AT_VBYTES (64 * AT_VSTRIDE)
template <int GRP>
__device__ __forceinline__ void attn_item(KP p, int wsid_, char* ws_, int layer, int b, int h, int qb, int nkeys, float lam, float lam_init, char* smem, int tid) {
    constexpr int KS = GRP ? 2 : 4;
    const int lane = tid & 63, wv = tid >> 6, r32 = lane & 31, hh = lane >> 5;
    const int mp = GRP ? (wv >> 1) : 0, sub = GRP ? (wv & 1) : wv;
    const int jq = qb * (GRP ? 64 : 128) + sub * 32 + r32;
    const bfu* Qg = (const bfu*)(ws_ + (GRP ? WS_QB : WS_QA)) + (((size_t)b * 4 + h) * NKEY + jq) * 64 + mp * 32;
    const bfu* Kg = GRP ? (const bfu*)(ws_ + WS_KB) + ((size_t)b * 4 + h) * NKEY * 64 : (const bfu*)(ws_ + WS_KA) + ((size_t)b * 2 + (h >> 1)) * NKEY * 64;
    const bfu* Vg = GRP ? (const bfu*)(ws_ + WS_VBT) + ((size_t)b * 4 + h) * 64 * NKEY : (const bfu*)(ws_ + WS_VAT) + ((size_t)b * 2 + (h >> 1)) * 64 * NKEY;
    bf16x8 qf[KS];
#pragma unroll
    for (int ks = 0; ks < KS; ++ks) qf[ks] = *(const bf16x8*)(Qg + ks * 16 + hh * 8);
    f32x16 oacc[2];
    float lrun = 0.f;
#pragma unroll
    for (int db = 0; db < 2; ++db)
#pragma unroll
        for (int i = 0; i < 16; ++i) oacc[db][i] = 0.f;
    const int lrow = tid >> 3, lch = ((tid & 7) ^ ((tid >> 4) & 7)) * 8;
    const bfu* kp0 = Kg + (size_t)lrow * 64 + lch; const bfu* kp1 = kp0 + 32 * 64;
    const bfu* vp0 = Vg + (size_t)lrow * NKEY + lch; const bfu* vp1 = vp0 + (size_t)32 * NKEY;
    char* ldst = smem + tid * 16;
#define AT_ISSUE(t_) { char* d_ = ldst + ((t_) & 1) * 16384; const size_t ko_ = (size_t)(t_) * 64 * 64; const int vo_ = (t_) * 64; \
        GLDS(kp0 + ko_, d_); GLDS(kp1 + ko_, d_ + 4096); GLDS(vp0 + vo_, d_ + 8192); GLDS(vp1 + vo_, d_ + 12288); }
    __syncthreads();
    AT_ISSUE(0)
    const int nt = nkeys >> 6;
    float mref = 0.f;
    const int swv = (r32 >> 1) & 7;
    for (int t = 0; t < nt; ++t) {
        asm volatile("s_waitcnt vmcnt(0)" ::: "memory");
        __syncthreads();
        if (t + 1 < nt) AT_ISSUE(t + 1)
        const char* cK = smem + (t & 1) * 16384; const char* cV = cK + 8192;
        f32x16 sacc[2];
        const float ninit = -mref;
#pragma unroll
        for (int kb = 0; kb < 2; ++kb) {
#pragma unroll
            for (int i = 0; i < 16; ++i) sacc[kb][i] = ninit;
            const int key = kb * 32 + r32;
#pragma unroll
            for (int ks = 0; ks < KS; ++ks) {
                const int c0 = mp * 4 + ks * 2 + hh;
                const bf16x8 kf = *(const bf16x8*)(cK + key * 128 + ((c0 ^ ((key >> 1) & 7)) * 16));
                sacc[kb] = __builtin_amdgcn_mfma_f32_32x32x16_bf16(kf, qf[ks], sacc[kb], 0, 0, 0);
            }
        }
        float mx = sacc[0][0];
#pragma unroll
        for (int i = 1; i < 16; ++i) mx = fmaxf(mx, sacc[0][i]);
#pragma unroll
        for (int i = 0; i < 16; ++i) mx = fmaxf(mx, sacc[1][i]);
        mx = xor32_max(mx);
        const bool need = (t == 0) || (mx > 8.f);
        if (__any(need)) {
            const float delta = need ? mx : 0.f;
            const float alpha = __builtin_amdgcn_exp2f(-delta);
            mref += delta; lrun *= alpha;
#pragma unroll
            for (int db = 0; db < 2; ++db)
#pragma unroll
                for (int i = 0; i < 16; ++i) oacc[db][i] *= alpha;
#pragma unroll
            for (int kb = 0; kb < 2; ++kb)
#pragma unroll
                for (int i = 0; i < 16; ++i) sacc[kb][i] -= delta;
        }
        float ps = 0.f;
#pragma unroll
        for (int kb = 0; kb < 2; ++kb)
#pragma unroll
            for (int i = 0; i < 16; ++i) { const float pv = __builtin_amdgcn_exp2f(sacc[kb][i]); sacc[kb][i] = pv; ps += pv; }
        lrun += ps;
#pragma unroll
        for (int kb = 0; kb < 2; ++kb)
#pragma unroll
            for (int s2 = 0; s2 < 2; ++s2) {
                union { bf16x8 v; unsigned u[4]; } pf;
#pragma unroll
                for (int i = 0; i < 4; ++i) pf.u[i] = pack2(sacc[kb][8 * s2 + 2 * i], sacc[kb][8 * s2 + 2 * i + 1]);
#pragma unroll
                for (int db = 0; db < 2; ++db) {
                    const char* vr = cV + (db * 32 + r32) * 128 + hh * 8;
                    union { bf16x8 v; uint2 u[2]; } vf;
                    vf.u[0] = *(const uint2*)(vr + (((kb * 4 + s2 * 2) ^ swv) * 16)); vf.u[1] = *(const uint2*)(vr + (((kb * 4 + s2 * 2 + 1) ^ swv) * 16));
                    oacc[db] = __builtin_amdgcn_mfma_f32_32x32x16_bf16(vf.v, pf.v, oacc[db], 0, 0, 0);
                }
            }
    }
    __syncthreads();
    bfu* MIX = (bfu*)(ws_ + WS_MIX);
    const int grow = grow_of(b, jq);
    const float il = 1.f / xor32_sum(lrun);
    if (GRP == 0) {
        bfu* dst = MIX + (size_t)grow * DM + h * 64;
#pragma unroll
        for (int db = 0; db < 2; ++db)
#pragma unroll
            for (int g = 0; g < 4; ++g)
                *(uint2*)(dst + db * 32 + g * 8 + hh * 4) = make_uint2(pack2(oacc[db][4 * g] * il, oacc[db][4 * g + 1] * il), pack2(oacc[db][4 * g + 2] * il, oacc[db][4 * g + 3] * il));
    } else {
        float* xs = (float*)smem + sub * 2048;
        if (mp == 1) {
            const float sc2 = lam * il;
#pragma unroll
            for (int db = 0; db < 2; ++db)
#pragma unroll
                for (int i = 0; i < 16; ++i) xs[(db * 16 + i) * 64 + lane] = oacc[db][i] * sc2;
        }
        __syncthreads();
        if (mp == 0) {
            float ss = 0.f;
#pragma unroll
            for (int db = 0; db < 2; ++db)
#pragma unroll
                for (int i = 0; i < 16; ++i) { const float o = oacc[db][i] * il - xs[(db * 16 + i) * 64 + lane]; oacc[db][i] = o; ss += o * o; }
            ss = xor32_sum(ss);
            const float rs = rsqrtf(ss * (1.f / 64.f) + 1e-6f) * (1.f - lam_init);
            const float* gn = p.b_subln + layer * 64;
            bfu* dst = MIX + (size_t)grow * DM + 256 + h * 64;
#pragma unroll
            for (int db = 0; db < 2; ++db)
#pragma unroll
                for (int g = 0; g < 4; ++g) {
                    const int d = db * 32 + g * 8 + hh * 4;
                    *(uint2*)(dst + d) = make_uint2(pack2(oacc[db][4 * g] * rs * gn[d], oacc[db][4 * g + 1] * rs * gn[d + 1]), pack2(oacc[db][4 * g + 2] * rs * gn[d + 2], oacc[db][4 * g + 3] * rs * gn[d + 3]));
                }
        }
    }
}
__device__ void phase_attn(KP p, int wsid_, int layer, bool do_ctx, unsigned* qctr, unsigned* cctr, int* s_item, char* smem) {
    PHASE_PROLOGUE
    const int tid = tid_;
    const float lam_init = 0.8f - 0.6f * expf(-0.3f * (float)layer);
    float d1 = 0.f, d2 = 0.f;
    for (int i = 0; i < 32; ++i) { d1 += p.b_lq1[layer * 32 + i] * p.b_lk1[layer * 32 + i]; d2 += p.b_lq2[layer * 32 + i] * p.b_lk2[layer * 32 + i]; }
    const float lam = expf(d1) - expf(d2) + lam_init;
    const int nitems = do_ctx ? 1728 : 1536;
    bool conv_left = cctr != nullptr;
    for (;;) {
        __syncthreads();
        if (TID512 == 0) *s_item = (int)atomicAdd(qctr, 1u);
        __syncthreads();
        const int pair_ = __builtin_amdgcn_readfirstlane(*s_item);
        if (2 * pair_ >= nitems) break;
        const int it = 2 * pair_ + hb_;
        int grp, b, h, qb, nkeys;
        if (it < 1024) { grp = 1; qb = 4 + (it & 31); h = (it >> 5) & 3; b = it >> 7; nkeys = NKEY; }
        else if (it < 1536) { grp = 0; const int r = it - 1024; qb = 2 + (r & 15); h = (r >> 4) & 3; b = r >> 6; nkeys = NKEY; }
        else if (it < 1664) { grp = 1; const int r = it - 1536; qb = r & 3; h = (r >> 2) & 3; b = r >> 4; nkeys = 256; }
        else { grp = 0; const int r = it - 1664; qb = r & 1; h = (r >> 1) & 3; b = r >> 3; nkeys = 256; }
        if (grp) attn_item<1>(p, wsid_, ws_, layer, b, h, qb, nkeys, lam, lam_init, smem, tid);
        else attn_item<0>(p, wsid_, ws_, layer, b, h, qb, nkeys, lam, lam_init, smem, tid);
        if (conv_left) conv_left = conv_big_step(p, wsid_, ws_, layer, cctr, s_item, smem, tid, hb_);
    }
    while (conv_left) conv_left = conv_big_step(p, wsid_, ws_, layer, cctr, s_item, smem, tid, hb_);
}

__device__ void phase_outproj(KP p, int wsid_, int layer, int nrows, int bid, int nb, char* smem) {
    PHASE_PROLOGUE
    const bfu* MIX = (const bfu*)(ws_ + WS_MIX); const bfu* W = (const bfu*)(ws_ + WS_WOUT);
    float* X = (float*)(ws_ + WS_X); const float* mod = (const float*)(ws_ + WS_MOD);
    const int nitems = (nrows / 128) * 8;
    for (int it = bid; it < nitems; it += nb) {
        const int mt = it >> 3, nt = it & 7, row0 = mt * 128, col0 = nt * 128;
        int b, j0, s; row_info(row0, b, j0, s);
        const float* ga = mod + ((size_t)layer * 9 + s) * 6144 + 2 * 1024;
        gemm_tile([&](int r) { return MIX + (size_t)(row0 + r) * DM; }, [&](int r) { return W + (size_t)(col0 + r) * DM; }, DM,
            [&](f32x4 (&acc)[4][4], int wr, int wc, int fr, int fq) {
                ACC_FOREACH({ float* xp = X + (size_t)(row0 + row) * DM + col0 + col; *xp += ga[col0 + col] * val; })
            }, smem, wsid_);
    }
}

__device__ void phase_norm2_route(KP p, int wsid_, int layer, int nrows, int bid, int nb, char* smem, bool dry = false) {
    PHASE_PROLOGUE
    const float* X = (const float*)(ws_ + WS_X); bfu* H = (bfu*)(ws_ + WS_H);
    const float* mod = (const float*)(ws_ + WS_MOD); const float* WRT = (const float*)(ws_ + WS_WRT);
    int* ECNT = (int*)(ws_ + WS_ECNT) + layer * 32; int* EIDX = (int*)(ws_ + WS_EIDX); float* EGATE = (float*)(ws_ + WS_EGATE); int* ELIST = (int*)(ws_ + WS_ELIST);
    float* lg = (float*)smem;
    int* lcnt = (int*)(lg + 4 * 16 * 48);
    int* lbase = lcnt + 32;
    int* lsel = lbase + 32;
    int* lrank = lsel + 128;
    char* slab = smem + 14336;
    constexpr int SLAB = 27136;
    const bfu* WH = (const bfu*)(ws_ + WS_WRTH); const bfu* WL = (const bfu*)(ws_ + WS_WRTL);
    const int tid = tid_, lane = tid & 63, wv = tid >> 6, r = lane & 15, kq = lane >> 4;
    const float* gf = p.g_ffn + layer * DM;
    const float* bg = p.r_b_group + layer * 4; const float* be = p.r_b_expert + layer * 32;
    const int nitems = nrows / 64;
    for (int it = bid; it < nitems; it += nb) {
        const int row = it * 64 + wv * 16 + r;
        int b, j, s; row_info(row, b, j, s);
        const float* xr = X + (size_t)row * DM;
        const float* sh = mod + ((size_t)layer * 9 + s) * 6144 + 3 * 1024; const float* sc = sh + 1024;
        if (tid < 32) lcnt[tid] = 0;
        float ss = 0.f;
#pragma unroll 16
        for (int c = 0; c < 64; ++c) { const float4 v = *(const float4*)(xr + c * 16 + kq * 4); ss += v.x * v.x + v.y * v.y + v.z * v.z + v.w * v.w; }
        ss = xor32_sum(xor16_sum(ss));
        const float rs = rsqrtf(ss * (1.f / 1024.f) + 1e-6f);
        f32x4 acc[3];
#pragma unroll
        for (int n = 0; n < 3; ++n) acc[n] = (f32x4){0.f, 0.f, 0.f, 0.f};
        uint4 sw0, sw1, sw2, sw3, sw4, sw5; float4 sg = make_float4(0.f, 0.f, 0.f, 0.f);
        const int ch0 = tid, ch1 = tid + 256, ch2 = tid + 512;
        const size_t wo0 = (size_t)(ch0 >> 4) * DM + (ch0 & 15) * 8, wo1 = (size_t)(ch1 >> 4) * DM + (ch1 & 15) * 8, wo2 = (size_t)(ch2 >> 4) * DM + (ch2 & 15) * 8;
        const int lo0 = (ch0 >> 4) * 272 + (ch0 & 15) * 16, lo1 = (ch1 >> 4) * 272 + (ch1 & 15) * 16, lo2 = (ch2 >> 4) * 272 + (ch2 & 15) * 16;
#define RT_SLAB_LOAD(sb_) { const int k0_ = (sb_) * 128; \
            sw0 = *(const uint4*)(WH + wo0 + k0_); sw1 = *(const uint4*)(WH + wo1 + k0_); sw2 = *(const uint4*)(WH + wo2 + k0_); \
            sw3 = *(const uint4*)(WL + wo0 + k0_); sw4 = *(const uint4*)(WL + wo1 + k0_); sw5 = *(const uint4*)(WL + wo2 + k0_); \
            if (tid < 32) { const float4 g4 = *(const float4*)(gf + k0_ + tid * 4), s4_ = *(const float4*)(sc + k0_ + tid * 4); sg = make_float4(g4.x * (1.f + s4_.x), g4.y * (1.f + s4_.y), g4.z * (1.f + s4_.z), g4.w * (1.f + s4_.w)); } \
            else if (tid < 64) sg = *(const float4*)(sh + k0_ + (tid - 32) * 4); }
#define RT_SLAB_STORE(buf_) { char* d_ = slab + (buf_) * SLAB; \
            *(uint4*)(d_ + lo0) = sw0; *(uint4*)(d_ + lo1) = sw1; *(uint4*)(d_ + lo2) = sw2; *(uint4*)(d_ + 13056 + lo0) = sw3; *(uint4*)(d_ + 13056 + lo1) = sw4; *(uint4*)(d_ + 13056 + lo2) = sw5; \
            if (tid < 64) *(float4*)(d_ + 26112 + tid * 16) = sg; }
        float4 xq0, xq1, xq2, xq3, xq4, xq5, xq6, xq7;
#define RT_X_LOAD(sb_) { const float* x_ = xr + (sb_) * 128 + kq * 8; xq0 = *(const float4*)(x_); xq1 = *(const float4*)(x_ + 4); xq2 = *(const float4*)(x_ + 32); xq3 = *(const float4*)(x_ + 36); \
            xq4 = *(const float4*)(x_ + 64); xq5 = *(const float4*)(x_ + 68); xq6 = *(const float4*)(x_ + 96); xq7 = *(const float4*)(x_ + 100); }
        __syncthreads();
        RT_SLAB_LOAD(0) RT_SLAB_STORE(0) RT_X_LOAD(0)
        __syncthreads();
        for (int sb = 0; sb < 8; ++sb) {
            if (sb + 1 < 8) RT_SLAB_LOAD(sb + 1)
            const float4 xc[8] = {xq0, xq1, xq2, xq3, xq4, xq5, xq6, xq7};
            if (sb + 1 < 8) RT_X_LOAD(sb + 1)
            const char* d = slab + (sb & 1) * SLAB;
#pragma unroll
            for (int s4 = 0; s4 < 4; ++s4) {
                const float4 g0 = *(const float4*)(d + 26112 + (s4 * 32 + kq * 8) * 4), g1 = *(const float4*)(d + 26112 + (s4 * 32 + kq * 8 + 4) * 4);
                const float4 h0 = *(const float4*)(d + 26624 + (s4 * 32 + kq * 8) * 4), h1 = *(const float4*)(d + 26624 + (s4 * 32 + kq * 8 + 4) * 4);
                const float4 xa = xc[2 * s4], xb = xc[2 * s4 + 1];
                float f[8];
                f[0] = xa.x * rs * g0.x + h0.x; f[1] = xa.y * rs * g0.y + h0.y; f[2] = xa.z * rs * g0.z + h0.z; f[3] = xa.w * rs * g0.w + h0.w;
                f[4] = xb.x * rs * g1.x + h1.x; f[5] = xb.y * rs * g1.y + h1.y; f[6] = xb.z * rs * g1.z + h1.z; f[7] = xb.w * rs * g1.w + h1.w;
                unsigned hi[4], lo[4];
#pragma unroll
                for (int i = 0; i < 4; ++i) {
                    hi[i] = pack2(f[2 * i], f[2 * i + 1]);
                    lo[i] = pack2(f[2 * i] - __uint_as_float(hi[i] << 16), f[2 * i + 1] - __uint_as_float(hi[i] & 0xFFFF0000u));
                }
                *(uint4*)(H + (size_t)row * DM + sb * 128 + s4 * 32 + kq * 8) = make_uint4(hi[0], hi[1], hi[2], hi[3]);
                const bf16x8 ah = mk8(hi[0], hi[1], hi[2], hi[3]), al = mk8(lo[0], lo[1], lo[2], lo[3]);
#pragma unroll
                for (int n = 0; n < 3; ++n) {
                    const bf16x8 wh = *(const bf16x8*)(d + (n * 16 + r) * 272 + (s4 * 32 + kq * 8) * 2), wl = *(const bf16x8*)(d + 13056 + (n * 16 + r) * 272 + (s4 * 32 + kq * 8) * 2);
                    acc[n] = __builtin_amdgcn_mfma_f32_16x16x32_bf16(ah, wh, acc[n], 0, 0, 0);
                    acc[n] = __builtin_amdgcn_mfma_f32_16x16x32_bf16(ah, wl, acc[n], 0, 0, 0);
                    acc[n] = __builtin_amdgcn_mfma_f32_16x16x32_bf16(al, wh, acc[n], 0, 0, 0);
                }
            }
            if (sb + 1 < 8) RT_SLAB_STORE((sb + 1) & 1)
            __syncthreads();
        }
#pragma unroll
        for (int n = 0; n < 3; ++n)
#pragma unroll
            for (int jj = 0; jj < 4; ++jj) lg[(wv * 16 + kq * 4 + jj) * 48 + n * 16 + r] = acc[n][jj];
        __syncthreads();
        if (lane < 16) {
            const float* L = lg + (wv * 16 + lane) * 48;
            const int grow = it * 64 + wv * 16 + lane;
            float gl[4]; float gm = -1e30f; int gi = 0;
#pragma unroll
            for (int g = 0; g < 4; ++g) { gl[g] = L[g] + bg[g]; if (gl[g] > gm) { gm = gl[g]; gi = g; } }
            float gs = 0.f;
#pragma unroll
            for (int g = 0; g < 4; ++g) gs += __expf(gl[g] - gm);
            const float gp = 1.f / gs;
            float v1 = -1e30f, v2 = -1e30f; int i1 = 0, i2 = 0;
            for (int e = 0; e < 8; ++e) {
                const float v = L[4 + gi * 8 + e] + be[gi * 8 + e];
                if (v > v1) { v2 = v1; i2 = i1; v1 = v; i1 = e; } else if (v > v2) { v2 = v; i2 = e; }
            }
            const float e2 = __expf(v2 - v1), den = 1.f / (1.f + e2);
            const int ex1 = gi * 8 + i1, ex2 = gi * 8 + i2;
            EIDX[grow * 2] = ex1; EIDX[grow * 2 + 1] = ex2;
            EGATE[grow * 2] = den * gp; EGATE[grow * 2 + 1] = e2 * den * gp;
            const int lr = wv * 16 + lane;
            lsel[lr * 2] = ex1; lsel[lr * 2 + 1] = ex2;
            lrank[lr * 2] = atomicAdd(&lcnt[ex1], 1); lrank[lr * 2 + 1] = atomicAdd(&lcnt[ex2], 1);
        }
        __syncthreads();
        if (tid < 32) lbase[tid] = (lcnt[tid] > 0 && !dry) ? atomicAdd(&ECNT[tid], lcnt[tid]) : 0;
        __syncthreads();
        if (tid < 128 && !dry) { const int e = lsel[tid]; ELIST[(size_t)e * (2 * MA) + lbase[e] + lrank[tid]] = ((it * 64 + (tid >> 1)) << 1) | (tid & 1); }
        __syncthreads();
    }
}

__device__ __forceinline__ int moe_prefix256(const int* ECNT, int* spre  , int wsid_) {
    if (TID512 == 0) { int a = 0; for (int e = 0; e < 32; ++e) { spre[e] = a; a += (ECNT[e] + 255) >> 8; } spre[32] = a; }
    __syncthreads();
    return spre[32];
}
__device__ void phase_outproj256(KP p, int wsid_, int layer, int nrows, int vblk, int nblk, char* smem_all, float gscale = 1.f) {
    PHASE_PROLOGUE
    const bfu* MIX = (const bfu*)(ws_ + WS_MIX); const bfu* W = (const bfu*)(ws_ + WS_WOUT);
    const float* mod = (const float*)(ws_ + WS_MOD);
    const int nitems = (nrows >> 8) * 4;
    for (int it = vblk; it < nitems; it += nblk) {
        const int mt = it >> 2, nt = it & 3, row0 = mt * 256, col0 = nt * 256;
        int b, j0, sm; row_info(row0, b, j0, sm);
        const float* ga = mod + ((size_t)layer * 9 + sm) * 6144 + 2 * 1024 + col0;
        const bfu* B0 = W + (size_t)col0 * DM;
        gemm256<DM, DM, DM>(MIX, [&](int r) { return row0 + r; }, B0, B0 + (size_t)128 * DM,
            [&](f32x4 (&acc)[2][2][4][2], int wr, int wc, int fr, int fq) {
                const __amdgpu_buffer_rsrc_t rs = __builtin_amdgcn_make_buffer_rsrc((void*)(ws_ + WS_X), 0, (int)((size_t)MA * DM * 4), 0x00020000);
                const int voff = ((wr * 64 + fq * 4) * DM + wc * 32 + fr) * 4;
#pragma unroll
                for (int bj = 0; bj < 2; ++bj)
#pragma unroll
                    for (int n = 0; n < 2; ++n) {
                        const float g = ga[bj * 128 + wc * 32 + n * 16 + fr] * gscale;
#pragma unroll
                        for (int ai = 0; ai < 2; ++ai)
#pragma unroll
                            for (int m = 0; m < 4; ++m)
#pragma unroll
                                for (int j = 0; j < 4; ++j) {
                                    const int so = ((row0 + ai * 128 + m * 16 + j) * DM + col0 + bj * 128 + n * 16) * 4;
                                    const float xo = __uint_as_float(__builtin_amdgcn_raw_buffer_load_b32(rs, voff, so, 0));
                                    __builtin_amdgcn_raw_buffer_store_b32(__float_as_uint(xo + g * acc[ai][bj][m][n][j]), rs, voff, so, 0);
                                }
                    }
            }, smem_all, wsid_);
    }
}
__device__ void phase_expert1_256(KP p, int wsid_, int layer, int vblk, int nblk, char* smem_all) {
    PHASE_PROLOGUE
    const bfu* H = (const bfu*)(ws_ + WS_H); const bfu* W1 = (const bfu*)(ws_ + WS_W1); const bfu* W3 = (const bfu*)(ws_ + WS_W3);
    const int* ECNT = (const int*)(ws_ + WS_ECNT) + layer * 32; const int* ELIST = (const int*)(ws_ + WS_ELIST);
    int* spre = (int*)(smem_all + 135168);
    const int nb256 = __builtin_amdgcn_readfirstlane(moe_prefix256(ECNT, spre, wsid_));
    const int nitems = nb256 * 4;
    for (int it = vblk; it < nitems; it += nblk) {
        const int blk = it >> 2, nt = it & 3;
        int e = 0;
        while (__builtin_amdgcn_readfirstlane(spre[e + 1]) <= blk) ++e;
        const int rb = blk - __builtin_amdgcn_readfirstlane(spre[e]), cnt = __builtin_amdgcn_readfirstlane(ECNT[e]);
        const int* lst = ELIST + (size_t)e * (2 * MA) + rb * 256;
        const int nvalid = min(256, cnt - rb * 256);
        const bfu* w1 = W1 + ((size_t)e * FF + nt * 128) * DM; const bfu* w3 = W3 + ((size_t)e * FF + nt * 128) * DM;
        gemm256<DM, DM, DM>(H, [&](int r) { return r < nvalid ? (lst[r] >> 1) : 0; }, w1, w3,
            [&](f32x4 (&acc)[2][2][4][2], int wr, int wc, int fr, int fq) {
                const __amdgpu_buffer_rsrc_t rs = __builtin_amdgcn_make_buffer_rsrc((void*)(ws_ + WS_HB), 0, (int)((size_t)(2 * MA + 32 * 256) * FF * 2), 0x00020000);
                const int voff = ((wr * 64 + fq * 4) * FF + wc * 32 + fr) * 2;
#pragma unroll
                for (int ai = 0; ai < 2; ++ai)
#pragma unroll
                    for (int m = 0; m < 4; ++m)
#pragma unroll
                        for (int n = 0; n < 2; ++n)
#pragma unroll
                            for (int j = 0; j < 4; ++j) {
                                const float a = acc[ai][0][m][n][j], g = acc[ai][1][m][n][j];
                                __builtin_amdgcn_raw_buffer_store_b16(f2bf(siluf_(a) * g), rs, voff, ((blk * 256 + ai * 128 + m * 16 + j) * FF + nt * 128 + n * 16) * 2, 0);
                            }
            }, smem_all, wsid_);
    }
}
__device__ void phase_expert2_256(KP p, int wsid_, int layer, int vblk, int nblk, char* smem_all) {
    PHASE_PROLOGUE
    const bfu* HB = (const bfu*)(ws_ + WS_HB); const bfu* W2 = (const bfu*)(ws_ + WS_W2);
    const int* ECNT = (const int*)(ws_ + WS_ECNT) + layer * 32; const int* ELIST = (const int*)(ws_ + WS_ELIST); const float* EGATE = (const float*)(ws_ + WS_EGATE);
    int* spre = (int*)(smem_all + 135168);
    const int nb256 = __builtin_amdgcn_readfirstlane(moe_prefix256(ECNT, spre, wsid_));
    const int nitems = nb256 * 4;
    for (int it = vblk; it < nitems; it += nblk) {
        const int blk = it >> 2, nt = it & 3;
        int e = 0;
        while (__builtin_amdgcn_readfirstlane(spre[e + 1]) <= blk) ++e;
        const int rb = blk - __builtin_amdgcn_readfirstlane(spre[e]), cnt = __builtin_amdgcn_readfirstlane(ECNT[e]);
        const int* lst = ELIST + (size_t)e * (2 * MA) + rb * 256;
        const int nvalid = min(256, cnt - rb * 256);
        const bfu* w2 = W2 + ((size_t)e * DM + nt * 256) * FF;
        gemm256<FF, FF, FF>(HB, [&](int r) { return blk * 256 + r; }, w2, w2 + (size_t)128 * FF,
            [&](f32x4 (&acc)[2][2][4][2], int wr, int wc, int fr, int fq) {
                int* sOff = (int*)smem_all; float* sGt = (float*)(smem_all + 1024);
                { const int r = TID512;
                  if (r < 256) {
                      const bool ok = r < nvalid; const int ent = ok ? lst[r] : 0;
                      sOff[r] = ok ? ((ent & 1) * MA + (ent >> 1)) * DM * 4 : -1; sGt[r] = EGATE[ent];
                  } }
                __syncthreads();
                const __amdgpu_buffer_rsrc_t rs = __builtin_amdgcn_make_buffer_rsrc((void*)(ws_ + WS_Y01), 0, (int)((size_t)2 * MA * DM * 4), 0x00020000);
                const int cofs = (nt * 256 + wc * 32 + fr) * 4;
#pragma unroll
                for (int ai = 0; ai < 2; ++ai)
#pragma unroll
                    for (int m = 0; m < 4; ++m) {
                        const int4 o4 = *(const int4*)(sOff + ai * 128 + wr * 64 + m * 16 + fq * 4); const float4 g4 = *(const float4*)(sGt + ai * 128 + wr * 64 + m * 16 + fq * 4);
                        const int oo[4] = {o4.x, o4.y, o4.z, o4.w}; const float gg[4] = {g4.x, g4.y, g4.z, g4.w};
#pragma unroll
                        for (int j = 0; j < 4; ++j) {
                            if (oo[j] >= 0) {
#pragma unroll
                                for (int bj = 0; bj < 2; ++bj)
#pragma unroll
                                    for (int n = 0; n < 2; ++n)
                                        __builtin_amdgcn_raw_buffer_store_b32(__float_as_uint(gg[j] * acc[ai][bj][m][n][j]), rs, oo[j] + cofs, (bj * 128 + n * 16) * 4, 0);
                            }
                        }
                    }
            }, smem_all, wsid_);
    }
}

__device__ __forceinline__ int moe_prefix(const int* ECNT, int* spre  , int wsid_) {
    if ((TID512 & 255) == 0) { int a = 0; for (int e = 0; e < 32; ++e) { spre[e] = a; a += (ECNT[e] + 127) >> 7; } spre[32] = a; }
    __syncthreads();
    return spre[32];
}
__device__ void phase_expert1(KP p, int wsid_, int layer, int bid, int nb, char* smem) {
    PHASE_PROLOGUE
    const bfu* H = (const bfu*)(ws_ + WS_H); const bfu* W1 = (const bfu*)(ws_ + WS_W1); const bfu* W3 = (const bfu*)(ws_ + WS_W3);
    bfu* HB = (bfu*)(ws_ + WS_HB);
    const int* ECNT = (const int*)(ws_ + WS_ECNT) + layer * 32; const int* ELIST = (const int*)(ws_ + WS_ELIST);
    int* spre = (int*)(smem + 65536);
    const int nblk = moe_prefix(ECNT, spre, wsid_);
    const int nitems = nblk * 8;
    for (int it = bid; it < nitems; it += nb) {
        const int blk = it >> 3, nt = it & 7;
        int e = 0;
        while (spre[e + 1] <= blk) ++e;
        const int rb = blk - spre[e], cnt = ECNT[e];
        const int* lst = ELIST + (size_t)e * (2 * MA) + rb * 128;
        const int nvalid = min(128, cnt - rb * 128);
        const bfu* w1 = W1 + (size_t)e * FF * DM; const bfu* w3 = W3 + (size_t)e * FF * DM;
        bfu* hb = HB + (size_t)blk * 128 * FF;
        gemm_tile([&](int r) { const int tok = r < nvalid ? (lst[r] >> 1) : 0; return H + (size_t)tok * DM; },
                  [&](int r) { const int wcx = r >> 6, n4 = (r >> 4) & 3, rr = r & 15; const int hc = nt * 64 + wcx * 32 + (n4 & 1) * 16 + rr; return (n4 < 2 ? w1 : w3) + (size_t)hc * DM; }, DM,
            [&](f32x4 (&acc)[4][4], int wr, int wc, int fr, int fq) {
#pragma unroll
                for (int m = 0; m < 4; ++m)
#pragma unroll
                    for (int n = 0; n < 2; ++n)
#pragma unroll
                        for (int jj = 0; jj < 4; ++jj) {
                            const int row = wr * 64 + m * 16 + fq * 4 + jj; const int hc = nt * 64 + wc * 32 + n * 16 + fr;
                            const float a = acc[m][n][jj], g = acc[m][n + 2][jj];
                            hb[(size_t)row * FF + hc] = f2bf(siluf_(a) * g);
                        }
            }, smem, wsid_);
    }
}
__device__ void phase_expert2(KP p, int wsid_, int layer, int bid, int nb, char* smem) {
    PHASE_PROLOGUE
    const bfu* HB = (const bfu*)(ws_ + WS_HB); const bfu* W2 = (const bfu*)(ws_ + WS_W2);
    float* Y = (float*)(ws_ + WS_Y01);
    const int* ECNT = (const int*)(ws_ + WS_ECNT) + layer * 32; const int* ELIST = (const int*)(ws_ + WS_ELIST); const float* EGATE = (const float*)(ws_ + WS_EGATE);
    int* spre = (int*)(smem + 65536);
    const int nblk = moe_prefix(ECNT, spre, wsid_);
    const int nitems = nblk * 8;
    for (int it = bid; it < nitems; it += nb) {
        const int blk = it >> 3, nt = it & 7;
        int e = 0;
        while (spre[e + 1] <= blk) ++e;
        const int rb = blk - spre[e], cnt = ECNT[e];
        const int* lst = ELIST + (size_t)e * (2 * MA) + rb * 128;
        const int nvalid = min(128, cnt - rb * 128);
        const bfu* w2 = W2 + (size_t)e * DM * FF;
        const bfu* hb = HB + (size_t)blk * 128 * FF;
        gemm_tile([&](int r) { return hb + (size_t)r * FF; }, [&](int r) { return w2 + (size_t)(nt * 128 + r) * FF; }, FF,
            [&](f32x4 (&acc)[4][4], int wr, int wc, int fr, int fq) {
#pragma unroll
                for (int m = 0; m < 4; ++m)
#pragma unroll
                    for (int jj = 0; jj < 4; ++jj) {
                        const int row = wr * 64 + m * 16 + fq * 4 + jj;
                        if (row < nvalid) {
                            const int ent = lst[row]; const float gt = EGATE[ent];
                            float* yp = Y + ((size_t)(ent & 1) * MA + (ent >> 1)) * DM + nt * 128 + wc * 64 + fr;
#pragma unroll
                            for (int n = 0; n < 4; ++n) yp[n * 16] = gt * acc[m][n][jj];
                        }
                    }
            }, smem, wsid_);
    }
}

#define XB_TMO      128
#define XB_XCNT(j)  (256  + 64 * (j))
#define XB_XSUB(j)  (1280 + 64 * (j))
#define XB_XGEN(j)  (2304 + 64 * (j))
#define XB_TOP      3328
#define XB_TOPGEN   3392
#define XCD_BAR_WORDS 3456
#define XB_SPIN_CAP (1u << 22)
#define LAS __attribute__((address_space(3)))

__device__ __forceinline__ unsigned xb_ld(unsigned* p)              { return __hip_atomic_load(p, __ATOMIC_RELAXED, __HIP_MEMORY_SCOPE_AGENT); }
__device__ __forceinline__ unsigned xb_add(unsigned* p, unsigned v) { return __hip_atomic_fetch_add(p, v, __ATOMIC_RELAXED, __HIP_MEMORY_SCOPE_AGENT); }
__device__ __forceinline__ unsigned xb_xcc_id() { return (unsigned)__builtin_amdgcn_s_getreg((3 << 11) | 20) & 0xFu; }
#define XB_SPIN(cond, bar) do { unsigned _sp = 0; while (cond) { __builtin_amdgcn_s_sleep(1); \
    if ((++_sp & 255u) == 0u) { if (xb_ld(&(bar)[XB_TMO])) break; if (_sp > XB_SPIN_CAP) { atomicAdd(&(bar)[XB_TMO], 1u); break; } } } } while (0)

struct XcdBarrier {
    unsigned* bar; unsigned x;
    volatile LAS unsigned* st;
};

__device__ __forceinline__ XcdBarrier xcd_barrier_post(unsigned* bar, volatile LAS unsigned* st, int wsid_) {
    XcdBarrier b; b.bar = bar; b.x = xb_xcc_id(); b.st = st;
    if (TID512 == 0) (void)xb_add(&bar[XB_XCNT(b.x)], 1u);
    return b;
}
__device__ __forceinline__ void xcd_barrier_complete(unsigned* bar, unsigned x, unsigned& nloc, unsigned& nx) {
    const unsigned G = gridDim.x * gridDim.y * gridDim.z;
    unsigned sum, cnt, mine, sp = 0u;
    for (;;) {
        sum = 0u; cnt = 0u; mine = 0u;
#pragma unroll
        for (unsigned j = 0; j < 16; ++j) { const unsigned c = xb_ld(&bar[XB_XCNT(j)]); sum += c; cnt += (c > 0u) ? 1u : 0u; mine = (j == x) ? c : mine; }
        if (sum == G) break;
        __builtin_amdgcn_s_sleep(1);
        if ((++sp & 255u) == 0u) { if (xb_ld(&bar[XB_TMO])) break; if (sp > XB_SPIN_CAP) { atomicAdd(&bar[XB_TMO], 1u); break; } }
    }
    nloc = mine > 0u ? mine : 1u; nx = cnt > 0u ? cnt : 1u;
}

__device__ __forceinline__ void xcd_barrier_(const XcdBarrier& b, int wsid_) {
    asm volatile("s_waitcnt vmcnt(0)" ::: "memory");
    __syncthreads();
    if (TID512 == 0) {
        unsigned* bar = b.bar;
        __builtin_amdgcn_s_waitcnt(0);
        unsigned nloc = b.st[0], nx = b.st[1];
        if (nloc == 0u) { xcd_barrier_complete(bar, b.x, nloc, nx); b.st[0] = nloc; b.st[1] = nx; }
        const unsigned old = xb_add(&bar[XB_XSUB(b.x)], 1u);
        const unsigned gen = old / nloc;
        if (old + 1u == (gen + 1u) * nloc) {
            __builtin_amdgcn_fence(__ATOMIC_RELEASE, "agent");
            asm volatile("s_waitcnt vmcnt(0)" ::: "memory");
            const unsigned og = xb_add(&bar[XB_TOP], 1u);
            const unsigned tg = og / nx;
            if (og + 1u == (tg + 1u) * nx) xb_add(&bar[XB_TOPGEN], 1u);
            else XB_SPIN(xb_ld(&bar[XB_TOPGEN]) == tg, bar);
            __builtin_amdgcn_fence(__ATOMIC_ACQUIRE, "agent");
            xb_add(&bar[XB_XGEN(b.x)], 1u);
            asm volatile("s_waitcnt vmcnt(0)" ::: "memory");
        } else {
            XB_SPIN(xb_ld(&bar[XB_XGEN(b.x)]) == gen, bar);
            __builtin_amdgcn_fence(__ATOMIC_ACQUIRE, "agent");
            asm volatile("s_waitcnt vmcnt(0)" ::: "memory");
        }
    }
    __syncthreads();
}


#define REP_MOD 1
#define REP_OUTPROJ 1
#define REP_ROUTE 1
#define REP_NORM1 1
#define REP_CONV 1
#define REP_INPROJ 1
#define REP_RK 1
#define REP_SCANATT 1
#define REP_R4 1
#define REP_ATT 1
#define REP_READOUT 1
#define REP_EXP1 1
#define REP_EXP2 1
#define REPEAT(N) _Pragma("nounroll") for (int rep_ = 0; rep_ < (N); ++rep_)
#define REPEAT2(N) _Pragma("nounroll") for (int rep2_ = 0; rep2_ < (N); ++rep2_)
#define CTL_Q(l) (4096 + 64 * (l))
#define CTL_XR 5120
__global__ void __launch_bounds__(512, 2) fwd(P p) {
    __shared__ __attribute__((aligned(16))) char smem_all[2 * SMEM_BYTES + 64];
    const int wsid_ = __builtin_amdgcn_readfirstlane((int)(threadIdx.x >> 6));
    const int hb = wsid_ >> 2;
    char* smem = smem_all + hb * SMEM_BYTES;
    uint4& xb_words = *(uint4*)(smem_all + 2 * SMEM_BYTES);
    int& s_item = *(int*)(smem_all + 2 * SMEM_BYTES + 16);
    int& s_vb = *(int*)(smem_all + 2 * SMEM_BYTES + 20);
    if (TID512 == 0) xb_words = make_uint4(0u, 0u, 0u, 0u);
    __syncthreads();
    unsigned* ctl = (unsigned*)(KPARG.ws + WS_CTL);
    XcdBarrier bar = xcd_barrier_post(ctl, (volatile LAS unsigned*)&xb_words, wsid_);
#define xcd_barrier(b_) xcd_barrier_(b_, wsid_)
    const int bid = blockIdx.x * 2 + hb, nb = gridDim.x * 2;
    const unsigned my_xcc = xb_xcc_id();
    if (TID512 == 0) s_vb = (int)atomicAdd(&ctl[CTL_XR + 16 * my_xcc], 1u);
    int vb = bid;
    phase_setup(KPARG, wsid_, bid, nb);
    REPEAT(REP_MOD) phase_mod(KPARG, wsid_, bid, nb, smem);
    for (int l = 0; l < NLAYER; ++l) {
        const int nr = l < NLAYER - 1 ? MA : ML;
        REPEAT(REP_CONV) phase_conv(KPARG, wsid_, l, bid, nb, smem);
        if (l == 0) {
            xcd_barrier(bar);
            if (TID512 == 0) { int pre = 0; for (unsigned x = 0; x < my_xcc; ++x) pre += (int)xb_ld(&ctl[CTL_XR + 16 * x]); s_vb += pre; }
            __syncthreads();
            vb = __builtin_amdgcn_readfirstlane(s_vb) * 2 + hb;
        }
        phase_norm1(KPARG, wsid_, l, 0, bid, nb);
        REPEAT(REP_NORM1 - 1) { xcd_barrier(bar); phase_norm1(KPARG, wsid_, l, 0, bid, nb, false); }
        xcd_barrier(bar);
        REPEAT(REP_INPROJ) { phase_inproj256(KPARG, wsid_, l, vb >> 1, nb >> 1, smem_all); xcd_barrier(bar); }
        REPEAT(REP_RK) { phase_rk(KPARG, wsid_, l, bid, nb, smem); xcd_barrier(bar); }
        REPEAT(REP_SCANATT) {
            if (bid < 128) { REPEAT(REP_R4) phase_r4(KPARG, wsid_, l, bid, 128, smem); }
            else phase_gate(KPARG, wsid_, l, bid - 128, nb - 128, smem);
            REPEAT2(REP_ATT) phase_attn(KPARG, wsid_, l, l < NLAYER - 1, ctl + CTL_Q(l) + 16 * rep_ + 32 * rep2_, ctl + CTL_Q(l) + 8 + 16 * rep_ + 32 * rep2_, &s_item, smem);
            xcd_barrier(bar);
        }
        REPEAT(REP_READOUT) { phase_readout(KPARG, wsid_, l, nr, bid, nb); xcd_barrier(bar); }
        phase_outproj256(KPARG, wsid_, l, nr, vb >> 1, nb >> 1, smem_all);
        REPEAT(REP_OUTPROJ - 1) { xcd_barrier(bar); phase_outproj256(KPARG, wsid_, l, nr, vb >> 1, nb >> 1, smem_all, 0.f); }
        xcd_barrier(bar);
        phase_norm2_route(KPARG, wsid_, l, nr, bid, nb, smem);
        REPEAT(REP_ROUTE - 1) { xcd_barrier(bar); phase_norm2_route(KPARG, wsid_, l, nr, bid, nb, smem, true); }
        xcd_barrier(bar);
        REPEAT(REP_EXP1) { phase_expert1_256(KPARG, wsid_, l, vb >> 1, nb >> 1, smem_all); xcd_barrier(bar); }
        REPEAT(REP_EXP2) { phase_expert2_256(KPARG, wsid_, l, vb >> 1, nb >> 1, smem_all); xcd_barrier(bar); }
    }
    phase_norm1(KPARG, wsid_, NLAYER, 1, bid, nb);
}

extern "C" void kernel_launch(void* const* d_in, const int* in_sizes, int n_in, void* d_out, int out_size, void* d_ws, size_t ws_size, hipStream_t stream) {
    if (n_in != 36 || ws_size < WS_END) { fprintf(stderr, "kernel_launch: unexpected n_in %d or ws_size %zu < %zu\n", n_in, ws_size, (size_t)WS_END); return; }
    static int grid = 0;
    if (!grid) {
        int dev = 0, cus = 0, per_cu = 0;
        hipGetDevice(&dev);
        hipDeviceGetAttribute(&cus, hipDeviceAttributeMultiprocessorCount, dev);
        hipOccupancyMaxActiveBlocksPerMultiprocessor(&per_cu, (const void*)fwd, 512, 0);
        if (per_cu < 1) per_cu = 1;
        grid = cus;
    }
    P p{};
    const float** pp = (const float**)&p;
    for (int i = 0; i < 36; ++i) pp[i] = (const float*)d_in[i];
    p.out = (float*)d_out; p.ws = (char*)d_ws;
    hipMemsetAsync((char*)d_ws + WS_CTL, 0, 65536, stream);
    fwd<<<grid, 512, 0, stream>>>(p);
}
```

```cpp
#include <hip/hip_runtime.h>
#include <stdint.h>
#include <stdio.h>

typedef unsigned short bfu;
using bf16x8 = __attribute__((ext_vector_type(8))) short;
using f32x4  = __attribute__((ext_vector_type(4))) float;

#define DM 1024
#define NB 8
#define SEQ 2048
#define CL 256
#define NKEY 2304
#define ML 16384
#define MC 2048
#define MA 18432
#define INW 3200
#define CSL 1920
#define NEXP 32
#define FF 512
#define NLAYER 4
#define LOG2E 1.4426950408889634f

#define MBy(x) ((size_t)(x) << 20)
constexpr size_t WS_CTL   = 0;
constexpr size_t WS_MOD   = 65536;
constexpr size_t WS_ROPE  = WS_MOD + (size_t)4 * 9 * 6144 * 4;
constexpr size_t WS_ECNT  = WS_ROPE + 64 * 16 * 2 * 4 + 64 * 8 * 2 * 4;
constexpr size_t WS_WRT   = WS_ECNT + 4096;
constexpr size_t WS_WRTH  = WS_WRT + (size_t)48 * 1024 * 4;
constexpr size_t WS_WRTL  = WS_WRTH + (size_t)48 * 1024 * 2;
constexpr size_t WS_EIDX  = WS_WRTL + (size_t)48 * 1024 * 2;
constexpr size_t WS_EGATE = WS_EIDX + (size_t)MA * 2 * 4;
constexpr size_t WS_ELIST = WS_EGATE + (size_t)MA * 2 * 4;
constexpr size_t WS_X     = MBy(8);
constexpr size_t WS_H     = WS_X + (size_t)MA * DM * 4;
constexpr size_t WS_WIN   = WS_H + (size_t)MA * DM * 2;
constexpr size_t WS_WOUT  = WS_WIN + (size_t)INW * DM * 2;
constexpr size_t WS_W1    = WS_WOUT + (size_t)DM * DM * 2;
constexpr size_t WS_W3    = WS_W1 + (size_t)NEXP * FF * DM * 2;
constexpr size_t WS_W2    = WS_W3 + (size_t)NEXP * FF * DM * 2;
constexpr size_t WS_LW2   = WS_W2 + (size_t)NEXP * FF * DM * 2;
constexpr size_t WS_LA2   = WS_LW2 + (size_t)2 * 512 * 64 * 2;
constexpr size_t WS_LG2   = WS_LA2 + (size_t)2 * 512 * 64 * 2;
constexpr size_t WS_QA    = WS_LG2 + (size_t)512 * 128 * 2;
constexpr size_t WS_KA    = WS_QA + (size_t)NB * 4 * NKEY * 64 * 2;
constexpr size_t WS_VAT   = WS_KA + (size_t)NB * 2 * NKEY * 64 * 2;
constexpr size_t WS_QB    = WS_VAT + (size_t)NB * 2 * NKEY * 64 * 2;
constexpr size_t WS_KB    = WS_QB + (size_t)NB * 4 * NKEY * 64 * 2;
constexpr size_t WS_VBT   = WS_KB + (size_t)NB * 4 * NKEY * 64 * 2;
constexpr size_t WS_CP    = WS_VBT + (size_t)NB * 4 * NKEY * 64 * 2;
constexpr size_t WS_GG    = WS_CP + (size_t)MA * CSL * 4;
constexpr size_t WS_MIX   = WS_GG + (size_t)MA * 512 * 4;
constexpr size_t HEADARR  = (size_t)NB * 8 * NKEY * 64 * 4;
#define OPS_REC 13568
constexpr size_t OPS_DIR  = (size_t)64 * 144 * OPS_REC;
constexpr size_t WS_OPS   = WS_MIX + (size_t)MA * DM * 2;
constexpr size_t WS_YS    = WS_OPS + 2 * OPS_DIR;
constexpr size_t WS_VB    = WS_YS + 2 * HEADARR;
constexpr size_t WS_BETA  = WS_VB + (size_t)MA * 512 * 2;
constexpr size_t WS_LXG   = WS_BETA + (size_t)2 * MA * 8 * 4;
constexpr size_t WS_SCR   = WS_LXG + (size_t)MA * 128 * 2;
constexpr size_t WS_END   = WS_SCR + (size_t)256 * 2 * 128 * 132 * 4;
constexpr size_t WS_Y01   = WS_OPS;
constexpr size_t WS_HB    = WS_OPS + (size_t)2 * MA * DM * 4;
static_assert((size_t)2 * MA * DM * 4 + (size_t)(2 * MA + 32 * 256) * 512 * 2 <= 2 * OPS_DIR, "MoE buffers must fit in OPS");

struct P {
    const float *x, *c, *ctx, *c_ctx, *w_mod, *b_mod, *g_mix, *g_ffn, *w_in, *a_q_gain, *a_k_gain, *b_lq1, *b_lk1, *b_lq2, *b_lk2, *b_subln,
        *c_mu, *c_w0, *c_w2, *c_a0, *c_a2, *c_g2, *c_k_k, *c_k_a, *c_r_k, *c_ln_w, *c_ln_b, *w_out, *r_w_group, *r_b_group, *r_w_expert, *r_b_expert,
        *e_w1, *e_w3, *e_w2, *g_final;
    float* out;
    char* ws;
};

typedef const __attribute__((address_space(4))) P& KP;
#define KPARG (*({ const __attribute__((address_space(4))) P* k_ = (const __attribute__((address_space(4))) P*)__builtin_amdgcn_kernarg_segment_ptr(); asm volatile("" : "+s"(k_)); k_; }))

__device__ __forceinline__ float bf2f(bfu b) { return __uint_as_float((unsigned)b << 16); }
__device__ __forceinline__ unsigned pack2(float a, float b) {
    typedef float f2 __attribute__((ext_vector_type(2)));
    typedef __bf16 b2 __attribute__((ext_vector_type(2)));
    f2 v = {a, b}; b2 r = __builtin_convertvector(v, b2); return __builtin_bit_cast(unsigned, r);
}
__device__ __forceinline__ bfu f2bf(float a) { return (bfu)(pack2(a, 0.f) & 0xFFFFu); }
__device__ __forceinline__ int lane_id_() { int l; asm volatile("v_mbcnt_lo_u32_b32 %0, -1, 0\n\tv_mbcnt_hi_u32_b32 %0, -1, %0" : "=v"(l)); return l; }
__device__ __forceinline__ float shfl_xor_(float v, int o) { return __int_as_float(__builtin_amdgcn_ds_bpermute((lane_id_() ^ o) << 2, __float_as_int(v))); }
template <int CTRL> __device__ __forceinline__ float dppf(float v) { return __int_as_float(__builtin_amdgcn_update_dpp(0, __float_as_int(v), CTRL, 0xF, 0xF, true)); }
__device__ __forceinline__ float sum8(float v) { v += dppf<0xB1>(v); v += dppf<0x4E>(v); v += dppf<0x141>(v); return v; }
__device__ __forceinline__ float xor16_sum(float v) { const auto r = __builtin_amdgcn_permlane16_swap(__float_as_uint(v), __float_as_uint(v), false, false); return __uint_as_float(r[0]) + __uint_as_float(r[1]); }
__device__ __forceinline__ float xor32_sum(float v) { const auto r = __builtin_amdgcn_permlane32_swap(__float_as_uint(v), __float_as_uint(v), false, false); return __uint_as_float(r[0]) + __uint_as_float(r[1]); }
__device__ __forceinline__ float xor32_max(float v) { const auto r = __builtin_amdgcn_permlane32_swap(__float_as_uint(v), __float_as_uint(v), false, false); return fmaxf(__uint_as_float(r[0]), __uint_as_float(r[1])); }
__device__ __forceinline__ float sum64(float v) { v = sum8(v); v += dppf<0x140>(v); v = xor16_sum(v); return xor32_sum(v); }
__device__ __forceinline__ float sigmoidf_(float x) { return __builtin_amdgcn_rcpf(1.f + __expf(-x)); }
__device__ __forceinline__ float siluf_(float x) { return x * __builtin_amdgcn_rcpf(1.f + __expf(-x)); }
__device__ __forceinline__ void row_info(int grow, int& b, int& j, int& s) {
    if (grow < ML) { b = grow >> 11; j = 256 + (grow & 2047); s = b; }
    else { int r = grow - ML; b = r >> 8; j = r & 255; s = 8; }
}
__device__ __forceinline__ int grow_of(int b, int j) { return j < 256 ? ML + b * 256 + j : b * 2048 + (j - 256); }

#define SMEM_BYTES 69632

#define TID512 ((wsid_ << 6) | lane_id_())
#define PHASE_PROLOGUE int tid_ = ((wsid_ & 3) << 6) | lane_id_(); asm volatile("" : "+v"(tid_)); const int hb_ = wsid_ >> 2; (void)hb_; \
    int z_ = 0; asm volatile("" : "+v"(z_)); char* ws_ = p.ws + __builtin_amdgcn_readfirstlane(z_);

__device__ void phase_setup(KP p, int wsid_, int bid, int nb) {
    PHASE_PROLOGUE
    float4* X4 = (float4*)(ws_ + WS_X);
    const float4* x4 = (const float4*)p.x; const float4* c4 = (const float4*)p.ctx;
    const size_t nl = (size_t)ML * DM / 4, nc = (size_t)MC * DM / 4;
    for (size_t i = (size_t)bid * 256 + tid_; i < nl + nc; i += (size_t)nb * 256) X4[i] = i < nl ? x4[i] : c4[i - nl];
    if (bid == 0) {
        float* TA = (float*)(ws_ + WS_ROPE); float* TB = TA + 64 * 16 * 2;
        for (int i = tid_; i < 64 * 16; i += 256) { int pos = i >> 4, f = i & 15; double inv = pow(10000.0, -(double)f / 16.0); double a = (double)pos * inv; TA[i * 2] = (float)cos(a); TA[i * 2 + 1] = (float)sin(a); }
        for (int i = tid_; i < 64 * 8; i += 256) { int pos = i >> 3, f = i & 7; double inv = pow(10000.0, -(double)f / 8.0); double a = (double)pos * inv; TB[i * 2] = (float)cos(a); TB[i * 2 + 1] = (float)sin(a); }
        int* ec = (int*)(ws_ + WS_ECNT);
        for (int i = tid_; i < 128; i += 256) ec[i] = 0;
    }
}

__device__ void phase_mod(KP p, int wsid_, int bid, int nb, char* smem) {
    PHASE_PROLOGUE
    float* act = (float*)smem;
    float* red = act + 9 * 1024;
    for (int i = tid_; i < 9 * 1024; i += 256) { float v = i < 8 * 1024 ? p.c[i] : p.c_ctx[i - 8 * 1024]; act[i] = siluf_(v); }
    __syncthreads();
    float* mod = (float*)(ws_ + WS_MOD);
    const int nitems = 4 * 6144 / 64;
    const int ct = tid_ & 15, kg = tid_ >> 4, wv = tid_ >> 6;
    for (int it = bid; it < nitems; it += nb) {
        const int layer = it / 96, n0 = (it % 96) * 64;
        const float* w = p.w_mod + (size_t)layer * DM * 6144 + (size_t)(kg * 64) * 6144 + n0 + ct * 4;
        float a[9][4];
#pragma unroll
        for (int s = 0; s < 9; ++s) { a[s][0] = 0.f; a[s][1] = 0.f; a[s][2] = 0.f; a[s][3] = 0.f; }
#pragma unroll 1
        for (int k0 = 0; k0 < 64; k0 += 16) {
            float4 wq[16];
#pragma unroll
            for (int j = 0; j < 16; ++j) wq[j] = *(const float4*)(w + (size_t)(k0 + j) * 6144);
#pragma unroll
            for (int j4 = 0; j4 < 4; ++j4)
#pragma unroll
                for (int s = 0; s < 9; ++s) {
                    const float4 av = *(const float4*)(act + s * 1024 + kg * 64 + k0 + j4 * 4);
                    const float avv[4] = {av.x, av.y, av.z, av.w};
#pragma unroll
                    for (int e = 0; e < 4; ++e) { const float4 q = wq[j4 * 4 + e]; a[s][0] += avv[e] * q.x; a[s][1] += avv[e] * q.y; a[s][2] += avv[e] * q.z; a[s][3] += avv[e] * q.w; }
                }
        }
#pragma unroll
        for (int s = 0; s < 9; ++s)
#pragma unroll
            for (int c = 0; c < 4; ++c) { a[s][c] = xor32_sum(xor16_sum(a[s][c])); }
        if ((tid_ & 63) < 16) {
#pragma unroll
            for (int s = 0; s < 9; ++s) *(float4*)(red + (wv * 9 + s) * 64 + ct * 4) = make_float4(a[s][0], a[s][1], a[s][2], a[s][3]);
        }
        __syncthreads();
        for (int i = tid_; i < 9 * 64; i += 256) {
            const int s = i >> 6, c2 = i & 63, n2 = n0 + c2;
            float v = red[(0 * 9 + s) * 64 + c2] + red[(1 * 9 + s) * 64 + c2] + red[(2 * 9 + s) * 64 + c2] + red[(3 * 9 + s) * 64 + c2];
            mod[((size_t)layer * 9 + s) * 6144 + n2] = v + p.b_mod[layer * 6144 + n2];
        }
        __syncthreads();
    }
}

__device__ __forceinline__ void conv_tile(const float* src, int K, int N, bfu* dst, int k0, int n0, float* ts, int tid_) {
    const int t = tid_;
    {
        const int kk = t >> 4, n4 = (t & 15) * 4;
#pragma unroll
        for (int pz = 0; pz < 4; ++pz) {
            const float4 v = *(const float4*)(src + (size_t)(k0 + kk + 16 * pz) * N + n0 + n4);
            float* d = ts + (kk + 16 * pz) * 65 + n4; d[0] = v.x; d[1] = v.y; d[2] = v.z; d[3] = v.w;
        }
    }
    __syncthreads();
    {
        const int n = t >> 2, kc = (t & 3) * 16;
        unsigned o[8];
#pragma unroll
        for (int i = 0; i < 8; ++i) o[i] = pack2(ts[(kc + 2 * i) * 65 + n], ts[(kc + 2 * i + 1) * 65 + n]);
        uint4* d = (uint4*)(dst + (size_t)(n0 + n) * K + k0 + kc);
        d[0] = make_uint4(o[0], o[1], o[2], o[3]); d[1] = make_uint4(o[4], o[5], o[6], o[7]);
    }
    __syncthreads();
}
__device__ void phase_conv(KP p, int wsid_, int layer, int bid, int nb, char* smem) {
    PHASE_PROLOGUE
    float* ts = (float*)smem;
    const float* srcs[8]; bfu* dsts[8]; int Ks[8], Ns[8], Bs[8];
    char* ws = ws_;
    srcs[0] = p.w_in + (size_t)layer * DM * INW;  Ks[0] = DM; Ns[0] = INW; Bs[0] = 1;  dsts[0] = (bfu*)(ws + WS_WIN);
    srcs[1] = p.w_out + (size_t)layer * DM * DM;  Ks[1] = DM; Ns[1] = DM;  Bs[1] = 1;  dsts[1] = (bfu*)(ws + WS_WOUT);
    srcs[2] = p.e_w1 + (size_t)layer * NEXP * DM * FF; Ks[2] = DM; Ns[2] = FF; Bs[2] = NEXP; dsts[2] = (bfu*)(ws + WS_W1);
    srcs[3] = p.e_w3 + (size_t)layer * NEXP * DM * FF; Ks[3] = DM; Ns[3] = FF; Bs[3] = NEXP; dsts[3] = (bfu*)(ws + WS_W3);
    srcs[4] = p.e_w2 + (size_t)layer * NEXP * FF * DM; Ks[4] = FF; Ns[4] = DM; Bs[4] = NEXP; dsts[4] = (bfu*)(ws + WS_W2);
    srcs[5] = p.c_w2 + (size_t)layer * 2 * 64 * 512;   Ks[5] = 64; Ns[5] = 512; Bs[5] = 2;   dsts[5] = (bfu*)(ws + WS_LW2);
    srcs[6] = p.c_a2 + (size_t)layer * 2 * 64 * 512;   Ks[6] = 64; Ns[6] = 512; Bs[6] = 2;   dsts[6] = (bfu*)(ws + WS_LA2);
    srcs[7] = p.c_g2 + (size_t)layer * 128 * 512;      Ks[7] = 128; Ns[7] = 512; Bs[7] = 1;  dsts[7] = (bfu*)(ws + WS_LG2);
    for (int it = bid; it < 1104; it += nb) {
        int jb, r;
        if (it < 800) { jb = 0; r = it; } else if (it < 1056) { jb = 1; r = it - 800; } else if (it < 1072) { jb = 5; r = it - 1056; } else if (it < 1088) { jb = 6; r = it - 1072; } else { jb = 7; r = it - 1088; }
        const float* src; bfu* dst; int K, N;
        if (jb == 0) { src = srcs[0]; dst = dsts[0]; K = DM; N = INW; } else if (jb == 1) { src = srcs[1]; dst = dsts[1]; K = DM; N = DM; }
        else if (jb == 5) { src = srcs[5]; dst = dsts[5]; K = 64; N = 512; } else if (jb == 6) { src = srcs[6]; dst = dsts[6]; K = 64; N = 512; } else { src = srcs[7]; dst = dsts[7]; K = 128; N = 512; }
        const int tk = K / 64, tn = N / 64, per = tk * tn, bt = r / per, r2 = r % per, kt = r2 / tn, nt = r2 % tn;
        conv_tile(src + (size_t)bt * K * N, K, N, dst + (size_t)bt * K * N, kt * 64, nt * 64, ts, tid_);
    }
    float* wrt = (float*)(ws + WS_WRT);
    const float* wg = p.r_w_group + (size_t)layer * DM * 4; const float* we = p.r_w_expert + (size_t)layer * DM * 32;
    for (int i = bid * 256 + tid_; i < 48 * 1024; i += nb * 256) {
        const int r = i >> 10, k = i & 1023;
        const float wv_ = r < 4 ? wg[k * 4 + r] : (r < 36 ? we[k * 32 + (r - 4)] : 0.f);
        wrt[i] = wv_;
        const bfu hi_ = f2bf(wv_);
        ((bfu*)(ws + WS_WRTH))[i] = hi_; ((bfu*)(ws + WS_WRTL))[i] = f2bf(wv_ - bf2f(hi_));
    }
}

__device__ __forceinline__ bool conv_big_step(KP p, int wsid_, char* ws_, int layer, unsigned* qctr, int* s_item, char* smem, int tid_, int hb_) {
    float* ts = (float*)smem;
    __syncthreads();
    if (TID512 == 0) *s_item = (int)atomicAdd(qctr, 1u);
    __syncthreads();
    const int gidx = __builtin_amdgcn_readfirstlane(*s_item);
    if (gidx >= 1536) return false;
    { const int q0 = hb_ * 4;
        const float* sp[4]; bfu* dp[4]; int Ks[4];
        float4 v[4][4];
        const int kk = tid_ >> 4, n4 = (tid_ & 15) * 4;
#pragma unroll
        for (int q = 0; q < 4; ++q) {
            const int it = gidx * 8 + q0 + q, jb = it >> 12, r = it & 4095, bt = r >> 7, r2 = r & 127;
            const float* src; bfu* dst; int K, N;
            if (jb == 0) { src = p.e_w1 + (size_t)layer * NEXP * DM * FF; dst = (bfu*)(ws_ + WS_W1); K = DM; N = FF; }
            else if (jb == 1) { src = p.e_w3 + (size_t)layer * NEXP * DM * FF; dst = (bfu*)(ws_ + WS_W3); K = DM; N = FF; }
            else { src = p.e_w2 + (size_t)layer * NEXP * FF * DM; dst = (bfu*)(ws_ + WS_W2); K = FF; N = DM; }
            const int tn = N >> 6, kt = r2 / tn, nt = r2 % tn;
            const float* s0 = src + (size_t)bt * K * N + (size_t)(kt * 64 + kk) * N + nt * 64 + n4;
#pragma unroll
            for (int pz = 0; pz < 4; ++pz) v[q][pz] = *(const float4*)(s0 + (size_t)(16 * pz) * N);
            Ks[q] = K;
            dp[q] = dst + (size_t)bt * K * N + (size_t)(nt * 64 + (tid_ >> 2)) * K + kt * 64 + (tid_ & 3) * 16;
        }
#pragma unroll
        for (int q = 0; q < 4; ++q)
#pragma unroll
            for (int pz = 0; pz < 4; ++pz) { float* d = ts + q * 4160 + (kk + 16 * pz) * 65 + n4; d[0] = v[q][pz].x; d[1] = v[q][pz].y; d[2] = v[q][pz].z; d[3] = v[q][pz].w; }
        __syncthreads();
        {
            const int n = tid_ >> 2, kc = (tid_ & 3) * 16;
#pragma unroll
            for (int q = 0; q < 4; ++q) {
                unsigned o[8];
#pragma unroll
                for (int i = 0; i < 8; ++i) o[i] = pack2(ts[q * 4160 + (kc + 2 * i) * 65 + n], ts[q * 4160 + (kc + 2 * i + 1) * 65 + n]);
                uint4* d = (uint4*)dp[q];
                d[0] = make_uint4(o[0], o[1], o[2], o[3]); d[1] = make_uint4(o[4], o[5], o[6], o[7]);
            }
        }
        __syncthreads();
    }
    return true;
}

__device__ void phase_conv_drain(KP p, int wsid_, int layer, unsigned* cctr, int* s_item, char* smem) {
    PHASE_PROLOGUE
    while (conv_big_step(p, wsid_, ws_, layer, cctr, s_item, smem, tid_, hb_)) {}
}

__device__ void phase_norm1(KP p, int wsid_, int layer, int mode, int bid, int nb, bool combine = true) {
    PHASE_PROLOGUE
    float* X = (float*)(ws_ + WS_X); bfu* H = (bfu*)(ws_ + WS_H);
    const bfu* Y0 = (const bfu*)(ws_ + WS_Y01); const bfu* Y1 = Y0 + (size_t)MA * DM;
    const float* mod = (const float*)(ws_ + WS_MOD);
    const int lane = tid_ & 63, wv = tid_ >> 6;
    const int nrows = mode ? ML : MA;
    if (bid == 0 && mode == 0 && tid_ < 32) ((int*)(ws_ + WS_ECNT))[layer * 32 + tid_] = 0;
    for (int row = bid * 4 + wv; row < nrows; row += nb * 4) {
        int b, j, s; row_info(row, b, j, s);
        float4 v[4];
        float ss = 0.f;
#pragma unroll
        for (int c = 0; c < 4; ++c) {
            const int col = c * 256 + lane * 4;
            float4 xv = *(const float4*)(X + (size_t)row * DM + col);
            if (layer > 0 && combine) {
                const uint2 ya = *(const uint2*)(Y0 + (size_t)row * DM + col), yb = *(const uint2*)(Y1 + (size_t)row * DM + col);
                const float4 a = make_float4(__uint_as_float(ya.x << 16), __uint_as_float(ya.x & 0xFFFF0000u), __uint_as_float(ya.y << 16), __uint_as_float(ya.y & 0xFFFF0000u));
                const float4 bq = make_float4(__uint_as_float(yb.x << 16), __uint_as_float(yb.x & 0xFFFF0000u), __uint_as_float(yb.y << 16), __uint_as_float(yb.y & 0xFFFF0000u));
                const float4 g = *(const float4*)(mod + ((size_t)(layer - 1) * 9 + s) * 6144 + 5 * 1024 + col);
                xv.x += g.x * (a.x + bq.x); xv.y += g.y * (a.y + bq.y); xv.z += g.z * (a.z + bq.z); xv.w += g.w * (a.w + bq.w);
                if (!mode) *(float4*)(X + (size_t)row * DM + col) = xv;
            }
            v[c] = xv; ss += xv.x * xv.x + xv.y * xv.y + xv.z * xv.z + xv.w * xv.w;
        }
        ss = sum64(ss);
        const float rs = rsqrtf(ss * (1.f / 1024.f) + 1e-6f);
#pragma unroll
        for (int c = 0; c < 4; ++c) {
            const int col = c * 256 + lane * 4;
            if (mode) {
                const float4 g = *(const float4*)(p.g_final + col);
                float4 o; o.x = v[c].x * rs * g.x; o.y = v[c].y * rs * g.y; o.z = v[c].z * rs * g.z; o.w = v[c].w * rs * g.w;
                *(float4*)(p.out + (size_t)row * DM + col) = o;
            } else {
                const float4 g = *(const float4*)(p.g_mix + layer * DM + col);
                const float4 sh = *(const float4*)(mod + ((size_t)layer * 9 + s) * 6144 + 0 * 1024 + col);
                const float4 sc = *(const float4*)(mod + ((size_t)layer * 9 + s) * 6144 + 1 * 1024 + col);
                const float o0 = v[c].x * rs * g.x * (1.f + sc.x) + sh.x, o1 = v[c].y * rs * g.y * (1.f + sc.y) + sh.y;
                const float o2 = v[c].z * rs * g.z * (1.f + sc.z) + sh.z, o3 = v[c].w * rs * g.w * (1.f + sc.w) + sh.w;
                *(uint2*)(H + (size_t)row * DM + col) = make_uint2(pack2(o0, o1), pack2(o2, o3));
            }
        }
    }
}

#define GLDS(gp, lp) __builtin_amdgcn_global_load_lds((const unsigned*)(gp), (__attribute__((address_space(3))) unsigned*)(lp), 16, 0, 0)
__device__ __forceinline__ int swzG(int x) { return (0x78 >> (2 * x)) & 3; }
template <class FA, class FB, class FE>
__device__ __forceinline__ void gemm_tile(FA arow, FB brow, int K, FE epi, char* smem, int wsid_) {
    int tid = TID512 & 255; asm volatile("" : "+v"(tid));
    const int lane = tid & 63, wid = tid >> 6, wr = wid >> 1, wc = wid & 1, fr = lane & 15, fq = lane >> 4;
    const int lrow = tid >> 2, lch = ((tid & 3) ^ swzG((tid >> 4) & 3)) * 8;
    const bfu* ga0 = arow(lrow) + lch; const bfu* ga1 = arow(lrow + 64) + lch;
    const bfu* gb0 = brow(lrow) + lch; const bfu* gb1 = brow(lrow + 64) + lch;
    f32x4 acc[4][4];
#pragma unroll
    for (int m = 0; m < 4; ++m)
#pragma unroll
        for (int n = 0; n < 4; ++n) acc[m][n] = (f32x4){0.f, 0.f, 0.f, 0.f};
    char* lds0 = smem + tid * 16;
#define GEMM_ISSUE(kt_) { char* d_ = lds0 + ((kt_) & 3) * 16384; const int ko_ = (kt_) * 32; \
        GLDS(ga0 + ko_, d_); GLDS(ga1 + ko_, d_ + 4096); GLDS(gb0 + ko_, d_ + 8192); GLDS(gb1 + ko_, d_ + 12288); }
    const int nk = K >> 5;
    __syncthreads();
    GEMM_ISSUE(0)
    if (nk > 1) GEMM_ISSUE(1)
    if (nk > 2) GEMM_ISSUE(2)
    const int offA = (wr * 64 + fr) * 64 + ((fq ^ swzG((fr >> 2) & 3)) * 16), offB = 8192 + (wc * 64 + fr) * 64 + ((fq ^ swzG((fr >> 2) & 3)) * 16);
    for (int kt = 0; kt < nk; ++kt) {
        if (kt + 2 < nk) asm volatile("s_waitcnt vmcnt(8)" ::: "memory");
        else if (kt + 1 < nk) asm volatile("s_waitcnt vmcnt(4)" ::: "memory");
        else asm volatile("s_waitcnt vmcnt(0)" ::: "memory");
        __builtin_amdgcn_s_barrier();
        if (kt + 3 < nk) GEMM_ISSUE(kt + 3)
        const char* st = smem + (kt & 3) * 16384;
        bf16x8 af[4], bfr[4];
#pragma unroll
        for (int m = 0; m < 4; ++m) af[m] = *(const bf16x8*)(st + offA + m * 1024);
#pragma unroll
        for (int n = 0; n < 4; ++n) bfr[n] = *(const bf16x8*)(st + offB + n * 1024);
        __builtin_amdgcn_s_setprio(1);
#pragma unroll
        for (int m = 0; m < 4; ++m)
#pragma unroll
            for (int n = 0; n < 4; ++n) acc[m][n] = __builtin_amdgcn_mfma_f32_16x16x32_bf16(af[m], bfr[n], acc[m][n], 0, 0, 0);
        __builtin_amdgcn_s_setprio(0);
    }
    __syncthreads();
    epi(acc, wr, wc, fr, fq);
}
#define ACC_FOREACH(...)                                                                      \
    _Pragma("unroll") for (int m_ = 0; m_ < 4; ++m_) _Pragma("unroll") for (int n_ = 0; n_ < 4; ++n_) \
    _Pragma("unroll") for (int j_ = 0; j_ < 4; ++j_) {                                        \
        const int row = wr * 64 + m_ * 16 + fq * 4 + j_; const int col = wc * 64 + n_ * 16 + fr; const float val = acc[m_][n_][j_]; __VA_ARGS__ }

__device__ __forceinline__ int lds_byte256(int r, int c) { const int st = (r >> 4) * 2 + (c >> 5), rr = r & 15, cc = c & 31, ob = rr * 64 + cc * 2; return st * 1024 + (ob ^ (((ob >> 9) & 1) << 5)); }
__device__ __forceinline__ void stage_rc256(int b, int& R, int& C) { const int st = b / 1024, sb = b % 1024, swz = sb ^ (((sb >> 9) & 1) << 5); R = (st >> 1) * 16 + swz / 64; C = (st & 1) * 32 + (swz % 64) / 2; }
#define G2_HT 8192
template <int lda, int ldb, int K, class FR, class FE>
__device__ __forceinline__ void gemm256(const bfu* Abase, FR arow, const bfu* B0, const bfu* B1, FE epi, char* shmc, int wsid_) {
    bfu* shm = (bfu*)shmc;
#define G2_SA(b, h) (shm + ((b) * 2 + (h)) * G2_HT)
#define G2_SB(b, h) (shm + (4 + (b) * 2 + (h)) * G2_HT)
    int tx = TID512; asm volatile("" : "+v"(tx));
    int sR, sC; stage_rc256(tx * 16, sR, sC);
    const int ra00 = arow(sR), ra01 = arow(sR + 64), ra10 = arow(128 + sR), ra11 = arow(128 + sR + 64);
#define G2_STAGE_A(P, h, kt) { int r0_ = (h) ? ra10 : ra00, r1_ = (h) ? ra11 : ra01; asm volatile("" : "+v"(r0_), "+v"(r1_)); const size_t ko_ = (size_t)(kt) * 64 + sC; \
        GLDS(Abase + (size_t)r0_ * lda + ko_, (char*)(P) + tx * 16); GLDS(Abase + (size_t)r1_ * lda + ko_, (char*)(P) + tx * 16 + 8192); }
#define G2_STAGE_B(P, h, kt) { int o_ = sR * ldb + sC; asm volatile("" : "+v"(o_)); const bfu* b_ = ((h) ? B1 : B0) + (size_t)(kt) * 64 + o_; GLDS(b_, (char*)(P) + tx * 16); GLDS(b_ + 64 * ldb, (char*)(P) + tx * 16 + 8192); }
    int wid = tx >> 6, lane = tx & 63, wr = wid >> 2, wc = wid & 3, fr = lane & 15, fq = lane >> 4;
#define G2_LDA(dst, b, h) _Pragma("unroll") for (int m = 0; m < 4; ++m) _Pragma("unroll") for (int k = 0; k < 2; ++k) \
        dst[m][k] = *(const bf16x8*)((const char*)G2_SA(b, h) + lds_byte256(wr * 64 + m * 16 + fr, k * 32 + fq * 8))
#define G2_LDB(dst, b, h) _Pragma("unroll") for (int n = 0; n < 2; ++n) _Pragma("unroll") for (int k = 0; k < 2; ++k) \
        dst[n][k] = *(const bf16x8*)((const char*)G2_SB(b, h) + lds_byte256(wc * 32 + n * 16 + fr, k * 32 + fq * 8))
#define G2_MMA(ai, bj, At_, Bt_) { __builtin_amdgcn_s_setprio(1); \
        _Pragma("unroll") for (int m = 0; m < 4; ++m) _Pragma("unroll") for (int n = 0; n < 2; ++n) _Pragma("unroll") for (int k = 0; k < 2; ++k) \
            acc[ai][bj][m][n] = __builtin_amdgcn_mfma_f32_16x16x32_bf16(At_[m][k], Bt_[n][k], acc[ai][bj][m][n], 0, 0, 0); \
        __builtin_amdgcn_s_setprio(0); }
#define G2_WV(n) asm volatile("s_waitcnt vmcnt(" #n ")" ::: "memory")
#define G2_WL(n) asm volatile("s_waitcnt lgkmcnt(" #n ")" ::: "memory")
#define G2_BAR __builtin_amdgcn_s_barrier()
#define G2_SCHED __builtin_amdgcn_sched_barrier(0)
    f32x4 acc[2][2][4][2];
#pragma unroll
    for (int a = 0; a < 2; ++a)
#pragma unroll
        for (int b = 0; b < 2; ++b)
#pragma unroll
            for (int m = 0; m < 4; ++m)
#pragma unroll
                for (int n = 0; n < 2; ++n) acc[a][b][m][n] = (f32x4){0.f, 0.f, 0.f, 0.f};
    bf16x8 At[4][2], Bx0[2][2], Bx1[2][2];
    constexpr int nt = K >> 6;
    __syncthreads();
    G2_STAGE_B(G2_SB(0, 0), 0, 0); G2_STAGE_A(G2_SA(0, 0), 0, 0); G2_STAGE_B(G2_SB(0, 1), 1, 0); G2_STAGE_A(G2_SA(0, 1), 1, 0);
    if (wr == 1) G2_BAR;
    G2_WV(4); G2_BAR;
    G2_STAGE_B(G2_SB(1, 0), 0, 1); G2_STAGE_A(G2_SA(1, 0), 0, 1); G2_STAGE_B(G2_SB(1, 1), 1, 1);
    G2_WV(6); G2_BAR;
    for (int t = 0; t < nt - 2; t += 2) {
        G2_LDB(Bx0, 0, 0); G2_SCHED; G2_LDA(At, 0, 0); G2_STAGE_A(G2_SA(1, 1), 1, t + 1);
        G2_WL(8); G2_BAR; G2_WL(0); G2_MMA(0, 0, At, Bx0); G2_BAR; G2_SCHED;
        G2_LDB(Bx1, 0, 1); G2_STAGE_B(G2_SB(0, 0), 0, t + 2);
        G2_BAR; G2_WL(0); G2_MMA(0, 1, At, Bx1); G2_BAR;
        G2_LDA(At, 0, 1); G2_STAGE_A(G2_SA(0, 0), 0, t + 2);
        G2_BAR; G2_WL(0); G2_MMA(1, 0, At, Bx0); G2_BAR; G2_SCHED;
        G2_STAGE_B(G2_SB(0, 1), 1, t + 2);
        G2_WV(6); G2_BAR; G2_MMA(1, 1, At, Bx1); G2_BAR;
        G2_LDB(Bx0, 1, 0); G2_SCHED; G2_LDA(At, 1, 0); G2_STAGE_A(G2_SA(0, 1), 1, t + 2);
        G2_WL(8); G2_BAR; G2_WL(0); G2_MMA(0, 0, At, Bx0); G2_BAR; G2_SCHED;
        G2_LDB(Bx1, 1, 1); G2_STAGE_B(G2_SB(1, 0), 0, t + 3);
        G2_BAR; G2_WL(0); G2_MMA(0, 1, At, Bx1); G2_BAR;
        G2_LDA(At, 1, 1); G2_STAGE_A(G2_SA(1, 0), 0, t + 3);
        G2_BAR; G2_WL(0); G2_MMA(1, 0, At, Bx0); G2_BAR; G2_SCHED;
        G2_STAGE_B(G2_SB(1, 1), 1, t + 3);
        G2_WV(6); G2_BAR; G2_MMA(1, 1, At, Bx1); G2_BAR;
    }
    tx = TID512; asm volatile("" : "+v"(tx)); stage_rc256(tx * 16, sR, sC); wid = tx >> 6; lane = tx & 63; wr = wid >> 2; wc = wid & 3; fr = lane & 15; fq = lane >> 4;
    { G2_LDB(Bx0, 0, 0); G2_WV(0); G2_LDA(At, 0, 0); G2_STAGE_A(G2_SA(1, 1), 1, nt - 1);
      G2_BAR; G2_WL(0); G2_MMA(0, 0, At, Bx0); G2_BAR;
      G2_LDB(Bx1, 0, 1); G2_BAR; G2_WL(0); G2_MMA(0, 1, At, Bx1); G2_BAR;
      G2_LDA(At, 0, 1); G2_WV(4); G2_BAR; G2_WL(0); G2_MMA(1, 0, At, Bx0); G2_MMA(1, 1, At, Bx1); G2_BAR; }
    { G2_LDB(Bx0, 1, 0); G2_LDA(At, 1, 0); G2_WV(2); G2_BAR; G2_WL(0); G2_MMA(0, 0, At, Bx0); G2_BAR;
      G2_LDB(Bx1, 1, 1); G2_WV(0); G2_BAR; G2_WL(0); G2_MMA(0, 1, At, Bx1); G2_BAR;
      G2_LDA(At, 1, 1); G2_BAR; G2_WL(0); G2_MMA(1, 0, At, Bx0); G2_MMA(1, 1, At, Bx1); G2_BAR; }
    if (wr == 0) G2_BAR;
    __syncthreads();
    epi(acc, wr, wc, fr, fq);
}

__device__ __forceinline__ void inproj_post(KP p, int wsid_, char* ws_, int layer, int row0, int nt, const float* Cs, int tid_) {
    const float* TA = (const float*)(ws_ + WS_ROPE); const float* TB = TA + 64 * 16 * 2;
    const int tid = tid_;
    int b, j0, s; row_info(row0, b, j0, s);
    const bool lat = row0 < ML;
    if (nt <= 2) {
        const int r = tid & 127, hl = tid >> 7;
        const bool isq = nt < 2;
        const float* gain = (isq ? p.a_q_gain : p.a_k_gain) + layer * 64;
        float ss = 0.f;
#pragma unroll
        for (int d4 = 0; d4 < 16; ++d4) { const float4 t4 = *(const float4*)(Cs + r * 132 + hl * 64 + d4 * 4); ss += t4.x * t4.x + t4.y * t4.y + t4.z * t4.z + t4.w * t4.w; }
        const float rs = rsqrtf(ss * (1.f / 64.f) + 1e-6f);
        const float qs = isq ? 0.125f * LOG2E : 1.f;
        bfu* dst = isq ? (bfu*)(ws_ + WS_QA) + (((size_t)b * 4 + (nt * 2 + hl)) * NKEY + j0 + r) * 64
                       : (bfu*)(ws_ + WS_KA) + (((size_t)b * 2 + hl) * NKEY + j0 + r) * 64;
        const int t = (j0 - 256) + r;
#pragma unroll 1
        for (int a = 0; a < 2; ++a) {
            float v[32];
#pragma unroll
            for (int d4 = 0; d4 < 8; ++d4) {
                const float4 t4 = *(const float4*)(Cs + r * 132 + hl * 64 + a * 32 + d4 * 4); const float4 g4 = *(const float4*)(gain + a * 32 + d4 * 4);
                v[d4 * 4] = t4.x * rs * g4.x; v[d4 * 4 + 1] = t4.y * rs * g4.y; v[d4 * 4 + 2] = t4.z * rs * g4.z; v[d4 * 4 + 3] = t4.w * rs * g4.w;
            }
            if (lat) {
                const int pos = a == 0 ? (t >> 6) : (t & 63);
#pragma unroll
                for (int f = 0; f < 16; ++f) {
                    const float cs = TA[(pos * 16 + f) * 2], sn = TA[(pos * 16 + f) * 2 + 1];
                    const float x0 = v[f], x1 = v[16 + f];
                    v[f] = x0 * cs - x1 * sn; v[16 + f] = x1 * cs + x0 * sn;
                }
            }
#pragma unroll
            for (int d8 = 0; d8 < 4; ++d8)
                ((uint4*)dst)[a * 4 + d8] = make_uint4(pack2(v[d8 * 8] * qs, v[d8 * 8 + 1] * qs), pack2(v[d8 * 8 + 2] * qs, v[d8 * 8 + 3] * qs),
                                                       pack2(v[d8 * 8 + 4] * qs, v[d8 * 8 + 5] * qs), pack2(v[d8 * 8 + 6] * qs, v[d8 * 8 + 7] * qs));
        }
    } else if (nt == 3 || nt == 8 || nt == 9) {
        const int c = tid & 127, half = tid >> 7, hl = c >> 6, d = c & 63;
        bfu* dst = nt == 3 ? (bfu*)(ws_ + WS_VAT) + (((size_t)b * 2 + hl) * 64 + d) * NKEY + j0 + half * 64
                           : (bfu*)(ws_ + WS_VBT) + (((size_t)b * 4 + ((nt - 8) * 2 + hl)) * 64 + d) * NKEY + j0 + half * 64;
#pragma unroll
        for (int r8 = 0; r8 < 8; ++r8) {
            const float* s0 = Cs + (half * 64 + r8 * 8) * 132 + c;
            ((uint4*)dst)[r8] = make_uint4(pack2(s0[0], s0[132]), pack2(s0[2 * 132], s0[3 * 132]), pack2(s0[4 * 132], s0[5 * 132]), pack2(s0[6 * 132], s0[7 * 132]));
        }
    } else if (nt <= 7) {
        const bool isq = nt < 6;
        const int hbase = ((nt - 4) & 1) * 2;
#pragma unroll
        for (int itq = 0; itq < 2; ++itq) {
            const int u = tid + 256 * itq, r = u & 127, hm = u >> 7;
            float v[32];
#pragma unroll
            for (int d4 = 0; d4 < 8; ++d4) { const float4 t4 = *(const float4*)(Cs + r * 132 + hm * 32 + d4 * 4); v[d4 * 4] = t4.x; v[d4 * 4 + 1] = t4.y; v[d4 * 4 + 2] = t4.z; v[d4 * 4 + 3] = t4.w; }
            if (lat) {
                const int t = (j0 - 256) + r;
#pragma unroll
                for (int a = 0; a < 2; ++a) {
                    const int pos = a == 0 ? (t >> 6) : (t & 63);
#pragma unroll
                    for (int f = 0; f < 8; ++f) {
                        const float cs = TB[(pos * 8 + f) * 2], sn = TB[(pos * 8 + f) * 2 + 1];
                        const float x0 = v[a * 16 + f], x1 = v[a * 16 + 8 + f];
                        v[a * 16 + f] = x0 * cs - x1 * sn; v[a * 16 + 8 + f] = x1 * cs + x0 * sn;
                    }
                }
            }
            const float qs = isq ? 0.17677669529663687f * LOG2E : 1.f;
            const int h = hbase + (hm >> 1), mp = hm & 1;
            bfu* dst = (bfu*)(ws_ + (isq ? WS_QB : WS_KB)) + (((size_t)b * 4 + h) * NKEY + j0 + r) * 64 + mp * 32;
#pragma unroll
            for (int d8 = 0; d8 < 4; ++d8)
                ((uint4*)dst)[d8] = make_uint4(pack2(v[d8 * 8] * qs, v[d8 * 8 + 1] * qs), pack2(v[d8 * 8 + 2] * qs, v[d8 * 8 + 3] * qs),
                                               pack2(v[d8 * 8 + 4] * qs, v[d8 * 8 + 5] * qs), pack2(v[d8 * 8 + 6] * qs, v[d8 * 8 + 7] * qs));
        }
    } else {
        const int r = tid & 127, half = tid >> 7;
        float* dst = (float*)(ws_ + WS_CP) + (size_t)(row0 + r) * CSL + (nt - 10) * 128 + half * 64;
#pragma unroll
        for (int d4 = 0; d4 < 16; ++d4) ((float4*)dst)[d4] = *(const float4*)(Cs + r * 132 + half * 64 + d4 * 4);
    }
}

__device__ void phase_inproj256(KP p, int wsid_, int layer, int vblk, int nblk, char* smem_all, unsigned* cctr, int* s_item) {
    PHASE_PROLOGUE
    const bfu* H = (const bfu*)(ws_ + WS_H); const bfu* W = (const bfu*)(ws_ + WS_WIN);
    for (int it = vblk; it < 72 * 13; it += nblk) {
        const int mt = (it / 104) * 8 + (it & 7), nt2 = (it >> 3) % 13;
        const int row0 = mt * 256, col0 = nt2 * 256;
        const bfu* B0 = W + (size_t)col0 * DM; const bfu* B1 = (nt2 == 12) ? B0 : B0 + (size_t)128 * DM;
        gemm256<DM, DM, DM>(H, [&](int r) { return row0 + r; }, B0, B1,
            [&](f32x4 (&acc)[2][2][4][2], int wr, int wc, int fr, int fq) {
                if (nt2 >= 5) {
                    const __amdgpu_buffer_rsrc_t rs = __builtin_amdgcn_make_buffer_rsrc((void*)(ws_ + WS_CP), 0, (int)((size_t)MA * CSL * 4), 0x00020000);
                    const int voff = (((wr * 64 + fq * 4) * CSL) + wc * 32 + fr) * 4;
#pragma unroll
                    for (int bj = 0; bj < 2; ++bj) {
                        const int cb = col0 + bj * 128 - 1280;
                        if (cb < CSL) {
#pragma unroll
                            for (int ai = 0; ai < 2; ++ai)
#pragma unroll
                                for (int m = 0; m < 4; ++m)
#pragma unroll
                                    for (int n = 0; n < 2; ++n)
#pragma unroll
                                        for (int j = 0; j < 4; ++j)
                                            __builtin_amdgcn_raw_buffer_store_b32(__float_as_uint(acc[ai][bj][m][n][j]), rs, voff, ((row0 + ai * 128 + m * 16 + j) * CSL + cb + n * 16) * 4, 0);
                        }
                    }
                } else {
                    float* SC = (float*)(ws_ + WS_SCR) + (size_t)blockIdx.x * (2 * 128 * 132);
                    const __amdgpu_buffer_rsrc_t rs = __builtin_amdgcn_make_buffer_rsrc((void*)SC, 0, 2 * 128 * 132 * 4, 0x00020000);
                    const int o0 = (wr * 64 + fq * 4) * 132 + wc * 32 + fr;
#pragma unroll
                    for (int bj = 0; bj < 2; ++bj) {
                        float* Cq = (float*)(smem_all + bj * SMEM_BYTES) + o0;
#pragma unroll
                        for (int m = 0; m < 4; ++m)
#pragma unroll
                            for (int n = 0; n < 2; ++n)
#pragma unroll
                                for (int j = 0; j < 4; ++j) {
                                    Cq[(m * 16 + j) * 132 + n * 16] = acc[0][bj][m][n][j];
                                    __builtin_amdgcn_raw_buffer_store_b32(__float_as_uint(acc[1][bj][m][n][j]), rs, o0 * 4, (bj * 128 * 132 + (m * 16 + j) * 132 + n * 16) * 4, 0);
                                }
                    }
                    __syncthreads();
                    int t2 = TID512 & 255; asm volatile("" : "+v"(t2));
                    float* Ch = (float*)(smem_all + hb_ * SMEM_BYTES);
                    inproj_post(p, wsid_, ws_, layer, row0, nt2 * 2 + hb_, Ch, t2);
                    __syncthreads();
                    { const float4* g4 = (const float4*)(SC + hb_ * (128 * 132)); float4* c4 = (float4*)Ch;
                      for (int i = t2; i < 128 * 132 / 4; i += 256) c4[i] = g4[i]; }
                    __syncthreads();
                    inproj_post(p, wsid_, ws_, layer, row0 + 128, nt2 * 2 + hb_, Ch, t2);
                    __syncthreads();
                }
            }, smem_all, wsid_);
    }
    if (vblk >= 72 * 13 - 3 * nblk) { for (int q = 0; q < 6; ++q) if (!conv_big_step(p, wsid_, ws_, layer, cctr, s_item, smem_all + hb_ * SMEM_BYTES, tid_, hb_)) break; }
}

__device__ void phase_inproj(KP p, int wsid_, int layer, int bid, int nb, char* smem) {
    PHASE_PROLOGUE
    const bfu* H = (const bfu*)(ws_ + WS_H); const bfu* W = (const bfu*)(ws_ + WS_WIN);
    float* Cs = (float*)smem;
    const int nitems = 144 * 25;
    for (int it = bid; it < nitems; it += nb) {
        const int mt = (it / 200) * 8 + (it / 5) % 8, nt = ((it / 40) % 5) * 5 + it % 5;
        const int row0 = mt * 128, col0 = nt * 128;
        gemm_tile([&](int r) { return H + (size_t)(row0 + r) * DM; }, [&](int r) { return W + (size_t)(col0 + r) * DM; }, DM,
            [&](f32x4 (&acc)[4][4], int wr, int wc, int fr, int fq) {
                ACC_FOREACH(Cs[row * 132 + col] = val;)
            }, smem, wsid_);
        __syncthreads();
        inproj_post(p, wsid_, ws_, layer, row0, nt, Cs, tid_);
        __syncthreads();
    }
}

__device__ void phase_gate(KP p, int wsid_, int layer, int bid, int nb, char* smem) {
    PHASE_PROLOGUE
    const bfu* LXG = (const bfu*)(ws_ + WS_LXG); const bfu* Bt = (const bfu*)(ws_ + WS_LG2);
    float* GG = (float*)(ws_ + WS_GG);
    const int nitems = 144 * 4;
    for (int it = bid; it < nitems; it += nb) {
        const int mt = it >> 2, nt = it & 3, row0 = mt * 128, col0 = nt * 128;
        gemm_tile([&](int r) { return LXG + (size_t)(row0 + r) * 128; }, [&](int r) { return Bt + (size_t)(col0 + r) * 128; }, 128,
            [&](f32x4 (&acc)[4][4], int wr, int wc, int fr, int fq) {
                ACC_FOREACH(GG[(size_t)(row0 + row) * 512 + col0 + col] = val;)
            }, smem, wsid_);
    }
}

#define OPS_AT 0
#define OPS_RT 2048
#define OPS_MAK 4096
#define OPS_T 5120
#define OPS_MRBK 6144
#define OPS_BK 7168
#define OPS_VF 11264
#define OPS_WC 13312
__device__ __forceinline__ char* ops_rec(char* ws_, int z, int seq, int c) { return ws_ + WS_OPS + ((size_t)(z * 64 + seq) * 144 + c) * OPS_REC; }
__device__ __forceinline__ float rdlane(float v, int l) { return __int_as_float(__builtin_amdgcn_readlane(__float_as_int(v), l)); }

__device__ __forceinline__ void chunk_tail(const float (&lw)[16], const float (&kk)[16], const float (&rr)[16], const float (&bb)[16], const float (&kd)[16], const float (&vv)[16],
                                           char* Lw, char* rec, int lane) {
    const int cl = lane & 15, g = lane >> 4;
    float Bt[16], Kt[16];
    float cum = 0.f, ep = 1.f;
#pragma unroll
    for (int t = 0; t < 16; ++t) {
        cum += lw[t];
        const float e = __expf(cum), ei = __expf(-cum);
        *(bfu*)(Lw + 0 + t * 128 + lane * 2) = f2bf(-kk[t] * ep);
        *(bfu*)(Lw + 2048 + t * 128 + lane * 2) = f2bf(rr[t] * e);
        Bt[t] = bb[t] * ei; Kt[t] = kd[t] * ei;
        *(bfu*)(Lw + 4096 + t * 128 + lane * 2) = f2bf(Bt[t]);
        *(bfu*)(Lw + 6144 + t * 128 + lane * 2) = f2bf(Kt[t]);
        ep = e;
    }
    const float eC = ep;
#pragma unroll
    for (int q = 0; q < 4; ++q) {
        *(uint4*)(rec + OPS_BK + ((lane >> 4) * 64 + cl + 16 * q) * 16) =
            make_uint4(pack2(Bt[4 * q] * eC, Bt[4 * q + 1] * eC), pack2(Bt[4 * q + 2] * eC, Bt[4 * q + 3] * eC), pack2(Kt[4 * q] * eC, Kt[4 * q + 1] * eC), pack2(Kt[4 * q + 2] * eC, Kt[4 * q + 3] * eC));
        *(uint2*)(rec + OPS_VF + ((lane >> 4) * 64 + cl + 16 * q) * 8) = make_uint2(pack2(vv[4 * q], vv[4 * q + 1]), pack2(vv[4 * q + 2], vv[4 * q + 3]));
    }
    *(float*)(rec + OPS_WC + lane * 4) = eC;
    f32x4 Mab = {0.f, 0.f, 0.f, 0.f}, Mak = Mab, Mrb = Mab, Mrk = Mab;
#pragma unroll
    for (int ks = 0; ks < 2; ++ks) {
        const int fo = cl * 128 + ks * 64 + g * 16;
        const bf16x8 aA = *(const bf16x8*)(Lw + 0 + fo), aR = *(const bf16x8*)(Lw + 2048 + fo), bB = *(const bf16x8*)(Lw + 4096 + fo), bK = *(const bf16x8*)(Lw + 6144 + fo);
        Mab = __builtin_amdgcn_mfma_f32_16x16x32_bf16(aA, bB, Mab, 0, 0, 0);
        Mak = __builtin_amdgcn_mfma_f32_16x16x32_bf16(aA, bK, Mak, 0, 0, 0);
        Mrb = __builtin_amdgcn_mfma_f32_16x16x32_bf16(aR, bB, Mrb, 0, 0, 0);
        Mrk = __builtin_amdgcn_mfma_f32_16x16x32_bf16(aR, bK, Mrk, 0, 0, 0);
    }
#pragma unroll
    for (int ks = 0; ks < 2; ++ks) {
        const uint2 a0 = *(const uint2*)(Lw + 0 + cl * 128 + (32 * ks + 4 * g) * 2), a1 = *(const uint2*)(Lw + 0 + cl * 128 + (32 * ks + 16 + 4 * g) * 2);
        const uint2 r0 = *(const uint2*)(Lw + 2048 + cl * 128 + (32 * ks + 4 * g) * 2), r1 = *(const uint2*)(Lw + 2048 + cl * 128 + (32 * ks + 16 + 4 * g) * 2);
        *(uint4*)(rec + OPS_AT + (ks * 64 + lane) * 16) = make_uint4(a0.x, a0.y, a1.x, a1.y);
        *(uint4*)(rec + OPS_RT + (ks * 64 + lane) * 16) = make_uint4(r0.x, r0.y, r1.x, r1.y);
    }
#pragma unroll
    for (int q = 0; q < 4; ++q) {
        const int tau = 4 * g + q;
        if (!(cl < tau)) { Mab[q] = 0.f; Mak[q] = 0.f; }
        if (!(cl <= tau)) { Mrb[q] = 0.f; Mrk[q] = 0.f; }
    }
#pragma unroll
    for (int q = 0; q < 4; ++q) *(float*)(Lw + 10240 + (4 * g + q) * 64 + cl * 4) = Mab[q];
    float Tc[16];
#pragma unroll
    for (int t = 0; t < 16; ++t) {
        float acc = (t == cl) ? 1.f : 0.f;
#pragma unroll
        for (int j4 = 0; j4 < (t + 3) / 4; ++j4) {
            const float4 mr = *(const float4*)(Lw + 10240 + t * 64 + j4 * 16);
            const float mm[4] = {mr.x, mr.y, mr.z, mr.w};
#pragma unroll
            for (int e = 0; e < 4; ++e) if (j4 * 4 + e < t) acc += mm[e] * Tc[j4 * 4 + e];
        }
        Tc[t] = acc;
    }
#pragma unroll
    for (int q = 0; q < 4; ++q) {
        const int tau = 4 * g + q;
        *(bfu*)(Lw + 8192 + tau * 32 + cl * 2) = f2bf(Mak[q]);
        *(bfu*)(Lw + 9216 + tau * 32 + cl * 2) = f2bf(Mrb[q]);
        *(bfu*)(Lw + 9728 + tau * 32 + cl * 2) = f2bf(Mrk[q]);
    }
    if (g == 0) {
#pragma unroll
        for (int t = 0; t < 16; ++t) *(bfu*)(Lw + 8704 + t * 32 + cl * 2) = f2bf(Tc[t]);
    }
    const uint2 fmak = *(const uint2*)(Lw + 8192 + cl * 32 + g * 8), ft = *(const uint2*)(Lw + 8704 + cl * 32 + g * 8);
    const uint2 fmrb = *(const uint2*)(Lw + 9216 + cl * 32 + g * 8), fmrk = *(const uint2*)(Lw + 9728 + cl * 32 + g * 8);
    *(uint4*)(rec + OPS_MAK + lane * 16) = make_uint4(fmak.x, fmak.y, 0u, 0u);
    *(uint4*)(rec + OPS_T + lane * 16) = make_uint4(ft.x, ft.y, 0u, 0u);
    *(uint4*)(rec + OPS_MRBK + lane * 16) = make_uint4(fmrb.x, fmrb.y, fmrk.x, fmrk.y);
}

__device__ void phase_rk(KP p, int wsid_, int layer, int bid, int nb, char* smem) {
    PHASE_PROLOGUE
    const int lane = tid_ & 63, wv = tid_ >> 6, cl = lane & 15, g = lane >> 4;
    char* Lw = smem + wv * 16384;
    const float* CP = (const float*)(ws_ + WS_CP);
    const float* mu = p.c_mu + layer * CSL;
    for (int it = bid * 4 + wv; it < 2 * 64 * 144; it += nb * 4) {
        const int c = it % 144, seq = (it / 144) & 63, z = it / (144 * 64), b = seq >> 3, h = seq & 7;
        const int grow0 = c < 16 ? ML + b * 256 + 16 * c : b * 2048 + 16 * (c - 16);
        const bool sstart = (c == 0 || c == 16), send = (c == 15 || c == 143);
        auto ldgrp = [&](int col, float (&P_)[18]) {
#pragma unroll
            for (int q = 0; q < 18; ++q) {
                const int tau = q - 1, nat = z ? 15 - tau : tau;
                const bool ok = (nat >= 0 || !sstart) && (nat <= 15 || !send);
                P_[q] = ok ? CP[(size_t)(grow0 + nat) * CSL + col] : 0.f;
            }
        };
        auto shiftg = [&](int col, const float (&P_)[18], float (&out)[16]) {
            const float m = mu[col];
#pragma unroll
            for (int t = 0; t < 16; ++t) out[t] = P_[t + 1] + m * (0.5f * (P_[t] + P_[t + 2]) - P_[t + 1]);
        };
        float Pw[18], Pa[18], Pr[18], Pk[18], Pv[18];
        ldgrp(1536 + z * 64 + lane, Pw); ldgrp(1664 + z * 64 + lane, Pa); ldgrp(h * 64 + lane, Pr); ldgrp(512 + h * 64 + lane, Pk); ldgrp(1024 + h * 64 + lane, Pv);
        float tmp[16], rr[16], kr[16], vv[16];
        shiftg(1536 + z * 64 + lane, Pw, tmp);
#pragma unroll
        for (int t = 0; t < 16; ++t) *(bfu*)(Lw + 10240 + t * 128 + lane * 2) = f2bf(1.f - 2.f * __builtin_amdgcn_rcpf(1.f + __expf(2.f * tmp[t])));
        shiftg(1664 + z * 64 + lane, Pa, tmp);
#pragma unroll
        for (int t = 0; t < 16; ++t) *(bfu*)(Lw + 12288 + t * 128 + lane * 2) = f2bf(tmp[t]);
        if (z == 0 && lane < 16) {
            float Pg[18]; ldgrp(1792 + h * 16 + lane, Pg); shiftg(1792 + h * 16 + lane, Pg, tmp);
            bfu* LXG = (bfu*)(ws_ + WS_LXG);
#pragma unroll
            for (int t = 0; t < 16; ++t) LXG[(size_t)(grow0 + t) * 128 + h * 16 + lane] = f2bf(sigmoidf_(tmp[t]));
        }
        shiftg(h * 64 + lane, Pr, rr);
        shiftg(512 + h * 64 + lane, Pk, kr);
        shiftg(1024 + h * 64 + lane, Pv, vv);
        const bfu* W2 = (const bfu*)(ws_ + WS_LW2) + ((size_t)z * 512 + h * 64) * 64;
        const bfu* A2 = (const bfu*)(ws_ + WS_LA2) + ((size_t)z * 512 + h * 64) * 64;
        float prew[16], prea[16];
#pragma unroll
        for (int which = 0; which < 2; ++which) {
            const bfu* Wm = which ? A2 : W2; const char* Xs = Lw + (which ? 12288 : 10240);
            f32x4 ac[4];
#pragma unroll
            for (int n = 0; n < 4; ++n) ac[n] = (f32x4){0.f, 0.f, 0.f, 0.f};
#pragma unroll
            for (int ks = 0; ks < 2; ++ks) {
                const bf16x8 af = *(const bf16x8*)(Xs + cl * 128 + ks * 64 + g * 16);
#pragma unroll
                for (int n = 0; n < 4; ++n) {
                    const bf16x8 bf = *(const bf16x8*)(Wm + (size_t)(16 * n + cl) * 64 + ks * 32 + g * 8);
                    ac[n] = __builtin_amdgcn_mfma_f32_16x16x32_bf16(af, bf, ac[n], 0, 0, 0);
                }
            }
#pragma unroll
            for (int n = 0; n < 4; ++n)
#pragma unroll
                for (int q = 0; q < 4; ++q) *(float*)(Lw + (4 * g + q) * 256 + (16 * n + cl) * 4) = ac[n][q];
#pragma unroll
            for (int t = 0; t < 16; ++t) { const float x = *(const float*)(Lw + t * 256 + lane * 4); if (which) prea[t] = x; else prew[t] = x; }
        }
        const int ch = h * 64 + lane;
        const float w0v = p.c_w0[((size_t)layer * 2 + z) * 512 + ch], a0v = p.c_a0[((size_t)layer * 2 + z) * 512 + ch];
        const float kkv = p.c_k_k[layer * 512 + ch], kav = p.c_k_a[layer * 512 + ch], rkv = p.c_r_k[layer * 512 + ch];
        float lw[16], kk[16], bb[16];
        float* BETA = (float*)(ws_ + WS_BETA) + (size_t)z * MA * 8;
#pragma unroll
        for (int t = 0; t < 16; ++t) {
            lw[t] = -0.6065306597126334f * sigmoidf_(w0v + prew[t]);
            const float icl = sigmoidf_(a0v + prea[t]);
            const float kv = kr[t] * kkv;
            const float ss = sum64(kv * kv);
            kk[t] = kv * rsqrtf(fmaxf(ss, 1e-24f));
            kr[t] = kr[t] * (1.f + (icl - 1.f) * kav);
            bb[t] = kk[t] * icl;
            const float bs = sum64(rr[t] * kr[t] * rkv);
            const int nat = z ? 15 - t : t;
            if (lane == 0) BETA[(size_t)(grow0 + nat) * 8 + h] = bs;
        }
        if (z == 0) {
            bfu* VB = (bfu*)(ws_ + WS_VB);
#pragma unroll
            for (int t = 0; t < 16; ++t) VB[(size_t)(grow0 + t) * 512 + ch] = f2bf(vv[t]);
        }
        chunk_tail(lw, kk, rr, bb, kr, vv, Lw, ops_rec(ws_, z, seq, c), lane);
    }
}

__device__ __forceinline__ bf16x8 mk8(unsigned a, unsigned b, unsigned c, unsigned d) { union { bf16x8 v; unsigned u[4]; } x; x.u[0] = a; x.u[1] = b; x.u[2] = c; x.u[3] = d; return x.v; }
__device__ __forceinline__ bf16x8 ld8(const char* p) { return *(const bf16x8*)p; }
__device__ __forceinline__ void glds16_asm(const void* gsrc, unsigned lds_dst) {
    unsigned keep;
    asm volatile("s_mov_b32 %0, m0\n\ts_mov_b32 m0, %2\n\ts_nop 0\n\tglobal_load_lds_dwordx4 %1, off\n\ts_mov_b32 m0, %0" : "=&s"(keep) : "v"(gsrc), "s"(lds_dst) : "memory");
}
__device__ void phase_r4(KP p, int wsid_, int layer, int bid, int nb, char* smem) {
    PHASE_PROLOGUE
    const int lane = tid_ & 63, vt = tid_ >> 6, cl = lane & 15, g = lane >> 4;
    for (int it = bid; it < 128; it += nb) {
        const int z = it >> 6, seq = it & 63;
        float* Y = (float*)(ws_ + WS_YS) + (size_t)z * (HEADARR / 4) + (size_t)seq * NKEY * 64;
        const char* recs = ws_ + WS_OPS + (size_t)(z * 64 + seq) * 144 * OPS_REC;
        f32x4 acc[4];
#pragma unroll
        for (int kt = 0; kt < 4; ++kt) acc[kt] = (f32x4){0.f, 0.f, 0.f, 0.f};
        const unsigned lbase = __builtin_amdgcn_readfirstlane((unsigned)(uintptr_t)(__attribute__((address_space(3))) char*)smem + vt * 1024);
#define R4_ISSUE(ci_) { const int c_ = z ? ((ci_) < 16 ? 15 - (ci_) : 143 - ((ci_) - 16)) : (ci_); const char* g_ = recs + (size_t)c_ * OPS_REC + tid_ * 16; const unsigned d_ = lbase + ((ci_) & 3) * OPS_REC; \
            glds16_asm(g_, d_); glds16_asm(g_ + 4096, d_ + 4096); glds16_asm(g_ + 8192, d_ + 8192); if (tid_ < 80) glds16_asm(g_ + 12288, d_ + 12288); }
        __syncthreads();
        R4_ISSUE(0) R4_ISSUE(1) R4_ISSUE(2)
        for (int ci = 0; ci < 144; ++ci) {
            const int c = z ? (ci < 16 ? 15 - ci : 143 - (ci - 16)) : ci;
            if (ci >= 3 && ci <= 141) { if (vt < 2) asm volatile("s_waitcnt vmcnt(20)" ::: "memory"); else asm volatile("s_waitcnt vmcnt(18)" ::: "memory"); }
            else asm volatile("s_waitcnt vmcnt(0)" ::: "memory");
            __builtin_amdgcn_s_barrier();
            if (ci + 3 < 144) R4_ISSUE(ci + 3)
            const char* rec = smem + (ci & 3) * OPS_REC;
            const f32x4 zero4 = {0.f, 0.f, 0.f, 0.f};
            bf16x8 sb[2];
#pragma unroll
            for (int ks = 0; ks < 2; ++ks)
                sb[ks] = mk8(pack2(acc[2 * ks][0], acc[2 * ks][1]), pack2(acc[2 * ks][2], acc[2 * ks][3]), pack2(acc[2 * ks + 1][0], acc[2 * ks + 1][1]), pack2(acc[2 * ks + 1][2], acc[2 * ks + 1][3]));
            const uint2 vf = *(const uint2*)(rec + OPS_VF + (vt * 64 + lane) * 8);
            f32x4 Z = __builtin_amdgcn_mfma_f32_16x16x32_bf16(ld8(rec + OPS_AT + lane * 16), sb[0], zero4, 0, 0, 0);
            Z = __builtin_amdgcn_mfma_f32_16x16x32_bf16(ld8(rec + OPS_AT + (64 + lane) * 16), sb[1], Z, 0, 0, 0);
            Z = __builtin_amdgcn_mfma_f32_16x16x32_bf16(ld8(rec + OPS_MAK + lane * 16), mk8(vf.x, vf.y, 0u, 0u), Z, 0, 0, 0);
            f32x4 Yv = __builtin_amdgcn_mfma_f32_16x16x32_bf16(ld8(rec + OPS_RT + lane * 16), sb[0], zero4, 0, 0, 0);
            Yv = __builtin_amdgcn_mfma_f32_16x16x32_bf16(ld8(rec + OPS_RT + (64 + lane) * 16), sb[1], Yv, 0, 0, 0);
            const f32x4 U = __builtin_amdgcn_mfma_f32_16x16x32_bf16(ld8(rec + OPS_T + lane * 16), mk8(pack2(Z[0], Z[1]), pack2(Z[2], Z[3]), 0u, 0u), zero4, 0, 0, 0);
            const bf16x8 ub = mk8(pack2(U[0], U[1]), pack2(U[2], U[3]), vf.x, vf.y);
            Yv = __builtin_amdgcn_mfma_f32_16x16x32_bf16(ld8(rec + OPS_MRBK + lane * 16), ub, Yv, 0, 0, 0);
#pragma unroll
            for (int kt = 0; kt < 4; ++kt) {
                const float4 wc = *(const float4*)(rec + OPS_WC + (16 * kt + 4 * g) * 4);
                f32x4 a = acc[kt];
                a[0] *= wc.x; a[1] *= wc.y; a[2] *= wc.z; a[3] *= wc.w;
                acc[kt] = __builtin_amdgcn_mfma_f32_16x16x32_bf16(ld8(rec + OPS_BK + (kt * 64 + lane) * 16), ub, a, 0, 0, 0);
            }
#pragma unroll
            for (int q = 0; q < 4; ++q) {
                const int tau = 4 * g + q, t = z ? 15 - tau : tau;
                Y[(size_t)(16 * c + t) * 64 + vt * 16 + cl] = Yv[q];
            }
        }
    }
}

__device__ void phase_readout(KP p, int wsid_, int layer, int nrows, int bid, int nb) {
    PHASE_PROLOGUE
    const float* Y0 = (const float*)(ws_ + WS_YS); const float* Y1 = Y0 + HEADARR / 4;
    const bfu* VB = (const bfu*)(ws_ + WS_VB); const float* B0 = (const float*)(ws_ + WS_BETA); const float* B1 = B0 + (size_t)MA * 8;
    const float* GG = (const float*)(ws_ + WS_GG);
    bfu* MIX = (bfu*)(ws_ + WS_MIX);
    const float* lnw = p.c_ln_w + layer * 512; const float* lnb = p.c_ln_b + layer * 512;
    const int lane = tid_ & 63, wv = tid_ >> 6;
    for (int row0 = (bid * 4 + wv) * 2; row0 < nrows; row0 += nb * 8) {
        int b, j, s; row_info(row0, b, j, s);
#pragma unroll
        for (int h = 0; h < 8; ++h) {
            const size_t o = (((size_t)b * 8 + h) * NKEY + j) * 64 + lane;
            const float ya = Y0[o] + Y1[o], yb = Y0[o + 64] + Y1[o + 64];
            const float va = bf2f(VB[(size_t)row0 * 512 + h * 64 + lane]), vb2 = bf2f(VB[(size_t)(row0 + 1) * 512 + h * 64 + lane]);
            const float ga = GG[(size_t)row0 * 512 + h * 64 + lane], gb = GG[(size_t)(row0 + 1) * 512 + h * 64 + lane];
            const float bsa = B0[(size_t)row0 * 8 + h] + B1[(size_t)row0 * 8 + h], bsb = B0[(size_t)(row0 + 1) * 8 + h] + B1[(size_t)(row0 + 1) * 8 + h];
            const float lw_ = lnw[h * 64 + lane], lb_ = lnb[h * 64 + lane];
            const float ma = sum64(ya) * (1.f / 64.f), mb = sum64(yb) * (1.f / 64.f);
            const float da = ya - ma, db = yb - mb;
            const float vra = sum64(da * da) * (1.f / 64.f), vrb = sum64(db * db) * (1.f / 64.f);
            const float oa = (da * rsqrtf(vra + 64e-5f) * lw_ + lb_ + bsa * va) * ga;
            const float ob = (db * rsqrtf(vrb + 64e-5f) * lw_ + lb_ + bsb * vb2) * gb;
            MIX[(size_t)row0 * DM + 512 + h * 64 + lane] = f2bf(oa);
            MIX[(size_t)(row0 + 1) * DM + 512 + h * 64 + lane] = f2bf(ob);
        }
    }
}

using f32x16 = __attribute__((ext_vector_type(16))) float;
#define AT_KBYTES 8192
#define AT_VSTRIDE 136
#define AT_VBYTES (64 * AT_VSTRIDE)
template <int GRP>
__device__ __forceinline__ void attn_item(KP p, int wsid_, char* ws_, int layer, int b, int h, int qb, int nkeys, float lam, float lam_init, char* smem, int tid) {
    constexpr int KS = GRP ? 2 : 4;
    const int lane = tid & 63, wv = tid >> 6, r32 = lane & 31, hh = lane >> 5;
    const int mp = GRP ? (wv >> 1) : 0, sub = GRP ? (wv & 1) : wv;
    const int jq = qb * (GRP ? 64 : 128) + sub * 32 + r32;
    const bfu* Qg = (const bfu*)(ws_ + (GRP ? WS_QB : WS_QA)) + (((size_t)b * 4 + h) * NKEY + jq) * 64 + mp * 32;
    const bfu* Kg = GRP ? (const bfu*)(ws_ + WS_KB) + ((size_t)b * 4 + h) * NKEY * 64 : (const bfu*)(ws_ + WS_KA) + ((size_t)b * 2 + (h >> 1)) * NKEY * 64;
    const bfu* Vg = GRP ? (const bfu*)(ws_ + WS_VBT) + ((size_t)b * 4 + h) * 64 * NKEY : (const bfu*)(ws_ + WS_VAT) + ((size_t)b * 2 + (h >> 1)) * 64 * NKEY;
    bf16x8 qf[KS];
#pragma unroll
    for (int ks = 0; ks < KS; ++ks) qf[ks] = *(const bf16x8*)(Qg + ks * 16 + hh * 8);
    f32x16 oacc[2];
    float lrun = 0.f;
#pragma unroll
    for (int db = 0; db < 2; ++db)
#pragma unroll
        for (int i = 0; i < 16; ++i) oacc[db][i] = 0.f;
    const int lrow = tid >> 3, lch = ((tid & 7) ^ ((tid >> 4) & 7)) * 8;
    const bfu* kp0 = Kg + (size_t)lrow * 64 + lch; const bfu* kp1 = kp0 + 32 * 64;
    const bfu* vp0 = Vg + (size_t)lrow * NKEY + lch; const bfu* vp1 = vp0 + (size_t)32 * NKEY;
    char* ldst = smem + tid * 16;
#define AT_ISSUE(t_) { char* d_ = ldst + ((t_) & 1) * 16384; const size_t ko_ = (size_t)(t_) * 64 * 64; const int vo_ = (t_) * 64; \
        GLDS(kp0 + ko_, d_); GLDS(kp1 + ko_, d_ + 4096); GLDS(vp0 + vo_, d_ + 8192); GLDS(vp1 + vo_, d_ + 12288); }
    __syncthreads();
    AT_ISSUE(0)
    const int nt = nkeys >> 6;
    float mref = 0.f;
    const int swv = (r32 >> 1) & 7;
    for (int t = 0; t < nt; ++t) {
        asm volatile("s_waitcnt vmcnt(0)" ::: "memory");
        __syncthreads();
        if (t + 1 < nt) AT_ISSUE(t + 1)
        const char* cK = smem + (t & 1) * 16384; const char* cV = cK + 8192;
        f32x16 sacc[2];
        const float ninit = -mref;
#pragma unroll
        for (int kb = 0; kb < 2; ++kb) {
#pragma unroll
            for (int i = 0; i < 16; ++i) sacc[kb][i] = ninit;
            const int key = kb * 32 + r32;
#pragma unroll
            for (int ks = 0; ks < KS; ++ks) {
                const int c0 = mp * 4 + ks * 2 + hh;
                const bf16x8 kf = *(const bf16x8*)(cK + key * 128 + ((c0 ^ ((key >> 1) & 7)) * 16));
                sacc[kb] = __builtin_amdgcn_mfma_f32_32x32x16_bf16(kf, qf[ks], sacc[kb], 0, 0, 0);
            }
        }
        float mx = sacc[0][0];
#pragma unroll
        for (int i = 1; i < 16; ++i) mx = fmaxf(mx, sacc[0][i]);
#pragma unroll
        for (int i = 0; i < 16; ++i) mx = fmaxf(mx, sacc[1][i]);
        mx = xor32_max(mx);
        const bool need = (t == 0) || (mx > 8.f);
        if (__any(need)) {
            const float delta = need ? mx : 0.f;
            const float alpha = __builtin_amdgcn_exp2f(-delta);
            mref += delta; lrun *= alpha;
#pragma unroll
            for (int db = 0; db < 2; ++db)
#pragma unroll
                for (int i = 0; i < 16; ++i) oacc[db][i] *= alpha;
#pragma unroll
            for (int kb = 0; kb < 2; ++kb)
#pragma unroll
                for (int i = 0; i < 16; ++i) sacc[kb][i] -= delta;
        }
        float ps = 0.f;
#pragma unroll
        for (int kb = 0; kb < 2; ++kb)
#pragma unroll
            for (int i = 0; i < 16; ++i) { const float pv = __builtin_amdgcn_exp2f(sacc[kb][i]); sacc[kb][i] = pv; ps += pv; }
        lrun += ps;
#pragma unroll
        for (int kb = 0; kb < 2; ++kb)
#pragma unroll
            for (int s2 = 0; s2 < 2; ++s2) {
                union { bf16x8 v; unsigned u[4]; } pf;
#pragma unroll
                for (int i = 0; i < 4; ++i) pf.u[i] = pack2(sacc[kb][8 * s2 + 2 * i], sacc[kb][8 * s2 + 2 * i + 1]);
#pragma unroll
                for (int db = 0; db < 2; ++db) {
                    const char* vr = cV + (db * 32 + r32) * 128 + hh * 8;
                    union { bf16x8 v; uint2 u[2]; } vf;
                    vf.u[0] = *(const uint2*)(vr + (((kb * 4 + s2 * 2) ^ swv) * 16)); vf.u[1] = *(const uint2*)(vr + (((kb * 4 + s2 * 2 + 1) ^ swv) * 16));
                    oacc[db] = __builtin_amdgcn_mfma_f32_32x32x16_bf16(vf.v, pf.v, oacc[db], 0, 0, 0);
                }
            }
    }
    __syncthreads();
    bfu* MIX = (bfu*)(ws_ + WS_MIX);
    const int grow = grow_of(b, jq);
    const float il = 1.f / xor32_sum(lrun);
    if (GRP == 0) {
        bfu* dst = MIX + (size_t)grow * DM + h * 64;
#pragma unroll
        for (int db = 0; db < 2; ++db)
#pragma unroll
            for (int g = 0; g < 4; ++g)
                *(uint2*)(dst + db * 32 + g * 8 + hh * 4) = make_uint2(pack2(oacc[db][4 * g] * il, oacc[db][4 * g + 1] * il), pack2(oacc[db][4 * g + 2] * il, oacc[db][4 * g + 3] * il));
    } else {
        float* xs = (float*)smem + sub * 2048;
        if (mp == 1) {
            const float sc2 = lam * il;
#pragma unroll
            for (int db = 0; db < 2; ++db)
#pragma unroll
                for (int i = 0; i < 16; ++i) xs[(db * 16 + i) * 64 + lane] = oacc[db][i] * sc2;
        }
        __syncthreads();
        if (mp == 0) {
            float ss = 0.f;
#pragma unroll
            for (int db = 0; db < 2; ++db)
#pragma unroll
                for (int i = 0; i < 16; ++i) { const float o = oacc[db][i] * il - xs[(db * 16 + i) * 64 + lane]; oacc[db][i] = o; ss += o * o; }
            ss = xor32_sum(ss);
            const float rs = rsqrtf(ss * (1.f / 64.f) + 1e-6f) * (1.f - lam_init);
            const float* gn = p.b_subln + layer * 64;
            bfu* dst = MIX + (size_t)grow * DM + 256 + h * 64;
#pragma unroll
            for (int db = 0; db < 2; ++db)
#pragma unroll
                for (int g = 0; g < 4; ++g) {
                    const int d = db * 32 + g * 8 + hh * 4;
                    *(uint2*)(dst + d) = make_uint2(pack2(oacc[db][4 * g] * rs * gn[d], oacc[db][4 * g + 1] * rs * gn[d + 1]), pack2(oacc[db][4 * g + 2] * rs * gn[d + 2], oacc[db][4 * g + 3] * rs * gn[d + 3]));
                }
        }
    }
}
__device__ void phase_attn(KP p, int wsid_, int layer, bool do_ctx, unsigned* qctr, unsigned* cctr, int* s_item, char* smem) {
    PHASE_PROLOGUE
    const int tid = tid_;
    const float lam_init = 0.8f - 0.6f * expf(-0.3f * (float)layer);
    float d1 = 0.f, d2 = 0.f;
    for (int i = 0; i < 32; ++i) { d1 += p.b_lq1[layer * 32 + i] * p.b_lk1[layer * 32 + i]; d2 += p.b_lq2[layer * 32 + i] * p.b_lk2[layer * 32 + i]; }
    const float lam = expf(d1) - expf(d2) + lam_init;
    const int nitems = do_ctx ? 1728 : 1536;
    bool conv_left = cctr != nullptr;
    for (;;) {
        __syncthreads();
        if (TID512 == 0) *s_item = (int)atomicAdd(qctr, 1u);
        __syncthreads();
        const int pair_ = __builtin_amdgcn_readfirstlane(*s_item);
        if (2 * pair_ >= nitems) break;
        const int it = 2 * pair_ + hb_;
        int grp, b, h, qb, nkeys;
        if (it < 512) { grp = 0; qb = 2 + (it & 15); h = (it >> 4) & 3; b = it >> 6; nkeys = NKEY; }
        else if (it < 1536) { grp = 1; const int r = it - 512; qb = 4 + (r & 31); h = (r >> 5) & 3; b = r >> 7; nkeys = NKEY; }
        else if (it < 1664) { grp = 1; const int r = it - 1536; qb = r & 3; h = (r >> 2) & 3; b = r >> 4; nkeys = 256; }
        else { grp = 0; const int r = it - 1664; qb = r & 1; h = (r >> 1) & 3; b = r >> 3; nkeys = 256; }
        if (grp) attn_item<1>(p, wsid_, ws_, layer, b, h, qb, nkeys, lam, lam_init, smem, tid);
        else attn_item<0>(p, wsid_, ws_, layer, b, h, qb, nkeys, lam, lam_init, smem, tid);
        if (conv_left) conv_left = conv_big_step(p, wsid_, ws_, layer, cctr, s_item, smem, tid, hb_);
    }
    while (conv_left) conv_left = conv_big_step(p, wsid_, ws_, layer, cctr, s_item, smem, tid, hb_);
}

__device__ void phase_outproj(KP p, int wsid_, int layer, int nrows, int bid, int nb, char* smem) {
    PHASE_PROLOGUE
    const bfu* MIX = (const bfu*)(ws_ + WS_MIX); const bfu* W = (const bfu*)(ws_ + WS_WOUT);
    float* X = (float*)(ws_ + WS_X); const float* mod = (const float*)(ws_ + WS_MOD);
    const int nitems = (nrows / 128) * 8;
    for (int it = bid; it < nitems; it += nb) {
        const int mt = it >> 3, nt = it & 7, row0 = mt * 128, col0 = nt * 128;
        int b, j0, s; row_info(row0, b, j0, s);
        const float* ga = mod + ((size_t)layer * 9 + s) * 6144 + 2 * 1024;
        gemm_tile([&](int r) { return MIX + (size_t)(row0 + r) * DM; }, [&](int r) { return W + (size_t)(col0 + r) * DM; }, DM,
            [&](f32x4 (&acc)[4][4], int wr, int wc, int fr, int fq) {
                ACC_FOREACH({ float* xp = X + (size_t)(row0 + row) * DM + col0 + col; *xp += ga[col0 + col] * val; })
            }, smem, wsid_);
    }
}

__device__ void phase_norm2_route(KP p, int wsid_, int layer, int nrows, int bid, int nb, char* smem, bool dry = false) {
    PHASE_PROLOGUE
    const float* X = (const float*)(ws_ + WS_X); bfu* H = (bfu*)(ws_ + WS_H);
    const float* mod = (const float*)(ws_ + WS_MOD); const float* WRT = (const float*)(ws_ + WS_WRT);
    int* ECNT = (int*)(ws_ + WS_ECNT) + layer * 32; int* EIDX = (int*)(ws_ + WS_EIDX); float* EGATE = (float*)(ws_ + WS_EGATE); int* ELIST = (int*)(ws_ + WS_ELIST);
    float* lg = (float*)smem;
    int* lcnt = (int*)(lg + 4 * 16 * 48);
    int* lbase = lcnt + 32;
    int* lsel = lbase + 32;
    int* lrank = lsel + 128;
    char* slab = smem + 14336;
    constexpr int SLAB = 27136;
    const bfu* WH = (const bfu*)(ws_ + WS_WRTH); const bfu* WL = (const bfu*)(ws_ + WS_WRTL);
    const int tid = tid_, lane = tid & 63, wv = tid >> 6, r = lane & 15, kq = lane >> 4;
    const float* gf = p.g_ffn + layer * DM;
    const float* bg = p.r_b_group + layer * 4; const float* be = p.r_b_expert + layer * 32;
    const int nitems = nrows / 64;
    for (int it = bid; it < nitems; it += nb) {
        const int row = it * 64 + wv * 16 + r;
        int b, j, s; row_info(row, b, j, s);
        const float* xr = X + (size_t)row * DM;
        const float* sh = mod + ((size_t)layer * 9 + s) * 6144 + 3 * 1024; const float* sc = sh + 1024;
        if (tid < 32) lcnt[tid] = 0;
        float ss = 0.f;
#pragma unroll 16
        for (int c = 0; c < 64; ++c) { const float4 v = *(const float4*)(xr + c * 16 + kq * 4); ss += v.x * v.x + v.y * v.y + v.z * v.z + v.w * v.w; }
        ss = xor32_sum(xor16_sum(ss));
        const float rs = rsqrtf(ss * (1.f / 1024.f) + 1e-6f);
        f32x4 acc[3];
#pragma unroll
        for (int n = 0; n < 3; ++n) acc[n] = (f32x4){0.f, 0.f, 0.f, 0.f};
        uint4 sw0, sw1, sw2, sw3, sw4, sw5; float4 sg = make_float4(0.f, 0.f, 0.f, 0.f);
        const int ch0 = tid, ch1 = tid + 256, ch2 = tid + 512;
        const size_t wo0 = (size_t)(ch0 >> 4) * DM + (ch0 & 15) * 8, wo1 = (size_t)(ch1 >> 4) * DM + (ch1 & 15) * 8, wo2 = (size_t)(ch2 >> 4) * DM + (ch2 & 15) * 8;
        const int lo0 = (ch0 >> 4) * 272 + (ch0 & 15) * 16, lo1 = (ch1 >> 4) * 272 + (ch1 & 15) * 16, lo2 = (ch2 >> 4) * 272 + (ch2 & 15) * 16;
#define RT_SLAB_LOAD(sb_) { const int k0_ = (sb_) * 128; \
            sw0 = *(const uint4*)(WH + wo0 + k0_); sw1 = *(const uint4*)(WH + wo1 + k0_); sw2 = *(const uint4*)(WH + wo2 + k0_); \
            sw3 = *(const uint4*)(WL + wo0 + k0_); sw4 = *(const uint4*)(WL + wo1 + k0_); sw5 = *(const uint4*)(WL + wo2 + k0_); \
            if (tid < 32) { const float4 g4 = *(const float4*)(gf + k0_ + tid * 4), s4_ = *(const float4*)(sc + k0_ + tid * 4); sg = make_float4(g4.x * (1.f + s4_.x), g4.y * (1.f + s4_.y), g4.z * (1.f + s4_.z), g4.w * (1.f + s4_.w)); } \
            else if (tid < 64) sg = *(const float4*)(sh + k0_ + (tid - 32) * 4); }
#define RT_SLAB_STORE(buf_) { char* d_ = slab + (buf_) * SLAB; \
            *(uint4*)(d_ + lo0) = sw0; *(uint4*)(d_ + lo1) = sw1; *(uint4*)(d_ + lo2) = sw2; *(uint4*)(d_ + 13056 + lo0) = sw3; *(uint4*)(d_ + 13056 + lo1) = sw4; *(uint4*)(d_ + 13056 + lo2) = sw5; \
            if (tid < 64) *(float4*)(d_ + 26112 + tid * 16) = sg; }
        float4 xq0, xq1, xq2, xq3, xq4, xq5, xq6, xq7;
#define RT_X_LOAD(sb_) { const float* x_ = xr + (sb_) * 128 + kq * 8; xq0 = *(const float4*)(x_); xq1 = *(const float4*)(x_ + 4); xq2 = *(const float4*)(x_ + 32); xq3 = *(const float4*)(x_ + 36); \
            xq4 = *(const float4*)(x_ + 64); xq5 = *(const float4*)(x_ + 68); xq6 = *(const float4*)(x_ + 96); xq7 = *(const float4*)(x_ + 100); }
        __syncthreads();
        RT_SLAB_LOAD(0) RT_SLAB_STORE(0) RT_X_LOAD(0)
        __syncthreads();
        for (int sb = 0; sb < 8; ++sb) {
            if (sb + 1 < 8) RT_SLAB_LOAD(sb + 1)
            const float4 xc[8] = {xq0, xq1, xq2, xq3, xq4, xq5, xq6, xq7};
            if (sb + 1 < 8) RT_X_LOAD(sb + 1)
            const char* d = slab + (sb & 1) * SLAB;
#pragma unroll
            for (int s4 = 0; s4 < 4; ++s4) {
                const float4 g0 = *(const float4*)(d + 26112 + (s4 * 32 + kq * 8) * 4), g1 = *(const float4*)(d + 26112 + (s4 * 32 + kq * 8 + 4) * 4);
                const float4 h0 = *(const float4*)(d + 26624 + (s4 * 32 + kq * 8) * 4), h1 = *(const float4*)(d + 26624 + (s4 * 32 + kq * 8 + 4) * 4);
                const float4 xa = xc[2 * s4], xb = xc[2 * s4 + 1];
                float f[8];
                f[0] = xa.x * rs * g0.x + h0.x; f[1] = xa.y * rs * g0.y + h0.y; f[2] = xa.z * rs * g0.z + h0.z; f[3] = xa.w * rs * g0.w + h0.w;
                f[4] = xb.x * rs * g1.x + h1.x; f[5] = xb.y * rs * g1.y + h1.y; f[6] = xb.z * rs * g1.z + h1.z; f[7] = xb.w * rs * g1.w + h1.w;
                unsigned hi[4], lo[4];
#pragma unroll
                for (int i = 0; i < 4; ++i) {
                    hi[i] = pack2(f[2 * i], f[2 * i + 1]);
                    lo[i] = pack2(f[2 * i] - __uint_as_float(hi[i] << 16), f[2 * i + 1] - __uint_as_float(hi[i] & 0xFFFF0000u));
                }
                *(uint4*)(H + (size_t)row * DM + sb * 128 + s4 * 32 + kq * 8) = make_uint4(hi[0], hi[1], hi[2], hi[3]);
                const bf16x8 ah = mk8(hi[0], hi[1], hi[2], hi[3]), al = mk8(lo[0], lo[1], lo[2], lo[3]);
#pragma unroll
                for (int n = 0; n < 3; ++n) {
                    const bf16x8 wh = *(const bf16x8*)(d + (n * 16 + r) * 272 + (s4 * 32 + kq * 8) * 2), wl = *(const bf16x8*)(d + 13056 + (n * 16 + r) * 272 + (s4 * 32 + kq * 8) * 2);
                    acc[n] = __builtin_amdgcn_mfma_f32_16x16x32_bf16(ah, wh, acc[n], 0, 0, 0);
                    acc[n] = __builtin_amdgcn_mfma_f32_16x16x32_bf16(ah, wl, acc[n], 0, 0, 0);
                    acc[n] = __builtin_amdgcn_mfma_f32_16x16x32_bf16(al, wh, acc[n], 0, 0, 0);
                }
            }
            if (sb + 1 < 8) RT_SLAB_STORE((sb + 1) & 1)
            __syncthreads();
        }
#pragma unroll
        for (int n = 0; n < 3; ++n)
#pragma unroll
            for (int jj = 0; jj < 4; ++jj) lg[(wv * 16 + kq * 4 + jj) * 48 + n * 16 + r] = acc[n][jj];
        __syncthreads();
        if (lane < 16) {
            const float* L = lg + (wv * 16 + lane) * 48;
            const int grow = it * 64 + wv * 16 + lane;
            float gl[4]; float gm = -1e30f; int gi = 0;
#pragma unroll
            for (int g = 0; g < 4; ++g) { gl[g] = L[g] + bg[g]; if (gl[g] > gm) { gm = gl[g]; gi = g; } }
            float gs = 0.f;
#pragma unroll
            for (int g = 0; g < 4; ++g) gs += __expf(gl[g] - gm);
            const float gp = 1.f / gs;
            float v1 = -1e30f, v2 = -1e30f; int i1 = 0, i2 = 0;
            for (int e = 0; e < 8; ++e) {
                const float v = L[4 + gi * 8 + e] + be[gi * 8 + e];
                if (v > v1) { v2 = v1; i2 = i1; v1 = v; i1 = e; } else if (v > v2) { v2 = v; i2 = e; }
            }
            const float e2 = __expf(v2 - v1), den = 1.f / (1.f + e2);
            const int ex1 = gi * 8 + i1, ex2 = gi * 8 + i2;
            EIDX[grow * 2] = ex1; EIDX[grow * 2 + 1] = ex2;
            EGATE[grow * 2] = den * gp; EGATE[grow * 2 + 1] = e2 * den * gp;
            const int lr = wv * 16 + lane;
            lsel[lr * 2] = ex1; lsel[lr * 2 + 1] = ex2;
            lrank[lr * 2] = atomicAdd(&lcnt[ex1], 1); lrank[lr * 2 + 1] = atomicAdd(&lcnt[ex2], 1);
        }
        __syncthreads();
        if (tid < 32) lbase[tid] = (lcnt[tid] > 0 && !dry) ? atomicAdd(&ECNT[tid], lcnt[tid]) : 0;
        __syncthreads();
        if (tid < 128 && !dry) { const int e = lsel[tid]; ELIST[(size_t)e * (2 * MA) + lbase[e] + lrank[tid]] = ((it * 64 + (tid >> 1)) << 1) | (tid & 1); }
        __syncthreads();
    }
}

__device__ __forceinline__ int moe_prefix256(const int* ECNT, int* spre  , int wsid_) {
    if (TID512 == 0) { int a = 0; for (int e = 0; e < 32; ++e) { spre[e] = a; a += (ECNT[e] + 255) >> 8; } spre[32] = a; }
    __syncthreads();
    return spre[32];
}
__device__ void phase_outproj256(KP p, int wsid_, int layer, int nrows, int vblk, int nblk, char* smem_all, unsigned* cctr, int* s_item, float gscale = 1.f) {
    PHASE_PROLOGUE
    const bfu* MIX = (const bfu*)(ws_ + WS_MIX); const bfu* W = (const bfu*)(ws_ + WS_WOUT);
    const float* mod = (const float*)(ws_ + WS_MOD);
    const int nitems = (nrows >> 8) * 4;
    for (int it = vblk; it < nitems; it += nblk) {
        const int mt = it >> 2, nt = it & 3, row0 = mt * 256, col0 = nt * 256;
        int b, j0, sm; row_info(row0, b, j0, sm);
        const float* ga = mod + ((size_t)layer * 9 + sm) * 6144 + 2 * 1024 + col0;
        const bfu* B0 = W + (size_t)col0 * DM;
        gemm256<DM, DM, DM>(MIX, [&](int r) { return row0 + r; }, B0, B0 + (size_t)128 * DM,
            [&](f32x4 (&acc)[2][2][4][2], int wr, int wc, int fr, int fq) {
                const __amdgpu_buffer_rsrc_t rs = __builtin_amdgcn_make_buffer_rsrc((void*)(ws_ + WS_X), 0, (int)((size_t)MA * DM * 4), 0x00020000);
                const int voff = ((wr * 64 + fq * 4) * DM + wc * 32 + fr) * 4;
#pragma unroll
                for (int bj = 0; bj < 2; ++bj)
#pragma unroll
                    for (int n = 0; n < 2; ++n) {
                        const float g = ga[bj * 128 + wc * 32 + n * 16 + fr] * gscale;
#pragma unroll
                        for (int ai = 0; ai < 2; ++ai)
#pragma unroll
                            for (int m = 0; m < 4; ++m)
#pragma unroll
                                for (int j = 0; j < 4; ++j) {
                                    const int so = ((row0 + ai * 128 + m * 16 + j) * DM + col0 + bj * 128 + n * 16) * 4;
                                    const float xo = __uint_as_float(__builtin_amdgcn_raw_buffer_load_b32(rs, voff, so, 0));
                                    __builtin_amdgcn_raw_buffer_store_b32(__float_as_uint(xo + g * acc[ai][bj][m][n][j]), rs, voff, so, 0);
                                }
                    }
            }, smem_all, wsid_);
    }
    if (nitems > nblk && vblk >= nitems - nblk) { for (int q = 0; q < 5; ++q) if (!conv_big_step(p, wsid_, ws_, layer, cctr, s_item, smem_all + hb_ * SMEM_BYTES, tid_, hb_)) break; }
}
__device__ void phase_experts256(KP p, int wsid_, int layer, int vblk, int nblk, unsigned* rbcnt, char* smem_all) {
    PHASE_PROLOGUE
    const bfu* H = (const bfu*)(ws_ + WS_H); const bfu* W1 = (const bfu*)(ws_ + WS_W1); const bfu* W3 = (const bfu*)(ws_ + WS_W3);
    const bfu* HB = (const bfu*)(ws_ + WS_HB); const bfu* W2 = (const bfu*)(ws_ + WS_W2);
    const int* ECNT = (const int*)(ws_ + WS_ECNT) + layer * 32; const int* ELIST = (const int*)(ws_ + WS_ELIST); const float* EGATE = (const float*)(ws_ + WS_EGATE);
    int* spre = (int*)(smem_all + 135168);
    const int nb256 = __builtin_amdgcn_readfirstlane(moe_prefix256(ECNT, spre, wsid_));
    const int n1 = nb256 * 4;
    for (int it = vblk; it < 2 * n1; it += nblk) {
        const bool second = it >= n1;
        const int t = second ? it - n1 : it, blk = t >> 2, nt = t & 3;
        int e = 0;
        while (__builtin_amdgcn_readfirstlane(spre[e + 1]) <= blk) ++e;
        const int rb = blk - __builtin_amdgcn_readfirstlane(spre[e]), cnt = __builtin_amdgcn_readfirstlane(ECNT[e]);
        const int* lst = ELIST + (size_t)e * (2 * MA) + rb * 256;
        const int nvalid = min(256, cnt - rb * 256);
        if (!second) {
            const bfu* w1 = W1 + ((size_t)e * FF + nt * 128) * DM; const bfu* w3 = W3 + ((size_t)e * FF + nt * 128) * DM;
            gemm256<DM, DM, DM>(H, [&](int r) { return r < nvalid ? (lst[r] >> 1) : 0; }, w1, w3,
                [&](f32x4 (&acc)[2][2][4][2], int wr, int wc, int fr, int fq) {
                    const __amdgpu_buffer_rsrc_t rs = __builtin_amdgcn_make_buffer_rsrc((void*)(ws_ + WS_HB), 0, (int)((size_t)(2 * MA + 32 * 256) * FF * 2), 0x00020000);
                    const int voff = ((wr * 64 + fq * 4) * FF + wc * 32 + fr) * 2;
#pragma unroll
                    for (int ai = 0; ai < 2; ++ai)
#pragma unroll
                        for (int m = 0; m < 4; ++m)
#pragma unroll
                            for (int n = 0; n < 2; ++n)
#pragma unroll
                                for (int j = 0; j < 4; ++j) {
                                    const float a = acc[ai][0][m][n][j], g = acc[ai][1][m][n][j];
                                    __builtin_amdgcn_raw_buffer_store_b16(f2bf(siluf_(a) * g), rs, voff, ((blk * 256 + ai * 128 + m * 16 + j) * FF + nt * 128 + n * 16) * 2, 16);
                                }
                    asm volatile("s_waitcnt vmcnt(0)" ::: "memory");
                    __syncthreads();
                    if (TID512 == 0) __hip_atomic_fetch_add(rbcnt + blk, 1u, __ATOMIC_RELAXED, __HIP_MEMORY_SCOPE_AGENT);
                }, smem_all, wsid_);
        } else {
            if (TID512 == 0) {
                unsigned spins = 0;
                while (__hip_atomic_load(rbcnt + blk, __ATOMIC_RELAXED, __HIP_MEMORY_SCOPE_AGENT) < 4u) { __builtin_amdgcn_s_sleep(1); if (++spins > (1u << 22)) break; }
                __builtin_amdgcn_fence(__ATOMIC_ACQUIRE, "agent");
                asm volatile("s_waitcnt vmcnt(0)" ::: "memory");
            }
            __syncthreads();
            const bfu* w2 = W2 + ((size_t)e * DM + nt * 256) * FF;
            gemm256<FF, FF, FF>(HB, [&](int r) { return blk * 256 + r; }, w2, w2 + (size_t)128 * FF,
                [&](f32x4 (&acc)[2][2][4][2], int wr, int wc, int fr, int fq) {
                    int* sOff = (int*)smem_all; float* sGt = (float*)(smem_all + 1024);
                    { const int r = TID512;
                      if (r < 256) {
                          const bool ok = r < nvalid; const int ent = ok ? lst[r] : 0;
                          sOff[r] = ok ? ((ent & 1) * MA + (ent >> 1)) * DM * 2 : -1; sGt[r] = EGATE[ent];
                      } }
                    __syncthreads();
                    const __amdgpu_buffer_rsrc_t rs = __builtin_amdgcn_make_buffer_rsrc((void*)(ws_ + WS_Y01), 0, (int)((size_t)2 * MA * DM * 2), 0x00020000);
                    const int cofs = (nt * 256 + wc * 32 + fr) * 2;
#pragma unroll
                    for (int ai = 0; ai < 2; ++ai)
#pragma unroll
                        for (int m = 0; m < 4; ++m) {
                            const int4 o4 = *(const int4*)(sOff + ai * 128 + wr * 64 + m * 16 + fq * 4); const float4 g4 = *(const float4*)(sGt + ai * 128 + wr * 64 + m * 16 + fq * 4);
                            const int oo[4] = {o4.x, o4.y, o4.z, o4.w}; const float gg[4] = {g4.x, g4.y, g4.z, g4.w};
#pragma unroll
                            for (int j = 0; j < 4; ++j) {
                                if (oo[j] >= 0) {
#pragma unroll
                                    for (int bj = 0; bj < 2; ++bj)
#pragma unroll
                                        for (int n = 0; n < 2; ++n)
                                            __builtin_amdgcn_raw_buffer_store_b16(f2bf(gg[j] * acc[ai][bj][m][n][j]), rs, oo[j] + cofs, (bj * 128 + n * 16) * 2, 0);
                                }
                            }
                        }
                }, smem_all, wsid_);
        }
    }
}

__device__ __forceinline__ int moe_prefix(const int* ECNT, int* spre  , int wsid_) {
    if ((TID512 & 255) == 0) { int a = 0; for (int e = 0; e < 32; ++e) { spre[e] = a; a += (ECNT[e] + 127) >> 7; } spre[32] = a; }
    __syncthreads();
    return spre[32];
}
__device__ void phase_expert1(KP p, int wsid_, int layer, int bid, int nb, char* smem) {
    PHASE_PROLOGUE
    const bfu* H = (const bfu*)(ws_ + WS_H); const bfu* W1 = (const bfu*)(ws_ + WS_W1); const bfu* W3 = (const bfu*)(ws_ + WS_W3);
    bfu* HB = (bfu*)(ws_ + WS_HB);
    const int* ECNT = (const int*)(ws_ + WS_ECNT) + layer * 32; const int* ELIST = (const int*)(ws_ + WS_ELIST);
    int* spre = (int*)(smem + 65536);
    const int nblk = moe_prefix(ECNT, spre, wsid_);
    const int nitems = nblk * 8;
    for (int it = bid; it < nitems; it += nb) {
        const int blk = it >> 3, nt = it & 7;
        int e = 0;
        while (spre[e + 1] <= blk) ++e;
        const int rb = blk - spre[e], cnt = ECNT[e];
        const int* lst = ELIST + (size_t)e * (2 * MA) + rb * 128;
        const int nvalid = min(128, cnt - rb * 128);
        const bfu* w1 = W1 + (size_t)e * FF * DM; const bfu* w3 = W3 + (size_t)e * FF * DM;
        bfu* hb = HB + (size_t)blk * 128 * FF;
        gemm_tile([&](int r) { const int tok = r < nvalid ? (lst[r] >> 1) : 0; return H + (size_t)tok * DM; },
                  [&](int r) { const int wcx = r >> 6, n4 = (r >> 4) & 3, rr = r & 15; const int hc = nt * 64 + wcx * 32 + (n4 & 1) * 16 + rr; return (n4 < 2 ? w1 : w3) + (size_t)hc * DM; }, DM,
            [&](f32x4 (&acc)[4][4], int wr, int wc, int fr, int fq) {
#pragma unroll
                for (int m = 0; m < 4; ++m)
#pragma unroll
                    for (int n = 0; n < 2; ++n)
#pragma unroll
                        for (int jj = 0; jj < 4; ++jj) {
                            const int row = wr * 64 + m * 16 + fq * 4 + jj; const int hc = nt * 64 + wc * 32 + n * 16 + fr;
                            const float a = acc[m][n][jj], g = acc[m][n + 2][jj];
                            hb[(size_t)row * FF + hc] = f2bf(siluf_(a) * g);
                        }
            }, smem, wsid_);
    }
}
__device__ void phase_expert2(KP p, int wsid_, int layer, int bid, int nb, char* smem) {
    PHASE_PROLOGUE
    const bfu* HB = (const bfu*)(ws_ + WS_HB); const bfu* W2 = (const bfu*)(ws_ + WS_W2);
    float* Y = (float*)(ws_ + WS_Y01);
    const int* ECNT = (const int*)(ws_ + WS_ECNT) + layer * 32; const int* ELIST = (const int*)(ws_ + WS_ELIST); const float* EGATE = (const float*)(ws_ + WS_EGATE);
    int* spre = (int*)(smem + 65536);
    const int nblk = moe_prefix(ECNT, spre, wsid_);
    const int nitems = nblk * 8;
    for (int it = bid; it < nitems; it += nb) {
        const int blk = it >> 3, nt = it & 7;
        int e = 0;
        while (spre[e + 1] <= blk) ++e;
        const int rb = blk - spre[e], cnt = ECNT[e];
        const int* lst = ELIST + (size_t)e * (2 * MA) + rb * 128;
        const int nvalid = min(128, cnt - rb * 128);
        const bfu* w2 = W2 + (size_t)e * DM * FF;
        const bfu* hb = HB + (size_t)blk * 128 * FF;
        gemm_tile([&](int r) { return hb + (size_t)r * FF; }, [&](int r) { return w2 + (size_t)(nt * 128 + r) * FF; }, FF,
            [&](f32x4 (&acc)[4][4], int wr, int wc, int fr, int fq) {
#pragma unroll
                for (int m = 0; m < 4; ++m)
#pragma unroll
                    for (int jj = 0; jj < 4; ++jj) {
                        const int row = wr * 64 + m * 16 + fq * 4 + jj;
                        if (row < nvalid) {
                            const int ent = lst[row]; const float gt = EGATE[ent];
                            float* yp = Y + ((size_t)(ent & 1) * MA + (ent >> 1)) * DM + nt * 128 + wc * 64 + fr;
#pragma unroll
                            for (int n = 0; n < 4; ++n) yp[n * 16] = gt * acc[m][n][jj];
                        }
                    }
            }, smem, wsid_);
    }
}

#define XB_TMO      128
#define XB_XCNT(j)  (256  + 64 * (j))
#define XB_XSUB(j)  (1280 + 64 * (j))
#define XB_XGEN(j)  (2304 + 64 * (j))
#define XB_TOP      3328
#define XB_TOPGEN   3392
#define XCD_BAR_WORDS 3456
#define XB_SPIN_CAP (1u << 22)
#define LAS __attribute__((address_space(3)))

__device__ __forceinline__ unsigned xb_ld(unsigned* p)              { return __hip_atomic_load(p, __ATOMIC_RELAXED, __HIP_MEMORY_SCOPE_AGENT); }
__device__ __forceinline__ unsigned xb_add(unsigned* p, unsigned v) { return __hip_atomic_fetch_add(p, v, __ATOMIC_RELAXED, __HIP_MEMORY_SCOPE_AGENT); }
__device__ __forceinline__ unsigned xb_xcc_id() { return (unsigned)__builtin_amdgcn_s_getreg((3 << 11) | 20) & 0xFu; }
#define XB_SPIN(cond, bar) do { unsigned _sp = 0; while (cond) { __builtin_amdgcn_s_sleep(1); \
    if ((++_sp & 255u) == 0u) { if (xb_ld(&(bar)[XB_TMO])) break; if (_sp > XB_SPIN_CAP) { atomicAdd(&(bar)[XB_TMO], 1u); break; } } } } while (0)

struct XcdBarrier {
    unsigned* bar; unsigned x;
    volatile LAS unsigned* st;
};

__device__ __forceinline__ XcdBarrier xcd_barrier_post(unsigned* bar, volatile LAS unsigned* st, int wsid_) {
    XcdBarrier b; b.bar = bar; b.x = xb_xcc_id(); b.st = st;
    if (TID512 == 0) (void)xb_add(&bar[XB_XCNT(b.x)], 1u);
    return b;
}
__device__ __forceinline__ void xcd_barrier_complete(unsigned* bar, unsigned x, unsigned& nloc, unsigned& nx) {
    const unsigned G = gridDim.x * gridDim.y * gridDim.z;
    unsigned sum, cnt, mine, sp = 0u;
    for (;;) {
        sum = 0u; cnt = 0u; mine = 0u;
#pragma unroll
        for (unsigned j = 0; j < 16; ++j) { const unsigned c = xb_ld(&bar[XB_XCNT(j)]); sum += c; cnt += (c > 0u) ? 1u : 0u; mine = (j == x) ? c : mine; }
        if (sum == G) break;
        __builtin_amdgcn_s_sleep(1);
        if ((++sp & 255u) == 0u) { if (xb_ld(&bar[XB_TMO])) break; if (sp > XB_SPIN_CAP) { atomicAdd(&bar[XB_TMO], 1u); break; } }
    }
    nloc = mine > 0u ? mine : 1u; nx = cnt > 0u ? cnt : 1u;
}

__device__ __forceinline__ void xcd_barrier_(const XcdBarrier& b, int wsid_) {
    asm volatile("s_waitcnt vmcnt(0)" ::: "memory");
    __syncthreads();
    if (TID512 == 0) {
        unsigned* bar = b.bar;
        __builtin_amdgcn_s_waitcnt(0);
        unsigned nloc = b.st[0], nx = b.st[1];
        if (nloc == 0u) { xcd_barrier_complete(bar, b.x, nloc, nx); b.st[0] = nloc; b.st[1] = nx; }
        const unsigned old = xb_add(&bar[XB_XSUB(b.x)], 1u);
        const unsigned gen = old / nloc;
        if (old + 1u == (gen + 1u) * nloc) {
            __builtin_amdgcn_fence(__ATOMIC_RELEASE, "agent");
            asm volatile("s_waitcnt vmcnt(0)" ::: "memory");
            const unsigned og = xb_add(&bar[XB_TOP], 1u);
            const unsigned tg = og / nx;
            if (og + 1u == (tg + 1u) * nx) xb_add(&bar[XB_TOPGEN], 1u);
            else XB_SPIN(xb_ld(&bar[XB_TOPGEN]) == tg, bar);
            __builtin_amdgcn_fence(__ATOMIC_ACQUIRE, "agent");
            xb_add(&bar[XB_XGEN(b.x)], 1u);
            asm volatile("s_waitcnt vmcnt(0)" ::: "memory");
        } else {
            XB_SPIN(xb_ld(&bar[XB_XGEN(b.x)]) == gen, bar);
            __builtin_amdgcn_fence(__ATOMIC_ACQUIRE, "agent");
            asm volatile("s_waitcnt vmcnt(0)" ::: "memory");
        }
    }
    __syncthreads();
}


#define REP_MOD 1
#define REP_OUTPROJ 1
#define REP_ROUTE 1
#define REP_NORM1 1
#define REP_CONV 1
#define REP_INPROJ 1
#define REP_RK 1
#define REP_SCANATT 1
#define REP_R4 1
#define REP_ATT 1
#define REP_READOUT 1
#define REP_EXP1 1
#define REP_EXP2 1
#define REPEAT(N) _Pragma("nounroll") for (int rep_ = 0; rep_ < (N); ++rep_)
#define REPEAT2(N) _Pragma("nounroll") for (int rep2_ = 0; rep2_ < (N); ++rep2_)
#define CTL_Q(l) (4096 + 64 * (l))
#define CTL_XR 5120
#define CTL_RBC 6144
__global__ void __launch_bounds__(512, 2) fwd(P p) {
    __shared__ __attribute__((aligned(16))) char smem_all[2 * SMEM_BYTES + 64];
    const int wsid_ = __builtin_amdgcn_readfirstlane((int)(threadIdx.x >> 6));
    const int hb = wsid_ >> 2;
    char* smem = smem_all + hb * SMEM_BYTES;
    uint4& xb_words = *(uint4*)(smem_all + 2 * SMEM_BYTES);
    int& s_item = *(int*)(smem_all + 2 * SMEM_BYTES + 16);
    int& s_vb = *(int*)(smem_all + 2 * SMEM_BYTES + 20);
    if (TID512 == 0) xb_words = make_uint4(0u, 0u, 0u, 0u);
    __syncthreads();
    unsigned* ctl = (unsigned*)(KPARG.ws + WS_CTL);
    XcdBarrier bar = xcd_barrier_post(ctl, (volatile LAS unsigned*)&xb_words, wsid_);
#define xcd_barrier(b_) xcd_barrier_(b_, wsid_)
    const int bid = blockIdx.x * 2 + hb, nb = gridDim.x * 2;
    const unsigned my_xcc = xb_xcc_id();
    if (TID512 == 0) s_vb = (int)atomicAdd(&ctl[CTL_XR + 16 * my_xcc], 1u);
    int vb = bid;
    phase_setup(KPARG, wsid_, bid, nb);
    REPEAT(REP_MOD) phase_mod(KPARG, wsid_, bid, nb, smem);
    for (int l = 0; l < NLAYER; ++l) {
        const int nr = l < NLAYER - 1 ? MA : ML;
        REPEAT(REP_CONV) phase_conv(KPARG, wsid_, l, bid, nb, smem);
        if (l == 0) {
            xcd_barrier(bar);
            if (TID512 == 0) { int pre = 0; for (unsigned x = 0; x < my_xcc; ++x) pre += (int)xb_ld(&ctl[CTL_XR + 16 * x]); s_vb += pre; }
            __syncthreads();
            vb = __builtin_amdgcn_readfirstlane(s_vb) * 2 + hb;
        }
        phase_norm1(KPARG, wsid_, l, 0, bid, nb);
        REPEAT(REP_NORM1 - 1) { xcd_barrier(bar); phase_norm1(KPARG, wsid_, l, 0, bid, nb, false); }
        xcd_barrier(bar);
        REPEAT(REP_INPROJ) { phase_inproj256(KPARG, wsid_, l, vb >> 1, nb >> 1, smem_all, ctl + CTL_Q(l) + 8, &s_item); xcd_barrier(bar); }
        REPEAT(REP_RK) { phase_rk(KPARG, wsid_, l, bid, nb, smem); xcd_barrier(bar); }
        REPEAT(REP_SCANATT) {
            if (bid < 128) { REPEAT(REP_R4) phase_r4(KPARG, wsid_, l, bid, 128, smem); }
            else phase_gate(KPARG, wsid_, l, bid - 128, nb - 128, smem);
            REPEAT2(REP_ATT) phase_attn(KPARG, wsid_, l, l < NLAYER - 1, ctl + CTL_Q(l) + 16 * rep_ + 32 * rep2_, l < NLAYER - 1 ? nullptr : ctl + CTL_Q(l) + 8, &s_item, smem);
            xcd_barrier(bar);
        }
        REPEAT(REP_READOUT) { phase_readout(KPARG, wsid_, l, nr, bid, nb); xcd_barrier(bar); }
        phase_outproj256(KPARG, wsid_, l, nr, vb >> 1, nb >> 1, smem_all, ctl + CTL_Q(l) + 8, &s_item);
        REPEAT(REP_OUTPROJ - 1) { xcd_barrier(bar); phase_outproj256(KPARG, wsid_, l, nr, vb >> 1, nb >> 1, smem_all, ctl + CTL_Q(l) + 8, &s_item, 0.f); }
        xcd_barrier(bar);
        phase_norm2_route(KPARG, wsid_, l, nr, bid, nb, smem);
        phase_conv_drain(KPARG, wsid_, l, ctl + CTL_Q(l) + 8, &s_item, smem);
        REPEAT(REP_ROUTE - 1) { xcd_barrier(bar); phase_norm2_route(KPARG, wsid_, l, nr, bid, nb, smem, true); }
        xcd_barrier(bar);
        phase_experts256(KPARG, wsid_, l, vb >> 1, nb >> 1, ctl + CTL_RBC + 256 * l, smem_all);
        xcd_barrier(bar);
    }
    phase_norm1(KPARG, wsid_, NLAYER, 1, bid, nb);
}

extern "C" void kernel_launch(void* const* d_in, const int* in_sizes, int n_in, void* d_out, int out_size, void* d_ws, size_t ws_size, hipStream_t stream) {
    if (n_in != 36 || ws_size < WS_END) { fprintf(stderr, "kernel_launch: unexpected n_in %d or ws_size %zu < %zu\n", n_in, ws_size, (size_t)WS_END); return; }
    static int grid = 0;
    if (!grid) {
        int dev = 0, cus = 0, per_cu = 0;
        hipGetDevice(&dev);
        hipDeviceGetAttribute(&cus, hipDeviceAttributeMultiprocessorCount, dev);
        hipOccupancyMaxActiveBlocksPerMultiprocessor(&per_cu, (const void*)fwd, 512, 0);
        if (per_cu < 1) per_cu = 1;
        grid = cus;
    }
    P p{};
    const float** pp = (const float**)&p;
    for (int i = 0; i < 36; ++i) pp[i] = (const float*)d_in[i];
    p.out = (float*)d_out; p.ws = (char*)d_ws;
    hipMemsetAsync((char*)d_ws + WS_CTL, 0, 65536, stream);
    fwd<<<grid, 512, 0, stream>>>(p);
}
```

```cpp
#include <hip/hip_runtime.h>
#include <stdint.h>
#include <stdio.h>

typedef unsigned short bfu;
using bf16x8 = __attribute__((ext_vector_type(8))) short;
using f32x4  = __attribute__((ext_vector_type(4))) float;

#define DM 1024
#define NB 8
#define SEQ 2048
#define CL 256
#define NKEY 2304
#define ML 16384
#define MC 2048
#define MA 18432
#define INW 3200
#define CSL 1920
#define NEXP 32
#define FF 512
#define NLAYER 4
#define LOG2E 1.4426950408889634f

#define MBy(x) ((size_t)(x) << 20)
constexpr size_t WS_CTL   = 0;
constexpr size_t WS_MOD   = 65536;
constexpr size_t WS_ROPE  = WS_MOD + (size_t)4 * 9 * 6144 * 4;
constexpr size_t WS_ECNT  = WS_ROPE + 64 * 16 * 2 * 4 + 64 * 8 * 2 * 4;
constexpr size_t WS_WRT   = WS_ECNT + 4096;
constexpr size_t WS_WRTH  = WS_WRT + (size_t)48 * 1024 * 4;
constexpr size_t WS_WRTL  = WS_WRTH + (size_t)48 * 1024 * 2;
constexpr size_t WS_EIDX  = WS_WRTL + (size_t)48 * 1024 * 2;
constexpr size_t WS_EGATE = WS_EIDX + (size_t)MA * 2 * 4;
constexpr size_t WS_ELIST = WS_EGATE + (size_t)MA * 2 * 4;
constexpr size_t WS_X     = MBy(8);
constexpr size_t WS_H     = WS_X + (size_t)MA * DM * 4;
constexpr size_t WS_WIN   = WS_H + (size_t)MA * DM * 2;
constexpr size_t WS_WOUT  = WS_WIN + (size_t)INW * DM * 2;
constexpr size_t WS_W1    = WS_WOUT + (size_t)DM * DM * 2;
constexpr size_t WS_W3    = WS_W1 + (size_t)NEXP * FF * DM * 2;
constexpr size_t WS_W2    = WS_W3 + (size_t)NEXP * FF * DM * 2;
constexpr size_t WS_LW2   = WS_W2 + (size_t)NEXP * FF * DM * 2;
constexpr size_t WS_LA2   = WS_LW2 + (size_t)2 * 512 * 64 * 2;
constexpr size_t WS_LG2   = WS_LA2 + (size_t)2 * 512 * 64 * 2;
constexpr size_t WS_QA    = WS_LG2 + (size_t)512 * 128 * 2;
constexpr size_t WS_KA    = WS_QA + (size_t)NB * 4 * NKEY * 64 * 2;
constexpr size_t WS_VAT   = WS_KA + (size_t)NB * 2 * NKEY * 64 * 2;
constexpr size_t WS_QB    = WS_VAT + (size_t)NB * 2 * NKEY * 64 * 2;
constexpr size_t WS_KB    = WS_QB + (size_t)NB * 4 * NKEY * 64 * 2;
constexpr size_t WS_VBT   = WS_KB + (size_t)NB * 4 * NKEY * 64 * 2;
constexpr size_t WS_CP    = WS_VBT + (size_t)NB * 4 * NKEY * 64 * 2;
constexpr size_t WS_GG    = WS_CP + (size_t)MA * CSL * 4;
constexpr size_t WS_MIX   = WS_GG + (size_t)MA * 512 * 4;
constexpr size_t HEADARR  = (size_t)NB * 8 * NKEY * 64 * 4;
#define OPS_REC 13568
constexpr size_t OPS_DIR  = (size_t)64 * 144 * OPS_REC;
constexpr size_t WS_OPS   = WS_MIX + (size_t)MA * DM * 2;
constexpr size_t WS_YS    = WS_OPS + 2 * OPS_DIR;
constexpr size_t WS_VB    = WS_YS + 2 * HEADARR;
constexpr size_t WS_BETA  = WS_VB + (size_t)MA * 512 * 2;
constexpr size_t WS_LXG   = WS_BETA + (size_t)2 * MA * 8 * 4;
constexpr size_t WS_SCR   = WS_LXG + (size_t)MA * 128 * 2;
constexpr size_t WS_END   = WS_SCR + (size_t)256 * 2 * 128 * 132 * 4;
constexpr size_t WS_Y01   = WS_OPS;
constexpr size_t WS_HB    = WS_OPS + (size_t)2 * MA * DM * 4;
static_assert((size_t)2 * MA * DM * 4 + (size_t)(2 * MA + 32 * 256) * 512 * 2 <= 2 * OPS_DIR, "MoE buffers must fit in OPS");

struct P {
    const float *x, *c, *ctx, *c_ctx, *w_mod, *b_mod, *g_mix, *g_ffn, *w_in, *a_q_gain, *a_k_gain, *b_lq1, *b_lk1, *b_lq2, *b_lk2, *b_subln,
        *c_mu, *c_w0, *c_w2, *c_a0, *c_a2, *c_g2, *c_k_k, *c_k_a, *c_r_k, *c_ln_w, *c_ln_b, *w_out, *r_w_group, *r_b_group, *r_w_expert, *r_b_expert,
        *e_w1, *e_w3, *e_w2, *g_final;
    float* out;
    char* ws;
};

typedef const __attribute__((address_space(4))) P& KP;
#define KPARG (*({ const __attribute__((address_space(4))) P* k_ = (const __attribute__((address_space(4))) P*)__builtin_amdgcn_kernarg_segment_ptr(); asm volatile("" : "+s"(k_)); k_; }))

__device__ __forceinline__ float bf2f(bfu b) { return __uint_as_float((unsigned)b << 16); }
__device__ __forceinline__ unsigned pack2(float a, float b) {
    typedef float f2 __attribute__((ext_vector_type(2)));
    typedef __bf16 b2 __attribute__((ext_vector_type(2)));
    f2 v = {a, b}; b2 r = __builtin_convertvector(v, b2); return __builtin_bit_cast(unsigned, r);
}
__device__ __forceinline__ bfu f2bf(float a) { return (bfu)(pack2(a, 0.f) & 0xFFFFu); }
__device__ __forceinline__ int lane_id_() { int l; asm volatile("v_mbcnt_lo_u32_b32 %0, -1, 0\n\tv_mbcnt_hi_u32_b32 %0, -1, %0" : "=v"(l)); return l; }
__device__ __forceinline__ float shfl_xor_(float v, int o) { return __int_as_float(__builtin_amdgcn_ds_bpermute((lane_id_() ^ o) << 2, __float_as_int(v))); }
template <int CTRL> __device__ __forceinline__ float dppf(float v) { return __int_as_float(__builtin_amdgcn_update_dpp(0, __float_as_int(v), CTRL, 0xF, 0xF, true)); }
__device__ __forceinline__ float sum8(float v) { v += dppf<0xB1>(v); v += dppf<0x4E>(v); v += dppf<0x141>(v); return v; }
__device__ __forceinline__ float xor16_sum(float v) { const auto r = __builtin_amdgcn_permlane16_swap(__float_as_uint(v), __float_as_uint(v), false, false); return __uint_as_float(r[0]) + __uint_as_float(r[1]); }
__device__ __forceinline__ float xor32_sum(float v) { const auto r = __builtin_amdgcn_permlane32_swap(__float_as_uint(v), __float_as_uint(v), false, false); return __uint_as_float(r[0]) + __uint_as_float(r[1]); }
__device__ __forceinline__ float xor32_max(float v) { const auto r = __builtin_amdgcn_permlane32_swap(__float_as_uint(v), __float_as_uint(v), false, false); return fmaxf(__uint_as_float(r[0]), __uint_as_float(r[1])); }
__device__ __forceinline__ float sum64(float v) { v = sum8(v); v += dppf<0x140>(v); v = xor16_sum(v); return xor32_sum(v); }
__device__ __forceinline__ float sigmoidf_(float x) { return __builtin_amdgcn_rcpf(1.f + __expf(-x)); }
__device__ __forceinline__ float siluf_(float x) { return x * __builtin_amdgcn_rcpf(1.f + __expf(-x)); }
__device__ __forceinline__ void row_info(int grow, int& b, int& j, int& s) {
    if (grow < ML) { b = grow >> 11; j = 256 + (grow & 2047); s = b; }
    else { int r = grow - ML; b = r >> 8; j = r & 255; s = 8; }
}
__device__ __forceinline__ int grow_of(int b, int j) { return j < 256 ? ML + b * 256 + j : b * 2048 + (j - 256); }

#define SMEM_BYTES 69632

#define TID512 ((wsid_ << 6) | lane_id_())
#define PHASE_PROLOGUE int tid_ = ((wsid_ & 3) << 6) | lane_id_(); asm volatile("" : "+v"(tid_)); const int hb_ = wsid_ >> 2; (void)hb_; \
    int z_ = 0; asm volatile("" : "+v"(z_)); char* ws_ = p.ws + __builtin_amdgcn_readfirstlane(z_);

__device__ void phase_setup(KP p, int wsid_, int bid, int nb) {
    PHASE_PROLOGUE
    float4* X4 = (float4*)(ws_ + WS_X);
    const float4* x4 = (const float4*)p.x; const float4* c4 = (const float4*)p.ctx;
    const size_t nl = (size_t)ML * DM / 4, nc = (size_t)MC * DM / 4;
    { const size_t stride = (size_t)nb * 256, ntot = nl + nc;
      size_t i0 = (size_t)bid * 256 + tid_;
      for (; i0 + 8 * stride < ntot; i0 += stride * 9) {
#define SU_LD(u) const size_t j##u = i0 + (u) * stride; const float4 t##u = j##u < nl ? x4[j##u] : c4[j##u - nl];
          SU_LD(0) SU_LD(1) SU_LD(2) SU_LD(3) SU_LD(4) SU_LD(5) SU_LD(6) SU_LD(7) SU_LD(8)
          X4[j0] = t0; X4[j1] = t1; X4[j2] = t2; X4[j3] = t3; X4[j4] = t4; X4[j5] = t5; X4[j6] = t6; X4[j7] = t7; X4[j8] = t8;
      }
      for (; i0 < ntot; i0 += stride) X4[i0] = i0 < nl ? x4[i0] : c4[i0 - nl];
    }
    if (bid == 0) {
        float* TA = (float*)(ws_ + WS_ROPE); float* TB = TA + 64 * 16 * 2;
        for (int i = tid_; i < 64 * 16; i += 256) { int pos = i >> 4, f = i & 15; double inv = pow(10000.0, -(double)f / 16.0); double a = (double)pos * inv; TA[i * 2] = (float)cos(a); TA[i * 2 + 1] = (float)sin(a); }
        for (int i = tid_; i < 64 * 8; i += 256) { int pos = i >> 3, f = i & 7; double inv = pow(10000.0, -(double)f / 8.0); double a = (double)pos * inv; TB[i * 2] = (float)cos(a); TB[i * 2 + 1] = (float)sin(a); }
        int* ec = (int*)(ws_ + WS_ECNT);
        for (int i = tid_; i < 128; i += 256) ec[i] = 0;
    }
}

__device__ void phase_mod(KP p, int wsid_, int bid, int nb, char* smem) {
    PHASE_PROLOGUE
    float* act = (float*)smem;
    float* red = act + 9 * 1024;
    for (int i = tid_; i < 9 * 1024; i += 256) { float v = i < 8 * 1024 ? p.c[i] : p.c_ctx[i - 8 * 1024]; act[i] = siluf_(v); }
    __syncthreads();
    float* mod = (float*)(ws_ + WS_MOD);
    const int nitems = 4 * 6144 / 64;
    const int ct = tid_ & 15, kg = tid_ >> 4, wv = tid_ >> 6;
    for (int it = bid; it < nitems; it += nb) {
        const int layer = it / 96, n0 = (it % 96) * 64;
        const float* w = p.w_mod + (size_t)layer * DM * 6144 + (size_t)(kg * 64) * 6144 + n0 + ct * 4;
        float a[9][4];
#pragma unroll
        for (int s = 0; s < 9; ++s) { a[s][0] = 0.f; a[s][1] = 0.f; a[s][2] = 0.f; a[s][3] = 0.f; }
#pragma unroll 1
        for (int k0 = 0; k0 < 64; k0 += 16) {
            float4 wq[16];
#pragma unroll
            for (int j = 0; j < 16; ++j) wq[j] = *(const float4*)(w + (size_t)(k0 + j) * 6144);
#pragma unroll
            for (int j = 0; j < 16; j += 4)
                asm volatile("" : "+v"(wq[j].x), "+v"(wq[j].y), "+v"(wq[j].z), "+v"(wq[j].w), "+v"(wq[j + 1].x), "+v"(wq[j + 1].y), "+v"(wq[j + 1].z), "+v"(wq[j + 1].w),
                                  "+v"(wq[j + 2].x), "+v"(wq[j + 2].y), "+v"(wq[j + 2].z), "+v"(wq[j + 2].w), "+v"(wq[j + 3].x), "+v"(wq[j + 3].y), "+v"(wq[j + 3].z), "+v"(wq[j + 3].w) :: "memory");
#pragma unroll
            for (int j4 = 0; j4 < 4; ++j4)
#pragma unroll
                for (int s = 0; s < 9; ++s) {
                    const float4 av = *(const float4*)(act + s * 1024 + kg * 64 + k0 + j4 * 4);
                    const float avv[4] = {av.x, av.y, av.z, av.w};
#pragma unroll
                    for (int e = 0; e < 4; ++e) { const float4 q = wq[j4 * 4 + e]; a[s][0] += avv[e] * q.x; a[s][1] += avv[e] * q.y; a[s][2] += avv[e] * q.z; a[s][3] += avv[e] * q.w; }
                }
        }
#pragma unroll
        for (int s = 0; s < 9; ++s)
#pragma unroll
            for (int c = 0; c < 4; ++c) { a[s][c] = xor32_sum(xor16_sum(a[s][c])); }
        if ((tid_ & 63) < 16) {
#pragma unroll
            for (int s = 0; s < 9; ++s) *(float4*)(red + (wv * 9 + s) * 64 + ct * 4) = make_float4(a[s][0], a[s][1], a[s][2], a[s][3]);
        }
        __syncthreads();
        for (int i = tid_; i < 9 * 64; i += 256) {
            const int s = i >> 6, c2 = i & 63, n2 = n0 + c2;
            float v = red[(0 * 9 + s) * 64 + c2] + red[(1 * 9 + s) * 64 + c2] + red[(2 * 9 + s) * 64 + c2] + red[(3 * 9 + s) * 64 + c2];
            mod[((size_t)layer * 9 + s) * 6144 + n2] = v + p.b_mod[layer * 6144 + n2];
        }
        __syncthreads();
    }
}

__device__ __forceinline__ void conv_tile(const float* src, int K, int N, bfu* dst, int k0, int n0, float* ts, int tid_) {
    const int t = tid_;
    {
        const int kk = t >> 4, n4 = (t & 15) * 4;
        float4 v[4];
#pragma unroll
        for (int pz = 0; pz < 4; ++pz) v[pz] = *(const float4*)(src + (size_t)(k0 + kk + 16 * pz) * N + n0 + n4);
        asm volatile("" : "+v"(v[0].x), "+v"(v[0].y), "+v"(v[0].z), "+v"(v[0].w), "+v"(v[1].x), "+v"(v[1].y), "+v"(v[1].z), "+v"(v[1].w),
                          "+v"(v[2].x), "+v"(v[2].y), "+v"(v[2].z), "+v"(v[2].w), "+v"(v[3].x), "+v"(v[3].y), "+v"(v[3].z), "+v"(v[3].w) :: "memory");
#pragma unroll
        for (int pz = 0; pz < 4; ++pz) { float* d = ts + (kk + 16 * pz) * 65 + n4; d[0] = v[pz].x; d[1] = v[pz].y; d[2] = v[pz].z; d[3] = v[pz].w; }
    }
    __syncthreads();
    {
        const int n = t >> 2, kc = (t & 3) * 16;
        unsigned o[8];
#pragma unroll
        for (int i = 0; i < 8; ++i) o[i] = pack2(ts[(kc + 2 * i) * 65 + n], ts[(kc + 2 * i + 1) * 65 + n]);
        uint4* d = (uint4*)(dst + (size_t)(n0 + n) * K + k0 + kc);
        d[0] = make_uint4(o[0], o[1], o[2], o[3]); d[1] = make_uint4(o[4], o[5], o[6], o[7]);
    }
    __syncthreads();
}
__device__ void phase_conv(KP p, int wsid_, int layer, int bid, int nb, char* smem) {
    PHASE_PROLOGUE
    float* ts = (float*)smem;
    const float* srcs[8]; bfu* dsts[8]; int Ks[8], Ns[8], Bs[8];
    char* ws = ws_;
    srcs[0] = p.w_in + (size_t)layer * DM * INW;  Ks[0] = DM; Ns[0] = INW; Bs[0] = 1;  dsts[0] = (bfu*)(ws + WS_WIN);
    srcs[1] = p.w_out + (size_t)layer * DM * DM;  Ks[1] = DM; Ns[1] = DM;  Bs[1] = 1;  dsts[1] = (bfu*)(ws + WS_WOUT);
    srcs[2] = p.e_w1 + (size_t)layer * NEXP * DM * FF; Ks[2] = DM; Ns[2] = FF; Bs[2] = NEXP; dsts[2] = (bfu*)(ws + WS_W1);
    srcs[3] = p.e_w3 + (size_t)layer * NEXP * DM * FF; Ks[3] = DM; Ns[3] = FF; Bs[3] = NEXP; dsts[3] = (bfu*)(ws + WS_W3);
    srcs[4] = p.e_w2 + (size_t)layer * NEXP * FF * DM; Ks[4] = FF; Ns[4] = DM; Bs[4] = NEXP; dsts[4] = (bfu*)(ws + WS_W2);
    srcs[5] = p.c_w2 + (size_t)layer * 2 * 64 * 512;   Ks[5] = 64; Ns[5] = 512; Bs[5] = 2;   dsts[5] = (bfu*)(ws + WS_LW2);
    srcs[6] = p.c_a2 + (size_t)layer * 2 * 64 * 512;   Ks[6] = 64; Ns[6] = 512; Bs[6] = 2;   dsts[6] = (bfu*)(ws + WS_LA2);
    srcs[7] = p.c_g2 + (size_t)layer * 128 * 512;      Ks[7] = 128; Ns[7] = 512; Bs[7] = 1;  dsts[7] = (bfu*)(ws + WS_LG2);
    for (int it = bid; it < 1104; it += nb) {
        int jb, r;
        if (it < 800) { jb = 0; r = it; } else if (it < 1056) { jb = 1; r = it - 800; } else if (it < 1072) { jb = 5; r = it - 1056; } else if (it < 1088) { jb = 6; r = it - 1072; } else { jb = 7; r = it - 1088; }
        const float* src; bfu* dst; int K, N;
        if (jb == 0) { src = srcs[0]; dst = dsts[0]; K = DM; N = INW; } else if (jb == 1) { src = srcs[1]; dst = dsts[1]; K = DM; N = DM; }
        else if (jb == 5) { src = srcs[5]; dst = dsts[5]; K = 64; N = 512; } else if (jb == 6) { src = srcs[6]; dst = dsts[6]; K = 64; N = 512; } else { src = srcs[7]; dst = dsts[7]; K = 128; N = 512; }
        const int tk = K / 64, tn = N / 64, per = tk * tn, bt = r / per, r2 = r % per, kt = r2 / tn, nt = r2 % tn;
        conv_tile(src + (size_t)bt * K * N, K, N, dst + (size_t)bt * K * N, kt * 64, nt * 64, ts, tid_);
    }
    float* wrt = (float*)(ws + WS_WRT);
    const float* wg = p.r_w_group + (size_t)layer * DM * 4; const float* we = p.r_w_expert + (size_t)layer * DM * 32;
    for (int i = bid * 256 + tid_; i < 48 * 1024; i += nb * 256) {
        const int r = i >> 10, k = i & 1023;
        const float wv_ = r < 4 ? wg[k * 4 + r] : (r < 36 ? we[k * 32 + (r - 4)] : 0.f);
        wrt[i] = wv_;
        const bfu hi_ = f2bf(wv_);
        ((bfu*)(ws + WS_WRTH))[i] = hi_; ((bfu*)(ws + WS_WRTL))[i] = f2bf(wv_ - bf2f(hi_));
    }
}

__device__ __forceinline__ bool conv_big_step(KP p, int wsid_, char* ws_, int layer, unsigned* qctr, int* s_item, char* smem, int tid_, int hb_) {
    float* ts = (float*)smem;
    __syncthreads();
    if (TID512 == 0) *s_item = (int)atomicAdd(qctr, 1u);
    __syncthreads();
    const int gidx = __builtin_amdgcn_readfirstlane(*s_item);
    if (gidx >= 1536) return false;
    { const int q0 = hb_ * 4;
        const float* sp[4]; bfu* dp[4]; int Ks[4];
        float4 v[4][4];
        const int kk = tid_ >> 4, n4 = (tid_ & 15) * 4;
#pragma unroll
        for (int q = 0; q < 4; ++q) {
            const int it = gidx * 8 + q0 + q, jb = it >> 12, r = it & 4095, bt = r >> 7, r2 = r & 127;
            const float* src; bfu* dst; int K, N;
            if (jb == 0) { src = p.e_w1 + (size_t)layer * NEXP * DM * FF; dst = (bfu*)(ws_ + WS_W1); K = DM; N = FF; }
            else if (jb == 1) { src = p.e_w3 + (size_t)layer * NEXP * DM * FF; dst = (bfu*)(ws_ + WS_W3); K = DM; N = FF; }
            else { src = p.e_w2 + (size_t)layer * NEXP * FF * DM; dst = (bfu*)(ws_ + WS_W2); K = FF; N = DM; }
            const int tn = N >> 6, kt = r2 / tn, nt = r2 % tn;
            const float* s0 = src + (size_t)bt * K * N + (size_t)(kt * 64 + kk) * N + nt * 64 + n4;
#pragma unroll
            for (int pz = 0; pz < 4; ++pz) v[q][pz] = *(const float4*)(s0 + (size_t)(16 * pz) * N);
            Ks[q] = K;
            dp[q] = dst + (size_t)bt * K * N + (size_t)(nt * 64 + (tid_ >> 2)) * K + kt * 64 + (tid_ & 3) * 16;
        }
#pragma unroll
        for (int q = 0; q < 4; ++q)
            asm volatile("" : "+v"(v[q][0].x), "+v"(v[q][0].y), "+v"(v[q][0].z), "+v"(v[q][0].w), "+v"(v[q][1].x), "+v"(v[q][1].y), "+v"(v[q][1].z), "+v"(v[q][1].w),
                              "+v"(v[q][2].x), "+v"(v[q][2].y), "+v"(v[q][2].z), "+v"(v[q][2].w), "+v"(v[q][3].x), "+v"(v[q][3].y), "+v"(v[q][3].z), "+v"(v[q][3].w) :: "memory");
#pragma unroll
        for (int q = 0; q < 4; ++q)
#pragma unroll
            for (int pz = 0; pz < 4; ++pz) { float* d = ts + q * 4160 + (kk + 16 * pz) * 65 + n4; d[0] = v[q][pz].x; d[1] = v[q][pz].y; d[2] = v[q][pz].z; d[3] = v[q][pz].w; }
        __syncthreads();
        {
            const int n = tid_ >> 2, kc = (tid_ & 3) * 16;
#pragma unroll
            for (int q = 0; q < 4; ++q) {
                unsigned o[8];
#pragma unroll
                for (int i = 0; i < 8; ++i) o[i] = pack2(ts[q * 4160 + (kc + 2 * i) * 65 + n], ts[q * 4160 + (kc + 2 * i + 1) * 65 + n]);
                uint4* d = (uint4*)dp[q];
                d[0] = make_uint4(o[0], o[1], o[2], o[3]); d[1] = make_uint4(o[4], o[5], o[6], o[7]);
            }
        }
        __syncthreads();
    }
    return true;
}

__device__ void phase_conv_drain(KP p, int wsid_, int layer, unsigned* cctr, int* s_item, char* smem) {
    PHASE_PROLOGUE
    while (conv_big_step(p, wsid_, ws_, layer, cctr, s_item, smem, tid_, hb_)) {}
}

__device__ void phase_norm1(KP p, int wsid_, int layer, int mode, int bid, int nb, bool combine = true) {
    PHASE_PROLOGUE
    float* X = (float*)(ws_ + WS_X); bfu* H = (bfu*)(ws_ + WS_H);
    const bfu* Y0 = (const bfu*)(ws_ + WS_Y01); const bfu* Y1 = Y0 + (size_t)MA * DM;
    const float* mod = (const float*)(ws_ + WS_MOD);
    const int lane = tid_ & 63, wv = tid_ >> 6;
    const int nrows = mode ? ML : MA;
    if (bid == 0 && mode == 0 && tid_ < 32) ((int*)(ws_ + WS_ECNT))[layer * 32 + tid_] = 0;
    for (int row = bid * 4 + wv; row < nrows; row += nb * 4) {
        int b, j, s; row_info(row, b, j, s);
        float4 v[4], g1[4], g2[4], g3[4], gc[4];
        uint2 ya[4], yb[4];
        const bool comb = layer > 0 && combine;
#pragma unroll
        for (int c = 0; c < 4; ++c) {
            const int col = c * 256 + lane * 4;
            v[c] = *(const float4*)(X + (size_t)row * DM + col);
            if (comb) {
                ya[c] = *(const uint2*)(Y0 + (size_t)row * DM + col); yb[c] = *(const uint2*)(Y1 + (size_t)row * DM + col);
                gc[c] = *(const float4*)(mod + ((size_t)(layer - 1) * 9 + s) * 6144 + 5 * 1024 + col);
            }
            if (mode) g1[c] = *(const float4*)(p.g_final + col);
            else {
                g1[c] = *(const float4*)(p.g_mix + layer * DM + col);
                g2[c] = *(const float4*)(mod + ((size_t)layer * 9 + s) * 6144 + 0 * 1024 + col);
                g3[c] = *(const float4*)(mod + ((size_t)layer * 9 + s) * 6144 + 1 * 1024 + col);
            }
        }
        float ss = 0.f;
#pragma unroll
        for (int c = 0; c < 4; ++c) {
            float4 xv = v[c];
            if (comb) {
                const float4 a = make_float4(__uint_as_float(ya[c].x << 16), __uint_as_float(ya[c].x & 0xFFFF0000u), __uint_as_float(ya[c].y << 16), __uint_as_float(ya[c].y & 0xFFFF0000u));
                const float4 bq = make_float4(__uint_as_float(yb[c].x << 16), __uint_as_float(yb[c].x & 0xFFFF0000u), __uint_as_float(yb[c].y << 16), __uint_as_float(yb[c].y & 0xFFFF0000u));
                const float4 g = gc[c];
                xv.x += g.x * (a.x + bq.x); xv.y += g.y * (a.y + bq.y); xv.z += g.z * (a.z + bq.z); xv.w += g.w * (a.w + bq.w);
            }
            v[c] = xv; ss += xv.x * xv.x + xv.y * xv.y + xv.z * xv.z + xv.w * xv.w;
        }
        ss = sum64(ss);
        const float rs = rsqrtf(ss * (1.f / 1024.f) + 1e-6f);
#pragma unroll
        for (int c = 0; c < 4; ++c) {
            const int col = c * 256 + lane * 4;
            if (comb && !mode) *(float4*)(X + (size_t)row * DM + col) = v[c];
            if (mode) {
                const float4 g = g1[c];
                float4 o; o.x = v[c].x * rs * g.x; o.y = v[c].y * rs * g.y; o.z = v[c].z * rs * g.z; o.w = v[c].w * rs * g.w;
                *(float4*)(p.out + (size_t)row * DM + col) = o;
            } else {
                const float4 g = g1[c], sh = g2[c], sc = g3[c];
                const float o0 = v[c].x * rs * g.x * (1.f + sc.x) + sh.x, o1 = v[c].y * rs * g.y * (1.f + sc.y) + sh.y;
                const float o2 = v[c].z * rs * g.z * (1.f + sc.z) + sh.z, o3 = v[c].w * rs * g.w * (1.f + sc.w) + sh.w;
                *(uint2*)(H + (size_t)row * DM + col) = make_uint2(pack2(o0, o1), pack2(o2, o3));
            }
        }
    }
}

#define GLDS(gp, lp) __builtin_amdgcn_global_load_lds((const unsigned*)(gp), (__attribute__((address_space(3))) unsigned*)(lp), 16, 0, 0)
__device__ __forceinline__ int swzG(int x) { return (0x78 >> (2 * x)) & 3; }
template <class FA, class FB, class FE>
__device__ __forceinline__ void gemm_tile(FA arow, FB brow, int K, FE epi, char* smem, int wsid_) {
    int tid = TID512 & 255; asm volatile("" : "+v"(tid));
    const int lane = tid & 63, wid = tid >> 6, wr = wid >> 1, wc = wid & 1, fr = lane & 15, fq = lane >> 4;
    const int lrow = tid >> 2, lch = ((tid & 3) ^ swzG((tid >> 4) & 3)) * 8;
    const bfu* ga0 = arow(lrow) + lch; const bfu* ga1 = arow(lrow + 64) + lch;
    const bfu* gb0 = brow(lrow) + lch; const bfu* gb1 = brow(lrow + 64) + lch;
    f32x4 acc[4][4];
#pragma unroll
    for (int m = 0; m < 4; ++m)
#pragma unroll
        for (int n = 0; n < 4; ++n) acc[m][n] = (f32x4){0.f, 0.f, 0.f, 0.f};
    char* lds0 = smem + tid * 16;
#define GEMM_ISSUE(kt_) { char* d_ = lds0 + ((kt_) & 3) * 16384; const int ko_ = (kt_) * 32; \
        GLDS(ga0 + ko_, d_); GLDS(ga1 + ko_, d_ + 4096); GLDS(gb0 + ko_, d_ + 8192); GLDS(gb1 + ko_, d_ + 12288); }
    const int nk = K >> 5;
    __syncthreads();
    GEMM_ISSUE(0)
    if (nk > 1) GEMM_ISSUE(1)
    if (nk > 2) GEMM_ISSUE(2)
    const int offA = (wr * 64 + fr) * 64 + ((fq ^ swzG((fr >> 2) & 3)) * 16), offB = 8192 + (wc * 64 + fr) * 64 + ((fq ^ swzG((fr >> 2) & 3)) * 16);
    for (int kt = 0; kt < nk; ++kt) {
        if (kt + 2 < nk) asm volatile("s_waitcnt vmcnt(8)" ::: "memory");
        else if (kt + 1 < nk) asm volatile("s_waitcnt vmcnt(4)" ::: "memory");
        else asm volatile("s_waitcnt vmcnt(0)" ::: "memory");
        __builtin_amdgcn_s_barrier();
        if (kt + 3 < nk) GEMM_ISSUE(kt + 3)
        const char* st = smem + (kt & 3) * 16384;
        bf16x8 af[4], bfr[4];
#pragma unroll
        for (int m = 0; m < 4; ++m) af[m] = *(const bf16x8*)(st + offA + m * 1024);
#pragma unroll
        for (int n = 0; n < 4; ++n) bfr[n] = *(const bf16x8*)(st + offB + n * 1024);
        __builtin_amdgcn_s_setprio(1);
#pragma unroll
        for (int m = 0; m < 4; ++m)
#pragma unroll
            for (int n = 0; n < 4; ++n) acc[m][n] = __builtin_amdgcn_mfma_f32_16x16x32_bf16(af[m], bfr[n], acc[m][n], 0, 0, 0);
        __builtin_amdgcn_s_setprio(0);
    }
    __syncthreads();
    epi(acc, wr, wc, fr, fq);
}
#define ACC_FOREACH(...)                                                                      \
    _Pragma("unroll") for (int m_ = 0; m_ < 4; ++m_) _Pragma("unroll") for (int n_ = 0; n_ < 4; ++n_) \
    _Pragma("unroll") for (int j_ = 0; j_ < 4; ++j_) {                                        \
        const int row = wr * 64 + m_ * 16 + fq * 4 + j_; const int col = wc * 64 + n_ * 16 + fr; const float val = acc[m_][n_][j_]; __VA_ARGS__ }

__device__ __forceinline__ int lds_byte256(int r, int c) { const int st = (r >> 4) * 2 + (c >> 5), rr = r & 15, cc = c & 31, ob = rr * 64 + cc * 2; return st * 1024 + (ob ^ (((ob >> 9) & 1) << 5)); }
__device__ __forceinline__ void stage_rc256(int b, int& R, int& C) { const int st = b / 1024, sb = b % 1024, swz = sb ^ (((sb >> 9) & 1) << 5); R = (st >> 1) * 16 + swz / 64; C = (st & 1) * 32 + (swz % 64) / 2; }
#define G2_HT 8192
template <int lda, int ldb, int K, class FR, class FE>
__device__ __forceinline__ void gemm256(const bfu* Abase, FR arow, const bfu* B0, const bfu* B1, FE epi, char* shmc, int wsid_) {
    bfu* shm = (bfu*)shmc;
#define G2_SA(b, h) (shm + ((b) * 2 + (h)) * G2_HT)
#define G2_SB(b, h) (shm + (4 + (b) * 2 + (h)) * G2_HT)
    int tx = TID512; asm volatile("" : "+v"(tx));
    int sR, sC; stage_rc256(tx * 16, sR, sC);
    const int ra00 = arow(sR), ra01 = arow(sR + 64), ra10 = arow(128 + sR), ra11 = arow(128 + sR + 64);
#define G2_STAGE_A(P, h, kt) { int r0_ = (h) ? ra10 : ra00, r1_ = (h) ? ra11 : ra01; asm volatile("" : "+v"(r0_), "+v"(r1_)); const size_t ko_ = (size_t)(kt) * 64 + sC; \
        GLDS(Abase + (size_t)r0_ * lda + ko_, (char*)(P) + tx * 16); GLDS(Abase + (size_t)r1_ * lda + ko_, (char*)(P) + tx * 16 + 8192); }
#define G2_STAGE_B(P, h, kt) { int o_ = sR * ldb + sC; asm volatile("" : "+v"(o_)); const bfu* b_ = ((h) ? B1 : B0) + (size_t)(kt) * 64 + o_; GLDS(b_, (char*)(P) + tx * 16); GLDS(b_ + 64 * ldb, (char*)(P) + tx * 16 + 8192); }
    int wid = tx >> 6, lane = tx & 63, wr = wid >> 2, wc = wid & 3, fr = lane & 15, fq = lane >> 4;
#define G2_LDA(dst, b, h) _Pragma("unroll") for (int m = 0; m < 4; ++m) _Pragma("unroll") for (int k = 0; k < 2; ++k) \
        dst[m][k] = *(const bf16x8*)((const char*)G2_SA(b, h) + lds_byte256(wr * 64 + m * 16 + fr, k * 32 + fq * 8))
#define G2_LDB(dst, b, h) _Pragma("unroll") for (int n = 0; n < 2; ++n) _Pragma("unroll") for (int k = 0; k < 2; ++k) \
        dst[n][k] = *(const bf16x8*)((const char*)G2_SB(b, h) + lds_byte256(wc * 32 + n * 16 + fr, k * 32 + fq * 8))
#define G2_MMA(ai, bj, At_, Bt_) { __builtin_amdgcn_s_setprio(1); \
        _Pragma("unroll") for (int m = 0; m < 4; ++m) _Pragma("unroll") for (int n = 0; n < 2; ++n) _Pragma("unroll") for (int k = 0; k < 2; ++k) \
            acc[ai][bj][m][n] = __builtin_amdgcn_mfma_f32_16x16x32_bf16(At_[m][k], Bt_[n][k], acc[ai][bj][m][n], 0, 0, 0); \
        __builtin_amdgcn_s_setprio(0); }
#define G2_WV(n) asm volatile("s_waitcnt vmcnt(" #n ")" ::: "memory")
#define G2_WL(n) asm volatile("s_waitcnt lgkmcnt(" #n ")" ::: "memory")
#define G2_BAR __builtin_amdgcn_s_barrier()
#define G2_SCHED __builtin_amdgcn_sched_barrier(0)
    f32x4 acc[2][2][4][2];
#pragma unroll
    for (int a = 0; a < 2; ++a)
#pragma unroll
        for (int b = 0; b < 2; ++b)
#pragma unroll
            for (int m = 0; m < 4; ++m)
#pragma unroll
                for (int n = 0; n < 2; ++n) acc[a][b][m][n] = (f32x4){0.f, 0.f, 0.f, 0.f};
    bf16x8 At[4][2], Bx0[2][2], Bx1[2][2];
    constexpr int nt = K >> 6;
    __syncthreads();
    G2_STAGE_B(G2_SB(0, 0), 0, 0); G2_STAGE_A(G2_SA(0, 0), 0, 0); G2_STAGE_B(G2_SB(0, 1), 1, 0); G2_STAGE_A(G2_SA(0, 1), 1, 0);
    if (wr == 1) G2_BAR;
    G2_WV(4); G2_BAR;
    G2_STAGE_B(G2_SB(1, 0), 0, 1); G2_STAGE_A(G2_SA(1, 0), 0, 1); G2_STAGE_B(G2_SB(1, 1), 1, 1);
    G2_WV(6); G2_BAR;
    for (int t = 0; t < nt - 2; t += 2) {
        G2_LDB(Bx0, 0, 0); G2_SCHED; G2_LDA(At, 0, 0); G2_STAGE_A(G2_SA(1, 1), 1, t + 1);
        G2_WL(8); G2_BAR; G2_WL(0); G2_MMA(0, 0, At, Bx0); G2_BAR; G2_SCHED;
        G2_LDB(Bx1, 0, 1); G2_STAGE_B(G2_SB(0, 0), 0, t + 2);
        G2_BAR; G2_WL(0); G2_MMA(0, 1, At, Bx1); G2_BAR;
        G2_LDA(At, 0, 1); G2_STAGE_A(G2_SA(0, 0), 0, t + 2);
        G2_BAR; G2_WL(0); G2_MMA(1, 0, At, Bx0); G2_BAR; G2_SCHED;
        G2_STAGE_B(G2_SB(0, 1), 1, t + 2);
        G2_WV(6); G2_BAR; G2_MMA(1, 1, At, Bx1); G2_BAR;
        G2_LDB(Bx0, 1, 0); G2_SCHED; G2_LDA(At, 1, 0); G2_STAGE_A(G2_SA(0, 1), 1, t + 2);
        G2_WL(8); G2_BAR; G2_WL(0); G2_MMA(0, 0, At, Bx0); G2_BAR; G2_SCHED;
        G2_LDB(Bx1, 1, 1); G2_STAGE_B(G2_SB(1, 0), 0, t + 3);
        G2_BAR; G2_WL(0); G2_MMA(0, 1, At, Bx1); G2_BAR;
        G2_LDA(At, 1, 1); G2_STAGE_A(G2_SA(1, 0), 0, t + 3);
        G2_BAR; G2_WL(0); G2_MMA(1, 0, At, Bx0); G2_BAR; G2_SCHED;
        G2_STAGE_B(G2_SB(1, 1), 1, t + 3);
        G2_WV(6); G2_BAR; G2_MMA(1, 1, At, Bx1); G2_BAR;
    }
    tx = TID512; asm volatile("" : "+v"(tx)); stage_rc256(tx * 16, sR, sC); wid = tx >> 6; lane = tx & 63; wr = wid >> 2; wc = wid & 3; fr = lane & 15; fq = lane >> 4;
    { G2_LDB(Bx0, 0, 0); G2_WV(0); G2_LDA(At, 0, 0); G2_STAGE_A(G2_SA(1, 1), 1, nt - 1);
      G2_BAR; G2_WL(0); G2_MMA(0, 0, At, Bx0); G2_BAR;
      G2_LDB(Bx1, 0, 1); G2_BAR; G2_WL(0); G2_MMA(0, 1, At, Bx1); G2_BAR;
      G2_LDA(At, 0, 1); G2_WV(4); G2_BAR; G2_WL(0); G2_MMA(1, 0, At, Bx0); G2_MMA(1, 1, At, Bx1); G2_BAR; }
    { G2_LDB(Bx0, 1, 0); G2_LDA(At, 1, 0); G2_WV(2); G2_BAR; G2_WL(0); G2_MMA(0, 0, At, Bx0); G2_BAR;
      G2_LDB(Bx1, 1, 1); G2_WV(0); G2_BAR; G2_WL(0); G2_MMA(0, 1, At, Bx1); G2_BAR;
      G2_LDA(At, 1, 1); G2_BAR; G2_WL(0); G2_MMA(1, 0, At, Bx0); G2_MMA(1, 1, At, Bx1); G2_BAR; }
    if (wr == 0) G2_BAR;
    __syncthreads();
    epi(acc, wr, wc, fr, fq);
}

__device__ __forceinline__ void inproj_post(KP p, int wsid_, char* ws_, int layer, int row0, int nt, const float* Cs, int tid_) {
    const float* TA = (const float*)(ws_ + WS_ROPE); const float* TB = TA + 64 * 16 * 2;
    const int tid = tid_;
    int b, j0, s; row_info(row0, b, j0, s);
    const bool lat = row0 < ML;
    if (nt <= 2) {
        const int r = tid & 127, hl = tid >> 7;
        const bool isq = nt < 2;
        const float* gain = (isq ? p.a_q_gain : p.a_k_gain) + layer * 64;
        float ss = 0.f;
#pragma unroll
        for (int d4 = 0; d4 < 16; ++d4) { const float4 t4 = *(const float4*)(Cs + r * 132 + hl * 64 + d4 * 4); ss += t4.x * t4.x + t4.y * t4.y + t4.z * t4.z + t4.w * t4.w; }
        const float rs = rsqrtf(ss * (1.f / 64.f) + 1e-6f);
        const float qs = isq ? 0.125f * LOG2E : 1.f;
        bfu* dst = isq ? (bfu*)(ws_ + WS_QA) + (((size_t)b * 4 + (nt * 2 + hl)) * NKEY + j0 + r) * 64
                       : (bfu*)(ws_ + WS_KA) + (((size_t)b * 2 + hl) * NKEY + j0 + r) * 64;
        const int t = (j0 - 256) + r;
#pragma unroll 1
        for (int a = 0; a < 2; ++a) {
            float v[32];
#pragma unroll
            for (int d4 = 0; d4 < 8; ++d4) {
                const float4 t4 = *(const float4*)(Cs + r * 132 + hl * 64 + a * 32 + d4 * 4); const float4 g4 = *(const float4*)(gain + a * 32 + d4 * 4);
                v[d4 * 4] = t4.x * rs * g4.x; v[d4 * 4 + 1] = t4.y * rs * g4.y; v[d4 * 4 + 2] = t4.z * rs * g4.z; v[d4 * 4 + 3] = t4.w * rs * g4.w;
            }
            if (lat) {
                const int pos = a == 0 ? (t >> 6) : (t & 63);
#pragma unroll
                for (int f = 0; f < 16; ++f) {
                    const float cs = TA[(pos * 16 + f) * 2], sn = TA[(pos * 16 + f) * 2 + 1];
                    const float x0 = v[f], x1 = v[16 + f];
                    v[f] = x0 * cs - x1 * sn; v[16 + f] = x1 * cs + x0 * sn;
                }
            }
#pragma unroll
            for (int d8 = 0; d8 < 4; ++d8)
                ((uint4*)dst)[a * 4 + d8] = make_uint4(pack2(v[d8 * 8] * qs, v[d8 * 8 + 1] * qs), pack2(v[d8 * 8 + 2] * qs, v[d8 * 8 + 3] * qs),
                                                       pack2(v[d8 * 8 + 4] * qs, v[d8 * 8 + 5] * qs), pack2(v[d8 * 8 + 6] * qs, v[d8 * 8 + 7] * qs));
        }
    } else if (nt == 3 || nt == 8 || nt == 9) {
        const int c = tid & 127, half = tid >> 7, hl = c >> 6, d = c & 63;
        bfu* dst = nt == 3 ? (bfu*)(ws_ + WS_VAT) + (((size_t)b * 2 + hl) * 64 + d) * NKEY + j0 + half * 64
                           : (bfu*)(ws_ + WS_VBT) + (((size_t)b * 4 + ((nt - 8) * 2 + hl)) * 64 + d) * NKEY + j0 + half * 64;
#pragma unroll
        for (int r8 = 0; r8 < 8; ++r8) {
            const float* s0 = Cs + (half * 64 + r8 * 8) * 132 + c;
            ((uint4*)dst)[r8] = make_uint4(pack2(s0[0], s0[132]), pack2(s0[2 * 132], s0[3 * 132]), pack2(s0[4 * 132], s0[5 * 132]), pack2(s0[6 * 132], s0[7 * 132]));
        }
    } else if (nt <= 7) {
        const bool isq = nt < 6;
        const int hbase = ((nt - 4) & 1) * 2;
#pragma unroll
        for (int itq = 0; itq < 2; ++itq) {
            const int u = tid + 256 * itq, r = u & 127, hm = u >> 7;
            float v[32];
#pragma unroll
            for (int d4 = 0; d4 < 8; ++d4) { const float4 t4 = *(const float4*)(Cs + r * 132 + hm * 32 + d4 * 4); v[d4 * 4] = t4.x; v[d4 * 4 + 1] = t4.y; v[d4 * 4 + 2] = t4.z; v[d4 * 4 + 3] = t4.w; }
            if (lat) {
                const int t = (j0 - 256) + r;
#pragma unroll
                for (int a = 0; a < 2; ++a) {
                    const int pos = a == 0 ? (t >> 6) : (t & 63);
#pragma unroll
                    for (int f = 0; f < 8; ++f) {
                        const float cs = TB[(pos * 8 + f) * 2], sn = TB[(pos * 8 + f) * 2 + 1];
                        const float x0 = v[a * 16 + f], x1 = v[a * 16 + 8 + f];
                        v[a * 16 + f] = x0 * cs - x1 * sn; v[a * 16 + 8 + f] = x1 * cs + x0 * sn;
                    }
                }
            }
            const float qs = isq ? 0.17677669529663687f * LOG2E : 1.f;
            const int h = hbase + (hm >> 1), mp = hm & 1;
            bfu* dst = (bfu*)(ws_ + (isq ? WS_QB : WS_KB)) + (((size_t)b * 4 + h) * NKEY + j0 + r) * 64 + mp * 32;
#pragma unroll
            for (int d8 = 0; d8 < 4; ++d8)
                ((uint4*)dst)[d8] = make_uint4(pack2(v[d8 * 8] * qs, v[d8 * 8 + 1] * qs), pack2(v[d8 * 8 + 2] * qs, v[d8 * 8 + 3] * qs),
                                               pack2(v[d8 * 8 + 4] * qs, v[d8 * 8 + 5] * qs), pack2(v[d8 * 8 + 6] * qs, v[d8 * 8 + 7] * qs));
        }
    } else {
        const int r = tid & 127, half = tid >> 7;
        float* dst = (float*)(ws_ + WS_CP) + (size_t)(row0 + r) * CSL + (nt - 10) * 128 + half * 64;
#pragma unroll
        for (int d4 = 0; d4 < 16; ++d4) ((float4*)dst)[d4] = *(const float4*)(Cs + r * 132 + half * 64 + d4 * 4);
    }
}

__device__ void phase_inproj256(KP p, int wsid_, int layer, int vblk, int nblk, char* smem_all, unsigned* cctr, int* s_item) {
    PHASE_PROLOGUE
    const bfu* H = (const bfu*)(ws_ + WS_H); const bfu* W = (const bfu*)(ws_ + WS_WIN);
    for (int it = vblk; it < 72 * 13; it += nblk) {
        const int mt = (it / 104) * 8 + (it & 7), nt2 = (it >> 3) % 13;
        const int row0 = mt * 256, col0 = nt2 * 256;
        const bfu* B0 = W + (size_t)col0 * DM; const bfu* B1 = (nt2 == 12) ? B0 : B0 + (size_t)128 * DM;
        gemm256<DM, DM, DM>(H, [&](int r) { return row0 + r; }, B0, B1,
            [&](f32x4 (&acc)[2][2][4][2], int wr, int wc, int fr, int fq) {
                if (nt2 >= 5) {
                    const __amdgpu_buffer_rsrc_t rs = __builtin_amdgcn_make_buffer_rsrc((void*)(ws_ + WS_CP), 0, (int)((size_t)MA * CSL * 4), 0x00020000);
                    const int voff = (((wr * 64 + fq * 4) * CSL) + wc * 32 + fr) * 4;
#pragma unroll
                    for (int bj = 0; bj < 2; ++bj) {
                        const int cb = col0 + bj * 128 - 1280;
                        if (cb < CSL) {
#pragma unroll
                            for (int ai = 0; ai < 2; ++ai)
#pragma unroll
                                for (int m = 0; m < 4; ++m)
#pragma unroll
                                    for (int n = 0; n < 2; ++n)
#pragma unroll
                                        for (int j = 0; j < 4; ++j)
                                            __builtin_amdgcn_raw_buffer_store_b32(__float_as_uint(acc[ai][bj][m][n][j]), rs, voff, ((row0 + ai * 128 + m * 16 + j) * CSL + cb + n * 16) * 4, 0);
                        }
                    }
                } else {
                    float* SC = (float*)(ws_ + WS_SCR) + (size_t)blockIdx.x * (2 * 128 * 132);
                    const __amdgpu_buffer_rsrc_t rs = __builtin_amdgcn_make_buffer_rsrc((void*)SC, 0, 2 * 128 * 132 * 4, 0x00020000);
                    const int o0 = (wr * 64 + fq * 4) * 132 + wc * 32 + fr;
#pragma unroll
                    for (int bj = 0; bj < 2; ++bj) {
                        float* Cq = (float*)(smem_all + bj * SMEM_BYTES) + o0;
#pragma unroll
                        for (int m = 0; m < 4; ++m)
#pragma unroll
                            for (int n = 0; n < 2; ++n)
#pragma unroll
                                for (int j = 0; j < 4; ++j) {
                                    Cq[(m * 16 + j) * 132 + n * 16] = acc[0][bj][m][n][j];
                                    __builtin_amdgcn_raw_buffer_store_b32(__float_as_uint(acc[1][bj][m][n][j]), rs, o0 * 4, (bj * 128 * 132 + (m * 16 + j) * 132 + n * 16) * 4, 0);
                                }
                    }
                    __syncthreads();
                    int t2 = TID512 & 255; asm volatile("" : "+v"(t2));
                    float* Ch = (float*)(smem_all + hb_ * SMEM_BYTES);
                    inproj_post(p, wsid_, ws_, layer, row0, nt2 * 2 + hb_, Ch, t2);
                    __syncthreads();
                    { const float4* g4 = (const float4*)(SC + hb_ * (128 * 132)); float4* c4 = (float4*)Ch;
                      for (int i = t2; i < 128 * 132 / 4; i += 256) c4[i] = g4[i]; }
                    __syncthreads();
                    inproj_post(p, wsid_, ws_, layer, row0 + 128, nt2 * 2 + hb_, Ch, t2);
                    __syncthreads();
                }
            }, smem_all, wsid_);
    }
    if (vblk >= 72 * 13 - 3 * nblk) { for (int q = 0; q < 6; ++q) if (!conv_big_step(p, wsid_, ws_, layer, cctr, s_item, smem_all + hb_ * SMEM_BYTES, tid_, hb_)) break; }
}

__device__ void phase_inproj(KP p, int wsid_, int layer, int bid, int nb, char* smem) {
    PHASE_PROLOGUE
    const bfu* H = (const bfu*)(ws_ + WS_H); const bfu* W = (const bfu*)(ws_ + WS_WIN);
    float* Cs = (float*)smem;
    const int nitems = 144 * 25;
    for (int it = bid; it < nitems; it += nb) {
        const int mt = (it / 200) * 8 + (it / 5) % 8, nt = ((it / 40) % 5) * 5 + it % 5;
        const int row0 = mt * 128, col0 = nt * 128;
        gemm_tile([&](int r) { return H + (size_t)(row0 + r) * DM; }, [&](int r) { return W + (size_t)(col0 + r) * DM; }, DM,
            [&](f32x4 (&acc)[4][4], int wr, int wc, int fr, int fq) {
                ACC_FOREACH(Cs[row * 132 + col] = val;)
            }, smem, wsid_);
        __syncthreads();
        inproj_post(p, wsid_, ws_, layer, row0, nt, Cs, tid_);
        __syncthreads();
    }
}

__device__ void phase_gate(KP p, int wsid_, int layer, int bid, int nb, char* smem) {
    PHASE_PROLOGUE
    const bfu* LXG = (const bfu*)(ws_ + WS_LXG); const bfu* Bt = (const bfu*)(ws_ + WS_LG2);
    float* GG = (float*)(ws_ + WS_GG);
    const int nitems = 144 * 4;
    for (int it = bid; it < nitems; it += nb) {
        const int mt = it >> 2, nt = it & 3, row0 = mt * 128, col0 = nt * 128;
        gemm_tile([&](int r) { return LXG + (size_t)(row0 + r) * 128; }, [&](int r) { return Bt + (size_t)(col0 + r) * 128; }, 128,
            [&](f32x4 (&acc)[4][4], int wr, int wc, int fr, int fq) {
                ACC_FOREACH(GG[(size_t)(row0 + row) * 512 + col0 + col] = val;)
            }, smem, wsid_);
    }
}

#define OPS_AT 0
#define OPS_RT 2048
#define OPS_MAK 4096
#define OPS_T 5120
#define OPS_MRBK 6144
#define OPS_BK 7168
#define OPS_VF 11264
#define OPS_WC 13312
__device__ __forceinline__ char* ops_rec(char* ws_, int z, int seq, int c) { return ws_ + WS_OPS + ((size_t)(z * 64 + seq) * 144 + c) * OPS_REC; }
__device__ __forceinline__ float rdlane(float v, int l) { return __int_as_float(__builtin_amdgcn_readlane(__float_as_int(v), l)); }

__device__ __forceinline__ void chunk_tail(const float (&lw)[16], const float (&kk)[16], const float (&rr)[16], const float (&bb)[16], const float (&kd)[16], const float (&vv)[16],
                                           char* Lw, char* rec, int lane) {
    const int cl = lane & 15, g = lane >> 4;
    float Bt[16], Kt[16];
    float cum = 0.f, ep = 1.f;
#pragma unroll
    for (int t = 0; t < 16; ++t) {
        cum += lw[t];
        const float e = __expf(cum), ei = __expf(-cum);
        *(bfu*)(Lw + 0 + t * 128 + lane * 2) = f2bf(-kk[t] * ep);
        *(bfu*)(Lw + 2048 + t * 128 + lane * 2) = f2bf(rr[t] * e);
        Bt[t] = bb[t] * ei; Kt[t] = kd[t] * ei;
        *(bfu*)(Lw + 4096 + t * 128 + lane * 2) = f2bf(Bt[t]);
        *(bfu*)(Lw + 6144 + t * 128 + lane * 2) = f2bf(Kt[t]);
        ep = e;
    }
    const float eC = ep;
#pragma unroll
    for (int q = 0; q < 4; ++q) {
        *(uint4*)(rec + OPS_BK + ((lane >> 4) * 64 + cl + 16 * q) * 16) =
            make_uint4(pack2(Bt[4 * q] * eC, Bt[4 * q + 1] * eC), pack2(Bt[4 * q + 2] * eC, Bt[4 * q + 3] * eC), pack2(Kt[4 * q] * eC, Kt[4 * q + 1] * eC), pack2(Kt[4 * q + 2] * eC, Kt[4 * q + 3] * eC));
        *(uint2*)(rec + OPS_VF + ((lane >> 4) * 64 + cl + 16 * q) * 8) = make_uint2(pack2(vv[4 * q], vv[4 * q + 1]), pack2(vv[4 * q + 2], vv[4 * q + 3]));
    }
    *(float*)(rec + OPS_WC + lane * 4) = eC;
    f32x4 Mab = {0.f, 0.f, 0.f, 0.f}, Mak = Mab, Mrb = Mab, Mrk = Mab;
#pragma unroll
    for (int ks = 0; ks < 2; ++ks) {
        const int fo = cl * 128 + ks * 64 + g * 16;
        const bf16x8 aA = *(const bf16x8*)(Lw + 0 + fo), aR = *(const bf16x8*)(Lw + 2048 + fo), bB = *(const bf16x8*)(Lw + 4096 + fo), bK = *(const bf16x8*)(Lw + 6144 + fo);
        Mab = __builtin_amdgcn_mfma_f32_16x16x32_bf16(aA, bB, Mab, 0, 0, 0);
        Mak = __builtin_amdgcn_mfma_f32_16x16x32_bf16(aA, bK, Mak, 0, 0, 0);
        Mrb = __builtin_amdgcn_mfma_f32_16x16x32_bf16(aR, bB, Mrb, 0, 0, 0);
        Mrk = __builtin_amdgcn_mfma_f32_16x16x32_bf16(aR, bK, Mrk, 0, 0, 0);
    }
#pragma unroll
    for (int ks = 0; ks < 2; ++ks) {
        const uint2 a0 = *(const uint2*)(Lw + 0 + cl * 128 + (32 * ks + 4 * g) * 2), a1 = *(const uint2*)(Lw + 0 + cl * 128 + (32 * ks + 16 + 4 * g) * 2);
        const uint2 r0 = *(const uint2*)(Lw + 2048 + cl * 128 + (32 * ks + 4 * g) * 2), r1 = *(const uint2*)(Lw + 2048 + cl * 128 + (32 * ks + 16 + 4 * g) * 2);
        *(uint4*)(rec + OPS_AT + (ks * 64 + lane) * 16) = make_uint4(a0.x, a0.y, a1.x, a1.y);
        *(uint4*)(rec + OPS_RT + (ks * 64 + lane) * 16) = make_uint4(r0.x, r0.y, r1.x, r1.y);
    }
#pragma unroll
    for (int q = 0; q < 4; ++q) {
        const int tau = 4 * g + q;
        if (!(cl < tau)) { Mab[q] = 0.f; Mak[q] = 0.f; }
        if (!(cl <= tau)) { Mrb[q] = 0.f; Mrk[q] = 0.f; }
    }
#pragma unroll
    for (int q = 0; q < 4; ++q) *(float*)(Lw + 10240 + (4 * g + q) * 64 + cl * 4) = Mab[q];
    float Tc[16];
#pragma unroll
    for (int t = 0; t < 16; ++t) {
        float acc = (t == cl) ? 1.f : 0.f;
#pragma unroll
        for (int j4 = 0; j4 < (t + 3) / 4; ++j4) {
            const float4 mr = *(const float4*)(Lw + 10240 + t * 64 + j4 * 16);
            const float mm[4] = {mr.x, mr.y, mr.z, mr.w};
#pragma unroll
            for (int e = 0; e < 4; ++e) if (j4 * 4 + e < t) acc += mm[e] * Tc[j4 * 4 + e];
        }
        Tc[t] = acc;
    }
#pragma unroll
    for (int q = 0; q < 4; ++q) {
        const int tau = 4 * g + q;
        *(bfu*)(Lw + 8192 + tau * 32 + cl * 2) = f2bf(Mak[q]);
        *(bfu*)(Lw + 9216 + tau * 32 + cl * 2) = f2bf(Mrb[q]);
        *(bfu*)(Lw + 9728 + tau * 32 + cl * 2) = f2bf(Mrk[q]);
    }
    if (g == 0) {
#pragma unroll
        for (int t = 0; t < 16; ++t) *(bfu*)(Lw + 8704 + t * 32 + cl * 2) = f2bf(Tc[t]);
    }
    const uint2 fmak = *(const uint2*)(Lw + 8192 + cl * 32 + g * 8), ft = *(const uint2*)(Lw + 8704 + cl * 32 + g * 8);
    const uint2 fmrb = *(const uint2*)(Lw + 9216 + cl * 32 + g * 8), fmrk = *(const uint2*)(Lw + 9728 + cl * 32 + g * 8);
    *(uint4*)(rec + OPS_MAK + lane * 16) = make_uint4(fmak.x, fmak.y, 0u, 0u);
    *(uint4*)(rec + OPS_T + lane * 16) = make_uint4(ft.x, ft.y, 0u, 0u);
    *(uint4*)(rec + OPS_MRBK + lane * 16) = make_uint4(fmrb.x, fmrb.y, fmrk.x, fmrk.y);
}

__device__ void phase_rk(KP p, int wsid_, int layer, int bid, int nb, char* smem) {
    PHASE_PROLOGUE
    const int lane = tid_ & 63, wv = tid_ >> 6, cl = lane & 15, g = lane >> 4;
    char* Lw = smem + wv * 16384;
    const float* CP = (const float*)(ws_ + WS_CP);
    const float* mu = p.c_mu + layer * CSL;
    for (int it = bid * 4 + wv; it < 2 * 64 * 144; it += nb * 4) {
        const int c = it % 144, seq = (it / 144) & 63, z = it / (144 * 64), b = seq >> 3, h = seq & 7;
        const int grow0 = c < 16 ? ML + b * 256 + 16 * c : b * 2048 + 16 * (c - 16);
        const bool sstart = (c == 0 || c == 16), send = (c == 15 || c == 143);
        auto ldgrp = [&](int col, float (&P_)[18]) {
#pragma unroll
            for (int q = 0; q < 18; ++q) {
                const int tau = q - 1, nat = z ? 15 - tau : tau;
                const bool ok = (nat >= 0 || !sstart) && (nat <= 15 || !send);
                P_[q] = ok ? CP[(size_t)(grow0 + nat) * CSL + col] : 0.f;
            }
        };
        auto shiftg = [&](int col, const float (&P_)[18], float (&out)[16]) {
            const float m = mu[col];
#pragma unroll
            for (int t = 0; t < 16; ++t) out[t] = P_[t + 1] + m * (0.5f * (P_[t] + P_[t + 2]) - P_[t + 1]);
        };
        float Pw[18], Pa[18], Pr[18], Pk[18], Pv[18];
        ldgrp(1536 + z * 64 + lane, Pw); ldgrp(1664 + z * 64 + lane, Pa); ldgrp(h * 64 + lane, Pr); ldgrp(512 + h * 64 + lane, Pk); ldgrp(1024 + h * 64 + lane, Pv);
        float tmp[16], rr[16], kr[16], vv[16];
        shiftg(1536 + z * 64 + lane, Pw, tmp);
#pragma unroll
        for (int t = 0; t < 16; ++t) *(bfu*)(Lw + 10240 + t * 128 + lane * 2) = f2bf(1.f - 2.f * __builtin_amdgcn_rcpf(1.f + __expf(2.f * tmp[t])));
        shiftg(1664 + z * 64 + lane, Pa, tmp);
#pragma unroll
        for (int t = 0; t < 16; ++t) *(bfu*)(Lw + 12288 + t * 128 + lane * 2) = f2bf(tmp[t]);
        if (z == 0 && lane < 16) {
            float Pg[18]; ldgrp(1792 + h * 16 + lane, Pg); shiftg(1792 + h * 16 + lane, Pg, tmp);
            bfu* LXG = (bfu*)(ws_ + WS_LXG);
#pragma unroll
            for (int t = 0; t < 16; ++t) LXG[(size_t)(grow0 + t) * 128 + h * 16 + lane] = f2bf(sigmoidf_(tmp[t]));
        }
        shiftg(h * 64 + lane, Pr, rr);
        shiftg(512 + h * 64 + lane, Pk, kr);
        shiftg(1024 + h * 64 + lane, Pv, vv);
        const bfu* W2 = (const bfu*)(ws_ + WS_LW2) + ((size_t)z * 512 + h * 64) * 64;
        const bfu* A2 = (const bfu*)(ws_ + WS_LA2) + ((size_t)z * 512 + h * 64) * 64;
        float prew[16], prea[16];
#pragma unroll
        for (int which = 0; which < 2; ++which) {
            const bfu* Wm = which ? A2 : W2; const char* Xs = Lw + (which ? 12288 : 10240);
            f32x4 ac[4];
#pragma unroll
            for (int n = 0; n < 4; ++n) ac[n] = (f32x4){0.f, 0.f, 0.f, 0.f};
#pragma unroll
            for (int ks = 0; ks < 2; ++ks) {
                const bf16x8 af = *(const bf16x8*)(Xs + cl * 128 + ks * 64 + g * 16);
#pragma unroll
                for (int n = 0; n < 4; ++n) {
                    const bf16x8 bf = *(const bf16x8*)(Wm + (size_t)(16 * n + cl) * 64 + ks * 32 + g * 8);
                    ac[n] = __builtin_amdgcn_mfma_f32_16x16x32_bf16(af, bf, ac[n], 0, 0, 0);
                }
            }
#pragma unroll
            for (int n = 0; n < 4; ++n)
#pragma unroll
                for (int q = 0; q < 4; ++q) *(float*)(Lw + (4 * g + q) * 256 + (16 * n + cl) * 4) = ac[n][q];
#pragma unroll
            for (int t = 0; t < 16; ++t) { const float x = *(const float*)(Lw + t * 256 + lane * 4); if (which) prea[t] = x; else prew[t] = x; }
        }
        const int ch = h * 64 + lane;
        const float w0v = p.c_w0[((size_t)layer * 2 + z) * 512 + ch], a0v = p.c_a0[((size_t)layer * 2 + z) * 512 + ch];
        const float kkv = p.c_k_k[layer * 512 + ch], kav = p.c_k_a[layer * 512 + ch], rkv = p.c_r_k[layer * 512 + ch];
        float lw[16], kk[16], bb[16];
        float* BETA = (float*)(ws_ + WS_BETA) + (size_t)z * MA * 8;
#pragma unroll
        for (int t = 0; t < 16; ++t) {
            lw[t] = -0.6065306597126334f * sigmoidf_(w0v + prew[t]);
            const float icl = sigmoidf_(a0v + prea[t]);
            const float kv = kr[t] * kkv;
            const float ss = sum64(kv * kv);
            kk[t] = kv * rsqrtf(fmaxf(ss, 1e-24f));
            kr[t] = kr[t] * (1.f + (icl - 1.f) * kav);
            bb[t] = kk[t] * icl;
            const float bs = sum64(rr[t] * kr[t] * rkv);
            const int nat = z ? 15 - t : t;
            if (lane == 0) BETA[(size_t)(grow0 + nat) * 8 + h] = bs;
        }
        if (z == 0) {
            bfu* VB = (bfu*)(ws_ + WS_VB);
#pragma unroll
            for (int t = 0; t < 16; ++t) VB[(size_t)(grow0 + t) * 512 + ch] = f2bf(vv[t]);
        }
        chunk_tail(lw, kk, rr, bb, kr, vv, Lw, ops_rec(ws_, z, seq, c), lane);
    }
}

__device__ __forceinline__ bf16x8 mk8(unsigned a, unsigned b, unsigned c, unsigned d) { union { bf16x8 v; unsigned u[4]; } x; x.u[0] = a; x.u[1] = b; x.u[2] = c; x.u[3] = d; return x.v; }
__device__ __forceinline__ bf16x8 ld8(const char* p) { return *(const bf16x8*)p; }
__device__ __forceinline__ void glds16_asm(const void* gsrc, unsigned lds_dst) {
    unsigned keep;
    asm volatile("s_mov_b32 %0, m0\n\ts_mov_b32 m0, %2\n\ts_nop 0\n\tglobal_load_lds_dwordx4 %1, off\n\ts_mov_b32 m0, %0" : "=&s"(keep) : "v"(gsrc), "s"(lds_dst) : "memory");
}
__device__ void phase_r4(KP p, int wsid_, int layer, int bid, int nb, char* smem) {
    PHASE_PROLOGUE
    const int lane = tid_ & 63, vt = tid_ >> 6, cl = lane & 15, g = lane >> 4;
    for (int it = bid; it < 128; it += nb) {
        const int z = it >> 6, seq = it & 63;
        float* Y = (float*)(ws_ + WS_YS) + (size_t)z * (HEADARR / 4) + (size_t)seq * NKEY * 64;
        const char* recs = ws_ + WS_OPS + (size_t)(z * 64 + seq) * 144 * OPS_REC;
        f32x4 acc[4];
#pragma unroll
        for (int kt = 0; kt < 4; ++kt) acc[kt] = (f32x4){0.f, 0.f, 0.f, 0.f};
        const unsigned lbase = __builtin_amdgcn_readfirstlane((unsigned)(uintptr_t)(__attribute__((address_space(3))) char*)smem + vt * 1024);
#define R4_ISSUE(ci_) { const int c_ = z ? ((ci_) < 16 ? 15 - (ci_) : 143 - ((ci_) - 16)) : (ci_); const char* g_ = recs + (size_t)c_ * OPS_REC + tid_ * 16; const unsigned d_ = lbase + ((ci_) & 3) * OPS_REC; \
            glds16_asm(g_, d_); glds16_asm(g_ + 4096, d_ + 4096); glds16_asm(g_ + 8192, d_ + 8192); if (tid_ < 80) glds16_asm(g_ + 12288, d_ + 12288); }
        __syncthreads();
        R4_ISSUE(0) R4_ISSUE(1) R4_ISSUE(2)
        for (int ci = 0; ci < 144; ++ci) {
            const int c = z ? (ci < 16 ? 15 - ci : 143 - (ci - 16)) : ci;
            if (ci >= 3 && ci <= 141) { if (vt < 2) asm volatile("s_waitcnt vmcnt(20)" ::: "memory"); else asm volatile("s_waitcnt vmcnt(18)" ::: "memory"); }
            else asm volatile("s_waitcnt vmcnt(0)" ::: "memory");
            __builtin_amdgcn_s_barrier();
            if (ci + 3 < 144) R4_ISSUE(ci + 3)
            const char* rec = smem + (ci & 3) * OPS_REC;
            const f32x4 zero4 = {0.f, 0.f, 0.f, 0.f};
            bf16x8 sb[2];
#pragma unroll
            for (int ks = 0; ks < 2; ++ks)
                sb[ks] = mk8(pack2(acc[2 * ks][0], acc[2 * ks][1]), pack2(acc[2 * ks][2], acc[2 * ks][3]), pack2(acc[2 * ks + 1][0], acc[2 * ks + 1][1]), pack2(acc[2 * ks + 1][2], acc[2 * ks + 1][3]));
            const uint2 vf = *(const uint2*)(rec + OPS_VF + (vt * 64 + lane) * 8);
            f32x4 Z = __builtin_amdgcn_mfma_f32_16x16x32_bf16(ld8(rec + OPS_AT + lane * 16), sb[0], zero4, 0, 0, 0);
            Z = __builtin_amdgcn_mfma_f32_16x16x32_bf16(ld8(rec + OPS_AT + (64 + lane) * 16), sb[1], Z, 0, 0, 0);
            Z = __builtin_amdgcn_mfma_f32_16x16x32_bf16(ld8(rec + OPS_MAK + lane * 16), mk8(vf.x, vf.y, 0u, 0u), Z, 0, 0, 0);
            f32x4 Yv = __builtin_amdgcn_mfma_f32_16x16x32_bf16(ld8(rec + OPS_RT + lane * 16), sb[0], zero4, 0, 0, 0);
            Yv = __builtin_amdgcn_mfma_f32_16x16x32_bf16(ld8(rec + OPS_RT + (64 + lane) * 16), sb[1], Yv, 0, 0, 0);
            const f32x4 U = __builtin_amdgcn_mfma_f32_16x16x32_bf16(ld8(rec + OPS_T + lane * 16), mk8(pack2(Z[0], Z[1]), pack2(Z[2], Z[3]), 0u, 0u), zero4, 0, 0, 0);
            const bf16x8 ub = mk8(pack2(U[0], U[1]), pack2(U[2], U[3]), vf.x, vf.y);
            Yv = __builtin_amdgcn_mfma_f32_16x16x32_bf16(ld8(rec + OPS_MRBK + lane * 16), ub, Yv, 0, 0, 0);
#pragma unroll
            for (int kt = 0; kt < 4; ++kt) {
                const float4 wc = *(const float4*)(rec + OPS_WC + (16 * kt + 4 * g) * 4);
                f32x4 a = acc[kt];
                a[0] *= wc.x; a[1] *= wc.y; a[2] *= wc.z; a[3] *= wc.w;
                acc[kt] = __builtin_amdgcn_mfma_f32_16x16x32_bf16(ld8(rec + OPS_BK + (kt * 64 + lane) * 16), ub, a, 0, 0, 0);
            }
#pragma unroll
            for (int q = 0; q < 4; ++q) {
                const int tau = 4 * g + q, t = z ? 15 - tau : tau;
                Y[(size_t)(16 * c + t) * 64 + vt * 16 + cl] = Yv[q];
            }
        }
    }
}

__device__ void phase_readout(KP p, int wsid_, int layer, int nrows, int bid, int nb) {
    PHASE_PROLOGUE
    const float* Y0 = (const float*)(ws_ + WS_YS); const float* Y1 = Y0 + HEADARR / 4;
    const bfu* VB = (const bfu*)(ws_ + WS_VB); const float* B0 = (const float*)(ws_ + WS_BETA); const float* B1 = B0 + (size_t)MA * 8;
    const float* GG = (const float*)(ws_ + WS_GG);
    bfu* MIX = (bfu*)(ws_ + WS_MIX);
    const float* lnw = p.c_ln_w + layer * 512; const float* lnb = p.c_ln_b + layer * 512;
    const int lane = tid_ & 63, wv = tid_ >> 6;
    for (int row0 = (bid * 4 + wv) * 2; row0 < nrows; row0 += nb * 8) {
        int b, j, s; row_info(row0, b, j, s);
        float y0a[8], y1a[8], y0b[8], y1b[8], gav[8], gbv[8], lwv[8], lbv[8]; bfu vav[8], vbv[8];
        float4 bq0[4], bq1[4];
#pragma unroll
        for (int h = 0; h < 8; ++h) {
            const size_t o = (((size_t)b * 8 + h) * NKEY + j) * 64 + lane;
            y0a[h] = Y0[o]; y1a[h] = Y1[o]; y0b[h] = Y0[o + 64]; y1b[h] = Y1[o + 64];
            vav[h] = VB[(size_t)row0 * 512 + h * 64 + lane]; vbv[h] = VB[(size_t)(row0 + 1) * 512 + h * 64 + lane];
            gav[h] = GG[(size_t)row0 * 512 + h * 64 + lane]; gbv[h] = GG[(size_t)(row0 + 1) * 512 + h * 64 + lane];
            lwv[h] = lnw[h * 64 + lane]; lbv[h] = lnb[h * 64 + lane];
        }
#pragma unroll
        for (int q = 0; q < 4; ++q) { bq0[q] = *(const float4*)(B0 + (size_t)row0 * 8 + q * 4); bq1[q] = *(const float4*)(B1 + (size_t)row0 * 8 + q * 4); }
        const float bs0[16] = {bq0[0].x, bq0[0].y, bq0[0].z, bq0[0].w, bq0[1].x, bq0[1].y, bq0[1].z, bq0[1].w, bq0[2].x, bq0[2].y, bq0[2].z, bq0[2].w, bq0[3].x, bq0[3].y, bq0[3].z, bq0[3].w};
        const float bs1[16] = {bq1[0].x, bq1[0].y, bq1[0].z, bq1[0].w, bq1[1].x, bq1[1].y, bq1[1].z, bq1[1].w, bq1[2].x, bq1[2].y, bq1[2].z, bq1[2].w, bq1[3].x, bq1[3].y, bq1[3].z, bq1[3].w};
#pragma unroll
        for (int h = 0; h < 8; ++h) {
            const float ya = y0a[h] + y1a[h], yb = y0b[h] + y1b[h];
            const float va = bf2f(vav[h]), vb2 = bf2f(vbv[h]);
            const float bsa = bs0[h] + bs1[h], bsb = bs0[8 + h] + bs1[8 + h];
            const float ma = sum64(ya) * (1.f / 64.f), mb = sum64(yb) * (1.f / 64.f);
            const float da = ya - ma, db = yb - mb;
            const float vra = sum64(da * da) * (1.f / 64.f), vrb = sum64(db * db) * (1.f / 64.f);
            const float oa = (da * rsqrtf(vra + 64e-5f) * lwv[h] + lbv[h] + bsa * va) * gav[h];
            const float ob = (db * rsqrtf(vrb + 64e-5f) * lwv[h] + lbv[h] + bsb * vb2) * gbv[h];
            MIX[(size_t)row0 * DM + 512 + h * 64 + lane] = f2bf(oa);
            MIX[(size_t)(row0 + 1) * DM + 512 + h * 64 + lane] = f2bf(ob);
        }
    }
}

using f32x16 = __attribute__((ext_vector_type(16))) float;
#define AT_KBYTES 8192
#define AT_VSTRIDE 136
#define AT_VBYTES (64 * AT_VSTRIDE)
template <int GRP>
__device__ __forceinline__ void attn_item(KP p, int wsid_, char* ws_, int layer, int b, int h, int qb, int nkeys, float lam, float lam_init, char* smem, int tid) {
    constexpr int KS = GRP ? 2 : 4;
    const int lane = tid & 63, wv = tid >> 6, r32 = lane & 31, hh = lane >> 5;
    const int mp = GRP ? (wv >> 1) : 0, sub = GRP ? (wv & 1) : wv;
    const int jq = qb * (GRP ? 64 : 128) + sub * 32 + r32;
    const bfu* Qg = (const bfu*)(ws_ + (GRP ? WS_QB : WS_QA)) + (((size_t)b * 4 + h) * NKEY + jq) * 64 + mp * 32;
    const bfu* Kg = GRP ? (const bfu*)(ws_ + WS_KB) + ((size_t)b * 4 + h) * NKEY * 64 : (const bfu*)(ws_ + WS_KA) + ((size_t)b * 2 + (h >> 1)) * NKEY * 64;
    const bfu* Vg = GRP ? (const bfu*)(ws_ + WS_VBT) + ((size_t)b * 4 + h) * 64 * NKEY : (const bfu*)(ws_ + WS_VAT) + ((size_t)b * 2 + (h >> 1)) * 64 * NKEY;
    bf16x8 qf[KS];
#pragma unroll
    for (int ks = 0; ks < KS; ++ks) qf[ks] = *(const bf16x8*)(Qg + ks * 16 + hh * 8);
    f32x16 oacc[2];
    float lrun = 0.f;
#pragma unroll
    for (int db = 0; db < 2; ++db)
#pragma unroll
        for (int i = 0; i < 16; ++i) oacc[db][i] = 0.f;
    const int lrow = tid >> 3, lch = ((tid & 7) ^ ((tid >> 4) & 7)) * 8;
    const bfu* kp0 = Kg + (size_t)lrow * 64 + lch; const bfu* kp1 = kp0 + 32 * 64;
    const bfu* vp0 = Vg + (size_t)lrow * NKEY + lch; const bfu* vp1 = vp0 + (size_t)32 * NKEY;
    char* ldst = smem + tid * 16;
#define AT_ISSUE(t_) { char* d_ = ldst + ((t_) & 1) * 16384; const size_t ko_ = (size_t)(t_) * 64 * 64; const int vo_ = (t_) * 64; \
        GLDS(kp0 + ko_, d_); GLDS(kp1 + ko_, d_ + 4096); GLDS(vp0 + vo_, d_ + 8192); GLDS(vp1 + vo_, d_ + 12288); }
    __syncthreads();
    AT_ISSUE(0)
    const int nt = nkeys >> 6;
    float mref = 0.f;
    const int swv = (r32 >> 1) & 7;
    for (int t = 0; t < nt; ++t) {
        asm volatile("s_waitcnt vmcnt(0)" ::: "memory");
        __syncthreads();
        if (t + 1 < nt) AT_ISSUE(t + 1)
        const char* cK = smem + (t & 1) * 16384; const char* cV = cK + 8192;
        f32x16 sacc[2];
        const float ninit = -mref;
#pragma unroll
        for (int kb = 0; kb < 2; ++kb) {
#pragma unroll
            for (int i = 0; i < 16; ++i) sacc[kb][i] = ninit;
            const int key = kb * 32 + r32;
#pragma unroll
            for (int ks = 0; ks < KS; ++ks) {
                const int c0 = mp * 4 + ks * 2 + hh;
                const bf16x8 kf = *(const bf16x8*)(cK + key * 128 + ((c0 ^ ((key >> 1) & 7)) * 16));
                sacc[kb] = __builtin_amdgcn_mfma_f32_32x32x16_bf16(kf, qf[ks], sacc[kb], 0, 0, 0);
            }
        }
        float mx = sacc[0][0];
#pragma unroll
        for (int i = 1; i < 16; ++i) mx = fmaxf(mx, sacc[0][i]);
#pragma unroll
        for (int i = 0; i < 16; ++i) mx = fmaxf(mx, sacc[1][i]);
        mx = xor32_max(mx);
        const bool need = (t == 0) || (mx > 8.f);
        if (__any(need)) {
            const float delta = need ? mx : 0.f;
            const float alpha = __builtin_amdgcn_exp2f(-delta);
            mref += delta; lrun *= alpha;
#pragma unroll
            for (int db = 0; db < 2; ++db)
#pragma unroll
                for (int i = 0; i < 16; ++i) oacc[db][i] *= alpha;
#pragma unroll
            for (int kb = 0; kb < 2; ++kb)
#pragma unroll
                for (int i = 0; i < 16; ++i) sacc[kb][i] -= delta;
        }
        float ps = 0.f;
#pragma unroll
        for (int kb = 0; kb < 2; ++kb)
#pragma unroll
            for (int i = 0; i < 16; ++i) { const float pv = __builtin_amdgcn_exp2f(sacc[kb][i]); sacc[kb][i] = pv; ps += pv; }
        lrun += ps;
#pragma unroll
        for (int kb = 0; kb < 2; ++kb)
#pragma unroll
            for (int s2 = 0; s2 < 2; ++s2) {
                union { bf16x8 v; unsigned u[4]; } pf;
#pragma unroll
                for (int i = 0; i < 4; ++i) pf.u[i] = pack2(sacc[kb][8 * s2 + 2 * i], sacc[kb][8 * s2 + 2 * i + 1]);
#pragma unroll
                for (int db = 0; db < 2; ++db) {
                    const char* vr = cV + (db * 32 + r32) * 128 + hh * 8;
                    union { bf16x8 v; uint2 u[2]; } vf;
                    vf.u[0] = *(const uint2*)(vr + (((kb * 4 + s2 * 2) ^ swv) * 16)); vf.u[1] = *(const uint2*)(vr + (((kb * 4 + s2 * 2 + 1) ^ swv) * 16));
                    oacc[db] = __builtin_amdgcn_mfma_f32_32x32x16_bf16(vf.v, pf.v, oacc[db], 0, 0, 0);
                }
            }
    }
    __syncthreads();
    bfu* MIX = (bfu*)(ws_ + WS_MIX);
    const int grow = grow_of(b, jq);
    const float il = 1.f / xor32_sum(lrun);
    if (GRP == 0) {
        bfu* dst = MIX + (size_t)grow * DM + h * 64;
#pragma unroll
        for (int db = 0; db < 2; ++db)
#pragma unroll
            for (int g = 0; g < 4; ++g)
                *(uint2*)(dst + db * 32 + g * 8 + hh * 4) = make_uint2(pack2(oacc[db][4 * g] * il, oacc[db][4 * g + 1] * il), pack2(oacc[db][4 * g + 2] * il, oacc[db][4 * g + 3] * il));
    } else {
        float* xs = (float*)smem + sub * 2048;
        if (mp == 1) {
            const float sc2 = lam * il;
#pragma unroll
            for (int db = 0; db < 2; ++db)
#pragma unroll
                for (int i = 0; i < 16; ++i) xs[(db * 16 + i) * 64 + lane] = oacc[db][i] * sc2;
        }
        __syncthreads();
        if (mp == 0) {
            float ss = 0.f;
#pragma unroll
            for (int db = 0; db < 2; ++db)
#pragma unroll
                for (int i = 0; i < 16; ++i) { const float o = oacc[db][i] * il - xs[(db * 16 + i) * 64 + lane]; oacc[db][i] = o; ss += o * o; }
            ss = xor32_sum(ss);
            const float rs = rsqrtf(ss * (1.f / 64.f) + 1e-6f) * (1.f - lam_init);
            const float* gn = p.b_subln + layer * 64;
            bfu* dst = MIX + (size_t)grow * DM + 256 + h * 64;
            float4 gq[2][4];
#pragma unroll
            for (int db = 0; db < 2; ++db)
#pragma unroll
                for (int g = 0; g < 4; ++g) gq[db][g] = *(const float4*)(gn + db * 32 + g * 8 + hh * 4);
#pragma unroll
            for (int db = 0; db < 2; ++db)
#pragma unroll
                for (int g = 0; g < 4; ++g) {
                    const int d = db * 32 + g * 8 + hh * 4;
                    *(uint2*)(dst + d) = make_uint2(pack2(oacc[db][4 * g] * rs * gq[db][g].x, oacc[db][4 * g + 1] * rs * gq[db][g].y), pack2(oacc[db][4 * g + 2] * rs * gq[db][g].z, oacc[db][4 * g + 3] * rs * gq[db][g].w));
                }
        }
    }
}
__device__ void phase_attn(KP p, int wsid_, int layer, bool do_ctx, unsigned* qctr, unsigned* cctr, int* s_item, char* smem) {
    PHASE_PROLOGUE
    const int tid = tid_;
    const float lam_init = 0.8f - 0.6f * expf(-0.3f * (float)layer);
    float d1 = 0.f, d2 = 0.f;
    for (int i = 0; i < 32; ++i) { d1 += p.b_lq1[layer * 32 + i] * p.b_lk1[layer * 32 + i]; d2 += p.b_lq2[layer * 32 + i] * p.b_lk2[layer * 32 + i]; }
    const float lam = expf(d1) - expf(d2) + lam_init;
    const int nitems = do_ctx ? 1728 : 1536;
    bool conv_left = cctr != nullptr;
    for (;;) {
        __syncthreads();
        if (TID512 == 0) *s_item = (int)atomicAdd(qctr, 1u);
        __syncthreads();
        const int pair_ = __builtin_amdgcn_readfirstlane(*s_item);
        if (2 * pair_ >= nitems) break;
        const int it = 2 * pair_ + hb_;
        int grp, b, h, qb, nkeys;
        if (it < 512) { grp = 0; qb = 2 + (it & 15); h = (it >> 4) & 3; b = it >> 6; nkeys = NKEY; }
        else if (it < 1536) { grp = 1; const int r = it - 512; qb = 4 + (r & 31); h = (r >> 5) & 3; b = r >> 7; nkeys = NKEY; }
        else if (it < 1664) { grp = 1; const int r = it - 1536; qb = r & 3; h = (r >> 2) & 3; b = r >> 4; nkeys = 256; }
        else { grp = 0; const int r = it - 1664; qb = r & 1; h = (r >> 1) & 3; b = r >> 3; nkeys = 256; }
        if (grp) attn_item<1>(p, wsid_, ws_, layer, b, h, qb, nkeys, lam, lam_init, smem, tid);
        else attn_item<0>(p, wsid_, ws_, layer, b, h, qb, nkeys, lam, lam_init, smem, tid);
        if (conv_left) conv_left = conv_big_step(p, wsid_, ws_, layer, cctr, s_item, smem, tid, hb_);
    }
    while (conv_left) conv_left = conv_big_step(p, wsid_, ws_, layer, cctr, s_item, smem, tid, hb_);
}

__device__ void phase_outproj(KP p, int wsid_, int layer, int nrows, int bid, int nb, char* smem) {
    PHASE_PROLOGUE
    const bfu* MIX = (const bfu*)(ws_ + WS_MIX); const bfu* W = (const bfu*)(ws_ + WS_WOUT);
    float* X = (float*)(ws_ + WS_X); const float* mod = (const float*)(ws_ + WS_MOD);
    const int nitems = (nrows / 128) * 8;
    for (int it = bid; it < nitems; it += nb) {
        const int mt = it >> 3, nt = it & 7, row0 = mt * 128, col0 = nt * 128;
        int b, j0, s; row_info(row0, b, j0, s);
        const float* ga = mod + ((size_t)layer * 9 + s) * 6144 + 2 * 1024;
        gemm_tile([&](int r) { return MIX + (size_t)(row0 + r) * DM; }, [&](int r) { return W + (size_t)(col0 + r) * DM; }, DM,
            [&](f32x4 (&acc)[4][4], int wr, int wc, int fr, int fq) {
                ACC_FOREACH({ float* xp = X + (size_t)(row0 + row) * DM + col0 + col; *xp += ga[col0 + col] * val; })
            }, smem, wsid_);
    }
}

__device__ void phase_norm2_route(KP p, int wsid_, int layer, int nrows, int bid, int nb, char* smem, bool dry = false) {
    PHASE_PROLOGUE
    const float* X = (const float*)(ws_ + WS_X); bfu* H = (bfu*)(ws_ + WS_H);
    const float* mod = (const float*)(ws_ + WS_MOD); const float* WRT = (const float*)(ws_ + WS_WRT);
    int* ECNT = (int*)(ws_ + WS_ECNT) + layer * 32; int* EIDX = (int*)(ws_ + WS_EIDX); float* EGATE = (float*)(ws_ + WS_EGATE); int* ELIST = (int*)(ws_ + WS_ELIST);
    float* lg = (float*)smem;
    int* lcnt = (int*)(lg + 4 * 16 * 48);
    int* lbase = lcnt + 32;
    int* lsel = lbase + 32;
    int* lrank = lsel + 128;
    char* slab = smem + 14336;
    constexpr int SLAB = 27136;
    const bfu* WH = (const bfu*)(ws_ + WS_WRTH); const bfu* WL = (const bfu*)(ws_ + WS_WRTL);
    const int tid = tid_, lane = tid & 63, wv = tid >> 6, r = lane & 15, kq = lane >> 4;
    const float* gf = p.g_ffn + layer * DM;
    const float* bg = p.r_b_group + layer * 4; const float* be = p.r_b_expert + layer * 32;
    const int nitems = nrows / 64;
    for (int it = bid; it < nitems; it += nb) {
        const int row = it * 64 + wv * 16 + r;
        int b, j, s; row_info(row, b, j, s);
        const float* xr = X + (size_t)row * DM;
        const float* sh = mod + ((size_t)layer * 9 + s) * 6144 + 3 * 1024; const float* sc = sh + 1024;
        if (tid < 32) lcnt[tid] = 0;
        float ss = 0.f;
#pragma unroll 1
        for (int c0 = 0; c0 < 64; c0 += 16) {
            float4 xv_[16];
#pragma unroll
            for (int c = 0; c < 16; ++c) xv_[c] = *(const float4*)(xr + (c0 + c) * 16 + kq * 4);
#pragma unroll
            for (int c = 0; c < 16; c += 4)
                asm volatile("" : "+v"(xv_[c].x), "+v"(xv_[c].y), "+v"(xv_[c].z), "+v"(xv_[c].w), "+v"(xv_[c + 1].x), "+v"(xv_[c + 1].y), "+v"(xv_[c + 1].z), "+v"(xv_[c + 1].w),
                                  "+v"(xv_[c + 2].x), "+v"(xv_[c + 2].y), "+v"(xv_[c + 2].z), "+v"(xv_[c + 2].w), "+v"(xv_[c + 3].x), "+v"(xv_[c + 3].y), "+v"(xv_[c + 3].z), "+v"(xv_[c + 3].w) :: "memory");
#pragma unroll
            for (int c = 0; c < 16; ++c) ss += xv_[c].x * xv_[c].x + xv_[c].y * xv_[c].y + xv_[c].z * xv_[c].z + xv_[c].w * xv_[c].w;
        }
        ss = xor32_sum(xor16_sum(ss));
        const float rs = rsqrtf(ss * (1.f / 1024.f) + 1e-6f);
        f32x4 acc[3];
#pragma unroll
        for (int n = 0; n < 3; ++n) acc[n] = (f32x4){0.f, 0.f, 0.f, 0.f};
        uint4 sw0, sw1, sw2, sw3, sw4, sw5; float4 sg = make_float4(0.f, 0.f, 0.f, 0.f);
        const int ch0 = tid, ch1 = tid + 256, ch2 = tid + 512;
        const size_t wo0 = (size_t)(ch0 >> 4) * DM + (ch0 & 15) * 8, wo1 = (size_t)(ch1 >> 4) * DM + (ch1 & 15) * 8, wo2 = (size_t)(ch2 >> 4) * DM + (ch2 & 15) * 8;
        const int lo0 = (ch0 >> 4) * 272 + (ch0 & 15) * 16, lo1 = (ch1 >> 4) * 272 + (ch1 & 15) * 16, lo2 = (ch2 >> 4) * 272 + (ch2 & 15) * 16;
#define RT_SLAB_LOAD(sb_) { const int k0_ = (sb_) * 128; \
            sw0 = *(const uint4*)(WH + wo0 + k0_); sw1 = *(const uint4*)(WH + wo1 + k0_); sw2 = *(const uint4*)(WH + wo2 + k0_); \
            sw3 = *(const uint4*)(WL + wo0 + k0_); sw4 = *(const uint4*)(WL + wo1 + k0_); sw5 = *(const uint4*)(WL + wo2 + k0_); \
            if (tid < 32) { const float4 g4 = *(const float4*)(gf + k0_ + tid * 4), s4_ = *(const float4*)(sc + k0_ + tid * 4); sg = make_float4(g4.x * (1.f + s4_.x), g4.y * (1.f + s4_.y), g4.z * (1.f + s4_.z), g4.w * (1.f + s4_.w)); } \
            else if (tid < 64) sg = *(const float4*)(sh + k0_ + (tid - 32) * 4); }
#define RT_SLAB_STORE(buf_) { char* d_ = slab + (buf_) * SLAB; \
            *(uint4*)(d_ + lo0) = sw0; *(uint4*)(d_ + lo1) = sw1; *(uint4*)(d_ + lo2) = sw2; *(uint4*)(d_ + 13056 + lo0) = sw3; *(uint4*)(d_ + 13056 + lo1) = sw4; *(uint4*)(d_ + 13056 + lo2) = sw5; \
            if (tid < 64) *(float4*)(d_ + 26112 + tid * 16) = sg; }
        float4 xq0, xq1, xq2, xq3, xq4, xq5, xq6, xq7;
#define RT_X_LOAD(sb_) { const float* x_ = xr + (sb_) * 128 + kq * 8; xq0 = *(const float4*)(x_); xq1 = *(const float4*)(x_ + 4); xq2 = *(const float4*)(x_ + 32); xq3 = *(const float4*)(x_ + 36); \
            xq4 = *(const float4*)(x_ + 64); xq5 = *(const float4*)(x_ + 68); xq6 = *(const float4*)(x_ + 96); xq7 = *(const float4*)(x_ + 100); }
        __syncthreads();
        RT_SLAB_LOAD(0) RT_SLAB_STORE(0) RT_X_LOAD(0)
        __syncthreads();
        for (int sb = 0; sb < 8; ++sb) {
            if (sb + 1 < 8) RT_SLAB_LOAD(sb + 1)
            const float4 xc[8] = {xq0, xq1, xq2, xq3, xq4, xq5, xq6, xq7};
            if (sb + 1 < 8) RT_X_LOAD(sb + 1)
            const char* d = slab + (sb & 1) * SLAB;
#pragma unroll
            for (int s4 = 0; s4 < 4; ++s4) {
                const float4 g0 = *(const float4*)(d + 26112 + (s4 * 32 + kq * 8) * 4), g1 = *(const float4*)(d + 26112 + (s4 * 32 + kq * 8 + 4) * 4);
                const float4 h0 = *(const float4*)(d + 26624 + (s4 * 32 + kq * 8) * 4), h1 = *(const float4*)(d + 26624 + (s4 * 32 + kq * 8 + 4) * 4);
                const float4 xa = xc[2 * s4], xb = xc[2 * s4 + 1];
                float f[8];
                f[0] = xa.x * rs * g0.x + h0.x; f[1] = xa.y * rs * g0.y + h0.y; f[2] = xa.z * rs * g0.z + h0.z; f[3] = xa.w * rs * g0.w + h0.w;
                f[4] = xb.x * rs * g1.x + h1.x; f[5] = xb.y * rs * g1.y + h1.y; f[6] = xb.z * rs * g1.z + h1.z; f[7] = xb.w * rs * g1.w + h1.w;
                unsigned hi[4], lo[4];
#pragma unroll
                for (int i = 0; i < 4; ++i) {
                    hi[i] = pack2(f[2 * i], f[2 * i + 1]);
                    lo[i] = pack2(f[2 * i] - __uint_as_float(hi[i] << 16), f[2 * i + 1] - __uint_as_float(hi[i] & 0xFFFF0000u));
                }
                *(uint4*)(H + (size_t)row * DM + sb * 128 + s4 * 32 + kq * 8) = make_uint4(hi[0], hi[1], hi[2], hi[3]);
                const bf16x8 ah = mk8(hi[0], hi[1], hi[2], hi[3]), al = mk8(lo[0], lo[1], lo[2], lo[3]);
#pragma unroll
                for (int n = 0; n < 3; ++n) {
                    const bf16x8 wh = *(const bf16x8*)(d + (n * 16 + r) * 272 + (s4 * 32 + kq * 8) * 2), wl = *(const bf16x8*)(d + 13056 + (n * 16 + r) * 272 + (s4 * 32 + kq * 8) * 2);
                    acc[n] = __builtin_amdgcn_mfma_f32_16x16x32_bf16(ah, wh, acc[n], 0, 0, 0);
                    acc[n] = __builtin_amdgcn_mfma_f32_16x16x32_bf16(ah, wl, acc[n], 0, 0, 0);
                    acc[n] = __builtin_amdgcn_mfma_f32_16x16x32_bf16(al, wh, acc[n], 0, 0, 0);
                }
            }
            if (sb + 1 < 8) RT_SLAB_STORE((sb + 1) & 1)
            __syncthreads();
        }
#pragma unroll
        for (int n = 0; n < 3; ++n)
#pragma unroll
            for (int jj = 0; jj < 4; ++jj) lg[(wv * 16 + kq * 4 + jj) * 48 + n * 16 + r] = acc[n][jj];
        __syncthreads();
        if (lane < 16) {
            const float* L = lg + (wv * 16 + lane) * 48;
            const int grow = it * 64 + wv * 16 + lane;
            float gl[4]; float gm = -1e30f; int gi = 0;
#pragma unroll
            for (int g = 0; g < 4; ++g) { gl[g] = L[g] + bg[g]; if (gl[g] > gm) { gm = gl[g]; gi = g; } }
            float gs = 0.f;
#pragma unroll
            for (int g = 0; g < 4; ++g) gs += __expf(gl[g] - gm);
            const float gp = 1.f / gs;
            float v1 = -1e30f, v2 = -1e30f; int i1 = 0, i2 = 0;
            const float4 be0 = *(const float4*)(be + gi * 8), be1 = *(const float4*)(be + gi * 8 + 4);
            const float bev[8] = {be0.x, be0.y, be0.z, be0.w, be1.x, be1.y, be1.z, be1.w};
#pragma unroll
            for (int e = 0; e < 8; ++e) {
                const float v = L[4 + gi * 8 + e] + bev[e];
                if (v > v1) { v2 = v1; i2 = i1; v1 = v; i1 = e; } else if (v > v2) { v2 = v; i2 = e; }
            }
            const float e2 = __expf(v2 - v1), den = 1.f / (1.f + e2);
            const int ex1 = gi * 8 + i1, ex2 = gi * 8 + i2;
            EIDX[grow * 2] = ex1; EIDX[grow * 2 + 1] = ex2;
            EGATE[grow * 2] = den * gp; EGATE[grow * 2 + 1] = e2 * den * gp;
            const int lr = wv * 16 + lane;
            lsel[lr * 2] = ex1; lsel[lr * 2 + 1] = ex2;
            lrank[lr * 2] = atomicAdd(&lcnt[ex1], 1); lrank[lr * 2 + 1] = atomicAdd(&lcnt[ex2], 1);
        }
        __syncthreads();
        if (tid < 32) lbase[tid] = (lcnt[tid] > 0 && !dry) ? atomicAdd(&ECNT[tid], lcnt[tid]) : 0;
        __syncthreads();
        if (tid < 128 && !dry) { const int e = lsel[tid]; ELIST[(size_t)e * (2 * MA) + lbase[e] + lrank[tid]] = ((it * 64 + (tid >> 1)) << 1) | (tid & 1); }
        __syncthreads();
    }
}

__device__ __forceinline__ int moe_prefix256(const int* ECNT, int* spre  , int wsid_) {
    const int t5 = TID512;
    if (t5 < 32) spre[40 + t5] = (ECNT[t5] + 255) >> 8;
    __syncthreads();
    if (t5 == 0) { int a = 0; for (int e = 0; e < 32; ++e) { spre[e] = a; a += spre[40 + e]; } spre[32] = a; }
    __syncthreads();
    return spre[32];
}
__device__ void phase_outproj256(KP p, int wsid_, int layer, int nrows, int vblk, int nblk, char* smem_all, unsigned* cctr, int* s_item, float gscale = 1.f) {
    PHASE_PROLOGUE
    const bfu* MIX = (const bfu*)(ws_ + WS_MIX); const bfu* W = (const bfu*)(ws_ + WS_WOUT);
    const float* mod = (const float*)(ws_ + WS_MOD);
    const int nitems = (nrows >> 8) * 4;
    for (int it = vblk; it < nitems; it += nblk) {
        const int mt = it >> 2, nt = it & 3, row0 = mt * 256, col0 = nt * 256;
        int b, j0, sm; row_info(row0, b, j0, sm);
        const float* ga = mod + ((size_t)layer * 9 + sm) * 6144 + 2 * 1024 + col0;
        const bfu* B0 = W + (size_t)col0 * DM;
        gemm256<DM, DM, DM>(MIX, [&](int r) { return row0 + r; }, B0, B0 + (size_t)128 * DM,
            [&](f32x4 (&acc)[2][2][4][2], int wr, int wc, int fr, int fq) {
                const __amdgpu_buffer_rsrc_t rs = __builtin_amdgcn_make_buffer_rsrc((void*)(ws_ + WS_X), 0, (int)((size_t)MA * DM * 4), 0x00020000);
                const int voff = ((wr * 64 + fq * 4) * DM + wc * 32 + fr) * 4;
#pragma unroll
                for (int bj = 0; bj < 2; ++bj) {
                    float xo[2][2][4][4];
                    const float g0 = ga[bj * 128 + wc * 32 + fr] * gscale, g1 = ga[bj * 128 + wc * 32 + 16 + fr] * gscale;
#pragma unroll
                    for (int n = 0; n < 2; ++n)
#pragma unroll
                        for (int ai = 0; ai < 2; ++ai)
#pragma unroll
                            for (int m = 0; m < 4; ++m)
#pragma unroll
                                for (int j = 0; j < 4; ++j)
                                    xo[n][ai][m][j] = __uint_as_float(__builtin_amdgcn_raw_buffer_load_b32(rs, voff, ((row0 + ai * 128 + m * 16 + j) * DM + col0 + bj * 128 + n * 16) * 4, 0));
#pragma unroll
                    for (int n = 0; n < 2; ++n)
#pragma unroll
                        for (int ai = 0; ai < 2; ++ai)
#pragma unroll
                            for (int m = 0; m < 4; ++m)
#pragma unroll
                                for (int j = 0; j < 4; ++j)
                                    __builtin_amdgcn_raw_buffer_store_b32(__float_as_uint(xo[n][ai][m][j] + (n ? g1 : g0) * acc[ai][bj][m][n][j]), rs, voff, ((row0 + ai * 128 + m * 16 + j) * DM + col0 + bj * 128 + n * 16) * 4, 0);
                }
            }, smem_all, wsid_);
    }
    if (nitems > nblk && vblk >= nitems - nblk) { for (int q = 0; q < 5; ++q) if (!conv_big_step(p, wsid_, ws_, layer, cctr, s_item, smem_all + hb_ * SMEM_BYTES, tid_, hb_)) break; }
}
__device__ void phase_experts256(KP p, int wsid_, int layer, int vblk, int nblk, unsigned* rbcnt, char* smem_all) {
    PHASE_PROLOGUE
    const bfu* H = (const bfu*)(ws_ + WS_H); const bfu* W1 = (const bfu*)(ws_ + WS_W1); const bfu* W3 = (const bfu*)(ws_ + WS_W3);
    const bfu* HB = (const bfu*)(ws_ + WS_HB); const bfu* W2 = (const bfu*)(ws_ + WS_W2);
    const int* ECNT = (const int*)(ws_ + WS_ECNT) + layer * 32; const int* ELIST = (const int*)(ws_ + WS_ELIST); const float* EGATE = (const float*)(ws_ + WS_EGATE);
    int* spre = (int*)(smem_all + 135168);
    const int nb256 = __builtin_amdgcn_readfirstlane(moe_prefix256(ECNT, spre, wsid_));
    const int n1 = nb256 * 4;
    for (int it = vblk; it < 2 * n1; it += nblk) {
        const bool second = it >= n1;
        const int t = second ? it - n1 : it, blk = t >> 2, nt = t & 3;
        int e = 0;
        while (__builtin_amdgcn_readfirstlane(spre[e + 1]) <= blk) ++e;
        const int rb = blk - __builtin_amdgcn_readfirstlane(spre[e]), cnt = __builtin_amdgcn_readfirstlane(ECNT[e]);
        const int* lst = ELIST + (size_t)e * (2 * MA) + rb * 256;
        const int nvalid = min(256, cnt - rb * 256);
        if (!second) {
            const bfu* w1 = W1 + ((size_t)e * FF + nt * 128) * DM; const bfu* w3 = W3 + ((size_t)e * FF + nt * 128) * DM;
            gemm256<DM, DM, DM>(H, [&](int r) { const int e_ = lst[r < nvalid ? r : 0]; return r < nvalid ? (e_ >> 1) : 0; }    , w1, w3,
                [&](f32x4 (&acc)[2][2][4][2], int wr, int wc, int fr, int fq) {
                    const __amdgpu_buffer_rsrc_t rs = __builtin_amdgcn_make_buffer_rsrc((void*)(ws_ + WS_HB), 0, (int)((size_t)(2 * MA + 32 * 256) * FF * 2), 0x00020000);
                    const int voff = ((wr * 64 + fq * 4) * FF + wc * 32 + fr) * 2;
#pragma unroll
                    for (int ai = 0; ai < 2; ++ai)
#pragma unroll
                        for (int m = 0; m < 4; ++m)
#pragma unroll
                            for (int n = 0; n < 2; ++n)
#pragma unroll
                                for (int j = 0; j < 4; ++j) {
                                    const float a = acc[ai][0][m][n][j], g = acc[ai][1][m][n][j];
                                    __builtin_amdgcn_raw_buffer_store_b16(f2bf(siluf_(a) * g), rs, voff, ((blk * 256 + ai * 128 + m * 16 + j) * FF + nt * 128 + n * 16) * 2, 16);
                                }
                    asm volatile("s_waitcnt vmcnt(0)" ::: "memory");
                    __syncthreads();
                    if (TID512 == 0) __hip_atomic_fetch_add(rbcnt + blk, 1u, __ATOMIC_RELAXED, __HIP_MEMORY_SCOPE_AGENT);
                }, smem_all, wsid_);
        } else {
            if (TID512 == 0) {
                unsigned spins = 0;
                while (__hip_atomic_load(rbcnt + blk, __ATOMIC_RELAXED, __HIP_MEMORY_SCOPE_AGENT) < 4u) { __builtin_amdgcn_s_sleep(1); if (++spins > (1u << 22)) break; }
                __builtin_amdgcn_fence(__ATOMIC_ACQUIRE, "agent");
                asm volatile("s_waitcnt vmcnt(0)" ::: "memory");
            }
            __syncthreads();
            const bfu* w2 = W2 + ((size_t)e * DM + nt * 256) * FF;
            gemm256<FF, FF, FF>(HB, [&](int r) { return blk * 256 + r; }, w2, w2 + (size_t)128 * FF,
                [&](f32x4 (&acc)[2][2][4][2], int wr, int wc, int fr, int fq) {
                    int* sOff = (int*)smem_all; float* sGt = (float*)(smem_all + 1024);
                    { const int r = TID512;
                      if (r < 256) {
                          const bool ok = r < nvalid; const int ent = ok ? lst[r] : 0;
                          sOff[r] = ok ? ((ent & 1) * MA + (ent >> 1)) * DM * 2 : -1; sGt[r] = EGATE[ent];
                      } }
                    __syncthreads();
                    const __amdgpu_buffer_rsrc_t rs = __builtin_amdgcn_make_buffer_rsrc((void*)(ws_ + WS_Y01), 0, (int)((size_t)2 * MA * DM * 2), 0x00020000);
                    const int cofs = (nt * 256 + wc * 32 + fr) * 2;
#pragma unroll
                    for (int ai = 0; ai < 2; ++ai)
#pragma unroll
                        for (int m = 0; m < 4; ++m) {
                            const int4 o4 = *(const int4*)(sOff + ai * 128 + wr * 64 + m * 16 + fq * 4); const float4 g4 = *(const float4*)(sGt + ai * 128 + wr * 64 + m * 16 + fq * 4);
                            const int oo[4] = {o4.x, o4.y, o4.z, o4.w}; const float gg[4] = {g4.x, g4.y, g4.z, g4.w};
#pragma unroll
                            for (int j = 0; j < 4; ++j) {
                                if (oo[j] >= 0) {
#pragma unroll
                                    for (int bj = 0; bj < 2; ++bj)
#pragma unroll
                                        for (int n = 0; n < 2; ++n)
                                            __builtin_amdgcn_raw_buffer_store_b16(f2bf(gg[j] * acc[ai][bj][m][n][j]), rs, oo[j] + cofs, (bj * 128 + n * 16) * 2, 0);
                                }
                            }
                        }
                }, smem_all, wsid_);
        }
    }
}

__device__ __forceinline__ int moe_prefix(const int* ECNT, int* spre  , int wsid_) {
    if ((TID512 & 255) == 0) { int a = 0; for (int e = 0; e < 32; ++e) { spre[e] = a; a += (ECNT[e] + 127) >> 7; } spre[32] = a; }
    __syncthreads();
    return spre[32];
}
__device__ void phase_expert1(KP p, int wsid_, int layer, int bid, int nb, char* smem) {
    PHASE_PROLOGUE
    const bfu* H = (const bfu*)(ws_ + WS_H); const bfu* W1 = (const bfu*)(ws_ + WS_W1); const bfu* W3 = (const bfu*)(ws_ + WS_W3);
    bfu* HB = (bfu*)(ws_ + WS_HB);
    const int* ECNT = (const int*)(ws_ + WS_ECNT) + layer * 32; const int* ELIST = (const int*)(ws_ + WS_ELIST);
    int* spre = (int*)(smem + 65536);
    const int nblk = moe_prefix(ECNT, spre, wsid_);
    const int nitems = nblk * 8;
    for (int it = bid; it < nitems; it += nb) {
        const int blk = it >> 3, nt = it & 7;
        int e = 0;
        while (spre[e + 1] <= blk) ++e;
        const int rb = blk - spre[e], cnt = ECNT[e];
        const int* lst = ELIST + (size_t)e * (2 * MA) + rb * 128;
        const int nvalid = min(128, cnt - rb * 128);
        const bfu* w1 = W1 + (size_t)e * FF * DM; const bfu* w3 = W3 + (size_t)e * FF * DM;
        bfu* hb = HB + (size_t)blk * 128 * FF;
        gemm_tile([&](int r) { const int tok = r < nvalid ? (lst[r] >> 1) : 0; return H + (size_t)tok * DM; },
                  [&](int r) { const int wcx = r >> 6, n4 = (r >> 4) & 3, rr = r & 15; const int hc = nt * 64 + wcx * 32 + (n4 & 1) * 16 + rr; return (n4 < 2 ? w1 : w3) + (size_t)hc * DM; }, DM,
            [&](f32x4 (&acc)[4][4], int wr, int wc, int fr, int fq) {
#pragma unroll
                for (int m = 0; m < 4; ++m)
#pragma unroll
                    for (int n = 0; n < 2; ++n)
#pragma unroll
                        for (int jj = 0; jj < 4; ++jj) {
                            const int row = wr * 64 + m * 16 + fq * 4 + jj; const int hc = nt * 64 + wc * 32 + n * 16 + fr;
                            const float a = acc[m][n][jj], g = acc[m][n + 2][jj];
                            hb[(size_t)row * FF + hc] = f2bf(siluf_(a) * g);
                        }
            }, smem, wsid_);
    }
}
__device__ void phase_expert2(KP p, int wsid_, int layer, int bid, int nb, char* smem) {
    PHASE_PROLOGUE
    const bfu* HB = (const bfu*)(ws_ + WS_HB); const bfu* W2 = (const bfu*)(ws_ + WS_W2);
    float* Y = (float*)(ws_ + WS_Y01);
    const int* ECNT = (const int*)(ws_ + WS_ECNT) + layer * 32; const int* ELIST = (const int*)(ws_ + WS_ELIST); const float* EGATE = (const float*)(ws_ + WS_EGATE);
    int* spre = (int*)(smem + 65536);
    const int nblk = moe_prefix(ECNT, spre, wsid_);
    const int nitems = nblk * 8;
    for (int it = bid; it < nitems; it += nb) {
        const int blk = it >> 3, nt = it & 7;
        int e = 0;
        while (spre[e + 1] <= blk) ++e;
        const int rb = blk - spre[e], cnt = ECNT[e];
        const int* lst = ELIST + (size_t)e * (2 * MA) + rb * 128;
        const int nvalid = min(128, cnt - rb * 128);
        const bfu* w2 = W2 + (size_t)e * DM * FF;
        const bfu* hb = HB + (size_t)blk * 128 * FF;
        gemm_tile([&](int r) { return hb + (size_t)r * FF; }, [&](int r) { return w2 + (size_t)(nt * 128 + r) * FF; }, FF,
            [&](f32x4 (&acc)[4][4], int wr, int wc, int fr, int fq) {
#pragma unroll
                for (int m = 0; m < 4; ++m)
#pragma unroll
                    for (int jj = 0; jj < 4; ++jj) {
                        const int row = wr * 64 + m * 16 + fq * 4 + jj;
                        if (row < nvalid) {
                            const int ent = lst[row]; const float gt = EGATE[ent];
                            float* yp = Y + ((size_t)(ent & 1) * MA + (ent >> 1)) * DM + nt * 128 + wc * 64 + fr;
#pragma unroll
                            for (int n = 0; n < 4; ++n) yp[n * 16] = gt * acc[m][n][jj];
                        }
                    }
            }, smem, wsid_);
    }
}

#define XB_TMO      128
#define XB_XCNT(j)  (256  + 64 * (j))
#define XB_XSUB(j)  (1280 + 64 * (j))
#define XB_XGEN(j)  (2304 + 64 * (j))
#define XB_TOP      3328
#define XB_TOPGEN   3392
#define XCD_BAR_WORDS 3456
#define XB_SPIN_CAP (1u << 22)
#define LAS __attribute__((address_space(3)))

__device__ __forceinline__ unsigned xb_ld(unsigned* p)              { return __hip_atomic_load(p, __ATOMIC_RELAXED, __HIP_MEMORY_SCOPE_AGENT); }
__device__ __forceinline__ unsigned xb_add(unsigned* p, unsigned v) { return __hip_atomic_fetch_add(p, v, __ATOMIC_RELAXED, __HIP_MEMORY_SCOPE_AGENT); }
__device__ __forceinline__ unsigned xb_xcc_id() { return (unsigned)__builtin_amdgcn_s_getreg((3 << 11) | 20) & 0xFu; }
#define XB_SPIN(cond, bar) do { unsigned _sp = 0; while (cond) { __builtin_amdgcn_s_sleep(1); \
    if ((++_sp & 255u) == 0u) { if (xb_ld(&(bar)[XB_TMO])) break; if (_sp > XB_SPIN_CAP) { atomicAdd(&(bar)[XB_TMO], 1u); break; } } } } while (0)

struct XcdBarrier {
    unsigned* bar; unsigned x;
    volatile LAS unsigned* st;
};

__device__ __forceinline__ XcdBarrier xcd_barrier_post(unsigned* bar, volatile LAS unsigned* st, int wsid_) {
    XcdBarrier b; b.bar = bar; b.x = xb_xcc_id(); b.st = st;
    if (TID512 == 0) (void)xb_add(&bar[XB_XCNT(b.x)], 1u);
    return b;
}
__device__ __forceinline__ void xcd_barrier_complete(unsigned* bar, unsigned x, unsigned& nloc, unsigned& nx) {
    const unsigned G = gridDim.x * gridDim.y * gridDim.z;
    unsigned sum, cnt, mine, sp = 0u;
    for (;;) {
        sum = 0u; cnt = 0u; mine = 0u;
#pragma unroll
        for (unsigned j = 0; j < 16; ++j) { const unsigned c = xb_ld(&bar[XB_XCNT(j)]); sum += c; cnt += (c > 0u) ? 1u : 0u; mine = (j == x) ? c : mine; }
        if (sum == G) break;
        __builtin_amdgcn_s_sleep(1);
        if ((++sp & 255u) == 0u) { if (xb_ld(&bar[XB_TMO])) break; if (sp > XB_SPIN_CAP) { atomicAdd(&bar[XB_TMO], 1u); break; } }
    }
    nloc = mine > 0u ? mine : 1u; nx = cnt > 0u ? cnt : 1u;
}

__device__ __forceinline__ void xcd_barrier_(const XcdBarrier& b, int wsid_) {
    asm volatile("s_waitcnt vmcnt(0)" ::: "memory");
    __syncthreads();
    if (TID512 == 0) {
        unsigned* bar = b.bar;
        __builtin_amdgcn_s_waitcnt(0);
        unsigned nloc = b.st[0], nx = b.st[1];
        if (nloc == 0u) { xcd_barrier_complete(bar, b.x, nloc, nx); b.st[0] = nloc; b.st[1] = nx; }
        const unsigned old = xb_add(&bar[XB_XSUB(b.x)], 1u);
        const unsigned gen = old / nloc;
        if (old + 1u == (gen + 1u) * nloc) {
            __builtin_amdgcn_fence(__ATOMIC_RELEASE, "agent");
            asm volatile("s_waitcnt vmcnt(0)" ::: "memory");
            const unsigned og = xb_add(&bar[XB_TOP], 1u);
            const unsigned tg = og / nx;
            if (og + 1u == (tg + 1u) * nx) xb_add(&bar[XB_TOPGEN], 1u);
            else XB_SPIN(xb_ld(&bar[XB_TOPGEN]) == tg, bar);
            __builtin_amdgcn_fence(__ATOMIC_ACQUIRE, "agent");
            xb_add(&bar[XB_XGEN(b.x)], 1u);
            asm volatile("s_waitcnt vmcnt(0)" ::: "memory");
        } else {
            XB_SPIN(xb_ld(&bar[XB_XGEN(b.x)]) == gen, bar);
            __builtin_amdgcn_fence(__ATOMIC_ACQUIRE, "agent");
            asm volatile("s_waitcnt vmcnt(0)" ::: "memory");
        }
    }
    __syncthreads();
}


#define REP_MOD 1
#define REP_OUTPROJ 1
#define REP_ROUTE 1
#define REP_NORM1 1
#define REP_CONV 1
#define REP_INPROJ 1
#define REP_RK 1
#define REP_SCANATT 1
#define REP_R4 1
#define REP_ATT 1
#define REP_READOUT 1
#define REP_EXP1 1
#define REP_EXP2 1
#define REPEAT(N) _Pragma("nounroll") for (int rep_ = 0; rep_ < (N); ++rep_)
#define REPEAT2(N) _Pragma("nounroll") for (int rep2_ = 0; rep2_ < (N); ++rep2_)
#define CTL_Q(l) (4096 + 64 * (l))
#define CTL_XR 5120
#define CTL_RBC 6144
__global__ void __launch_bounds__(512, 2) fwd(P p) {
    __shared__ __attribute__((aligned(16))) char smem_all[2 * SMEM_BYTES + 64];
    const int wsid_ = __builtin_amdgcn_readfirstlane((int)(threadIdx.x >> 6));
    const int hb = wsid_ >> 2;
    char* smem = smem_all + hb * SMEM_BYTES;
    uint4& xb_words = *(uint4*)(smem_all + 2 * SMEM_BYTES);
    int& s_item = *(int*)(smem_all + 2 * SMEM_BYTES + 16);
    int& s_vb = *(int*)(smem_all + 2 * SMEM_BYTES + 20);
    if (TID512 == 0) xb_words = make_uint4(0u, 0u, 0u, 0u);
    __syncthreads();
    unsigned* ctl = (unsigned*)(KPARG.ws + WS_CTL);
    XcdBarrier bar = xcd_barrier_post(ctl, (volatile LAS unsigned*)&xb_words, wsid_);
#define xcd_barrier(b_) xcd_barrier_(b_, wsid_)
    const int bid = blockIdx.x * 2 + hb, nb = gridDim.x * 2;
    const unsigned my_xcc = xb_xcc_id();
    if (TID512 == 0) s_vb = (int)atomicAdd(&ctl[CTL_XR + 16 * my_xcc], 1u);
    int vb = bid;
    phase_setup(KPARG, wsid_, bid, nb);
    REPEAT(REP_MOD) phase_mod(KPARG, wsid_, bid, nb, smem);
    for (int l = 0; l < NLAYER; ++l) {
        const int nr = l < NLAYER - 1 ? MA : ML;
        REPEAT(REP_CONV) phase_conv(KPARG, wsid_, l, bid, nb, smem);
        if (l == 0) {
            xcd_barrier(bar);
            if (TID512 == 0) { int pre = 0; for (unsigned x = 0; x < my_xcc; ++x) pre += (int)xb_ld(&ctl[CTL_XR + 16 * x]); s_vb += pre; }
            __syncthreads();
            vb = __builtin_amdgcn_readfirstlane(s_vb) * 2 + hb;
        }
        phase_norm1(KPARG, wsid_, l, 0, bid, nb);
        REPEAT(REP_NORM1 - 1) { xcd_barrier(bar); phase_norm1(KPARG, wsid_, l, 0, bid, nb, false); }
        xcd_barrier(bar);
        REPEAT(REP_INPROJ) { phase_inproj256(KPARG, wsid_, l, vb >> 1, nb >> 1, smem_all, ctl + CTL_Q(l) + 8, &s_item); xcd_barrier(bar); }
        REPEAT(REP_RK) { phase_rk(KPARG, wsid_, l, bid, nb, smem); xcd_barrier(bar); }
        REPEAT(REP_SCANATT) {
            if (bid < 128) { REPEAT(REP_R4) phase_r4(KPARG, wsid_, l, bid, 128, smem); }
            else phase_gate(KPARG, wsid_, l, bid - 128, nb - 128, smem);
            REPEAT2(REP_ATT) phase_attn(KPARG, wsid_, l, l < NLAYER - 1, ctl + CTL_Q(l) + 16 * rep_ + 32 * rep2_, l < NLAYER - 1 ? nullptr : ctl + CTL_Q(l) + 8, &s_item, smem);
            xcd_barrier(bar);
        }
        REPEAT(REP_READOUT) { phase_readout(KPARG, wsid_, l, nr, bid, nb); xcd_barrier(bar); }
        phase_outproj256(KPARG, wsid_, l, nr, vb >> 1, nb >> 1, smem_all, ctl + CTL_Q(l) + 8, &s_item);
        REPEAT(REP_OUTPROJ - 1) { xcd_barrier(bar); phase_outproj256(KPARG, wsid_, l, nr, vb >> 1, nb >> 1, smem_all, ctl + CTL_Q(l) + 8, &s_item, 0.f); }
        xcd_barrier(bar);
        phase_norm2_route(KPARG, wsid_, l, nr, bid, nb, smem);
        phase_conv_drain(KPARG, wsid_, l, ctl + CTL_Q(l) + 8, &s_item, smem);
        REPEAT(REP_ROUTE - 1) { xcd_barrier(bar); phase_norm2_route(KPARG, wsid_, l, nr, bid, nb, smem, true); }
        xcd_barrier(bar);
        phase_experts256(KPARG, wsid_, l, vb >> 1, nb >> 1, ctl + CTL_RBC + 256 * l, smem_all);
        xcd_barrier(bar);
    }
    phase_norm1(KPARG, wsid_, NLAYER, 1, bid, nb);
}

extern "C" void kernel_launch(void* const* d_in, const int* in_sizes, int n_in, void* d_out, int out_size, void* d_ws, size_t ws_size, hipStream_t stream) {
    if (n_in != 36 || ws_size < WS_END) { fprintf(stderr, "kernel_launch: unexpected n_in %d or ws_size %zu < %zu\n", n_in, ws_size, (size_t)WS_END); return; }
    static int grid = 0;
    if (!grid) {
        int dev = 0, cus = 0, per_cu = 0;
        hipGetDevice(&dev);
        hipDeviceGetAttribute(&cus, hipDeviceAttributeMultiprocessorCount, dev);
        hipOccupancyMaxActiveBlocksPerMultiprocessor(&per_cu, (const void*)fwd, 512, 0);
        if (per_cu < 1) per_cu = 1;
        grid = cus;
    }
    P p{};
    const float** pp = (const float**)&p;
    for (int i = 0; i < 36; ++i) pp[i] = (const float*)d_in[i];
    p.out = (float*)d_out; p.ws = (char*)d_ws;
    hipMemsetAsync((char*)d_ws + WS_CTL, 0, 65536, stream);
    fwd<<<grid, 512, 0, stream>>>(p);
}
```

```cpp
#include <hip/hip_runtime.h>
#include <stdint.h>
#include <stdio.h>

typedef unsigned short bfu;
using bf16x8 = __attribute__((ext_vector_type(8))) short;
using f32x4  = __attribute__((ext_vector_type(4))) float;

#define DM 1024
#define NB 8
#define SEQ 2048
#define CL 256
#define NKEY 2304
#define ML 16384
#define MC 2048
#define MA 18432
#define INW 3200
#define CSL 1920
#define NEXP 32
#define FF 512
#define NLAYER 4
#define LOG2E 1.4426950408889634f

#define MBy(x) ((size_t)(x) << 20)
constexpr size_t WS_CTL   = 0;
constexpr size_t WS_MOD   = 65536;
constexpr size_t WS_ROPE  = WS_MOD + (size_t)4 * 9 * 6144 * 4;
constexpr size_t WS_ECNT  = WS_ROPE + 64 * 16 * 2 * 4 + 64 * 8 * 2 * 4;
constexpr size_t WS_WRT   = WS_ECNT + 4096;
constexpr size_t WS_WRTH  = WS_WRT + (size_t)48 * 1024 * 4;
constexpr size_t WS_WRTL  = WS_WRTH + (size_t)48 * 1024 * 2;
constexpr size_t WS_EIDX  = WS_WRTL + (size_t)48 * 1024 * 2;
constexpr size_t WS_EGATE = WS_EIDX + (size_t)MA * 2 * 4;
constexpr size_t WS_ELIST = WS_EGATE + (size_t)MA * 2 * 4;
constexpr size_t WS_X     = MBy(8);
constexpr size_t WS_H     = WS_X + (size_t)MA * DM * 4;
constexpr size_t WS_WIN   = WS_H + (size_t)MA * DM * 2;
constexpr size_t WS_WOUT  = WS_WIN + (size_t)INW * DM * 2;
constexpr size_t WS_W1    = WS_WOUT + (size_t)DM * DM * 2;
constexpr size_t WS_W3    = WS_W1 + (size_t)NEXP * FF * DM * 2;
constexpr size_t WS_W2    = WS_W3 + (size_t)NEXP * FF * DM * 2;
constexpr size_t WS_LW2   = WS_W2 + (size_t)NEXP * FF * DM * 2;
constexpr size_t WS_LA2   = WS_LW2 + (size_t)2 * 512 * 64 * 2;
constexpr size_t WS_LG2   = WS_LA2 + (size_t)2 * 512 * 64 * 2;
constexpr size_t WS_QA    = WS_LG2 + (size_t)512 * 128 * 2;
constexpr size_t WS_KA    = WS_QA + (size_t)NB * 4 * NKEY * 64 * 2;
constexpr size_t WS_VAT   = WS_KA + (size_t)NB * 2 * NKEY * 64 * 2;
constexpr size_t WS_QB    = WS_VAT + (size_t)NB * 2 * NKEY * 64 * 2;
constexpr size_t WS_KB    = WS_QB + (size_t)NB * 4 * NKEY * 64 * 2;
constexpr size_t WS_VBT   = WS_KB + (size_t)NB * 4 * NKEY * 64 * 2;
constexpr size_t WS_CP    = WS_VBT + (size_t)NB * 4 * NKEY * 64 * 2;
constexpr size_t WS_GG    = WS_CP + (size_t)MA * CSL * 4;
constexpr size_t WS_MIX   = WS_GG + (size_t)MA * 512 * 4;
constexpr size_t HEADARR  = (size_t)NB * 8 * NKEY * 64 * 4;
#define OPS_REC 13568
constexpr size_t OPS_DIR  = (size_t)64 * 144 * OPS_REC;
constexpr size_t WS_OPS   = WS_MIX + (size_t)MA * DM * 2;
constexpr size_t WS_YS    = WS_OPS + 2 * OPS_DIR;
constexpr size_t WS_VB    = WS_YS + 2 * HEADARR;
constexpr size_t WS_BETA  = WS_VB + (size_t)MA * 512 * 2;
constexpr size_t WS_LXG   = WS_BETA + (size_t)2 * MA * 8 * 4;
constexpr size_t WS_SCR   = WS_LXG + (size_t)MA * 128 * 2;
constexpr size_t WS_END   = WS_SCR + (size_t)256 * 2 * 128 * 132 * 4;
constexpr size_t WS_Y01   = WS_OPS;
constexpr size_t WS_HB    = WS_OPS + (size_t)2 * MA * DM * 4;
static_assert((size_t)2 * MA * DM * 4 + (size_t)(2 * MA + 32 * 256) * 512 * 2 <= 2 * OPS_DIR, "MoE buffers must fit in OPS");

struct P {
    const float *x, *c, *ctx, *c_ctx, *w_mod, *b_mod, *g_mix, *g_ffn, *w_in, *a_q_gain, *a_k_gain, *b_lq1, *b_lk1, *b_lq2, *b_lk2, *b_subln,
        *c_mu, *c_w0, *c_w2, *c_a0, *c_a2, *c_g2, *c_k_k, *c_k_a, *c_r_k, *c_ln_w, *c_ln_b, *w_out, *r_w_group, *r_b_group, *r_w_expert, *r_b_expert,
        *e_w1, *e_w3, *e_w2, *g_final;
    float* out;
    char* ws;
};

typedef const __attribute__((address_space(4))) P& KP;
#define KPARG (*({ const __attribute__((address_space(4))) P* k_ = (const __attribute__((address_space(4))) P*)__builtin_amdgcn_kernarg_segment_ptr(); asm volatile("" : "+s"(k_)); k_; }))

__device__ __forceinline__ float bf2f(bfu b) { return __uint_as_float((unsigned)b << 16); }
__device__ __forceinline__ unsigned pack2(float a, float b) {
    typedef float f2 __attribute__((ext_vector_type(2)));
    typedef __bf16 b2 __attribute__((ext_vector_type(2)));
    f2 v = {a, b}; b2 r = __builtin_convertvector(v, b2); return __builtin_bit_cast(unsigned, r);
}
__device__ __forceinline__ bfu f2bf(float a) { return (bfu)(pack2(a, 0.f) & 0xFFFFu); }
__device__ __forceinline__ int lane_id_() { int l; asm volatile("v_mbcnt_lo_u32_b32 %0, -1, 0\n\tv_mbcnt_hi_u32_b32 %0, -1, %0" : "=v"(l)); return l; }
__device__ __forceinline__ float shfl_xor_(float v, int o) { return __int_as_float(__builtin_amdgcn_ds_bpermute((lane_id_() ^ o) << 2, __float_as_int(v))); }
template <int CTRL> __device__ __forceinline__ float dppf(float v) { return __int_as_float(__builtin_amdgcn_update_dpp(0, __float_as_int(v), CTRL, 0xF, 0xF, true)); }
__device__ __forceinline__ float sum8(float v) { v += dppf<0xB1>(v); v += dppf<0x4E>(v); v += dppf<0x141>(v); return v; }
__device__ __forceinline__ float xor16_sum(float v) { const auto r = __builtin_amdgcn_permlane16_swap(__float_as_uint(v), __float_as_uint(v), false, false); return __uint_as_float(r[0]) + __uint_as_float(r[1]); }
__device__ __forceinline__ float xor32_sum(float v) { const auto r = __builtin_amdgcn_permlane32_swap(__float_as_uint(v), __float_as_uint(v), false, false); return __uint_as_float(r[0]) + __uint_as_float(r[1]); }
__device__ __forceinline__ float xor32_max(float v) { const auto r = __builtin_amdgcn_permlane32_swap(__float_as_uint(v), __float_as_uint(v), false, false); return fmaxf(__uint_as_float(r[0]), __uint_as_float(r[1])); }
__device__ __forceinline__ float sum64(float v) { v = sum8(v); v += dppf<0x140>(v); v = xor16_sum(v); return xor32_sum(v); }
__device__ __forceinline__ float sigmoidf_(float x) { return __builtin_amdgcn_rcpf(1.f + __expf(-x)); }
__device__ __forceinline__ float siluf_(float x) { return x * __builtin_amdgcn_rcpf(1.f + __expf(-x)); }
__device__ __forceinline__ void row_info(int grow, int& b, int& j, int& s) {
    if (grow < ML) { b = grow >> 11; j = 256 + (grow & 2047); s = b; }
    else { int r = grow - ML; b = r >> 8; j = r & 255; s = 8; }
}
__device__ __forceinline__ int grow_of(int b, int j) { return j < 256 ? ML + b * 256 + j : b * 2048 + (j - 256); }

#define SMEM_BYTES 69632

#define TID512 ((wsid_ << 6) | lane_id_())
#define PHASE_PROLOGUE int tid_ = ((wsid_ & 3) << 6) | lane_id_(); asm volatile("" : "+v"(tid_)); const int hb_ = wsid_ >> 2; (void)hb_; \
    int z_ = 0; asm volatile("" : "+v"(z_)); char* ws_ = p.ws + __builtin_amdgcn_readfirstlane(z_);

__device__ void phase_setup(KP p, int wsid_, int bid, int nb) {
    PHASE_PROLOGUE
    float4* X4 = (float4*)(ws_ + WS_X);
    const float4* x4 = (const float4*)p.x; const float4* c4 = (const float4*)p.ctx;
    const size_t nl = (size_t)ML * DM / 4, nc = (size_t)MC * DM / 4;
    { const size_t stride = (size_t)nb * 256, ntot = nl + nc;
      size_t i0 = (size_t)bid * 256 + tid_;
      for (; i0 + 8 * stride < ntot; i0 += stride * 9) {
#define SU_LD(u) const size_t j##u = i0 + (u) * stride; const float4 t##u = j##u < nl ? x4[j##u] : c4[j##u - nl];
          SU_LD(0) SU_LD(1) SU_LD(2) SU_LD(3) SU_LD(4) SU_LD(5) SU_LD(6) SU_LD(7) SU_LD(8)
          X4[j0] = t0; X4[j1] = t1; X4[j2] = t2; X4[j3] = t3; X4[j4] = t4; X4[j5] = t5; X4[j6] = t6; X4[j7] = t7; X4[j8] = t8;
      }
      for (; i0 < ntot; i0 += stride) X4[i0] = i0 < nl ? x4[i0] : c4[i0 - nl];
    }
    if (bid == 0) {
        float* TA = (float*)(ws_ + WS_ROPE); float* TB = TA + 64 * 16 * 2;
        for (int i = tid_; i < 64 * 16; i += 256) { int pos = i >> 4, f = i & 15; double inv = pow(10000.0, -(double)f / 16.0); double a = (double)pos * inv; TA[i * 2] = (float)cos(a); TA[i * 2 + 1] = (float)sin(a); }
        for (int i = tid_; i < 64 * 8; i += 256) { int pos = i >> 3, f = i & 7; double inv = pow(10000.0, -(double)f / 8.0); double a = (double)pos * inv; TB[i * 2] = (float)cos(a); TB[i * 2 + 1] = (float)sin(a); }
        int* ec = (int*)(ws_ + WS_ECNT);
        for (int i = tid_; i < 128; i += 256) ec[i] = 0;
    }
}

__device__ void phase_mod(KP p, int wsid_, int bid, int nb, char* smem) {
    PHASE_PROLOGUE
    float* act = (float*)smem;
    float* red = act + 9 * 1024;
    for (int i = tid_; i < 9 * 1024; i += 256) { float v = i < 8 * 1024 ? p.c[i] : p.c_ctx[i - 8 * 1024]; act[i] = siluf_(v); }
    __syncthreads();
    float* mod = (float*)(ws_ + WS_MOD);
    const int nitems = 4 * 6144 / 64;
    const int ct = tid_ & 15, kg = tid_ >> 4, wv = tid_ >> 6;
    for (int it = bid; it < nitems; it += nb) {
        const int layer = it / 96, n0 = (it % 96) * 64;
        const float* w = p.w_mod + (size_t)layer * DM * 6144 + (size_t)(kg * 64) * 6144 + n0 + ct * 4;
        float a[9][4];
#pragma unroll
        for (int s = 0; s < 9; ++s) { a[s][0] = 0.f; a[s][1] = 0.f; a[s][2] = 0.f; a[s][3] = 0.f; }
#pragma unroll 1
        for (int k0 = 0; k0 < 64; k0 += 16) {
            float4 wq[16];
#pragma unroll
            for (int j = 0; j < 16; ++j) wq[j] = *(const float4*)(w + (size_t)(k0 + j) * 6144);
#pragma unroll
            for (int j4 = 0; j4 < 4; ++j4)
#pragma unroll
                for (int s = 0; s < 9; ++s) {
                    const float4 av = *(const float4*)(act + s * 1024 + kg * 64 + k0 + j4 * 4);
                    const float avv[4] = {av.x, av.y, av.z, av.w};
#pragma unroll
                    for (int e = 0; e < 4; ++e) { const float4 q = wq[j4 * 4 + e]; a[s][0] += avv[e] * q.x; a[s][1] += avv[e] * q.y; a[s][2] += avv[e] * q.z; a[s][3] += avv[e] * q.w; }
                }
        }
#pragma unroll
        for (int s = 0; s < 9; ++s)
#pragma unroll
            for (int c = 0; c < 4; ++c) { a[s][c] = xor32_sum(xor16_sum(a[s][c])); }
        if ((tid_ & 63) < 16) {
#pragma unroll
            for (int s = 0; s < 9; ++s) *(float4*)(red + (wv * 9 + s) * 64 + ct * 4) = make_float4(a[s][0], a[s][1], a[s][2], a[s][3]);
        }
        __syncthreads();
        for (int i = tid_; i < 9 * 64; i += 256) {
            const int s = i >> 6, c2 = i & 63, n2 = n0 + c2;
            float v = red[(0 * 9 + s) * 64 + c2] + red[(1 * 9 + s) * 64 + c2] + red[(2 * 9 + s) * 64 + c2] + red[(3 * 9 + s) * 64 + c2];
            mod[((size_t)layer * 9 + s) * 6144 + n2] = v + p.b_mod[layer * 6144 + n2];
        }
        __syncthreads();
    }
}

__device__ __forceinline__ void conv_tile(const float* src, int K, int N, bfu* dst, int k0, int n0, float* ts, int tid_) {
    const int t = tid_;
    {
        const int kk = t >> 4, n4 = (t & 15) * 4;
        float4 v[4];
#pragma unroll
        for (int pz = 0; pz < 4; ++pz) v[pz] = *(const float4*)(src + (size_t)(k0 + kk + 16 * pz) * N + n0 + n4);
        asm volatile("" : "+v"(v[0].x), "+v"(v[0].y), "+v"(v[0].z), "+v"(v[0].w), "+v"(v[1].x), "+v"(v[1].y), "+v"(v[1].z), "+v"(v[1].w),
                          "+v"(v[2].x), "+v"(v[2].y), "+v"(v[2].z), "+v"(v[2].w), "+v"(v[3].x), "+v"(v[3].y), "+v"(v[3].z), "+v"(v[3].w) :: "memory");
#pragma unroll
        for (int pz = 0; pz < 4; ++pz) { float* d = ts + (kk + 16 * pz) * 65 + n4; d[0] = v[pz].x; d[1] = v[pz].y; d[2] = v[pz].z; d[3] = v[pz].w; }
    }
    __syncthreads();
    {
        const int n = t >> 2, kc = (t & 3) * 16;
        unsigned o[8];
#pragma unroll
        for (int i = 0; i < 8; ++i) o[i] = pack2(ts[(kc + 2 * i) * 65 + n], ts[(kc + 2 * i + 1) * 65 + n]);
        uint4* d = (uint4*)(dst + (size_t)(n0 + n) * K + k0 + kc);
        d[0] = make_uint4(o[0], o[1], o[2], o[3]); d[1] = make_uint4(o[4], o[5], o[6], o[7]);
    }
    __syncthreads();
}
__device__ void phase_conv(KP p, int wsid_, int layer, int bid, int nb, char* smem) {
    PHASE_PROLOGUE
    float* ts = (float*)smem;
    const float* srcs[8]; bfu* dsts[8]; int Ks[8], Ns[8], Bs[8];
    char* ws = ws_;
    srcs[0] = p.w_in + (size_t)layer * DM * INW;  Ks[0] = DM; Ns[0] = INW; Bs[0] = 1;  dsts[0] = (bfu*)(ws + WS_WIN);
    srcs[1] = p.w_out + (size_t)layer * DM * DM;  Ks[1] = DM; Ns[1] = DM;  Bs[1] = 1;  dsts[1] = (bfu*)(ws + WS_WOUT);
    srcs[2] = p.e_w1 + (size_t)layer * NEXP * DM * FF; Ks[2] = DM; Ns[2] = FF; Bs[2] = NEXP; dsts[2] = (bfu*)(ws + WS_W1);
    srcs[3] = p.e_w3 + (size_t)layer * NEXP * DM * FF; Ks[3] = DM; Ns[3] = FF; Bs[3] = NEXP; dsts[3] = (bfu*)(ws + WS_W3);
    srcs[4] = p.e_w2 + (size_t)layer * NEXP * FF * DM; Ks[4] = FF; Ns[4] = DM; Bs[4] = NEXP; dsts[4] = (bfu*)(ws + WS_W2);
    srcs[5] = p.c_w2 + (size_t)layer * 2 * 64 * 512;   Ks[5] = 64; Ns[5] = 512; Bs[5] = 2;   dsts[5] = (bfu*)(ws + WS_LW2);
    srcs[6] = p.c_a2 + (size_t)layer * 2 * 64 * 512;   Ks[6] = 64; Ns[6] = 512; Bs[6] = 2;   dsts[6] = (bfu*)(ws + WS_LA2);
    srcs[7] = p.c_g2 + (size_t)layer * 128 * 512;      Ks[7] = 128; Ns[7] = 512; Bs[7] = 1;  dsts[7] = (bfu*)(ws + WS_LG2);
    for (int it = bid; it < 1104; it += nb) {
        int jb, r;
        if (it < 800) { jb = 0; r = it; } else if (it < 1056) { jb = 1; r = it - 800; } else if (it < 1072) { jb = 5; r = it - 1056; } else if (it < 1088) { jb = 6; r = it - 1072; } else { jb = 7; r = it - 1088; }
        const float* src; bfu* dst; int K, N;
        if (jb == 0) { src = srcs[0]; dst = dsts[0]; K = DM; N = INW; } else if (jb == 1) { src = srcs[1]; dst = dsts[1]; K = DM; N = DM; }
        else if (jb == 5) { src = srcs[5]; dst = dsts[5]; K = 64; N = 512; } else if (jb == 6) { src = srcs[6]; dst = dsts[6]; K = 64; N = 512; } else { src = srcs[7]; dst = dsts[7]; K = 128; N = 512; }
        const int tk = K / 64, tn = N / 64, per = tk * tn, bt = r / per, r2 = r % per, kt = r2 / tn, nt = r2 % tn;
        conv_tile(src + (size_t)bt * K * N, K, N, dst + (size_t)bt * K * N, kt * 64, nt * 64, ts, tid_);
    }
    float* wrt = (float*)(ws + WS_WRT);
    const float* wg = p.r_w_group + (size_t)layer * DM * 4; const float* we = p.r_w_expert + (size_t)layer * DM * 32;
    for (int i = bid * 256 + tid_; i < 48 * 1024; i += nb * 256) {
        const int r = i >> 10, k = i & 1023;
        const float wv_ = r < 4 ? wg[k * 4 + r] : (r < 36 ? we[k * 32 + (r - 4)] : 0.f);
        wrt[i] = wv_;
        const bfu hi_ = f2bf(wv_);
        ((bfu*)(ws + WS_WRTH))[i] = hi_; ((bfu*)(ws + WS_WRTL))[i] = f2bf(wv_ - bf2f(hi_));
    }
}

__device__ __forceinline__ bool conv_big_step(KP p, int wsid_, char* ws_, int layer, unsigned* qctr, int* s_item, char* smem, int tid_, int hb_) {
    float* ts = (float*)smem;
    __syncthreads();
    if (TID512 == 0) *s_item = (int)atomicAdd(qctr, 1u);
    __syncthreads();
    const int gidx = __builtin_amdgcn_readfirstlane(*s_item);
    if (gidx >= 1536) return false;
    { const int q0 = hb_ * 4;
        const float* sp[4]; bfu* dp[4]; int Ks[4];
        float4 v[4][4];
        const int kk = tid_ >> 4, n4 = (tid_ & 15) * 4;
#pragma unroll
        for (int q = 0; q < 4; ++q) {
            const int it = gidx * 8 + q0 + q, jb = it >> 12, r = it & 4095, bt = r >> 7, r2 = r & 127;
            const float* src; bfu* dst; int K, N;
            if (jb == 0) { src = p.e_w1 + (size_t)layer * NEXP * DM * FF; dst = (bfu*)(ws_ + WS_W1); K = DM; N = FF; }
            else if (jb == 1) { src = p.e_w3 + (size_t)layer * NEXP * DM * FF; dst = (bfu*)(ws_ + WS_W3); K = DM; N = FF; }
            else { src = p.e_w2 + (size_t)layer * NEXP * FF * DM; dst = (bfu*)(ws_ + WS_W2); K = FF; N = DM; }
            const int tn = N >> 6, kt = r2 / tn, nt = r2 % tn;
            const float* s0 = src + (size_t)bt * K * N + (size_t)(kt * 64 + kk) * N + nt * 64 + n4;
#pragma unroll
            for (int pz = 0; pz < 4; ++pz) v[q][pz] = *(const float4*)(s0 + (size_t)(16 * pz) * N);
            Ks[q] = K;
            dp[q] = dst + (size_t)bt * K * N + (size_t)(nt * 64 + (tid_ >> 2)) * K + kt * 64 + (tid_ & 3) * 16;
        }
#pragma unroll
        for (int q = 0; q < 4; ++q)
            asm volatile("" : "+v"(v[q][0].x), "+v"(v[q][0].y), "+v"(v[q][0].z), "+v"(v[q][0].w), "+v"(v[q][1].x), "+v"(v[q][1].y), "+v"(v[q][1].z), "+v"(v[q][1].w),
                              "+v"(v[q][2].x), "+v"(v[q][2].y), "+v"(v[q][2].z), "+v"(v[q][2].w), "+v"(v[q][3].x), "+v"(v[q][3].y), "+v"(v[q][3].z), "+v"(v[q][3].w) :: "memory");
#pragma unroll
        for (int q = 0; q < 4; ++q)
#pragma unroll
            for (int pz = 0; pz < 4; ++pz) { float* d = ts + q * 4160 + (kk + 16 * pz) * 65 + n4; d[0] = v[q][pz].x; d[1] = v[q][pz].y; d[2] = v[q][pz].z; d[3] = v[q][pz].w; }
        __syncthreads();
        {
            const int n = tid_ >> 2, kc = (tid_ & 3) * 16;
#pragma unroll
            for (int q = 0; q < 4; ++q) {
                unsigned o[8];
#pragma unroll
                for (int i = 0; i < 8; ++i) o[i] = pack2(ts[q * 4160 + (kc + 2 * i) * 65 + n], ts[q * 4160 + (kc + 2 * i + 1) * 65 + n]);
                uint4* d = (uint4*)dp[q];
                d[0] = make_uint4(o[0], o[1], o[2], o[3]); d[1] = make_uint4(o[4], o[5], o[6], o[7]);
            }
        }
        __syncthreads();
    }
    return true;
}

__device__ void phase_conv_drain(KP p, int wsid_, int layer, unsigned* cctr, int* s_item, char* smem) {
    PHASE_PROLOGUE
    while (conv_big_step(p, wsid_, ws_, layer, cctr, s_item, smem, tid_, hb_)) {}
}

__device__ void phase_norm1(KP p, int wsid_, int layer, int mode, int bid, int nb, bool combine = true) {
    PHASE_PROLOGUE
    float* X = (float*)(ws_ + WS_X); bfu* H = (bfu*)(ws_ + WS_H);
    const bfu* Y0 = (const bfu*)(ws_ + WS_Y01); const bfu* Y1 = Y0 + (size_t)MA * DM;
    const float* mod = (const float*)(ws_ + WS_MOD);
    const int lane = tid_ & 63, wv = tid_ >> 6;
    const int nrows = mode ? ML : MA;
    if (bid == 0 && mode == 0 && tid_ < 32) ((int*)(ws_ + WS_ECNT))[layer * 32 + tid_] = 0;
    for (int row = bid * 4 + wv; row < nrows; row += nb * 4) {
        int b, j, s; row_info(row, b, j, s);
        float4 v[4], g1[4], g2[4], g3[4], gc[4];
        uint2 ya[4], yb[4];
        const bool comb = layer > 0 && combine;
#pragma unroll
        for (int c = 0; c < 4; ++c) {
            const int col = c * 256 + lane * 4;
            v[c] = *(const float4*)(X + (size_t)row * DM + col);
            if (comb) {
                ya[c] = *(const uint2*)(Y0 + (size_t)row * DM + col); yb[c] = *(const uint2*)(Y1 + (size_t)row * DM + col);
                gc[c] = *(const float4*)(mod + ((size_t)(layer - 1) * 9 + s) * 6144 + 5 * 1024 + col);
            }
            if (mode) g1[c] = *(const float4*)(p.g_final + col);
            else {
                g1[c] = *(const float4*)(p.g_mix + layer * DM + col);
                g2[c] = *(const float4*)(mod + ((size_t)layer * 9 + s) * 6144 + 0 * 1024 + col);
                g3[c] = *(const float4*)(mod + ((size_t)layer * 9 + s) * 6144 + 1 * 1024 + col);
            }
        }
        float ss = 0.f;
#pragma unroll
        for (int c = 0; c < 4; ++c) {
            float4 xv = v[c];
            if (comb) {
                const float4 a = make_float4(__uint_as_float(ya[c].x << 16), __uint_as_float(ya[c].x & 0xFFFF0000u), __uint_as_float(ya[c].y << 16), __uint_as_float(ya[c].y & 0xFFFF0000u));
                const float4 bq = make_float4(__uint_as_float(yb[c].x << 16), __uint_as_float(yb[c].x & 0xFFFF0000u), __uint_as_float(yb[c].y << 16), __uint_as_float(yb[c].y & 0xFFFF0000u));
                const float4 g = gc[c];
                xv.x += g.x * (a.x + bq.x); xv.y += g.y * (a.y + bq.y); xv.z += g.z * (a.z + bq.z); xv.w += g.w * (a.w + bq.w);
            }
            v[c] = xv; ss += xv.x * xv.x + xv.y * xv.y + xv.z * xv.z + xv.w * xv.w;
        }
        ss = sum64(ss);
        const float rs = rsqrtf(ss * (1.f / 1024.f) + 1e-6f);
#pragma unroll
        for (int c = 0; c < 4; ++c) {
            const int col = c * 256 + lane * 4;
            if (comb && !mode) *(float4*)(X + (size_t)row * DM + col) = v[c];
            if (mode) {
                const float4 g = g1[c];
                float4 o; o.x = v[c].x * rs * g.x; o.y = v[c].y * rs * g.y; o.z = v[c].z * rs * g.z; o.w = v[c].w * rs * g.w;
                *(float4*)(p.out + (size_t)row * DM + col) = o;
            } else {
                const float4 g = g1[c], sh = g2[c], sc = g3[c];
                const float o0 = v[c].x * rs * g.x * (1.f + sc.x) + sh.x, o1 = v[c].y * rs * g.y * (1.f + sc.y) + sh.y;
                const float o2 = v[c].z * rs * g.z * (1.f + sc.z) + sh.z, o3 = v[c].w * rs * g.w * (1.f + sc.w) + sh.w;
                *(uint2*)(H + (size_t)row * DM + col) = make_uint2(pack2(o0, o1), pack2(o2, o3));
            }
        }
    }
}

#define GLDS(gp, lp) __builtin_amdgcn_global_load_lds((const unsigned*)(gp), (__attribute__((address_space(3))) unsigned*)(lp), 16, 0, 0)
__device__ __forceinline__ int swzG(int x) { return (0x78 >> (2 * x)) & 3; }
template <class FA, class FB, class FE>
__device__ __forceinline__ void gemm_tile(FA arow, FB brow, int K, FE epi, char* smem, int wsid_) {
    int tid = TID512 & 255; asm volatile("" : "+v"(tid));
    const int lane = tid & 63, wid = tid >> 6, wr = wid >> 1, wc = wid & 1, fr = lane & 15, fq = lane >> 4;
    const int lrow = tid >> 2, lch = ((tid & 3) ^ swzG((tid >> 4) & 3)) * 8;
    const bfu* ga0 = arow(lrow) + lch; const bfu* ga1 = arow(lrow + 64) + lch;
    const bfu* gb0 = brow(lrow) + lch; const bfu* gb1 = brow(lrow + 64) + lch;
    f32x4 acc[4][4];
#pragma unroll
    for (int m = 0; m < 4; ++m)
#pragma unroll
        for (int n = 0; n < 4; ++n) acc[m][n] = (f32x4){0.f, 0.f, 0.f, 0.f};
    char* lds0 = smem + tid * 16;
#define GEMM_ISSUE(kt_) { char* d_ = lds0 + ((kt_) & 3) * 16384; const int ko_ = (kt_) * 32; \
        GLDS(ga0 + ko_, d_); GLDS(ga1 + ko_, d_ + 4096); GLDS(gb0 + ko_, d_ + 8192); GLDS(gb1 + ko_, d_ + 12288); }
    const int nk = K >> 5;
    __syncthreads();
    GEMM_ISSUE(0)
    if (nk > 1) GEMM_ISSUE(1)
    if (nk > 2) GEMM_ISSUE(2)
    const int offA = (wr * 64 + fr) * 64 + ((fq ^ swzG((fr >> 2) & 3)) * 16), offB = 8192 + (wc * 64 + fr) * 64 + ((fq ^ swzG((fr >> 2) & 3)) * 16);
    for (int kt = 0; kt < nk; ++kt) {
        if (kt + 2 < nk) asm volatile("s_waitcnt vmcnt(8)" ::: "memory");
        else if (kt + 1 < nk) asm volatile("s_waitcnt vmcnt(4)" ::: "memory");
        else asm volatile("s_waitcnt vmcnt(0)" ::: "memory");
        __builtin_amdgcn_s_barrier();
        if (kt + 3 < nk) GEMM_ISSUE(kt + 3)
        const char* st = smem + (kt & 3) * 16384;
        bf16x8 af[4], bfr[4];
#pragma unroll
        for (int m = 0; m < 4; ++m) af[m] = *(const bf16x8*)(st + offA + m * 1024);
#pragma unroll
        for (int n = 0; n < 4; ++n) bfr[n] = *(const bf16x8*)(st + offB + n * 1024);
        __builtin_amdgcn_s_setprio(1);
#pragma unroll
        for (int m = 0; m < 4; ++m)
#pragma unroll
            for (int n = 0; n < 4; ++n) acc[m][n] = __builtin_amdgcn_mfma_f32_16x16x32_bf16(af[m], bfr[n], acc[m][n], 0, 0, 0);
        __builtin_amdgcn_s_setprio(0);
    }
    __syncthreads();
    epi(acc, wr, wc, fr, fq);
}
#define ACC_FOREACH(...)                                                                      \
    _Pragma("unroll") for (int m_ = 0; m_ < 4; ++m_) _Pragma("unroll") for (int n_ = 0; n_ < 4; ++n_) \
    _Pragma("unroll") for (int j_ = 0; j_ < 4; ++j_) {                                        \
        const int row = wr * 64 + m_ * 16 + fq * 4 + j_; const int col = wc * 64 + n_ * 16 + fr; const float val = acc[m_][n_][j_]; __VA_ARGS__ }

__device__ __forceinline__ int lds_byte256(int r, int c) { const int st = (r >> 4) * 2 + (c >> 5), rr = r & 15, cc = c & 31, ob = rr * 64 + cc * 2; return st * 1024 + (ob ^ (((ob >> 9) & 1) << 5)); }
__device__ __forceinline__ void stage_rc256(int b, int& R, int& C) { const int st = b / 1024, sb = b % 1024, swz = sb ^ (((sb >> 9) & 1) << 5); R = (st >> 1) * 16 + swz / 64; C = (st & 1) * 32 + (swz % 64) / 2; }
#define G2_HT 8192
template <int lda, int ldb, int K, class FR, class FE>
__device__ __forceinline__ void gemm256(const bfu* Abase, FR arow, const bfu* B0, const bfu* B1, FE epi, char* shmc, int wsid_) {
    bfu* shm = (bfu*)shmc;
#define G2_SA(b, h) (shm + ((b) * 2 + (h)) * G2_HT)
#define G2_SB(b, h) (shm + (4 + (b) * 2 + (h)) * G2_HT)
    int tx = TID512; asm volatile("" : "+v"(tx));
    int sR, sC; stage_rc256(tx * 16, sR, sC);
    const int ra00 = arow(sR), ra01 = arow(sR + 64), ra10 = arow(128 + sR), ra11 = arow(128 + sR + 64);
#define G2_STAGE_A(P, h, kt) { int r0_ = (h) ? ra10 : ra00, r1_ = (h) ? ra11 : ra01; asm volatile("" : "+v"(r0_), "+v"(r1_)); const size_t ko_ = (size_t)(kt) * 64 + sC; \
        GLDS(Abase + (size_t)r0_ * lda + ko_, (char*)(P) + tx * 16); GLDS(Abase + (size_t)r1_ * lda + ko_, (char*)(P) + tx * 16 + 8192); }
#define G2_STAGE_B(P, h, kt) { int o_ = sR * ldb + sC; asm volatile("" : "+v"(o_)); const bfu* b_ = ((h) ? B1 : B0) + (size_t)(kt) * 64 + o_; GLDS(b_, (char*)(P) + tx * 16); GLDS(b_ + 64 * ldb, (char*)(P) + tx * 16 + 8192); }
    int wid = tx >> 6, lane = tx & 63, wr = wid >> 2, wc = wid & 3, fr = lane & 15, fq = lane >> 4;
#define G2_LDA(dst, b, h) _Pragma("unroll") for (int m = 0; m < 4; ++m) _Pragma("unroll") for (int k = 0; k < 2; ++k) \
        dst[m][k] = *(const bf16x8*)((const char*)G2_SA(b, h) + lds_byte256(wr * 64 + m * 16 + fr, k * 32 + fq * 8))
#define G2_LDB(dst, b, h) _Pragma("unroll") for (int n = 0; n < 2; ++n) _Pragma("unroll") for (int k = 0; k < 2; ++k) \
        dst[n][k] = *(const bf16x8*)((const char*)G2_SB(b, h) + lds_byte256(wc * 32 + n * 16 + fr, k * 32 + fq * 8))
#define G2_MMA(ai, bj, At_, Bt_) { __builtin_amdgcn_s_setprio(1); \
        _Pragma("unroll") for (int m = 0; m < 4; ++m) _Pragma("unroll") for (int n = 0; n < 2; ++n) _Pragma("unroll") for (int k = 0; k < 2; ++k) \
            acc[ai][bj][m][n] = __builtin_amdgcn_mfma_f32_16x16x32_bf16(At_[m][k], Bt_[n][k], acc[ai][bj][m][n], 0, 0, 0); \
        __builtin_amdgcn_s_setprio(0); }
#define G2_WV(n) asm volatile("s_waitcnt vmcnt(" #n ")" ::: "memory")
#define G2_WL(n) asm volatile("s_waitcnt lgkmcnt(" #n ")" ::: "memory")
#define G2_BAR __builtin_amdgcn_s_barrier()
#define G2_SCHED __builtin_amdgcn_sched_barrier(0)
    f32x4 acc[2][2][4][2];
#pragma unroll
    for (int a = 0; a < 2; ++a)
#pragma unroll
        for (int b = 0; b < 2; ++b)
#pragma unroll
            for (int m = 0; m < 4; ++m)
#pragma unroll
                for (int n = 0; n < 2; ++n) acc[a][b][m][n] = (f32x4){0.f, 0.f, 0.f, 0.f};
    bf16x8 At[4][2], Bx0[2][2], Bx1[2][2];
    constexpr int nt = K >> 6;
    __syncthreads();
    G2_STAGE_B(G2_SB(0, 0), 0, 0); G2_STAGE_A(G2_SA(0, 0), 0, 0); G2_STAGE_B(G2_SB(0, 1), 1, 0); G2_STAGE_A(G2_SA(0, 1), 1, 0);
    if (wr == 1) G2_BAR;
    G2_WV(4); G2_BAR;
    G2_STAGE_B(G2_SB(1, 0), 0, 1); G2_STAGE_A(G2_SA(1, 0), 0, 1); G2_STAGE_B(G2_SB(1, 1), 1, 1);
    G2_WV(6); G2_BAR;
    for (int t = 0; t < nt - 2; t += 2) {
        G2_LDB(Bx0, 0, 0); G2_SCHED; G2_LDA(At, 0, 0); G2_STAGE_A(G2_SA(1, 1), 1, t + 1);
        G2_WL(8); G2_BAR; G2_WL(0); G2_MMA(0, 0, At, Bx0); G2_BAR; G2_SCHED;
        G2_LDB(Bx1, 0, 1); G2_STAGE_B(G2_SB(0, 0), 0, t + 2);
        G2_BAR; G2_WL(0); G2_MMA(0, 1, At, Bx1); G2_BAR;
        G2_LDA(At, 0, 1); G2_STAGE_A(G2_SA(0, 0), 0, t + 2);
        G2_BAR; G2_WL(0); G2_MMA(1, 0, At, Bx0); G2_BAR; G2_SCHED;
        G2_STAGE_B(G2_SB(0, 1), 1, t + 2);
        G2_WV(6); G2_BAR; G2_MMA(1, 1, At, Bx1); G2_BAR;
        G2_LDB(Bx0, 1, 0); G2_SCHED; G2_LDA(At, 1, 0); G2_STAGE_A(G2_SA(0, 1), 1, t + 2);
        G2_WL(8); G2_BAR; G2_WL(0); G2_MMA(0, 0, At, Bx0); G2_BAR; G2_SCHED;
        G2_LDB(Bx1, 1, 1); G2_STAGE_B(G2_SB(1, 0), 0, t + 3);
        G2_BAR; G2_WL(0); G2_MMA(0, 1, At, Bx1); G2_BAR;
        G2_LDA(At, 1, 1); G2_STAGE_A(G2_SA(1, 0), 0, t + 3);
        G2_BAR; G2_WL(0); G2_MMA(1, 0, At, Bx0); G2_BAR; G2_SCHED;
        G2_STAGE_B(G2_SB(1, 1), 1, t + 3);
        G2_WV(6); G2_BAR; G2_MMA(1, 1, At, Bx1); G2_BAR;
    }
    tx = TID512; asm volatile("" : "+v"(tx)); stage_rc256(tx * 16, sR, sC); wid = tx >> 6; lane = tx & 63; wr = wid >> 2; wc = wid & 3; fr = lane & 15; fq = lane >> 4;
    { G2_LDB(Bx0, 0, 0); G2_WV(0); G2_LDA(At, 0, 0); G2_STAGE_A(G2_SA(1, 1), 1, nt - 1);
      G2_BAR; G2_WL(0); G2_MMA(0, 0, At, Bx0); G2_BAR;
      G2_LDB(Bx1, 0, 1); G2_BAR; G2_WL(0); G2_MMA(0, 1, At, Bx1); G2_BAR;
      G2_LDA(At, 0, 1); G2_WV(4); G2_BAR; G2_WL(0); G2_MMA(1, 0, At, Bx0); G2_MMA(1, 1, At, Bx1); G2_BAR; }
    { G2_LDB(Bx0, 1, 0); G2_LDA(At, 1, 0); G2_WV(2); G2_BAR; G2_WL(0); G2_MMA(0, 0, At, Bx0); G2_BAR;
      G2_LDB(Bx1, 1, 1); G2_WV(0); G2_BAR; G2_WL(0); G2_MMA(0, 1, At, Bx1); G2_BAR;
      G2_LDA(At, 1, 1); G2_BAR; G2_WL(0); G2_MMA(1, 0, At, Bx0); G2_MMA(1, 1, At, Bx1); G2_BAR; }
    if (wr == 0) G2_BAR;
    __syncthreads();
    epi(acc, wr, wc, fr, fq);
}

__device__ __forceinline__ void inproj_post(KP p, int wsid_, char* ws_, int layer, int row0, int nt, const float* Cs, int tid_) {
    const float* TA = (const float*)(ws_ + WS_ROPE); const float* TB = TA + 64 * 16 * 2;
    const int tid = tid_;
    int b, j0, s; row_info(row0, b, j0, s);
    const bool lat = row0 < ML;
    if (nt <= 2) {
        const int r = tid & 127, hl = tid >> 7;
        const bool isq = nt < 2;
        const float* gain = (isq ? p.a_q_gain : p.a_k_gain) + layer * 64;
        float ss = 0.f;
#pragma unroll
        for (int d4 = 0; d4 < 16; ++d4) { const float4 t4 = *(const float4*)(Cs + r * 132 + hl * 64 + d4 * 4); ss += t4.x * t4.x + t4.y * t4.y + t4.z * t4.z + t4.w * t4.w; }
        const float rs = rsqrtf(ss * (1.f / 64.f) + 1e-6f);
        const float qs = isq ? 0.125f * LOG2E : 1.f;
        bfu* dst = isq ? (bfu*)(ws_ + WS_QA) + (((size_t)b * 4 + (nt * 2 + hl)) * NKEY + j0 + r) * 64
                       : (bfu*)(ws_ + WS_KA) + (((size_t)b * 2 + hl) * NKEY + j0 + r) * 64;
        const int t = (j0 - 256) + r;
#pragma unroll 1
        for (int a = 0; a < 2; ++a) {
            float v[32];
#pragma unroll
            for (int d4 = 0; d4 < 8; ++d4) {
                const float4 t4 = *(const float4*)(Cs + r * 132 + hl * 64 + a * 32 + d4 * 4); const float4 g4 = *(const float4*)(gain + a * 32 + d4 * 4);
                v[d4 * 4] = t4.x * rs * g4.x; v[d4 * 4 + 1] = t4.y * rs * g4.y; v[d4 * 4 + 2] = t4.z * rs * g4.z; v[d4 * 4 + 3] = t4.w * rs * g4.w;
            }
            if (lat) {
                const int pos = a == 0 ? (t >> 6) : (t & 63);
#pragma unroll
                for (int f = 0; f < 16; ++f) {
                    const float cs = TA[(pos * 16 + f) * 2], sn = TA[(pos * 16 + f) * 2 + 1];
                    const float x0 = v[f], x1 = v[16 + f];
                    v[f] = x0 * cs - x1 * sn; v[16 + f] = x1 * cs + x0 * sn;
                }
            }
#pragma unroll
            for (int d8 = 0; d8 < 4; ++d8)
                ((uint4*)dst)[a * 4 + d8] = make_uint4(pack2(v[d8 * 8] * qs, v[d8 * 8 + 1] * qs), pack2(v[d8 * 8 + 2] * qs, v[d8 * 8 + 3] * qs),
                                                       pack2(v[d8 * 8 + 4] * qs, v[d8 * 8 + 5] * qs), pack2(v[d8 * 8 + 6] * qs, v[d8 * 8 + 7] * qs));
        }
    } else if (nt == 3 || nt == 8 || nt == 9) {
        const int c = tid & 127, half = tid >> 7, hl = c >> 6, d = c & 63;
        bfu* dst = nt == 3 ? (bfu*)(ws_ + WS_VAT) + (((size_t)b * 2 + hl) * 64 + d) * NKEY + j0 + half * 64
                           : (bfu*)(ws_ + WS_VBT) + (((size_t)b * 4 + ((nt - 8) * 2 + hl)) * 64 + d) * NKEY + j0 + half * 64;
#pragma unroll
        for (int r8 = 0; r8 < 8; ++r8) {
            const float* s0 = Cs + (half * 64 + r8 * 8) * 132 + c;
            ((uint4*)dst)[r8] = make_uint4(pack2(s0[0], s0[132]), pack2(s0[2 * 132], s0[3 * 132]), pack2(s0[4 * 132], s0[5 * 132]), pack2(s0[6 * 132], s0[7 * 132]));
        }
    } else if (nt <= 7) {
        const bool isq = nt < 6;
        const int hbase = ((nt - 4) & 1) * 2;
#pragma unroll
        for (int itq = 0; itq < 2; ++itq) {
            const int u = tid + 256 * itq, r = u & 127, hm = u >> 7;
            float v[32];
#pragma unroll
            for (int d4 = 0; d4 < 8; ++d4) { const float4 t4 = *(const float4*)(Cs + r * 132 + hm * 32 + d4 * 4); v[d4 * 4] = t4.x; v[d4 * 4 + 1] = t4.y; v[d4 * 4 + 2] = t4.z; v[d4 * 4 + 3] = t4.w; }
            if (lat) {
                const int t = (j0 - 256) + r;
#pragma unroll
                for (int a = 0; a < 2; ++a) {
                    const int pos = a == 0 ? (t >> 6) : (t & 63);
#pragma unroll
                    for (int f = 0; f < 8; ++f) {
                        const float cs = TB[(pos * 8 + f) * 2], sn = TB[(pos * 8 + f) * 2 + 1];
                        const float x0 = v[a * 16 + f], x1 = v[a * 16 + 8 + f];
                        v[a * 16 + f] = x0 * cs - x1 * sn; v[a * 16 + 8 + f] = x1 * cs + x0 * sn;
                    }
                }
            }
            const float qs = isq ? 0.17677669529663687f * LOG2E : 1.f;
            const int h = hbase + (hm >> 1), mp = hm & 1;
            bfu* dst = (bfu*)(ws_ + (isq ? WS_QB : WS_KB)) + (((size_t)b * 4 + h) * NKEY + j0 + r) * 64 + mp * 32;
#pragma unroll
            for (int d8 = 0; d8 < 4; ++d8)
                ((uint4*)dst)[d8] = make_uint4(pack2(v[d8 * 8] * qs, v[d8 * 8 + 1] * qs), pack2(v[d8 * 8 + 2] * qs, v[d8 * 8 + 3] * qs),
                                               pack2(v[d8 * 8 + 4] * qs, v[d8 * 8 + 5] * qs), pack2(v[d8 * 8 + 6] * qs, v[d8 * 8 + 7] * qs));
        }
    } else {
        const int r = tid & 127, half = tid >> 7;
        float* dst = (float*)(ws_ + WS_CP) + (size_t)(row0 + r) * CSL + (nt - 10) * 128 + half * 64;
#pragma unroll
        for (int d4 = 0; d4 < 16; ++d4) ((float4*)dst)[d4] = *(const float4*)(Cs + r * 132 + half * 64 + d4 * 4);
    }
}

__device__ void phase_inproj256(KP p, int wsid_, int layer, int vblk, int nblk, char* smem_all, unsigned* cctr, int* s_item) {
    PHASE_PROLOGUE
    const bfu* H = (const bfu*)(ws_ + WS_H); const bfu* W = (const bfu*)(ws_ + WS_WIN);
    for (int it = vblk; it < 72 * 13; it += nblk) {
        const int mt = (it / 104) * 8 + (it & 7), nt2 = (it >> 3) % 13;
        const int row0 = mt * 256, col0 = nt2 * 256;
        const bfu* B0 = W + (size_t)col0 * DM; const bfu* B1 = (nt2 == 12) ? B0 : B0 + (size_t)128 * DM;
        gemm256<DM, DM, DM>(H, [&](int r) { return row0 + r; }, B0, B1,
            [&](f32x4 (&acc)[2][2][4][2], int wr, int wc, int fr, int fq) {
                if (nt2 >= 5) {
                    const __amdgpu_buffer_rsrc_t rs = __builtin_amdgcn_make_buffer_rsrc((void*)(ws_ + WS_CP), 0, (int)((size_t)MA * CSL * 4), 0x00020000);
                    const int voff = (((wr * 64 + fq * 4) * CSL) + wc * 32 + fr) * 4;
#pragma unroll
                    for (int bj = 0; bj < 2; ++bj) {
                        const int cb = col0 + bj * 128 - 1280;
                        if (cb < CSL) {
#pragma unroll
                            for (int ai = 0; ai < 2; ++ai)
#pragma unroll
                                for (int m = 0; m < 4; ++m)
#pragma unroll
                                    for (int n = 0; n < 2; ++n)
#pragma unroll
                                        for (int j = 0; j < 4; ++j)
                                            __builtin_amdgcn_raw_buffer_store_b32(__float_as_uint(acc[ai][bj][m][n][j]), rs, voff, ((row0 + ai * 128 + m * 16 + j) * CSL + cb + n * 16) * 4, 0);
                        }
                    }
                } else {
                    float* SC = (float*)(ws_ + WS_SCR) + (size_t)blockIdx.x * (2 * 128 * 132);
                    const __amdgpu_buffer_rsrc_t rs = __builtin_amdgcn_make_buffer_rsrc((void*)SC, 0, 2 * 128 * 132 * 4, 0x00020000);
                    const int o0 = (wr * 64 + fq * 4) * 132 + wc * 32 + fr;
#pragma unroll
                    for (int bj = 0; bj < 2; ++bj) {
                        float* Cq = (float*)(smem_all + bj * SMEM_BYTES) + o0;
#pragma unroll
                        for (int m = 0; m < 4; ++m)
#pragma unroll
                            for (int n = 0; n < 2; ++n)
#pragma unroll
                                for (int j = 0; j < 4; ++j) {
                                    Cq[(m * 16 + j) * 132 + n * 16] = acc[0][bj][m][n][j];
                                    __builtin_amdgcn_raw_buffer_store_b32(__float_as_uint(acc[1][bj][m][n][j]), rs, o0 * 4, (bj * 128 * 132 + (m * 16 + j) * 132 + n * 16) * 4, 0);
                                }
                    }
                    __syncthreads();
                    int t2 = TID512 & 255; asm volatile("" : "+v"(t2));
                    float* Ch = (float*)(smem_all + hb_ * SMEM_BYTES);
                    inproj_post(p, wsid_, ws_, layer, row0, nt2 * 2 + hb_, Ch, t2);
                    __syncthreads();
                    { const float4* g4 = (const float4*)(SC + hb_ * (128 * 132)); float4* c4 = (float4*)Ch;
                      for (int i = t2; i < 128 * 132 / 4; i += 256) c4[i] = g4[i]; }
                    __syncthreads();
                    inproj_post(p, wsid_, ws_, layer, row0 + 128, nt2 * 2 + hb_, Ch, t2);
                    __syncthreads();
                }
            }, smem_all, wsid_);
    }
    if (vblk >= 72 * 13 - 3 * nblk) { for (int q = 0; q < 6; ++q) if (!conv_big_step(p, wsid_, ws_, layer, cctr, s_item, smem_all + hb_ * SMEM_BYTES, tid_, hb_)) break; }
}

__device__ void phase_inproj(KP p, int wsid_, int layer, int bid, int nb, char* smem) {
    PHASE_PROLOGUE
    const bfu* H = (const bfu*)(ws_ + WS_H); const bfu* W = (const bfu*)(ws_ + WS_WIN);
    float* Cs = (float*)smem;
    const int nitems = 144 * 25;
    for (int it = bid; it < nitems; it += nb) {
        const int mt = (it / 200) * 8 + (it / 5) % 8, nt = ((it / 40) % 5) * 5 + it % 5;
        const int row0 = mt * 128, col0 = nt * 128;
        gemm_tile([&](int r) { return H + (size_t)(row0 + r) * DM; }, [&](int r) { return W + (size_t)(col0 + r) * DM; }, DM,
            [&](f32x4 (&acc)[4][4], int wr, int wc, int fr, int fq) {
                ACC_FOREACH(Cs[row * 132 + col] = val;)
            }, smem, wsid_);
        __syncthreads();
        inproj_post(p, wsid_, ws_, layer, row0, nt, Cs, tid_);
        __syncthreads();
    }
}

__device__ void phase_gate(KP p, int wsid_, int layer, int bid, int nb, char* smem) {
    PHASE_PROLOGUE
    const bfu* LXG = (const bfu*)(ws_ + WS_LXG); const bfu* Bt = (const bfu*)(ws_ + WS_LG2);
    float* GG = (float*)(ws_ + WS_GG);
    const int nitems = 144 * 4;
    for (int it = bid; it < nitems; it += nb) {
        const int mt = it >> 2, nt = it & 3, row0 = mt * 128, col0 = nt * 128;
        gemm_tile([&](int r) { return LXG + (size_t)(row0 + r) * 128; }, [&](int r) { return Bt + (size_t)(col0 + r) * 128; }, 128,
            [&](f32x4 (&acc)[4][4], int wr, int wc, int fr, int fq) {
                ACC_FOREACH(GG[(size_t)(row0 + row) * 512 + col0 + col] = val;)
            }, smem, wsid_);
    }
}

#define OPS_AT 0
#define OPS_RT 2048
#define OPS_MAK 4096
#define OPS_T 5120
#define OPS_MRBK 6144
#define OPS_BK 7168
#define OPS_VF 11264
#define OPS_WC 13312
__device__ __forceinline__ char* ops_rec(char* ws_, int z, int seq, int c) { return ws_ + WS_OPS + ((size_t)(z * 64 + seq) * 144 + c) * OPS_REC; }
__device__ __forceinline__ float rdlane(float v, int l) { return __int_as_float(__builtin_amdgcn_readlane(__float_as_int(v), l)); }

__device__ __forceinline__ void chunk_tail(const float (&lw)[16], const float (&kk)[16], const float (&rr)[16], const float (&bb)[16], const float (&kd)[16], const float (&vv)[16],
                                           char* Lw, char* rec, int lane) {
    const int cl = lane & 15, g = lane >> 4;
    float Bt[16], Kt[16];
    float cum = 0.f, ep = 1.f;
#pragma unroll
    for (int t = 0; t < 16; ++t) {
        cum += lw[t];
        const float e = __expf(cum), ei = __expf(-cum);
        *(bfu*)(Lw + 0 + t * 128 + lane * 2) = f2bf(-kk[t] * ep);
        *(bfu*)(Lw + 2048 + t * 128 + lane * 2) = f2bf(rr[t] * e);
        Bt[t] = bb[t] * ei; Kt[t] = kd[t] * ei;
        *(bfu*)(Lw + 4096 + t * 128 + lane * 2) = f2bf(Bt[t]);
        *(bfu*)(Lw + 6144 + t * 128 + lane * 2) = f2bf(Kt[t]);
        ep = e;
    }
    const float eC = ep;
#pragma unroll
    for (int q = 0; q < 4; ++q) {
        *(uint4*)(rec + OPS_BK + ((lane >> 4) * 64 + cl + 16 * q) * 16) =
            make_uint4(pack2(Bt[4 * q] * eC, Bt[4 * q + 1] * eC), pack2(Bt[4 * q + 2] * eC, Bt[4 * q + 3] * eC), pack2(Kt[4 * q] * eC, Kt[4 * q + 1] * eC), pack2(Kt[4 * q + 2] * eC, Kt[4 * q + 3] * eC));
        *(uint2*)(rec + OPS_VF + ((lane >> 4) * 64 + cl + 16 * q) * 8) = make_uint2(pack2(vv[4 * q], vv[4 * q + 1]), pack2(vv[4 * q + 2], vv[4 * q + 3]));
    }
    *(float*)(rec + OPS_WC + lane * 4) = eC;
    f32x4 Mab = {0.f, 0.f, 0.f, 0.f}, Mak = Mab, Mrb = Mab, Mrk = Mab;
#pragma unroll
    for (int ks = 0; ks < 2; ++ks) {
        const int fo = cl * 128 + ks * 64 + g * 16;
        const bf16x8 aA = *(const bf16x8*)(Lw + 0 + fo), aR = *(const bf16x8*)(Lw + 2048 + fo), bB = *(const bf16x8*)(Lw + 4096 + fo), bK = *(const bf16x8*)(Lw + 6144 + fo);
        Mab = __builtin_amdgcn_mfma_f32_16x16x32_bf16(aA, bB, Mab, 0, 0, 0);
        Mak = __builtin_amdgcn_mfma_f32_16x16x32_bf16(aA, bK, Mak, 0, 0, 0);
        Mrb = __builtin_amdgcn_mfma_f32_16x16x32_bf16(aR, bB, Mrb, 0, 0, 0);
        Mrk = __builtin_amdgcn_mfma_f32_16x16x32_bf16(aR, bK, Mrk, 0, 0, 0);
    }
#pragma unroll
    for (int ks = 0; ks < 2; ++ks) {
        const uint2 a0 = *(const uint2*)(Lw + 0 + cl * 128 + (32 * ks + 4 * g) * 2), a1 = *(const uint2*)(Lw + 0 + cl * 128 + (32 * ks + 16 + 4 * g) * 2);
        const uint2 r0 = *(const uint2*)(Lw + 2048 + cl * 128 + (32 * ks + 4 * g) * 2), r1 = *(const uint2*)(Lw + 2048 + cl * 128 + (32 * ks + 16 + 4 * g) * 2);
        *(uint4*)(rec + OPS_AT + (ks * 64 + lane) * 16) = make_uint4(a0.x, a0.y, a1.x, a1.y);
        *(uint4*)(rec + OPS_RT + (ks * 64 + lane) * 16) = make_uint4(r0.x, r0.y, r1.x, r1.y);
    }
#pragma unroll
    for (int q = 0; q < 4; ++q) {
        const int tau = 4 * g + q;
        if (!(cl < tau)) { Mab[q] = 0.f; Mak[q] = 0.f; }
        if (!(cl <= tau)) { Mrb[q] = 0.f; Mrk[q] = 0.f; }
    }
#pragma unroll
    for (int q = 0; q < 4; ++q) *(float*)(Lw + 10240 + (4 * g + q) * 64 + cl * 4) = Mab[q];
    float Tc[16];
#pragma unroll
    for (int t = 0; t < 16; ++t) {
        float acc = (t == cl) ? 1.f : 0.f;
#pragma unroll
        for (int j4 = 0; j4 < (t + 3) / 4; ++j4) {
            const float4 mr = *(const float4*)(Lw + 10240 + t * 64 + j4 * 16);
            const float mm[4] = {mr.x, mr.y, mr.z, mr.w};
#pragma unroll
            for (int e = 0; e < 4; ++e) if (j4 * 4 + e < t) acc += mm[e] * Tc[j4 * 4 + e];
        }
        Tc[t] = acc;
    }
#pragma unroll
    for (int q = 0; q < 4; ++q) {
        const int tau = 4 * g + q;
        *(bfu*)(Lw + 8192 + tau * 32 + cl * 2) = f2bf(Mak[q]);
        *(bfu*)(Lw + 9216 + tau * 32 + cl * 2) = f2bf(Mrb[q]);
        *(bfu*)(Lw + 9728 + tau * 32 + cl * 2) = f2bf(Mrk[q]);
    }
    if (g == 0) {
#pragma unroll
        for (int t = 0; t < 16; ++t) *(bfu*)(Lw + 8704 + t * 32 + cl * 2) = f2bf(Tc[t]);
    }
    const uint2 fmak = *(const uint2*)(Lw + 8192 + cl * 32 + g * 8), ft = *(const uint2*)(Lw + 8704 + cl * 32 + g * 8);
    const uint2 fmrb = *(const uint2*)(Lw + 9216 + cl * 32 + g * 8), fmrk = *(const uint2*)(Lw + 9728 + cl * 32 + g * 8);
    *(uint4*)(rec + OPS_MAK + lane * 16) = make_uint4(fmak.x, fmak.y, 0u, 0u);
    *(uint4*)(rec + OPS_T + lane * 16) = make_uint4(ft.x, ft.y, 0u, 0u);
    *(uint4*)(rec + OPS_MRBK + lane * 16) = make_uint4(fmrb.x, fmrb.y, fmrk.x, fmrk.y);
}

__device__ void phase_rk(KP p, int wsid_, int layer, int bid, int nb, char* smem) {
    PHASE_PROLOGUE
    const int lane = tid_ & 63, wv = tid_ >> 6, cl = lane & 15, g = lane >> 4;
    char* Lw = smem + wv * 16384;
    const float* CP = (const float*)(ws_ + WS_CP);
    const float* mu = p.c_mu + layer * CSL;
    for (int it = bid * 4 + wv; it < 2 * 64 * 144; it += nb * 4) {
        const int c = it % 144, seq = (it / 144) & 63, z = it / (144 * 64), b = seq >> 3, h = seq & 7;
        const int grow0 = c < 16 ? ML + b * 256 + 16 * c : b * 2048 + 16 * (c - 16);
        const bool sstart = (c == 0 || c == 16), send = (c == 15 || c == 143);
        auto ldgrp = [&](int col, float (&P_)[18]) {
#pragma unroll
            for (int q = 0; q < 18; ++q) {
                const int tau = q - 1, nat = z ? 15 - tau : tau;
                const bool ok = (nat >= 0 || !sstart) && (nat <= 15 || !send);
                P_[q] = ok ? CP[(size_t)(grow0 + nat) * CSL + col] : 0.f;
            }
        };
        auto shiftg = [&](int col, const float (&P_)[18], float (&out)[16]) {
            const float m = mu[col];
#pragma unroll
            for (int t = 0; t < 16; ++t) out[t] = P_[t + 1] + m * (0.5f * (P_[t] + P_[t + 2]) - P_[t + 1]);
        };
        float Pw[18], Pa[18], Pr[18], Pk[18], Pv[18];
        ldgrp(1536 + z * 64 + lane, Pw); ldgrp(1664 + z * 64 + lane, Pa); ldgrp(h * 64 + lane, Pr); ldgrp(512 + h * 64 + lane, Pk); ldgrp(1024 + h * 64 + lane, Pv);
        float tmp[16], rr[16], kr[16], vv[16];
        shiftg(1536 + z * 64 + lane, Pw, tmp);
#pragma unroll
        for (int t = 0; t < 16; ++t) *(bfu*)(Lw + 10240 + t * 128 + lane * 2) = f2bf(1.f - 2.f * __builtin_amdgcn_rcpf(1.f + __expf(2.f * tmp[t])));
        shiftg(1664 + z * 64 + lane, Pa, tmp);
#pragma unroll
        for (int t = 0; t < 16; ++t) *(bfu*)(Lw + 12288 + t * 128 + lane * 2) = f2bf(tmp[t]);
        if (z == 0 && lane < 16) {
            float Pg[18]; ldgrp(1792 + h * 16 + lane, Pg); shiftg(1792 + h * 16 + lane, Pg, tmp);
            bfu* LXG = (bfu*)(ws_ + WS_LXG);
#pragma unroll
            for (int t = 0; t < 16; ++t) LXG[(size_t)(grow0 + t) * 128 + h * 16 + lane] = f2bf(sigmoidf_(tmp[t]));
        }
        const bfu* W2 = (const bfu*)(ws_ + WS_LW2) + ((size_t)z * 512 + h * 64) * 64;
        const bfu* A2 = (const bfu*)(ws_ + WS_LA2) + ((size_t)z * 512 + h * 64) * 64;
        bf16x8 wfr[2][2][4];
#pragma unroll
        for (int which = 0; which < 2; ++which)
#pragma unroll
            for (int ks = 0; ks < 2; ++ks)
#pragma unroll
                for (int n = 0; n < 4; ++n) wfr[which][ks][n] = *(const bf16x8*)((which ? A2 : W2) + (size_t)(16 * n + cl) * 64 + ks * 32 + g * 8);
        const int ch = h * 64 + lane;
        float w0v = p.c_w0[((size_t)layer * 2 + z) * 512 + ch], a0v = p.c_a0[((size_t)layer * 2 + z) * 512 + ch];
        float kkv = p.c_k_k[layer * 512 + ch], kav = p.c_k_a[layer * 512 + ch], rkv = p.c_r_k[layer * 512 + ch];
        shiftg(h * 64 + lane, Pr, rr);
        shiftg(512 + h * 64 + lane, Pk, kr);
        shiftg(1024 + h * 64 + lane, Pv, vv);
#pragma unroll
        for (int which = 0; which < 2; ++which)
#pragma unroll
            for (int ks = 0; ks < 2; ++ks)
                asm volatile("" : "+v"(wfr[which][ks][0]), "+v"(wfr[which][ks][1]), "+v"(wfr[which][ks][2]), "+v"(wfr[which][ks][3]) :: "memory");
        asm volatile("" : "+v"(w0v), "+v"(a0v), "+v"(kkv), "+v"(kav), "+v"(rkv));
        float prew[16], prea[16];
#pragma unroll
        for (int which = 0; which < 2; ++which) {
            const char* Xs = Lw + (which ? 12288 : 10240);
            f32x4 ac[4];
#pragma unroll
            for (int n = 0; n < 4; ++n) ac[n] = (f32x4){0.f, 0.f, 0.f, 0.f};
#pragma unroll
            for (int ks = 0; ks < 2; ++ks) {
                const bf16x8 af = *(const bf16x8*)(Xs + cl * 128 + ks * 64 + g * 16);
#pragma unroll
                for (int n = 0; n < 4; ++n) {
                    ac[n] = __builtin_amdgcn_mfma_f32_16x16x32_bf16(af, wfr[which][ks][n], ac[n], 0, 0, 0);
                }
            }
#pragma unroll
            for (int n = 0; n < 4; ++n)
#pragma unroll
                for (int q = 0; q < 4; ++q) *(float*)(Lw + (4 * g + q) * 256 + (16 * n + cl) * 4) = ac[n][q];
#pragma unroll
            for (int t = 0; t < 16; ++t) { const float x = *(const float*)(Lw + t * 256 + lane * 4); if (which) prea[t] = x; else prew[t] = x; }
        }
        float lw[16], kk[16], bb[16];
        float* BETA = (float*)(ws_ + WS_BETA) + (size_t)z * MA * 8;
#pragma unroll
        for (int t = 0; t < 16; ++t) {
            lw[t] = -0.6065306597126334f * sigmoidf_(w0v + prew[t]);
            const float icl = sigmoidf_(a0v + prea[t]);
            const float kv = kr[t] * kkv;
            const float ss = sum64(kv * kv);
            kk[t] = kv * rsqrtf(fmaxf(ss, 1e-24f));
            kr[t] = kr[t] * (1.f + (icl - 1.f) * kav);
            bb[t] = kk[t] * icl;
            const float bs = sum64(rr[t] * kr[t] * rkv);
            const int nat = z ? 15 - t : t;
            if (lane == 0) BETA[(size_t)(grow0 + nat) * 8 + h] = bs;
        }
        if (z == 0) {
            bfu* VB = (bfu*)(ws_ + WS_VB);
#pragma unroll
            for (int t = 0; t < 16; ++t) VB[(size_t)(grow0 + t) * 512 + ch] = f2bf(vv[t]);
        }
        chunk_tail(lw, kk, rr, bb, kr, vv, Lw, ops_rec(ws_, z, seq, c), lane);
    }
}

__device__ __forceinline__ bf16x8 mk8(unsigned a, unsigned b, unsigned c, unsigned d) { union { bf16x8 v; unsigned u[4]; } x; x.u[0] = a; x.u[1] = b; x.u[2] = c; x.u[3] = d; return x.v; }
__device__ __forceinline__ bf16x8 ld8(const char* p) { return *(const bf16x8*)p; }
__device__ __forceinline__ void glds16_asm(const void* gsrc, unsigned lds_dst) {
    unsigned keep;
    asm volatile("s_mov_b32 %0, m0\n\ts_mov_b32 m0, %2\n\ts_nop 0\n\tglobal_load_lds_dwordx4 %1, off\n\ts_mov_b32 m0, %0" : "=&s"(keep) : "v"(gsrc), "s"(lds_dst) : "memory");
}
__device__ void phase_r4(KP p, int wsid_, int layer, int bid, int nb, char* smem) {
    PHASE_PROLOGUE
    const int lane = tid_ & 63, vt = tid_ >> 6, cl = lane & 15, g = lane >> 4;
    for (int it = bid; it < 128; it += nb) {
        const int z = it >> 6, seq = it & 63;
        float* Y = (float*)(ws_ + WS_YS) + (size_t)z * (HEADARR / 4) + (size_t)seq * NKEY * 64;
        const char* recs = ws_ + WS_OPS + (size_t)(z * 64 + seq) * 144 * OPS_REC;
        f32x4 acc[4];
#pragma unroll
        for (int kt = 0; kt < 4; ++kt) acc[kt] = (f32x4){0.f, 0.f, 0.f, 0.f};
        const unsigned lbase = __builtin_amdgcn_readfirstlane((unsigned)(uintptr_t)(__attribute__((address_space(3))) char*)smem + vt * 1024);
#define R4_ISSUE(ci_) { const int c_ = z ? ((ci_) < 16 ? 15 - (ci_) : 143 - ((ci_) - 16)) : (ci_); const char* g_ = recs + (size_t)c_ * OPS_REC + tid_ * 16; const unsigned d_ = lbase + ((ci_) & 3) * OPS_REC; \
            glds16_asm(g_, d_); glds16_asm(g_ + 4096, d_ + 4096); glds16_asm(g_ + 8192, d_ + 8192); if (tid_ < 80) glds16_asm(g_ + 12288, d_ + 12288); }
        __syncthreads();
        R4_ISSUE(0) R4_ISSUE(1) R4_ISSUE(2)
        for (int ci = 0; ci < 144; ++ci) {
            const int c = z ? (ci < 16 ? 15 - ci : 143 - (ci - 16)) : ci;
            if (ci >= 3 && ci <= 141) { if (vt < 2) asm volatile("s_waitcnt vmcnt(20)" ::: "memory"); else asm volatile("s_waitcnt vmcnt(18)" ::: "memory"); }
            else asm volatile("s_waitcnt vmcnt(0)" ::: "memory");
            __builtin_amdgcn_s_barrier();
            if (ci + 3 < 144) R4_ISSUE(ci + 3)
            const char* rec = smem + (ci & 3) * OPS_REC;
            const f32x4 zero4 = {0.f, 0.f, 0.f, 0.f};
            bf16x8 sb[2];
#pragma unroll
            for (int ks = 0; ks < 2; ++ks)
                sb[ks] = mk8(pack2(acc[2 * ks][0], acc[2 * ks][1]), pack2(acc[2 * ks][2], acc[2 * ks][3]), pack2(acc[2 * ks + 1][0], acc[2 * ks + 1][1]), pack2(acc[2 * ks + 1][2], acc[2 * ks + 1][3]));
            const uint2 vf = *(const uint2*)(rec + OPS_VF + (vt * 64 + lane) * 8);
            f32x4 Z = __builtin_amdgcn_mfma_f32_16x16x32_bf16(ld8(rec + OPS_AT + lane * 16), sb[0], zero4, 0, 0, 0);
            Z = __builtin_amdgcn_mfma_f32_16x16x32_bf16(ld8(rec + OPS_AT + (64 + lane) * 16), sb[1], Z, 0, 0, 0);
            Z = __builtin_amdgcn_mfma_f32_16x16x32_bf16(ld8(rec + OPS_MAK + lane * 16), mk8(vf.x, vf.y, 0u, 0u), Z, 0, 0, 0);
            f32x4 Yv = __builtin_amdgcn_mfma_f32_16x16x32_bf16(ld8(rec + OPS_RT + lane * 16), sb[0], zero4, 0, 0, 0);
            Yv = __builtin_amdgcn_mfma_f32_16x16x32_bf16(ld8(rec + OPS_RT + (64 + lane) * 16), sb[1], Yv, 0, 0, 0);
            const f32x4 U = __builtin_amdgcn_mfma_f32_16x16x32_bf16(ld8(rec + OPS_T + lane * 16), mk8(pack2(Z[0], Z[1]), pack2(Z[2], Z[3]), 0u, 0u), zero4, 0, 0, 0);
            const bf16x8 ub = mk8(pack2(U[0], U[1]), pack2(U[2], U[3]), vf.x, vf.y);
            Yv = __builtin_amdgcn_mfma_f32_16x16x32_bf16(ld8(rec + OPS_MRBK + lane * 16), ub, Yv, 0, 0, 0);
#pragma unroll
            for (int kt = 0; kt < 4; ++kt) {
                const float4 wc = *(const float4*)(rec + OPS_WC + (16 * kt + 4 * g) * 4);
                f32x4 a = acc[kt];
                a[0] *= wc.x; a[1] *= wc.y; a[2] *= wc.z; a[3] *= wc.w;
                acc[kt] = __builtin_amdgcn_mfma_f32_16x16x32_bf16(ld8(rec + OPS_BK + (kt * 64 + lane) * 16), ub, a, 0, 0, 0);
            }
#pragma unroll
            for (int q = 0; q < 4; ++q) {
                const int tau = 4 * g + q, t = z ? 15 - tau : tau;
                Y[(size_t)(16 * c + t) * 64 + vt * 16 + cl] = Yv[q];
            }
        }
    }
}

__device__ void phase_readout(KP p, int wsid_, int layer, int nrows, int bid, int nb) {
    PHASE_PROLOGUE
    const float* Y0 = (const float*)(ws_ + WS_YS); const float* Y1 = Y0 + HEADARR / 4;
    const bfu* VB = (const bfu*)(ws_ + WS_VB); const float* B0 = (const float*)(ws_ + WS_BETA); const float* B1 = B0 + (size_t)MA * 8;
    const float* GG = (const float*)(ws_ + WS_GG);
    bfu* MIX = (bfu*)(ws_ + WS_MIX);
    const float* lnw = p.c_ln_w + layer * 512; const float* lnb = p.c_ln_b + layer * 512;
    const int lane = tid_ & 63, wv = tid_ >> 6;
    for (int row0 = (bid * 4 + wv) * 2; row0 < nrows; row0 += nb * 8) {
        int b, j, s; row_info(row0, b, j, s);
        float y0a[8], y1a[8], y0b[8], y1b[8], gav[8], gbv[8], lwv[8], lbv[8]; bfu vav[8], vbv[8];
        float4 bq0[4], bq1[4];
#pragma unroll
        for (int h = 0; h < 8; ++h) {
            const size_t o = (((size_t)b * 8 + h) * NKEY + j) * 64 + lane;
            y0a[h] = Y0[o]; y1a[h] = Y1[o]; y0b[h] = Y0[o + 64]; y1b[h] = Y1[o + 64];
            vav[h] = VB[(size_t)row0 * 512 + h * 64 + lane]; vbv[h] = VB[(size_t)(row0 + 1) * 512 + h * 64 + lane];
            gav[h] = GG[(size_t)row0 * 512 + h * 64 + lane]; gbv[h] = GG[(size_t)(row0 + 1) * 512 + h * 64 + lane];
            lwv[h] = lnw[h * 64 + lane]; lbv[h] = lnb[h * 64 + lane];
        }
#pragma unroll
        for (int q = 0; q < 4; ++q) { bq0[q] = *(const float4*)(B0 + (size_t)row0 * 8 + q * 4); bq1[q] = *(const float4*)(B1 + (size_t)row0 * 8 + q * 4); }
        const float bs0[16] = {bq0[0].x, bq0[0].y, bq0[0].z, bq0[0].w, bq0[1].x, bq0[1].y, bq0[1].z, bq0[1].w, bq0[2].x, bq0[2].y, bq0[2].z, bq0[2].w, bq0[3].x, bq0[3].y, bq0[3].z, bq0[3].w};
        const float bs1[16] = {bq1[0].x, bq1[0].y, bq1[0].z, bq1[0].w, bq1[1].x, bq1[1].y, bq1[1].z, bq1[1].w, bq1[2].x, bq1[2].y, bq1[2].z, bq1[2].w, bq1[3].x, bq1[3].y, bq1[3].z, bq1[3].w};
#pragma unroll
        for (int h = 0; h < 8; ++h) {
            const float ya = y0a[h] + y1a[h], yb = y0b[h] + y1b[h];
            const float va = bf2f(vav[h]), vb2 = bf2f(vbv[h]);
            const float bsa = bs0[h] + bs1[h], bsb = bs0[8 + h] + bs1[8 + h];
            const float ma = sum64(ya) * (1.f / 64.f), mb = sum64(yb) * (1.f / 64.f);
            const float da = ya - ma, db = yb - mb;
            const float vra = sum64(da * da) * (1.f / 64.f), vrb = sum64(db * db) * (1.f / 64.f);
            const float oa = (da * rsqrtf(vra + 64e-5f) * lwv[h] + lbv[h] + bsa * va) * gav[h];
            const float ob = (db * rsqrtf(vrb + 64e-5f) * lwv[h] + lbv[h] + bsb * vb2) * gbv[h];
            MIX[(size_t)row0 * DM + 512 + h * 64 + lane] = f2bf(oa);
            MIX[(size_t)(row0 + 1) * DM + 512 + h * 64 + lane] = f2bf(ob);
        }
    }
}

using f32x16 = __attribute__((ext_vector_type(16))) float;
#define AT_KBYTES 8192
#define AT_VSTRIDE 136
#define AT_VBYTES (64 * AT_VSTRIDE)
template <int GRP>
__device__ __forceinline__ void attn_item(KP p, int wsid_, char* ws_, int layer, int b, int h, int qb, int nkeys, float lam, float lam_init, char* smem, int tid) {
    constexpr int KS = GRP ? 2 : 4;
    const int lane = tid & 63, wv = tid >> 6, r32 = lane & 31, hh = lane >> 5;
    const int mp = GRP ? (wv >> 1) : 0, sub = GRP ? (wv & 1) : wv;
    const int jq = qb * (GRP ? 64 : 128) + sub * 32 + r32;
    const bfu* Qg = (const bfu*)(ws_ + (GRP ? WS_QB : WS_QA)) + (((size_t)b * 4 + h) * NKEY + jq) * 64 + mp * 32;
    const bfu* Kg = GRP ? (const bfu*)(ws_ + WS_KB) + ((size_t)b * 4 + h) * NKEY * 64 : (const bfu*)(ws_ + WS_KA) + ((size_t)b * 2 + (h >> 1)) * NKEY * 64;
    const bfu* Vg = GRP ? (const bfu*)(ws_ + WS_VBT) + ((size_t)b * 4 + h) * 64 * NKEY : (const bfu*)(ws_ + WS_VAT) + ((size_t)b * 2 + (h >> 1)) * 64 * NKEY;
    bf16x8 qf[KS];
#pragma unroll
    for (int ks = 0; ks < KS; ++ks) qf[ks] = *(const bf16x8*)(Qg + ks * 16 + hh * 8);
    f32x16 oacc[2];
    float lrun = 0.f;
#pragma unroll
    for (int db = 0; db < 2; ++db)
#pragma unroll
        for (int i = 0; i < 16; ++i) oacc[db][i] = 0.f;
    const int lrow = tid >> 3, lch = ((tid & 7) ^ ((tid >> 4) & 7)) * 8;
    const bfu* kp0 = Kg + (size_t)lrow * 64 + lch; const bfu* kp1 = kp0 + 32 * 64;
    const bfu* vp0 = Vg + (size_t)lrow * NKEY + lch; const bfu* vp1 = vp0 + (size_t)32 * NKEY;
    char* ldst = smem + tid * 16;
#define AT_ISSUE(t_) { char* d_ = ldst + ((t_) & 1) * 16384; const size_t ko_ = (size_t)(t_) * 64 * 64; const int vo_ = (t_) * 64; \
        GLDS(kp0 + ko_, d_); GLDS(kp1 + ko_, d_ + 4096); GLDS(vp0 + vo_, d_ + 8192); GLDS(vp1 + vo_, d_ + 12288); }
    __syncthreads();
    AT_ISSUE(0)
    const int nt = nkeys >> 6;
    float mref = 0.f;
    const int swv = (r32 >> 1) & 7;
    for (int t = 0; t < nt; ++t) {
        asm volatile("s_waitcnt vmcnt(0)" ::: "memory");
        __syncthreads();
        if (t + 1 < nt) AT_ISSUE(t + 1)
        const char* cK = smem + (t & 1) * 16384; const char* cV = cK + 8192;
        f32x16 sacc[2];
        const float ninit = -mref;
#pragma unroll
        for (int kb = 0; kb < 2; ++kb) {
#pragma unroll
            for (int i = 0; i < 16; ++i) sacc[kb][i] = ninit;
            const int key = kb * 32 + r32;
#pragma unroll
            for (int ks = 0; ks < KS; ++ks) {
                const int c0 = mp * 4 + ks * 2 + hh;
                const bf16x8 kf = *(const bf16x8*)(cK + key * 128 + ((c0 ^ ((key >> 1) & 7)) * 16));
                sacc[kb] = __builtin_amdgcn_mfma_f32_32x32x16_bf16(kf, qf[ks], sacc[kb], 0, 0, 0);
            }
        }
        float mx = sacc[0][0];
#pragma unroll
        for (int i = 1; i < 16; ++i) mx = fmaxf(mx, sacc[0][i]);
#pragma unroll
        for (int i = 0; i < 16; ++i) mx = fmaxf(mx, sacc[1][i]);
        mx = xor32_max(mx);
        const bool need = (t == 0) || (mx > 8.f);
        if (__any(need)) {
            const float delta = need ? mx : 0.f;
            const float alpha = __builtin_amdgcn_exp2f(-delta);
            mref += delta; lrun *= alpha;
#pragma unroll
            for (int db = 0; db < 2; ++db)
#pragma unroll
                for (int i = 0; i < 16; ++i) oacc[db][i] *= alpha;
#pragma unroll
            for (int kb = 0; kb < 2; ++kb)
#pragma unroll
                for (int i = 0; i < 16; ++i) sacc[kb][i] -= delta;
        }
        float ps = 0.f;
#pragma unroll
        for (int kb = 0; kb < 2; ++kb)
#pragma unroll
            for (int i = 0; i < 16; ++i) { const float pv = __builtin_amdgcn_exp2f(sacc[kb][i]); sacc[kb][i] = pv; ps += pv; }
        lrun += ps;
#pragma unroll
        for (int kb = 0; kb < 2; ++kb)
#pragma unroll
            for (int s2 = 0; s2 < 2; ++s2) {
                union { bf16x8 v; unsigned u[4]; } pf;
#pragma unroll
                for (int i = 0; i < 4; ++i) pf.u[i] = pack2(sacc[kb][8 * s2 + 2 * i], sacc[kb][8 * s2 + 2 * i + 1]);
#pragma unroll
                for (int db = 0; db < 2; ++db) {
                    const char* vr = cV + (db * 32 + r32) * 128 + hh * 8;
                    union { bf16x8 v; uint2 u[2]; } vf;
                    vf.u[0] = *(const uint2*)(vr + (((kb * 4 + s2 * 2) ^ swv) * 16)); vf.u[1] = *(const uint2*)(vr + (((kb * 4 + s2 * 2 + 1) ^ swv) * 16));
                    oacc[db] = __builtin_amdgcn_mfma_f32_32x32x16_bf16(vf.v, pf.v, oacc[db], 0, 0, 0);
                }
            }
    }
    __syncthreads();
    bfu* MIX = (bfu*)(ws_ + WS_MIX);
    const int grow = grow_of(b, jq);
    const float il = 1.f / xor32_sum(lrun);
    if (GRP == 0) {
        bfu* dst = MIX + (size_t)grow * DM + h * 64;
#pragma unroll
        for (int db = 0; db < 2; ++db)
#pragma unroll
            for (int g = 0; g < 4; ++g)
                *(uint2*)(dst + db * 32 + g * 8 + hh * 4) = make_uint2(pack2(oacc[db][4 * g] * il, oacc[db][4 * g + 1] * il), pack2(oacc[db][4 * g + 2] * il, oacc[db][4 * g + 3] * il));
    } else {
        float* xs = (float*)smem + sub * 2048;
        if (mp == 1) {
            const float sc2 = lam * il;
#pragma unroll
            for (int db = 0; db < 2; ++db)
#pragma unroll
                for (int i = 0; i < 16; ++i) xs[(db * 16 + i) * 64 + lane] = oacc[db][i] * sc2;
        }
        __syncthreads();
        if (mp == 0) {
            float ss = 0.f;
#pragma unroll
            for (int db = 0; db < 2; ++db)
#pragma unroll
                for (int i = 0; i < 16; ++i) { const float o = oacc[db][i] * il - xs[(db * 16 + i) * 64 + lane]; oacc[db][i] = o; ss += o * o; }
            ss = xor32_sum(ss);
            const float rs = rsqrtf(ss * (1.f / 64.f) + 1e-6f) * (1.f - lam_init);
            const float* gn = p.b_subln + layer * 64;
            bfu* dst = MIX + (size_t)grow * DM + 256 + h * 64;
            float4 gq[2][4];
#pragma unroll
            for (int db = 0; db < 2; ++db)
#pragma unroll
                for (int g = 0; g < 4; ++g) gq[db][g] = *(const float4*)(gn + db * 32 + g * 8 + hh * 4);
#pragma unroll
            for (int db = 0; db < 2; ++db)
#pragma unroll
                for (int g = 0; g < 4; ++g) {
                    const int d = db * 32 + g * 8 + hh * 4;
                    *(uint2*)(dst + d) = make_uint2(pack2(oacc[db][4 * g] * rs * gq[db][g].x, oacc[db][4 * g + 1] * rs * gq[db][g].y), pack2(oacc[db][4 * g + 2] * rs * gq[db][g].z, oacc[db][4 * g + 3] * rs * gq[db][g].w));
                }
        }
    }
}
__device__ void phase_attn(KP p, int wsid_, int layer, bool do_ctx, unsigned* qctr, unsigned* cctr, int* s_item, char* smem) {
    PHASE_PROLOGUE
    const int tid = tid_;
    const float lam_init = 0.8f - 0.6f * expf(-0.3f * (float)layer);
    float d1 = 0.f, d2 = 0.f;
    for (int i = 0; i < 32; ++i) { d1 += p.b_lq1[layer * 32 + i] * p.b_lk1[layer * 32 + i]; d2 += p.b_lq2[layer * 32 + i] * p.b_lk2[layer * 32 + i]; }
    const float lam = expf(d1) - expf(d2) + lam_init;
    const int nitems = do_ctx ? 1728 : 1536;
    bool conv_left = cctr != nullptr;
    for (;;) {
        __syncthreads();
        if (TID512 == 0) *s_item = (int)atomicAdd(qctr, 1u);
        __syncthreads();
        const int pair_ = __builtin_amdgcn_readfirstlane(*s_item);
        if (2 * pair_ >= nitems) break;
        const int it = 2 * pair_ + hb_;
        int grp, b, h, qb, nkeys;
        if (it < 512) { grp = 0; qb = 2 + (it & 15); h = (it >> 4) & 3; b = it >> 6; nkeys = NKEY; }
        else if (it < 1536) { grp = 1; const int r = it - 512; qb = 4 + (r & 31); h = (r >> 5) & 3; b = r >> 7; nkeys = NKEY; }
        else if (it < 1664) { grp = 1; const int r = it - 1536; qb = r & 3; h = (r >> 2) & 3; b = r >> 4; nkeys = 256; }
        else { grp = 0; const int r = it - 1664; qb = r & 1; h = (r >> 1) & 3; b = r >> 3; nkeys = 256; }
        if (grp) attn_item<1>(p, wsid_, ws_, layer, b, h, qb, nkeys, lam, lam_init, smem, tid);
        else attn_item<0>(p, wsid_, ws_, layer, b, h, qb, nkeys, lam, lam_init, smem, tid);
        if (conv_left) conv_left = conv_big_step(p, wsid_, ws_, layer, cctr, s_item, smem, tid, hb_);
    }
    while (conv_left) conv_left = conv_big_step(p, wsid_, ws_, layer, cctr, s_item, smem, tid, hb_);
}

__device__ void phase_outproj(KP p, int wsid_, int layer, int nrows, int bid, int nb, char* smem) {
    PHASE_PROLOGUE
    const bfu* MIX = (const bfu*)(ws_ + WS_MIX); const bfu* W = (const bfu*)(ws_ + WS_WOUT);
    float* X = (float*)(ws_ + WS_X); const float* mod = (const float*)(ws_ + WS_MOD);
    const int nitems = (nrows / 128) * 8;
    for (int it = bid; it < nitems; it += nb) {
        const int mt = it >> 3, nt = it & 7, row0 = mt * 128, col0 = nt * 128;
        int b, j0, s; row_info(row0, b, j0, s);
        const float* ga = mod + ((size_t)layer * 9 + s) * 6144 + 2 * 1024;
        gemm_tile([&](int r) { return MIX + (size_t)(row0 + r) * DM; }, [&](int r) { return W + (size_t)(col0 + r) * DM; }, DM,
            [&](f32x4 (&acc)[4][4], int wr, int wc, int fr, int fq) {
                ACC_FOREACH({ float* xp = X + (size_t)(row0 + row) * DM + col0 + col; *xp += ga[col0 + col] * val; })
            }, smem, wsid_);
    }
}

__device__ void phase_norm2_route(KP p, int wsid_, int layer, int nrows, int bid, int nb, char* smem, bool dry = false) {
    PHASE_PROLOGUE
    const float* X = (const float*)(ws_ + WS_X); bfu* H = (bfu*)(ws_ + WS_H);
    const float* mod = (const float*)(ws_ + WS_MOD); const float* WRT = (const float*)(ws_ + WS_WRT);
    int* ECNT = (int*)(ws_ + WS_ECNT) + layer * 32; int* EIDX = (int*)(ws_ + WS_EIDX); float* EGATE = (float*)(ws_ + WS_EGATE); int* ELIST = (int*)(ws_ + WS_ELIST);
    float* lg = (float*)smem;
    int* lcnt = (int*)(lg + 4 * 16 * 48);
    int* lbase = lcnt + 32;
    int* lsel = lbase + 32;
    int* lrank = lsel + 128;
    char* slab = smem + 14336;
    constexpr int SLAB = 27136;
    const bfu* WH = (const bfu*)(ws_ + WS_WRTH); const bfu* WL = (const bfu*)(ws_ + WS_WRTL);
    const int tid = tid_, lane = tid & 63, wv = tid >> 6, r = lane & 15, kq = lane >> 4;
    const float* gf = p.g_ffn + layer * DM;
    const float* bg = p.r_b_group + layer * 4; const float* be = p.r_b_expert + layer * 32;
    const int nitems = nrows / 64;
    for (int it = bid; it < nitems; it += nb) {
        const int row = it * 64 + wv * 16 + r;
        int b, j, s; row_info(row, b, j, s);
        const float* xr = X + (size_t)row * DM;
        const float* sh = mod + ((size_t)layer * 9 + s) * 6144 + 3 * 1024; const float* sc = sh + 1024;
        if (tid < 32) lcnt[tid] = 0;
        float ss = 0.f;
#pragma unroll 1
        for (int c0 = 0; c0 < 64; c0 += 16) {
            float4 xv_[16];
#pragma unroll
            for (int c = 0; c < 16; ++c) xv_[c] = *(const float4*)(xr + (c0 + c) * 16 + kq * 4);
#pragma unroll
            for (int c = 0; c < 16; c += 4)
                asm volatile("" : "+v"(xv_[c].x), "+v"(xv_[c].y), "+v"(xv_[c].z), "+v"(xv_[c].w), "+v"(xv_[c + 1].x), "+v"(xv_[c + 1].y), "+v"(xv_[c + 1].z), "+v"(xv_[c + 1].w),
                                  "+v"(xv_[c + 2].x), "+v"(xv_[c + 2].y), "+v"(xv_[c + 2].z), "+v"(xv_[c + 2].w), "+v"(xv_[c + 3].x), "+v"(xv_[c + 3].y), "+v"(xv_[c + 3].z), "+v"(xv_[c + 3].w) :: "memory");
#pragma unroll
            for (int c = 0; c < 16; ++c) ss += xv_[c].x * xv_[c].x + xv_[c].y * xv_[c].y + xv_[c].z * xv_[c].z + xv_[c].w * xv_[c].w;
        }
        ss = xor32_sum(xor16_sum(ss));
        const float rs = rsqrtf(ss * (1.f / 1024.f) + 1e-6f);
        f32x4 acc[3];
#pragma unroll
        for (int n = 0; n < 3; ++n) acc[n] = (f32x4){0.f, 0.f, 0.f, 0.f};
        uint4 sw0, sw1, sw2, sw3, sw4, sw5; float4 sg = make_float4(0.f, 0.f, 0.f, 0.f);
        const int ch0 = tid, ch1 = tid + 256, ch2 = tid + 512;
        const size_t wo0 = (size_t)(ch0 >> 4) * DM + (ch0 & 15) * 8, wo1 = (size_t)(ch1 >> 4) * DM + (ch1 & 15) * 8, wo2 = (size_t)(ch2 >> 4) * DM + (ch2 & 15) * 8;
        const int lo0 = (ch0 >> 4) * 272 + (ch0 & 15) * 16, lo1 = (ch1 >> 4) * 272 + (ch1 & 15) * 16, lo2 = (ch2 >> 4) * 272 + (ch2 & 15) * 16;
#define RT_SLAB_LOAD(sb_) { const int k0_ = (sb_) * 128; \
            sw0 = *(const uint4*)(WH + wo0 + k0_); sw1 = *(const uint4*)(WH + wo1 + k0_); sw2 = *(const uint4*)(WH + wo2 + k0_); \
            sw3 = *(const uint4*)(WL + wo0 + k0_); sw4 = *(const uint4*)(WL + wo1 + k0_); sw5 = *(const uint4*)(WL + wo2 + k0_); \
            if (tid < 32) { const float4 g4 = *(const float4*)(gf + k0_ + tid * 4), s4_ = *(const float4*)(sc + k0_ + tid * 4); sg = make_float4(g4.x * (1.f + s4_.x), g4.y * (1.f + s4_.y), g4.z * (1.f + s4_.z), g4.w * (1.f + s4_.w)); } \
            else if (tid < 64) sg = *(const float4*)(sh + k0_ + (tid - 32) * 4); }
#define RT_SLAB_STORE(buf_) { char* d_ = slab + (buf_) * SLAB; \
            *(uint4*)(d_ + lo0) = sw0; *(uint4*)(d_ + lo1) = sw1; *(uint4*)(d_ + lo2) = sw2; *(uint4*)(d_ + 13056 + lo0) = sw3; *(uint4*)(d_ + 13056 + lo1) = sw4; *(uint4*)(d_ + 13056 + lo2) = sw5; \
            if (tid < 64) *(float4*)(d_ + 26112 + tid * 16) = sg; }
        float4 xq0, xq1, xq2, xq3, xq4, xq5, xq6, xq7;
#define RT_X_LOAD(sb_) { const float* x_ = xr + (sb_) * 128 + kq * 8; xq0 = *(const float4*)(x_); xq1 = *(const float4*)(x_ + 4); xq2 = *(const float4*)(x_ + 32); xq3 = *(const float4*)(x_ + 36); \
            xq4 = *(const float4*)(x_ + 64); xq5 = *(const float4*)(x_ + 68); xq6 = *(const float4*)(x_ + 96); xq7 = *(const float4*)(x_ + 100); }
        __syncthreads();
        RT_SLAB_LOAD(0) RT_SLAB_STORE(0) RT_X_LOAD(0)
        __syncthreads();
        for (int sb = 0; sb < 8; ++sb) {
            if (sb + 1 < 8) RT_SLAB_LOAD(sb + 1)
            const float4 xc[8] = {xq0, xq1, xq2, xq3, xq4, xq5, xq6, xq7};
            if (sb + 1 < 8) RT_X_LOAD(sb + 1)
            const char* d = slab + (sb & 1) * SLAB;
#pragma unroll
            for (int s4 = 0; s4 < 4; ++s4) {
                const float4 g0 = *(const float4*)(d + 26112 + (s4 * 32 + kq * 8) * 4), g1 = *(const float4*)(d + 26112 + (s4 * 32 + kq * 8 + 4) * 4);
                const float4 h0 = *(const float4*)(d + 26624 + (s4 * 32 + kq * 8) * 4), h1 = *(const float4*)(d + 26624 + (s4 * 32 + kq * 8 + 4) * 4);
                const float4 xa = xc[2 * s4], xb = xc[2 * s4 + 1];
                float f[8];
                f[0] = xa.x * rs * g0.x + h0.x; f[1] = xa.y * rs * g0.y + h0.y; f[2] = xa.z * rs * g0.z + h0.z; f[3] = xa.w * rs * g0.w + h0.w;
                f[4] = xb.x * rs * g1.x + h1.x; f[5] = xb.y * rs * g1.y + h1.y; f[6] = xb.z * rs * g1.z + h1.z; f[7] = xb.w * rs * g1.w + h1.w;
                unsigned hi[4], lo[4];
#pragma unroll
                for (int i = 0; i < 4; ++i) {
                    hi[i] = pack2(f[2 * i], f[2 * i + 1]);
                    lo[i] = pack2(f[2 * i] - __uint_as_float(hi[i] << 16), f[2 * i + 1] - __uint_as_float(hi[i] & 0xFFFF0000u));
                }
                *(uint4*)(H + (size_t)row * DM + sb * 128 + s4 * 32 + kq * 8) = make_uint4(hi[0], hi[1], hi[2], hi[3]);
                const bf16x8 ah = mk8(hi[0], hi[1], hi[2], hi[3]), al = mk8(lo[0], lo[1], lo[2], lo[3]);
#pragma unroll
                for (int n = 0; n < 3; ++n) {
                    const bf16x8 wh = *(const bf16x8*)(d + (n * 16 + r) * 272 + (s4 * 32 + kq * 8) * 2), wl = *(const bf16x8*)(d + 13056 + (n * 16 + r) * 272 + (s4 * 32 + kq * 8) * 2);
                    acc[n] = __builtin_amdgcn_mfma_f32_16x16x32_bf16(ah, wh, acc[n], 0, 0, 0);
                    acc[n] = __builtin_amdgcn_mfma_f32_16x16x32_bf16(ah, wl, acc[n], 0, 0, 0);
                    acc[n] = __builtin_amdgcn_mfma_f32_16x16x32_bf16(al, wh, acc[n], 0, 0, 0);
                }
            }
            if (sb + 1 < 8) RT_SLAB_STORE((sb + 1) & 1)
            __syncthreads();
        }
#pragma unroll
        for (int n = 0; n < 3; ++n)
#pragma unroll
            for (int jj = 0; jj < 4; ++jj) lg[(wv * 16 + kq * 4 + jj) * 48 + n * 16 + r] = acc[n][jj];
        __syncthreads();
        if (lane < 16) {
            const float* L = lg + (wv * 16 + lane) * 48;
            const int grow = it * 64 + wv * 16 + lane;
            float gl[4]; float gm = -1e30f; int gi = 0;
#pragma unroll
            for (int g = 0; g < 4; ++g) { gl[g] = L[g] + bg[g]; if (gl[g] > gm) { gm = gl[g]; gi = g; } }
            float gs = 0.f;
#pragma unroll
            for (int g = 0; g < 4; ++g) gs += __expf(gl[g] - gm);
            const float gp = 1.f / gs;
            float v1 = -1e30f, v2 = -1e30f; int i1 = 0, i2 = 0;
            const float4 be0 = *(const float4*)(be + gi * 8), be1 = *(const float4*)(be + gi * 8 + 4);
            const float bev[8] = {be0.x, be0.y, be0.z, be0.w, be1.x, be1.y, be1.z, be1.w};
#pragma unroll
            for (int e = 0; e < 8; ++e) {
                const float v = L[4 + gi * 8 + e] + bev[e];
                if (v > v1) { v2 = v1; i2 = i1; v1 = v; i1 = e; } else if (v > v2) { v2 = v; i2 = e; }
            }
            const float e2 = __expf(v2 - v1), den = 1.f / (1.f + e2);
            const int ex1 = gi * 8 + i1, ex2 = gi * 8 + i2;
            EIDX[grow * 2] = ex1; EIDX[grow * 2 + 1] = ex2;
            EGATE[grow * 2] = den * gp; EGATE[grow * 2 + 1] = e2 * den * gp;
            const int lr = wv * 16 + lane;
            lsel[lr * 2] = ex1; lsel[lr * 2 + 1] = ex2;
            lrank[lr * 2] = atomicAdd(&lcnt[ex1], 1); lrank[lr * 2 + 1] = atomicAdd(&lcnt[ex2], 1);
        }
        __syncthreads();
        if (tid < 32) lbase[tid] = (lcnt[tid] > 0 && !dry) ? atomicAdd(&ECNT[tid], lcnt[tid]) : 0;
        __syncthreads();
        if (tid < 128 && !dry) { const int e = lsel[tid]; ELIST[(size_t)e * (2 * MA) + lbase[e] + lrank[tid]] = ((it * 64 + (tid >> 1)) << 1) | (tid & 1); }
        __syncthreads();
    }
}

__device__ __forceinline__ int moe_prefix256(const int* ECNT, int* spre  , int wsid_) {
    const int t5 = TID512;
    if (t5 < 32) spre[40 + t5] = (ECNT[t5] + 255) >> 8;
    __syncthreads();
    if (t5 == 0) { int a = 0; for (int e = 0; e < 32; ++e) { spre[e] = a; a += spre[40 + e]; } spre[32] = a; }
    __syncthreads();
    return spre[32];
}
__device__ void phase_outproj256(KP p, int wsid_, int layer, int nrows, int vblk, int nblk, char* smem_all, unsigned* cctr, int* s_item, float gscale = 1.f) {
    PHASE_PROLOGUE
    const bfu* MIX = (const bfu*)(ws_ + WS_MIX); const bfu* W = (const bfu*)(ws_ + WS_WOUT);
    const float* mod = (const float*)(ws_ + WS_MOD);
    const int nitems = (nrows >> 8) * 4;
    for (int it = vblk; it < nitems; it += nblk) {
        const int mt = it >> 2, nt = it & 3, row0 = mt * 256, col0 = nt * 256;
        int b, j0, sm; row_info(row0, b, j0, sm);
        const float* ga = mod + ((size_t)layer * 9 + sm) * 6144 + 2 * 1024 + col0;
        const bfu* B0 = W + (size_t)col0 * DM;
        gemm256<DM, DM, DM>(MIX, [&](int r) { return row0 + r; }, B0, B0 + (size_t)128 * DM,
            [&](f32x4 (&acc)[2][2][4][2], int wr, int wc, int fr, int fq) {
                const __amdgpu_buffer_rsrc_t rs = __builtin_amdgcn_make_buffer_rsrc((void*)(ws_ + WS_X), 0, (int)((size_t)MA * DM * 4), 0x00020000);
                const int voff = ((wr * 64 + fq * 4) * DM + wc * 32 + fr) * 4;
#pragma unroll
                for (int bj = 0; bj < 2; ++bj) {
                    float xo[2][2][4][4];
                    const float g0 = ga[bj * 128 + wc * 32 + fr] * gscale, g1 = ga[bj * 128 + wc * 32 + 16 + fr] * gscale;
#pragma unroll
                    for (int n = 0; n < 2; ++n)
#pragma unroll
                        for (int ai = 0; ai < 2; ++ai)
#pragma unroll
                            for (int m = 0; m < 4; ++m)
#pragma unroll
                                for (int j = 0; j < 4; ++j)
                                    xo[n][ai][m][j] = __uint_as_float(__builtin_amdgcn_raw_buffer_load_b32(rs, voff, ((row0 + ai * 128 + m * 16 + j) * DM + col0 + bj * 128 + n * 16) * 4, 0));
#pragma unroll
                    for (int n = 0; n < 2; ++n)
#pragma unroll
                        for (int ai = 0; ai < 2; ++ai)
#pragma unroll
                            for (int m = 0; m < 4; ++m)
#pragma unroll
                                for (int j = 0; j < 4; ++j)
                                    __builtin_amdgcn_raw_buffer_store_b32(__float_as_uint(xo[n][ai][m][j] + (n ? g1 : g0) * acc[ai][bj][m][n][j]), rs, voff, ((row0 + ai * 128 + m * 16 + j) * DM + col0 + bj * 128 + n * 16) * 4, 0);
                }
            }, smem_all, wsid_);
    }
    if (nitems > nblk && vblk >= nitems - nblk) { for (int q = 0; q < 5; ++q) if (!conv_big_step(p, wsid_, ws_, layer, cctr, s_item, smem_all + hb_ * SMEM_BYTES, tid_, hb_)) break; }
}
__device__ void phase_experts256(KP p, int wsid_, int layer, int vblk, int nblk, unsigned* rbcnt, char* smem_all) {
    PHASE_PROLOGUE
    const bfu* H = (const bfu*)(ws_ + WS_H); const bfu* W1 = (const bfu*)(ws_ + WS_W1); const bfu* W3 = (const bfu*)(ws_ + WS_W3);
    const bfu* HB = (const bfu*)(ws_ + WS_HB); const bfu* W2 = (const bfu*)(ws_ + WS_W2);
    const int* ECNT = (const int*)(ws_ + WS_ECNT) + layer * 32; const int* ELIST = (const int*)(ws_ + WS_ELIST); const float* EGATE = (const float*)(ws_ + WS_EGATE);
    int* spre = (int*)(smem_all + 135168);
    const int nb256 = __builtin_amdgcn_readfirstlane(moe_prefix256(ECNT, spre, wsid_));
    const int n1 = nb256 * 4;
    for (int it = vblk; it < 2 * n1; it += nblk) {
        const bool second = it >= n1;
        const int t = second ? it - n1 : it, blk = t >> 2, nt = t & 3;
        int e = 0;
        while (__builtin_amdgcn_readfirstlane(spre[e + 1]) <= blk) ++e;
        const int rb = blk - __builtin_amdgcn_readfirstlane(spre[e]), cnt = __builtin_amdgcn_readfirstlane(ECNT[e]);
        const int* lst = ELIST + (size_t)e * (2 * MA) + rb * 256;
        const int nvalid = min(256, cnt - rb * 256);
        if (!second) {
            const bfu* w1 = W1 + ((size_t)e * FF + nt * 128) * DM; const bfu* w3 = W3 + ((size_t)e * FF + nt * 128) * DM;
            gemm256<DM, DM, DM>(H, [&](int r) { const int e_ = lst[r < nvalid ? r : 0]; return r < nvalid ? (e_ >> 1) : 0; }    , w1, w3,
                [&](f32x4 (&acc)[2][2][4][2], int wr, int wc, int fr, int fq) {
                    const __amdgpu_buffer_rsrc_t rs = __builtin_amdgcn_make_buffer_rsrc((void*)(ws_ + WS_HB), 0, (int)((size_t)(2 * MA + 32 * 256) * FF * 2), 0x00020000);
                    const int voff = ((wr * 64 + fq * 4) * FF + wc * 32 + fr) * 2;
#pragma unroll
                    for (int ai = 0; ai < 2; ++ai)
#pragma unroll
                        for (int m = 0; m < 4; ++m)
#pragma unroll
                            for (int n = 0; n < 2; ++n)
#pragma unroll
                                for (int j = 0; j < 4; ++j) {
                                    const float a = acc[ai][0][m][n][j], g = acc[ai][1][m][n][j];
                                    __builtin_amdgcn_raw_buffer_store_b16(f2bf(siluf_(a) * g), rs, voff, ((blk * 256 + ai * 128 + m * 16 + j) * FF + nt * 128 + n * 16) * 2, 16);
                                }
                    asm volatile("s_waitcnt vmcnt(0)" ::: "memory");
                    __syncthreads();
                    if (TID512 == 0) __hip_atomic_fetch_add(rbcnt + blk, 1u, __ATOMIC_RELAXED, __HIP_MEMORY_SCOPE_AGENT);
                }, smem_all, wsid_);
        } else {
            if (TID512 == 0) {
                unsigned spins = 0;
                while (__hip_atomic_load(rbcnt + blk, __ATOMIC_RELAXED, __HIP_MEMORY_SCOPE_AGENT) < 4u) { __builtin_amdgcn_s_sleep(1); if (++spins > (1u << 22)) break; }
                __builtin_amdgcn_fence(__ATOMIC_ACQUIRE, "agent");
                asm volatile("s_waitcnt vmcnt(0)" ::: "memory");
            }
            __syncthreads();
            const bfu* w2 = W2 + ((size_t)e * DM + nt * 256) * FF;
            gemm256<FF, FF, FF>(HB, [&](int r) { return blk * 256 + r; }, w2, w2 + (size_t)128 * FF,
                [&](f32x4 (&acc)[2][2][4][2], int wr, int wc, int fr, int fq) {
                    int* sOff = (int*)smem_all; float* sGt = (float*)(smem_all + 1024);
                    { const int r = TID512;
                      if (r < 256) {
                          const bool ok = r < nvalid; const int ent = ok ? lst[r] : 0;
                          sOff[r] = ok ? ((ent & 1) * MA + (ent >> 1)) * DM * 2 : -1; sGt[r] = EGATE[ent];
                      } }
                    __syncthreads();
                    const __amdgpu_buffer_rsrc_t rs = __builtin_amdgcn_make_buffer_rsrc((void*)(ws_ + WS_Y01), 0, (int)((size_t)2 * MA * DM * 2), 0x00020000);
                    const int cofs = (nt * 256 + wc * 32 + fr) * 2;
#pragma unroll
                    for (int ai = 0; ai < 2; ++ai)
#pragma unroll
                        for (int m = 0; m < 4; ++m) {
                            const int4 o4 = *(const int4*)(sOff + ai * 128 + wr * 64 + m * 16 + fq * 4); const float4 g4 = *(const float4*)(sGt + ai * 128 + wr * 64 + m * 16 + fq * 4);
                            const int oo[4] = {o4.x, o4.y, o4.z, o4.w}; const float gg[4] = {g4.x, g4.y, g4.z, g4.w};
#pragma unroll
                            for (int j = 0; j < 4; ++j) {
                                if (oo[j] >= 0) {
#pragma unroll
                                    for (int bj = 0; bj < 2; ++bj)
#pragma unroll
                                        for (int n = 0; n < 2; ++n)
                                            __builtin_amdgcn_raw_buffer_store_b16(f2bf(gg[j] * acc[ai][bj][m][n][j]), rs, oo[j] + cofs, (bj * 128 + n * 16) * 2, 0);
                                }
                            }
                        }
                }, smem_all, wsid_);
        }
    }
}

__device__ __forceinline__ int moe_prefix(const int* ECNT, int* spre  , int wsid_) {
    if ((TID512 & 255) == 0) { int a = 0; for (int e = 0; e < 32; ++e) { spre[e] = a; a += (ECNT[e] + 127) >> 7; } spre[32] = a; }
    __syncthreads();
    return spre[32];
}
__device__ void phase_expert1(KP p, int wsid_, int layer, int bid, int nb, char* smem) {
    PHASE_PROLOGUE
    const bfu* H = (const bfu*)(ws_ + WS_H); const bfu* W1 = (const bfu*)(ws_ + WS_W1); const bfu* W3 = (const bfu*)(ws_ + WS_W3);
    bfu* HB = (bfu*)(ws_ + WS_HB);
    const int* ECNT = (const int*)(ws_ + WS_ECNT) + layer * 32; const int* ELIST = (const int*)(ws_ + WS_ELIST);
    int* spre = (int*)(smem + 65536);
    const int nblk = moe_prefix(ECNT, spre, wsid_);
    const int nitems = nblk * 8;
    for (int it = bid; it < nitems; it += nb) {
        const int blk = it >> 3, nt = it & 7;
        int e = 0;
        while (spre[e + 1] <= blk) ++e;
        const int rb = blk - spre[e], cnt = ECNT[e];
        const int* lst = ELIST + (size_t)e * (2 * MA) + rb * 128;
        const int nvalid = min(128, cnt - rb * 128);
        const bfu* w1 = W1 + (size_t)e * FF * DM; const bfu* w3 = W3 + (size_t)e * FF * DM;
        bfu* hb = HB + (size_t)blk * 128 * FF;
        gemm_tile([&](int r) { const int tok = r < nvalid ? (lst[r] >> 1) : 0; return H + (size_t)tok * DM; },
                  [&](int r) { const int wcx = r >> 6, n4 = (r >> 4) & 3, rr = r & 15; const int hc = nt * 64 + wcx * 32 + (n4 & 1) * 16 + rr; return (n4 < 2 ? w1 : w3) + (size_t)hc * DM; }, DM,
            [&](f32x4 (&acc)[4][4], int wr, int wc, int fr, int fq) {
#pragma unroll
                for (int m = 0; m < 4; ++m)
#pragma unroll
                    for (int n = 0; n < 2; ++n)
#pragma unroll
                        for (int jj = 0; jj < 4; ++jj) {
                            const int row = wr * 64 + m * 16 + fq * 4 + jj; const int hc = nt * 64 + wc * 32 + n * 16 + fr;
                            const float a = acc[m][n][jj], g = acc[m][n + 2][jj];
                            hb[(size_t)row * FF + hc] = f2bf(siluf_(a) * g);
                        }
            }, smem, wsid_);
    }
}
__device__ void phase_expert2(KP p, int wsid_, int layer, int bid, int nb, char* smem) {
    PHASE_PROLOGUE
    const bfu* HB = (const bfu*)(ws_ + WS_HB); const bfu* W2 = (const bfu*)(ws_ + WS_W2);
    float* Y = (float*)(ws_ + WS_Y01);
    const int* ECNT = (const int*)(ws_ + WS_ECNT) + layer * 32; const int* ELIST = (const int*)(ws_ + WS_ELIST); const float* EGATE = (const float*)(ws_ + WS_EGATE);
    int* spre = (int*)(smem + 65536);
    const int nblk = moe_prefix(ECNT, spre, wsid_);
    const int nitems = nblk * 8;
    for (int it = bid; it < nitems; it += nb) {
        const int blk = it >> 3, nt = it & 7;
        int e = 0;
        while (spre[e + 1] <= blk) ++e;
        const int rb = blk - spre[e], cnt = ECNT[e];
        const int* lst = ELIST + (size_t)e * (2 * MA) + rb * 128;
        const int nvalid = min(128, cnt - rb * 128);
        const bfu* w2 = W2 + (size_t)e * DM * FF;
        const bfu* hb = HB + (size_t)blk * 128 * FF;
        gemm_tile([&](int r) { return hb + (size_t)r * FF; }, [&](int r) { return w2 + (size_t)(nt * 128 + r) * FF; }, FF,
            [&](f32x4 (&acc)[4][4], int wr, int wc, int fr, int fq) {
#pragma unroll
                for (int m = 0; m < 4; ++m)
#pragma unroll
                    for (int jj = 0; jj < 4; ++jj) {
                        const int row = wr * 64 + m * 16 + fq * 4 + jj;
                        if (row < nvalid) {
                            const int ent = lst[row]; const float gt = EGATE[ent];
                            float* yp = Y + ((size_t)(ent & 1) * MA + (ent >> 1)) * DM + nt * 128 + wc * 64 + fr;
#pragma unroll
                            for (int n = 0; n < 4; ++n) yp[n * 16] = gt * acc[m][n][jj];
                        }
                    }
            }, smem, wsid_);
    }
}

#define XB_TMO      128
#define XB_XCNT(j)  (256  + 64 * (j))
#define XB_XSUB(j)  (1280 + 64 * (j))
#define XB_XGEN(j)  (2304 + 64 * (j))
#define XB_TOP      3328
#define XB_TOPGEN   3392
#define XCD_BAR_WORDS 3456
#define XB_SPIN_CAP (1u << 22)
#define LAS __attribute__((address_space(3)))

__device__ __forceinline__ unsigned xb_ld(unsigned* p)              { return __hip_atomic_load(p, __ATOMIC_RELAXED, __HIP_MEMORY_SCOPE_AGENT); }
__device__ __forceinline__ unsigned xb_add(unsigned* p, unsigned v) { return __hip_atomic_fetch_add(p, v, __ATOMIC_RELAXED, __HIP_MEMORY_SCOPE_AGENT); }
__device__ __forceinline__ unsigned xb_xcc_id() { return (unsigned)__builtin_amdgcn_s_getreg((3 << 11) | 20) & 0xFu; }
#define XB_SPIN(cond, bar) do { unsigned _sp = 0; while (cond) { __builtin_amdgcn_s_sleep(1); \
    if ((++_sp & 255u) == 0u) { if (xb_ld(&(bar)[XB_TMO])) break; if (_sp > XB_SPIN_CAP) { atomicAdd(&(bar)[XB_TMO], 1u); break; } } } } while (0)

struct XcdBarrier {
    unsigned* bar; unsigned x;
    volatile LAS unsigned* st;
};

__device__ __forceinline__ XcdBarrier xcd_barrier_post(unsigned* bar, volatile LAS unsigned* st, int wsid_) {
    XcdBarrier b; b.bar = bar; b.x = xb_xcc_id(); b.st = st;
    if (TID512 == 0) (void)xb_add(&bar[XB_XCNT(b.x)], 1u);
    return b;
}
__device__ __forceinline__ void xcd_barrier_complete(unsigned* bar, unsigned x, unsigned& nloc, unsigned& nx) {
    const unsigned G = gridDim.x * gridDim.y * gridDim.z;
    unsigned sum, cnt, mine, sp = 0u;
    for (;;) {
        sum = 0u; cnt = 0u; mine = 0u;
#pragma unroll
        for (unsigned j = 0; j < 16; ++j) { const unsigned c = xb_ld(&bar[XB_XCNT(j)]); sum += c; cnt += (c > 0u) ? 1u : 0u; mine = (j == x) ? c : mine; }
        if (sum == G) break;
        __builtin_amdgcn_s_sleep(1);
        if ((++sp & 255u) == 0u) { if (xb_ld(&bar[XB_TMO])) break; if (sp > XB_SPIN_CAP) { atomicAdd(&bar[XB_TMO], 1u); break; } }
    }
    nloc = mine > 0u ? mine : 1u; nx = cnt > 0u ? cnt : 1u;
}

__device__ __forceinline__ void xcd_barrier_(const XcdBarrier& b, int wsid_) {
    asm volatile("s_waitcnt vmcnt(0)" ::: "memory");
    __syncthreads();
    if (TID512 == 0) {
        unsigned* bar = b.bar;
        __builtin_amdgcn_s_waitcnt(0);
        unsigned nloc = b.st[0], nx = b.st[1];
        if (nloc == 0u) { xcd_barrier_complete(bar, b.x, nloc, nx); b.st[0] = nloc; b.st[1] = nx; }
        const unsigned old = xb_add(&bar[XB_XSUB(b.x)], 1u);
        const unsigned gen = old / nloc;
        if (old + 1u == (gen + 1u) * nloc) {
            __builtin_amdgcn_fence(__ATOMIC_RELEASE, "agent");
            asm volatile("s_waitcnt vmcnt(0)" ::: "memory");
            const unsigned og = xb_add(&bar[XB_TOP], 1u);
            const unsigned tg = og / nx;
            if (og + 1u == (tg + 1u) * nx) xb_add(&bar[XB_TOPGEN], 1u);
            else XB_SPIN(xb_ld(&bar[XB_TOPGEN]) == tg, bar);
            __builtin_amdgcn_fence(__ATOMIC_ACQUIRE, "agent");
            xb_add(&bar[XB_XGEN(b.x)], 1u);
            asm volatile("s_waitcnt vmcnt(0)" ::: "memory");
        } else {
            XB_SPIN(xb_ld(&bar[XB_XGEN(b.x)]) == gen, bar);
            __builtin_amdgcn_fence(__ATOMIC_ACQUIRE, "agent");
            asm volatile("s_waitcnt vmcnt(0)" ::: "memory");
        }
    }
    __syncthreads();
}


#define REP_MOD 1
#define REP_OUTPROJ 1
#define REP_ROUTE 1
#define REP_NORM1 1
#define REP_CONV 1
#define REP_INPROJ 1
#define REP_RK 1
#define REP_SCANATT 1
#define REP_R4 1
#define REP_ATT 1
#define REP_READOUT 1
#define REP_EXP1 1
#define REP_EXP2 1
#define REPEAT(N) _Pragma("nounroll") for (int rep_ = 0; rep_ < (N); ++rep_)
#define REPEAT2(N) _Pragma("nounroll") for (int rep2_ = 0; rep2_ < (N); ++rep2_)
#define CTL_Q(l) (4096 + 64 * (l))
#define CTL_XR 5120
#define CTL_RBC 6144
__global__ void __launch_bounds__(512, 2) fwd(P p) {
    __shared__ __attribute__((aligned(16))) char smem_all[2 * SMEM_BYTES + 64];
    const int wsid_ = __builtin_amdgcn_readfirstlane((int)(threadIdx.x >> 6));
    const int hb = wsid_ >> 2;
    char* smem = smem_all + hb * SMEM_BYTES;
    uint4& xb_words = *(uint4*)(smem_all + 2 * SMEM_BYTES);
    int& s_item = *(int*)(smem_all + 2 * SMEM_BYTES + 16);
    int& s_vb = *(int*)(smem_all + 2 * SMEM_BYTES + 20);
    if (TID512 == 0) xb_words = make_uint4(0u, 0u, 0u, 0u);
    __syncthreads();
    unsigned* ctl = (unsigned*)(KPARG.ws + WS_CTL);
    XcdBarrier bar = xcd_barrier_post(ctl, (volatile LAS unsigned*)&xb_words, wsid_);
#define xcd_barrier(b_) xcd_barrier_(b_, wsid_)
    const int bid = blockIdx.x * 2 + hb, nb = gridDim.x * 2;
    const unsigned my_xcc = xb_xcc_id();
    if (TID512 == 0) s_vb = (int)atomicAdd(&ctl[CTL_XR + 16 * my_xcc], 1u);
    int vb = bid;
    phase_setup(KPARG, wsid_, bid, nb);
    REPEAT(REP_MOD) phase_mod(KPARG, wsid_, bid, nb, smem);
    for (int l = 0; l < NLAYER; ++l) {
        const int nr = l < NLAYER - 1 ? MA : ML;
        REPEAT(REP_CONV) phase_conv(KPARG, wsid_, l, bid, nb, smem);
        if (l == 0) {
            xcd_barrier(bar);
            if (TID512 == 0) { int pre = 0; for (unsigned x = 0; x < my_xcc; ++x) pre += (int)xb_ld(&ctl[CTL_XR + 16 * x]); s_vb += pre; }
            __syncthreads();
            vb = __builtin_amdgcn_readfirstlane(s_vb) * 2 + hb;
        }
        phase_norm1(KPARG, wsid_, l, 0, bid, nb);
        REPEAT(REP_NORM1 - 1) { xcd_barrier(bar); phase_norm1(KPARG, wsid_, l, 0, bid, nb, false); }
        xcd_barrier(bar);
        REPEAT(REP_INPROJ) { phase_inproj256(KPARG, wsid_, l, vb >> 1, nb >> 1, smem_all, ctl + CTL_Q(l) + 8, &s_item); xcd_barrier(bar); }
        REPEAT(REP_RK) { phase_rk(KPARG, wsid_, l, bid, nb, smem); xcd_barrier(bar); }
        REPEAT(REP_SCANATT) {
            if (bid < 128) { REPEAT(REP_R4) phase_r4(KPARG, wsid_, l, bid, 128, smem); }
            else phase_gate(KPARG, wsid_, l, bid - 128, nb - 128, smem);
            REPEAT2(REP_ATT) phase_attn(KPARG, wsid_, l, l < NLAYER - 1, ctl + CTL_Q(l) + 16 * rep_ + 32 * rep2_, l < NLAYER - 1 ? nullptr : ctl + CTL_Q(l) + 8, &s_item, smem);
            xcd_barrier(bar);
        }
        REPEAT(REP_READOUT) { phase_readout(KPARG, wsid_, l, nr, bid, nb); xcd_barrier(bar); }
        phase_outproj256(KPARG, wsid_, l, nr, vb >> 1, nb >> 1, smem_all, ctl + CTL_Q(l) + 8, &s_item);
        REPEAT(REP_OUTPROJ - 1) { xcd_barrier(bar); phase_outproj256(KPARG, wsid_, l, nr, vb >> 1, nb >> 1, smem_all, ctl + CTL_Q(l) + 8, &s_item, 0.f); }
        xcd_barrier(bar);
        phase_norm2_route(KPARG, wsid_, l, nr, bid, nb, smem);
        phase_conv_drain(KPARG, wsid_, l, ctl + CTL_Q(l) + 8, &s_item, smem);
        REPEAT(REP_ROUTE - 1) { xcd_barrier(bar); phase_norm2_route(KPARG, wsid_, l, nr, bid, nb, smem, true); }
        xcd_barrier(bar);
        phase_experts256(KPARG, wsid_, l, vb >> 1, nb >> 1, ctl + CTL_RBC + 256 * l, smem_all);
        xcd_barrier(bar);
    }
    phase_norm1(KPARG, wsid_, NLAYER, 1, bid, nb);
}

extern "C" void kernel_launch(void* const* d_in, const int* in_sizes, int n_in, void* d_out, int out_size, void* d_ws, size_t ws_size, hipStream_t stream) {
    if (n_in != 36 || ws_size < WS_END) { fprintf(stderr, "kernel_launch: unexpected n_in %d or ws_size %zu < %zu\n", n_in, ws_size, (size_t)WS_END); return; }
    static int grid = 0;
    if (!grid) {
        int dev = 0, cus = 0, per_cu = 0;
        hipGetDevice(&dev);
        hipDeviceGetAttribute(&cus, hipDeviceAttributeMultiprocessorCount, dev);
        hipOccupancyMaxActiveBlocksPerMultiprocessor(&per_cu, (const void*)fwd, 512, 0);
        if (per_cu < 1) per_cu = 1;
        grid = cus;
    }
    P p{};
    const float** pp = (const float**)&p;
    for (int i = 0; i < 36; ++i) pp[i] = (const float*)d_in[i];
    p.out = (float*)d_out; p.ws = (char*)d_ws;
    hipMemsetAsync((char*)d_ws + WS_CTL, 0, 65536, stream);
    fwd<<<grid, 512, 0, stream>>>(p);
}
```

```cpp
#include <hip/hip_runtime.h>
#include <stdint.h>
#include <stdio.h>

typedef unsigned short bfu;
using bf16x8 = __attribute__((ext_vector_type(8))) short;
using f32x4  = __attribute__((ext_vector_type(4))) float;

#define DM 1024
#define NB 8
#define SEQ 2048
#define CL 256
#define NKEY 2304
#define ML 16384
#define MC 2048
#define MA 18432
#define INW 3200
#define CSL 1920
#define NEXP 32
#define FF 512
#define NLAYER 4
#define LOG2E 1.4426950408889634f

#define MBy(x) ((size_t)(x) << 20)
constexpr size_t WS_CTL   = 0;
constexpr size_t WS_MOD   = 65536;
constexpr size_t WS_ROPE  = WS_MOD + (size_t)4 * 9 * 6144 * 4;
constexpr size_t WS_ECNT  = WS_ROPE + 64 * 16 * 2 * 4 + 64 * 8 * 2 * 4;
constexpr size_t WS_WRT   = WS_ECNT + 4096;
constexpr size_t WS_WRTH  = WS_WRT + (size_t)48 * 1024 * 4;
constexpr size_t WS_WRTL  = WS_WRTH + (size_t)48 * 1024 * 2;
constexpr size_t WS_EIDX  = WS_WRTL + (size_t)48 * 1024 * 2;
constexpr size_t WS_EGATE = WS_EIDX + (size_t)MA * 2 * 4;
constexpr size_t WS_ELIST = WS_EGATE + (size_t)MA * 2 * 4;
constexpr size_t WS_X     = MBy(8);
constexpr size_t WS_H     = WS_X + (size_t)MA * DM * 4;
constexpr size_t WS_WIN   = WS_H + (size_t)MA * DM * 2;
constexpr size_t WS_WOUT  = WS_WIN + (size_t)INW * DM * 2;
constexpr size_t WS_W1    = WS_WOUT + (size_t)DM * DM * 2;
constexpr size_t WS_W3    = WS_W1 + (size_t)NEXP * FF * DM * 2;
constexpr size_t WS_W2    = WS_W3 + (size_t)NEXP * FF * DM * 2;
constexpr size_t WS_LW2   = WS_W2 + (size_t)NEXP * FF * DM * 2;
constexpr size_t WS_LA2   = WS_LW2 + (size_t)2 * 512 * 64 * 2;
constexpr size_t WS_LG2   = WS_LA2 + (size_t)2 * 512 * 64 * 2;
constexpr size_t WS_QA    = WS_LG2 + (size_t)512 * 128 * 2;
constexpr size_t WS_KA    = WS_QA + (size_t)NB * 4 * NKEY * 64 * 2;
constexpr size_t WS_VAT   = WS_KA + (size_t)NB * 2 * NKEY * 64 * 2;
constexpr size_t WS_QB    = WS_VAT + (size_t)NB * 2 * NKEY * 64 * 2;
constexpr size_t WS_KB    = WS_QB + (size_t)NB * 4 * NKEY * 64 * 2;
constexpr size_t WS_VBT   = WS_KB + (size_t)NB * 4 * NKEY * 64 * 2;
constexpr size_t WS_CP    = WS_VBT + (size_t)NB * 4 * NKEY * 64 * 2;
constexpr size_t WS_GG    = WS_CP + (size_t)MA * CSL * 4;
constexpr size_t WS_MIX   = WS_GG + (size_t)MA * 512 * 4;
constexpr size_t HEADARR  = (size_t)NB * 8 * NKEY * 64 * 4;
#define OPS_REC 13568
constexpr size_t OPS_DIR  = (size_t)64 * 144 * OPS_REC;
constexpr size_t WS_OPS   = WS_MIX + (size_t)MA * DM * 2;
constexpr size_t WS_YS    = WS_OPS + 2 * OPS_DIR;
constexpr size_t WS_VB    = WS_YS + 2 * HEADARR;
constexpr size_t WS_BETA  = WS_VB + (size_t)MA * 512 * 2;
constexpr size_t WS_LXG   = WS_BETA + (size_t)2 * MA * 8 * 4;
constexpr size_t WS_SCR   = WS_LXG + (size_t)MA * 128 * 2;
constexpr size_t WS_END   = WS_SCR + (size_t)256 * 2 * 128 * 132 * 4;
constexpr size_t WS_Y01   = WS_OPS;
constexpr size_t WS_HB    = WS_OPS + (size_t)2 * MA * DM * 4;
static_assert((size_t)2 * MA * DM * 4 + (size_t)(2 * MA + 32 * 256) * 512 * 2 <= 2 * OPS_DIR, "MoE buffers must fit in OPS");

struct P {
    const float *x, *c, *ctx, *c_ctx, *w_mod, *b_mod, *g_mix, *g_ffn, *w_in, *a_q_gain, *a_k_gain, *b_lq1, *b_lk1, *b_lq2, *b_lk2, *b_subln,
        *c_mu, *c_w0, *c_w2, *c_a0, *c_a2, *c_g2, *c_k_k, *c_k_a, *c_r_k, *c_ln_w, *c_ln_b, *w_out, *r_w_group, *r_b_group, *r_w_expert, *r_b_expert,
        *e_w1, *e_w3, *e_w2, *g_final;
    float* out;
    char* ws;
};

typedef const __attribute__((address_space(4))) P& KP;
#define KPARG (*({ const __attribute__((address_space(4))) P* k_ = (const __attribute__((address_space(4))) P*)__builtin_amdgcn_kernarg_segment_ptr(); asm volatile("" : "+s"(k_)); k_; }))

__device__ __forceinline__ float bf2f(bfu b) { return __uint_as_float((unsigned)b << 16); }
__device__ __forceinline__ unsigned pack2(float a, float b) {
    typedef float f2 __attribute__((ext_vector_type(2)));
    typedef __bf16 b2 __attribute__((ext_vector_type(2)));
    f2 v = {a, b}; b2 r = __builtin_convertvector(v, b2); return __builtin_bit_cast(unsigned, r);
}
__device__ __forceinline__ bfu f2bf(float a) { return (bfu)(pack2(a, 0.f) & 0xFFFFu); }
__device__ __forceinline__ int lane_id_() { int l; asm volatile("v_mbcnt_lo_u32_b32 %0, -1, 0\n\tv_mbcnt_hi_u32_b32 %0, -1, %0" : "=v"(l)); return l; }
__device__ __forceinline__ float shfl_xor_(float v, int o) { return __int_as_float(__builtin_amdgcn_ds_bpermute((lane_id_() ^ o) << 2, __float_as_int(v))); }
template <int CTRL> __device__ __forceinline__ float dppf(float v) { return __int_as_float(__builtin_amdgcn_update_dpp(0, __float_as_int(v), CTRL, 0xF, 0xF, true)); }
__device__ __forceinline__ float sum8(float v) { v += dppf<0xB1>(v); v += dppf<0x4E>(v); v += dppf<0x141>(v); return v; }
__device__ __forceinline__ float xor16_sum(float v) { const auto r = __builtin_amdgcn_permlane16_swap(__float_as_uint(v), __float_as_uint(v), false, false); return __uint_as_float(r[0]) + __uint_as_float(r[1]); }
__device__ __forceinline__ float xor32_sum(float v) { const auto r = __builtin_amdgcn_permlane32_swap(__float_as_uint(v), __float_as_uint(v), false, false); return __uint_as_float(r[0]) + __uint_as_float(r[1]); }
__device__ __forceinline__ float xor32_max(float v) { const auto r = __builtin_amdgcn_permlane32_swap(__float_as_uint(v), __float_as_uint(v), false, false); return fmaxf(__uint_as_float(r[0]), __uint_as_float(r[1])); }
__device__ __forceinline__ float sum64(float v) { v = sum8(v); v += dppf<0x140>(v); v = xor16_sum(v); return xor32_sum(v); }
__device__ __forceinline__ float sigmoidf_(float x) { return __builtin_amdgcn_rcpf(1.f + __expf(-x)); }
__device__ __forceinline__ float siluf_(float x) { return x * __builtin_amdgcn_rcpf(1.f + __expf(-x)); }
__device__ __forceinline__ void row_info(int grow, int& b, int& j, int& s) {
    if (grow < ML) { b = grow >> 11; j = 256 + (grow & 2047); s = b; }
    else { int r = grow - ML; b = r >> 8; j = r & 255; s = 8; }
}
__device__ __forceinline__ int grow_of(int b, int j) { return j < 256 ? ML + b * 256 + j : b * 2048 + (j - 256); }

#define SMEM_BYTES 69632

#define TID512 ((wsid_ << 6) | lane_id_())
#define PHASE_PROLOGUE int tid_ = ((wsid_ & 3) << 6) | lane_id_(); asm volatile("" : "+v"(tid_)); const int hb_ = wsid_ >> 2; (void)hb_; \
    int z_ = 0; asm volatile("" : "+v"(z_)); char* ws_ = p.ws + __builtin_amdgcn_readfirstlane(z_);

__device__ void phase_setup(KP p, int wsid_, int bid, int nb) {
    PHASE_PROLOGUE
    if (bid == 0) {
        float* TA = (float*)(ws_ + WS_ROPE); float* TB = TA + 64 * 16 * 2;
        for (int i = tid_; i < 64 * 16; i += 256) { int pos = i >> 4, f = i & 15; double inv = pow(10000.0, -(double)f / 16.0); double a = (double)pos * inv; TA[i * 2] = (float)cos(a); TA[i * 2 + 1] = (float)sin(a); }
        for (int i = tid_; i < 64 * 8; i += 256) { int pos = i >> 3, f = i & 7; double inv = pow(10000.0, -(double)f / 8.0); double a = (double)pos * inv; TB[i * 2] = (float)cos(a); TB[i * 2 + 1] = (float)sin(a); }
        int* ec = (int*)(ws_ + WS_ECNT);
        for (int i = tid_; i < 128; i += 256) ec[i] = 0;
    }
}

__device__ void phase_mod(KP p, int wsid_, int bid, int nb, char* smem) {
    PHASE_PROLOGUE
    float* act = (float*)smem;
    float* red = act + 9 * 1024;
    {
        float4 cv_[9];
#pragma unroll
        for (int k = 0; k < 8; ++k) cv_[k] = *(const float4*)(p.c + (size_t)(tid_ + 256 * k) * 4);
        cv_[8] = *(const float4*)(p.c_ctx + (size_t)tid_ * 4);
#pragma unroll
        for (int k = 0; k < 9; ++k) *(float4*)(act + (size_t)(tid_ + 256 * k) * 4) = make_float4(siluf_(cv_[k].x), siluf_(cv_[k].y), siluf_(cv_[k].z), siluf_(cv_[k].w));
    }
    __syncthreads();
    float* mod = (float*)(ws_ + WS_MOD);
    const int nitems = 4 * 6144 / 64;
    const int ct = tid_ & 15, kg = tid_ >> 4, wv = tid_ >> 6;
    for (int it = bid; it < nitems; it += nb) {
        const int layer = it / 96, n0 = (it % 96) * 64;
        const float* w = p.w_mod + (size_t)layer * DM * 6144 + (size_t)(kg * 64) * 6144 + n0 + ct * 4;
        float a[9][4];
#pragma unroll
        for (int s = 0; s < 9; ++s) { a[s][0] = 0.f; a[s][1] = 0.f; a[s][2] = 0.f; a[s][3] = 0.f; }
#pragma unroll 1
        for (int k0 = 0; k0 < 64; k0 += 16) {
            float4 wq[16];
#pragma unroll
            for (int j = 0; j < 16; ++j) wq[j] = *(const float4*)(w + (size_t)(k0 + j) * 6144);
#pragma unroll
            for (int j4 = 0; j4 < 4; ++j4)
#pragma unroll
                for (int s = 0; s < 9; ++s) {
                    const float4 av = *(const float4*)(act + s * 1024 + kg * 64 + k0 + j4 * 4);
                    const float avv[4] = {av.x, av.y, av.z, av.w};
#pragma unroll
                    for (int e = 0; e < 4; ++e) { const float4 q = wq[j4 * 4 + e]; a[s][0] += avv[e] * q.x; a[s][1] += avv[e] * q.y; a[s][2] += avv[e] * q.z; a[s][3] += avv[e] * q.w; }
                }
        }
#pragma unroll
        for (int s = 0; s < 9; ++s)
#pragma unroll
            for (int c = 0; c < 4; ++c) { a[s][c] = xor32_sum(xor16_sum(a[s][c])); }
        if ((tid_ & 63) < 16) {
#pragma unroll
            for (int s = 0; s < 9; ++s) *(float4*)(red + (wv * 9 + s) * 64 + ct * 4) = make_float4(a[s][0], a[s][1], a[s][2], a[s][3]);
        }
        __syncthreads();
        for (int i = tid_; i < 9 * 64; i += 256) {
            const int s = i >> 6, c2 = i & 63, n2 = n0 + c2;
            float v = red[(0 * 9 + s) * 64 + c2] + red[(1 * 9 + s) * 64 + c2] + red[(2 * 9 + s) * 64 + c2] + red[(3 * 9 + s) * 64 + c2];
            mod[((size_t)layer * 9 + s) * 6144 + n2] = v + p.b_mod[layer * 6144 + n2];
        }
        __syncthreads();
    }
}

__device__ __forceinline__ void conv_tile(const float* src, int K, int N, bfu* dst, int k0, int n0, float* ts, int tid_) {
    const int t = tid_;
    {
        const int kk = t >> 4, n4 = (t & 15) * 4;
        float4 v[4];
#pragma unroll
        for (int pz = 0; pz < 4; ++pz) v[pz] = *(const float4*)(src + (size_t)(k0 + kk + 16 * pz) * N + n0 + n4);
        asm volatile("" : "+v"(v[0].x), "+v"(v[0].y), "+v"(v[0].z), "+v"(v[0].w), "+v"(v[1].x), "+v"(v[1].y), "+v"(v[1].z), "+v"(v[1].w),
                          "+v"(v[2].x), "+v"(v[2].y), "+v"(v[2].z), "+v"(v[2].w), "+v"(v[3].x), "+v"(v[3].y), "+v"(v[3].z), "+v"(v[3].w) :: "memory");
#pragma unroll
        for (int pz = 0; pz < 4; ++pz) { float* d = ts + (kk + 16 * pz) * 65 + n4; d[0] = v[pz].x; d[1] = v[pz].y; d[2] = v[pz].z; d[3] = v[pz].w; }
    }
    __syncthreads();
    {
        const int n = t >> 2, kc = (t & 3) * 16;
        unsigned o[8];
#pragma unroll
        for (int i = 0; i < 8; ++i) o[i] = pack2(ts[(kc + 2 * i) * 65 + n], ts[(kc + 2 * i + 1) * 65 + n]);
        uint4* d = (uint4*)(dst + (size_t)(n0 + n) * K + k0 + kc);
        d[0] = make_uint4(o[0], o[1], o[2], o[3]); d[1] = make_uint4(o[4], o[5], o[6], o[7]);
    }
    __syncthreads();
}
__device__ void phase_conv(KP p, int wsid_, int layer, int bid, int nb, char* smem, int parts = 3) {
    PHASE_PROLOGUE
    float* ts = (float*)smem;
    const float* srcs[8]; bfu* dsts[8]; int Ks[8], Ns[8], Bs[8];
    char* ws = ws_;
    srcs[0] = p.w_in + (size_t)layer * DM * INW;  Ks[0] = DM; Ns[0] = INW; Bs[0] = 1;  dsts[0] = (bfu*)(ws + WS_WIN);
    srcs[1] = p.w_out + (size_t)layer * DM * DM;  Ks[1] = DM; Ns[1] = DM;  Bs[1] = 1;  dsts[1] = (bfu*)(ws + WS_WOUT);
    srcs[2] = p.e_w1 + (size_t)layer * NEXP * DM * FF; Ks[2] = DM; Ns[2] = FF; Bs[2] = NEXP; dsts[2] = (bfu*)(ws + WS_W1);
    srcs[3] = p.e_w3 + (size_t)layer * NEXP * DM * FF; Ks[3] = DM; Ns[3] = FF; Bs[3] = NEXP; dsts[3] = (bfu*)(ws + WS_W3);
    srcs[4] = p.e_w2 + (size_t)layer * NEXP * FF * DM; Ks[4] = FF; Ns[4] = DM; Bs[4] = NEXP; dsts[4] = (bfu*)(ws + WS_W2);
    srcs[5] = p.c_w2 + (size_t)layer * 2 * 64 * 512;   Ks[5] = 64; Ns[5] = 512; Bs[5] = 2;   dsts[5] = (bfu*)(ws + WS_LW2);
    srcs[6] = p.c_a2 + (size_t)layer * 2 * 64 * 512;   Ks[6] = 64; Ns[6] = 512; Bs[6] = 2;   dsts[6] = (bfu*)(ws + WS_LA2);
    srcs[7] = p.c_g2 + (size_t)layer * 128 * 512;      Ks[7] = 128; Ns[7] = 512; Bs[7] = 1;  dsts[7] = (bfu*)(ws + WS_LG2);
    if (parts & 1) for (int it = bid; it < 1104; it += nb) {
        int jb, r;
        if (it < 800) { jb = 0; r = it; } else if (it < 1056) { jb = 1; r = it - 800; } else if (it < 1072) { jb = 5; r = it - 1056; } else if (it < 1088) { jb = 6; r = it - 1072; } else { jb = 7; r = it - 1088; }
        const float* src; bfu* dst; int K, N;
        if (jb == 0) { src = srcs[0]; dst = dsts[0]; K = DM; N = INW; } else if (jb == 1) { src = srcs[1]; dst = dsts[1]; K = DM; N = DM; }
        else if (jb == 5) { src = srcs[5]; dst = dsts[5]; K = 64; N = 512; } else if (jb == 6) { src = srcs[6]; dst = dsts[6]; K = 64; N = 512; } else { src = srcs[7]; dst = dsts[7]; K = 128; N = 512; }
        const int tk = K / 64, tn = N / 64, per = tk * tn, bt = r / per, r2 = r % per, kt = r2 / tn, nt = r2 % tn;
        conv_tile(src + (size_t)bt * K * N, K, N, dst + (size_t)bt * K * N, kt * 64, nt * 64, ts, tid_);
    }
    float* wrt = (float*)(ws + WS_WRT);
    const float* wg = p.r_w_group + (size_t)layer * DM * 4; const float* we = p.r_w_expert + (size_t)layer * DM * 32;
    if (parts & 2) for (int i = bid * 256 + tid_; i < 48 * 1024; i += nb * 256) {
        const int r = i >> 10, k = i & 1023;
        const float wv_ = r < 4 ? wg[k * 4 + r] : (r < 36 ? we[k * 32 + (r - 4)] : 0.f);
        wrt[i] = wv_;
        const bfu hi_ = f2bf(wv_);
        ((bfu*)(ws + WS_WRTH))[i] = hi_; ((bfu*)(ws + WS_WRTL))[i] = f2bf(wv_ - bf2f(hi_));
    }
}

__device__ __forceinline__ bool conv_big_step(KP p, int wsid_, char* ws_, int layer, unsigned* qctr, int* s_item, char* smem, int tid_, int hb_) {
    float* ts = (float*)smem;
    __syncthreads();
    if (TID512 == 0) *s_item = (int)atomicAdd(qctr, 1u);
    __syncthreads();
    const int gidx = __builtin_amdgcn_readfirstlane(*s_item);
    if (gidx >= 1536) return false;
    { const int q0 = hb_ * 4;
        const float* sp[4]; bfu* dp[4]; int Ks[4];
        float4 v[4][4];
        const int kk = tid_ >> 4, n4 = (tid_ & 15) * 4;
#pragma unroll
        for (int q = 0; q < 4; ++q) {
            const int it = gidx * 8 + q0 + q, jb = it >> 12, r = it & 4095, bt = r >> 7, r2 = r & 127;
            const float* src; bfu* dst; int K, N;
            if (jb == 0) { src = p.e_w1 + (size_t)layer * NEXP * DM * FF; dst = (bfu*)(ws_ + WS_W1); K = DM; N = FF; }
            else if (jb == 1) { src = p.e_w3 + (size_t)layer * NEXP * DM * FF; dst = (bfu*)(ws_ + WS_W3); K = DM; N = FF; }
            else { src = p.e_w2 + (size_t)layer * NEXP * FF * DM; dst = (bfu*)(ws_ + WS_W2); K = FF; N = DM; }
            const int tn = N >> 6, kt = r2 / tn, nt = r2 % tn;
            const float* s0 = src + (size_t)bt * K * N + (size_t)(kt * 64 + kk) * N + nt * 64 + n4;
#pragma unroll
            for (int pz = 0; pz < 4; ++pz) v[q][pz] = *(const float4*)(s0 + (size_t)(16 * pz) * N);
            Ks[q] = K;
            dp[q] = dst + (size_t)bt * K * N + (size_t)(nt * 64 + (tid_ >> 2)) * K + kt * 64 + (tid_ & 3) * 16;
        }
#pragma unroll
        for (int q = 0; q < 4; ++q)
            asm volatile("" : "+v"(v[q][0].x), "+v"(v[q][0].y), "+v"(v[q][0].z), "+v"(v[q][0].w), "+v"(v[q][1].x), "+v"(v[q][1].y), "+v"(v[q][1].z), "+v"(v[q][1].w),
                              "+v"(v[q][2].x), "+v"(v[q][2].y), "+v"(v[q][2].z), "+v"(v[q][2].w), "+v"(v[q][3].x), "+v"(v[q][3].y), "+v"(v[q][3].z), "+v"(v[q][3].w) :: "memory");
#pragma unroll
        for (int q = 0; q < 4; ++q)
#pragma unroll
            for (int pz = 0; pz < 4; ++pz) { float* d = ts + q * 4160 + (kk + 16 * pz) * 65 + n4; d[0] = v[q][pz].x; d[1] = v[q][pz].y; d[2] = v[q][pz].z; d[3] = v[q][pz].w; }
        __syncthreads();
        {
            const int n = tid_ >> 2, kc = (tid_ & 3) * 16;
#pragma unroll
            for (int q = 0; q < 4; ++q) {
                unsigned o[8];
#pragma unroll
                for (int i = 0; i < 8; ++i) o[i] = pack2(ts[q * 4160 + (kc + 2 * i) * 65 + n], ts[q * 4160 + (kc + 2 * i + 1) * 65 + n]);
                uint4* d = (uint4*)dp[q];
                d[0] = make_uint4(o[0], o[1], o[2], o[3]); d[1] = make_uint4(o[4], o[5], o[6], o[7]);
            }
        }
        __syncthreads();
    }
    return true;
}

__device__ void phase_conv_drain(KP p, int wsid_, int layer, unsigned* cctr, int* s_item, char* smem) {
    PHASE_PROLOGUE
    while (conv_big_step(p, wsid_, ws_, layer, cctr, s_item, smem, tid_, hb_)) {}
}

__device__ void phase_norm1(KP p, int wsid_, int layer, int mode, int bid, int nb, bool combine = true) {
    PHASE_PROLOGUE
    float* X = (float*)(ws_ + WS_X); bfu* H = (bfu*)(ws_ + WS_H);
    const bfu* Y0 = (const bfu*)(ws_ + WS_Y01); const bfu* Y1 = Y0 + (size_t)MA * DM;
    const float* mod = (const float*)(ws_ + WS_MOD);
    const int lane = tid_ & 63, wv = tid_ >> 6;
    const int nrows = mode ? ML : MA;
    if (bid == 0 && mode == 0 && tid_ < 32) ((int*)(ws_ + WS_ECNT))[layer * 32 + tid_] = 0;
    const int nw_ = nb * 4, rpw_ = (nrows + nw_ - 1) / nw_;
    int row = (bid * 4 + wv) * rpw_; const int rend = min(row + rpw_, nrows);
    const bool comb = layer > 0 && combine;
    float4 xn[4]; uint2 yan[4], ybn[4];
#define N1_LOAD(r_) { _Pragma("unroll") for (int c = 0; c < 4; ++c) { const int col = c * 256 + lane * 4; \
        xn[c] = layer > 0 ? *(const float4*)(X + (size_t)(r_) * DM + col) : ((r_) < ML ? *(const float4*)(p.x + (size_t)(r_) * DM + col) : *(const float4*)(p.ctx + (size_t)((r_) - ML) * DM + col)); \
        if (comb) { yan[c] = *(const uint2*)(Y0 + (size_t)(r_) * DM + col); ybn[c] = *(const uint2*)(Y1 + (size_t)(r_) * DM + col); } } }
    int s_cur = -1;
    float4 g1[4], g2[4], g3[4], gc[4];
    if (row < rend) N1_LOAD(row)
    for (; row < rend; ++row) {
        int b, j, s; row_info(row, b, j, s);
        float4 v[4]; uint2 ya[4], yb[4];
#pragma unroll
        for (int c = 0; c < 4; ++c) { v[c] = xn[c]; ya[c] = yan[c]; yb[c] = ybn[c]; }
        if (s != s_cur) {
            s_cur = s;
#pragma unroll
            for (int c = 0; c < 4; ++c) {
                const int col = c * 256 + lane * 4;
                if (comb) gc[c] = *(const float4*)(mod + ((size_t)(layer - 1) * 9 + s) * 6144 + 5 * 1024 + col);
                if (mode) g1[c] = *(const float4*)(p.g_final + col);
                else {
                    g1[c] = *(const float4*)(p.g_mix + layer * DM + col);
                    g2[c] = *(const float4*)(mod + ((size_t)layer * 9 + s) * 6144 + 0 * 1024 + col);
                    g3[c] = *(const float4*)(mod + ((size_t)layer * 9 + s) * 6144 + 1 * 1024 + col);
                }
            }
        }
        if (row + 1 < rend) N1_LOAD(row + 1)
        asm volatile("" ::: "memory");
        float ss = 0.f;
#pragma unroll
        for (int c = 0; c < 4; ++c) {
            float4 xv = v[c];
            if (comb) {
                const float4 a = make_float4(__uint_as_float(ya[c].x << 16), __uint_as_float(ya[c].x & 0xFFFF0000u), __uint_as_float(ya[c].y << 16), __uint_as_float(ya[c].y & 0xFFFF0000u));
                const float4 bq = make_float4(__uint_as_float(yb[c].x << 16), __uint_as_float(yb[c].x & 0xFFFF0000u), __uint_as_float(yb[c].y << 16), __uint_as_float(yb[c].y & 0xFFFF0000u));
                const float4 g = gc[c];
                xv.x += g.x * (a.x + bq.x); xv.y += g.y * (a.y + bq.y); xv.z += g.z * (a.z + bq.z); xv.w += g.w * (a.w + bq.w);
            }
            v[c] = xv; ss += xv.x * xv.x + xv.y * xv.y + xv.z * xv.z + xv.w * xv.w;
        }
        ss = sum64(ss);
        const float rs = rsqrtf(ss * (1.f / 1024.f) + 1e-6f);
#pragma unroll
        for (int c = 0; c < 4; ++c) {
            const int col = c * 256 + lane * 4;
            if (comb && !mode) *(float4*)(X + (size_t)row * DM + col) = v[c];
            if (mode) {
                const float4 g = g1[c];
                float4 o; o.x = v[c].x * rs * g.x; o.y = v[c].y * rs * g.y; o.z = v[c].z * rs * g.z; o.w = v[c].w * rs * g.w;
                *(float4*)(p.out + (size_t)row * DM + col) = o;
            } else {
                const float4 g = g1[c], sh = g2[c], sc = g3[c];
                const float o0 = v[c].x * rs * g.x * (1.f + sc.x) + sh.x, o1 = v[c].y * rs * g.y * (1.f + sc.y) + sh.y;
                const float o2 = v[c].z * rs * g.z * (1.f + sc.z) + sh.z, o3 = v[c].w * rs * g.w * (1.f + sc.w) + sh.w;
                *(uint2*)(H + (size_t)row * DM + col) = make_uint2(pack2(o0, o1), pack2(o2, o3));
            }
        }
    }
}

#define GLDS(gp, lp) __builtin_amdgcn_global_load_lds((const unsigned*)(gp), (__attribute__((address_space(3))) unsigned*)(lp), 16, 0, 0)
__device__ __forceinline__ int swzG(int x) { return (0x78 >> (2 * x)) & 3; }
template <class FA, class FB, class FE>
__device__ __forceinline__ void gemm_tile(FA arow, FB brow, int K, FE epi, char* smem, int wsid_) {
    int tid = TID512 & 255; asm volatile("" : "+v"(tid));
    const int lane = tid & 63, wid = tid >> 6, wr = wid >> 1, wc = wid & 1, fr = lane & 15, fq = lane >> 4;
    const int lrow = tid >> 2, lch = ((tid & 3) ^ swzG((tid >> 4) & 3)) * 8;
    const bfu* ga0 = arow(lrow) + lch; const bfu* ga1 = arow(lrow + 64) + lch;
    const bfu* gb0 = brow(lrow) + lch; const bfu* gb1 = brow(lrow + 64) + lch;
    f32x4 acc[4][4];
#pragma unroll
    for (int m = 0; m < 4; ++m)
#pragma unroll
        for (int n = 0; n < 4; ++n) acc[m][n] = (f32x4){0.f, 0.f, 0.f, 0.f};
    char* lds0 = smem + tid * 16;
#define GEMM_ISSUE(kt_) { char* d_ = lds0 + ((kt_) & 3) * 16384; const int ko_ = (kt_) * 32; \
        GLDS(ga0 + ko_, d_); GLDS(ga1 + ko_, d_ + 4096); GLDS(gb0 + ko_, d_ + 8192); GLDS(gb1 + ko_, d_ + 12288); }
    const int nk = K >> 5;
    __syncthreads();
    GEMM_ISSUE(0)
    if (nk > 1) GEMM_ISSUE(1)
    if (nk > 2) GEMM_ISSUE(2)
    const int offA = (wr * 64 + fr) * 64 + ((fq ^ swzG((fr >> 2) & 3)) * 16), offB = 8192 + (wc * 64 + fr) * 64 + ((fq ^ swzG((fr >> 2) & 3)) * 16);
    for (int kt = 0; kt < nk; ++kt) {
        if (kt + 2 < nk) asm volatile("s_waitcnt vmcnt(8)" ::: "memory");
        else if (kt + 1 < nk) asm volatile("s_waitcnt vmcnt(4)" ::: "memory");
        else asm volatile("s_waitcnt vmcnt(0)" ::: "memory");
        __builtin_amdgcn_s_barrier();
        if (kt + 3 < nk) GEMM_ISSUE(kt + 3)
        const char* st = smem + (kt & 3) * 16384;
        bf16x8 af[4], bfr[4];
#pragma unroll
        for (int m = 0; m < 4; ++m) af[m] = *(const bf16x8*)(st + offA + m * 1024);
#pragma unroll
        for (int n = 0; n < 4; ++n) bfr[n] = *(const bf16x8*)(st + offB + n * 1024);
        __builtin_amdgcn_s_setprio(1);
#pragma unroll
        for (int m = 0; m < 4; ++m)
#pragma unroll
            for (int n = 0; n < 4; ++n) acc[m][n] = __builtin_amdgcn_mfma_f32_16x16x32_bf16(af[m], bfr[n], acc[m][n], 0, 0, 0);
        __builtin_amdgcn_s_setprio(0);
    }
    __syncthreads();
    epi(acc, wr, wc, fr, fq);
}
#define ACC_FOREACH(...)                                                                      \
    _Pragma("unroll") for (int m_ = 0; m_ < 4; ++m_) _Pragma("unroll") for (int n_ = 0; n_ < 4; ++n_) \
    _Pragma("unroll") for (int j_ = 0; j_ < 4; ++j_) {                                        \
        const int row = wr * 64 + m_ * 16 + fq * 4 + j_; const int col = wc * 64 + n_ * 16 + fr; const float val = acc[m_][n_][j_]; __VA_ARGS__ }

__device__ __forceinline__ int lds_byte256(int r, int c) { const int st = (r >> 4) * 2 + (c >> 5), rr = r & 15, cc = c & 31, ob = rr * 64 + cc * 2; return st * 1024 + (ob ^ (((ob >> 9) & 1) << 5)); }
__device__ __forceinline__ void stage_rc256(int b, int& R, int& C) { const int st = b / 1024, sb = b % 1024, swz = sb ^ (((sb >> 9) & 1) << 5); R = (st >> 1) * 16 + swz / 64; C = (st & 1) * 32 + (swz % 64) / 2; }
#define G2_HT 8192
template <int lda, int ldb, int K, class FR, class FE>
__device__ __forceinline__ void gemm256(const bfu* Abase, FR arow, const bfu* B0, const bfu* B1, FE epi, char* shmc, int wsid_) {
    bfu* shm = (bfu*)shmc;
#define G2_SA(b, h) (shm + ((b) * 2 + (h)) * G2_HT)
#define G2_SB(b, h) (shm + (4 + (b) * 2 + (h)) * G2_HT)
    int tx = TID512; asm volatile("" : "+v"(tx));
    int sR, sC; stage_rc256(tx * 16, sR, sC);
    const int ra00 = arow(sR), ra01 = arow(sR + 64), ra10 = arow(128 + sR), ra11 = arow(128 + sR + 64);
#define G2_STAGE_A(P, h, kt) { int r0_ = (h) ? ra10 : ra00, r1_ = (h) ? ra11 : ra01; asm volatile("" : "+v"(r0_), "+v"(r1_)); const size_t ko_ = (size_t)(kt) * 64 + sC; \
        GLDS(Abase + (size_t)r0_ * lda + ko_, (char*)(P) + tx * 16); GLDS(Abase + (size_t)r1_ * lda + ko_, (char*)(P) + tx * 16 + 8192); }
#define G2_STAGE_B(P, h, kt) { int o_ = sR * ldb + sC; asm volatile("" : "+v"(o_)); const bfu* b_ = ((h) ? B1 : B0) + (size_t)(kt) * 64 + o_; GLDS(b_, (char*)(P) + tx * 16); GLDS(b_ + 64 * ldb, (char*)(P) + tx * 16 + 8192); }
    int wid = tx >> 6, lane = tx & 63, wr = wid >> 2, wc = wid & 3, fr = lane & 15, fq = lane >> 4;
#define G2_LDA(dst, b, h) _Pragma("unroll") for (int m = 0; m < 4; ++m) _Pragma("unroll") for (int k = 0; k < 2; ++k) \
        dst[m][k] = *(const bf16x8*)((const char*)G2_SA(b, h) + lds_byte256(wr * 64 + m * 16 + fr, k * 32 + fq * 8))
#define G2_LDB(dst, b, h) _Pragma("unroll") for (int n = 0; n < 2; ++n) _Pragma("unroll") for (int k = 0; k < 2; ++k) \
        dst[n][k] = *(const bf16x8*)((const char*)G2_SB(b, h) + lds_byte256(wc * 32 + n * 16 + fr, k * 32 + fq * 8))
#define G2_MMA(ai, bj, At_, Bt_) { __builtin_amdgcn_s_setprio(1); \
        _Pragma("unroll") for (int m = 0; m < 4; ++m) _Pragma("unroll") for (int n = 0; n < 2; ++n) _Pragma("unroll") for (int k = 0; k < 2; ++k) \
            acc[ai][bj][m][n] = __builtin_amdgcn_mfma_f32_16x16x32_bf16(At_[m][k], Bt_[n][k], acc[ai][bj][m][n], 0, 0, 0); \
        __builtin_amdgcn_s_setprio(0); }
#define G2_WV(n) asm volatile("s_waitcnt vmcnt(" #n ")" ::: "memory")
#define G2_WL(n) asm volatile("s_waitcnt lgkmcnt(" #n ")" ::: "memory")
#define G2_BAR __builtin_amdgcn_s_barrier()
#define G2_SCHED __builtin_amdgcn_sched_barrier(0)
    f32x4 acc[2][2][4][2];
#pragma unroll
    for (int a = 0; a < 2; ++a)
#pragma unroll
        for (int b = 0; b < 2; ++b)
#pragma unroll
            for (int m = 0; m < 4; ++m)
#pragma unroll
                for (int n = 0; n < 2; ++n) acc[a][b][m][n] = (f32x4){0.f, 0.f, 0.f, 0.f};
    bf16x8 At[4][2], Bx0[2][2], Bx1[2][2];
    constexpr int nt = K >> 6;
    __syncthreads();
    G2_STAGE_B(G2_SB(0, 0), 0, 0); G2_STAGE_A(G2_SA(0, 0), 0, 0); G2_STAGE_B(G2_SB(0, 1), 1, 0); G2_STAGE_A(G2_SA(0, 1), 1, 0);
    if (wr == 1) G2_BAR;
    G2_WV(4); G2_BAR;
    G2_STAGE_B(G2_SB(1, 0), 0, 1); G2_STAGE_A(G2_SA(1, 0), 0, 1); G2_STAGE_B(G2_SB(1, 1), 1, 1);
    G2_WV(6); G2_BAR;
    for (int t = 0; t < nt - 2; t += 2) {
        G2_LDB(Bx0, 0, 0); G2_SCHED; G2_LDA(At, 0, 0); G2_STAGE_A(G2_SA(1, 1), 1, t + 1);
        G2_WL(8); G2_BAR; G2_WL(0); G2_MMA(0, 0, At, Bx0); G2_BAR; G2_SCHED;
        G2_LDB(Bx1, 0, 1); G2_STAGE_B(G2_SB(0, 0), 0, t + 2);
        G2_BAR; G2_WL(0); G2_MMA(0, 1, At, Bx1); G2_BAR;
        G2_LDA(At, 0, 1); G2_STAGE_A(G2_SA(0, 0), 0, t + 2);
        G2_BAR; G2_WL(0); G2_MMA(1, 0, At, Bx0); G2_BAR; G2_SCHED;
        G2_STAGE_B(G2_SB(0, 1), 1, t + 2);
        G2_WV(6); G2_BAR; G2_MMA(1, 1, At, Bx1); G2_BAR;
        G2_LDB(Bx0, 1, 0); G2_SCHED; G2_LDA(At, 1, 0); G2_STAGE_A(G2_SA(0, 1), 1, t + 2);
        G2_WL(8); G2_BAR; G2_WL(0); G2_MMA(0, 0, At, Bx0); G2_BAR; G2_SCHED;
        G2_LDB(Bx1, 1, 1); G2_STAGE_B(G2_SB(1, 0), 0, t + 3);
        G2_BAR; G2_WL(0); G2_MMA(0, 1, At, Bx1); G2_BAR;
        G2_LDA(At, 1, 1); G2_STAGE_A(G2_SA(1, 0), 0, t + 3);
        G2_BAR; G2_WL(0); G2_MMA(1, 0, At, Bx0); G2_BAR; G2_SCHED;
        G2_STAGE_B(G2_SB(1, 1), 1, t + 3);
        G2_WV(6); G2_BAR; G2_MMA(1, 1, At, Bx1); G2_BAR;
    }
    tx = TID512; asm volatile("" : "+v"(tx)); stage_rc256(tx * 16, sR, sC); wid = tx >> 6; lane = tx & 63; wr = wid >> 2; wc = wid & 3; fr = lane & 15; fq = lane >> 4;
    { G2_LDB(Bx0, 0, 0); G2_WV(0); G2_LDA(At, 0, 0); G2_STAGE_A(G2_SA(1, 1), 1, nt - 1);
      G2_BAR; G2_WL(0); G2_MMA(0, 0, At, Bx0); G2_BAR;
      G2_LDB(Bx1, 0, 1); G2_BAR; G2_WL(0); G2_MMA(0, 1, At, Bx1); G2_BAR;
      G2_LDA(At, 0, 1); G2_WV(4); G2_BAR; G2_WL(0); G2_MMA(1, 0, At, Bx0); G2_MMA(1, 1, At, Bx1); G2_BAR; }
    { G2_LDB(Bx0, 1, 0); G2_LDA(At, 1, 0); G2_WV(2); G2_BAR; G2_WL(0); G2_MMA(0, 0, At, Bx0); G2_BAR;
      G2_LDB(Bx1, 1, 1); G2_WV(0); G2_BAR; G2_WL(0); G2_MMA(0, 1, At, Bx1); G2_BAR;
      G2_LDA(At, 1, 1); G2_BAR; G2_WL(0); G2_MMA(1, 0, At, Bx0); G2_MMA(1, 1, At, Bx1); G2_BAR; }
    if (wr == 0) G2_BAR;
    __syncthreads();
    epi(acc, wr, wc, fr, fq);
}

__device__ __forceinline__ void inproj_post(KP p, int wsid_, char* ws_, int layer, int row0, int nt, const float* Cs, int tid_) {
    const float* TA = (const float*)(ws_ + WS_ROPE); const float* TB = TA + 64 * 16 * 2;
    const int tid = tid_;
    int b, j0, s; row_info(row0, b, j0, s);
    const bool lat = row0 < ML;
    if (nt <= 2) {
        const int r = tid & 127, hl = tid >> 7;
        const bool isq = nt < 2;
        const float* gain = (isq ? p.a_q_gain : p.a_k_gain) + layer * 64;
        float ss = 0.f;
#pragma unroll
        for (int d4 = 0; d4 < 16; ++d4) { const float4 t4 = *(const float4*)(Cs + r * 132 + hl * 64 + d4 * 4); ss += t4.x * t4.x + t4.y * t4.y + t4.z * t4.z + t4.w * t4.w; }
        const float rs = rsqrtf(ss * (1.f / 64.f) + 1e-6f);
        const float qs = isq ? 0.125f * LOG2E : 1.f;
        bfu* dst = isq ? (bfu*)(ws_ + WS_QA) + (((size_t)b * 4 + (nt * 2 + hl)) * NKEY + j0 + r) * 64
                       : (bfu*)(ws_ + WS_KA) + (((size_t)b * 2 + hl) * NKEY + j0 + r) * 64;
        const int t = (j0 - 256) + r;
#pragma unroll 1
        for (int a = 0; a < 2; ++a) {
            float v[32];
#pragma unroll
            for (int d4 = 0; d4 < 8; ++d4) {
                const float4 t4 = *(const float4*)(Cs + r * 132 + hl * 64 + a * 32 + d4 * 4); const float4 g4 = *(const float4*)(gain + a * 32 + d4 * 4);
                v[d4 * 4] = t4.x * rs * g4.x; v[d4 * 4 + 1] = t4.y * rs * g4.y; v[d4 * 4 + 2] = t4.z * rs * g4.z; v[d4 * 4 + 3] = t4.w * rs * g4.w;
            }
            if (lat) {
                const int pos = a == 0 ? (t >> 6) : (t & 63);
#pragma unroll
                for (int f = 0; f < 16; ++f) {
                    const float cs = TA[(pos * 16 + f) * 2], sn = TA[(pos * 16 + f) * 2 + 1];
                    const float x0 = v[f], x1 = v[16 + f];
                    v[f] = x0 * cs - x1 * sn; v[16 + f] = x1 * cs + x0 * sn;
                }
            }
#pragma unroll
            for (int d8 = 0; d8 < 4; ++d8)
                ((uint4*)dst)[a * 4 + d8] = make_uint4(pack2(v[d8 * 8] * qs, v[d8 * 8 + 1] * qs), pack2(v[d8 * 8 + 2] * qs, v[d8 * 8 + 3] * qs),
                                                       pack2(v[d8 * 8 + 4] * qs, v[d8 * 8 + 5] * qs), pack2(v[d8 * 8 + 6] * qs, v[d8 * 8 + 7] * qs));
        }
    } else if (nt == 3 || nt == 8 || nt == 9) {
        const int c = tid & 127, half = tid >> 7, hl = c >> 6, d = c & 63;
        bfu* dst = nt == 3 ? (bfu*)(ws_ + WS_VAT) + (((size_t)b * 2 + hl) * 64 + d) * NKEY + j0 + half * 64
                           : (bfu*)(ws_ + WS_VBT) + (((size_t)b * 4 + ((nt - 8) * 2 + hl)) * 64 + d) * NKEY + j0 + half * 64;
#pragma unroll
        for (int r8 = 0; r8 < 8; ++r8) {
            const float* s0 = Cs + (half * 64 + r8 * 8) * 132 + c;
            ((uint4*)dst)[r8] = make_uint4(pack2(s0[0], s0[132]), pack2(s0[2 * 132], s0[3 * 132]), pack2(s0[4 * 132], s0[5 * 132]), pack2(s0[6 * 132], s0[7 * 132]));
        }
    } else if (nt <= 7) {
        const bool isq = nt < 6;
        const int hbase = ((nt - 4) & 1) * 2;
#pragma unroll
        for (int itq = 0; itq < 2; ++itq) {
            const int u = tid + 256 * itq, r = u & 127, hm = u >> 7;
            float v[32];
#pragma unroll
            for (int d4 = 0; d4 < 8; ++d4) { const float4 t4 = *(const float4*)(Cs + r * 132 + hm * 32 + d4 * 4); v[d4 * 4] = t4.x; v[d4 * 4 + 1] = t4.y; v[d4 * 4 + 2] = t4.z; v[d4 * 4 + 3] = t4.w; }
            if (lat) {
                const int t = (j0 - 256) + r;
#pragma unroll
                for (int a = 0; a < 2; ++a) {
                    const int pos = a == 0 ? (t >> 6) : (t & 63);
#pragma unroll
                    for (int f = 0; f < 8; ++f) {
                        const float cs = TB[(pos * 8 + f) * 2], sn = TB[(pos * 8 + f) * 2 + 1];
                        const float x0 = v[a * 16 + f], x1 = v[a * 16 + 8 + f];
                        v[a * 16 + f] = x0 * cs - x1 * sn; v[a * 16 + 8 + f] = x1 * cs + x0 * sn;
                    }
                }
            }
            const float qs = isq ? 0.17677669529663687f * LOG2E : 1.f;
            const int h = hbase + (hm >> 1), mp = hm & 1;
            bfu* dst = (bfu*)(ws_ + (isq ? WS_QB : WS_KB)) + (((size_t)b * 4 + h) * NKEY + j0 + r) * 64 + mp * 32;
#pragma unroll
            for (int d8 = 0; d8 < 4; ++d8)
                ((uint4*)dst)[d8] = make_uint4(pack2(v[d8 * 8] * qs, v[d8 * 8 + 1] * qs), pack2(v[d8 * 8 + 2] * qs, v[d8 * 8 + 3] * qs),
                                               pack2(v[d8 * 8 + 4] * qs, v[d8 * 8 + 5] * qs), pack2(v[d8 * 8 + 6] * qs, v[d8 * 8 + 7] * qs));
        }
    } else {
        const int r = tid & 127, half = tid >> 7;
        float* dst = (float*)(ws_ + WS_CP) + (size_t)(row0 + r) * CSL + (nt - 10) * 128 + half * 64;
#pragma unroll
        for (int d4 = 0; d4 < 16; ++d4) ((float4*)dst)[d4] = *(const float4*)(Cs + r * 132 + half * 64 + d4 * 4);
    }
}

__device__ void phase_inproj256(KP p, int wsid_, int layer, int vblk, int nblk, char* smem_all, unsigned* cctr, int* s_item) {
    PHASE_PROLOGUE
    const bfu* H = (const bfu*)(ws_ + WS_H); const bfu* W = (const bfu*)(ws_ + WS_WIN);
    for (int it = vblk; it < 72 * 13; it += nblk) {
        const int mt = (it / 104) * 8 + (it & 7), nt2 = (it >> 3) % 13;
        const int row0 = mt * 256, col0 = nt2 * 256;
        const bfu* B0 = W + (size_t)col0 * DM; const bfu* B1 = (nt2 == 12) ? B0 : B0 + (size_t)128 * DM;
        gemm256<DM, DM, DM>(H, [&](int r) { return row0 + r; }, B0, B1,
            [&](f32x4 (&acc)[2][2][4][2], int wr, int wc, int fr, int fq) {
                if (nt2 >= 5) {
                    const __amdgpu_buffer_rsrc_t rs = __builtin_amdgcn_make_buffer_rsrc((void*)(ws_ + WS_CP), 0, (int)((size_t)MA * CSL * 4), 0x00020000);
                    const int voff = (((wr * 64 + fq * 4) * CSL) + wc * 32 + fr) * 4;
#pragma unroll
                    for (int bj = 0; bj < 2; ++bj) {
                        const int cb = col0 + bj * 128 - 1280;
                        if (cb < CSL) {
#pragma unroll
                            for (int ai = 0; ai < 2; ++ai)
#pragma unroll
                                for (int m = 0; m < 4; ++m)
#pragma unroll
                                    for (int n = 0; n < 2; ++n)
#pragma unroll
                                        for (int j = 0; j < 4; ++j)
                                            __builtin_amdgcn_raw_buffer_store_b32(__float_as_uint(acc[ai][bj][m][n][j]), rs, voff, ((row0 + ai * 128 + m * 16 + j) * CSL + cb + n * 16) * 4, 0);
                        }
                    }
                } else {
                    float* SC = (float*)(ws_ + WS_SCR) + (size_t)blockIdx.x * (2 * 128 * 132);
                    const __amdgpu_buffer_rsrc_t rs = __builtin_amdgcn_make_buffer_rsrc((void*)SC, 0, 2 * 128 * 132 * 4, 0x00020000);
                    const int o0 = (wr * 64 + fq * 4) * 132 + wc * 32 + fr;
#pragma unroll
                    for (int bj = 0; bj < 2; ++bj) {
                        float* Cq = (float*)(smem_all + bj * SMEM_BYTES) + o0;
#pragma unroll
                        for (int m = 0; m < 4; ++m)
#pragma unroll
                            for (int n = 0; n < 2; ++n)
#pragma unroll
                                for (int j = 0; j < 4; ++j) {
                                    Cq[(m * 16 + j) * 132 + n * 16] = acc[0][bj][m][n][j];
                                    __builtin_amdgcn_raw_buffer_store_b32(__float_as_uint(acc[1][bj][m][n][j]), rs, o0 * 4, (bj * 128 * 132 + (m * 16 + j) * 132 + n * 16) * 4, 0);
                                }
                    }
                    __syncthreads();
                    int t2 = TID512 & 255; asm volatile("" : "+v"(t2));
                    float* Ch = (float*)(smem_all + hb_ * SMEM_BYTES);
                    inproj_post(p, wsid_, ws_, layer, row0, nt2 * 2 + hb_, Ch, t2);
                    __syncthreads();
                    { const float4* g4 = (const float4*)(SC + hb_ * (128 * 132)); float4* c4 = (float4*)Ch;
                      float4 q_[16];
#pragma unroll
                      for (int k = 0; k < 16; ++k) q_[k] = g4[t2 + 256 * k];
                      float4 qx_ = make_float4(0.f, 0.f, 0.f, 0.f);
                      if (t2 < 128) qx_ = g4[t2 + 4096];
#pragma unroll
                      for (int k = 0; k < 16; k += 4)
                          asm volatile("" : "+v"(q_[k].x), "+v"(q_[k].y), "+v"(q_[k].z), "+v"(q_[k].w), "+v"(q_[k + 1].x), "+v"(q_[k + 1].y), "+v"(q_[k + 1].z), "+v"(q_[k + 1].w),
                                            "+v"(q_[k + 2].x), "+v"(q_[k + 2].y), "+v"(q_[k + 2].z), "+v"(q_[k + 2].w), "+v"(q_[k + 3].x), "+v"(q_[k + 3].y), "+v"(q_[k + 3].z), "+v"(q_[k + 3].w) :: "memory");
#pragma unroll
                      for (int k = 0; k < 16; ++k) c4[t2 + 256 * k] = q_[k];
                      if (t2 < 128) c4[t2 + 4096] = qx_; }
                    __syncthreads();
                    inproj_post(p, wsid_, ws_, layer, row0 + 128, nt2 * 2 + hb_, Ch, t2);
                    __syncthreads();
                }
            }, smem_all, wsid_);
    }
    if (vblk >= 72 * 13 - 3 * nblk) { for (int q = 0; q < 4; ++q) if (!conv_big_step(p, wsid_, ws_, layer, cctr, s_item, smem_all + hb_ * SMEM_BYTES, tid_, hb_)) break; }
}

__device__ void phase_inproj(KP p, int wsid_, int layer, int bid, int nb, char* smem) {
    PHASE_PROLOGUE
    const bfu* H = (const bfu*)(ws_ + WS_H); const bfu* W = (const bfu*)(ws_ + WS_WIN);
    float* Cs = (float*)smem;
    const int nitems = 144 * 25;
    for (int it = bid; it < nitems; it += nb) {
        const int mt = (it / 200) * 8 + (it / 5) % 8, nt = ((it / 40) % 5) * 5 + it % 5;
        const int row0 = mt * 128, col0 = nt * 128;
        gemm_tile([&](int r) { return H + (size_t)(row0 + r) * DM; }, [&](int r) { return W + (size_t)(col0 + r) * DM; }, DM,
            [&](f32x4 (&acc)[4][4], int wr, int wc, int fr, int fq) {
                ACC_FOREACH(Cs[row * 132 + col] = val;)
            }, smem, wsid_);
        __syncthreads();
        inproj_post(p, wsid_, ws_, layer, row0, nt, Cs, tid_);
        __syncthreads();
    }
}

__device__ void phase_gate(KP p, int wsid_, int layer, int bid, int nb, char* smem) {
    PHASE_PROLOGUE
    const bfu* LXG = (const bfu*)(ws_ + WS_LXG); const bfu* Bt = (const bfu*)(ws_ + WS_LG2);
    float* GG = (float*)(ws_ + WS_GG);
    const int nitems = 144 * 4;
    for (int it = bid; it < nitems; it += nb) {
        const int mt = it >> 2, nt = it & 3, row0 = mt * 128, col0 = nt * 128;
        gemm_tile([&](int r) { return LXG + (size_t)(row0 + r) * 128; }, [&](int r) { return Bt + (size_t)(col0 + r) * 128; }, 128,
            [&](f32x4 (&acc)[4][4], int wr, int wc, int fr, int fq) {
                ACC_FOREACH(GG[(size_t)(row0 + row) * 512 + col0 + col] = val;)
            }, smem, wsid_);
    }
}

#define OPS_AT 0
#define OPS_RT 2048
#define OPS_MAK 4096
#define OPS_T 5120
#define OPS_MRBK 6144
#define OPS_BK 7168
#define OPS_VF 11264
#define OPS_WC 13312
__device__ __forceinline__ char* ops_rec(char* ws_, int z, int seq, int c) { return ws_ + WS_OPS + ((size_t)(z * 64 + seq) * 144 + c) * OPS_REC; }
__device__ __forceinline__ float rdlane(float v, int l) { return __int_as_float(__builtin_amdgcn_readlane(__float_as_int(v), l)); }

__device__ __forceinline__ void chunk_tail(const float (&lw)[16], const float (&kk)[16], const float (&rr)[16], const float (&bb)[16], const float (&kd)[16], const float (&vv)[16],
                                           char* Lw, char* rec, int lane) {
    const int cl = lane & 15, g = lane >> 4;
    float Bt[16], Kt[16];
    float cum = 0.f, ep = 1.f;
#pragma unroll
    for (int t = 0; t < 16; ++t) {
        cum += lw[t];
        const float e = __expf(cum), ei = __expf(-cum);
        *(bfu*)(Lw + 0 + t * 128 + lane * 2) = f2bf(-kk[t] * ep);
        *(bfu*)(Lw + 2048 + t * 128 + lane * 2) = f2bf(rr[t] * e);
        Bt[t] = bb[t] * ei; Kt[t] = kd[t] * ei;
        *(bfu*)(Lw + 4096 + t * 128 + lane * 2) = f2bf(Bt[t]);
        *(bfu*)(Lw + 6144 + t * 128 + lane * 2) = f2bf(Kt[t]);
        ep = e;
    }
    const float eC = ep;
#pragma unroll
    for (int q = 0; q < 4; ++q) {
        *(uint4*)(rec + OPS_BK + ((lane >> 4) * 64 + cl + 16 * q) * 16) =
            make_uint4(pack2(Bt[4 * q] * eC, Bt[4 * q + 1] * eC), pack2(Bt[4 * q + 2] * eC, Bt[4 * q + 3] * eC), pack2(Kt[4 * q] * eC, Kt[4 * q + 1] * eC), pack2(Kt[4 * q + 2] * eC, Kt[4 * q + 3] * eC));
        *(uint2*)(rec + OPS_VF + ((lane >> 4) * 64 + cl + 16 * q) * 8) = make_uint2(pack2(vv[4 * q], vv[4 * q + 1]), pack2(vv[4 * q + 2], vv[4 * q + 3]));
    }
    *(float*)(rec + OPS_WC + lane * 4) = eC;
    f32x4 Mab = {0.f, 0.f, 0.f, 0.f}, Mak = Mab, Mrb = Mab, Mrk = Mab;
#pragma unroll
    for (int ks = 0; ks < 2; ++ks) {
        const int fo = cl * 128 + ks * 64 + g * 16;
        const bf16x8 aA = *(const bf16x8*)(Lw + 0 + fo), aR = *(const bf16x8*)(Lw + 2048 + fo), bB = *(const bf16x8*)(Lw + 4096 + fo), bK = *(const bf16x8*)(Lw + 6144 + fo);
        Mab = __builtin_amdgcn_mfma_f32_16x16x32_bf16(aA, bB, Mab, 0, 0, 0);
        Mak = __builtin_amdgcn_mfma_f32_16x16x32_bf16(aA, bK, Mak, 0, 0, 0);
        Mrb = __builtin_amdgcn_mfma_f32_16x16x32_bf16(aR, bB, Mrb, 0, 0, 0);
        Mrk = __builtin_amdgcn_mfma_f32_16x16x32_bf16(aR, bK, Mrk, 0, 0, 0);
    }
#pragma unroll
    for (int ks = 0; ks < 2; ++ks) {
        const uint2 a0 = *(const uint2*)(Lw + 0 + cl * 128 + (32 * ks + 4 * g) * 2), a1 = *(const uint2*)(Lw + 0 + cl * 128 + (32 * ks + 16 + 4 * g) * 2);
        const uint2 r0 = *(const uint2*)(Lw + 2048 + cl * 128 + (32 * ks + 4 * g) * 2), r1 = *(const uint2*)(Lw + 2048 + cl * 128 + (32 * ks + 16 + 4 * g) * 2);
        *(uint4*)(rec + OPS_AT + (ks * 64 + lane) * 16) = make_uint4(a0.x, a0.y, a1.x, a1.y);
        *(uint4*)(rec + OPS_RT + (ks * 64 + lane) * 16) = make_uint4(r0.x, r0.y, r1.x, r1.y);
    }
#pragma unroll
    for (int q = 0; q < 4; ++q) {
        const int tau = 4 * g + q;
        if (!(cl < tau)) { Mab[q] = 0.f; Mak[q] = 0.f; }
        if (!(cl <= tau)) { Mrb[q] = 0.f; Mrk[q] = 0.f; }
    }
#pragma unroll
    for (int q = 0; q < 4; ++q) *(float*)(Lw + 10240 + (4 * g + q) * 64 + cl * 4) = Mab[q];
    float Tc[16];
#pragma unroll
    for (int t = 0; t < 16; ++t) {
        float acc = (t == cl) ? 1.f : 0.f;
#pragma unroll
        for (int j4 = 0; j4 < (t + 3) / 4; ++j4) {
            const float4 mr = *(const float4*)(Lw + 10240 + t * 64 + j4 * 16);
            const float mm[4] = {mr.x, mr.y, mr.z, mr.w};
#pragma unroll
            for (int e = 0; e < 4; ++e) if (j4 * 4 + e < t) acc += mm[e] * Tc[j4 * 4 + e];
        }
        Tc[t] = acc;
    }
#pragma unroll
    for (int q = 0; q < 4; ++q) {
        const int tau = 4 * g + q;
        *(bfu*)(Lw + 8192 + tau * 32 + cl * 2) = f2bf(Mak[q]);
        *(bfu*)(Lw + 9216 + tau * 32 + cl * 2) = f2bf(Mrb[q]);
        *(bfu*)(Lw + 9728 + tau * 32 + cl * 2) = f2bf(Mrk[q]);
    }
    if (g == 0) {
#pragma unroll
        for (int t = 0; t < 16; ++t) *(bfu*)(Lw + 8704 + t * 32 + cl * 2) = f2bf(Tc[t]);
    }
    const uint2 fmak = *(const uint2*)(Lw + 8192 + cl * 32 + g * 8), ft = *(const uint2*)(Lw + 8704 + cl * 32 + g * 8);
    const uint2 fmrb = *(const uint2*)(Lw + 9216 + cl * 32 + g * 8), fmrk = *(const uint2*)(Lw + 9728 + cl * 32 + g * 8);
    *(uint4*)(rec + OPS_MAK + lane * 16) = make_uint4(fmak.x, fmak.y, 0u, 0u);
    *(uint4*)(rec + OPS_T + lane * 16) = make_uint4(ft.x, ft.y, 0u, 0u);
    *(uint4*)(rec + OPS_MRBK + lane * 16) = make_uint4(fmrb.x, fmrb.y, fmrk.x, fmrk.y);
}

__device__ void phase_rk(KP p, int wsid_, int layer, int bid, int nb, char* smem) {
    PHASE_PROLOGUE
    const int lane = tid_ & 63, wv = tid_ >> 6, cl = lane & 15, g = lane >> 4;
    char* Lw = smem + wv * 16384;
    const float* CP = (const float*)(ws_ + WS_CP);
    const float* mu = p.c_mu + layer * CSL;
    for (int it = bid * 4 + wv; it < 2 * 64 * 144; it += nb * 4) {
        const int c = it % 144, seq = (it / 144) & 63, z = it / (144 * 64), b = seq >> 3, h = seq & 7;
        const int grow0 = c < 16 ? ML + b * 256 + 16 * c : b * 2048 + 16 * (c - 16);
        const bool sstart = (c == 0 || c == 16), send = (c == 15 || c == 143);
        auto ldgrp = [&](int col, float (&P_)[18]) {
#pragma unroll
            for (int q = 0; q < 18; ++q) {
                const int tau = q - 1, nat = z ? 15 - tau : tau;
                const bool ok = (nat >= 0 || !sstart) && (nat <= 15 || !send);
                P_[q] = ok ? CP[(size_t)(grow0 + nat) * CSL + col] : 0.f;
            }
        };
        auto shiftg = [&](int col, const float (&P_)[18], float (&out)[16]) {
            const float m = mu[col];
#pragma unroll
            for (int t = 0; t < 16; ++t) out[t] = P_[t + 1] + m * (0.5f * (P_[t] + P_[t + 2]) - P_[t + 1]);
        };
        float Pw[18], Pa[18], Pr[18], Pk[18], Pv[18];
        ldgrp(1536 + z * 64 + lane, Pw); ldgrp(1664 + z * 64 + lane, Pa); ldgrp(h * 64 + lane, Pr); ldgrp(512 + h * 64 + lane, Pk); ldgrp(1024 + h * 64 + lane, Pv);
        float tmp[16], rr[16], kr[16], vv[16];
        shiftg(1536 + z * 64 + lane, Pw, tmp);
#pragma unroll
        for (int t = 0; t < 16; ++t) *(bfu*)(Lw + 10240 + t * 128 + lane * 2) = f2bf(1.f - 2.f * __builtin_amdgcn_rcpf(1.f + __expf(2.f * tmp[t])));
        shiftg(1664 + z * 64 + lane, Pa, tmp);
#pragma unroll
        for (int t = 0; t < 16; ++t) *(bfu*)(Lw + 12288 + t * 128 + lane * 2) = f2bf(tmp[t]);
        if (z == 0 && lane < 16) {
            float Pg[18]; ldgrp(1792 + h * 16 + lane, Pg); shiftg(1792 + h * 16 + lane, Pg, tmp);
            bfu* LXG = (bfu*)(ws_ + WS_LXG);
#pragma unroll
            for (int t = 0; t < 16; ++t) LXG[(size_t)(grow0 + t) * 128 + h * 16 + lane] = f2bf(sigmoidf_(tmp[t]));
        }
        const bfu* W2 = (const bfu*)(ws_ + WS_LW2) + ((size_t)z * 512 + h * 64) * 64;
        const bfu* A2 = (const bfu*)(ws_ + WS_LA2) + ((size_t)z * 512 + h * 64) * 64;
        bf16x8 wfr[2][2][4];
#pragma unroll
        for (int which = 0; which < 2; ++which)
#pragma unroll
            for (int ks = 0; ks < 2; ++ks)
#pragma unroll
                for (int n = 0; n < 4; ++n) wfr[which][ks][n] = *(const bf16x8*)((which ? A2 : W2) + (size_t)(16 * n + cl) * 64 + ks * 32 + g * 8);
        const int ch = h * 64 + lane;
        float w0v = p.c_w0[((size_t)layer * 2 + z) * 512 + ch], a0v = p.c_a0[((size_t)layer * 2 + z) * 512 + ch];
        float kkv = p.c_k_k[layer * 512 + ch], kav = p.c_k_a[layer * 512 + ch], rkv = p.c_r_k[layer * 512 + ch];
        shiftg(h * 64 + lane, Pr, rr);
        shiftg(512 + h * 64 + lane, Pk, kr);
        shiftg(1024 + h * 64 + lane, Pv, vv);
#pragma unroll
        for (int which = 0; which < 2; ++which)
#pragma unroll
            for (int ks = 0; ks < 2; ++ks)
                asm volatile("" : "+v"(wfr[which][ks][0]), "+v"(wfr[which][ks][1]), "+v"(wfr[which][ks][2]), "+v"(wfr[which][ks][3]) :: "memory");
        asm volatile("" : "+v"(w0v), "+v"(a0v), "+v"(kkv), "+v"(kav), "+v"(rkv));
        float prew[16], prea[16];
#pragma unroll
        for (int which = 0; which < 2; ++which) {
            const char* Xs = Lw + (which ? 12288 : 10240);
            f32x4 ac[4];
#pragma unroll
            for (int n = 0; n < 4; ++n) ac[n] = (f32x4){0.f, 0.f, 0.f, 0.f};
#pragma unroll
            for (int ks = 0; ks < 2; ++ks) {
                const bf16x8 af = *(const bf16x8*)(Xs + cl * 128 + ks * 64 + g * 16);
#pragma unroll
                for (int n = 0; n < 4; ++n) {
                    ac[n] = __builtin_amdgcn_mfma_f32_16x16x32_bf16(af, wfr[which][ks][n], ac[n], 0, 0, 0);
                }
            }
#pragma unroll
            for (int n = 0; n < 4; ++n)
#pragma unroll
                for (int q = 0; q < 4; ++q) *(float*)(Lw + (4 * g + q) * 256 + (16 * n + cl) * 4) = ac[n][q];
#pragma unroll
            for (int t = 0; t < 16; ++t) { const float x = *(const float*)(Lw + t * 256 + lane * 4); if (which) prea[t] = x; else prew[t] = x; }
        }
        float lw[16], kk[16], bb[16];
        float* BETA = (float*)(ws_ + WS_BETA) + (size_t)z * MA * 8;
#pragma unroll
        for (int t = 0; t < 16; ++t) {
            lw[t] = -0.6065306597126334f * sigmoidf_(w0v + prew[t]);
            const float icl = sigmoidf_(a0v + prea[t]);
            const float kv = kr[t] * kkv;
            const float ss = sum64(kv * kv);
            kk[t] = kv * rsqrtf(fmaxf(ss, 1e-24f));
            kr[t] = kr[t] * (1.f + (icl - 1.f) * kav);
            bb[t] = kk[t] * icl;
            const float bs = sum64(rr[t] * kr[t] * rkv);
            const int nat = z ? 15 - t : t;
            if (lane == 0) BETA[(size_t)(grow0 + nat) * 8 + h] = bs;
        }
        if (z == 0) {
            bfu* VB = (bfu*)(ws_ + WS_VB);
#pragma unroll
            for (int t = 0; t < 16; ++t) VB[(size_t)(grow0 + t) * 512 + ch] = f2bf(vv[t]);
        }
        chunk_tail(lw, kk, rr, bb, kr, vv, Lw, ops_rec(ws_, z, seq, c), lane);
    }
}

__device__ __forceinline__ bf16x8 mk8(unsigned a, unsigned b, unsigned c, unsigned d) { union { bf16x8 v; unsigned u[4]; } x; x.u[0] = a; x.u[1] = b; x.u[2] = c; x.u[3] = d; return x.v; }
__device__ __forceinline__ bf16x8 ld8(const char* p) { return *(const bf16x8*)p; }
__device__ __forceinline__ void glds16_asm(const void* gsrc, unsigned lds_dst) {
    unsigned keep;
    asm volatile("s_mov_b32 %0, m0\n\ts_mov_b32 m0, %2\n\ts_nop 0\n\tglobal_load_lds_dwordx4 %1, off\n\ts_mov_b32 m0, %0" : "=&s"(keep) : "v"(gsrc), "s"(lds_dst) : "memory");
}
__device__ void phase_r4(KP p, int wsid_, int layer, int bid, int nb, char* smem) {
    PHASE_PROLOGUE
    const int lane = tid_ & 63, vt = tid_ >> 6, cl = lane & 15, g = lane >> 4;
    for (int it = bid; it < 128; it += nb) {
        const int z = it >> 6, seq = it & 63;
        float* Y = (float*)(ws_ + WS_YS) + (size_t)z * (HEADARR / 4) + (size_t)seq * NKEY * 64;
        const char* recs = ws_ + WS_OPS + (size_t)(z * 64 + seq) * 144 * OPS_REC;
        f32x4 acc[4];
#pragma unroll
        for (int kt = 0; kt < 4; ++kt) acc[kt] = (f32x4){0.f, 0.f, 0.f, 0.f};
        const unsigned lbase = __builtin_amdgcn_readfirstlane((unsigned)(uintptr_t)(__attribute__((address_space(3))) char*)smem + vt * 1024);
#define R4_ISSUE(ci_) { const int c_ = z ? ((ci_) < 16 ? 15 - (ci_) : 143 - ((ci_) - 16)) : (ci_); const char* g_ = recs + (size_t)c_ * OPS_REC + tid_ * 16; const unsigned d_ = lbase + ((ci_) & 3) * OPS_REC; \
            glds16_asm(g_, d_); glds16_asm(g_ + 4096, d_ + 4096); glds16_asm(g_ + 8192, d_ + 8192); if (tid_ < 80) glds16_asm(g_ + 12288, d_ + 12288); }
        __syncthreads();
        R4_ISSUE(0) R4_ISSUE(1) R4_ISSUE(2)
        for (int ci = 0; ci < 144; ++ci) {
            const int c = z ? (ci < 16 ? 15 - ci : 143 - (ci - 16)) : ci;
            if (ci >= 3 && ci <= 141) { if (vt < 2) asm volatile("s_waitcnt vmcnt(20)" ::: "memory"); else asm volatile("s_waitcnt vmcnt(18)" ::: "memory"); }
            else asm volatile("s_waitcnt vmcnt(0)" ::: "memory");
            __builtin_amdgcn_s_barrier();
            if (ci + 3 < 144) R4_ISSUE(ci + 3)
            const char* rec = smem + (ci & 3) * OPS_REC;
            const f32x4 zero4 = {0.f, 0.f, 0.f, 0.f};
            bf16x8 sb[2];
#pragma unroll
            for (int ks = 0; ks < 2; ++ks)
                sb[ks] = mk8(pack2(acc[2 * ks][0], acc[2 * ks][1]), pack2(acc[2 * ks][2], acc[2 * ks][3]), pack2(acc[2 * ks + 1][0], acc[2 * ks + 1][1]), pack2(acc[2 * ks + 1][2], acc[2 * ks + 1][3]));
            const uint2 vf = *(const uint2*)(rec + OPS_VF + (vt * 64 + lane) * 8);
            f32x4 Z = __builtin_amdgcn_mfma_f32_16x16x32_bf16(ld8(rec + OPS_AT + lane * 16), sb[0], zero4, 0, 0, 0);
            Z = __builtin_amdgcn_mfma_f32_16x16x32_bf16(ld8(rec + OPS_AT + (64 + lane) * 16), sb[1], Z, 0, 0, 0);
            Z = __builtin_amdgcn_mfma_f32_16x16x32_bf16(ld8(rec + OPS_MAK + lane * 16), mk8(vf.x, vf.y, 0u, 0u), Z, 0, 0, 0);
            f32x4 Yv = __builtin_amdgcn_mfma_f32_16x16x32_bf16(ld8(rec + OPS_RT + lane * 16), sb[0], zero4, 0, 0, 0);
            Yv = __builtin_amdgcn_mfma_f32_16x16x32_bf16(ld8(rec + OPS_RT + (64 + lane) * 16), sb[1], Yv, 0, 0, 0);
            const f32x4 U = __builtin_amdgcn_mfma_f32_16x16x32_bf16(ld8(rec + OPS_T + lane * 16), mk8(pack2(Z[0], Z[1]), pack2(Z[2], Z[3]), 0u, 0u), zero4, 0, 0, 0);
            const bf16x8 ub = mk8(pack2(U[0], U[1]), pack2(U[2], U[3]), vf.x, vf.y);
            Yv = __builtin_amdgcn_mfma_f32_16x16x32_bf16(ld8(rec + OPS_MRBK + lane * 16), ub, Yv, 0, 0, 0);
#pragma unroll
            for (int kt = 0; kt < 4; ++kt) {
                const float4 wc = *(const float4*)(rec + OPS_WC + (16 * kt + 4 * g) * 4);
                f32x4 a = acc[kt];
                a[0] *= wc.x; a[1] *= wc.y; a[2] *= wc.z; a[3] *= wc.w;
                acc[kt] = __builtin_amdgcn_mfma_f32_16x16x32_bf16(ld8(rec + OPS_BK + (kt * 64 + lane) * 16), ub, a, 0, 0, 0);
            }
#pragma unroll
            for (int q = 0; q < 4; ++q) {
                const int tau = 4 * g + q, t = z ? 15 - tau : tau;
                Y[(size_t)(16 * c + t) * 64 + vt * 16 + cl] = Yv[q];
            }
        }
    }
}

__device__ void phase_readout(KP p, int wsid_, int layer, int nrows, unsigned* qctr, int* s_item) {
    PHASE_PROLOGUE
    const float* Y0 = (const float*)(ws_ + WS_YS); const float* Y1 = Y0 + HEADARR / 4;
    const bfu* VB = (const bfu*)(ws_ + WS_VB); const float* B0 = (const float*)(ws_ + WS_BETA); const float* B1 = B0 + (size_t)MA * 8;
    const float* GG = (const float*)(ws_ + WS_GG);
    bfu* MIX = (bfu*)(ws_ + WS_MIX);
    const float* lnw = p.c_ln_w + layer * 512; const float* lnb = p.c_ln_b + layer * 512;
    const int lane = tid_ & 63, wv = tid_ >> 6;
    const int npairs = nrows >> 5;
    for (;;) {
      __syncthreads();
      if (TID512 == 0) *s_item = (int)atomicAdd(qctr, 1u);
      __syncthreads();
      const int pair_ = __builtin_amdgcn_readfirstlane(*s_item);
      if (pair_ >= npairs) break;
#pragma unroll 1
      for (int k2 = 0; k2 < 2; ++k2) {
        const int row0 = (2 * pair_ + hb_) * 16 + wv * 4 + k2 * 2;
        int b, j, s; row_info(row0, b, j, s);
        float y0a[8], y1a[8], y0b[8], y1b[8], gav[8], gbv[8], lwv[8], lbv[8]; bfu vav[8], vbv[8];
        float4 bq0[4], bq1[4];
#pragma unroll
        for (int h = 0; h < 8; ++h) {
            const size_t o = (((size_t)b * 8 + h) * NKEY + j) * 64 + lane;
            y0a[h] = Y0[o]; y1a[h] = Y1[o]; y0b[h] = Y0[o + 64]; y1b[h] = Y1[o + 64];
            vav[h] = VB[(size_t)row0 * 512 + h * 64 + lane]; vbv[h] = VB[(size_t)(row0 + 1) * 512 + h * 64 + lane];
            gav[h] = GG[(size_t)row0 * 512 + h * 64 + lane]; gbv[h] = GG[(size_t)(row0 + 1) * 512 + h * 64 + lane];
            lwv[h] = lnw[h * 64 + lane]; lbv[h] = lnb[h * 64 + lane];
        }
#pragma unroll
        for (int q = 0; q < 4; ++q) { bq0[q] = *(const float4*)(B0 + (size_t)row0 * 8 + q * 4); bq1[q] = *(const float4*)(B1 + (size_t)row0 * 8 + q * 4); }
        const float bs0[16] = {bq0[0].x, bq0[0].y, bq0[0].z, bq0[0].w, bq0[1].x, bq0[1].y, bq0[1].z, bq0[1].w, bq0[2].x, bq0[2].y, bq0[2].z, bq0[2].w, bq0[3].x, bq0[3].y, bq0[3].z, bq0[3].w};
        const float bs1[16] = {bq1[0].x, bq1[0].y, bq1[0].z, bq1[0].w, bq1[1].x, bq1[1].y, bq1[1].z, bq1[1].w, bq1[2].x, bq1[2].y, bq1[2].z, bq1[2].w, bq1[3].x, bq1[3].y, bq1[3].z, bq1[3].w};
#pragma unroll
        for (int h = 0; h < 8; ++h) {
            const float ya = y0a[h] + y1a[h], yb = y0b[h] + y1b[h];
            const float va = bf2f(vav[h]), vb2 = bf2f(vbv[h]);
            const float bsa = bs0[h] + bs1[h], bsb = bs0[8 + h] + bs1[8 + h];
            const float ma = sum64(ya) * (1.f / 64.f), mb = sum64(yb) * (1.f / 64.f);
            const float da = ya - ma, db = yb - mb;
            const float vra = sum64(da * da) * (1.f / 64.f), vrb = sum64(db * db) * (1.f / 64.f);
            const float oa = (da * rsqrtf(vra + 64e-5f) * lwv[h] + lbv[h] + bsa * va) * gav[h];
            const float ob = (db * rsqrtf(vrb + 64e-5f) * lwv[h] + lbv[h] + bsb * vb2) * gbv[h];
            MIX[(size_t)row0 * DM + 512 + h * 64 + lane] = f2bf(oa);
            MIX[(size_t)(row0 + 1) * DM + 512 + h * 64 + lane] = f2bf(ob);
        }
      }
    }
}

using f32x16 = __attribute__((ext_vector_type(16))) float;
#define AT_KBYTES 8192
#define AT_VSTRIDE 136
#define AT_VBYTES (64 * AT_VSTRIDE)
template <int GRP>
__device__ __forceinline__ void attn_item(KP p, int wsid_, char* ws_, int layer, int b, int h, int qb, int nkeys, float lam, float lam_init, char* smem, int tid) {
    constexpr int KS = GRP ? 2 : 4;
    const int lane = tid & 63, wv = tid >> 6, r32 = lane & 31, hh = lane >> 5;
    const int mp = GRP ? (wv >> 1) : 0, sub = GRP ? (wv & 1) : wv;
    const int jq = qb * (GRP ? 64 : 128) + sub * 32 + r32;
    const bfu* Qg = (const bfu*)(ws_ + (GRP ? WS_QB : WS_QA)) + (((size_t)b * 4 + h) * NKEY + jq) * 64 + mp * 32;
    const bfu* Kg = GRP ? (const bfu*)(ws_ + WS_KB) + ((size_t)b * 4 + h) * NKEY * 64 : (const bfu*)(ws_ + WS_KA) + ((size_t)b * 2 + (h >> 1)) * NKEY * 64;
    const bfu* Vg = GRP ? (const bfu*)(ws_ + WS_VBT) + ((size_t)b * 4 + h) * 64 * NKEY : (const bfu*)(ws_ + WS_VAT) + ((size_t)b * 2 + (h >> 1)) * 64 * NKEY;
    bf16x8 qf[KS];
#pragma unroll
    for (int ks = 0; ks < KS; ++ks) qf[ks] = *(const bf16x8*)(Qg + ks * 16 + hh * 8);
    f32x16 oacc[2];
    float lrun = 0.f;
#pragma unroll
    for (int db = 0; db < 2; ++db)
#pragma unroll
        for (int i = 0; i < 16; ++i) oacc[db][i] = 0.f;
    const int lrow = tid >> 3, lch = ((tid & 7) ^ ((tid >> 4) & 7)) * 8;
    const bfu* kp0 = Kg + (size_t)lrow * 64 + lch; const bfu* kp1 = kp0 + 32 * 64;
    const bfu* vp0 = Vg + (size_t)lrow * NKEY + lch; const bfu* vp1 = vp0 + (size_t)32 * NKEY;
    char* ldst = smem + tid * 16;
#define AT_ISSUE(t_) { char* d_ = ldst + ((t_) & 1) * 16384; const size_t ko_ = (size_t)(t_) * 64 * 64; const int vo_ = (t_) * 64; \
        GLDS(kp0 + ko_, d_); GLDS(kp1 + ko_, d_ + 4096); GLDS(vp0 + vo_, d_ + 8192); GLDS(vp1 + vo_, d_ + 12288); }
    __syncthreads();
    AT_ISSUE(0)
    const int nt = nkeys >> 6;
    float mref = 0.f;
    const int swv = (r32 >> 1) & 7;
    for (int t = 0; t < nt; ++t) {
        asm volatile("s_waitcnt vmcnt(0)" ::: "memory");
        __syncthreads();
        if (t + 1 < nt) AT_ISSUE(t + 1)
        const char* cK = smem + (t & 1) * 16384; const char* cV = cK + 8192;
        f32x16 sacc[2];
        const float ninit = -mref;
#pragma unroll
        for (int kb = 0; kb < 2; ++kb) {
#pragma unroll
            for (int i = 0; i < 16; ++i) sacc[kb][i] = ninit;
            const int key = kb * 32 + r32;
#pragma unroll
            for (int ks = 0; ks < KS; ++ks) {
                const int c0 = mp * 4 + ks * 2 + hh;
                const bf16x8 kf = *(const bf16x8*)(cK + key * 128 + ((c0 ^ ((key >> 1) & 7)) * 16));
                sacc[kb] = __builtin_amdgcn_mfma_f32_32x32x16_bf16(kf, qf[ks], sacc[kb], 0, 0, 0);
            }
        }
        float mx = sacc[0][0];
#pragma unroll
        for (int i = 1; i < 16; ++i) mx = fmaxf(mx, sacc[0][i]);
#pragma unroll
        for (int i = 0; i < 16; ++i) mx = fmaxf(mx, sacc[1][i]);
        mx = xor32_max(mx);
        const bool need = (t == 0) || (mx > 8.f);
        if (__any(need)) {
            const float delta = need ? mx : 0.f;
            const float alpha = __builtin_amdgcn_exp2f(-delta);
            mref += delta; lrun *= alpha;
#pragma unroll
            for (int db = 0; db < 2; ++db)
#pragma unroll
                for (int i = 0; i < 16; ++i) oacc[db][i] *= alpha;
#pragma unroll
            for (int kb = 0; kb < 2; ++kb)
#pragma unroll
                for (int i = 0; i < 16; ++i) sacc[kb][i] -= delta;
        }
        float ps = 0.f;
#pragma unroll
        for (int kb = 0; kb < 2; ++kb)
#pragma unroll
            for (int i = 0; i < 16; ++i) { const float pv = __builtin_amdgcn_exp2f(sacc[kb][i]); sacc[kb][i] = pv; ps += pv; }
        lrun += ps;
#pragma unroll
        for (int kb = 0; kb < 2; ++kb)
#pragma unroll
            for (int s2 = 0; s2 < 2; ++s2) {
                union { bf16x8 v; unsigned u[4]; } pf;
#pragma unroll
                for (int i = 0; i < 4; ++i) pf.u[i] = pack2(sacc[kb][8 * s2 + 2 * i], sacc[kb][8 * s2 + 2 * i + 1]);
#pragma unroll
                for (int db = 0; db < 2; ++db) {
                    const char* vr = cV + (db * 32 + r32) * 128 + hh * 8;
                    union { bf16x8 v; uint2 u[2]; } vf;
                    vf.u[0] = *(const uint2*)(vr + (((kb * 4 + s2 * 2) ^ swv) * 16)); vf.u[1] = *(const uint2*)(vr + (((kb * 4 + s2 * 2 + 1) ^ swv) * 16));
                    oacc[db] = __builtin_amdgcn_mfma_f32_32x32x16_bf16(vf.v, pf.v, oacc[db], 0, 0, 0);
                }
            }
    }
    __syncthreads();
    bfu* MIX = (bfu*)(ws_ + WS_MIX);
    const int grow = grow_of(b, jq);
    const float il = 1.f / xor32_sum(lrun);
    if (GRP == 0) {
        bfu* dst = MIX + (size_t)grow * DM + h * 64;
#pragma unroll
        for (int db = 0; db < 2; ++db)
#pragma unroll
            for (int g = 0; g < 4; ++g)
                *(uint2*)(dst + db * 32 + g * 8 + hh * 4) = make_uint2(pack2(oacc[db][4 * g] * il, oacc[db][4 * g + 1] * il), pack2(oacc[db][4 * g + 2] * il, oacc[db][4 * g + 3] * il));
    } else {
        float* xs = (float*)smem + sub * 2048;
        if (mp == 1) {
            const float sc2 = lam * il;
#pragma unroll
            for (int db = 0; db < 2; ++db)
#pragma unroll
                for (int i = 0; i < 16; ++i) xs[(db * 16 + i) * 64 + lane] = oacc[db][i] * sc2;
        }
        __syncthreads();
        if (mp == 0) {
            float ss = 0.f;
#pragma unroll
            for (int db = 0; db < 2; ++db)
#pragma unroll
                for (int i = 0; i < 16; ++i) { const float o = oacc[db][i] * il - xs[(db * 16 + i) * 64 + lane]; oacc[db][i] = o; ss += o * o; }
            ss = xor32_sum(ss);
            const float rs = rsqrtf(ss * (1.f / 64.f) + 1e-6f) * (1.f - lam_init);
            const float* gn = p.b_subln + layer * 64;
            bfu* dst = MIX + (size_t)grow * DM + 256 + h * 64;
            float4 gq[2][4];
#pragma unroll
            for (int db = 0; db < 2; ++db)
#pragma unroll
                for (int g = 0; g < 4; ++g) gq[db][g] = *(const float4*)(gn + db * 32 + g * 8 + hh * 4);
#pragma unroll
            for (int db = 0; db < 2; ++db)
#pragma unroll
                for (int g = 0; g < 4; ++g) {
                    const int d = db * 32 + g * 8 + hh * 4;
                    *(uint2*)(dst + d) = make_uint2(pack2(oacc[db][4 * g] * rs * gq[db][g].x, oacc[db][4 * g + 1] * rs * gq[db][g].y), pack2(oacc[db][4 * g + 2] * rs * gq[db][g].z, oacc[db][4 * g + 3] * rs * gq[db][g].w));
                }
        }
    }
}
__device__ void phase_attn(KP p, int wsid_, int layer, bool do_ctx, unsigned* qctr, unsigned* cctr, int* s_item, char* smem) {
    PHASE_PROLOGUE
    const int tid = tid_;
    const float lam_init = 0.8f - 0.6f * expf(-0.3f * (float)layer);
    float d1 = 0.f, d2 = 0.f;
    for (int i = 0; i < 32; ++i) { d1 += p.b_lq1[layer * 32 + i] * p.b_lk1[layer * 32 + i]; d2 += p.b_lq2[layer * 32 + i] * p.b_lk2[layer * 32 + i]; }
    const float lam = expf(d1) - expf(d2) + lam_init;
    const int nitems = do_ctx ? 1728 : 1536;
    bool conv_left = cctr != nullptr;
    for (;;) {
        __syncthreads();
        if (TID512 == 0) *s_item = (int)atomicAdd(qctr, 1u);
        __syncthreads();
        const int pair_ = __builtin_amdgcn_readfirstlane(*s_item);
        if (2 * pair_ >= nitems) break;
        const int it = 2 * pair_ + hb_;
        int grp, b, h, qb, nkeys;
        if (it < 512) { grp = 0; qb = 2 + (it & 15); h = (it >> 4) & 3; b = it >> 6; nkeys = NKEY; }
        else if (it < 1536) { grp = 1; const int r = it - 512; qb = 4 + (r & 31); h = (r >> 5) & 3; b = r >> 7; nkeys = NKEY; }
        else if (it < 1664) { grp = 1; const int r = it - 1536; qb = r & 3; h = (r >> 2) & 3; b = r >> 4; nkeys = 256; }
        else { grp = 0; const int r = it - 1664; qb = r & 1; h = (r >> 1) & 3; b = r >> 3; nkeys = 256; }
        if (grp) attn_item<1>(p, wsid_, ws_, layer, b, h, qb, nkeys, lam, lam_init, smem, tid);
        else attn_item<0>(p, wsid_, ws_, layer, b, h, qb, nkeys, lam, lam_init, smem, tid);
        if (conv_left) conv_left = conv_big_step(p, wsid_, ws_, layer, cctr, s_item, smem, tid, hb_);
    }
    while (conv_left) conv_left = conv_big_step(p, wsid_, ws_, layer, cctr, s_item, smem, tid, hb_);
}

__device__ void phase_outproj(KP p, int wsid_, int layer, int nrows, int bid, int nb, char* smem) {
    PHASE_PROLOGUE
    const bfu* MIX = (const bfu*)(ws_ + WS_MIX); const bfu* W = (const bfu*)(ws_ + WS_WOUT);
    float* X = (float*)(ws_ + WS_X); const float* mod = (const float*)(ws_ + WS_MOD);
    const int nitems = (nrows / 128) * 8;
    for (int it = bid; it < nitems; it += nb) {
        const int mt = it >> 3, nt = it & 7, row0 = mt * 128, col0 = nt * 128;
        int b, j0, s; row_info(row0, b, j0, s);
        const float* ga = mod + ((size_t)layer * 9 + s) * 6144 + 2 * 1024;
        gemm_tile([&](int r) { return MIX + (size_t)(row0 + r) * DM; }, [&](int r) { return W + (size_t)(col0 + r) * DM; }, DM,
            [&](f32x4 (&acc)[4][4], int wr, int wc, int fr, int fq) {
                ACC_FOREACH({ float* xp = X + (size_t)(row0 + row) * DM + col0 + col; *xp += ga[col0 + col] * val; })
            }, smem, wsid_);
    }
}

__device__ void phase_norm2_route(KP p, int wsid_, int layer, int nrows, int bid, int nb, char* smem, bool dry = false) {
    PHASE_PROLOGUE
    const float* X = (const float*)(ws_ + WS_X); bfu* H = (bfu*)(ws_ + WS_H);
    const float* mod = (const float*)(ws_ + WS_MOD); const float* WRT = (const float*)(ws_ + WS_WRT);
    int* ECNT = (int*)(ws_ + WS_ECNT) + layer * 32; int* EIDX = (int*)(ws_ + WS_EIDX); float* EGATE = (float*)(ws_ + WS_EGATE); int* ELIST = (int*)(ws_ + WS_ELIST);
    float* lg = (float*)smem;
    int* lcnt = (int*)(lg + 4 * 16 * 48);
    int* lbase = lcnt + 32;
    int* lsel = lbase + 32;
    int* lrank = lsel + 128;
    char* slab = smem + 14336;
    constexpr int SLAB = 27136;
    const bfu* WH = (const bfu*)(ws_ + WS_WRTH); const bfu* WL = (const bfu*)(ws_ + WS_WRTL);
    const int tid = tid_, lane = tid & 63, wv = tid >> 6, r = lane & 15, kq = lane >> 4;
    const float* gf = p.g_ffn + layer * DM;
    const float* bg = p.r_b_group + layer * 4; const float* be = p.r_b_expert + layer * 32;
    const int nitems = nrows / 64;
    for (int it = bid; it < nitems; it += nb) {
        const int row = it * 64 + wv * 16 + r;
        int b, j, s; row_info(row, b, j, s);
        const float* xr = X + (size_t)row * DM;
        const float* sh = mod + ((size_t)layer * 9 + s) * 6144 + 3 * 1024; const float* sc = sh + 1024;
        if (tid < 32) lcnt[tid] = 0;
        float ss = 0.f;
#pragma unroll 1
        for (int c0 = 0; c0 < 64; c0 += 16) {
            float4 xv_[16];
#pragma unroll
            for (int c = 0; c < 16; ++c) xv_[c] = *(const float4*)(xr + (c0 + c) * 16 + kq * 4);
#pragma unroll
            for (int c = 0; c < 16; c += 4)
                asm volatile("" : "+v"(xv_[c].x), "+v"(xv_[c].y), "+v"(xv_[c].z), "+v"(xv_[c].w), "+v"(xv_[c + 1].x), "+v"(xv_[c + 1].y), "+v"(xv_[c + 1].z), "+v"(xv_[c + 1].w),
                                  "+v"(xv_[c + 2].x), "+v"(xv_[c + 2].y), "+v"(xv_[c + 2].z), "+v"(xv_[c + 2].w), "+v"(xv_[c + 3].x), "+v"(xv_[c + 3].y), "+v"(xv_[c + 3].z), "+v"(xv_[c + 3].w) :: "memory");
#pragma unroll
            for (int c = 0; c < 16; ++c) ss += xv_[c].x * xv_[c].x + xv_[c].y * xv_[c].y + xv_[c].z * xv_[c].z + xv_[c].w * xv_[c].w;
        }
        ss = xor32_sum(xor16_sum(ss));
        const float rs = rsqrtf(ss * (1.f / 1024.f) + 1e-6f);
        f32x4 acc[3];
#pragma unroll
        for (int n = 0; n < 3; ++n) acc[n] = (f32x4){0.f, 0.f, 0.f, 0.f};
        uint4 sw0, sw1, sw2, sw3, sw4, sw5; float4 sgA = make_float4(0.f, 0.f, 0.f, 0.f), sgB = sgA;
        const int ch0 = tid, ch1 = tid + 256, ch2 = tid + 512;
        const size_t wo0 = (size_t)(ch0 >> 4) * DM + (ch0 & 15) * 8, wo1 = (size_t)(ch1 >> 4) * DM + (ch1 & 15) * 8, wo2 = (size_t)(ch2 >> 4) * DM + (ch2 & 15) * 8;
        const int lo0 = (ch0 >> 4) * 272 + (ch0 & 15) * 16, lo1 = (ch1 >> 4) * 272 + (ch1 & 15) * 16, lo2 = (ch2 >> 4) * 272 + (ch2 & 15) * 16;
#define RT_SLAB_LOAD(sb_) { const int k0_ = (sb_) * 128; \
            sw0 = *(const uint4*)(WH + wo0 + k0_); sw1 = *(const uint4*)(WH + wo1 + k0_); sw2 = *(const uint4*)(WH + wo2 + k0_); \
            sw3 = *(const uint4*)(WL + wo0 + k0_); sw4 = *(const uint4*)(WL + wo1 + k0_); sw5 = *(const uint4*)(WL + wo2 + k0_); \
            if (tid < 32) { sgA = *(const float4*)(gf + k0_ + tid * 4); sgB = *(const float4*)(sc + k0_ + tid * 4); } \
            else if (tid < 64) sgA = *(const float4*)(sh + k0_ + (tid - 32) * 4); }
#define RT_SLAB_STORE(buf_) { char* d_ = slab + (buf_) * SLAB; \
            *(uint4*)(d_ + lo0) = sw0; *(uint4*)(d_ + lo1) = sw1; *(uint4*)(d_ + lo2) = sw2; *(uint4*)(d_ + 13056 + lo0) = sw3; *(uint4*)(d_ + 13056 + lo1) = sw4; *(uint4*)(d_ + 13056 + lo2) = sw5; \
            if (tid < 64) *(float4*)(d_ + 26112 + tid * 16) = tid < 32 ? make_float4(sgA.x * (1.f + sgB.x), sgA.y * (1.f + sgB.y), sgA.z * (1.f + sgB.z), sgA.w * (1.f + sgB.w)) : sgA; }
        float4 xq0, xq1, xq2, xq3, xq4, xq5, xq6, xq7;
#define RT_X_LOAD(sb_) { const float* x_ = xr + (sb_) * 128 + kq * 8; xq0 = *(const float4*)(x_); xq1 = *(const float4*)(x_ + 4); xq2 = *(const float4*)(x_ + 32); xq3 = *(const float4*)(x_ + 36); \
            xq4 = *(const float4*)(x_ + 64); xq5 = *(const float4*)(x_ + 68); xq6 = *(const float4*)(x_ + 96); xq7 = *(const float4*)(x_ + 100); }
        __syncthreads();
        RT_SLAB_LOAD(0) RT_SLAB_STORE(0) RT_X_LOAD(0)
        __syncthreads();
        for (int sb = 0; sb < 8; ++sb) {
            if (sb + 1 < 8) RT_SLAB_LOAD(sb + 1)
            const float4 xc[8] = {xq0, xq1, xq2, xq3, xq4, xq5, xq6, xq7};
            if (sb + 1 < 8) RT_X_LOAD(sb + 1)
            const char* d = slab + (sb & 1) * SLAB;
#pragma unroll
            for (int s4 = 0; s4 < 4; ++s4) {
                const float4 g0 = *(const float4*)(d + 26112 + (s4 * 32 + kq * 8) * 4), g1 = *(const float4*)(d + 26112 + (s4 * 32 + kq * 8 + 4) * 4);
                const float4 h0 = *(const float4*)(d + 26624 + (s4 * 32 + kq * 8) * 4), h1 = *(const float4*)(d + 26624 + (s4 * 32 + kq * 8 + 4) * 4);
                const float4 xa = xc[2 * s4], xb = xc[2 * s4 + 1];
                float f[8];
                f[0] = xa.x * rs * g0.x + h0.x; f[1] = xa.y * rs * g0.y + h0.y; f[2] = xa.z * rs * g0.z + h0.z; f[3] = xa.w * rs * g0.w + h0.w;
                f[4] = xb.x * rs * g1.x + h1.x; f[5] = xb.y * rs * g1.y + h1.y; f[6] = xb.z * rs * g1.z + h1.z; f[7] = xb.w * rs * g1.w + h1.w;
                unsigned hi[4], lo[4];
#pragma unroll
                for (int i = 0; i < 4; ++i) {
                    hi[i] = pack2(f[2 * i], f[2 * i + 1]);
                    lo[i] = pack2(f[2 * i] - __uint_as_float(hi[i] << 16), f[2 * i + 1] - __uint_as_float(hi[i] & 0xFFFF0000u));
                }
                *(uint4*)(H + (size_t)row * DM + sb * 128 + s4 * 32 + kq * 8) = make_uint4(hi[0], hi[1], hi[2], hi[3]);
                const bf16x8 ah = mk8(hi[0], hi[1], hi[2], hi[3]), al = mk8(lo[0], lo[1], lo[2], lo[3]);
#pragma unroll
                for (int n = 0; n < 3; ++n) {
                    const bf16x8 wh = *(const bf16x8*)(d + (n * 16 + r) * 272 + (s4 * 32 + kq * 8) * 2), wl = *(const bf16x8*)(d + 13056 + (n * 16 + r) * 272 + (s4 * 32 + kq * 8) * 2);
                    acc[n] = __builtin_amdgcn_mfma_f32_16x16x32_bf16(ah, wh, acc[n], 0, 0, 0);
                    acc[n] = __builtin_amdgcn_mfma_f32_16x16x32_bf16(ah, wl, acc[n], 0, 0, 0);
                    acc[n] = __builtin_amdgcn_mfma_f32_16x16x32_bf16(al, wh, acc[n], 0, 0, 0);
                }
            }
            if (sb + 1 < 8) RT_SLAB_STORE((sb + 1) & 1)
            __syncthreads();
        }
#pragma unroll
        for (int n = 0; n < 3; ++n)
#pragma unroll
            for (int jj = 0; jj < 4; ++jj) lg[(wv * 16 + kq * 4 + jj) * 48 + n * 16 + r] = acc[n][jj];
        __syncthreads();
        if (lane < 16) {
            const float* L = lg + (wv * 16 + lane) * 48;
            const int grow = it * 64 + wv * 16 + lane;
            float gl[4]; float gm = -1e30f; int gi = 0;
#pragma unroll
            for (int g = 0; g < 4; ++g) { gl[g] = L[g] + bg[g]; if (gl[g] > gm) { gm = gl[g]; gi = g; } }
            float gs = 0.f;
#pragma unroll
            for (int g = 0; g < 4; ++g) gs += __expf(gl[g] - gm);
            const float gp = 1.f / gs;
            float v1 = -1e30f, v2 = -1e30f; int i1 = 0, i2 = 0;
            const float4 be0 = *(const float4*)(be + gi * 8), be1 = *(const float4*)(be + gi * 8 + 4);
            const float bev[8] = {be0.x, be0.y, be0.z, be0.w, be1.x, be1.y, be1.z, be1.w};
#pragma unroll
            for (int e = 0; e < 8; ++e) {
                const float v = L[4 + gi * 8 + e] + bev[e];
                if (v > v1) { v2 = v1; i2 = i1; v1 = v; i1 = e; } else if (v > v2) { v2 = v; i2 = e; }
            }
            const float e2 = __expf(v2 - v1), den = 1.f / (1.f + e2);
            const int ex1 = gi * 8 + i1, ex2 = gi * 8 + i2;
            EIDX[grow * 2] = ex1; EIDX[grow * 2 + 1] = ex2;
            EGATE[grow * 2] = den * gp; EGATE[grow * 2 + 1] = e2 * den * gp;
            const int lr = wv * 16 + lane;
            lsel[lr * 2] = ex1; lsel[lr * 2 + 1] = ex2;
            lrank[lr * 2] = atomicAdd(&lcnt[ex1], 1); lrank[lr * 2 + 1] = atomicAdd(&lcnt[ex2], 1);
        }
        __syncthreads();
        if (tid < 32) lbase[tid] = (lcnt[tid] > 0 && !dry) ? atomicAdd(&ECNT[tid], lcnt[tid]) : 0;
        __syncthreads();
        if (tid < 128 && !dry) { const int e = lsel[tid]; ELIST[(size_t)e * (2 * MA) + lbase[e] + lrank[tid]] = ((it * 64 + (tid >> 1)) << 1) | (tid & 1); }
        __syncthreads();
    }
}

__device__ __forceinline__ int moe_prefix256(const int* ECNT, int* spre  , int wsid_) {
    const int t5 = TID512;
    if (t5 < 32) spre[40 + t5] = (ECNT[t5] + 255) >> 8;
    __syncthreads();
    if (t5 == 0) { int a = 0; for (int e = 0; e < 32; ++e) { spre[e] = a; a += spre[40 + e]; } spre[32] = a; }
    __syncthreads();
    return spre[32];
}
__device__ void phase_outproj256(KP p, int wsid_, int layer, int nrows, int vblk, int nblk, char* smem_all, unsigned* cctr, int* s_item, float gscale = 1.f) {
    PHASE_PROLOGUE
    const bfu* MIX = (const bfu*)(ws_ + WS_MIX); const bfu* W = (const bfu*)(ws_ + WS_WOUT);
    const float* mod = (const float*)(ws_ + WS_MOD);
    const int nitems = (ML >> 8) * 4;
    for (int it = vblk; it < nitems; it += nblk) {
        const int mt = it >> 2, nt = it & 3, row0 = mt * 256, col0 = nt * 256;
        int b, j0, sm; row_info(row0, b, j0, sm);
        const float* ga = mod + ((size_t)layer * 9 + sm) * 6144 + 2 * 1024 + col0;
        const bfu* B0 = W + (size_t)col0 * DM;
        gemm256<DM, DM, DM>(MIX, [&](int r) { return row0 + r; }, B0, B0 + (size_t)128 * DM,
            [&](f32x4 (&acc)[2][2][4][2], int wr, int wc, int fr, int fq) {
                const __amdgpu_buffer_rsrc_t rs = __builtin_amdgcn_make_buffer_rsrc((void*)(ws_ + WS_X), 0, (int)((size_t)MA * DM * 4), 0x00020000);
                const __amdgpu_buffer_rsrc_t rl = layer > 0 ? rs : (row0 < ML ? __builtin_amdgcn_make_buffer_rsrc((void*)p.x, 0, (int)((size_t)ML * DM * 4), 0x00020000)
                                                                         : __builtin_amdgcn_make_buffer_rsrc((void*)(p.ctx - (size_t)ML * DM), 0, (int)((size_t)MA * DM * 4), 0x00020000));
                const int voff = ((wr * 64 + fq * 4) * DM + wc * 32 + fr) * 4;
#pragma unroll
                for (int bj = 0; bj < 2; ++bj) {
                    float xo[2][2][4][4];
                    const float g0 = ga[bj * 128 + wc * 32 + fr] * gscale, g1 = ga[bj * 128 + wc * 32 + 16 + fr] * gscale;
#pragma unroll
                    for (int n = 0; n < 2; ++n)
#pragma unroll
                        for (int ai = 0; ai < 2; ++ai)
#pragma unroll
                            for (int m = 0; m < 4; ++m)
#pragma unroll
                                for (int j = 0; j < 4; ++j)
                                    xo[n][ai][m][j] = __uint_as_float(__builtin_amdgcn_raw_buffer_load_b32(rl, voff, ((row0 + ai * 128 + m * 16 + j) * DM + col0 + bj * 128 + n * 16) * 4, 0));
#pragma unroll
                    for (int n = 0; n < 2; ++n)
#pragma unroll
                        for (int ai = 0; ai < 2; ++ai)
#pragma unroll
                            for (int m = 0; m < 4; ++m)
#pragma unroll
                                for (int j = 0; j < 4; ++j)
                                    __builtin_amdgcn_raw_buffer_store_b32(__float_as_uint(xo[n][ai][m][j] + (n ? g1 : g0) * acc[ai][bj][m][n][j]), rs, voff, ((row0 + ai * 128 + m * 16 + j) * DM + col0 + bj * 128 + n * 16) * 4, 0);
                }
            }, smem_all, wsid_);
    }
    if (nrows > ML) {
        if (vblk < 64) {
            const int it = vblk * 2 + hb_, mt = it >> 3, nt = it & 7, row0 = ML + mt * 128, col0 = nt * 128;
            const float* ga = mod + ((size_t)layer * 9 + 8) * 6144 + 2 * 1024 + col0;
            float* X = (float*)(ws_ + WS_X);
            const float* xsrc = layer > 0 ? (const float*)X : p.ctx - (size_t)ML * DM;
            gemm_tile([&](int r) { return MIX + (size_t)(row0 + r) * DM; }, [&](int r) { return W + (size_t)(col0 + r) * DM; }, DM,
                [&](f32x4 (&acc)[4][4], int wr, int wc, int fr, int fq) {
                    float xo[4][4][4];
#pragma unroll
                    for (int m = 0; m < 4; ++m)
#pragma unroll
                        for (int n = 0; n < 4; ++n)
#pragma unroll
                            for (int j = 0; j < 4; ++j) xo[m][n][j] = xsrc[(size_t)(row0 + wr * 64 + m * 16 + fq * 4 + j) * DM + col0 + wc * 64 + n * 16 + fr];
#pragma unroll
                    for (int n = 0; n < 4; ++n) {
                        const float g = ga[wc * 64 + n * 16 + fr] * gscale;
#pragma unroll
                        for (int m = 0; m < 4; ++m)
#pragma unroll
                            for (int j = 0; j < 4; ++j) X[(size_t)(row0 + wr * 64 + m * 16 + fq * 4 + j) * DM + col0 + wc * 64 + n * 16 + fr] = xo[m][n][j] + g * acc[m][n][j];
                    }
                }, smem_all + hb_ * SMEM_BYTES, wsid_);
        } else { for (int q = 0; q < 4; ++q) if (!conv_big_step(p, wsid_, ws_, layer, cctr, s_item, smem_all + hb_ * SMEM_BYTES, tid_, hb_)) break; }
    }
}
__device__ void phase_experts256(KP p, int wsid_, int layer, int vblk, int nblk, unsigned* rbcnt, char* smem_all) {
    PHASE_PROLOGUE
    const bfu* H = (const bfu*)(ws_ + WS_H); const bfu* W1 = (const bfu*)(ws_ + WS_W1); const bfu* W3 = (const bfu*)(ws_ + WS_W3);
    const bfu* HB = (const bfu*)(ws_ + WS_HB); const bfu* W2 = (const bfu*)(ws_ + WS_W2);
    const int* ECNT = (const int*)(ws_ + WS_ECNT) + layer * 32; const int* ELIST = (const int*)(ws_ + WS_ELIST); const float* EGATE = (const float*)(ws_ + WS_EGATE);
    int* spre = (int*)(smem_all + 135168);
    const int nb256 = __builtin_amdgcn_readfirstlane(moe_prefix256(ECNT, spre, wsid_));
    const int n1 = nb256 * 4;
    for (int it = vblk; it < 2 * n1; it += nblk) {
        const bool second = it >= n1;
        const int t = second ? it - n1 : it, blk = t >> 2, nt = t & 3;
        int e = 0;
        while (__builtin_amdgcn_readfirstlane(spre[e + 1]) <= blk) ++e;
        const int rb = blk - __builtin_amdgcn_readfirstlane(spre[e]), cnt = __builtin_amdgcn_readfirstlane(ECNT[e]);
        const int* lst = ELIST + (size_t)e * (2 * MA) + rb * 256;
        const int nvalid = min(256, cnt - rb * 256);
        if (!second) {
            const bfu* w1 = W1 + ((size_t)e * FF + nt * 128) * DM; const bfu* w3 = W3 + ((size_t)e * FF + nt * 128) * DM;
            gemm256<DM, DM, DM>(H, [&](int r) { const int e_ = lst[r < nvalid ? r : 0]; return r < nvalid ? (e_ >> 1) : 0; }    , w1, w3,
                [&](f32x4 (&acc)[2][2][4][2], int wr, int wc, int fr, int fq) {
                    const __amdgpu_buffer_rsrc_t rs = __builtin_amdgcn_make_buffer_rsrc((void*)(ws_ + WS_HB), 0, (int)((size_t)(2 * MA + 32 * 256) * FF * 2), 0x00020000);
                    const int voff = ((wr * 64 + fq * 4) * FF + wc * 32 + fr) * 2;
#pragma unroll
                    for (int ai = 0; ai < 2; ++ai)
#pragma unroll
                        for (int m = 0; m < 4; ++m)
#pragma unroll
                            for (int n = 0; n < 2; ++n)
#pragma unroll
                                for (int j = 0; j < 4; ++j) {
                                    const float a = acc[ai][0][m][n][j], g = acc[ai][1][m][n][j];
                                    __builtin_amdgcn_raw_buffer_store_b16(f2bf(siluf_(a) * g), rs, voff, ((blk * 256 + ai * 128 + m * 16 + j) * FF + nt * 128 + n * 16) * 2, 16);
                                }
                    asm volatile("s_waitcnt vmcnt(0)" ::: "memory");
                    __syncthreads();
                    if (TID512 == 0) __hip_atomic_fetch_add(rbcnt + blk, 1u, __ATOMIC_RELAXED, __HIP_MEMORY_SCOPE_AGENT);
                }, smem_all, wsid_);
        } else {
            if (TID512 == 0) {
                unsigned spins = 0;
                while (__hip_atomic_load(rbcnt + blk, __ATOMIC_RELAXED, __HIP_MEMORY_SCOPE_AGENT) < 4u) { __builtin_amdgcn_s_sleep(1); if (++spins > (1u << 22)) break; }
                __builtin_amdgcn_fence(__ATOMIC_ACQUIRE, "agent");
                asm volatile("s_waitcnt vmcnt(0)" ::: "memory");
            }
            __syncthreads();
            const bfu* w2 = W2 + ((size_t)e * DM + nt * 256) * FF;
            gemm256<FF, FF, FF>(HB, [&](int r) { return blk * 256 + r; }, w2, w2 + (size_t)128 * FF,
                [&](f32x4 (&acc)[2][2][4][2], int wr, int wc, int fr, int fq) {
                    int* sOff = (int*)smem_all; float* sGt = (float*)(smem_all + 1024);
                    { const int r = TID512;
                      if (r < 256) {
                          const bool ok = r < nvalid; const int ent = ok ? lst[r] : 0;
                          sOff[r] = ok ? ((ent & 1) * MA + (ent >> 1)) * DM * 2 : -1; sGt[r] = EGATE[ent];
                      } }
                    __syncthreads();
                    const __amdgpu_buffer_rsrc_t rs = __builtin_amdgcn_make_buffer_rsrc((void*)(ws_ + WS_Y01), 0, (int)((size_t)2 * MA * DM * 2), 0x00020000);
                    const int cofs = (nt * 256 + wc * 32 + fr) * 2;
#pragma unroll
                    for (int ai = 0; ai < 2; ++ai)
#pragma unroll
                        for (int m = 0; m < 4; ++m) {
                            const int4 o4 = *(const int4*)(sOff + ai * 128 + wr * 64 + m * 16 + fq * 4); const float4 g4 = *(const float4*)(sGt + ai * 128 + wr * 64 + m * 16 + fq * 4);
                            const int oo[4] = {o4.x, o4.y, o4.z, o4.w}; const float gg[4] = {g4.x, g4.y, g4.z, g4.w};
#pragma unroll
                            for (int j = 0; j < 4; ++j) {
                                if (oo[j] >= 0) {
#pragma unroll
                                    for (int bj = 0; bj < 2; ++bj)
#pragma unroll
                                        for (int n = 0; n < 2; ++n)
                                            __builtin_amdgcn_raw_buffer_store_b16(f2bf(gg[j] * acc[ai][bj][m][n][j]), rs, oo[j] + cofs, (bj * 128 + n * 16) * 2, 0);
                                }
                            }
                        }
                }, smem_all, wsid_);
        }
    }
}

__device__ __forceinline__ int moe_prefix(const int* ECNT, int* spre  , int wsid_) {
    if ((TID512 & 255) == 0) { int a = 0; for (int e = 0; e < 32; ++e) { spre[e] = a; a += (ECNT[e] + 127) >> 7; } spre[32] = a; }
    __syncthreads();
    return spre[32];
}
__device__ void phase_expert1(KP p, int wsid_, int layer, int bid, int nb, char* smem) {
    PHASE_PROLOGUE
    const bfu* H = (const bfu*)(ws_ + WS_H); const bfu* W1 = (const bfu*)(ws_ + WS_W1); const bfu* W3 = (const bfu*)(ws_ + WS_W3);
    bfu* HB = (bfu*)(ws_ + WS_HB);
    const int* ECNT = (const int*)(ws_ + WS_ECNT) + layer * 32; const int* ELIST = (const int*)(ws_ + WS_ELIST);
    int* spre = (int*)(smem + 65536);
    const int nblk = moe_prefix(ECNT, spre, wsid_);
    const int nitems = nblk * 8;
    for (int it = bid; it < nitems; it += nb) {
        const int blk = it >> 3, nt = it & 7;
        int e = 0;
        while (spre[e + 1] <= blk) ++e;
        const int rb = blk - spre[e], cnt = ECNT[e];
        const int* lst = ELIST + (size_t)e * (2 * MA) + rb * 128;
        const int nvalid = min(128, cnt - rb * 128);
        const bfu* w1 = W1 + (size_t)e * FF * DM; const bfu* w3 = W3 + (size_t)e * FF * DM;
        bfu* hb = HB + (size_t)blk * 128 * FF;
        gemm_tile([&](int r) { const int tok = r < nvalid ? (lst[r] >> 1) : 0; return H + (size_t)tok * DM; },
                  [&](int r) { const int wcx = r >> 6, n4 = (r >> 4) & 3, rr = r & 15; const int hc = nt * 64 + wcx * 32 + (n4 & 1) * 16 + rr; return (n4 < 2 ? w1 : w3) + (size_t)hc * DM; }, DM,
            [&](f32x4 (&acc)[4][4], int wr, int wc, int fr, int fq) {
#pragma unroll
                for (int m = 0; m < 4; ++m)
#pragma unroll
                    for (int n = 0; n < 2; ++n)
#pragma unroll
                        for (int jj = 0; jj < 4; ++jj) {
                            const int row = wr * 64 + m * 16 + fq * 4 + jj; const int hc = nt * 64 + wc * 32 + n * 16 + fr;
                            const float a = acc[m][n][jj], g = acc[m][n + 2][jj];
                            hb[(size_t)row * FF + hc] = f2bf(siluf_(a) * g);
                        }
            }, smem, wsid_);
    }
}
__device__ void phase_expert2(KP p, int wsid_, int layer, int bid, int nb, char* smem) {
    PHASE_PROLOGUE
    const bfu* HB = (const bfu*)(ws_ + WS_HB); const bfu* W2 = (const bfu*)(ws_ + WS_W2);
    float* Y = (float*)(ws_ + WS_Y01);
    const int* ECNT = (const int*)(ws_ + WS_ECNT) + layer * 32; const int* ELIST = (const int*)(ws_ + WS_ELIST); const float* EGATE = (const float*)(ws_ + WS_EGATE);
    int* spre = (int*)(smem + 65536);
    const int nblk = moe_prefix(ECNT, spre, wsid_);
    const int nitems = nblk * 8;
    for (int it = bid; it < nitems; it += nb) {
        const int blk = it >> 3, nt = it & 7;
        int e = 0;
        while (spre[e + 1] <= blk) ++e;
        const int rb = blk - spre[e], cnt = ECNT[e];
        const int* lst = ELIST + (size_t)e * (2 * MA) + rb * 128;
        const int nvalid = min(128, cnt - rb * 128);
        const bfu* w2 = W2 + (size_t)e * DM * FF;
        const bfu* hb = HB + (size_t)blk * 128 * FF;
        gemm_tile([&](int r) { return hb + (size_t)r * FF; }, [&](int r) { return w2 + (size_t)(nt * 128 + r) * FF; }, FF,
            [&](f32x4 (&acc)[4][4], int wr, int wc, int fr, int fq) {
#pragma unroll
                for (int m = 0; m < 4; ++m)
#pragma unroll
                    for (int jj = 0; jj < 4; ++jj) {
                        const int row = wr * 64 + m * 16 + fq * 4 + jj;
                        if (row < nvalid) {
                            const int ent = lst[row]; const float gt = EGATE[ent];
                            float* yp = Y + ((size_t)(ent & 1) * MA + (ent >> 1)) * DM + nt * 128 + wc * 64 + fr;
#pragma unroll
                            for (int n = 0; n < 4; ++n) yp[n * 16] = gt * acc[m][n][jj];
                        }
                    }
            }, smem, wsid_);
    }
}

#define XB_TMO      128
#define XB_XCNT(j)  (256  + 64 * (j))
#define XB_XSUB(j)  (1280 + 64 * (j))
#define XB_XGEN(j)  (2304 + 64 * (j))
#define XB_TOP      3328
#define XB_TOPGEN   3392
#define XCD_BAR_WORDS 3456
#define XB_SPIN_CAP (1u << 22)
#define LAS __attribute__((address_space(3)))

__device__ __forceinline__ unsigned xb_ld(unsigned* p)              { return __hip_atomic_load(p, __ATOMIC_RELAXED, __HIP_MEMORY_SCOPE_AGENT); }
__device__ __forceinline__ unsigned xb_add(unsigned* p, unsigned v) { return __hip_atomic_fetch_add(p, v, __ATOMIC_RELAXED, __HIP_MEMORY_SCOPE_AGENT); }
__device__ __forceinline__ unsigned xb_xcc_id() { return (unsigned)__builtin_amdgcn_s_getreg((3 << 11) | 20) & 0xFu; }
#define XB_SPIN(cond, bar) do { unsigned _sp = 0; while (cond) { __builtin_amdgcn_s_sleep(1); \
    if ((++_sp & 255u) == 0u) { if (xb_ld(&(bar)[XB_TMO])) break; if (_sp > XB_SPIN_CAP) { atomicAdd(&(bar)[XB_TMO], 1u); break; } } } } while (0)

struct XcdBarrier {
    unsigned* bar; unsigned x;
    volatile LAS unsigned* st;
};

__device__ __forceinline__ XcdBarrier xcd_barrier_post(unsigned* bar, volatile LAS unsigned* st, int wsid_) {
    XcdBarrier b; b.bar = bar; b.x = xb_xcc_id(); b.st = st;
    if (TID512 == 0) (void)xb_add(&bar[XB_XCNT(b.x)], 1u);
    return b;
}
__device__ __forceinline__ void xcd_barrier_complete(unsigned* bar, unsigned x, unsigned& nloc, unsigned& nx) {
    const unsigned G = gridDim.x * gridDim.y * gridDim.z;
    unsigned sum, cnt, mine, sp = 0u;
    for (;;) {
        sum = 0u; cnt = 0u; mine = 0u;
#pragma unroll
        for (unsigned j = 0; j < 16; ++j) { const unsigned c = xb_ld(&bar[XB_XCNT(j)]); sum += c; cnt += (c > 0u) ? 1u : 0u; mine = (j == x) ? c : mine; }
        if (sum == G) break;
        __builtin_amdgcn_s_sleep(1);
        if ((++sp & 255u) == 0u) { if (xb_ld(&bar[XB_TMO])) break; if (sp > XB_SPIN_CAP) { atomicAdd(&bar[XB_TMO], 1u); break; } }
    }
    nloc = mine > 0u ? mine : 1u; nx = cnt > 0u ? cnt : 1u;
}

__device__ __forceinline__ void xcd_barrier_(const XcdBarrier& b, int wsid_) {
    asm volatile("s_waitcnt vmcnt(0)" ::: "memory");
    __syncthreads();
    if (TID512 == 0) {
        unsigned* bar = b.bar;
        __builtin_amdgcn_s_waitcnt(0);
        unsigned nloc = b.st[0], nx = b.st[1];
        if (nloc == 0u) { xcd_barrier_complete(bar, b.x, nloc, nx); b.st[0] = nloc; b.st[1] = nx; }
        const unsigned old = xb_add(&bar[XB_XSUB(b.x)], 1u);
        const unsigned gen = old / nloc;
        if (old + 1u == (gen + 1u) * nloc) {
            __builtin_amdgcn_fence(__ATOMIC_RELEASE, "agent");
            asm volatile("s_waitcnt vmcnt(0)" ::: "memory");
            const unsigned og = xb_add(&bar[XB_TOP], 1u);
            const unsigned tg = og / nx;
            if (og + 1u == (tg + 1u) * nx) xb_add(&bar[XB_TOPGEN], 1u);
            else XB_SPIN(xb_ld(&bar[XB_TOPGEN]) == tg, bar);
            __builtin_amdgcn_fence(__ATOMIC_ACQUIRE, "agent");
            xb_add(&bar[XB_XGEN(b.x)], 1u);
            asm volatile("s_waitcnt vmcnt(0)" ::: "memory");
        } else {
            XB_SPIN(xb_ld(&bar[XB_XGEN(b.x)]) == gen, bar);
            __builtin_amdgcn_fence(__ATOMIC_ACQUIRE, "agent");
            asm volatile("s_waitcnt vmcnt(0)" ::: "memory");
        }
    }
    __syncthreads();
}


#define REP_MOD 1
#define REP_OUTPROJ 1
#define REP_ROUTE 1
#define REP_NORM1 1
#define REP_CONV 1
#define REP_INPROJ 1
#define REP_RK 1
#define REP_SCANATT 1
#define REP_R4 1
#define REP_ATT 1
#define REP_READOUT 1
#define REP_EXP1 1
#define REP_EXP2 1
#define REPEAT(N) _Pragma("nounroll") for (int rep_ = 0; rep_ < (N); ++rep_)
#define REPEAT2(N) _Pragma("nounroll") for (int rep2_ = 0; rep2_ < (N); ++rep2_)
#define CTL_Q(l) (4096 + 64 * (l))
#define CTL_XR 5120
#define CTL_RBC 6144
__global__ void __launch_bounds__(512, 2) fwd(P p) {
    __shared__ __attribute__((aligned(16))) char smem_all[2 * SMEM_BYTES + 64];
    const int wsid_ = __builtin_amdgcn_readfirstlane((int)(threadIdx.x >> 6));
    const int hb = wsid_ >> 2;
    char* smem = smem_all + hb * SMEM_BYTES;
    uint4& xb_words = *(uint4*)(smem_all + 2 * SMEM_BYTES);
    int& s_item = *(int*)(smem_all + 2 * SMEM_BYTES + 16);
    int& s_vb = *(int*)(smem_all + 2 * SMEM_BYTES + 20);
    if (TID512 == 0) xb_words = make_uint4(0u, 0u, 0u, 0u);
    __syncthreads();
    unsigned* ctl = (unsigned*)(KPARG.ws + WS_CTL);
    XcdBarrier bar = xcd_barrier_post(ctl, (volatile LAS unsigned*)&xb_words, wsid_);
#define xcd_barrier(b_) xcd_barrier_(b_, wsid_)
    const int bid = blockIdx.x * 2 + hb, nb = gridDim.x * 2;
    const unsigned my_xcc = xb_xcc_id();
    if (TID512 == 0) s_vb = (int)atomicAdd(&ctl[CTL_XR + 16 * my_xcc], 1u);
    int vb = bid;
    phase_setup(KPARG, wsid_, bid, nb);
    REPEAT(REP_MOD) phase_mod(KPARG, wsid_, bid, nb, smem);
    for (int l = 0; l < NLAYER; ++l) {
        const int nr = l < NLAYER - 1 ? MA : ML;
        REPEAT(REP_CONV) phase_conv(KPARG, wsid_, l, bid, nb, smem, l == 0 ? 3 : 2);
        if (l == 0) {
            xcd_barrier(bar);
            if (TID512 == 0) { int pre = 0; for (unsigned x = 0; x < my_xcc; ++x) pre += (int)xb_ld(&ctl[CTL_XR + 16 * x]); s_vb += pre; }
            __syncthreads();
            vb = __builtin_amdgcn_readfirstlane(s_vb) * 2 + hb;
        }
        phase_norm1(KPARG, wsid_, l, 0, bid, nb);
        REPEAT(REP_NORM1 - 1) { xcd_barrier(bar); phase_norm1(KPARG, wsid_, l, 0, bid, nb, false); }
        xcd_barrier(bar);
        REPEAT(REP_INPROJ) { phase_inproj256(KPARG, wsid_, l, vb >> 1, nb >> 1, smem_all, ctl + CTL_Q(l) + 8, &s_item); xcd_barrier(bar); }
        REPEAT(REP_RK) { phase_rk(KPARG, wsid_, l, bid, nb, smem); xcd_barrier(bar); }
        REPEAT(REP_SCANATT) {
            if (bid < 128) { REPEAT(REP_R4) phase_r4(KPARG, wsid_, l, bid, 128, smem); }
            else phase_gate(KPARG, wsid_, l, bid - 128, nb - 128, smem);
            asm volatile("s_waitcnt vmcnt(0)" ::: "memory");
            __syncthreads();
            if (TID512 == 0) { __builtin_amdgcn_fence(__ATOMIC_RELEASE, "agent"); asm volatile("s_waitcnt vmcnt(0)" ::: "memory"); xb_add(&ctl[CTL_Q(l) + 40], 1u); }
            REPEAT2(REP_ATT) phase_attn(KPARG, wsid_, l, l < NLAYER - 1, ctl + CTL_Q(l) + 16 * rep_ + 32 * rep2_, l < NLAYER - 1 ? nullptr : ctl + CTL_Q(l) + 8, &s_item, smem);
            if (TID512 == 0) {
                unsigned spins = 0;
                while (xb_ld(&ctl[CTL_Q(l) + 40]) < gridDim.x) { __builtin_amdgcn_s_sleep(1); if (++spins > (1u << 22)) break; }
                __builtin_amdgcn_fence(__ATOMIC_ACQUIRE, "agent");
                asm volatile("s_waitcnt vmcnt(0)" ::: "memory");
            }
            __syncthreads();
            phase_readout(KPARG, wsid_, l, nr, ctl + CTL_Q(l) + 48, &s_item);
            xcd_barrier(bar);
        }
        phase_outproj256(KPARG, wsid_, l, nr, vb >> 1, nb >> 1, smem_all, ctl + CTL_Q(l) + 8, &s_item);
        REPEAT(REP_OUTPROJ - 1) { xcd_barrier(bar); phase_outproj256(KPARG, wsid_, l, nr, vb >> 1, nb >> 1, smem_all, ctl + CTL_Q(l) + 8, &s_item, 0.f); }
        xcd_barrier(bar);
        phase_norm2_route(KPARG, wsid_, l, nr, bid, nb, smem);
        if (l + 1 < NLAYER && bid >= nr / 64) phase_conv(KPARG, wsid_, l + 1, bid - nr / 64, nb - nr / 64, smem, 1);
        phase_conv_drain(KPARG, wsid_, l, ctl + CTL_Q(l) + 8, &s_item, smem);
        REPEAT(REP_ROUTE - 1) { xcd_barrier(bar); phase_norm2_route(KPARG, wsid_, l, nr, bid, nb, smem, true); }
        xcd_barrier(bar);
        phase_experts256(KPARG, wsid_, l, vb >> 1, nb >> 1, ctl + CTL_RBC + 256 * l, smem_all);
        xcd_barrier(bar);
    }
    phase_norm1(KPARG, wsid_, NLAYER, 1, bid, nb);
}

extern "C" void kernel_launch(void* const* d_in, const int* in_sizes, int n_in, void* d_out, int out_size, void* d_ws, size_t ws_size, hipStream_t stream) {
    if (n_in != 36 || ws_size < WS_END) { fprintf(stderr, "kernel_launch: unexpected n_in %d or ws_size %zu < %zu\n", n_in, ws_size, (size_t)WS_END); return; }
    static int grid = 0;
    if (!grid) {
        int dev = 0, cus = 0, per_cu = 0;
        hipGetDevice(&dev);
        hipDeviceGetAttribute(&cus, hipDeviceAttributeMultiprocessorCount, dev);
        hipOccupancyMaxActiveBlocksPerMultiprocessor(&per_cu, (const void*)fwd, 512, 0);
        if (per_cu < 1) per_cu = 1;
        grid = cus;
    }
    P p{};
    const float** pp = (const float**)&p;
    for (int i = 0; i < 36; ++i) pp[i] = (const float*)d_in[i];
    p.out = (float*)d_out; p.ws = (char*)d_ws;
    hipMemsetAsync((char*)d_ws + WS_CTL, 0, 65536, stream);
    fwd<<<grid, 512, 0, stream>>>(p);
}
```
